# Optimizing an MI355X kernel written in HIP

```python
import math
import jax
import jax.numpy as jnp
from jax import lax
import numpy as np

D_MODEL = 2048
BATCH = 4
SEQ = 2048
DEPTH = 2

HEAD_DIM = 128
GDN_HEADS = 8
GDN_CONV = 4
GDN_CHUNK = 64
GDN_WIDTH = GDN_HEADS * HEAD_DIM
HGRN_HEADS = 8
HGRN_CHUNK = 16
HGRN_WIDTH = HGRN_HEADS * HEAD_DIM
DIL_GROUPS = ((128, 1), (512, 4), (2048, 16))
DIL_HEADS_PER_GROUP = 4
DIL_HEADS = len(DIL_GROUPS) * DIL_HEADS_PER_GROUP
DIL_WIDTH = DIL_HEADS * HEAD_DIM
MOBA_HEADS = 4
MOBA_BLOCK = 256
MOBA_TOPK = 3
MOBA_QUERY_CHUNK = 32
MOBA_WIDTH = MOBA_HEADS * HEAD_DIM
ROPE_THETA = 10000.0
N_EXPERTS = 16
N_EXPERT_GROUPS = 4
EXPERTS_PER_GROUP = N_EXPERTS // N_EXPERT_GROUPS
TOP_K = 2
D_EXPERT = 512
DEEPNORM_ALPHA = (2.0 * DEPTH) ** 0.25
DEEPNORM_BETA = (8.0 * DEPTH) ** -0.25
LN_EPS = 1e-5
RMS_EPS = 1e-6
NEG_INF = -1e30

_EVEN_PARTS = (3 * GDN_WIDTH, GDN_WIDTH, GDN_HEADS, GDN_HEADS, HGRN_WIDTH, HGRN_WIDTH, HGRN_WIDTH, HGRN_WIDTH)
EVEN_IN = sum(_EVEN_PARTS)
EVEN_SPLITS = tuple(int(s) for s in np.cumsum(_EVEN_PARTS)[:-1])
EVEN_OUT = GDN_WIDTH + HGRN_WIDTH
_ODD_PARTS = (DIL_WIDTH, DIL_WIDTH, DIL_WIDTH, MOBA_WIDTH, MOBA_WIDTH, MOBA_WIDTH)
ODD_IN = sum(_ODD_PARTS)
ODD_SPLITS = tuple(int(s) for s in np.cumsum(_ODD_PARTS)[:-1])
ODD_OUT = (DIL_HEADS_PER_GROUP + MOBA_HEADS) * HEAD_DIM
N_EVEN = (DEPTH + 1) // 2
N_ODD = DEPTH // 2

kernel_name = 'hybrid_gdn_hgrn2_dilated_moba_grouped_moe'


def layer_norm(x, gain, bias):
    xf = x.astype(jnp.float32)
    mu = jnp.mean(xf, axis=-1, keepdims=True)
    var = jnp.mean(jnp.square(xf - mu), axis=-1, keepdims=True)
    y = (xf - mu) * lax.rsqrt(var + LN_EPS) * gain.astype(jnp.float32) + bias.astype(jnp.float32)
    return y.astype(x.dtype)


def rms_norm(x, gain):
    return x * lax.rsqrt(jnp.mean(jnp.square(x), axis=-1, keepdims=True) + RMS_EPS) * gain.astype(jnp.float32)


def l2_normalize(x):
    return x * lax.rsqrt(jnp.sum(jnp.square(x), axis=-1, keepdims=True) + RMS_EPS)


def split_heads(x, n_heads):
    b, s, _ = x.shape
    return x.reshape(b, s, n_heads, -1).transpose(0, 2, 1, 3)


def merge_heads(x):
    b, n, s, dh = x.shape
    return x.transpose(0, 2, 1, 3).reshape(b, s, n * dh)


def to_chunks(x, c):
    b, h, s = x.shape[:3]
    return jnp.moveaxis(x.reshape(b, h, s // c, c, *x.shape[3:]), 2, 0)


def from_chunks(x):
    n, b, h, c, d = x.shape
    return jnp.moveaxis(x, 0, 2).reshape(b, h, n * c, d)


def rope_tables(seq_len, dim):
    inv_freq = ROPE_THETA ** (-jnp.arange(0, dim, 2, dtype=jnp.float32) / dim)
    ang = jnp.arange(seq_len, dtype=jnp.float32)[:, None] * inv_freq[None, :]
    return jnp.cos(ang), jnp.sin(ang)


def apply_rope(x, cos, sin):
    x1, x2 = jnp.split(x, 2, axis=-1)
    return jnp.concatenate([x1 * cos - x2 * sin, x2 * cos + x1 * sin], axis=-1)


def causal_short_conv(x, w):
    k = w.shape[0]
    s = x.shape[1]
    xp = jnp.pad(x, ((0, 0), (k - 1, 0), (0, 0)))
    return sum(xp[:, j:j + s, :] * w[j] for j in range(k))


def gated_delta_rule_chunked(q, k, v, g, beta):
    c = GDN_CHUNK
    b, h, s, dk = q.shape
    dv = v.shape[-1]
    qc, kc, vc = to_chunks(q, c), to_chunks(k, c), to_chunks(v, c)
    gcum = jnp.cumsum(to_chunks(g, c), axis=-1)
    bc = to_chunks(beta, c)
    strict = jnp.tril(jnp.ones((c, c), bool), -1)
    incl = jnp.tril(jnp.ones((c, c), bool))
    diff = gcum[..., :, None] - gcum[..., None, :]
    dec_strict = jnp.where(strict, jnp.exp(jnp.where(strict, diff, 0.0)), 0.0)
    dec_incl = jnp.where(incl, jnp.exp(jnp.where(incl, diff, 0.0)), 0.0)
    kk = jnp.einsum('nbhid,nbhjd->nbhij', kc, kc)
    a_mat = jnp.eye(c, dtype=q.dtype) + bc[..., :, None] * dec_strict * kk
    rhs = jnp.concatenate([bc[..., None] * vc, (bc * jnp.exp(gcum))[..., None] * kc], axis=-1)
    sol = lax.linalg.triangular_solve(a_mat, rhs, left_side=True, lower=True, unit_diagonal=True)
    u_base, w_mat = sol[..., :dv], sol[..., dv:]
    qk = jnp.einsum('nbhid,nbhjd->nbhij', qc, kc) * dec_incl
    q_dec = qc * jnp.exp(gcum)[..., None]
    k_dec = kc * jnp.exp(gcum[..., -1:] - gcum)[..., None]
    chunk_dec = jnp.exp(gcum[..., -1])

    def step(state, inp):
        u_b, w_c, q_d, qk_c, k_d, d_c = inp
        u = u_b - jnp.einsum('bhck,bhkv->bhcv', w_c, state)
        o = jnp.einsum('bhck,bhkv->bhcv', q_d, state) + jnp.einsum('bhij,bhjv->bhiv', qk_c, u)
        state = d_c[..., None, None] * state + jnp.einsum('bhck,bhcv->bhkv', k_d, u)
        return state, o

    s0 = jnp.zeros((b, h, dk, dv), q.dtype)
    _, o = lax.scan(step, s0, (u_base, w_mat, q_dec, qk, k_dec, chunk_dec))
    return from_chunks(o)


def hgrn2_chunked(q, f, i):
    c = HGRN_CHUNK
    b, h, s, fd = q.shape
    vd = i.shape[-1]
    qc, ic, fc = to_chunks(q, c), to_chunks(i, c), to_chunks(f, c)
    kc = 1.0 - fc
    bcum = jnp.cumsum(jnp.log(fc), axis=-2)
    q_dec = qc * jnp.exp(bcum)
    k_inv = kc * jnp.exp(-bcum)
    k_dec = kc * jnp.exp(bcum[..., -1:, :] - bcum)
    incl = jnp.tril(jnp.ones((c, c), bool))
    p = jnp.where(incl, jnp.einsum('nbhif,nbhjf->nbhij', q_dec, k_inv), 0.0)
    o_intra = jnp.einsum('nbhij,nbhjv->nbhiv', p, ic)
    chunk_dec = jnp.exp(bcum[..., -1, :])

    def step(state, inp):
        q_d, k_d, i_c, d_c = inp
        o = jnp.einsum('bhcf,bhfv->bhcv', q_d, state)
        state = d_c[..., None] * state + jnp.einsum('bhcf,bhcv->bhfv', k_d, i_c)
        return state, o

    s0 = jnp.zeros((b, h, fd, vd), q.dtype)
    _, o_inter = lax.scan(step, s0, (q_dec, k_dec, ic, chunk_dec))
    return from_chunks(o_intra + o_inter)


def even_mixer(x, w_in, conv_w, a_log, dt_bias, gdn_norm, hgrn_norm, lower_bound, w_out):
    f32 = jnp.float32
    h = jnp.einsum('bsd,de->bse', x, w_in).astype(f32)
    qkv_a, z_a, b_a, a_a, q_b, f_b, i_b, g_b = jnp.split(h, EVEN_SPLITS, axis=-1)
    qkv_a = jax.nn.silu(causal_short_conv(qkv_a, conv_w.astype(f32)))
    q_a, k_a, v_a = jnp.split(qkv_a, 3, axis=-1)
    q_a = l2_normalize(split_heads(q_a, GDN_HEADS)) * HEAD_DIM ** -0.5
    k_a = l2_normalize(split_heads(k_a, GDN_HEADS))
    v_a = split_heads(v_a, GDN_HEADS)
    beta = jax.nn.sigmoid(b_a).transpose(0, 2, 1)
    g = (-jnp.exp(a_log.astype(f32)) * jax.nn.softplus(a_a + dt_bias.astype(f32))).transpose(0, 2, 1)
    o_a = gated_delta_rule_chunked(q_a, k_a, v_a, g, beta)
    o_a = rms_norm(o_a, gdn_norm) * jax.nn.silu(split_heads(z_a, GDN_HEADS))
    lb = lower_bound.astype(f32).reshape(HGRN_HEADS, 1, HEAD_DIM)
    f = lb + (1.0 - lb) * jax.nn.sigmoid(split_heads(f_b, HGRN_HEADS))
    o_b = hgrn2_chunked(split_heads(q_b, HGRN_HEADS), f, split_heads(i_b, HGRN_HEADS))
    o_b = rms_norm(o_b, hgrn_norm) * jax.nn.silu(split_heads(g_b, HGRN_HEADS))
    o = merge_heads(jnp.concatenate([o_a, o_b], axis=1))
    return jnp.einsum('bse,ed->bsd', o.astype(x.dtype), w_out)


def banded_causal_attention(q, k, v, window):
    *lead, length, dh = q.shape
    w = window
    nb = -(-length // w)
    lp = nb * w
    lead_pad = [(0, 0)] * len(lead)
    qb = jnp.pad(q, lead_pad + [(0, lp - length), (0, 0)]).reshape(*lead, nb, w, dh)
    kp = jnp.pad(k, lead_pad + [(w, lp - length), (0, 0)]).reshape(*lead, nb + 1, w, dh)
    vp = jnp.pad(v, lead_pad + [(w, lp - length), (0, 0)]).reshape(*lead, nb + 1, w, dh)
    kcat = jnp.concatenate([kp[..., :-1, :, :], kp[..., 1:, :, :]], axis=-2)
    vcat = jnp.concatenate([vp[..., :-1, :, :], vp[..., 1:, :, :]], axis=-2)
    s = jnp.einsum('...nqd,...nkd->...nqk', qb, kcat) * dh ** -0.5
    r = jnp.arange(w)[:, None]
    c = jnp.arange(2 * w)[None, :]
    dist = r + w - c
    kpos = (jnp.arange(nb) * w)[:, None, None] + c[None] - w
    mask = (dist >= 0)[None] & (dist <= w)[None] & (kpos >= 0)
    s = jnp.where(mask, s, NEG_INF)
    m = jnp.max(s, axis=-1, keepdims=True)
    p = jnp.exp(s - m)
    den = jnp.sum(p, axis=-1)
    o = jnp.einsum('...nqk,...nkd->...nqd', p, vcat) / den[..., None]
    lse = m[..., 0] + jnp.log(den)
    o = o.reshape(*lead, lp, dh)[..., :length, :]
    lse = lse.reshape(*lead, lp)[..., :length]
    return o, lse


def dilated_window_attention(q, k, v, window, dilation):
    b, h, s, dh = q.shape
    length = s // dilation

    def to_sub(t):
        return t.reshape(b, h, length, dilation, dh).transpose(0, 1, 3, 2, 4)

    o, lse = banded_causal_attention(to_sub(q), to_sub(k), to_sub(v), window // dilation)
    o = o.transpose(0, 1, 3, 2, 4).reshape(b, h, s, dh)
    lse = lse.transpose(0, 1, 3, 2).reshape(b, h, s)
    return o, lse


def moba_attention(q, k, v):
    b, h, s, dh = q.shape
    blk = MOBA_BLOCK
    sp = -(-s // blk) * blk
    pad = ((0, 0), (0, 0), (0, sp - s), (0, 0))
    q, k, v = (jnp.pad(t, pad) for t in (q, k, v))
    n_blk = sp // blk
    k_blocks = k.reshape(b, h, n_blk, blk, dh)
    v_blocks = v.reshape(b, h, n_blk, blk, dh)
    k_mean = jnp.mean(k_blocks, axis=3)
    q_block_id = jnp.arange(sp) // blk
    fully_past = jnp.arange(n_blk)[None, :] < q_block_id[:, None]
    gate = jnp.where(fully_past, jnp.einsum('bhsd,bhnd->bhsn', q, k_mean), NEG_INF)
    top_k = min(MOBA_TOPK, n_blk)
    _, sel = lax.top_k(gate, top_k)
    sel_valid = jnp.arange(top_k)[None, :] < q_block_id[:, None]
    scale = dh ** -0.5
    qn = MOBA_QUERY_CHUNK
    b_idx = jnp.arange(b)[:, None, None, None]
    h_idx = jnp.arange(h)[None, :, None, None]

    def attend_chunk(ci):
        start = ci * qn
        q_c = lax.dynamic_slice_in_dim(q, start, qn, axis=2)
        sel_c = lax.dynamic_slice_in_dim(sel, start, qn, axis=2)
        valid_c = lax.dynamic_slice_in_dim(sel_valid, start, qn, axis=0)
        k_sel = k_blocks[b_idx, h_idx, sel_c]
        v_sel = v_blocks[b_idx, h_idx, sel_c]
        s_sel = jnp.einsum('bhqd,bhqnjd->bhqnj', q_c, k_sel) * scale
        s_sel = jnp.where(valid_c[None, None, :, :, None], s_sel, NEG_INF).reshape(b, h, qn, top_k * blk)
        own = start // blk
        k_own = lax.dynamic_index_in_dim(k_blocks, own, axis=2, keepdims=False)
        v_own = lax.dynamic_index_in_dim(v_blocks, own, axis=2, keepdims=False)
        q_pos = start + jnp.arange(qn)
        k_pos = own * blk + jnp.arange(blk)
        s_own = jnp.where(k_pos[None, :] <= q_pos[:, None],
                          jnp.einsum('bhqd,bhjd->bhqj', q_c, k_own) * scale, NEG_INF)
        p = jax.nn.softmax(jnp.concatenate([s_sel, s_own], axis=-1), axis=-1)
        p_sel = p[..., :top_k * blk].reshape(b, h, qn, top_k, blk)
        p_own = p[..., top_k * blk:]
        return jnp.einsum('bhqnj,bhqnjd->bhqd', p_sel, v_sel) + jnp.einsum('bhqj,bhjd->bhqd', p_own, v_own)

    out = lax.map(attend_chunk, jnp.arange(sp // qn))
    out = jnp.moveaxis(out, 0, 2).reshape(b, h, sp, dh)
    return out[:, :, :s]


def odd_mixer(x, w_in, w_out, cos, sin):
    h = jnp.einsum('bsd,de->bse', x, w_in).astype(jnp.float32)
    cq, ck, cv, dq, dk, dv = jnp.split(h, ODD_SPLITS, axis=-1)
    cq = apply_rope(split_heads(cq, DIL_HEADS), cos, sin)
    ck = apply_rope(split_heads(ck, DIL_HEADS), cos, sin)
    cv = split_heads(cv, DIL_HEADS)
    outs, lses = [], []
    for gi, (window, dilation) in enumerate(DIL_GROUPS):
        hs = slice(gi * DIL_HEADS_PER_GROUP, (gi + 1) * DIL_HEADS_PER_GROUP)
        o_g, l_g = dilated_window_attention(cq[:, hs], ck[:, hs], cv[:, hs], window, dilation)
        outs.append(o_g)
        lses.append(l_g)
    wts = jax.nn.softmax(jnp.stack(lses, axis=0), axis=0)
    o_c = jnp.sum(wts[..., None] * jnp.stack(outs, axis=0), axis=0)
    o_d = moba_attention(apply_rope(split_heads(dq, MOBA_HEADS), cos, sin),
                         apply_rope(split_heads(dk, MOBA_HEADS), cos, sin),
                         split_heads(dv, MOBA_HEADS))
    o = merge_heads(jnp.concatenate([o_c, o_d], axis=1))
    return jnp.einsum('bse,ed->bsd', o.astype(x.dtype), w_out)


def moe_ffn(x, router_w, router_bias, w_gate, w_up, w_down):
    b, s, d = x.shape
    t = x.reshape(b * s, d)
    scores = jax.nn.sigmoid(jnp.einsum('td,de->te', t, router_w).astype(jnp.float32))
    biased = scores + router_bias.astype(jnp.float32)
    grouped = biased.reshape(-1, N_EXPERT_GROUPS, EXPERTS_PER_GROUP)
    group_score = jnp.sum(lax.top_k(grouped, 2)[0], axis=-1)
    best_group = jnp.argmax(group_score, axis=-1)
    in_group = (jnp.arange(N_EXPERTS) // EXPERTS_PER_GROUP)[None, :] == best_group[:, None]
    _, top_idx = lax.top_k(jnp.where(in_group, biased, NEG_INF), TOP_K)
    top_scores = jnp.take_along_axis(scores, top_idx, axis=-1)
    weights = top_scores / jnp.sum(top_scores, axis=-1, keepdims=True)
    gates = jnp.sum(jax.nn.one_hot(top_idx, N_EXPERTS, dtype=jnp.float32) * weights[..., None], axis=1)
    hid = jax.nn.silu(jnp.einsum('td,edf->tef', t, w_gate)) * jnp.einsum('td,edf->tef', t, w_up)
    y = jnp.einsum('tef,efd->td', hid * gates[..., None].astype(hid.dtype), w_down)
    return y.reshape(b, s, d).astype(x.dtype)


def setup_inputs(seed: int = 0) -> dict:
    key = jax.random.key(seed)
    ks = jax.random.split(key, 20)
    f32 = jnp.float32

    def nrm(k, shape, scale):
        return jax.random.normal(k, shape, f32) * scale

    x = nrm(ks[0], (BATCH, SEQ, D_MODEL), 1.0)
    ev_w_in = nrm(ks[1], (N_EVEN, D_MODEL, EVEN_IN), D_MODEL ** -0.5)
    ev_conv_w = nrm(ks[2], (N_EVEN, GDN_CONV, 3 * GDN_WIDTH), GDN_CONV ** -0.5)
    ev_a_log = jnp.log(jax.random.uniform(ks[3], (N_EVEN, GDN_HEADS), f32, 1.0, 16.0))
    dt = jnp.exp(jax.random.uniform(ks[4], (N_EVEN, GDN_HEADS), f32, math.log(1e-3), math.log(1e-1)))
    ev_dt_bias = dt + jnp.log(-jnp.expm1(-dt))
    ev_gdn_norm = 1.0 + nrm(ks[5], (N_EVEN, HEAD_DIM), 0.02)
    ev_hgrn_norm = 1.0 + nrm(ks[6], (N_EVEN, HEAD_DIM), 0.02)
    hgrn_lb_logits = nrm(ks[7], (DEPTH + 1, HGRN_WIDTH), 0.1)
    ev_w_out = nrm(ks[8], (N_EVEN, EVEN_OUT, D_MODEL), EVEN_OUT ** -0.5 * DEEPNORM_BETA)
    od_w_in = nrm(ks[9], (N_ODD, D_MODEL, ODD_IN), D_MODEL ** -0.5)
    od_w_out = nrm(ks[10], (N_ODD, ODD_OUT, D_MODEL), ODD_OUT ** -0.5 * DEEPNORM_BETA)
    router_w = nrm(ks[11], (D_MODEL, N_EXPERTS), D_MODEL ** -0.5)
    router_bias = nrm(ks[12], (N_EXPERTS,), 0.01)
    moe_w_gate = nrm(ks[13], (DEPTH, N_EXPERTS, D_MODEL, D_EXPERT), D_MODEL ** -0.5)
    moe_w_up = nrm(ks[14], (DEPTH, N_EXPERTS, D_MODEL, D_EXPERT), D_MODEL ** -0.5)
    moe_w_down = nrm(ks[15], (DEPTH, N_EXPERTS, D_EXPERT, D_MODEL), D_EXPERT ** -0.5 * DEEPNORM_BETA)
    ln_gain = 1.0 + nrm(ks[16], (DEPTH, 2, D_MODEL), 0.02)
    ln_bias = nrm(ks[17], (DEPTH, 2, D_MODEL), 0.01)
    return {'x': x, 'ev_w_in': ev_w_in, 'ev_conv_w': ev_conv_w, 'ev_a_log': ev_a_log,
            'ev_dt_bias': ev_dt_bias, 'ev_gdn_norm': ev_gdn_norm, 'ev_hgrn_norm': ev_hgrn_norm,
            'hgrn_lb_logits': hgrn_lb_logits, 'ev_w_out': ev_w_out, 'od_w_in': od_w_in,
            'od_w_out': od_w_out, 'router_w': router_w, 'router_bias': router_bias,
            'moe_w_gate': moe_w_gate, 'moe_w_up': moe_w_up, 'moe_w_down': moe_w_down,
            'ln_gain': ln_gain, 'ln_bias': ln_bias}


def reference(x, ev_w_in, ev_conv_w, ev_a_log, ev_dt_bias, ev_gdn_norm, ev_hgrn_norm, hgrn_lb_logits,
              ev_w_out, od_w_in, od_w_out, router_w, router_bias, moe_w_gate, moe_w_up, moe_w_down,
              ln_gain, ln_bias):
    cos, sin = rope_tables(x.shape[1], HEAD_DIM)
    lower_bounds = jnp.cumsum(jax.nn.softmax(hgrn_lb_logits.astype(jnp.float32), axis=0), axis=0)
    h = x
    for layer in range(DEPTH):
        if layer % 2 == 0:
            e = layer // 2
            mix = even_mixer(h, ev_w_in[e], ev_conv_w[e], ev_a_log[e], ev_dt_bias[e], ev_gdn_norm[e],
                             ev_hgrn_norm[e], lower_bounds[layer], ev_w_out[e])
        else:
            o = layer // 2
            mix = odd_mixer(h, od_w_in[o], od_w_out[o], cos, sin)
        h = layer_norm(DEEPNORM_ALPHA * h + mix, ln_gain[layer, 0], ln_bias[layer, 0])
        ffn = moe_ffn(h, router_w, router_bias, moe_w_gate[layer], moe_w_up[layer], moe_w_down[layer])
        h = layer_norm(DEEPNORM_ALPHA * h + ffn, ln_gain[layer, 1], ln_bias[layer, 1])
    return h
```

```cpp
#include <hip/hip_runtime.h>
#include <cstdio>
#include <cstdint>

#define GAS __attribute__((address_space(1)))
#define LAS __attribute__((address_space(3)))
typedef unsigned short bf16_t;
typedef short bf16x8 __attribute__((ext_vector_type(8)));
typedef short bf16x4 __attribute__((ext_vector_type(4)));
typedef float f32x4 __attribute__((ext_vector_type(4)));
typedef float f32x2 __attribute__((ext_vector_type(2)));
typedef unsigned u32x4 __attribute__((ext_vector_type(4)));
typedef unsigned u32x2 __attribute__((ext_vector_type(2)));

constexpr int NB = 4, SEQ = 2048, T = NB * SEQ, D = 2048;
constexpr int EVEN_IN = 8208, ODD_IN = 6144;
constexpr int NE = 16, DEXP = 512;
constexpr float ALPHA = 1.4142135623730951f;
constexpr float LN_EPS = 1e-5f, RMS_EPS = 1e-6f;
constexpr int NWAVES = 8, NTHR = 512;
constexpr int LDS_BYTES = 147456;

constexpr size_t MiB = 1u << 20;
constexpr size_t WS_CTL = 0;
constexpr size_t WS_LIST = 1 * MiB;
constexpr size_t WS_GATEW = 2 * MiB;
constexpr size_t WS_BA = 2 * MiB + 512 * 1024;
constexpr size_t WS_ROPE = 3 * MiB;
constexpr size_t WS_KMEAN = 4 * MiB;
constexpr size_t WS_WREG = 8 * MiB;
constexpr size_t WS_WIN = WS_WREG;
constexpr size_t WS_AB8 = WS_WREG + 16 * MiB;
constexpr size_t WS_WOUT = WS_WREG + 32 * MiB;
constexpr size_t WS_WGU = WS_WREG + 40 * MiB;
constexpr size_t WS_WD = WS_WREG + 104 * MiB;
constexpr size_t WS_AB = WS_WREG + 136 * MiB;
constexpr size_t WS_H1 = WS_AB + 32 * MiB;
constexpr size_t WS_OC = WS_H1 + 128 * MiB;
constexpr size_t WS_MIX = WS_OC + 32 * MiB;
constexpr size_t WS_SCR = WS_MIX + 32 * MiB;
constexpr size_t WS_HID = WS_SCR;
constexpr size_t WS_Y2 = WS_SCR + 20 * MiB;
constexpr size_t WS_ABS = WS_SCR + 84 * MiB;
constexpr size_t WS_END = WS_SCR + 216 * MiB;
static_assert(WS_END == 584 * MiB, "workspace map");

typedef __bf16 bf16v2_t __attribute__((ext_vector_type(2)));
__device__ __forceinline__ unsigned pk2(float lo, float hi) { const f32x2 f = {lo, hi}; return __builtin_bit_cast(unsigned, __builtin_convertvector(f, bf16v2_t)); }
__device__ __forceinline__ unsigned f2bf(float f) { return pk2(f, 0.f) & 0xffffu; }
__device__ __forceinline__ unsigned pk4_fp8(float a, float b, float c, float d) {
    a = fminf(fmaxf(a, -448.f), 448.f); b = fminf(fmaxf(b, -448.f), 448.f); c = fminf(fmaxf(c, -448.f), 448.f); d = fminf(fmaxf(d, -448.f), 448.f);
    int w = 0; w = __builtin_amdgcn_cvt_pk_fp8_f32(a, b, w, false); w = __builtin_amdgcn_cvt_pk_fp8_f32(c, d, w, true); return (unsigned)w;
}
constexpr float W_PRE = 64.f;  constexpr int SC_W = 0x79797979;
constexpr float A_PRE = 4.f;   constexpr int SC_A4 = 0x7d7d7d7d;
constexpr int SC_A1 = 0x7f7f7f7f;
constexpr float X_PRE = 16.f;  constexpr int SC_A16 = 0x7b7b7b7b;
typedef int i32x8 __attribute__((ext_vector_type(8)));
__device__ __forceinline__ float bf2f(unsigned short b) { return __builtin_bit_cast(float, (unsigned)b << 16); }
__device__ __forceinline__ float bflo(unsigned w) { return __builtin_bit_cast(float, w << 16); }
__device__ __forceinline__ float bfhi(unsigned w) { return __builtin_bit_cast(float, w & 0xffff0000u); }
__device__ __forceinline__ unsigned cvt_pk_bf16(float lo, float hi) { return pk2(lo, hi); }
template <int CTRL> __device__ __forceinline__ float dpp_f(float x) { return __builtin_bit_cast(float, __builtin_amdgcn_update_dpp(0, __builtin_bit_cast(int, x), CTRL, 0xf, 0xf, true)); }
__device__ __forceinline__ float xor16_f(float x) { return __builtin_bit_cast(float, __builtin_amdgcn_ds_swizzle(__builtin_bit_cast(int, x), 0x401f)); }
__device__ __forceinline__ float row16_sum(float v) { v += dpp_f<0xB1>(v); v += dpp_f<0x4E>(v); v += dpp_f<0x141>(v); v += dpp_f<0x140>(v); return v; }
__device__ __forceinline__ float xor32_sum(float v) { const int i = __builtin_bit_cast(int, v); const auto r = __builtin_amdgcn_permlane32_swap(i, i, false, false);
    return __builtin_bit_cast(float, (int)r[0]) + __builtin_bit_cast(float, (int)r[1]); }
__device__ __forceinline__ float xor32_max(float v) { const int i = __builtin_bit_cast(int, v); const auto r = __builtin_amdgcn_permlane32_swap(i, i, false, false);
    return fmaxf(__builtin_bit_cast(float, (int)r[0]), __builtin_bit_cast(float, (int)r[1])); }
__device__ __forceinline__ float wave_sum(float v) { v = row16_sum(v); v += xor16_f(v); return xor32_sum(v); }
__device__ __forceinline__ float sigmoidf_(float x) { return 1.0f / (1.0f + __expf(-x)); }
__device__ __forceinline__ float siluf_(float x) { return x / (1.0f + __expf(-x)); }
#define LDS_WAIT() asm volatile("s_waitcnt lgkmcnt(0)" ::: "memory")
template <class Tp> __device__ __forceinline__ Tp* opq(Tp* x) { asm volatile("" : "+s"(x)); return x; }
template <class Tp> __device__ __forceinline__ Tp* opqg(Tp* x) { GAS Tp* g = (GAS Tp*)x; asm volatile("" : "+s"(g)); return (Tp*)g; }
__device__ __forceinline__ float ld_agent(const float* p) { return __hip_atomic_load(p, __ATOMIC_RELAXED, __HIP_MEMORY_SCOPE_AGENT); }

namespace pg8 {
constexpr int BM = 256, BK = 64, HALF = 128, HTB = HALF * BK * 2, STAGE_BYTES = 8 * HTB, NXCD = 8, WGM = 8;
__device__ __forceinline__ int lds_byte(int r, int c) { const int st = (r >> 4) * 2 + (c >> 5), rr = r & 15, cc = c & 31, ob = rr * 64 + cc * 2; return st * 1024 + (ob ^ (((ob >> 9) & 1) << 5)); }
__device__ __forceinline__ void stage_rc(int b, int& R, int& C) { const int st = b / 1024, sb = b % 1024, swz = sb ^ (((sb >> 9) & 1) << 5); R = (st >> 1) * 16 + swz / 64; C = (st & 1) * 32 + (swz % 64) / 2; }
__device__ __forceinline__ int perm32(int rho) { const int n = rho >> 4, i = rho & 15; return 8 * (i >> 2) + 4 * n + (i & 3); }

struct Unit { int pm, pn, e, cnt, arow0, brow0; };
struct Gemm { const unsigned char* A; const unsigned char* Bt; int K; unsigned abytes, bbytes; int sc_a; };

struct StaticOrder {
    static constexpr bool CONTIG = true;
    int nM, nN, nwg, G, c;
    __device__ void init(int M, int N, int G_, int c_) { nM = M / BM; nN = N / BM; nwg = nM * nN; G = G_; c = c_; }
    __device__ bool next(int i, Unit& u) const {
        const long L = (long)i * G + c; if (L >= nwg) return false;
        int wgid = (int)L; { const int q = nwg / NXCD, r = nwg % NXCD, xcd = wgid % NXCD, off = wgid / NXCD; wgid = (xcd < r ? xcd * (q + 1) : r * (q + 1) + (xcd - r) * q) + off; }
        const int nig = WGM * nN, gid = wgid / nig, fm = gid * WGM, gsz = (nM - fm) < WGM ? (nM - fm) : WGM;
        u.pm = fm + ((wgid % nig) % gsz); u.pn = (wgid % nig) / gsz; u.e = 0; u.cnt = 0; u.arow0 = u.pm * BM; u.brow0 = u.pn * BM; return true;
    }
    __device__ __forceinline__ unsigned arow(const Unit& u, int r) const { return (unsigned)(u.arow0 + r); }
    __device__ __forceinline__ void done(const Unit&, int) const {}
    struct State {};
    __device__ __forceinline__ bool first(State&, Unit& u, int) const { return next(0, u); }
    __device__ __forceinline__ void issue(State&, int, int) const {}
    __device__ __forceinline__ bool fin(State&, int i, Unit& u, int) const { return next(i, u); }
};

constexpr int MOE_TAB_OFF = 131072;
constexpr int MOE_HIST_OFF = 131072 + 3072;
__device__ __forceinline__ void moe_build_table(LAS unsigned char* lds, int tid) {
    LAS int* tab = (LAS int*)(lds + MOE_TAB_OFF);
    const LAS int* cnts = (const LAS int*)(lds + MOE_HIST_OFF) + 16;
    if (tid == 0) {
        int s = 0;
#pragma unroll 1
        for (int e = 0; e < NE; ++e) { const int c = cnts[e]; const int nt = (c + 255) >> 8;
#pragma unroll 1
            for (int k = 0; k < nt; ++k) { tab[4 + 4 * (s + k)] = e; tab[4 + 4 * (s + k) + 1] = k; tab[4 + 4 * (s + k) + 2] = c; }
            s += nt; }
        tab[0] = s;
    }
    __syncthreads();
}
template <int NPN, bool GATHER>
struct MoeOrder {
    static constexpr bool CONTIG = !GATHER;
    const int* list;
    LAS const int* tab; int G, c, brows;
    unsigned* tcnt;
    __device__ void init(LAS unsigned char* lds, const int* list_, int G_, int c_, int brows_, unsigned* tcnt_ = nullptr) { list = list_; G = G_; c = c_; brows = brows_; tab = (LAS const int*)(lds + MOE_TAB_OFF); tcnt = tcnt_; }
    __device__ __forceinline__ void done(const Unit& u, int lane) const {
        if (tcnt) { asm volatile("s_waitcnt vmcnt(0)" ::: "memory"); if (lane == 0) __hip_atomic_fetch_add(tcnt + (u.arow0 >> 8), 1u, __ATOMIC_RELAXED, __HIP_MEMORY_SCOPE_AGENT); }
    }
    __device__ bool next(int i, Unit& u) const {
        int L = i * G + c; const int ntile = __builtin_amdgcn_readfirstlane(tab[0]); if (L >= ntile * NPN) return false;
        if (NPN == 4 && i == 0 && G == 256) L = (c & 7) * 32 + (c >> 3);
        const int tile = L / NPN; u.pn = L % NPN;
        u.e = __builtin_amdgcn_readfirstlane(tab[4 + 4 * tile]); u.pm = __builtin_amdgcn_readfirstlane(tab[4 + 4 * tile + 1]); u.cnt = __builtin_amdgcn_readfirstlane(tab[4 + 4 * tile + 2]);
        u.arow0 = tile * BM; u.brow0 = u.e * brows + u.pn * BM; return true;
    }
    __device__ __forceinline__ unsigned arow(const Unit& u, int r) const {
        if (!GATHER) return (unsigned)(u.arow0 + r);
        int idx = u.pm * BM + r; if (idx >= u.cnt) idx = 0;
        return (unsigned)(list[u.e * T + idx] >> 1);
    }
    struct State {};
    __device__ __forceinline__ bool first(State&, Unit& u, int) const { return next(0, u); }
    __device__ __forceinline__ void issue(State&, int, int) const {}
    __device__ __forceinline__ bool fin(State&, int i, Unit& u, int) const { return next(i, u); }
};
constexpr int MOE_Q_OFF = 131072 + 3072 + 512;
struct MoeDownS {
    static constexpr bool CONTIG = true;
    typedef __attribute__((address_space(1))) unsigned gu32;
    LAS const int* tab; LAS unsigned* slot; gu32* tcnt; int brows, G, c;
    struct State {};
    __device__ void init(LAS unsigned char* lds, unsigned* tcnt_, int brows_, int G_, int c_) { tab = (LAS const int*)(lds + MOE_TAB_OFF); slot = (LAS unsigned*)(lds + MOE_Q_OFF); tcnt = (gu32*)tcnt_; brows = brows_; G = G_; c = c_; }
    __device__ __forceinline__ unsigned nunits() const { return (unsigned)__builtin_amdgcn_readfirstlane(tab[0]) * 8u; }
    __device__ __forceinline__ unsigned qof(int k) const {
        const int nG = __builtin_amdgcn_readfirstlane(tab[0]) * 4, h = nG % G, nl = G - h;
        return (unsigned)(c >= h ? k * nl + (k >= 3 ? (k - 2) * h : 0) + (c - h) : (k + 3) * nl + k * h + c);
    }
    __device__ __forceinline__ void wait_tile(unsigned q, unsigned cv) const {
        unsigned sp = 0;
        while (cv < 32u) { __builtin_amdgcn_s_sleep(2); if (++sp > (1u << 22)) break; cv = __hip_atomic_load(tcnt + (q >> 3), __ATOMIC_RELAXED, __HIP_MEMORY_SCOPE_AGENT); }
        asm volatile("buffer_inv sc1" ::: "memory");
    }
    __device__ __forceinline__ bool decode(unsigned q, Unit& u) const {
        if (q >= nunits()) return false;
        const int tile = (int)(q >> 3); u.pn = (int)(q & 7u);
        u.e = __builtin_amdgcn_readfirstlane(tab[4 + 4 * tile]); u.pm = __builtin_amdgcn_readfirstlane(tab[4 + 4 * tile + 1]); u.cnt = __builtin_amdgcn_readfirstlane(tab[4 + 4 * tile + 2]);
        u.arow0 = tile * BM; u.brow0 = u.e * brows + u.pn * BM; return true;
    }
    __device__ __forceinline__ bool first(State&, Unit& u, int tid) const {
        const unsigned q = qof(0);
        if (tid == 0 && q < nunits()) wait_tile(q, __hip_atomic_load(tcnt + (q >> 3), __ATOMIC_RELAXED, __HIP_MEMORY_SCOPE_AGENT));
        __syncthreads();
        return decode(q, u);
    }
    __device__ __forceinline__ void issue(State&, int i, int tid) const {
        const unsigned q = qof(i);
        if (tid == 0 && q < nunits()) {
            const __amdgpu_buffer_rsrc_t rc = __builtin_amdgcn_make_buffer_rsrc((void*)tcnt, (short)0, 128 * 4, 0x00020000);
            __builtin_amdgcn_raw_ptr_buffer_load_lds(rc, (LAS void*)slot, 4, (int)((q >> 3) * 4u), 0, 0, 16);
        }
    }
    __device__ __forceinline__ bool fin(State&, int i, Unit& u, int tid) const {
        const unsigned q = qof(i);
        if (tid == 0 && q < nunits()) {
            unsigned cv; asm volatile("ds_read_b32 %0, %1\n\ts_waitcnt lgkmcnt(0)" : "=v"(cv) : "v"((unsigned)(size_t)slot) : "memory");
            wait_tile(q, cv);
        }
        return decode(q, u);
    }
    __device__ __forceinline__ unsigned arow(const Unit& u, int r) const { return (unsigned)(u.arow0 + r); }
    __device__ __forceinline__ void done(const Unit&, int) const {}
};

struct EpiBf16 {
    static constexpr bool PERM = true;
    bf16_t* O; int ldc; unsigned obytes;
    __device__ __forceinline__ void operator()(const f32x4 (&acc)[2][2][4][2], const Unit& u, int wr, int wc, int fr, int fq) const {
        const __amdgpu_buffer_rsrc_t rO = __builtin_amdgcn_make_buffer_rsrc((void*)O, (short)0, (int)obytes, 0x00020000);
        const unsigned voff = (unsigned)((wr * 64 + fr) * ldc + wc * 32 + 8 * fq) * 2u;
        const unsigned sbase = (unsigned)(u.pm * BM * ldc + u.pn * BM) * 2u;
#pragma unroll
        for (int ai = 0; ai < 2; ++ai)
#pragma unroll
            for (int m = 0; m < 4; ++m)
#pragma unroll
                for (int bj = 0; bj < 2; ++bj) { const f32x4 v0 = acc[ai][bj][m][0], v1 = acc[ai][bj][m][1];
                    u32x4 w; w.x = cvt_pk_bf16(v0[0], v0[1]); w.y = cvt_pk_bf16(v0[2], v0[3]); w.z = cvt_pk_bf16(v1[0], v1[1]); w.w = cvt_pk_bf16(v1[2], v1[3]);
                    __builtin_amdgcn_raw_buffer_store_b128(w, rO, (int)voff, (int)(sbase + (unsigned)((ai * HALF + m * 16) * ldc + bj * HALF) * 2u), 0); }
    }
};
struct EpiGateUp {
    static constexpr bool PERM = true;
    unsigned char* HID; const int* list; const float* gatew;
    __device__ __forceinline__ void operator()(const f32x4 (&acc)[2][2][4][2], const Unit& u, int wr, int wc, int fr, int fq) const {
        const int col0 = u.pn * 128 + wc * 32 + 8 * fq;
#pragma unroll
        for (int ai = 0; ai < 2; ++ai)
#pragma unroll
            for (int m = 0; m < 4; ++m) {
                const int r = ai * HALF + wr * 64 + m * 16 + fr; const int idx = u.pm * BM + r;
                float wgt = 0.f; if (idx < u.cnt) wgt = gatew[list[u.e * T + idx]] * A_PRE;
                const f32x4 g0 = acc[ai][0][m][0], g1 = acc[ai][0][m][1], u0 = acc[ai][1][m][0], u1 = acc[ai][1][m][1];
                float h[8];
#pragma unroll
                for (int i = 0; i < 4; ++i) { h[i] = siluf_(g0[i]) * u0[i] * wgt; h[4 + i] = siluf_(g1[i]) * u1[i] * wgt; }
                u32x2 w; w.x = pk4_fp8(h[0], h[1], h[2], h[3]); w.y = pk4_fp8(h[4], h[5], h[6], h[7]);
                *(u32x2*)(HID + (size_t)(u.arow0 + r) * DEXP + col0) = w;
            }
    }
};
struct EpiGateUpB {
    static constexpr bool PERM = true;
    bf16_t* HID; const int* list; const float* gatew;
    __device__ __forceinline__ void operator()(const f32x4 (&acc)[2][2][4][2], const Unit& u, int wr, int wc, int fr, int fq) const {
        const __amdgpu_buffer_rsrc_t rH = __builtin_amdgcn_make_buffer_rsrc((void*)HID, (short)0, 20480 * 512 * 2, 0x00020000);
        const __amdgpu_buffer_rsrc_t rL = __builtin_amdgcn_make_buffer_rsrc((void*)(list + (size_t)u.e * T), (short)0, T * 4, 0x00020000);
        const __amdgpu_buffer_rsrc_t rG = __builtin_amdgcn_make_buffer_rsrc((void*)gatew, (short)0, 2 * T * 4, 0x00020000);
        const unsigned voff = (unsigned)((wr * 64 + fr) * DEXP + u.pn * 128 + wc * 32 + 8 * fq) * 2u;
        const int idx0 = u.pm * BM + wr * 64 + fr;
#pragma unroll
        for (int ai = 0; ai < 2; ++ai)
#pragma unroll
            for (int m = 0; m < 4; ++m) {
                const int idx = idx0 + ai * HALF + m * 16;
                const int ent = __builtin_amdgcn_raw_buffer_load_b32(rL, idx * 4, 0, 0);
                float wgt = __builtin_bit_cast(float, __builtin_amdgcn_raw_buffer_load_b32(rG, (idx < u.cnt ? ent : 0) * 4, 0, 0)); wgt = idx < u.cnt ? wgt : 0.f;
                const f32x4 g0 = acc[ai][0][m][0], g1 = acc[ai][0][m][1], u0 = acc[ai][1][m][0], u1 = acc[ai][1][m][1];
                float h[8];
#pragma unroll
                for (int i = 0; i < 4; ++i) { h[i] = siluf_(g0[i]) * u0[i] * wgt; h[4 + i] = siluf_(g1[i]) * u1[i] * wgt; }
                u32x4 w; w.x = cvt_pk_bf16(h[0], h[1]); w.y = cvt_pk_bf16(h[2], h[3]); w.z = cvt_pk_bf16(h[4], h[5]); w.w = cvt_pk_bf16(h[6], h[7]);
                __builtin_amdgcn_raw_buffer_store_b128(w, rH, (int)voff, (int)((u.arow0 + ai * HALF + m * 16) * DEXP * 2), 16);
            }
    }
};
struct EpiDown {
    static constexpr bool PERM = true;
    bf16_t* Y2; const int* list;
    __device__ __forceinline__ void operator()(const f32x4 (&acc)[2][2][4][2], const Unit& u, int wr, int wc, int fr, int fq) const {
        const int col0 = u.pn * BM + wc * 32 + 8 * fq;
#pragma unroll
        for (int ai = 0; ai < 2; ++ai)
#pragma unroll
            for (int m = 0; m < 4; ++m) {
                const int r = ai * HALF + wr * 64 + m * 16 + fr; const int idx = u.pm * BM + r;
                if (idx < u.cnt) { const int ent = list[u.e * T + idx]; bf16_t* rowp = Y2 + (size_t)ent * D + col0;
#pragma unroll
                    for (int bj = 0; bj < 2; ++bj) { const f32x4 v0 = acc[ai][bj][m][0], v1 = acc[ai][bj][m][1];
                        u32x4 w; w.x = cvt_pk_bf16(v0[0], v0[1]); w.y = cvt_pk_bf16(v0[2], v0[3]); w.z = cvt_pk_bf16(v1[0], v1[1]); w.w = cvt_pk_bf16(v1[2], v1[3]);
                        *(u32x4*)(rowp + bj * HALF) = w; } }
            }
    }
};

constexpr int NXT_OFF = 131072 + 4096;
template <class Epi, class Sched>
__device__ __forceinline__ void gemm_phase(LAS unsigned char* lds, int wave_id, const Gemm g, const Sched& S, const Epi& E) {
    int lane; asm volatile("v_mbcnt_lo_u32_b32 %0, -1, 0\n\tv_mbcnt_hi_u32_b32 %0, -1, %0" : "=v"(lane));
    const int wid = wave_id, tid = wid * 64 + lane, wr = wid >> 2, wc = wid & 3, fr = lane & 15, fq = lane >> 4;
    const int K = g.K, nt = K / 128;
    unsigned voffB[2];
#pragma unroll
    for (int i = 0; i < 2; ++i) { int R, C; stage_rc(tid * 16 + i * 8192, R, C); const int Rb = Epi::PERM ? ((R & ~31) + perm32(R & 31)) : R; voffB[i] = (unsigned)(Rb * K + 2 * C); }
    const unsigned ldsw = (unsigned)wid * 1024u;
    const int aoff = lds_byte(wr * 64 + fr, 16 * (fq & 1)) + (fq >> 1) * 1024, boff = lds_byte(wc * 32 + fr, 16 * (fq & 1)) + (fq >> 1) * 1024;
    LAS unsigned char* ldsB = lds + 4 * HTB + boff;
    LAS unsigned char* ldsA = lds + aoff;
    const int sc_act = g.sc_a;
#define PG8_SA(b, h) (((b) * 2 + (h)) * HTB)
#define PG8_SB(b, h) ((4 + (b) * 2 + (h)) * HTB)
#define PG8_STAGE(bufoff, rsrc, soff, voff) do { _Pragma("unroll") for (int _i = 0; _i < 2; ++_i) \
        __builtin_amdgcn_raw_ptr_buffer_load_lds(rsrc, (LAS void*)(lds + (bufoff) + ldsw + _i * 8192), 16, (int)(voff)[_i], (int)(soff), 0, 0); } while (0)
#define PG8_LD32(dstv, addr) do { const u32x4 _c0 = *(const LAS u32x4*)(lds + (addr)), _c1 = *(const LAS u32x4*)(lds + (addr) + 16); dstv = (i32x8){(int)_c0.x, (int)_c0.y, (int)_c0.z, (int)_c0.w, (int)_c1.x, (int)_c1.y, (int)_c1.z, (int)_c1.w}; } while (0)
#define PG8_LDA(dst, b, h) do { _Pragma("unroll") for (int m = 0; m < 4; ++m) { const u32x4 _c0 = *(const LAS u32x4*)(ldsA + PG8_SA(b, h) + m * 2048), _c1 = *(const LAS u32x4*)(ldsA + PG8_SA(b, h) + m * 2048 + 16); \
        dst[m] = (i32x8){(int)_c0.x, (int)_c0.y, (int)_c0.z, (int)_c0.w, (int)_c1.x, (int)_c1.y, (int)_c1.z, (int)_c1.w}; } } while (0)
#define PG8_LDB(dst, b, h) do { _Pragma("unroll") for (int n = 0; n < 2; ++n) { const u32x4 _c0 = *(const LAS u32x4*)(ldsB + ((b) * 2 + (h)) * HTB + n * 2048), _c1 = *(const LAS u32x4*)(ldsB + ((b) * 2 + (h)) * HTB + n * 2048 + 16); \
        dst[n] = (i32x8){(int)_c0.x, (int)_c0.y, (int)_c0.z, (int)_c0.w, (int)_c1.x, (int)_c1.y, (int)_c1.z, (int)_c1.w}; } } while (0)
#define PG8_MMA(ai, bj, At, Bt) do { __builtin_amdgcn_sched_barrier(0); __builtin_amdgcn_s_setprio(1); _Pragma("unroll") for (int m = 0; m < 4; ++m) _Pragma("unroll") for (int n = 0; n < 2; ++n) \
        acc[ai][bj][m][n] = __builtin_amdgcn_mfma_scale_f32_16x16x128_f8f6f4(Bt[n], At[m], acc[ai][bj][m][n], 0, 0, 0, SC_W, 0, sc_act); \
        _Pragma("unroll") for (int m = 0; m < 4; ++m) asm volatile("" :: "v"(acc[ai][bj][m][0]), "v"(acc[ai][bj][m][1]));     \
        __builtin_amdgcn_s_setprio(0); __builtin_amdgcn_sched_barrier(0); } while (0)
#define PG8_WAIT_V(n) asm volatile("s_waitcnt vmcnt(" #n ")" ::: "memory")
#define PG8_WAIT_L(n) asm volatile("s_waitcnt lgkmcnt(" #n ")" ::: "memory")
#define PG8_BAR __builtin_amdgcn_s_barrier()
#define PG8_SCHED __builtin_amdgcn_sched_barrier(0)
#define PG8_AOFFS(u, o0, o1) do { _Pragma("unroll") for (int _i = 0; _i < 2; ++_i) { int _R, _C; stage_rc(tid * 16 + _i * 8192, _R, _C); \
        o0[_i] = S.arow(u, _R) * (unsigned)K + 2u * (unsigned)_C; o1[_i] = S.arow(u, HALF + _R) * (unsigned)K + 2u * (unsigned)_C; } } while (0)
    Unit cur, nxt; int ui = 0;
    if (!S.next(0, cur)) return;
    f32x4 acc[2][2][4][2];
#pragma unroll
    for (int a = 0; a < 2; ++a)
#pragma unroll
        for (int b = 0; b < 2; ++b)
#pragma unroll
            for (int m = 0; m < 4; ++m)
#pragma unroll
                for (int n = 0; n < 2; ++n) acc[a][b][m][n] = (f32x4){0.f, 0.f, 0.f, 0.f};
    i32x8 At[4], B0[2], B1[2];
    unsigned cA0[2], cA1[2];
    PG8_AOFFS(cur, cA0, cA1);
    const __amdgpu_buffer_rsrc_t rA = __builtin_amdgcn_make_buffer_rsrc((void*)g.A, (short)0, (int)g.abytes, 0x00020000);
    const __amdgpu_buffer_rsrc_t rB = __builtin_amdgcn_make_buffer_rsrc((void*)g.Bt, (short)0, (int)g.bbytes, 0x00020000);
    const unsigned kstep = (unsigned)(BK * 2);
    const unsigned hstep = (unsigned)HALF * (unsigned)K;
    unsigned cB = (unsigned)cur.brow0 * (unsigned)K;
    PG8_STAGE(PG8_SB(0, 0), rB, cB, voffB); PG8_STAGE(PG8_SB(0, 1), rB, cB + hstep, voffB); PG8_STAGE(PG8_SA(0, 0), rA, 0u, cA0); PG8_STAGE(PG8_SA(0, 1), rA, 0u, cA1);
    if (wr == 1) PG8_BAR;
    PG8_WAIT_V(2); PG8_BAR;
    PG8_STAGE(PG8_SB(1, 0), rB, cB + kstep, voffB); PG8_STAGE(PG8_SA(1, 0), rA, kstep, cA0); PG8_STAGE(PG8_SB(1, 1), rB, cB + hstep + kstep, voffB);
    PG8_WAIT_V(6); PG8_BAR;
#define PG8_PAIR(a1, a2, b2, SWITCH) do { \
            PG8_LDB(B0, 0, 0); PG8_LDB(B1, 0, 1); PG8_SCHED; PG8_LDA(At, 0, 0); PG8_STAGE(PG8_SA(1, 1), rA, a1, cA1); \
            SWITCH; \
            PG8_WAIT_V(8); PG8_WAIT_L(0); PG8_BAR; PG8_MMA(0, 0, At, B0); PG8_MMA(0, 1, At, B1); PG8_BAR; PG8_SCHED; \
            PG8_LDA(At, 0, 1); PG8_STAGE(PG8_SB(0, 0), rB, b2, voffB); PG8_STAGE(PG8_SB(0, 1), rB, (b2) + hstep, voffB); PG8_STAGE(PG8_SA(0, 0), rA, a2, cA0); \
            PG8_WAIT_V(8); PG8_WAIT_L(0); PG8_BAR; PG8_MMA(1, 0, At, B0); PG8_MMA(1, 1, At, B1); PG8_BAR; PG8_SCHED; \
            PG8_LDB(B0, 1, 0); PG8_LDB(B1, 1, 1); PG8_SCHED; PG8_LDA(At, 1, 0); PG8_STAGE(PG8_SA(0, 1), rA, a2, cA1); \
            PG8_WAIT_V(8); PG8_WAIT_L(0); PG8_BAR; PG8_MMA(0, 0, At, B0); PG8_MMA(0, 1, At, B1); PG8_BAR; PG8_SCHED; \
            PG8_LDA(At, 1, 1); PG8_STAGE(PG8_SB(1, 0), rB, (b2) + kstep, voffB); PG8_STAGE(PG8_SB(1, 1), rB, (b2) + kstep + hstep, voffB); PG8_STAGE(PG8_SA(1, 0), rA, (a2) + kstep, cA0); \
            PG8_WAIT_V(8); PG8_WAIT_L(0); PG8_BAR; PG8_MMA(1, 0, At, B0); PG8_MMA(1, 1, At, B1); PG8_BAR; PG8_SCHED; } while (0)
    for (;;) {
        const bool has_next = S.next(ui + 1, nxt);
        const unsigned nB = has_next ? (unsigned)nxt.brow0 * (unsigned)K : cB;
        unsigned dlt = 0u;
        if constexpr (Sched::CONTIG) { dlt = has_next ? (unsigned)(nxt.arow0 - cur.arow0) * (unsigned)K : 0u; }
        else { unsigned n0[2], n1[2]; if (has_next) { PG8_AOFFS(nxt, n0, n1); } else { n0[0] = cA0[0]; n0[1] = cA0[1]; n1[0] = cA1[0]; n1[1] = cA1[1]; }
          *((LAS u32x4*)(lds + NXT_OFF) + tid) = (u32x4){n0[0], n0[1], n1[0], n1[1]}; }
        for (int t = 0; t < nt - 2; t += 2) {
            const unsigned a1 = (unsigned)(t + 1) * kstep, a2 = (unsigned)(t + 2) * kstep, b2 = cB + (unsigned)(t + 2) * kstep;
            PG8_PAIR(a1, a2, b2, (void)0);
        }
        {
            const unsigned a1 = (unsigned)(nt - 1) * kstep;
            PG8_PAIR(a1, 0u, nB, do { if constexpr (Sched::CONTIG) { cA0[0] += dlt; cA0[1] += dlt; cA1[0] += dlt; cA1[1] += dlt; } else { const u32x4 _n = *((LAS u32x4*)(lds + NXT_OFF) + tid); cA0[0] = _n.x; cA0[1] = _n.y; cA1[0] = _n.z; cA1[1] = _n.w; } } while (0));
        }
        { int l2; asm volatile("v_mbcnt_lo_u32_b32 %0, -1, 0\n\tv_mbcnt_hi_u32_b32 %0, -1, %0" : "=v"(l2));
          E(acc, cur, wr, wc, l2 & 15, l2 >> 4); S.done(cur, l2); }
        if (!has_next) break;
#pragma unroll
        for (int a = 0; a < 2; ++a)
#pragma unroll
            for (int b = 0; b < 2; ++b)
#pragma unroll
                for (int m = 0; m < 4; ++m)
#pragma unroll
                    for (int n = 0; n < 2; ++n) acc[a][b][m][n] = (f32x4){0.f, 0.f, 0.f, 0.f};
        cur = nxt; cB = nB; ++ui;
    }
    PG8_WAIT_V(0);
    if (wr == 0) PG8_BAR;
    PG8_BAR;
#undef PG8_PAIR
#undef PG8_AOFFS
#undef PG8_SA
#undef PG8_SB
#undef PG8_STAGE
#undef PG8_LDA
#undef PG8_LDB
#undef PG8_MMA
#undef PG8_WAIT_V
#undef PG8_WAIT_L
#undef PG8_BAR
#undef PG8_SCHED
}
struct Gemm16 { const bf16_t* A; const bf16_t* Bt; int K; unsigned abytes, bbytes; };
struct EpiGateUp16 {
    static constexpr bool PERM = true;
    bf16_t* HID; const int* list; const float* gatew;
    __device__ __forceinline__ void operator()(const f32x4 (&acc)[2][2][4][2], const Unit& u, int wr, int wc, int fr, int fq) const {
        const int col0 = u.pn * 128 + wc * 32 + 8 * fq;
#pragma unroll
        for (int ai = 0; ai < 2; ++ai)
#pragma unroll
            for (int m = 0; m < 4; ++m) {
                const int r = ai * HALF + wr * 64 + m * 16 + fr; const int idx = u.pm * BM + r;
                float wgt = 0.f; if (idx < u.cnt) wgt = gatew[list[u.e * T + idx]];
                const f32x4 g0 = acc[ai][0][m][0], g1 = acc[ai][0][m][1], u0 = acc[ai][1][m][0], u1 = acc[ai][1][m][1];
                float h[8];
#pragma unroll
                for (int i = 0; i < 4; ++i) { h[i] = siluf_(g0[i]) * u0[i] * wgt; h[4 + i] = siluf_(g1[i]) * u1[i] * wgt; }
                u32x4 w; w.x = cvt_pk_bf16(h[0], h[1]); w.y = cvt_pk_bf16(h[2], h[3]); w.z = cvt_pk_bf16(h[4], h[5]); w.w = cvt_pk_bf16(h[6], h[7]);
                *(u32x4*)(HID + (size_t)(u.arow0 + r) * DEXP + col0) = w;
            }
    }
};
template <class Epi, class Sched>
__device__ __forceinline__ void gemm_phase16(LAS unsigned char* lds, int wave_id, const Gemm16 g, const Sched& S, const Epi& E) {
    int lane; asm volatile("v_mbcnt_lo_u32_b32 %0, -1, 0\n\tv_mbcnt_hi_u32_b32 %0, -1, %0" : "=v"(lane));
    const int wid = wave_id, tid = wid * 64 + lane, wr = wid >> 2, wc = wid & 3, fr = lane & 15, fq = lane >> 4;
    const int K = g.K, nt = K / BK;
    unsigned voffB[2];
#pragma unroll
    for (int i = 0; i < 2; ++i) { int R, C; stage_rc(tid * 16 + i * 8192, R, C); const int Rb = Epi::PERM ? ((R & ~31) + perm32(R & 31)) : R; voffB[i] = (unsigned)(Rb * K + C) * 2u; }
    const unsigned ldsw = (unsigned)wid * 1024u;
    const int aoff = lds_byte(wr * 64 + fr, fq * 8), boff = lds_byte(wc * 32 + fr, fq * 8);
#define PG8_SA(b, h) (((b) * 2 + (h)) * HTB)
#define PG8_SB(b, h) ((4 + (b) * 2 + (h)) * HTB)
#define PG8_STAGE(bufoff, rsrc, soff, voff) do { _Pragma("unroll") for (int _i = 0; _i < 2; ++_i) \
        __builtin_amdgcn_raw_ptr_buffer_load_lds(rsrc, (LAS void*)(lds + (bufoff) + ldsw + _i * 8192), 16, (int)(voff)[_i], (int)(soff), 0, 0); } while (0)
#define PG8_LDA(dst, b, h) do { _Pragma("unroll") for (int m = 0; m < 4; ++m) _Pragma("unroll") for (int k = 0; k < 2; ++k) dst[m][k] = *(const LAS bf16x8*)(lds + PG8_SA(b, h) + aoff + m * 2048 + k * 1024); } while (0)
#define PG8_LDB(dst, b, h) do { _Pragma("unroll") for (int n = 0; n < 2; ++n) _Pragma("unroll") for (int k = 0; k < 2; ++k) dst[n][k] = *(const LAS bf16x8*)(lds + PG8_SB(b, h) + boff + n * 2048 + k * 1024); } while (0)
#define PG8_MMA(ai, bj, At, Bt) do { __builtin_amdgcn_s_setprio(1); _Pragma("unroll") for (int m = 0; m < 4; ++m) _Pragma("unroll") for (int n = 0; n < 2; ++n) _Pragma("unroll") for (int k = 0; k < 2; ++k) \
        acc[ai][bj][m][n] = __builtin_amdgcn_mfma_f32_16x16x32_bf16(Bt[n][k], At[m][k], acc[ai][bj][m][n], 0, 0, 0); __builtin_amdgcn_s_setprio(0); } while (0)
#define PG8_WAIT_V(n) asm volatile("s_waitcnt vmcnt(" #n ")" ::: "memory")
#define PG8_WAIT_L(n) asm volatile("s_waitcnt lgkmcnt(" #n ")" ::: "memory")
#define PG8_BAR __builtin_amdgcn_s_barrier()
#define PG8_SCHED __builtin_amdgcn_sched_barrier(0)
#define PG8_AOFFS(u, o0, o1) do { _Pragma("unroll") for (int _i = 0; _i < 2; ++_i) { int _R, _C; stage_rc(tid * 16 + _i * 8192, _R, _C); \
        o0[_i] = (S.arow(u, _R) * (unsigned)K + (unsigned)_C) * 2u; o1[_i] = (S.arow(u, HALF + _R) * (unsigned)K + (unsigned)_C) * 2u; } } while (0)
    Unit cur, nxt; int ui = 0;
    typename Sched::State st;
    if (!S.first(st, cur, tid)) return;
    f32x4 acc[2][2][4][2];
#pragma unroll
    for (int a = 0; a < 2; ++a)
#pragma unroll
        for (int b = 0; b < 2; ++b)
#pragma unroll
            for (int m = 0; m < 4; ++m)
#pragma unroll
                for (int n = 0; n < 2; ++n) acc[a][b][m][n] = (f32x4){0.f, 0.f, 0.f, 0.f};
    bf16x8 At[4][2], B0[2][2], B1[2][2];
    unsigned cA0[2], cA1[2];
    PG8_AOFFS(cur, cA0, cA1);
    const __amdgpu_buffer_rsrc_t rA = __builtin_amdgcn_make_buffer_rsrc((void*)g.A, (short)0, (int)g.abytes, 0x00020000);
    const __amdgpu_buffer_rsrc_t rB = __builtin_amdgcn_make_buffer_rsrc((void*)g.Bt, (short)0, (int)g.bbytes, 0x00020000);
    const unsigned kstep = (unsigned)(BK * 2);
    const unsigned hstep = (unsigned)HALF * (unsigned)K * 2u;
    unsigned cB = (unsigned)cur.brow0 * (unsigned)K * 2u;
    PG8_STAGE(PG8_SB(0, 0), rB, cB, voffB); PG8_STAGE(PG8_SB(0, 1), rB, cB + hstep, voffB); PG8_STAGE(PG8_SA(0, 0), rA, 0u, cA0); PG8_STAGE(PG8_SA(0, 1), rA, 0u, cA1);
    if (wr == 1) PG8_BAR;
    PG8_WAIT_V(2); PG8_BAR;
    PG8_STAGE(PG8_SB(1, 0), rB, cB + kstep, voffB); PG8_STAGE(PG8_SA(1, 0), rA, kstep, cA0); PG8_STAGE(PG8_SB(1, 1), rB, cB + hstep + kstep, voffB);
    PG8_WAIT_V(6); PG8_BAR;
#define PG8_PAIR(a1, a2, b2, SWITCH) do { \
            PG8_LDB(B0, 0, 0); PG8_LDB(B1, 0, 1); PG8_SCHED; PG8_LDA(At, 0, 0); PG8_STAGE(PG8_SA(1, 1), rA, a1, cA1); \
            SWITCH; \
            PG8_WAIT_V(8); PG8_WAIT_L(0); PG8_BAR; PG8_MMA(0, 0, At, B0); PG8_MMA(0, 1, At, B1); PG8_BAR; PG8_SCHED; \
            PG8_LDA(At, 0, 1); PG8_STAGE(PG8_SB(0, 0), rB, b2, voffB); PG8_STAGE(PG8_SB(0, 1), rB, (b2) + hstep, voffB); PG8_STAGE(PG8_SA(0, 0), rA, a2, cA0); \
            PG8_WAIT_V(8); PG8_WAIT_L(0); PG8_BAR; PG8_MMA(1, 0, At, B0); PG8_MMA(1, 1, At, B1); PG8_BAR; PG8_SCHED; \
            PG8_LDB(B0, 1, 0); PG8_LDB(B1, 1, 1); PG8_SCHED; PG8_LDA(At, 1, 0); PG8_STAGE(PG8_SA(0, 1), rA, a2, cA1); \
            PG8_WAIT_V(8); PG8_WAIT_L(0); PG8_BAR; PG8_MMA(0, 0, At, B0); PG8_MMA(0, 1, At, B1); PG8_BAR; PG8_SCHED; \
            PG8_LDA(At, 1, 1); PG8_STAGE(PG8_SB(1, 0), rB, (b2) + kstep, voffB); PG8_STAGE(PG8_SB(1, 1), rB, (b2) + kstep + hstep, voffB); PG8_STAGE(PG8_SA(1, 0), rA, (a2) + kstep, cA0); \
            PG8_WAIT_V(8); PG8_WAIT_L(0); PG8_BAR; PG8_MMA(1, 0, At, B0); PG8_MMA(1, 1, At, B1); PG8_BAR; PG8_SCHED; } while (0)
    for (;;) {
        S.issue(st, ui + 1, tid);
        for (int t = 0; t < nt - 2; t += 2) {
            const unsigned a1 = (unsigned)(t + 1) * kstep, a2 = (unsigned)(t + 2) * kstep, b2 = cB + (unsigned)(t + 2) * kstep;
            PG8_PAIR(a1, a2, b2, (void)0);
        }
        const bool has_next = S.fin(st, ui + 1, nxt, tid);
        const unsigned nB = has_next ? (unsigned)nxt.brow0 * (unsigned)K * 2u : cB;
        {
            const unsigned a1 = (unsigned)(nt - 1) * kstep;
            PG8_PAIR(a1, 0u, nB, do { if (has_next) { PG8_AOFFS(nxt, cA0, cA1); } } while (0));
        }
        if (wr == 0) PG8_BAR;
        { int l2; asm volatile("v_mbcnt_lo_u32_b32 %0, -1, 0\n\tv_mbcnt_hi_u32_b32 %0, -1, %0" : "=v"(l2));
          E(acc, cur, wr, wc, l2 & 15, l2 >> 4); S.done(cur, l2); }
        if (!has_next) break;
#pragma unroll
        for (int a = 0; a < 2; ++a)
#pragma unroll
            for (int b = 0; b < 2; ++b)
#pragma unroll
                for (int m = 0; m < 4; ++m)
#pragma unroll
                    for (int n = 0; n < 2; ++n) acc[a][b][m][n] = (f32x4){0.f, 0.f, 0.f, 0.f};
        cur = nxt; cB = nB; ++ui;
        if (wr == 1) PG8_BAR;
    }
    PG8_WAIT_V(0);
    PG8_BAR;
#undef PG8_PAIR
#undef PG8_AOFFS
#undef PG8_SA
#undef PG8_SB
#undef PG8_STAGE
#undef PG8_LDA
#undef PG8_LDB
#undef PG8_MMA
#undef PG8_WAIT_V
#undef PG8_WAIT_L
#undef PG8_BAR
#undef PG8_SCHED
}
}

#define XB_TMO      128
#define XB_XCNT(j)  (256  + 64 * (j))
#define XB_XSUB(j)  (1280 + 64 * (j))
#define XB_XGEN(j)  (2304 + 64 * (j))
#define XB_TOP      3328
#define XB_TOPGEN   3392
#define XCD_BAR_WORDS 3456
#define XB_SPIN_CAP (1u << 20)
__device__ __forceinline__ unsigned xb_ld(unsigned* p)              { return __hip_atomic_load(p, __ATOMIC_RELAXED, __HIP_MEMORY_SCOPE_AGENT); }
__device__ __forceinline__ unsigned xb_add(unsigned* p, unsigned v) { return __hip_atomic_fetch_add(p, v, __ATOMIC_RELAXED, __HIP_MEMORY_SCOPE_AGENT); }
__device__ __forceinline__ unsigned xb_xcc_id() { return (unsigned)__builtin_amdgcn_s_getreg((3 << 11) | 20) & 0xFu; }
#define XB_SPIN(cond, bar) do { unsigned _sp = 0; while (cond) { __builtin_amdgcn_s_sleep(1); \
    if ((++_sp & 255u) == 0u) { if (xb_ld(&(bar)[XB_TMO])) break; if (_sp > XB_SPIN_CAP) { atomicAdd(&(bar)[XB_TMO], 1u); break; } } } } while (0)
__device__ __forceinline__ void xcd_barrier_complete(unsigned* bar, unsigned x, unsigned& nloc, unsigned& nx) {
    const unsigned G = gridDim.x;
    unsigned sum, cnt, mine, sp = 0u;
    for (;;) {
        sum = 0u; cnt = 0u; mine = 0u;
#pragma unroll
        for (unsigned j = 0; j < 16; ++j) { const unsigned c = xb_ld(&bar[XB_XCNT(j)]); sum += c; cnt += (c > 0u) ? 1u : 0u; mine = (j == x) ? c : mine; }
        if (sum == G) break;
        __builtin_amdgcn_s_sleep(1);
        if ((++sp & 255u) == 0u) { if (xb_ld(&bar[XB_TMO])) break; if (sp > XB_SPIN_CAP) { atomicAdd(&bar[XB_TMO], 1u); break; } }
    }
    nloc = mine > 0u ? mine : 1u; nx = cnt > 0u ? cnt : 1u;
}
__device__ __forceinline__ void xcd_barrier(unsigned* bar, volatile LAS unsigned* st, int wave) {
    asm volatile("s_waitcnt vmcnt(0) lgkmcnt(0)" ::: "memory");
    __syncthreads();
    int lane; asm volatile("v_mbcnt_lo_u32_b32 %0, -1, 0\n\tv_mbcnt_hi_u32_b32 %0, -1, %0" : "=v"(lane));
    if (wave == 0 && lane == 0) {
        __builtin_amdgcn_s_waitcnt(0);
        const unsigned x = xb_xcc_id();
        unsigned nloc = st[0], nx = st[1];
        if (nloc == 0u) { xcd_barrier_complete(bar, x, nloc, nx); st[0] = nloc; st[1] = nx; }
        const unsigned old = xb_add(&bar[XB_XSUB(x)], 1u);
        const unsigned gen = old / nloc;
        if (old + 1u == (gen + 1u) * nloc) {
            __builtin_amdgcn_fence(__ATOMIC_RELEASE, "agent");
            asm volatile("s_waitcnt vmcnt(0)" ::: "memory");
            const unsigned og = xb_add(&bar[XB_TOP], 1u);
            const unsigned tg = og / nx;
            if (og + 1u == (tg + 1u) * nx) xb_add(&bar[XB_TOPGEN], 1u);
            else XB_SPIN(xb_ld(&bar[XB_TOPGEN]) == tg, bar);
            __builtin_amdgcn_fence(__ATOMIC_ACQUIRE, "agent");
            xb_add(&bar[XB_XGEN(x)], 1u);
            asm volatile("s_waitcnt vmcnt(0)" ::: "memory");
        } else {
            XB_SPIN(xb_ld(&bar[XB_XGEN(x)]) == gen, bar);
            __builtin_amdgcn_fence(__ATOMIC_ACQUIRE, "agent");
            asm volatile("s_waitcnt vmcnt(0)" ::: "memory");
        }
    }
    __syncthreads();
}

struct Params {
    const float* in[18];
    float* out; unsigned char* ws;
};
enum { I_X = 0, I_EV_WIN, I_EV_CONV, I_EV_ALOG, I_EV_DTB, I_EV_GDNN, I_EV_HGRNN, I_LBLOG, I_EV_WOUT, I_OD_WIN, I_OD_WOUT, I_RW, I_RB, I_MG, I_MU, I_MD, I_LNG, I_LNB };

struct Frame {
    LAS unsigned char* lds;
    int tid, lane, wave, G, bid;
};
__device__ __forceinline__ Frame refresh(const Frame& F0) {
    Frame F = F0; int l; asm volatile("v_mbcnt_lo_u32_b32 %0, -1, 0\n\tv_mbcnt_hi_u32_b32 %0, -1, %0" : "=v"(l));
    F.lane = l; F.tid = F0.wave * 64 + l; return F;
}

constexpr size_t WS_W3 = WS_AB + 16 * MiB, WS_WOUT1 = WS_WOUT + 4 * MiB, WS_WGU1 = WS_WGU + 32 * MiB;
struct CDesc { const float* src; unsigned char* dst; int ld, Kd, fp8; };
__device__ __forceinline__ CDesc conv_desc(const Params& p, unsigned char* ws, int kind, int r) {
    CDesc d;
    switch (kind) {
    case 0: { const int kb = r / 256, nb = r % 256, n0 = nb * 32; const int c0 = n0 < 4096 ? n0 : n0 + 16;
        d.src = p.in[I_EV_WIN] + (size_t)(kb * 64) * EVEN_IN + c0; d.ld = EVEN_IN; d.dst = ws + WS_WIN + (size_t)n0 * 2048 + kb * 64; d.Kd = 2048; d.fp8 = 1; break; }
    case 1: { const int kb = r / 64, nb = r % 64; d.src = p.in[I_EV_WOUT] + (size_t)(kb * 64) * 2048 + nb * 32; d.ld = 2048; d.dst = ws + WS_WOUT + (size_t)(nb * 32) * 2048 + kb * 64; d.Kd = 2048; d.fp8 = 1; break; }
    case 2: case 6: { const int layer = kind == 6; const int isup = r >= 8192; if (isup) r -= 8192;
        const int e = r / 512, q = r % 512, kb = q / 16, nb = q % 16, f0 = nb * 32;
        d.src = (isup ? p.in[I_MU] : p.in[I_MG]) + (size_t)(layer * NE + e) * 2048 * 512 + (size_t)(kb * 64) * 512 + f0; d.ld = 512;
        d.dst = ws + (layer ? WS_WGU1 : WS_WGU) + (size_t)e * 1024 * 2048 + (size_t)(256 * (f0 >> 7) + 128 * isup + (f0 & 127)) * 2048 + kb * 64; d.Kd = 2048; d.fp8 = 1; break; }
    case 3: case 7: { const int layer = kind == 7; const int e = r / 512, q = r % 512, kb = q / 64, nb = q % 64;
        d.src = p.in[I_MD] + (size_t)(layer * NE + e) * 512 * 2048 + (size_t)(kb * 64) * 2048 + nb * 32; d.ld = 2048;
        d.dst = ws + WS_WD + ((size_t)e * 2048 * 512 + (size_t)(nb * 32) * 512 + kb * 64) * 2; d.Kd = 512; d.fp8 = 0; break; }
    case 4: { const int kb = r / 192, nb = r % 192; d.src = p.in[I_OD_WIN] + (size_t)(kb * 64) * ODD_IN + nb * 32; d.ld = ODD_IN; d.dst = ws + WS_W3 + (size_t)(nb * 32) * 2048 + kb * 64; d.Kd = 2048; d.fp8 = 1; break; }
    default: { const int kb = r / 64, nb = r % 64; d.src = p.in[I_OD_WOUT] + (size_t)(kb * 64) * 2048 + nb * 32; d.ld = 2048; d.dst = ws + WS_WOUT1 + (size_t)(nb * 32) * 1024 + kb * 64; d.Kd = 1024; d.fp8 = 1; break; }
    }
    return d;
}
__device__ __forceinline__ void conv_load(const CDesc& d, int lane, float (&wv)[32]) {
    const float* wp = d.src + (size_t)(lane >> 5) * d.ld + (lane & 31);
#pragma unroll
    for (int i = 0; i < 32; ++i) wv[i] = __builtin_nontemporal_load(wp + (size_t)(2 * i) * d.ld);
}
__device__ __forceinline__ void conv_store(const CDesc& d, int lane, const float (&wv)[32], LAS float* scr) {
#pragma unroll
    for (int i = 0; i < 32; ++i) scr[(2 * i + (lane >> 5)) * 33 + (lane & 31)] = wv[i];
    LDS_WAIT(); asm volatile("" ::: "memory");
    if (d.fp8) {
        const int c = lane & 3;
#pragma unroll
        for (int j = 0; j < 2; ++j) { const int n = (lane >> 2) + 16 * j; const LAS float* sp = scr + (16 * c) * 33 + n;
            u32x4 o;
            o.x = pk4_fp8(sp[0 * 33] * W_PRE, sp[1 * 33] * W_PRE, sp[2 * 33] * W_PRE, sp[3 * 33] * W_PRE);     o.y = pk4_fp8(sp[4 * 33] * W_PRE, sp[5 * 33] * W_PRE, sp[6 * 33] * W_PRE, sp[7 * 33] * W_PRE);
            o.z = pk4_fp8(sp[8 * 33] * W_PRE, sp[9 * 33] * W_PRE, sp[10 * 33] * W_PRE, sp[11 * 33] * W_PRE);   o.w = pk4_fp8(sp[12 * 33] * W_PRE, sp[13 * 33] * W_PRE, sp[14 * 33] * W_PRE, sp[15 * 33] * W_PRE);
            *(u32x4*)(d.dst + (size_t)n * d.Kd + 16 * c) = o; }
    } else {
        const int c = lane & 7;
#pragma unroll
        for (int j = 0; j < 4; ++j) { const int n = (lane >> 3) + 8 * j; const LAS float* sp = scr + (8 * c) * 33 + n;
            u32x4 o; o.x = pk2(sp[0 * 33], sp[1 * 33]); o.y = pk2(sp[2 * 33], sp[3 * 33]); o.z = pk2(sp[4 * 33], sp[5 * 33]); o.w = pk2(sp[6 * 33], sp[7 * 33]);
            *(u32x4*)(d.dst + ((size_t)n * d.Kd + 8 * c) * 2) = o; }
    }
    LDS_WAIT(); asm volatile("" ::: "memory");
}
__device__ __forceinline__ CDesc conv_item(const Params& p, unsigned char* ws, int set, int it) {
    if (set == 0) return it < 8192 ? conv_desc(p, ws, 0, it) : conv_desc(p, ws, 1, it - 8192);
    if (set == 1) { int r = it;
        if (r < 16384) return conv_desc(p, ws, 2, r); r -= 16384;
        if (r < 8192) return conv_desc(p, ws, 3, r); r -= 8192;
        if (r < 6144) return conv_desc(p, ws, 4, r); r -= 6144;
        if (r < 1024) return conv_desc(p, ws, 5, r); r -= 1024;
        return conv_desc(p, ws, 6, r); }
    return conv_desc(p, ws, 7, it);
}
__device__ __forceinline__ void convert_set(const Params& p, const Frame& F0, int set, int w, int nw) {
    const Frame F = refresh(F0);
    LAS float* scr = (LAS float*)(F.lds + F.wave * 16384);
    unsigned char* ws = opq(p.ws);
    const int N = set == 0 ? 8192 + 2048 : set == 1 ? 16384 + 8192 + 6144 + 1024 + 16384 : 8192;
    for (int it = w; it < N; it += 2 * nw) {
        const bool two = it + nw < N;
        const CDesc d0 = conv_item(p, ws, set, it), d1 = conv_item(p, ws, set, two ? it + nw : it);
        float v0[32], v1[32];
        conv_load(d0, F.lane, v0); if (two) conv_load(d1, F.lane, v1);
        conv_store(d0, F.lane, v0, scr); if (two) conv_store(d1, F.lane, v1, scr);
    }
}

__device__ __forceinline__ void load_w16_lds(const Frame& F0, const float* W, int ld, int c0) {
    const Frame F = refresh(F0);
    LAS float* l = (LAS float*)F.lds;
    for (int i = F.tid; i < 2048 * 16; i += NTHR) { const int k = i >> 4, e = i & 15; l[e * 2048 + k] = W[(size_t)k * ld + c0 + e]; }
}
__device__ __forceinline__ float dot16(const Frame& F, const f32x4 (&v)[8]) {
    const LAS f32x4* l = (const LAS f32x4*)F.lds;
    float res = 0.f;
#pragma unroll 1
    for (int e = 0; e < 16; ++e) { float s = 0.f;
#pragma unroll
        for (int j = 0; j < 8; ++j) { const f32x4 w = l[e * 512 + 64 * j + F.lane]; s += (v[j].x * w.x + v[j].y * w.y) + (v[j].z * w.z + v[j].w * w.w); }
        s = wave_sum(s); res = (F.lane == e) ? s : res; }
    return res;
}

__device__ __forceinline__ void p0_xpass(const Params& p, const Frame& F0) {
    const Frame F = refresh(F0);
    const int gw = F.bid * NWAVES + F.wave, NGW = F.G * NWAVES;
    float* BA = (float*)(opq(p.ws) + WS_BA); bf16_t* AB = (bf16_t*)(opq(p.ws) + WS_AB);
    for (int m = gw; m < T; m += NGW) {
        const f32x4* xr = (const f32x4*)(p.in[I_X] + (size_t)m * D) + F.lane;
        f32x4 v[8];
#pragma unroll
        for (int j = 0; j < 8; ++j) v[j] = xr[64 * j];
        unsigned* o = (unsigned*)((unsigned char*)AB + (size_t)m * D) + F.lane;
#pragma unroll
        for (int j = 0; j < 8; ++j) o[64 * j] = pk4_fp8(v[j].x * X_PRE, v[j].y * X_PRE, v[j].z * X_PRE, v[j].w * X_PRE);
        const float a = dot16(F, v);
        if (F.lane < 16) BA[(size_t)m * 16 + F.lane] = a;
    }
}

constexpr size_t WS_R16A = WS_OC + 16 * MiB, WS_R16B = WS_SCR + 190 * MiB;
__device__ __forceinline__ bf16_t* r16_row(unsigned char* ws, int m) { return (bf16_t*)(ws + (m < T / 2 ? WS_R16A + (size_t)m * D * 2 : WS_R16B + (size_t)(m - T / 2) * D * 2)); }
template <bool ROUTE, bool TWO, bool RES16, bool OUT16>
__device__ __forceinline__ void ln_pass(const Params& p, const Frame& F0, const float* resid, const bf16_t* add1, int ld1, const bf16_t* add2, const float* gain, const float* bias,
                                        float* outf, bf16_t* outb, int layer) {
    const Frame F = refresh(F0);
    const int TPB = (T + F.G - 1) / F.G;
    const int mbeg = ROUTE ? F.bid * TPB + F.wave : F.bid * NWAVES + F.wave, mend = ROUTE ? min(T, (F.bid + 1) * TPB) : T, mstep = ROUTE ? NWAVES : F.G * NWAVES;
    int* SEL = (int*)(opq(p.ws) + WS_CTL + 65536);
    int* HIST = (int*)(opq(p.ws) + WS_CTL + 32768);
    LAS int* lhist = (LAS int*)(F.lds + pg8::MOE_HIST_OFF);
    float* gatew = (float*)(opq(p.ws) + WS_GATEW) + (size_t)layer * 2 * T;
    if (ROUTE) { if (F.tid < NE) lhist[F.tid] = 0; __syncthreads(); }
    f32x4 gn[8], bs[8];
#pragma unroll
    for (int j = 0; j < 8; ++j) { gn[j] = ((const f32x4*)gain)[64 * j + F.lane]; bs[j] = ((const f32x4*)bias)[64 * j + F.lane]; }
    for (int m = mbeg; m < mend; m += mstep) {
        const f32x4* xr = (const f32x4*)(resid + (size_t)m * D) + F.lane;
        const u32x2* xr16 = (const u32x2*)r16_row(opq(p.ws), m) + F.lane;
        f32x4 v[8]; float s = 0.f;
#pragma unroll
        for (int j = 0; j < 8; ++j) {
            if (RES16) { const u32x2 a = xr16[64 * j]; v[j] = (f32x4){bflo(a.x), bfhi(a.x), bflo(a.y), bfhi(a.y)} * ALPHA; }
            else v[j] = xr[64 * j] * ALPHA;
            if (add1) { const u32x2 a = ((const u32x2*)(add1 + (size_t)(TWO ? 2 * m : m) * ld1))[64 * j + F.lane]; v[j].x += bflo(a.x); v[j].y += bfhi(a.x); v[j].z += bflo(a.y); v[j].w += bfhi(a.y); }
            if (TWO) { const u32x2 a = ((const u32x2*)(add2 + (size_t)(2 * m + 1) * ld1))[64 * j + F.lane]; v[j].x += bflo(a.x); v[j].y += bfhi(a.x); v[j].z += bflo(a.y); v[j].w += bfhi(a.y); }
#ifdef DBG_SANITIZE
            if (!(fabsf(v[j].x) < 1e30f)) v[j].x = 0.f; if (!(fabsf(v[j].y) < 1e30f)) v[j].y = 0.f; if (!(fabsf(v[j].z) < 1e30f)) v[j].z = 0.f; if (!(fabsf(v[j].w) < 1e30f)) v[j].w = 0.f;
#endif
            s += (v[j].x + v[j].y) + (v[j].z + v[j].w);
        }
        const float mean = wave_sum(s) * (1.f / D); float s2 = 0.f;
#pragma unroll
        for (int j = 0; j < 8; ++j) { v[j] = v[j] - mean; s2 += (v[j].x * v[j].x + v[j].y * v[j].y) + (v[j].z * v[j].z + v[j].w * v[j].w); }
        const float rstd = 1.f / sqrtf(wave_sum(s2) * (1.f / D) + LN_EPS);
#pragma unroll
        for (int j = 0; j < 8; ++j) v[j] = v[j] * rstd * gn[j] + bs[j];
        if (OUT16) { u32x2* of = (u32x2*)r16_row(opq(p.ws), m) + F.lane;
#pragma unroll
            for (int j = 0; j < 8; ++j) { u32x2 w; w.x = pk2(v[j].x, v[j].y); w.y = pk2(v[j].z, v[j].w); of[64 * j] = w; } }
        else { f32x4* of = (f32x4*)(outf + (size_t)m * D) + F.lane;
#pragma unroll
            for (int j = 0; j < 8; ++j) of[64 * j] = v[j]; }
        if (outb) {
            { unsigned* o = (unsigned*)((unsigned char*)outb + (size_t)m * D) + F.lane;
#pragma unroll
                for (int j = 0; j < 8; ++j) o[64 * j] = pk4_fp8(v[j].x, v[j].y, v[j].z, v[j].w); } }
        if (ROUTE) {
            const float lgl = dot16(F, v);
            const float scl = 1.0f / (1.0f + expf(-lgl)), bil = scl + p.in[I_RB][F.lane & 15];
            float sc[16], bi[16];
#pragma unroll
            for (int e = 0; e < 16; ++e) { sc[e] = __builtin_bit_cast(float, __builtin_amdgcn_readlane(__builtin_bit_cast(int, scl), e)); bi[e] = __builtin_bit_cast(float, __builtin_amdgcn_readlane(__builtin_bit_cast(int, bil), e)); }
            int bg = 0; float bgs = -3.0e38f;
#pragma unroll
            for (int g = 0; g < 4; ++g) { float m1 = -3.0e38f, m2 = -3.0e38f;
#pragma unroll
                for (int k = 0; k < 4; ++k) { const float x = bi[4 * g + k]; if (x > m1) { m2 = m1; m1 = x; } else if (x > m2) m2 = x; }
                const float gs = m1 + m2; if (gs > bgs) { bgs = gs; bg = g; } }
            int i1 = 0, i2 = 0; float b1 = -3.0e38f, b2 = -3.0e38f, s1 = 0.f, s2v = 0.f;
#pragma unroll
            for (int e = 0; e < 16; ++e) { if ((e >> 2) == bg) { const float x = bi[e]; if (x > b1) { b2 = b1; i2 = i1; s2v = s1; b1 = x; i1 = e; s1 = sc[e]; } else if (x > b2) { b2 = x; i2 = e; s2v = sc[e]; } } }
            if (F.lane == 0) {
                const float den = s1 + s2v;
                SEL[m] = i1 | (i2 << 8); gatew[2 * m] = s1 / den; gatew[2 * m + 1] = s2v / den;
                __hip_atomic_fetch_add(lhist + i1, 1, __ATOMIC_RELAXED, __HIP_MEMORY_SCOPE_WORKGROUP); __hip_atomic_fetch_add(lhist + i2, 1, __ATOMIC_RELAXED, __HIP_MEMORY_SCOPE_WORKGROUP);
            }
        }
    }
    if (ROUTE) { __syncthreads(); if (F.tid < NE) HIST[F.bid * NE + F.tid] = lhist[F.tid]; }
}

__device__ __forceinline__ void moe_lists(const Params& p, const Frame& F0, int layer) {
    const Frame F = refresh(F0);
    const int* SEL = (const int*)(opq(p.ws) + WS_CTL + 65536);
    const int* HIST = (const int*)(opq(p.ws) + WS_CTL + 32768);
    int* list = (int*)(opq(p.ws) + WS_LIST) + (size_t)layer * NE * T;
    LAS int* ltot = (LAS int*)(F.lds + pg8::MOE_HIST_OFF) + 16;
    LAS int* lbase = (LAS int*)(F.lds + pg8::MOE_HIST_OFF) + 32;
    if (F.tid < NE) { int base = 0, tot = 0;
        for (int b = 0; b < F.G; ++b) { const int h = HIST[b * NE + F.tid]; if (b < F.bid) base += h; tot += h; }
        ltot[F.tid] = tot; lbase[F.tid] = base; }
    __syncthreads();
    LAS int* ltpre = (LAS int*)(F.lds + pg8::MOE_HIST_OFF) + 48;
    LAS int* lslot = (LAS int*)(F.lds + pg8::MOE_HIST_OFF) + 64;
    if (F.tid == 0) { int sacc = 0;
#pragma unroll 1
        for (int e = 0; e < NE; ++e) { ltpre[e] = sacc; sacc += (ltot[e] + 255) >> 8; } }
    __syncthreads();
    const int TPB = (T + F.G - 1) / F.G, m0 = F.bid * TPB, m1 = min(T, m0 + TPB);
    if (F.wave == 0) {
        for (int q0 = 2 * m0; q0 < 2 * m1; q0 += 64) {
            const int q = q0 + F.lane; const bool ok = q < 2 * m1;
            int e = -1; if (ok) { const int sv = SEL[q >> 1]; e = (q & 1) ? ((sv >> 8) & 255) : (sv & 255); }
            int rank = 0, cntsame = 0;
#pragma unroll 1
            for (int k = 0; k < NE; ++k) { const unsigned long long bal = __ballot(e == k); if (e == k) { rank = __popcll(bal & ((1ull << F.lane) - 1ull)); cntsame = __popcll(bal); } }
            if (ok) { const int pos = lbase[e] + rank; list[e * T + pos] = q; lslot[q - 2 * m0] = 256 * ltpre[e] + pos; }
            __builtin_amdgcn_s_waitcnt(0);
            if (ok && rank == cntsame - 1) lbase[e] += cntsame;
            __builtin_amdgcn_s_waitcnt(0);
        }
    }
    __syncthreads();
    {
        const unsigned char* AB8 = opq(p.ws) + WS_AB; unsigned char* ABS = opq(p.ws) + WS_ABS;
        const int nt_ = m1 - m0;
        for (int t0 = F.wave; t0 < nt_; t0 += 4 * NWAVES) {
            u32x4 r0[4], r1[4];
#pragma unroll
            for (int k = 0; k < 4; ++k) { const int tt = t0 + k * NWAVES; if (tt < nt_) { const u32x4* src = (const u32x4*)(AB8 + (size_t)(m0 + tt) * D) + F.lane; r0[k] = src[0]; r1[k] = src[64]; } }
#pragma unroll
            for (int k = 0; k < 4; ++k) { const int tt = t0 + k * NWAVES; if (tt < nt_) {
#pragma unroll
                for (int jj = 0; jj < 2; ++jj) { u32x4* dst = (u32x4*)(ABS + (size_t)lslot[2 * tt + jj] * D) + F.lane; dst[0] = r0[k]; dst[64] = r1[k]; } } }
        }
    }
}

constexpr int H1LD = 8192, C_ZA = 3072, C_QB = 4096, C_FB = 5120, C_IB = 6144, C_GB = 7168;
constexpr size_t G_U0 = 0;
constexpr size_t G_WM = 32 * MiB;
constexpr size_t G_QD = 48 * MiB;
constexpr size_t G_KDT = 64 * MiB;
constexpr size_t G_QK = 80 * MiB;
constexpr size_t G_CD = 88 * MiB;
constexpr size_t H_QD = 89 * MiB;
constexpr size_t H_KI = 105 * MiB;
constexpr size_t H_KDT = 121 * MiB;
constexpr size_t H_IT = 137 * MiB;
constexpr size_t H_CD = 153 * MiB;
constexpr size_t O_A = 155 * MiB;
constexpr size_t O_B = 171 * MiB;
static_assert(O_B + 16 * MiB <= 216 * MiB, "mixer-0 scratch");

__device__ __forceinline__ f32x4 mfma32(bf16x8 a, bf16x8 b, f32x4 c) { return __builtin_amdgcn_mfma_f32_16x16x32_bf16(a, b, c, 0, 0, 0); }
__device__ __forceinline__ f32x4 mfma16(bf16x4 a, bf16x4 b, f32x4 c) { const bf16x8 a8 = {a[0], a[1], a[2], a[3], 0, 0, 0, 0}, b8 = {b[0], b[1], b[2], b[3], 0, 0, 0, 0}; return __builtin_amdgcn_mfma_f32_16x16x32_bf16(a8, b8, c, 0, 0, 0); }
__device__ __forceinline__ bf16x8 pack8(f32x4 lo, f32x4 hi) {
    u32x4 w; w.x = cvt_pk_bf16(lo[0], lo[1]); w.y = cvt_pk_bf16(lo[2], lo[3]); w.z = cvt_pk_bf16(hi[0], hi[1]); w.w = cvt_pk_bf16(hi[2], hi[3]); return __builtin_bit_cast(bf16x8, w);
}
__device__ __forceinline__ bf16x4 pack4(f32x4 v) { u32x2 w; w.x = cvt_pk_bf16(v[0], v[1]); w.y = cvt_pk_bf16(v[2], v[3]); return __builtin_bit_cast(bf16x4, w); }
__device__ __forceinline__ bf16x8 frag_perm(const LAS bf16_t* rowp, int col) {
    const u32x2 lo = *(const LAS u32x2*)(rowp + col), hi = *(const LAS u32x2*)(rowp + col + 16);
    u32x4 w; w.x = lo.x; w.y = lo.y; w.z = hi.x; w.w = hi.y; return __builtin_bit_cast(bf16x8, w);
}

__device__ __forceinline__ void gdn_pre_pair(const Params& p, const Frame& F, int unit0, int unit1) {
    const int hb = F.wave >> 2, w4 = F.wave & 3, t8 = F.tid & 255, lane = F.lane, fr = lane & 15, g = lane >> 4;
    const int unit = hb ? unit1 : unit0;
    const bool active = unit < 1024;
    const int bh = unit >> 5, ci = unit & 31, b = bh >> 3, h = bh & 7;
    const int tok0 = b * SEQ + ci * 64;
    LAS unsigned char* hl = F.lds + hb * 72192;
    LAS bf16_t* Qb = (LAS bf16_t*)(hl);
    LAS bf16_t* Kb = (LAS bf16_t*)(hl + 17408);
    LAS bf16_t* RVt = (LAS bf16_t*)(hl + 34816);
    LAS bf16_t* RKt = (LAS bf16_t*)(hl + 53248);
    LAS float* sc_g = (LAS float*)(hl + 71680);
    LAS float* sc_b = sc_g + 64;
    LAS float* Lm = (LAS float*)(hl);
    LAS bf16_t* Tb = (LAS bf16_t*)(hl + 17408);
    const bf16_t* H1 = (const bf16_t*)(opq(p.ws) + WS_H1);
    const float* BA = (const float*)(opq(p.ws) + WS_BA);
    unsigned char* scr = opq(p.ws) + WS_SCR;
    if (active) {
        if (t8 < 192) {
            const int sec = t8 >> 6, c2 = (t8 & 63) * 2;
            const int col = sec * 1024 + h * 128 + c2;
            const float* cw = p.in[I_EV_CONV] + col;
            const float w0a = cw[0], w0b = cw[1], w1a = cw[3072], w1b = cw[3073], w2a = cw[6144], w2b = cw[6145], w3a = cw[9216], w3b = cw[9217];
            float xa[3], xb[3];
#pragma unroll
            for (int k = 0; k < 3; ++k) { const int s = ci * 64 - 3 + k; unsigned v = 0u; if (s >= 0) v = *(const unsigned*)(H1 + (size_t)(b * SEQ + s) * H1LD + col); xa[k] = bflo(v); xb[k] = bfhi(v); }
#pragma unroll 1
            for (int q2 = 0; q2 < 2; ++q2) {
                unsigned vv[32];
#pragma unroll
                for (int tl = 0; tl < 32; ++tl) vv[tl] = *(const unsigned*)(H1 + (size_t)(tok0 + 32 * q2 + tl) * H1LD + col);
#pragma unroll
                for (int t2 = 0; t2 < 32; ++t2) {
                    const int tl = 32 * q2 + t2;
                    const float x3a = bflo(vv[t2]), x3b = bfhi(vv[t2]);
                    float ya = w0a * xa[0] + w1a * xa[1] + w2a * xa[2] + w3a * x3a, yb = w0b * xb[0] + w1b * xb[1] + w2b * xb[2] + w3b * x3b;
                    xa[0] = xa[1]; xa[1] = xa[2]; xa[2] = x3a; xb[0] = xb[1]; xb[1] = xb[2]; xb[2] = x3b;
                    ya = siluf_(ya); yb = siluf_(yb);
                    if (sec == 0) *(LAS unsigned*)(Qb + tl * 136 + c2) = pk2(ya, yb);
                    else if (sec == 1) *(LAS unsigned*)(Kb + tl * 136 + c2) = pk2(ya, yb);
                    else { const float be = sigmoidf_(BA[(size_t)(tok0 + tl) * 16 + h]); RVt[c2 * 72 + tl] = (bf16_t)f2bf(ya * be); RVt[(c2 + 1) * 72 + tl] = (bf16_t)f2bf(yb * be); }
                }
            }
        } else {
            const int t = tok0 + lane;
            const float ba = BA[(size_t)t * 16 + h], aa = BA[(size_t)t * 16 + 8 + h];
            const float xx = aa + p.in[I_EV_DTB][h];
            const float sp = xx > 20.f ? xx : log1pf(expf(xx));
            float gg = -expf(p.in[I_EV_ALOG][h]) * sp;
            gg += dpp_f<0x111>(gg); gg += dpp_f<0x112>(gg); gg += dpp_f<0x114>(gg); gg += dpp_f<0x118>(gg);
            { const float t0 = __builtin_bit_cast(float, __builtin_amdgcn_readlane(__builtin_bit_cast(int, gg), 15)), t1 = __builtin_bit_cast(float, __builtin_amdgcn_readlane(__builtin_bit_cast(int, gg), 31)),
                          t2 = __builtin_bit_cast(float, __builtin_amdgcn_readlane(__builtin_bit_cast(int, gg), 47));
              gg += (lane >= 16 ? t0 : 0.f) + (lane >= 32 ? t1 : 0.f) + (lane >= 48 ? t2 : 0.f); }
            sc_g[lane] = gg; sc_b[lane] = sigmoidf_(ba);
        }
    }
    __syncthreads();
    if (active) {
        bf16_t* QDg = (bf16_t*)(scr + G_QD) + (size_t)unit * 64 * 128;
#pragma unroll 2
        for (int rr = 0; rr < 16; ++rr) {
            const int r = w4 * 16 + rr;
            const unsigned qv = *(const LAS unsigned*)(Qb + r * 136 + 2 * lane), kv = *(const LAS unsigned*)(Kb + r * 136 + 2 * lane);
            const float q0 = bflo(qv), q1 = bfhi(qv), k0 = bflo(kv), k1 = bfhi(kv);
            const float sq = wave_sum(q0 * q0 + q1 * q1), sk = wave_sum(k0 * k0 + k1 * k1);
            const float rq = rsqrtf(sq + RMS_EPS) * 0.08838834764831845f, rk = rsqrtf(sk + RMS_EPS);
            const float gc = sc_g[r], be = sc_b[r], eg = expf(gc);
            const float qn0 = q0 * rq, qn1 = q1 * rq, kn0 = k0 * rk, kn1 = k1 * rk;
            *(LAS unsigned*)(Qb + r * 136 + 2 * lane) = pk2(qn0, qn1);
            *(LAS unsigned*)(Kb + r * 136 + 2 * lane) = pk2(kn0, kn1);
            RKt[(2 * lane) * 72 + r] = (bf16_t)f2bf(kn0 * be * eg); RKt[(2 * lane + 1) * 72 + r] = (bf16_t)f2bf(kn1 * be * eg);
            *(unsigned*)(QDg + r * 128 + 2 * lane) = pk2(qn0 * eg, qn1 * eg);
        }
    }
    __syncthreads();
    f32x4 kk[4];
    if (active) {
        {
            bf16_t* KDt = (bf16_t*)(scr + G_KDT) + (size_t)unit * 128 * 64;
            const float gl = sc_g[63];
#pragma unroll
            for (int it = 0; it < 4; ++it) { const int idx = t8 + 256 * it, f = idx >> 3, c0 = (idx & 7) * 8;
                float v[8];
#pragma unroll
                for (int i = 0; i < 8; ++i) v[i] = bf2f(Kb[(c0 + i) * 136 + f]) * expf(gl - sc_g[c0 + i]);
                u32x4 w; w.x = pk2(v[0], v[1]); w.y = pk2(v[2], v[3]); w.z = pk2(v[4], v[5]); w.w = pk2(v[6], v[7]);
                *(u32x4*)(KDt + f * 64 + c0) = w; }
        }
        const int mt = w4;
        bf16_t* QKm = (bf16_t*)(scr + G_QK) + (size_t)unit * 64 * 64;
        bf16x8 a[4];
#pragma unroll
        for (int kb = 0; kb < 4; ++kb) a[kb] = *(const LAS bf16x8*)(Kb + (16 * mt + fr) * 136 + 32 * kb + 8 * g);
#pragma unroll
        for (int nt = 0; nt < 4; ++nt) {
            f32x4 c = (f32x4){0.f, 0.f, 0.f, 0.f}, c2 = (f32x4){0.f, 0.f, 0.f, 0.f};
#pragma unroll
            for (int kb = 0; kb < 4; ++kb) { const bf16x8 bq = *(const LAS bf16x8*)(Qb + (16 * nt + fr) * 136 + 32 * kb + 8 * g), bk = *(const LAS bf16x8*)(Kb + (16 * nt + fr) * 136 + 32 * kb + 8 * g);
                c = mfma32(a[kb], bq, c); c2 = mfma32(a[kb], bk, c2); }
            const int cj = 16 * nt + fr; const float gcol = sc_g[cj];
            {
                float v[4];
#pragma unroll
                for (int r = 0; r < 4; ++r) { const int j = 16 * mt + 4 * g + r; v[r] = (cj >= j) ? expf(gcol - sc_g[j]) * c[r] : 0.f; }
                u32x2 w; w.x = pk2(v[0], v[1]); w.y = pk2(v[2], v[3]);
                *(u32x2*)(QKm + cj * 64 + 16 * mt + 4 * g) = w;
            }
#pragma unroll
            for (int r = 0; r < 4; ++r) { const int i = 16 * mt + 4 * g + r; kk[nt][r] = (i > cj) ? sc_b[i] * expf(sc_g[i] - gcol) * c2[r] : 0.f; }
        }
    }
    __syncthreads();
    if (active) {
#pragma unroll
        for (int nt = 0; nt < 4; ++nt)
#pragma unroll
            for (int r = 0; r < 4; ++r) Lm[(16 * w4 + 4 * g + r) * 68 + 16 * nt + fr] = kk[nt][r];
    }
    __syncthreads();
    if (active && w4 == 0) {
        float t[64];
#pragma unroll
        for (int i = 0; i < 64; ++i) t[i] = 0.f;
#pragma unroll
        for (int i = 0; i < 64; ++i) {
            float a0 = (i == lane) ? 1.f : 0.f, a1 = 0.f, a2 = 0.f, a3 = 0.f;
#pragma unroll
            for (int jj = 0; jj < (i + 3) / 4; ++jj) { const f32x4 lv = *(const LAS f32x4*)(Lm + i * 68 + 4 * jj);
                a0 -= lv[0] * t[4 * jj]; a1 -= lv[1] * t[4 * jj + 1]; a2 -= lv[2] * t[4 * jj + 2]; a3 -= lv[3] * t[4 * jj + 3]; }
            t[i] = (a0 + a1) + (a2 + a3);
        }
#pragma unroll
        for (int i = 0; i < 64; ++i) Tb[i * 72 + lane] = (bf16_t)f2bf(t[i]);
    }
    __syncthreads();
    if (active) {
        f32x4* U0f = (f32x4*)(scr + G_U0) + (size_t)unit * 8 * 4 * 64;
        bf16_t* Wm = (bf16_t*)(scr + G_WM) + (size_t)unit * 64 * 128;
#pragma unroll
        for (int hh = 0; hh < 2; ++hh) {
            const int ct = w4 + 4 * hh;
            bf16x8 bv[2], ak[2];
#pragma unroll
            for (int k = 0; k < 2; ++k) { bv[k] = *(const LAS bf16x8*)(RVt + (16 * ct + fr) * 72 + 32 * k + 8 * g); ak[k] = *(const LAS bf16x8*)(RKt + (16 * ct + fr) * 72 + 32 * k + 8 * g); }
#pragma unroll
            for (int mt = 0; mt < 4; ++mt) {
                f32x4 c = (f32x4){0.f, 0.f, 0.f, 0.f}, c2 = (f32x4){0.f, 0.f, 0.f, 0.f};
#pragma unroll
                for (int k = 0; k < 2; ++k) { const bf16x8 tt = *(const LAS bf16x8*)(Tb + (16 * mt + fr) * 72 + 32 * k + 8 * g); c = mfma32(tt, bv[k], c); c2 = mfma32(ak[k], tt, c2); }
                U0f[(ct * 4 + mt) * 64 + lane] = c;
                u32x2 w; w.x = pk2(-c2[0], -c2[1]); w.y = pk2(-c2[2], -c2[3]);
                *(u32x2*)(Wm + (16 * mt + fr) * 128 + 16 * ct + 4 * g) = w;
            }
        }
        if (t8 == 0) ((float*)(scr + G_CD))[unit] = expf(sc_g[63]);
    }
    __syncthreads();
}

__device__ __forceinline__ void hgrn_pre_unit(const Params& p, const Frame& F, int tc) {
    const int col = 2 * F.tid, h = col >> 7, f = col & 127;
    const float* lbl = p.in[I_LBLOG];
    float lb[2];
#pragma unroll
    for (int k = 0; k < 2; ++k) { const float l0 = lbl[col + k], l1 = lbl[1024 + col + k], l2 = lbl[2048 + col + k]; const float m = fmaxf(l0, fmaxf(l1, l2));
        const float e0 = expf(l0 - m), e1 = expf(l1 - m), e2 = expf(l2 - m); lb[k] = e0 / (e0 + e1 + e2); }
    const int t0 = tc * 16, b = t0 / SEQ, chunk = (t0 % SEQ) >> 4, bh = b * 8 + h;
    const bf16_t* H1 = (const bf16_t*)(opq(p.ws) + WS_H1);
    unsigned char* scr = opq(p.ws) + WS_SCR;
    float bc0[16], bc1[16], kk0[16], kk1[16]; unsigned iv[16];
    float cum0 = 0.f, cum1 = 0.f;
#pragma unroll
    for (int c = 0; c < 16; ++c) {
        const size_t row = (size_t)(t0 + c);
        const unsigned qv = *(const unsigned*)(H1 + row * H1LD + C_QB + col), fv = *(const unsigned*)(H1 + row * H1LD + C_FB + col);
        iv[c] = *(const unsigned*)(H1 + row * H1LD + C_IB + col);
        const float f0 = lb[0] + (1.f - lb[0]) * sigmoidf_(bflo(fv)), f1 = lb[1] + (1.f - lb[1]) * sigmoidf_(bfhi(fv));
        cum0 += logf(f0); cum1 += logf(f1);
        bc0[c] = cum0; bc1[c] = cum1; kk0[c] = 1.f - f0; kk1[c] = 1.f - f1;
        *(unsigned*)((bf16_t*)(scr + H_QD) + row * 1024 + col) = pk2(bflo(qv) * expf(cum0), bfhi(qv) * expf(cum1));
        *(unsigned*)((bf16_t*)(scr + H_KI) + row * 1024 + col) = pk2(kk0[c] * expf(-cum0), kk1[c] * expf(-cum1));
    }
    unsigned kd0[8], kd1[8], i0[8], i1[8];
#pragma unroll
    for (int c = 0; c < 16; c += 2) {
        kd0[c >> 1] = pk2(kk0[c] * expf(cum0 - bc0[c]), kk0[c + 1] * expf(cum0 - bc0[c + 1]));
        kd1[c >> 1] = pk2(kk1[c] * expf(cum1 - bc1[c]), kk1[c + 1] * expf(cum1 - bc1[c + 1]));
        i0[c >> 1] = (iv[c] & 0xffffu) | (iv[c + 1] << 16);
        i1[c >> 1] = (iv[c] >> 16) | (iv[c + 1] & 0xffff0000u);
    }
    const size_t base = ((size_t)(bh * 128 + chunk) * 128 + f) * 16;
    u32x4* kd = (u32x4*)((bf16_t*)(scr + H_KDT) + base); u32x4* it = (u32x4*)((bf16_t*)(scr + H_IT) + base);
    kd[0] = (u32x4){kd0[0], kd0[1], kd0[2], kd0[3]}; kd[1] = (u32x4){kd0[4], kd0[5], kd0[6], kd0[7]};
    kd[2] = (u32x4){kd1[0], kd1[1], kd1[2], kd1[3]}; kd[3] = (u32x4){kd1[4], kd1[5], kd1[6], kd1[7]};
    it[0] = (u32x4){i0[0], i0[1], i0[2], i0[3]}; it[1] = (u32x4){i0[4], i0[5], i0[6], i0[7]};
    it[2] = (u32x4){i1[0], i1[1], i1[2], i1[3]}; it[3] = (u32x4){i1[4], i1[5], i1[6], i1[7]};
    *(f32x2*)((float*)(scr + H_CD) + (size_t)(bh * 128 + chunk) * 128 + f) = (f32x2){expf(cum0), expf(cum1)};
}

__device__ __forceinline__ void p2_pre(const Params& p, const Frame& F0) {
    const Frame F = refresh(F0);
    for (int u = F.bid; u < 1024; u += 2 * F.G) gdn_pre_pair(p, F, u, u + F.G);
    for (int u = F.bid; u < 512; u += F.G) hgrn_pre_unit(p, F, u);
}

__device__ __forceinline__ void gdn_scan(const Params& p, const Frame& F0, int bh) {
    const Frame F = refresh(F0);
    const int lane = F.lane, fr = lane & 15, g = lane >> 4, wave = F.wave, b = bh >> 3, h = bh & 7;
    unsigned char* scr = opqg(p.ws) + WS_SCR;
    constexpr int BUFB = 62464, OFF_QD = 17408, OFF_KDT = 34816, OFF_QK = 53248;
    const bf16_t* gWM = (const bf16_t*)(scr + G_WM); const bf16_t* gQD = (const bf16_t*)(scr + G_QD);
    const bf16_t* gKDT = (const bf16_t*)(scr + G_KDT); const bf16_t* gQK = (const bf16_t*)(scr + G_QK);
    const f32x4* gU0 = (const f32x4*)(scr + G_U0); const float* gCD = (const float*)(scr + G_CD);
    bf16_t* OA = (bf16_t*)(scr + O_A);
    u32x4 rw[2], rq[2], rk[2], rqk; f32x4 u0c[4], u0n[4];
#define GS_ISSUE(u) do { _Pragma("unroll") for (int i = 0; i < 2; ++i) { const int idx = F.tid + 512 * i; \
        rw[i] = *(const u32x4*)(gWM + (size_t)(u) * 8192 + idx * 8); rq[i] = *(const u32x4*)(gQD + (size_t)(u) * 8192 + idx * 8); rk[i] = *(const u32x4*)(gKDT + (size_t)(u) * 8192 + idx * 8); } \
        rqk = *(const u32x4*)(gQK + (size_t)(u) * 4096 + F.tid * 8); \
        _Pragma("unroll") for (int mt = 0; mt < 4; ++mt) u0n[mt] = gU0[(((size_t)(u) * 8 + wave) * 4 + mt) * 64 + lane]; } while (0)
#define GS_WRITE(bufp) do { _Pragma("unroll") for (int i = 0; i < 2; ++i) { const int idx = F.tid + 512 * i; \
        *(LAS u32x4*)((bufp) + ((idx >> 4) * 136 + (idx & 15) * 8) * 2) = rw[i]; *(LAS u32x4*)((bufp) + OFF_QD + ((idx >> 4) * 136 + (idx & 15) * 8) * 2) = rq[i]; \
        *(LAS u32x4*)((bufp) + OFF_KDT + ((idx >> 3) * 72 + (idx & 7) * 8) * 2) = rk[i]; } \
        *(LAS u32x4*)((bufp) + OFF_QK + ((F.tid >> 3) * 72 + (F.tid & 7) * 8) * 2) = rqk; } while (0)
    f32x4 Sacc[8];
#pragma unroll
    for (int ft = 0; ft < 8; ++ft) Sacc[ft] = (f32x4){0.f, 0.f, 0.f, 0.f};
    GS_ISSUE(bh * 32);
    GS_WRITE(F.lds);
#pragma unroll
    for (int mt = 0; mt < 4; ++mt) u0c[mt] = u0n[mt];
    __syncthreads();
    for (int ci = 0; ci < 32; ++ci) {
        const int u = bh * 32 + ci;
        LAS unsigned char* buf = F.lds + (ci & 1) * BUFB;
        if (ci + 1 < 32) GS_ISSUE(u + 1);
        const float dec = ld_agent(gCD + u);
        const LAS bf16_t* WM = (const LAS bf16_t*)buf; const LAS bf16_t* QD = (const LAS bf16_t*)(buf + OFF_QD);
        const LAS bf16_t* KDT = (const LAS bf16_t*)(buf + OFF_KDT); const LAS bf16_t* QK = (const LAS bf16_t*)(buf + OFF_QK);
        bf16x8 Sbf[4];
#pragma unroll
        for (int kb = 0; kb < 4; ++kb) Sbf[kb] = pack8(Sacc[2 * kb], Sacc[2 * kb + 1]);
        f32x4 uacc[4], oacc[4];
#pragma unroll
        for (int mt = 0; mt < 4; ++mt) { uacc[mt] = u0c[mt]; oacc[mt] = (f32x4){0.f, 0.f, 0.f, 0.f}; }
#pragma unroll
        for (int mt = 0; mt < 4; ++mt)
#pragma unroll
            for (int kb = 0; kb < 4; ++kb) {
                uacc[mt] = mfma32(frag_perm(WM + (16 * mt + fr) * 136, 32 * kb + 4 * g), Sbf[kb], uacc[mt]);
                oacc[mt] = mfma32(frag_perm(QD + (16 * mt + fr) * 136, 32 * kb + 4 * g), Sbf[kb], oacc[mt]);
            }
        bf16x8 ubf[2];
#pragma unroll
        for (int k = 0; k < 2; ++k) ubf[k] = pack8(uacc[2 * k], uacc[2 * k + 1]);
#pragma unroll
        for (int mt = 0; mt < 4; ++mt)
#pragma unroll
            for (int k = 0; k < 2; ++k) oacc[mt] = mfma32(frag_perm(QK + (16 * mt + fr) * 72, 32 * k + 4 * g), ubf[k], oacc[mt]);
#pragma unroll
        for (int ft = 0; ft < 8; ++ft) {
            Sacc[ft] = Sacc[ft] * dec;
#pragma unroll
            for (int k = 0; k < 2; ++k) Sacc[ft] = mfma32(frag_perm(KDT + (16 * ft + fr) * 72, 32 * k + 4 * g), ubf[k], Sacc[ft]);
        }
        {
            bf16_t* orow = OA + (size_t)(b * SEQ + ci * 64) * 1024 + h * 128 + 16 * wave + fr;
#pragma unroll
            for (int mt = 0; mt < 4; ++mt)
#pragma unroll
                for (int r = 0; r < 4; ++r) orow[(size_t)(16 * mt + 4 * g + r) * 1024] = (bf16_t)f2bf(oacc[mt][r]);
        }
        if (ci + 1 < 32) { GS_WRITE(F.lds + ((ci + 1) & 1) * BUFB);
#pragma unroll
            for (int mt = 0; mt < 4; ++mt) u0c[mt] = u0n[mt]; }
        __syncthreads();
    }
#undef GS_ISSUE
#undef GS_WRITE
}

__device__ __forceinline__ void hgrn_scan(const Params& p, const Frame& F0, int bh) {
    const Frame F = refresh(F0);
    const int lane = F.lane, fr = lane & 15, g = lane >> 4, wave = F.wave, b = bh >> 3, h = bh & 7;
    unsigned char* scr = opqg(p.ws) + WS_SCR;
    constexpr int BUFB = 61440, OFF_KI = 17408, OFF_KDT = 34816, OFF_CD = 59392;
    const bf16_t* gQD = (const bf16_t*)(scr + H_QD); const bf16_t* gKI = (const bf16_t*)(scr + H_KI);
    const bf16_t* gKDT = (const bf16_t*)(scr + H_KDT) + (size_t)bh * 128 * 128 * 16; const bf16_t* gIT = (const bf16_t*)(scr + H_IT) + (size_t)bh * 128 * 128 * 16;
    const float* gCD = (const float*)(scr + H_CD) + (size_t)bh * 128 * 128;
    bf16_t* OB = (bf16_t*)(scr + O_B);
    u32x4 rq[2], rk[2], rd[2], rc; u32x2 itn[4], itc[4];
#define HS_ISSUE(grp) do { _Pragma("unroll") for (int i = 0; i < 2; ++i) { const int idx = F.tid + 512 * i; const size_t go = (size_t)(b * SEQ + (grp) * 64 + (idx >> 4)) * 1024 + h * 128 + (idx & 15) * 8; \
        rq[i] = *(const u32x4*)(gQD + go); rk[i] = *(const u32x4*)(gKI + go); rd[i] = *(const u32x4*)(gKDT + (size_t)(grp) * 8192 + idx * 8); } \
        if (F.tid < 128) rc = *(const u32x4*)(gCD + (size_t)(grp) * 512 + F.tid * 4); \
        _Pragma("unroll") for (int sc = 0; sc < 4; ++sc) itn[sc] = *(const u32x2*)(gIT + ((size_t)((grp) * 4 + sc) * 128 + 16 * wave + fr) * 16 + 4 * g); } while (0)
#define HS_WRITE(bufp) do { _Pragma("unroll") for (int i = 0; i < 2; ++i) { const int idx = F.tid + 512 * i; \
        *(LAS u32x4*)((bufp) + ((idx >> 4) * 136 + (idx & 15) * 8) * 2) = rq[i]; *(LAS u32x4*)((bufp) + OFF_KI + ((idx >> 4) * 136 + (idx & 15) * 8) * 2) = rk[i]; \
        *(LAS u32x4*)((bufp) + OFF_KDT + ((idx >> 1) * 24 + (idx & 1) * 8) * 2) = rd[i]; } \
        if (F.tid < 128) *(LAS u32x4*)((bufp) + OFF_CD + F.tid * 16) = rc; } while (0)
    f32x4 Sacc[8];
#pragma unroll
    for (int ft = 0; ft < 8; ++ft) Sacc[ft] = (f32x4){0.f, 0.f, 0.f, 0.f};
    HS_ISSUE(0);
    HS_WRITE(F.lds);
#pragma unroll
    for (int sc = 0; sc < 4; ++sc) itc[sc] = itn[sc];
    __syncthreads();
    for (int grp = 0; grp < 32; ++grp) {
        LAS unsigned char* buf = F.lds + (grp & 1) * BUFB;
        if (grp + 1 < 32) HS_ISSUE(grp + 1);
        const LAS bf16_t* QD = (const LAS bf16_t*)buf; const LAS bf16_t* KI = (const LAS bf16_t*)(buf + OFF_KI);
        const LAS bf16_t* KDT = (const LAS bf16_t*)(buf + OFF_KDT); const LAS float* CD = (const LAS float*)(buf + OFF_CD);
#pragma unroll
        for (int sc = 0; sc < 4; ++sc) {
            bf16x8 Sbf[4];
#pragma unroll
            for (int kb = 0; kb < 4; ++kb) Sbf[kb] = pack8(Sacc[2 * kb], Sacc[2 * kb + 1]);
            f32x4 o = (f32x4){0.f, 0.f, 0.f, 0.f}, pT = (f32x4){0.f, 0.f, 0.f, 0.f};
#pragma unroll
            for (int kb = 0; kb < 4; ++kb) {
                const bf16x8 qf = frag_perm(QD + (16 * sc + fr) * 136, 32 * kb + 4 * g), kf = frag_perm(KI + (16 * sc + fr) * 136, 32 * kb + 4 * g);
                o = mfma32(qf, Sbf[kb], o);
                pT = mfma32(kf, qf, pT);
            }
#pragma unroll
            for (int r = 0; r < 4; ++r) pT[r] = (fr >= 4 * g + r) ? pT[r] : 0.f;
            const bf16x4 itf = __builtin_bit_cast(bf16x4, itc[sc]);
            o = mfma16(pack4(pT), itf, o);
#pragma unroll
            for (int ft = 0; ft < 8; ++ft) {
                const f32x4 d = *(const LAS f32x4*)(CD + sc * 128 + 16 * ft + 4 * g);
                const bf16x4 kd = *(const LAS bf16x4*)(KDT + ((sc * 128) + 16 * ft + fr) * 24 + 4 * g);
                Sacc[ft] = mfma16(kd, itf, Sacc[ft] * d);
            }
            bf16_t* orow = OB + (size_t)(b * SEQ + grp * 64 + sc * 16) * 1024 + h * 128 + 16 * wave + fr;
#pragma unroll
            for (int r = 0; r < 4; ++r) orow[(size_t)(4 * g + r) * 1024] = (bf16_t)f2bf(o[r]);
        }
        if (grp + 1 < 32) { HS_WRITE(F.lds + ((grp + 1) & 1) * BUFB);
#pragma unroll
            for (int sc = 0; sc < 4; ++sc) itc[sc] = itn[sc]; }
        __syncthreads();
    }
#undef HS_ISSUE
#undef HS_WRITE
}

__device__ __forceinline__ void p4_gate(const Params& p, const Frame& F0) {
    const Frame F = refresh(F0);
    const int gw = F.bid * NWAVES + F.wave, NGW = F.G * NWAVES, hs = F.lane >> 4, e0 = (F.lane & 15) * 8;
    unsigned char* scr = opq(p.ws) + WS_SCR;
    const bf16_t* H1 = (const bf16_t*)(opq(p.ws) + WS_H1); bf16_t* OC = (bf16_t*)(opq(p.ws) + WS_OC);
    for (int m = gw; m < T; m += NGW) {
#pragma unroll
        for (int rr = 0; rr < 4; ++rr) {
            const int hh = rr * 4 + hs;
            const bool isb = hh >= 8; const int hd = hh & 7;
            const bf16_t* osrc = (const bf16_t*)(scr + (isb ? O_B : O_A)) + (size_t)m * 1024 + hd * 128 + e0;
            const bf16_t* zsrc = H1 + (size_t)m * H1LD + (isb ? C_GB : C_ZA) + hd * 128 + e0;
            const float* gsrc = (isb ? p.in[I_EV_HGRNN] : p.in[I_EV_GDNN]) + e0;
            const u32x4 ov = *(const u32x4*)osrc, zv = *(const u32x4*)zsrc;
            const f32x4 g0 = *(const f32x4*)gsrc, g1 = *(const f32x4*)(gsrc + 4);
            float x[8] = {bflo(ov.x), bfhi(ov.x), bflo(ov.y), bfhi(ov.y), bflo(ov.z), bfhi(ov.z), bflo(ov.w), bfhi(ov.w)};
            const float z[8] = {bflo(zv.x), bfhi(zv.x), bflo(zv.y), bfhi(zv.y), bflo(zv.z), bfhi(zv.z), bflo(zv.w), bfhi(zv.w)};
            const float gn[8] = {g0[0], g0[1], g0[2], g0[3], g1[0], g1[1], g1[2], g1[3]};
            float ss = 0.f;
#pragma unroll
            for (int i = 0; i < 8; ++i) ss += x[i] * x[i];
            ss = row16_sum(ss);
            const float rinv = rsqrtf(ss * (1.f / 128.f) + RMS_EPS);
#pragma unroll
            for (int i = 0; i < 8; ++i) x[i] = x[i] * rinv * gn[i] * siluf_(z[i]);
            u32x2 w; w.x = pk4_fp8(x[0] * A_PRE, x[1] * A_PRE, x[2] * A_PRE, x[3] * A_PRE); w.y = pk4_fp8(x[4] * A_PRE, x[5] * A_PRE, x[6] * A_PRE, x[7] * A_PRE);
            *(u32x2*)((unsigned char*)OC + (size_t)m * 2048 + hh * 128 + e0) = w;
        }
    }
}

constexpr int H3LD = 6144;
constexpr size_t A_QR = 0;
constexpr size_t A_KR = 32 * MiB;
constexpr size_t A_VT = 64 * MiB;
constexpr size_t A_OG = 96 * MiB;
constexpr size_t A_LSE = 120 * MiB;
constexpr size_t A_KPART = 121 * MiB;
constexpr float QSCALE = 0.08838834764831845f * 1.4426950408889634f;
__device__ __forceinline__ int head_dil_log2(int hd) { return hd < 4 ? 0 : hd < 8 ? 2 : hd < 12 ? 4 : 0; }
__device__ __forceinline__ int posp(int s, int dl) { return ((s & ((1 << dl) - 1)) << (11 - dl)) + (s >> dl); }

__device__ __forceinline__ void rope_unit(const Params& p, const Frame& F, int unit) {
    const int hh = unit & 1, st = (unit >> 1) & 31, b = unit >> 6, s0 = st * 64;
    const bf16_t* H3 = (const bf16_t*)(opq(p.ws) + WS_H1);
    unsigned char* scr = opq(p.ws) + WS_SCR;
    bf16_t* QR = (bf16_t*)(scr + A_QR); bf16_t* KR = (bf16_t*)(scr + A_KR); bf16_t* VT = (bf16_t*)(scr + A_VT); float* KPART = (float*)(scr + A_KPART);
    LAS float* KS = (LAS float*)F.lds;
    LAS bf16_t* VL = (LAS bf16_t*)(F.lds + 33280);
    const int tok2 = F.tid >> 4, pj = (F.tid & 15) * 4;
    float cs[2][4], sn[2][4];
#pragma unroll
    for (int tt = 0; tt < 2; ++tt)
#pragma unroll
        for (int i = 0; i < 4; ++i) { const float inv = powf(10000.0f, -(float)(pj + i) * (1.0f / 64.0f)); const float ang = (float)(s0 + tok2 + 32 * tt) * inv; sincosf(ang, &sn[tt][i], &cs[tt][i]); }
    for (int hi = 0; hi < 8; ++hi) {
        const int hd = hh * 8 + hi, dl = head_dil_log2(hd);
        const int qcol = hd < 12 ? hd * 128 : 4608 + (hd - 12) * 128, kcol = hd < 12 ? 1536 + hd * 128 : 5120 + (hd - 12) * 128, vcol = hd < 12 ? 3072 + hd * 128 : 5632 + (hd - 12) * 128;
        const size_t hb = (size_t)(b * 16 + hd) * 2048;
#pragma unroll
        for (int tt = 0; tt < 2; ++tt) {
            const int tl = tok2 + 32 * tt, s = s0 + tl; const size_t row = (size_t)(b * SEQ + s) * H3LD; const size_t orow = (hb + posp(s, dl)) * 128;
#pragma unroll
            for (int qk = 0; qk < 2; ++qk) {
                const bf16_t* src = H3 + row + (qk ? kcol : qcol) + pj;
                const u32x2 a = *(const u32x2*)src, c = *(const u32x2*)(src + 64);
                const float x1[4] = {bflo(a.x), bfhi(a.x), bflo(a.y), bfhi(a.y)}, x2[4] = {bflo(c.x), bfhi(c.x), bflo(c.y), bfhi(c.y)};
                float y1[4], y2[4]; const float sc = qk ? 1.0f : QSCALE;
#pragma unroll
                for (int i = 0; i < 4; ++i) { y1[i] = (x1[i] * cs[tt][i] - x2[i] * sn[tt][i]) * sc; y2[i] = (x2[i] * cs[tt][i] + x1[i] * sn[tt][i]) * sc; }
                bf16_t* dst = (qk ? KR : QR) + orow + pj;
                u32x2 w1, w2; w1.x = pk2(y1[0], y1[1]); w1.y = pk2(y1[2], y1[3]); w2.x = pk2(y2[0], y2[1]); w2.y = pk2(y2[2], y2[3]);
                *(u32x2*)dst = w1; *(u32x2*)(dst + 64) = w2;
                if (qk && hd >= 12) {
#pragma unroll
                    for (int i = 0; i < 4; ++i) { KS[tl * 129 + pj + i] = y1[i]; KS[tl * 129 + 64 + pj + i] = y2[i]; }
                }
            }
        }
#pragma unroll
        for (int i = 0; i < 2; ++i) { const int idx = F.tid + 512 * i, tl = idx >> 4, pc = idx & 15;
            *(LAS u32x4*)(VL + tl * 136 + pc * 8) = *(const u32x4*)(H3 + (size_t)(b * SEQ + s0 + tl) * H3LD + vcol + pc * 8); }
        __syncthreads();
        if (hd >= 12 && F.tid < 128) { float sum = 0.f;
#pragma unroll 8
            for (int tl = 0; tl < 64; ++tl) sum += KS[tl * 129 + F.tid];
            KPART[((size_t)(b * 4 + hd - 12) * 32 + st) * 128 + F.tid] = sum; }
        {
            const int pp = posp(s0 + F.lane, dl);
#pragma unroll 4
            for (int i = 0; i < 16; ++i) { const int d = F.wave * 16 + i; VT[((size_t)(b * 16 + hd) * 128 + d) * 2048 + pp] = VL[F.lane * 136 + d]; }
        }
        __syncthreads();
    }
}

template <int MODE>
__device__ __forceinline__ void attn_item(const Params& p, const Frame& F0, int b, int hd, int q0, int ktile_lo, int ktile_hi) {
    const Frame F = refresh(F0);
    const int lane = F.lane, fr = lane & 15, g = lane >> 4, wave = F.wave;
    unsigned char* scr = opq(p.ws) + WS_SCR;
    const size_t hb = (size_t)(b * 16 + hd);
    const bf16_t* Qg = (const bf16_t*)(scr + A_QR) + hb * 2048 * 128; const bf16_t* Kg = (const bf16_t*)(scr + A_KR) + hb * 2048 * 128; const bf16_t* Vg = (const bf16_t*)(scr + A_VT) + hb * 128 * 2048;
    constexpr int BUFB = 35840, OFF_V = 17408, OFF_KM = 71680;
    const int nq = q0 + 16 * wave + fr;
    bf16x8 qf[4];
#pragma unroll
    for (int kb = 0; kb < 4; ++kb) qf[kb] = *(const bf16x8*)(Qg + (size_t)nq * 128 + 32 * kb + 8 * g);
    unsigned selmask = 0u;
    if (MODE == 1) {
        const int qb = q0 >> 8, h = hd - 12;
        LAS float* KM = (LAS float*)(F.lds + OFF_KM);
        const float* KPART = (const float*)(scr + A_KPART) + (size_t)(b * 4 + h) * 32 * 128;
#pragma unroll
        for (int i = 0; i < 2; ++i) { const int idx = F.tid + 512 * i, jb = idx >> 7, d = idx & 127;
            KM[idx] = (KPART[(4 * jb + 0) * 128 + d] + KPART[(4 * jb + 1) * 128 + d]) + (KPART[(4 * jb + 2) * 128 + d] + KPART[(4 * jb + 3) * 128 + d]); }
        __syncthreads();
        float gate[8];
#pragma unroll
        for (int jb = 0; jb < 8; ++jb) { float s = 0.f;
#pragma unroll
            for (int kb = 0; kb < 4; ++kb) { const u32x4 qq = __builtin_bit_cast(u32x4, qf[kb]); const LAS float* km = KM + jb * 128 + 32 * kb + 8 * g;
                const f32x4 k0 = *(const LAS f32x4*)km, k1 = *(const LAS f32x4*)(km + 4);
                s += (bflo(qq.x) * k0[0] + bfhi(qq.x) * k0[1]) + (bflo(qq.y) * k0[2] + bfhi(qq.y) * k0[3]) + (bflo(qq.z) * k1[0] + bfhi(qq.z) * k1[1]) + (bflo(qq.w) * k1[2] + bfhi(qq.w) * k1[3]); }
            s += xor16_f(s); s = xor32_sum(s); gate[jb] = s; }
#pragma unroll
        for (int jb = 0; jb < 8; ++jb) { int rank = 0;
#pragma unroll
            for (int j2 = 0; j2 < 8; ++j2) if (j2 != jb && j2 < qb) rank += (gate[j2] > gate[jb] || (gate[j2] == gate[jb] && j2 < jb)) ? 1 : 0;
            if (jb < qb && rank < 3) selmask |= 1u << jb; }
        __syncthreads();
    }
    u32x4 rk[2], rv[2];
#define AT_ISSUE(kt) do { _Pragma("unroll") for (int i = 0; i < 2; ++i) { const int idx = F.tid + 512 * i; \
        rk[i] = *(const u32x4*)(Kg + (size_t)((kt) * 64 + (idx >> 4)) * 128 + (idx & 15) * 8); rv[i] = *(const u32x4*)(Vg + (size_t)(idx >> 3) * 2048 + (kt) * 64 + (idx & 7) * 8); } } while (0)
#define AT_WRITE(bufp) do { _Pragma("unroll") for (int i = 0; i < 2; ++i) { const int idx = F.tid + 512 * i; \
        *(LAS u32x4*)((bufp) + ((idx >> 4) * 136 + (idx & 15) * 8) * 2) = rk[i]; *(LAS u32x4*)((bufp) + OFF_V + ((idx >> 3) * 72 + (idx & 7) * 8) * 2) = rv[i]; } } while (0)
    f32x4 oacc[8];
#pragma unroll
    for (int dt = 0; dt < 8; ++dt) oacc[dt] = (f32x4){0.f, 0.f, 0.f, 0.f};
    float mrun = -1e30f, lrun = 0.f;
    AT_ISSUE(ktile_lo);
    AT_WRITE(F.lds);
    __syncthreads();
    for (int kt = ktile_lo; kt < ktile_hi; ++kt) {
        LAS unsigned char* buf = F.lds + ((kt - ktile_lo) & 1) * BUFB;
        if (kt + 1 < ktile_hi) AT_ISSUE(kt + 1);
        const LAS bf16_t* KL = (const LAS bf16_t*)buf; const LAS bf16_t* VL = (const LAS bf16_t*)(buf + OFF_V);
        f32x4 sT[4];
#pragma unroll
        for (int t4 = 0; t4 < 4; ++t4) { sT[t4] = (f32x4){0.f, 0.f, 0.f, 0.f};
#pragma unroll
            for (int kb = 0; kb < 4; ++kb) sT[t4] = mfma32(*(const LAS bf16x8*)(KL + (16 * t4 + fr) * 136 + 32 * kb + 8 * g), qf[kb], sT[t4]); }
        const int k0 = kt * 64; float mx = -1e30f;
        const float NEG = -__builtin_huge_valf();
#pragma unroll
        for (int t4 = 0; t4 < 4; ++t4)
#pragma unroll
            for (int r = 0; r < 4; ++r) { const int nk = k0 + 16 * t4 + 4 * g + r; bool v;
                if (MODE == 0) v = (nk <= nq) && (nq - nk <= 128);
                else v = ((k0 >> 8) == (q0 >> 8)) ? (nk <= nq) : (((selmask >> (k0 >> 8)) & 1u) != 0u);
                sT[t4][r] = v ? sT[t4][r] : NEG; mx = fmaxf(mx, sT[t4][r]); }
        mx = fmaxf(mx, xor16_f(mx)); mx = xor32_max(mx);
        const float mnew = fmaxf(mrun, mx), alpha = exp2f(mrun - mnew); mrun = mnew;
        float ps = 0.f;
#pragma unroll
        for (int t4 = 0; t4 < 4; ++t4)
#pragma unroll
            for (int r = 0; r < 4; ++r) { const float pv = exp2f(sT[t4][r] - mnew); sT[t4][r] = pv; ps += pv; }
        lrun = lrun * alpha + ps;
        const bf16x8 pb0 = pack8(sT[0], sT[1]), pb1 = pack8(sT[2], sT[3]);
#pragma unroll
        for (int dt = 0; dt < 8; ++dt) {
            oacc[dt] = oacc[dt] * alpha;
            oacc[dt] = mfma32(frag_perm(VL + (16 * dt + fr) * 72, 4 * g), pb0, oacc[dt]);
            oacc[dt] = mfma32(frag_perm(VL + (16 * dt + fr) * 72, 32 + 4 * g), pb1, oacc[dt]);
        }
        if (kt + 1 < ktile_hi) AT_WRITE(F.lds + ((kt + 1 - ktile_lo) & 1) * BUFB);
        __syncthreads();
    }
#undef AT_ISSUE
#undef AT_WRITE
    lrun += xor16_f(lrun); lrun = xor32_sum(lrun);
    const float inv = 1.0f / lrun;
    if (MODE == 0) {
        bf16_t* og = (bf16_t*)(scr + A_OG) + ((size_t)(b * 12 + hd) * 2048 + nq) * 128;
#pragma unroll
        for (int dt = 0; dt < 8; ++dt) { u32x2 w; w.x = pk2(oacc[dt][0] * inv, oacc[dt][1] * inv); w.y = pk2(oacc[dt][2] * inv, oacc[dt][3] * inv); *(u32x2*)(og + 16 * dt + 4 * g) = w; }
        if (g == 0) ((float*)(scr + A_LSE))[(size_t)(b * 12 + hd) * 2048 + nq] = mrun + log2f(lrun);
    } else {
        unsigned char* oc = (opq(p.ws) + WS_OC) + (size_t)(b * SEQ + nq) * 1024 + 512 + (hd - 12) * 128;
        const float inv4 = inv * A_PRE;
#pragma unroll
        for (int dt = 0; dt < 8; ++dt) *(unsigned*)(oc + 16 * dt + 4 * g) = pk4_fp8(oacc[dt][0] * inv4, oacc[dt][1] * inv4, oacc[dt][2] * inv4, oacc[dt][3] * inv4);
    }
}

__device__ __forceinline__ void attn_phase(const Params& p, const Frame& F0) {
    const Frame F = refresh(F0);
    const int i = F.bid & 15, bhm = F.bid >> 4;
    const int nd = (i == 0) ? 7 : (i <= 2) ? 6 : (i <= 4) ? 5 : (i <= 6) ? 4 : (i <= 8) ? 3 : (i <= 10) ? 2 : (i == 11) ? 1 : 0;
    const int st = (i == 0) ? 0 : (i == 1) ? 7 : (i == 2) ? 13 : (i == 3) ? 19 : (i == 4) ? 24 : (i == 5) ? 29 : (i == 6) ? 33 : (i == 7) ? 37 : (i == 8) ? 40 : (i == 9) ? 43 : (i == 10) ? 45 : (i == 11) ? 47 : 48;
    const bool balanced = (F.G == 256);
    for (int k = 0;; ++k) {
        int it;
        if (balanced) { if (k > nd) break; it = (k == 0) ? (bhm * 16 + i) : (256 + bhm * 48 + st + k - 1); }
        else { it = F.bid + k * F.G; if (it >= 1024) break; }
        if (it < 256) { const int qt = it & 15; attn_item<1>(p, F, it >> 6, 12 + ((it >> 4) & 3), qt * 128, 0, 2 * (qt + 1)); }
        else { const int id = it - 256, qt = id & 15, hd = (id >> 4) % 12, b = (id >> 4) / 12, dl = head_dil_log2(hd); const int q0 = qt * 128, first = ((q0 & ((2048 >> dl) - 1)) == 0);
            attn_item<0>(p, F, b, hd, q0, first ? 2 * qt : 2 * qt - 2, 2 * qt + 2); }
    }
}

__device__ __forceinline__ void merge_pass(const Params& p, const Frame& F0) {
    const Frame F = refresh(F0);
    const int gw = F.bid * NWAVES + F.wave, NGW = F.G * NWAVES, hg = F.lane >> 4, d0 = (F.lane & 15) * 8;
    unsigned char* scr = opq(p.ws) + WS_SCR;
    const bf16_t* OG = (const bf16_t*)(scr + A_OG); const float* LSE = (const float*)(scr + A_LSE); bf16_t* OC = (bf16_t*)(opq(p.ws) + WS_OC);
    for (int m = gw; m < T; m += NGW) {
        const int b = m >> 11, s = m & 2047;
        float ls[3]; u32x4 ov[3];
#pragma unroll
        for (int gi = 0; gi < 3; ++gi) { const int hd = 4 * gi + hg; const size_t idx = (size_t)(b * 12 + hd) * 2048 + posp(s, 2 * gi); ls[gi] = LSE[idx]; ov[gi] = *(const u32x4*)(OG + idx * 128 + d0); }
        const float mx = fmaxf(ls[0], fmaxf(ls[1], ls[2]));
        float w[3]; float ws = 0.f;
#pragma unroll
        for (int gi = 0; gi < 3; ++gi) { w[gi] = exp2f(ls[gi] - mx); ws += w[gi]; }
        const float inv = 1.0f / ws;
        float o[8] = {0.f, 0.f, 0.f, 0.f, 0.f, 0.f, 0.f, 0.f};
#pragma unroll
        for (int gi = 0; gi < 3; ++gi) { const float wg = w[gi] * inv;
            o[0] += wg * bflo(ov[gi].x); o[1] += wg * bfhi(ov[gi].x); o[2] += wg * bflo(ov[gi].y); o[3] += wg * bfhi(ov[gi].y);
            o[4] += wg * bflo(ov[gi].z); o[5] += wg * bfhi(ov[gi].z); o[6] += wg * bflo(ov[gi].w); o[7] += wg * bfhi(ov[gi].w); }
        u32x2 wv; wv.x = pk4_fp8(o[0] * A_PRE, o[1] * A_PRE, o[2] * A_PRE, o[3] * A_PRE); wv.y = pk4_fp8(o[4] * A_PRE, o[5] * A_PRE, o[6] * A_PRE, o[7] * A_PRE);
        *(u32x2*)((unsigned char*)OC + (size_t)m * 1024 + hg * 128 + d0) = wv;
    }
}

#define GRID_SYNC() xcd_barrier((unsigned*)(opq(p.ws) + WS_CTL), (volatile LAS unsigned*)(F.lds + LDS_BYTES - 16), F.wave)
#ifndef REPMASK
#define REPMASK 0u
#endif
__device__ __forceinline__ int repn(int k) { int n = 1 + (int)(((REPMASK) >> k) & 1u); asm volatile("" : "+s"(n)); return n; }
#define RP(k) for (int _r = 0, _n = repn(k); _r < _n; ++_r)
__global__ void __launch_bounds__(NTHR, 2) mk_fwd(Params p) {
    extern __shared__ __attribute__((aligned(16))) unsigned char lds_raw[];
    Frame F; F.lds = (LAS unsigned char*)lds_raw; F.tid = 0; F.lane = 0; F.wave = __builtin_amdgcn_readfirstlane(threadIdx.x >> 6); F.G = gridDim.x; F.bid = blockIdx.x;
#define P_WS (opq(p.ws))
#define P_AB ((bf16_t*)(opq(p.ws) + WS_AB))
#define P_R (opq(p.out))
#define P_MIX ((bf16_t*)(opq(p.ws) + WS_MIX))
#define P_HID ((bf16_t*)(opq(p.ws) + WS_HID))
#define P_Y2 ((bf16_t*)(opq(p.ws) + WS_Y2))

    {
        if (threadIdx.x == 0) { volatile LAS unsigned* st = (volatile LAS unsigned*)(F.lds + LDS_BYTES - 16); st[0] = 0u; st[1] = 0u;
            (void)xb_add((unsigned*)(p.ws + WS_CTL) + XB_XCNT(xb_xcc_id()), 1u); }
        __syncthreads();
    }
    RP(0) { convert_set(p, F, 0, F.bid * NWAVES + F.wave, F.G * NWAVES); __syncthreads(); }
    RP(1) { load_w16_lds(F, p.in[I_EV_WIN], EVEN_IN, 4096); __syncthreads(); p0_xpass(p, F); __syncthreads(); }
    GRID_SYNC();

    RP(2) {
        pg8::StaticOrder S; S.init(T, 8192, F.G, F.bid);
        pg8::Gemm g{(const unsigned char*)(P_WS + WS_AB), (const unsigned char*)(P_WS + WS_WIN), 2048, (unsigned)(T * 2048), (unsigned)(8192 * 2048), SC_A16};
        pg8::EpiBf16 E{(bf16_t*)(P_WS + WS_H1), H1LD, (unsigned)(T * 8192 * 2)};
        pg8::gemm_phase(F.lds, F.wave, g, S, E);
    }
    GRID_SYNC();
    RP(3) { p2_pre(p, F); }
    GRID_SYNC();
    RP(4) { if (F.bid < 32) gdn_scan(p, F, F.bid); else if (F.bid < 64) hgrn_scan(p, F, F.bid - 32);
            else if (F.G > 64) convert_set(p, F, 1, (F.bid - 64) * NWAVES + F.wave, (F.G - 64) * NWAVES); }
    if (F.G <= 64) { convert_set(p, F, 1, F.bid * NWAVES + F.wave, F.G * NWAVES); }
    GRID_SYNC();
    RP(5) { p4_gate(p, F); }
    GRID_SYNC();
    RP(6) {
        pg8::StaticOrder S; S.init(T, 2048, F.G, F.bid);
        pg8::Gemm g{(const unsigned char*)(P_WS + WS_OC), (const unsigned char*)(P_WS + WS_WOUT), 2048, (unsigned)(T * 2048), (unsigned)(2048 * 2048), SC_A4};
        pg8::EpiBf16 E{P_MIX, 2048, (unsigned)(T * 2048 * 2)};
        pg8::gemm_phase(F.lds, F.wave, g, S, E);
    }
    GRID_SYNC();
#define MOE_BLOCK(layer, resid, mixp, outfinal, outb2) do { \
        for (int _r = 0, _n = ((layer) == 0 ? repn(7) : 1); _r < _n; ++_r) { load_w16_lds(F, p.in[I_RW], 16, 0); __syncthreads(); \
            ln_pass<true, false, (layer) != 0, true>(p, F, resid, mixp, D, nullptr, p.in[I_LNG] + (size_t)((layer) * 2 + 0) * D, p.in[I_LNB] + (size_t)((layer) * 2 + 0) * D, P_R, P_AB, layer); __syncthreads(); } \
        GRID_SYNC(); \
        const int* list = (const int*)(P_WS + WS_LIST) + (size_t)(layer) * NE * T; \
        const float* gatew = (const float*)(P_WS + WS_GATEW) + (size_t)(layer) * 2 * T; \
        RP(8) { moe_lists(p, F, layer); } \
        GRID_SYNC(); \
        { const Frame Fr = refresh(F); pg8::moe_build_table(F.lds, Fr.tid); } \
        unsigned* tcnt = (unsigned*)(P_WS + WS_CTL) + 3600 + 128 * (layer);        \
        { pg8::MoeOrder<4, false> S; S.init(F.lds, list, F.G, F.bid, 1024, tcnt); \
            pg8::Gemm g{(const unsigned char*)(P_WS + WS_ABS), (const unsigned char*)(P_WS + ((layer) ? WS_WGU1 : WS_WGU)), 2048, (unsigned)(20480 * 2048), (unsigned)(NE * 1024 * 2048), SC_A1}; \
            pg8::EpiGateUpB E{P_HID, list, gatew}; pg8::gemm_phase(F.lds, F.wave, g, S, E); } \
          \
        { pg8::MoeDownS S; S.init(F.lds, tcnt, 2048, F.G, F.bid); \
            pg8::Gemm16 g{P_HID, (const bf16_t*)(P_WS + WS_WD), 512, (unsigned)(20480 * 512 * 2), (unsigned)(NE * 2048 * 512 * 2)}; \
            pg8::EpiDown E{P_Y2, list}; pg8::gemm_phase16(F.lds, F.wave, g, S, E); } \
        GRID_SYNC(); \
        ln_pass<false, true, true, (layer) == 0>(p, F, P_R, P_Y2, D, P_Y2, p.in[I_LNG] + (size_t)((layer) * 2 + 1) * D, p.in[I_LNB] + (size_t)((layer) * 2 + 1) * D, outfinal, outb2, layer); \
    } while (0)
    MOE_BLOCK(0, p.in[I_X], P_MIX, P_R, (bf16_t*)(P_WS + WS_AB8));
    __syncthreads();
    RP(11) { convert_set(p, F, 2, F.bid * NWAVES + F.wave, F.G * NWAVES); __syncthreads(); }
    GRID_SYNC();
    RP(12) {
        pg8::StaticOrder S; S.init(T, 6144, F.G, F.bid);
        pg8::Gemm g{(const unsigned char*)(P_WS + WS_AB8), (const unsigned char*)(P_WS + WS_W3), 2048, (unsigned)(T * 2048), (unsigned)(6144 * 2048), SC_A1};
        pg8::EpiBf16 E{(bf16_t*)(P_WS + WS_H1), H3LD, (unsigned)(T * 6144 * 2)};
        pg8::gemm_phase(F.lds, F.wave, g, S, E);
    }
    GRID_SYNC();
    RP(13) { const Frame Fr = refresh(F); for (int u = Fr.bid; u < 256; u += Fr.G) rope_unit(p, Fr, u); }
    GRID_SYNC();
    RP(14) { attn_phase(p, F); }
    GRID_SYNC();
    RP(15) { merge_pass(p, F); }
    GRID_SYNC();
    RP(16) {
        pg8::StaticOrder S; S.init(T, 2048, F.G, F.bid);
        pg8::Gemm g{(const unsigned char*)(P_WS + WS_OC), (const unsigned char*)(P_WS + WS_WOUT1), 1024, (unsigned)(T * 1024), (unsigned)(2048 * 1024), SC_A4};
        pg8::EpiBf16 E{P_MIX, 2048, (unsigned)(T * 2048 * 2)};
        pg8::gemm_phase(F.lds, F.wave, g, S, E);
    }
    GRID_SYNC();
    MOE_BLOCK(1, P_R, P_MIX, p.out, (bf16_t*)nullptr);
#undef MOE_BLOCK
#undef P_WS
#undef P_AB
#undef P_R
#undef P_MIX
#undef P_HID
#undef P_Y2
}

extern "C" void kernel_launch(void* const* d_in, const int* in_sizes, int n_in, void* d_out, int out_size,
                              void* d_ws, size_t ws_size, hipStream_t stream) {
    static int grid_blocks = 0;
    if (!grid_blocks) {
        int dev = 0, cus = 0, per_cu = 0;
        (void)hipGetDevice(&dev);
        (void)hipDeviceGetAttribute(&cus, hipDeviceAttributeMultiprocessorCount, dev);
        (void)hipFuncSetAttribute((const void*)mk_fwd, hipFuncAttributeMaxDynamicSharedMemorySize, LDS_BYTES);
        (void)hipOccupancyMaxActiveBlocksPerMultiprocessor(&per_cu, (const void*)mk_fwd, NTHR, LDS_BYTES);
        if (per_cu < 1) fprintf(stderr, "kernel_launch: occupancy query says %d blocks per CU\n", per_cu);
        grid_blocks = cus;
        if (ws_size < WS_END) { fprintf(stderr, "kernel_launch: workspace too small: %zu < %zu\n", ws_size, (size_t)WS_END); grid_blocks = -1; }
        if (n_in != 18) { fprintf(stderr, "kernel_launch: expected 18 inputs, got %d\n", n_in); grid_blocks = -1; }
    }
    if (grid_blocks < 0) return;
    Params p{};
    for (int i = 0; i < 18; ++i) p.in[i] = (const float*)d_in[i];
    p.out = (float*)d_out; p.ws = (unsigned char*)d_ws;
    (void)hipMemsetAsync(d_ws, 0, 16384, stream);
    void* args[] = {&p};
    hipError_t e = hipLaunchCooperativeKernel((void*)mk_fwd, dim3(grid_blocks), dim3(NTHR), args, LDS_BYTES, stream);
    if (e != hipSuccess) fprintf(stderr, "cooperative launch failed: %s (grid %d)\n", hipGetErrorString(e), grid_blocks);
}
```

```cpp
#include <hip/hip_runtime.h>
#include <cstdio>
#include <cstdint>

#define GAS __attribute__((address_space(1)))
#define LAS __attribute__((address_space(3)))
typedef unsigned short bf16_t;
typedef short bf16x8 __attribute__((ext_vector_type(8)));
typedef short bf16x4 __attribute__((ext_vector_type(4)));
typedef float f32x4 __attribute__((ext_vector_type(4)));
typedef float f32x2 __attribute__((ext_vector_type(2)));
typedef unsigned u32x4 __attribute__((ext_vector_type(4)));
typedef unsigned u32x2 __attribute__((ext_vector_type(2)));

constexpr int NB = 4, SEQ = 2048, T = NB * SEQ, D = 2048;
constexpr int EVEN_IN = 8208, ODD_IN = 6144;
constexpr int NE = 16, DEXP = 512;
constexpr float ALPHA = 1.4142135623730951f;
constexpr float LN_EPS = 1e-5f, RMS_EPS = 1e-6f;
constexpr int NWAVES = 8, NTHR = 512;
constexpr int LDS_BYTES = 147456;

constexpr size_t MiB = 1u << 20;
constexpr size_t WS_CTL = 0;
constexpr size_t WS_LIST = 1 * MiB;
constexpr size_t WS_GATEW = 2 * MiB;
constexpr size_t WS_BA = 2 * MiB + 512 * 1024;
constexpr size_t WS_ROPE = 3 * MiB;
constexpr size_t WS_KMEAN = 4 * MiB;
constexpr size_t WS_WREG = 8 * MiB;
constexpr size_t WS_WIN = WS_WREG;
constexpr size_t WS_AB8 = WS_WREG + 16 * MiB;
constexpr size_t WS_WOUT = WS_WREG + 32 * MiB;
constexpr size_t WS_WGU = WS_WREG + 40 * MiB;
constexpr size_t WS_WD = WS_WREG + 104 * MiB;
constexpr size_t WS_AB = WS_WREG + 136 * MiB;
constexpr size_t WS_H1 = WS_AB + 32 * MiB;
constexpr size_t WS_OC = WS_H1 + 128 * MiB;
constexpr size_t WS_MIX = WS_OC + 32 * MiB;
constexpr size_t WS_SCR = WS_MIX + 32 * MiB;
constexpr size_t WS_HID = WS_SCR;
constexpr size_t WS_Y2 = WS_SCR + 20 * MiB;
constexpr size_t WS_ABS = WS_SCR + 84 * MiB;
constexpr size_t WS_END = WS_SCR + 216 * MiB;
static_assert(WS_END == 584 * MiB, "workspace map");

typedef __bf16 bf16v2_t __attribute__((ext_vector_type(2)));
__device__ __forceinline__ unsigned pk2(float lo, float hi) { const f32x2 f = {lo, hi}; return __builtin_bit_cast(unsigned, __builtin_convertvector(f, bf16v2_t)); }
__device__ __forceinline__ unsigned f2bf(float f) { return pk2(f, 0.f) & 0xffffu; }
__device__ __forceinline__ unsigned pk4_fp8(float a, float b, float c, float d) {
    a = fminf(fmaxf(a, -448.f), 448.f); b = fminf(fmaxf(b, -448.f), 448.f); c = fminf(fmaxf(c, -448.f), 448.f); d = fminf(fmaxf(d, -448.f), 448.f);
    int w = 0; w = __builtin_amdgcn_cvt_pk_fp8_f32(a, b, w, false); w = __builtin_amdgcn_cvt_pk_fp8_f32(c, d, w, true); return (unsigned)w;
}
constexpr float W_PRE = 64.f;  constexpr int SC_W = 0x79797979;
constexpr float A_PRE = 4.f;   constexpr int SC_A4 = 0x7d7d7d7d;
constexpr int SC_A1 = 0x7f7f7f7f;
constexpr float X_PRE = 16.f;  constexpr int SC_A16 = 0x7b7b7b7b;
typedef int i32x8 __attribute__((ext_vector_type(8)));
__device__ __forceinline__ float bf2f(unsigned short b) { return __builtin_bit_cast(float, (unsigned)b << 16); }
__device__ __forceinline__ float bflo(unsigned w) { return __builtin_bit_cast(float, w << 16); }
__device__ __forceinline__ float bfhi(unsigned w) { return __builtin_bit_cast(float, w & 0xffff0000u); }
__device__ __forceinline__ unsigned cvt_pk_bf16(float lo, float hi) { return pk2(lo, hi); }
template <int CTRL> __device__ __forceinline__ float dpp_f(float x) { return __builtin_bit_cast(float, __builtin_amdgcn_update_dpp(0, __builtin_bit_cast(int, x), CTRL, 0xf, 0xf, true)); }
__device__ __forceinline__ float xor16_f(float x) { return __builtin_bit_cast(float, __builtin_amdgcn_ds_swizzle(__builtin_bit_cast(int, x), 0x401f)); }
__device__ __forceinline__ float row16_sum(float v) { v += dpp_f<0xB1>(v); v += dpp_f<0x4E>(v); v += dpp_f<0x141>(v); v += dpp_f<0x140>(v); return v; }
__device__ __forceinline__ float xor32_sum(float v) { const int i = __builtin_bit_cast(int, v); const auto r = __builtin_amdgcn_permlane32_swap(i, i, false, false);
    return __builtin_bit_cast(float, (int)r[0]) + __builtin_bit_cast(float, (int)r[1]); }
__device__ __forceinline__ float xor32_max(float v) { const int i = __builtin_bit_cast(int, v); const auto r = __builtin_amdgcn_permlane32_swap(i, i, false, false);
    return fmaxf(__builtin_bit_cast(float, (int)r[0]), __builtin_bit_cast(float, (int)r[1])); }
__device__ __forceinline__ float wave_sum(float v) { v = row16_sum(v); v += xor16_f(v); return xor32_sum(v); }
__device__ __forceinline__ float sigmoidf_(float x) { return 1.0f / (1.0f + __expf(-x)); }
__device__ __forceinline__ float siluf_(float x) { return x / (1.0f + __expf(-x)); }
#define LDS_WAIT() asm volatile("s_waitcnt lgkmcnt(0)" ::: "memory")
template <class Tp> __device__ __forceinline__ Tp* opq(Tp* x) { asm volatile("" : "+s"(x)); return x; }
template <class Tp> __device__ __forceinline__ Tp* opqg(Tp* x) { GAS Tp* g = (GAS Tp*)x; asm volatile("" : "+s"(g)); return (Tp*)g; }
__device__ __forceinline__ float ld_agent(const float* p) { return __hip_atomic_load(p, __ATOMIC_RELAXED, __HIP_MEMORY_SCOPE_AGENT); }

namespace pg8 {
constexpr int BM = 256, BK = 64, HALF = 128, HTB = HALF * BK * 2, STAGE_BYTES = 8 * HTB, NXCD = 8, WGM = 8;
__device__ __forceinline__ int lds_byte(int r, int c) { const int st = (r >> 4) * 2 + (c >> 5), rr = r & 15, cc = c & 31, ob = rr * 64 + cc * 2; return st * 1024 + (ob ^ (((ob >> 9) & 1) << 5)); }
__device__ __forceinline__ void stage_rc(int b, int& R, int& C) { const int st = b / 1024, sb = b % 1024, swz = sb ^ (((sb >> 9) & 1) << 5); R = (st >> 1) * 16 + swz / 64; C = (st & 1) * 32 + (swz % 64) / 2; }
__device__ __forceinline__ int perm32(int rho) { const int n = rho >> 4, i = rho & 15; return 8 * (i >> 2) + 4 * n + (i & 3); }

struct Unit { int pm, pn, e, cnt, arow0, brow0; };
struct Gemm { const unsigned char* A; const unsigned char* Bt; int K; unsigned abytes, bbytes; int sc_a; };

struct StaticOrder {
    static constexpr bool CONTIG = true;
    int nM, nN, nwg, G, c;
    __device__ void init(int M, int N, int G_, int c_) { nM = M / BM; nN = N / BM; nwg = nM * nN; G = G_; c = c_; }
    __device__ bool next(int i, Unit& u) const {
        const long L = (long)i * G + c; if (L >= nwg) return false;
        int wgid = (int)L; { const int q = nwg / NXCD, r = nwg % NXCD, xcd = wgid % NXCD, off = wgid / NXCD; wgid = (xcd < r ? xcd * (q + 1) : r * (q + 1) + (xcd - r) * q) + off; }
        const int nig = WGM * nN, gid = wgid / nig, fm = gid * WGM, gsz = (nM - fm) < WGM ? (nM - fm) : WGM;
        u.pm = fm + ((wgid % nig) % gsz); u.pn = (wgid % nig) / gsz; u.e = 0; u.cnt = 0; u.arow0 = u.pm * BM; u.brow0 = u.pn * BM; return true;
    }
    __device__ __forceinline__ unsigned arow(const Unit& u, int r) const { return (unsigned)(u.arow0 + r); }
    __device__ __forceinline__ void done(const Unit&, int) const {}
    struct State {};
    __device__ __forceinline__ bool first(State&, Unit& u, int) const { return next(0, u); }
    __device__ __forceinline__ void issue(State&, int, int) const {}
    __device__ __forceinline__ bool fin(State&, int i, Unit& u, int) const { return next(i, u); }
};

constexpr int MOE_TAB_OFF = 131072;
constexpr int MOE_HIST_OFF = 131072 + 3072;
__device__ __forceinline__ void moe_build_table(LAS unsigned char* lds, int tid) {
    LAS int* tab = (LAS int*)(lds + MOE_TAB_OFF);
    const LAS int* cnts = (const LAS int*)(lds + MOE_HIST_OFF) + 16;
    if (tid == 0) {
        int s = 0;
#pragma unroll 1
        for (int e = 0; e < NE; ++e) { const int c = cnts[e]; const int nt = (c + 255) >> 8;
#pragma unroll 1
            for (int k = 0; k < nt; ++k) { tab[4 + 4 * (s + k)] = e; tab[4 + 4 * (s + k) + 1] = k; tab[4 + 4 * (s + k) + 2] = c; }
            s += nt; }
        tab[0] = s;
    }
    __syncthreads();
}
template <int NPN, bool GATHER>
struct MoeOrder {
    static constexpr bool CONTIG = !GATHER;
    const int* list;
    LAS const int* tab; int G, c, brows;
    unsigned* tcnt;
    __device__ void init(LAS unsigned char* lds, const int* list_, int G_, int c_, int brows_, unsigned* tcnt_ = nullptr) { list = list_; G = G_; c = c_; brows = brows_; tab = (LAS const int*)(lds + MOE_TAB_OFF); tcnt = tcnt_; }
    __device__ __forceinline__ void done(const Unit& u, int lane) const {
        if (tcnt) { asm volatile("s_waitcnt vmcnt(0)" ::: "memory"); if (lane == 0) __hip_atomic_fetch_add(tcnt + (u.arow0 >> 8), 1u, __ATOMIC_RELAXED, __HIP_MEMORY_SCOPE_AGENT); }
    }
    __device__ bool next(int i, Unit& u) const {
        int L = i * G + c; const int ntile = __builtin_amdgcn_readfirstlane(tab[0]); if (L >= ntile * NPN) return false;
        if (NPN == 4 && i == 0 && G == 256) L = (c & 7) * 32 + (c >> 3);
        const int tile = L / NPN; u.pn = L % NPN;
        u.e = __builtin_amdgcn_readfirstlane(tab[4 + 4 * tile]); u.pm = __builtin_amdgcn_readfirstlane(tab[4 + 4 * tile + 1]); u.cnt = __builtin_amdgcn_readfirstlane(tab[4 + 4 * tile + 2]);
        u.arow0 = tile * BM; u.brow0 = u.e * brows + u.pn * BM; return true;
    }
    __device__ __forceinline__ unsigned arow(const Unit& u, int r) const {
        if (!GATHER) return (unsigned)(u.arow0 + r);
        int idx = u.pm * BM + r; if (idx >= u.cnt) idx = 0;
        return (unsigned)(list[u.e * T + idx] >> 1);
    }
    struct State {};
    __device__ __forceinline__ bool first(State&, Unit& u, int) const { return next(0, u); }
    __device__ __forceinline__ void issue(State&, int, int) const {}
    __device__ __forceinline__ bool fin(State&, int i, Unit& u, int) const { return next(i, u); }
};
constexpr int MOE_Q_OFF = 131072 + 3072 + 512;
struct MoeDownS {
    static constexpr bool CONTIG = true;
    typedef __attribute__((address_space(1))) unsigned gu32;
    LAS const int* tab; LAS unsigned* slot; gu32* tcnt; int brows, G, c;
    struct State {};
    __device__ void init(LAS unsigned char* lds, unsigned* tcnt_, int brows_, int G_, int c_) { tab = (LAS const int*)(lds + MOE_TAB_OFF); slot = (LAS unsigned*)(lds + MOE_Q_OFF); tcnt = (gu32*)tcnt_; brows = brows_; G = G_; c = c_; }
    __device__ __forceinline__ unsigned nunits() const { return (unsigned)__builtin_amdgcn_readfirstlane(tab[0]) * 8u; }
    __device__ __forceinline__ unsigned qof(int k) const {
        const int nG = __builtin_amdgcn_readfirstlane(tab[0]) * 4, h = nG % G, nl = G - h;
        return (unsigned)(c >= h ? k * nl + (k >= 3 ? (k - 2) * h : 0) + (c - h) : (k + 3) * nl + k * h + c);
    }
    __device__ __forceinline__ void wait_tile(unsigned q, unsigned cv) const {
        unsigned sp = 0;
        while (cv < 32u) { __builtin_amdgcn_s_sleep(2); if (++sp > (1u << 22)) break; cv = __hip_atomic_load(tcnt + (q >> 3), __ATOMIC_RELAXED, __HIP_MEMORY_SCOPE_AGENT); }
        asm volatile("buffer_inv sc1" ::: "memory");
    }
    __device__ __forceinline__ bool decode(unsigned q, Unit& u) const {
        if (q >= nunits()) return false;
        const int tile = (int)(q >> 3); u.pn = (int)(q & 7u);
        u.e = __builtin_amdgcn_readfirstlane(tab[4 + 4 * tile]); u.pm = __builtin_amdgcn_readfirstlane(tab[4 + 4 * tile + 1]); u.cnt = __builtin_amdgcn_readfirstlane(tab[4 + 4 * tile + 2]);
        u.arow0 = tile * BM; u.brow0 = u.e * brows + u.pn * BM; return true;
    }
    __device__ __forceinline__ bool first(State&, Unit& u, int tid) const {
        const unsigned q = qof(0);
        if (tid == 0 && q < nunits()) wait_tile(q, __hip_atomic_load(tcnt + (q >> 3), __ATOMIC_RELAXED, __HIP_MEMORY_SCOPE_AGENT));
        __syncthreads();
        return decode(q, u);
    }
    __device__ __forceinline__ void issue(State&, int i, int tid) const {
        const unsigned q = qof(i);
        if (tid == 0 && q < nunits()) {
            const __amdgpu_buffer_rsrc_t rc = __builtin_amdgcn_make_buffer_rsrc((void*)tcnt, (short)0, 128 * 4, 0x00020000);
            __builtin_amdgcn_raw_ptr_buffer_load_lds(rc, (LAS void*)slot, 4, (int)((q >> 3) * 4u), 0, 0, 16);
        }
    }
    __device__ __forceinline__ bool fin(State&, int i, Unit& u, int tid) const {
        const unsigned q = qof(i);
        if (tid == 0 && q < nunits()) {
            unsigned cv; asm volatile("ds_read_b32 %0, %1\n\ts_waitcnt lgkmcnt(0)" : "=v"(cv) : "v"((unsigned)(size_t)slot) : "memory");
            wait_tile(q, cv);
        }
        return decode(q, u);
    }
    __device__ __forceinline__ unsigned arow(const Unit& u, int r) const { return (unsigned)(u.arow0 + r); }
    __device__ __forceinline__ void done(const Unit&, int) const {}
};

struct EpiBf16 {
    static constexpr bool PERM = true;
    bf16_t* O; int ldc; unsigned obytes;
    __device__ __forceinline__ void operator()(const f32x4 (&acc)[2][2][4][2], const Unit& u, int wr, int wc, int fr, int fq) const {
        const __amdgpu_buffer_rsrc_t rO = __builtin_amdgcn_make_buffer_rsrc((void*)O, (short)0, (int)obytes, 0x00020000);
        const unsigned voff = (unsigned)((wr * 64 + fr) * ldc + wc * 32 + 8 * fq) * 2u;
        const unsigned sbase = (unsigned)(u.pm * BM * ldc + u.pn * BM) * 2u;
#pragma unroll
        for (int ai = 0; ai < 2; ++ai)
#pragma unroll
            for (int m = 0; m < 4; ++m)
#pragma unroll
                for (int bj = 0; bj < 2; ++bj) { const f32x4 v0 = acc[ai][bj][m][0], v1 = acc[ai][bj][m][1];
                    u32x4 w; w.x = cvt_pk_bf16(v0[0], v0[1]); w.y = cvt_pk_bf16(v0[2], v0[3]); w.z = cvt_pk_bf16(v1[0], v1[1]); w.w = cvt_pk_bf16(v1[2], v1[3]);
                    __builtin_amdgcn_raw_buffer_store_b128(w, rO, (int)voff, (int)(sbase + (unsigned)((ai * HALF + m * 16) * ldc + bj * HALF) * 2u), 0); }
    }
};
struct EpiGateUp {
    static constexpr bool PERM = true;
    unsigned char* HID; const int* list; const float* gatew;
    __device__ __forceinline__ void operator()(const f32x4 (&acc)[2][2][4][2], const Unit& u, int wr, int wc, int fr, int fq) const {
        const int col0 = u.pn * 128 + wc * 32 + 8 * fq;
#pragma unroll
        for (int ai = 0; ai < 2; ++ai)
#pragma unroll
            for (int m = 0; m < 4; ++m) {
                const int r = ai * HALF + wr * 64 + m * 16 + fr; const int idx = u.pm * BM + r;
                float wgt = 0.f; if (idx < u.cnt) wgt = gatew[list[u.e * T + idx]] * A_PRE;
                const f32x4 g0 = acc[ai][0][m][0], g1 = acc[ai][0][m][1], u0 = acc[ai][1][m][0], u1 = acc[ai][1][m][1];
                float h[8];
#pragma unroll
                for (int i = 0; i < 4; ++i) { h[i] = siluf_(g0[i]) * u0[i] * wgt; h[4 + i] = siluf_(g1[i]) * u1[i] * wgt; }
                u32x2 w; w.x = pk4_fp8(h[0], h[1], h[2], h[3]); w.y = pk4_fp8(h[4], h[5], h[6], h[7]);
                *(u32x2*)(HID + (size_t)(u.arow0 + r) * DEXP + col0) = w;
            }
    }
};
struct EpiGateUpB {
    static constexpr bool PERM = true;
    bf16_t* HID; const int* list; const float* gatew;
    __device__ __forceinline__ void operator()(const f32x4 (&acc)[2][2][4][2], const Unit& u, int wr, int wc, int fr, int fq) const {
        const __amdgpu_buffer_rsrc_t rH = __builtin_amdgcn_make_buffer_rsrc((void*)HID, (short)0, 20480 * 512 * 2, 0x00020000);
        const __amdgpu_buffer_rsrc_t rL = __builtin_amdgcn_make_buffer_rsrc((void*)(list + (size_t)u.e * T), (short)0, T * 4, 0x00020000);
        const __amdgpu_buffer_rsrc_t rG = __builtin_amdgcn_make_buffer_rsrc((void*)gatew, (short)0, 2 * T * 4, 0x00020000);
        const unsigned voff = (unsigned)((wr * 64 + fr) * DEXP + u.pn * 128 + wc * 32 + 8 * fq) * 2u;
        const int idx0 = u.pm * BM + wr * 64 + fr;
#pragma unroll
        for (int ai = 0; ai < 2; ++ai)
#pragma unroll
            for (int m = 0; m < 4; ++m) {
                const int idx = idx0 + ai * HALF + m * 16;
                const int ent = __builtin_amdgcn_raw_buffer_load_b32(rL, idx * 4, 0, 0);
                float wgt = __builtin_bit_cast(float, __builtin_amdgcn_raw_buffer_load_b32(rG, (idx < u.cnt ? ent : 0) * 4, 0, 0)); wgt = idx < u.cnt ? wgt : 0.f;
                const f32x4 g0 = acc[ai][0][m][0], g1 = acc[ai][0][m][1], u0 = acc[ai][1][m][0], u1 = acc[ai][1][m][1];
                float h[8];
#pragma unroll
                for (int i = 0; i < 4; ++i) { h[i] = siluf_(g0[i]) * u0[i] * wgt; h[4 + i] = siluf_(g1[i]) * u1[i] * wgt; }
                u32x4 w; w.x = cvt_pk_bf16(h[0], h[1]); w.y = cvt_pk_bf16(h[2], h[3]); w.z = cvt_pk_bf16(h[4], h[5]); w.w = cvt_pk_bf16(h[6], h[7]);
                __builtin_amdgcn_raw_buffer_store_b128(w, rH, (int)voff, (int)((u.arow0 + ai * HALF + m * 16) * DEXP * 2), 16);
            }
    }
};
struct EpiDown {
    static constexpr bool PERM = true;
    bf16_t* Y2; const int* list;
    __device__ __forceinline__ void operator()(const f32x4 (&acc)[2][2][4][2], const Unit& u, int wr, int wc, int fr, int fq) const {
        const int col0 = u.pn * BM + wc * 32 + 8 * fq;
#pragma unroll
        for (int ai = 0; ai < 2; ++ai)
#pragma unroll
            for (int m = 0; m < 4; ++m) {
                const int r = ai * HALF + wr * 64 + m * 16 + fr; const int idx = u.pm * BM + r;
                if (idx < u.cnt) { const int ent = list[u.e * T + idx]; bf16_t* rowp = Y2 + (size_t)ent * D + col0;
#pragma unroll
                    for (int bj = 0; bj < 2; ++bj) { const f32x4 v0 = acc[ai][bj][m][0], v1 = acc[ai][bj][m][1];
                        u32x4 w; w.x = cvt_pk_bf16(v0[0], v0[1]); w.y = cvt_pk_bf16(v0[2], v0[3]); w.z = cvt_pk_bf16(v1[0], v1[1]); w.w = cvt_pk_bf16(v1[2], v1[3]);
                        *(u32x4*)(rowp + bj * HALF) = w; } }
            }
    }
};

constexpr int NXT_OFF = 131072 + 4096;
template <class Epi, class Sched>
__device__ __forceinline__ void gemm_phase(LAS unsigned char* lds, int wave_id, const Gemm g, const Sched& S, const Epi& E) {
    int lane; asm volatile("v_mbcnt_lo_u32_b32 %0, -1, 0\n\tv_mbcnt_hi_u32_b32 %0, -1, %0" : "=v"(lane));
    const int wid = wave_id, tid = wid * 64 + lane, wr = wid >> 2, wc = wid & 3, fr = lane & 15, fq = lane >> 4;
    const int K = g.K, nt = K / 128;
    unsigned voffB[2];
#pragma unroll
    for (int i = 0; i < 2; ++i) { int R, C; stage_rc(tid * 16 + i * 8192, R, C); const int Rb = Epi::PERM ? ((R & ~31) + perm32(R & 31)) : R; voffB[i] = (unsigned)(Rb * K + 2 * C); }
    const unsigned ldsw = (unsigned)wid * 1024u;
    const int aoff = lds_byte(wr * 64 + fr, 16 * (fq & 1)) + (fq >> 1) * 1024, boff = lds_byte(wc * 32 + fr, 16 * (fq & 1)) + (fq >> 1) * 1024;
    LAS unsigned char* ldsB = lds + 4 * HTB + boff;
    LAS unsigned char* ldsA = lds + aoff;
    const int sc_act = g.sc_a;
#define PG8_SA(b, h) (((b) * 2 + (h)) * HTB)
#define PG8_SB(b, h) ((4 + (b) * 2 + (h)) * HTB)
#define PG8_STAGE(bufoff, rsrc, soff, voff) do { _Pragma("unroll") for (int _i = 0; _i < 2; ++_i) \
        __builtin_amdgcn_raw_ptr_buffer_load_lds(rsrc, (LAS void*)(lds + (bufoff) + ldsw + _i * 8192), 16, (int)(voff)[_i], (int)(soff), 0, 0); } while (0)
#define PG8_LD32(dstv, addr) do { const u32x4 _c0 = *(const LAS u32x4*)(lds + (addr)), _c1 = *(const LAS u32x4*)(lds + (addr) + 16); dstv = (i32x8){(int)_c0.x, (int)_c0.y, (int)_c0.z, (int)_c0.w, (int)_c1.x, (int)_c1.y, (int)_c1.z, (int)_c1.w}; } while (0)
#define PG8_LDA(dst, b, h) do { _Pragma("unroll") for (int m = 0; m < 4; ++m) { const u32x4 _c0 = *(const LAS u32x4*)(ldsA + PG8_SA(b, h) + m * 2048), _c1 = *(const LAS u32x4*)(ldsA + PG8_SA(b, h) + m * 2048 + 16); \
        dst[m] = (i32x8){(int)_c0.x, (int)_c0.y, (int)_c0.z, (int)_c0.w, (int)_c1.x, (int)_c1.y, (int)_c1.z, (int)_c1.w}; } } while (0)
#define PG8_LDB(dst, b, h) do { _Pragma("unroll") for (int n = 0; n < 2; ++n) { const u32x4 _c0 = *(const LAS u32x4*)(ldsB + ((b) * 2 + (h)) * HTB + n * 2048), _c1 = *(const LAS u32x4*)(ldsB + ((b) * 2 + (h)) * HTB + n * 2048 + 16); \
        dst[n] = (i32x8){(int)_c0.x, (int)_c0.y, (int)_c0.z, (int)_c0.w, (int)_c1.x, (int)_c1.y, (int)_c1.z, (int)_c1.w}; } } while (0)
#define PG8_MMA(ai, bj, At, Bt) do { __builtin_amdgcn_sched_barrier(0); __builtin_amdgcn_s_setprio(1); _Pragma("unroll") for (int m = 0; m < 4; ++m) _Pragma("unroll") for (int n = 0; n < 2; ++n) \
        acc[ai][bj][m][n] = __builtin_amdgcn_mfma_scale_f32_16x16x128_f8f6f4(Bt[n], At[m], acc[ai][bj][m][n], 0, 0, 0, SC_W, 0, sc_act); \
        _Pragma("unroll") for (int m = 0; m < 4; ++m) asm volatile("" :: "v"(acc[ai][bj][m][0]), "v"(acc[ai][bj][m][1]));     \
        __builtin_amdgcn_s_setprio(0); __builtin_amdgcn_sched_barrier(0); } while (0)
#define PG8_WAIT_V(n) asm volatile("s_waitcnt vmcnt(" #n ")" ::: "memory")
#define PG8_WAIT_L(n) asm volatile("s_waitcnt lgkmcnt(" #n ")" ::: "memory")
#define PG8_BAR __builtin_amdgcn_s_barrier()
#define PG8_SCHED __builtin_amdgcn_sched_barrier(0)
#define PG8_AOFFS(u, o0, o1) do { _Pragma("unroll") for (int _i = 0; _i < 2; ++_i) { int _R, _C; stage_rc(tid * 16 + _i * 8192, _R, _C); \
        o0[_i] = S.arow(u, _R) * (unsigned)K + 2u * (unsigned)_C; o1[_i] = S.arow(u, HALF + _R) * (unsigned)K + 2u * (unsigned)_C; } } while (0)
    Unit cur, nxt; int ui = 0;
    if (!S.next(0, cur)) return;
    f32x4 acc[2][2][4][2];
#pragma unroll
    for (int a = 0; a < 2; ++a)
#pragma unroll
        for (int b = 0; b < 2; ++b)
#pragma unroll
            for (int m = 0; m < 4; ++m)
#pragma unroll
                for (int n = 0; n < 2; ++n) acc[a][b][m][n] = (f32x4){0.f, 0.f, 0.f, 0.f};
    i32x8 At[4], B0[2], B1[2];
    unsigned cA0[2], cA1[2];
    PG8_AOFFS(cur, cA0, cA1);
    const __amdgpu_buffer_rsrc_t rA = __builtin_amdgcn_make_buffer_rsrc((void*)g.A, (short)0, (int)g.abytes, 0x00020000);
    const __amdgpu_buffer_rsrc_t rB = __builtin_amdgcn_make_buffer_rsrc((void*)g.Bt, (short)0, (int)g.bbytes, 0x00020000);
    const unsigned kstep = (unsigned)(BK * 2);
    const unsigned hstep = (unsigned)HALF * (unsigned)K;
    unsigned cB = (unsigned)cur.brow0 * (unsigned)K;
    PG8_STAGE(PG8_SB(0, 0), rB, cB, voffB); PG8_STAGE(PG8_SB(0, 1), rB, cB + hstep, voffB); PG8_STAGE(PG8_SA(0, 0), rA, 0u, cA0); PG8_STAGE(PG8_SA(0, 1), rA, 0u, cA1);
    if (wr == 1) PG8_BAR;
    PG8_WAIT_V(2); PG8_BAR;
    PG8_STAGE(PG8_SB(1, 0), rB, cB + kstep, voffB); PG8_STAGE(PG8_SA(1, 0), rA, kstep, cA0); PG8_STAGE(PG8_SB(1, 1), rB, cB + hstep + kstep, voffB);
    PG8_WAIT_V(6); PG8_BAR;
#define PG8_PAIR(a1, a2, b2, SWITCH) do { \
            PG8_LDB(B0, 0, 0); PG8_LDB(B1, 0, 1); PG8_SCHED; PG8_LDA(At, 0, 0); PG8_STAGE(PG8_SA(1, 1), rA, a1, cA1); \
            SWITCH; \
            PG8_WAIT_V(8); PG8_WAIT_L(0); PG8_BAR; PG8_MMA(0, 0, At, B0); PG8_MMA(0, 1, At, B1); PG8_BAR; PG8_SCHED; \
            PG8_LDA(At, 0, 1); PG8_STAGE(PG8_SB(0, 0), rB, b2, voffB); PG8_STAGE(PG8_SB(0, 1), rB, (b2) + hstep, voffB); PG8_STAGE(PG8_SA(0, 0), rA, a2, cA0); \
            PG8_WAIT_V(8); PG8_WAIT_L(0); PG8_BAR; PG8_MMA(1, 0, At, B0); PG8_MMA(1, 1, At, B1); PG8_BAR; PG8_SCHED; \
            PG8_LDB(B0, 1, 0); PG8_LDB(B1, 1, 1); PG8_SCHED; PG8_LDA(At, 1, 0); PG8_STAGE(PG8_SA(0, 1), rA, a2, cA1); \
            PG8_WAIT_V(8); PG8_WAIT_L(0); PG8_BAR; PG8_MMA(0, 0, At, B0); PG8_MMA(0, 1, At, B1); PG8_BAR; PG8_SCHED; \
            PG8_LDA(At, 1, 1); PG8_STAGE(PG8_SB(1, 0), rB, (b2) + kstep, voffB); PG8_STAGE(PG8_SB(1, 1), rB, (b2) + kstep + hstep, voffB); PG8_STAGE(PG8_SA(1, 0), rA, (a2) + kstep, cA0); \
            PG8_WAIT_V(8); PG8_WAIT_L(0); PG8_BAR; PG8_MMA(1, 0, At, B0); PG8_MMA(1, 1, At, B1); PG8_BAR; PG8_SCHED; } while (0)
    for (;;) {
        const bool has_next = S.next(ui + 1, nxt);
        const unsigned nB = has_next ? (unsigned)nxt.brow0 * (unsigned)K : cB;
        unsigned dlt = 0u;
        if constexpr (Sched::CONTIG) { dlt = has_next ? (unsigned)(nxt.arow0 - cur.arow0) * (unsigned)K : 0u; }
        else { unsigned n0[2], n1[2]; if (has_next) { PG8_AOFFS(nxt, n0, n1); } else { n0[0] = cA0[0]; n0[1] = cA0[1]; n1[0] = cA1[0]; n1[1] = cA1[1]; }
          *((LAS u32x4*)(lds + NXT_OFF) + tid) = (u32x4){n0[0], n0[1], n1[0], n1[1]}; }
        for (int t = 0; t < nt - 2; t += 2) {
            const unsigned a1 = (unsigned)(t + 1) * kstep, a2 = (unsigned)(t + 2) * kstep, b2 = cB + (unsigned)(t + 2) * kstep;
            PG8_PAIR(a1, a2, b2, (void)0);
        }
        {
            const unsigned a1 = (unsigned)(nt - 1) * kstep;
            PG8_PAIR(a1, 0u, nB, do { if constexpr (Sched::CONTIG) { cA0[0] += dlt; cA0[1] += dlt; cA1[0] += dlt; cA1[1] += dlt; } else { const u32x4 _n = *((LAS u32x4*)(lds + NXT_OFF) + tid); cA0[0] = _n.x; cA0[1] = _n.y; cA1[0] = _n.z; cA1[1] = _n.w; } } while (0));
        }
        { int l2; asm volatile("v_mbcnt_lo_u32_b32 %0, -1, 0\n\tv_mbcnt_hi_u32_b32 %0, -1, %0" : "=v"(l2));
          E(acc, cur, wr, wc, l2 & 15, l2 >> 4); S.done(cur, l2); }
        if (!has_next) break;
#pragma unroll
        for (int a = 0; a < 2; ++a)
#pragma unroll
            for (int b = 0; b < 2; ++b)
#pragma unroll
                for (int m = 0; m < 4; ++m)
#pragma unroll
                    for (int n = 0; n < 2; ++n) acc[a][b][m][n] = (f32x4){0.f, 0.f, 0.f, 0.f};
        cur = nxt; cB = nB; ++ui;
    }
    PG8_WAIT_V(0);
    if (wr == 0) PG8_BAR;
    PG8_BAR;
#undef PG8_PAIR
#undef PG8_AOFFS
#undef PG8_SA
#undef PG8_SB
#undef PG8_STAGE
#undef PG8_LDA
#undef PG8_LDB
#undef PG8_MMA
#undef PG8_WAIT_V
#undef PG8_WAIT_L
#undef PG8_BAR
#undef PG8_SCHED
}
struct Gemm16 { const bf16_t* A; const bf16_t* Bt; int K; unsigned abytes, bbytes; };
struct EpiGateUp16 {
    static constexpr bool PERM = true;
    bf16_t* HID; const int* list; const float* gatew;
    __device__ __forceinline__ void operator()(const f32x4 (&acc)[2][2][4][2], const Unit& u, int wr, int wc, int fr, int fq) const {
        const int col0 = u.pn * 128 + wc * 32 + 8 * fq;
#pragma unroll
        for (int ai = 0; ai < 2; ++ai)
#pragma unroll
            for (int m = 0; m < 4; ++m) {
                const int r = ai * HALF + wr * 64 + m * 16 + fr; const int idx = u.pm * BM + r;
                float wgt = 0.f; if (idx < u.cnt) wgt = gatew[list[u.e * T + idx]];
                const f32x4 g0 = acc[ai][0][m][0], g1 = acc[ai][0][m][1], u0 = acc[ai][1][m][0], u1 = acc[ai][1][m][1];
                float h[8];
#pragma unroll
                for (int i = 0; i < 4; ++i) { h[i] = siluf_(g0[i]) * u0[i] * wgt; h[4 + i] = siluf_(g1[i]) * u1[i] * wgt; }
                u32x4 w; w.x = cvt_pk_bf16(h[0], h[1]); w.y = cvt_pk_bf16(h[2], h[3]); w.z = cvt_pk_bf16(h[4], h[5]); w.w = cvt_pk_bf16(h[6], h[7]);
                *(u32x4*)(HID + (size_t)(u.arow0 + r) * DEXP + col0) = w;
            }
    }
};
template <class Epi, class Sched>
__device__ __forceinline__ void gemm_phase16(LAS unsigned char* lds, int wave_id, const Gemm16 g, const Sched& S, const Epi& E) {
    int lane; asm volatile("v_mbcnt_lo_u32_b32 %0, -1, 0\n\tv_mbcnt_hi_u32_b32 %0, -1, %0" : "=v"(lane));
    const int wid = wave_id, tid = wid * 64 + lane, wr = wid >> 2, wc = wid & 3, fr = lane & 15, fq = lane >> 4;
    const int K = g.K, nt = K / BK;
    unsigned voffB[2];
#pragma unroll
    for (int i = 0; i < 2; ++i) { int R, C; stage_rc(tid * 16 + i * 8192, R, C); const int Rb = Epi::PERM ? ((R & ~31) + perm32(R & 31)) : R; voffB[i] = (unsigned)(Rb * K + C) * 2u; }
    const unsigned ldsw = (unsigned)wid * 1024u;
    const int aoff = lds_byte(wr * 64 + fr, fq * 8), boff = lds_byte(wc * 32 + fr, fq * 8);
#define PG8_SA(b, h) (((b) * 2 + (h)) * HTB)
#define PG8_SB(b, h) ((4 + (b) * 2 + (h)) * HTB)
#define PG8_STAGE(bufoff, rsrc, soff, voff) do { _Pragma("unroll") for (int _i = 0; _i < 2; ++_i) \
        __builtin_amdgcn_raw_ptr_buffer_load_lds(rsrc, (LAS void*)(lds + (bufoff) + ldsw + _i * 8192), 16, (int)(voff)[_i], (int)(soff), 0, 0); } while (0)
#define PG8_LDA(dst, b, h) do { _Pragma("unroll") for (int m = 0; m < 4; ++m) _Pragma("unroll") for (int k = 0; k < 2; ++k) dst[m][k] = *(const LAS bf16x8*)(lds + PG8_SA(b, h) + aoff + m * 2048 + k * 1024); } while (0)
#define PG8_LDB(dst, b, h) do { _Pragma("unroll") for (int n = 0; n < 2; ++n) _Pragma("unroll") for (int k = 0; k < 2; ++k) dst[n][k] = *(const LAS bf16x8*)(lds + PG8_SB(b, h) + boff + n * 2048 + k * 1024); } while (0)
#define PG8_MMA(ai, bj, At, Bt) do { __builtin_amdgcn_s_setprio(1); _Pragma("unroll") for (int m = 0; m < 4; ++m) _Pragma("unroll") for (int n = 0; n < 2; ++n) _Pragma("unroll") for (int k = 0; k < 2; ++k) \
        acc[ai][bj][m][n] = __builtin_amdgcn_mfma_f32_16x16x32_bf16(Bt[n][k], At[m][k], acc[ai][bj][m][n], 0, 0, 0); __builtin_amdgcn_s_setprio(0); } while (0)
#define PG8_WAIT_V(n) asm volatile("s_waitcnt vmcnt(" #n ")" ::: "memory")
#define PG8_WAIT_L(n) asm volatile("s_waitcnt lgkmcnt(" #n ")" ::: "memory")
#define PG8_BAR __builtin_amdgcn_s_barrier()
#define PG8_SCHED __builtin_amdgcn_sched_barrier(0)
#define PG8_AOFFS(u, o0, o1) do { _Pragma("unroll") for (int _i = 0; _i < 2; ++_i) { int _R, _C; stage_rc(tid * 16 + _i * 8192, _R, _C); \
        o0[_i] = (S.arow(u, _R) * (unsigned)K + (unsigned)_C) * 2u; o1[_i] = (S.arow(u, HALF + _R) * (unsigned)K + (unsigned)_C) * 2u; } } while (0)
    Unit cur, nxt; int ui = 0;
    typename Sched::State st;
    if (!S.first(st, cur, tid)) return;
    f32x4 acc[2][2][4][2];
#pragma unroll
    for (int a = 0; a < 2; ++a)
#pragma unroll
        for (int b = 0; b < 2; ++b)
#pragma unroll
            for (int m = 0; m < 4; ++m)
#pragma unroll
                for (int n = 0; n < 2; ++n) acc[a][b][m][n] = (f32x4){0.f, 0.f, 0.f, 0.f};
    bf16x8 At[4][2], B0[2][2], B1[2][2];
    unsigned cA0[2], cA1[2];
    PG8_AOFFS(cur, cA0, cA1);
    const __amdgpu_buffer_rsrc_t rA = __builtin_amdgcn_make_buffer_rsrc((void*)g.A, (short)0, (int)g.abytes, 0x00020000);
    const __amdgpu_buffer_rsrc_t rB = __builtin_amdgcn_make_buffer_rsrc((void*)g.Bt, (short)0, (int)g.bbytes, 0x00020000);
    const unsigned kstep = (unsigned)(BK * 2);
    const unsigned hstep = (unsigned)HALF * (unsigned)K * 2u;
    unsigned cB = (unsigned)cur.brow0 * (unsigned)K * 2u;
    PG8_STAGE(PG8_SB(0, 0), rB, cB, voffB); PG8_STAGE(PG8_SB(0, 1), rB, cB + hstep, voffB); PG8_STAGE(PG8_SA(0, 0), rA, 0u, cA0); PG8_STAGE(PG8_SA(0, 1), rA, 0u, cA1);
    if (wr == 1) PG8_BAR;
    PG8_WAIT_V(2); PG8_BAR;
    PG8_STAGE(PG8_SB(1, 0), rB, cB + kstep, voffB); PG8_STAGE(PG8_SA(1, 0), rA, kstep, cA0); PG8_STAGE(PG8_SB(1, 1), rB, cB + hstep + kstep, voffB);
    PG8_WAIT_V(6); PG8_BAR;
#define PG8_PAIR(a1, a2, b2, SWITCH) do { \
            PG8_LDB(B0, 0, 0); PG8_LDB(B1, 0, 1); PG8_SCHED; PG8_LDA(At, 0, 0); PG8_STAGE(PG8_SA(1, 1), rA, a1, cA1); \
            SWITCH; \
            PG8_WAIT_V(8); PG8_WAIT_L(0); PG8_BAR; PG8_MMA(0, 0, At, B0); PG8_MMA(0, 1, At, B1); PG8_BAR; PG8_SCHED; \
            PG8_LDA(At, 0, 1); PG8_STAGE(PG8_SB(0, 0), rB, b2, voffB); PG8_STAGE(PG8_SB(0, 1), rB, (b2) + hstep, voffB); PG8_STAGE(PG8_SA(0, 0), rA, a2, cA0); \
            PG8_WAIT_V(8); PG8_WAIT_L(0); PG8_BAR; PG8_MMA(1, 0, At, B0); PG8_MMA(1, 1, At, B1); PG8_BAR; PG8_SCHED; \
            PG8_LDB(B0, 1, 0); PG8_LDB(B1, 1, 1); PG8_SCHED; PG8_LDA(At, 1, 0); PG8_STAGE(PG8_SA(0, 1), rA, a2, cA1); \
            PG8_WAIT_V(8); PG8_WAIT_L(0); PG8_BAR; PG8_MMA(0, 0, At, B0); PG8_MMA(0, 1, At, B1); PG8_BAR; PG8_SCHED; \
            PG8_LDA(At, 1, 1); PG8_STAGE(PG8_SB(1, 0), rB, (b2) + kstep, voffB); PG8_STAGE(PG8_SB(1, 1), rB, (b2) + kstep + hstep, voffB); PG8_STAGE(PG8_SA(1, 0), rA, (a2) + kstep, cA0); \
            PG8_WAIT_V(8); PG8_WAIT_L(0); PG8_BAR; PG8_MMA(1, 0, At, B0); PG8_MMA(1, 1, At, B1); PG8_BAR; PG8_SCHED; } while (0)
    for (;;) {
        S.issue(st, ui + 1, tid);
        for (int t = 0; t < nt - 2; t += 2) {
            const unsigned a1 = (unsigned)(t + 1) * kstep, a2 = (unsigned)(t + 2) * kstep, b2 = cB + (unsigned)(t + 2) * kstep;
            PG8_PAIR(a1, a2, b2, (void)0);
        }
        const bool has_next = S.fin(st, ui + 1, nxt, tid);
        const unsigned nB = has_next ? (unsigned)nxt.brow0 * (unsigned)K * 2u : cB;
        {
            const unsigned a1 = (unsigned)(nt - 1) * kstep;
            PG8_PAIR(a1, 0u, nB, do { if (has_next) { PG8_AOFFS(nxt, cA0, cA1); } } while (0));
        }
        if (wr == 0) PG8_BAR;
        { int l2; asm volatile("v_mbcnt_lo_u32_b32 %0, -1, 0\n\tv_mbcnt_hi_u32_b32 %0, -1, %0" : "=v"(l2));
          E(acc, cur, wr, wc, l2 & 15, l2 >> 4); S.done(cur, l2); }
        if (!has_next) break;
#pragma unroll
        for (int a = 0; a < 2; ++a)
#pragma unroll
            for (int b = 0; b < 2; ++b)
#pragma unroll
                for (int m = 0; m < 4; ++m)
#pragma unroll
                    for (int n = 0; n < 2; ++n) acc[a][b][m][n] = (f32x4){0.f, 0.f, 0.f, 0.f};
        cur = nxt; cB = nB; ++ui;
        if (wr == 1) PG8_BAR;
    }
    PG8_WAIT_V(0);
    PG8_BAR;
#undef PG8_PAIR
#undef PG8_AOFFS
#undef PG8_SA
#undef PG8_SB
#undef PG8_STAGE
#undef PG8_LDA
#undef PG8_LDB
#undef PG8_MMA
#undef PG8_WAIT_V
#undef PG8_WAIT_L
#undef PG8_BAR
#undef PG8_SCHED
}
}

#define XB_TMO      128
#define XB_XCNT(j)  (256  + 64 * (j))
#define XB_XSUB(j)  (1280 + 64 * (j))
#define XB_XGEN(j)  (2304 + 64 * (j))
#define XB_TOP      3328
#define XB_TOPGEN   3392
#define XCD_BAR_WORDS 3456
#define XB_SPIN_CAP (1u << 20)
__device__ __forceinline__ unsigned xb_ld(unsigned* p)              { return __hip_atomic_load(p, __ATOMIC_RELAXED, __HIP_MEMORY_SCOPE_AGENT); }
__device__ __forceinline__ unsigned xb_add(unsigned* p, unsigned v) { return __hip_atomic_fetch_add(p, v, __ATOMIC_RELAXED, __HIP_MEMORY_SCOPE_AGENT); }
__device__ __forceinline__ unsigned xb_xcc_id() { return (unsigned)__builtin_amdgcn_s_getreg((3 << 11) | 20) & 0xFu; }
#define XB_SPIN(cond, bar) do { unsigned _sp = 0; while (cond) { __builtin_amdgcn_s_sleep(1); \
    if ((++_sp & 255u) == 0u) { if (xb_ld(&(bar)[XB_TMO])) break; if (_sp > XB_SPIN_CAP) { atomicAdd(&(bar)[XB_TMO], 1u); break; } } } } while (0)
__device__ __forceinline__ void xcd_barrier_complete(unsigned* bar, unsigned x, unsigned& nloc, unsigned& nx) {
    const unsigned G = gridDim.x;
    unsigned sum, cnt, mine, sp = 0u;
    for (;;) {
        sum = 0u; cnt = 0u; mine = 0u;
#pragma unroll
        for (unsigned j = 0; j < 16; ++j) { const unsigned c = xb_ld(&bar[XB_XCNT(j)]); sum += c; cnt += (c > 0u) ? 1u : 0u; mine = (j == x) ? c : mine; }
        if (sum == G) break;
        __builtin_amdgcn_s_sleep(1);
        if ((++sp & 255u) == 0u) { if (xb_ld(&bar[XB_TMO])) break; if (sp > XB_SPIN_CAP) { atomicAdd(&bar[XB_TMO], 1u); break; } }
    }
    nloc = mine > 0u ? mine : 1u; nx = cnt > 0u ? cnt : 1u;
}
__device__ __forceinline__ void xcd_barrier(unsigned* bar, volatile LAS unsigned* st, int wave) {
    asm volatile("s_waitcnt vmcnt(0) lgkmcnt(0)" ::: "memory");
    __syncthreads();
    int lane; asm volatile("v_mbcnt_lo_u32_b32 %0, -1, 0\n\tv_mbcnt_hi_u32_b32 %0, -1, %0" : "=v"(lane));
    if (wave == 0 && lane == 0) {
        __builtin_amdgcn_s_waitcnt(0);
        const unsigned x = xb_xcc_id();
        unsigned nloc = st[0], nx = st[1];
        if (nloc == 0u) { xcd_barrier_complete(bar, x, nloc, nx); st[0] = nloc; st[1] = nx; }
        const unsigned old = xb_add(&bar[XB_XSUB(x)], 1u);
        const unsigned gen = old / nloc;
        if (old + 1u == (gen + 1u) * nloc) {
            __builtin_amdgcn_fence(__ATOMIC_RELEASE, "agent");
            asm volatile("s_waitcnt vmcnt(0)" ::: "memory");
            const unsigned og = xb_add(&bar[XB_TOP], 1u);
            const unsigned tg = og / nx;
            if (og + 1u == (tg + 1u) * nx) xb_add(&bar[XB_TOPGEN], 1u);
            else XB_SPIN(xb_ld(&bar[XB_TOPGEN]) == tg, bar);
            __builtin_amdgcn_fence(__ATOMIC_ACQUIRE, "agent");
            xb_add(&bar[XB_XGEN(x)], 1u);
            asm volatile("s_waitcnt vmcnt(0)" ::: "memory");
        } else {
            XB_SPIN(xb_ld(&bar[XB_XGEN(x)]) == gen, bar);
            __builtin_amdgcn_fence(__ATOMIC_ACQUIRE, "agent");
            asm volatile("s_waitcnt vmcnt(0)" ::: "memory");
        }
    }
    __syncthreads();
}

struct Params {
    const float* in[18];
    float* out; unsigned char* ws;
};
enum { I_X = 0, I_EV_WIN, I_EV_CONV, I_EV_ALOG, I_EV_DTB, I_EV_GDNN, I_EV_HGRNN, I_LBLOG, I_EV_WOUT, I_OD_WIN, I_OD_WOUT, I_RW, I_RB, I_MG, I_MU, I_MD, I_LNG, I_LNB };

struct Frame {
    LAS unsigned char* lds;
    int tid, lane, wave, G, bid;
};
__device__ __forceinline__ Frame refresh(const Frame& F0) {
    Frame F = F0; int l; asm volatile("v_mbcnt_lo_u32_b32 %0, -1, 0\n\tv_mbcnt_hi_u32_b32 %0, -1, %0" : "=v"(l));
    F.lane = l; F.tid = F0.wave * 64 + l; return F;
}

constexpr size_t WS_W3 = WS_AB + 16 * MiB, WS_WOUT1 = WS_WOUT + 4 * MiB, WS_WGU1 = WS_WGU + 32 * MiB;
struct CDesc { const float* src; unsigned char* dst; int ld, Kd, fp8; };
__device__ __forceinline__ CDesc conv_desc(const Params& p, unsigned char* ws, int kind, int r) {
    CDesc d;
    switch (kind) {
    case 0: { const int kb = r / 256, nb = r % 256, n0 = nb * 32; const int c0 = n0 < 4096 ? n0 : n0 + 16;
        d.src = p.in[I_EV_WIN] + (size_t)(kb * 64) * EVEN_IN + c0; d.ld = EVEN_IN; d.dst = ws + WS_WIN + (size_t)n0 * 2048 + kb * 64; d.Kd = 2048; d.fp8 = 1; break; }
    case 1: { const int kb = r / 64, nb = r % 64; d.src = p.in[I_EV_WOUT] + (size_t)(kb * 64) * 2048 + nb * 32; d.ld = 2048; d.dst = ws + WS_WOUT + (size_t)(nb * 32) * 2048 + kb * 64; d.Kd = 2048; d.fp8 = 1; break; }
    case 2: case 6: { const int layer = kind == 6; const int isup = r >= 8192; if (isup) r -= 8192;
        const int e = r / 512, q = r % 512, kb = q / 16, nb = q % 16, f0 = nb * 32;
        d.src = (isup ? p.in[I_MU] : p.in[I_MG]) + (size_t)(layer * NE + e) * 2048 * 512 + (size_t)(kb * 64) * 512 + f0; d.ld = 512;
        d.dst = ws + (layer ? WS_WGU1 : WS_WGU) + (size_t)e * 1024 * 2048 + (size_t)(256 * (f0 >> 7) + 128 * isup + (f0 & 127)) * 2048 + kb * 64; d.Kd = 2048; d.fp8 = 1; break; }
    case 3: case 7: { const int layer = kind == 7; const int e = r / 512, q = r % 512, kb = q / 64, nb = q % 64;
        d.src = p.in[I_MD] + (size_t)(layer * NE + e) * 512 * 2048 + (size_t)(kb * 64) * 2048 + nb * 32; d.ld = 2048;
        d.dst = ws + WS_WD + ((size_t)e * 2048 * 512 + (size_t)(nb * 32) * 512 + kb * 64) * 2; d.Kd = 512; d.fp8 = 0; break; }
    case 4: { const int kb = r / 192, nb = r % 192; d.src = p.in[I_OD_WIN] + (size_t)(kb * 64) * ODD_IN + nb * 32; d.ld = ODD_IN; d.dst = ws + WS_W3 + (size_t)(nb * 32) * 2048 + kb * 64; d.Kd = 2048; d.fp8 = 1; break; }
    default: { const int kb = r / 64, nb = r % 64; d.src = p.in[I_OD_WOUT] + (size_t)(kb * 64) * 2048 + nb * 32; d.ld = 2048; d.dst = ws + WS_WOUT1 + (size_t)(nb * 32) * 1024 + kb * 64; d.Kd = 1024; d.fp8 = 1; break; }
    }
    return d;
}
__device__ __forceinline__ void conv_load(const CDesc& d, int lane, float (&wv)[32]) {
    const float* wp = d.src + (size_t)(lane >> 5) * d.ld + (lane & 31);
#pragma unroll
    for (int i = 0; i < 32; ++i) wv[i] = __builtin_nontemporal_load(wp + (size_t)(2 * i) * d.ld);
}
__device__ __forceinline__ void conv_store(const CDesc& d, int lane, const float (&wv)[32], LAS float* scr) {
#pragma unroll
    for (int i = 0; i < 32; ++i) scr[(2 * i + (lane >> 5)) * 33 + (lane & 31)] = wv[i];
    LDS_WAIT(); asm volatile("" ::: "memory");
    if (d.fp8) {
        const int c = lane & 3;
#pragma unroll
        for (int j = 0; j < 2; ++j) { const int n = (lane >> 2) + 16 * j; const LAS float* sp = scr + (16 * c) * 33 + n;
            u32x4 o;
            o.x = pk4_fp8(sp[0 * 33] * W_PRE, sp[1 * 33] * W_PRE, sp[2 * 33] * W_PRE, sp[3 * 33] * W_PRE);     o.y = pk4_fp8(sp[4 * 33] * W_PRE, sp[5 * 33] * W_PRE, sp[6 * 33] * W_PRE, sp[7 * 33] * W_PRE);
            o.z = pk4_fp8(sp[8 * 33] * W_PRE, sp[9 * 33] * W_PRE, sp[10 * 33] * W_PRE, sp[11 * 33] * W_PRE);   o.w = pk4_fp8(sp[12 * 33] * W_PRE, sp[13 * 33] * W_PRE, sp[14 * 33] * W_PRE, sp[15 * 33] * W_PRE);
            *(u32x4*)(d.dst + (size_t)n * d.Kd + 16 * c) = o; }
    } else {
        const int c = lane & 7;
#pragma unroll
        for (int j = 0; j < 4; ++j) { const int n = (lane >> 3) + 8 * j; const LAS float* sp = scr + (8 * c) * 33 + n;
            u32x4 o; o.x = pk2(sp[0 * 33], sp[1 * 33]); o.y = pk2(sp[2 * 33], sp[3 * 33]); o.z = pk2(sp[4 * 33], sp[5 * 33]); o.w = pk2(sp[6 * 33], sp[7 * 33]);
            *(u32x4*)(d.dst + ((size_t)n * d.Kd + 8 * c) * 2) = o; }
    }
    LDS_WAIT(); asm volatile("" ::: "memory");
}
__device__ __forceinline__ CDesc conv_item(const Params& p, unsigned char* ws, int set, int it) {
    if (set == 0) return it < 8192 ? conv_desc(p, ws, 0, it) : conv_desc(p, ws, 1, it - 8192);
    if (set == 1) { int r = it;
        if (r < 16384) return conv_desc(p, ws, 2, r); r -= 16384;
        if (r < 8192) return conv_desc(p, ws, 3, r); r -= 8192;
        if (r < 6144) return conv_desc(p, ws, 4, r); r -= 6144;
        if (r < 1024) return conv_desc(p, ws, 5, r); r -= 1024;
        return conv_desc(p, ws, 6, r); }
    return conv_desc(p, ws, 7, it);
}
__device__ __forceinline__ void convert_set(const Params& p, const Frame& F0, int set, int w, int nw) {
    const Frame F = refresh(F0);
    LAS float* scr = (LAS float*)(F.lds + F.wave * 16384);
    unsigned char* ws = opq(p.ws);
    const int N = set == 0 ? 8192 + 2048 : set == 1 ? 16384 + 8192 + 6144 + 1024 + 16384 : 8192;
    for (int it = w; it < N; it += 2 * nw) {
        const bool two = it + nw < N;
        const CDesc d0 = conv_item(p, ws, set, it), d1 = conv_item(p, ws, set, two ? it + nw : it);
        float v0[32], v1[32];
        conv_load(d0, F.lane, v0); if (two) conv_load(d1, F.lane, v1);
        conv_store(d0, F.lane, v0, scr); if (two) conv_store(d1, F.lane, v1, scr);
    }
}

__device__ __forceinline__ void load_w16_lds(const Frame& F0, const float* W, int ld, int c0) {
    const Frame F = refresh(F0);
    LAS float* l = (LAS float*)F.lds;
    for (int i = F.tid; i < 2048 * 16; i += NTHR) { const int k = i >> 4, e = i & 15; l[e * 2048 + k] = W[(size_t)k * ld + c0 + e]; }
}
__device__ __forceinline__ float dot16(const Frame& F, const f32x4 (&v)[8]) {
    const LAS f32x4* l = (const LAS f32x4*)F.lds;
    float res = 0.f;
#pragma unroll 1
    for (int e = 0; e < 16; ++e) { float s = 0.f;
#pragma unroll
        for (int j = 0; j < 8; ++j) { const f32x4 w = l[e * 512 + 64 * j + F.lane]; s += (v[j].x * w.x + v[j].y * w.y) + (v[j].z * w.z + v[j].w * w.w); }
        s = wave_sum(s); res = (F.lane == e) ? s : res; }
    return res;
}

__device__ __forceinline__ void p0_xpass(const Params& p, const Frame& F0) {
    const Frame F = refresh(F0);
    const int gw = F.bid * NWAVES + F.wave, NGW = F.G * NWAVES;
    float* BA = (float*)(opq(p.ws) + WS_BA); bf16_t* AB = (bf16_t*)(opq(p.ws) + WS_AB);
    for (int m = gw; m < T; m += NGW) {
        const f32x4* xr = (const f32x4*)(p.in[I_X] + (size_t)m * D) + F.lane;
        f32x4 v[8];
#pragma unroll
        for (int j = 0; j < 8; ++j) v[j] = xr[64 * j];
        unsigned* o = (unsigned*)((unsigned char*)AB + (size_t)m * D) + F.lane;
#pragma unroll
        for (int j = 0; j < 8; ++j) o[64 * j] = pk4_fp8(v[j].x * X_PRE, v[j].y * X_PRE, v[j].z * X_PRE, v[j].w * X_PRE);
        const float a = dot16(F, v);
        if (F.lane < 16) BA[(size_t)m * 16 + F.lane] = a;
    }
}

constexpr size_t WS_R16A = WS_OC + 16 * MiB, WS_R16B = WS_SCR + 190 * MiB;
__device__ __forceinline__ bf16_t* r16_row(unsigned char* ws, int m) { return (bf16_t*)(ws + (m < T / 2 ? WS_R16A + (size_t)m * D * 2 : WS_R16B + (size_t)(m - T / 2) * D * 2)); }
template <bool ROUTE, bool TWO, bool RES16, bool OUT16>
__device__ __forceinline__ void ln_pass(const Params& p, const Frame& F0, const float* resid, const bf16_t* add1, int ld1, const bf16_t* add2, const float* gain, const float* bias,
                                        float* outf, bf16_t* outb, int layer) {
    const Frame F = refresh(F0);
    const int TPB = (T + F.G - 1) / F.G;
    const int mbeg = ROUTE ? F.bid * TPB + F.wave : F.bid * NWAVES + F.wave, mend = ROUTE ? min(T, (F.bid + 1) * TPB) : T, mstep = ROUTE ? NWAVES : F.G * NWAVES;
    int* SEL = (int*)(opq(p.ws) + WS_CTL + 65536);
    int* HIST = (int*)(opq(p.ws) + WS_CTL + 32768);
    LAS int* lhist = (LAS int*)(F.lds + pg8::MOE_HIST_OFF);
    float* gatew = (float*)(opq(p.ws) + WS_GATEW) + (size_t)layer * 2 * T;
    if (ROUTE) { if (F.tid < NE) lhist[F.tid] = 0; __syncthreads(); }
    f32x4 gn[8], bs[8];
#pragma unroll
    for (int j = 0; j < 8; ++j) { gn[j] = ((const f32x4*)gain)[64 * j + F.lane]; bs[j] = ((const f32x4*)bias)[64 * j + F.lane]; }
    for (int m = mbeg; m < mend; m += mstep) {
        const f32x4* xr = (const f32x4*)(resid + (size_t)m * D) + F.lane;
        const u32x2* xr16 = (const u32x2*)r16_row(opq(p.ws), m) + F.lane;
        f32x4 v[8]; float s = 0.f;
#pragma unroll
        for (int j = 0; j < 8; ++j) {
            if (RES16) { const u32x2 a = xr16[64 * j]; v[j] = (f32x4){bflo(a.x), bfhi(a.x), bflo(a.y), bfhi(a.y)} * ALPHA; }
            else v[j] = xr[64 * j] * ALPHA;
            if (add1) { const u32x2 a = ((const u32x2*)(add1 + (size_t)(TWO ? 2 * m : m) * ld1))[64 * j + F.lane]; v[j].x += bflo(a.x); v[j].y += bfhi(a.x); v[j].z += bflo(a.y); v[j].w += bfhi(a.y); }
            if (TWO) { const u32x2 a = ((const u32x2*)(add2 + (size_t)(2 * m + 1) * ld1))[64 * j + F.lane]; v[j].x += bflo(a.x); v[j].y += bfhi(a.x); v[j].z += bflo(a.y); v[j].w += bfhi(a.y); }
#ifdef DBG_SANITIZE
            if (!(fabsf(v[j].x) < 1e30f)) v[j].x = 0.f; if (!(fabsf(v[j].y) < 1e30f)) v[j].y = 0.f; if (!(fabsf(v[j].z) < 1e30f)) v[j].z = 0.f; if (!(fabsf(v[j].w) < 1e30f)) v[j].w = 0.f;
#endif
            s += (v[j].x + v[j].y) + (v[j].z + v[j].w);
        }
        const float mean = wave_sum(s) * (1.f / D); float s2 = 0.f;
#pragma unroll
        for (int j = 0; j < 8; ++j) { v[j] = v[j] - mean; s2 += (v[j].x * v[j].x + v[j].y * v[j].y) + (v[j].z * v[j].z + v[j].w * v[j].w); }
        const float rstd = 1.f / sqrtf(wave_sum(s2) * (1.f / D) + LN_EPS);
#pragma unroll
        for (int j = 0; j < 8; ++j) v[j] = v[j] * rstd * gn[j] + bs[j];
        if (OUT16) { u32x2* of = (u32x2*)r16_row(opq(p.ws), m) + F.lane;
#pragma unroll
            for (int j = 0; j < 8; ++j) { u32x2 w; w.x = pk2(v[j].x, v[j].y); w.y = pk2(v[j].z, v[j].w); of[64 * j] = w; } }
        else { f32x4* of = (f32x4*)(outf + (size_t)m * D) + F.lane;
#pragma unroll
            for (int j = 0; j < 8; ++j) of[64 * j] = v[j]; }
        if (outb) {
            { unsigned* o = (unsigned*)((unsigned char*)outb + (size_t)m * D) + F.lane;
#pragma unroll
                for (int j = 0; j < 8; ++j) o[64 * j] = pk4_fp8(v[j].x, v[j].y, v[j].z, v[j].w); } }
        if (ROUTE) {
            const float lgl = dot16(F, v);
            const float scl = 1.0f / (1.0f + expf(-lgl)), bil = scl + p.in[I_RB][F.lane & 15];
            float sc[16], bi[16];
#pragma unroll
            for (int e = 0; e < 16; ++e) { sc[e] = __builtin_bit_cast(float, __builtin_amdgcn_readlane(__builtin_bit_cast(int, scl), e)); bi[e] = __builtin_bit_cast(float, __builtin_amdgcn_readlane(__builtin_bit_cast(int, bil), e)); }
            int bg = 0; float bgs = -3.0e38f;
#pragma unroll
            for (int g = 0; g < 4; ++g) { float m1 = -3.0e38f, m2 = -3.0e38f;
#pragma unroll
                for (int k = 0; k < 4; ++k) { const float x = bi[4 * g + k]; if (x > m1) { m2 = m1; m1 = x; } else if (x > m2) m2 = x; }
                const float gs = m1 + m2; if (gs > bgs) { bgs = gs; bg = g; } }
            int i1 = 0, i2 = 0; float b1 = -3.0e38f, b2 = -3.0e38f, s1 = 0.f, s2v = 0.f;
#pragma unroll
            for (int e = 0; e < 16; ++e) { if ((e >> 2) == bg) { const float x = bi[e]; if (x > b1) { b2 = b1; i2 = i1; s2v = s1; b1 = x; i1 = e; s1 = sc[e]; } else if (x > b2) { b2 = x; i2 = e; s2v = sc[e]; } } }
            if (F.lane == 0) {
                const float den = s1 + s2v;
                SEL[m] = i1 | (i2 << 8); gatew[2 * m] = s1 / den; gatew[2 * m + 1] = s2v / den;
                __hip_atomic_fetch_add(lhist + i1, 1, __ATOMIC_RELAXED, __HIP_MEMORY_SCOPE_WORKGROUP); __hip_atomic_fetch_add(lhist + i2, 1, __ATOMIC_RELAXED, __HIP_MEMORY_SCOPE_WORKGROUP);
            }
        }
    }
    if (ROUTE) { __syncthreads(); if (F.tid < NE) HIST[F.bid * NE + F.tid] = lhist[F.tid]; }
}

__device__ __forceinline__ void moe_lists(const Params& p, const Frame& F0, int layer) {
    const Frame F = refresh(F0);
    const int* SEL = (const int*)(opq(p.ws) + WS_CTL + 65536);
    const int* HIST = (const int*)(opq(p.ws) + WS_CTL + 32768);
    int* list = (int*)(opq(p.ws) + WS_LIST) + (size_t)layer * NE * T;
    LAS int* ltot = (LAS int*)(F.lds + pg8::MOE_HIST_OFF) + 16;
    LAS int* lbase = (LAS int*)(F.lds + pg8::MOE_HIST_OFF) + 32;
    if (F.tid < NE) { int base = 0, tot = 0;
        for (int b = 0; b < F.G; ++b) { const int h = HIST[b * NE + F.tid]; if (b < F.bid) base += h; tot += h; }
        ltot[F.tid] = tot; lbase[F.tid] = base; }
    __syncthreads();
    LAS int* ltpre = (LAS int*)(F.lds + pg8::MOE_HIST_OFF) + 48;
    LAS int* lslot = (LAS int*)(F.lds + pg8::MOE_HIST_OFF) + 64;
    if (F.tid == 0) { int sacc = 0;
#pragma unroll 1
        for (int e = 0; e < NE; ++e) { ltpre[e] = sacc; sacc += (ltot[e] + 255) >> 8; } }
    __syncthreads();
    const int TPB = (T + F.G - 1) / F.G, m0 = F.bid * TPB, m1 = min(T, m0 + TPB);
    if (F.wave == 0) {
        for (int q0 = 2 * m0; q0 < 2 * m1; q0 += 64) {
            const int q = q0 + F.lane; const bool ok = q < 2 * m1;
            int e = -1; if (ok) { const int sv = SEL[q >> 1]; e = (q & 1) ? ((sv >> 8) & 255) : (sv & 255); }
            int rank = 0, cntsame = 0;
#pragma unroll 1
            for (int k = 0; k < NE; ++k) { const unsigned long long bal = __ballot(e == k); if (e == k) { rank = __popcll(bal & ((1ull << F.lane) - 1ull)); cntsame = __popcll(bal); } }
            if (ok) { const int pos = lbase[e] + rank; list[e * T + pos] = q; lslot[q - 2 * m0] = 256 * ltpre[e] + pos; }
            __builtin_amdgcn_s_waitcnt(0);
            if (ok && rank == cntsame - 1) lbase[e] += cntsame;
            __builtin_amdgcn_s_waitcnt(0);
        }
    }
    __syncthreads();
    {
        const unsigned char* AB8 = opq(p.ws) + WS_AB; unsigned char* ABS = opq(p.ws) + WS_ABS;
        const int nt_ = m1 - m0;
        for (int t0 = F.wave; t0 < nt_; t0 += 4 * NWAVES) {
            u32x4 r0[4], r1[4];
#pragma unroll
            for (int k = 0; k < 4; ++k) { const int tt = t0 + k * NWAVES; if (tt < nt_) { const u32x4* src = (const u32x4*)(AB8 + (size_t)(m0 + tt) * D) + F.lane; r0[k] = src[0]; r1[k] = src[64]; } }
#pragma unroll
            for (int k = 0; k < 4; ++k) { const int tt = t0 + k * NWAVES; if (tt < nt_) {
#pragma unroll
                for (int jj = 0; jj < 2; ++jj) { u32x4* dst = (u32x4*)(ABS + (size_t)lslot[2 * tt + jj] * D) + F.lane; dst[0] = r0[k]; dst[64] = r1[k]; } } }
        }
    }
}

constexpr int H1LD = 8192, C_ZA = 3072, C_QB = 4096, C_FB = 5120, C_IB = 6144, C_GB = 7168;
constexpr size_t G_U0 = 0;
constexpr size_t G_WM = 32 * MiB;
constexpr size_t G_QD = 48 * MiB;
constexpr size_t G_KDT = 64 * MiB;
constexpr size_t G_QK = 80 * MiB;
constexpr size_t G_CD = 88 * MiB;
constexpr size_t H_QD = 89 * MiB;
constexpr size_t H_KI = 105 * MiB;
constexpr size_t H_KDT = 121 * MiB;
constexpr size_t H_IT = 137 * MiB;
constexpr size_t H_CD = 153 * MiB;
constexpr size_t O_A = 155 * MiB;
constexpr size_t O_B = 171 * MiB;
static_assert(O_B + 16 * MiB <= 216 * MiB, "mixer-0 scratch");

__device__ __forceinline__ f32x4 mfma32(bf16x8 a, bf16x8 b, f32x4 c) { return __builtin_amdgcn_mfma_f32_16x16x32_bf16(a, b, c, 0, 0, 0); }
__device__ __forceinline__ f32x4 mfma16(bf16x4 a, bf16x4 b, f32x4 c) { const bf16x8 a8 = {a[0], a[1], a[2], a[3], 0, 0, 0, 0}, b8 = {b[0], b[1], b[2], b[3], 0, 0, 0, 0}; return __builtin_amdgcn_mfma_f32_16x16x32_bf16(a8, b8, c, 0, 0, 0); }
__device__ __forceinline__ bf16x8 pack8(f32x4 lo, f32x4 hi) {
    u32x4 w; w.x = cvt_pk_bf16(lo[0], lo[1]); w.y = cvt_pk_bf16(lo[2], lo[3]); w.z = cvt_pk_bf16(hi[0], hi[1]); w.w = cvt_pk_bf16(hi[2], hi[3]); return __builtin_bit_cast(bf16x8, w);
}
__device__ __forceinline__ bf16x4 pack4(f32x4 v) { u32x2 w; w.x = cvt_pk_bf16(v[0], v[1]); w.y = cvt_pk_bf16(v[2], v[3]); return __builtin_bit_cast(bf16x4, w); }
__device__ __forceinline__ bf16x8 frag_perm(const LAS bf16_t* rowp, int col) {
    const u32x2 lo = *(const LAS u32x2*)(rowp + col), hi = *(const LAS u32x2*)(rowp + col + 16);
    u32x4 w; w.x = lo.x; w.y = lo.y; w.z = hi.x; w.w = hi.y; return __builtin_bit_cast(bf16x8, w);
}

__device__ __forceinline__ void gdn_pre_pair(const Params& p, const Frame& F, int unit0, int unit1) {
    const int hb = F.wave >> 2, w4 = F.wave & 3, t8 = F.tid & 255, lane = F.lane, fr = lane & 15, g = lane >> 4;
    const int unit = hb ? unit1 : unit0;
    const bool active = unit < 1024;
    const int bh = unit >> 5, ci = unit & 31, b = bh >> 3, h = bh & 7;
    const int tok0 = b * SEQ + ci * 64;
    LAS unsigned char* hl = F.lds + hb * 72192;
    LAS bf16_t* Qb = (LAS bf16_t*)(hl);
    LAS bf16_t* Kb = (LAS bf16_t*)(hl + 17408);
    LAS bf16_t* RVt = (LAS bf16_t*)(hl + 34816);
    LAS bf16_t* RKt = (LAS bf16_t*)(hl + 53248);
    LAS float* sc_g = (LAS float*)(hl + 71680);
    LAS float* sc_b = sc_g + 64;
    LAS float* Lm = (LAS float*)(hl);
    LAS bf16_t* Tb = (LAS bf16_t*)(hl + 17408);
    const bf16_t* H1 = (const bf16_t*)(opq(p.ws) + WS_H1);
    const float* BA = (const float*)(opq(p.ws) + WS_BA);
    unsigned char* scr = opq(p.ws) + WS_SCR;
    if (active) {
        if (t8 < 192) {
            const int sec = t8 >> 6, c2 = (t8 & 63) * 2;
            const int col = sec * 1024 + h * 128 + c2;
            const float* cw = p.in[I_EV_CONV] + col;
            const float w0a = cw[0], w0b = cw[1], w1a = cw[3072], w1b = cw[3073], w2a = cw[6144], w2b = cw[6145], w3a = cw[9216], w3b = cw[9217];
            float xa[3], xb[3];
#pragma unroll
            for (int k = 0; k < 3; ++k) { const int s = ci * 64 - 3 + k; unsigned v = 0u; if (s >= 0) v = *(const unsigned*)(H1 + (size_t)(b * SEQ + s) * H1LD + col); xa[k] = bflo(v); xb[k] = bfhi(v); }
#pragma unroll 1
            for (int q2 = 0; q2 < 2; ++q2) {
                unsigned vv[32];
#pragma unroll
                for (int tl = 0; tl < 32; ++tl) vv[tl] = *(const unsigned*)(H1 + (size_t)(tok0 + 32 * q2 + tl) * H1LD + col);
#pragma unroll
                for (int t2 = 0; t2 < 32; ++t2) {
                    const int tl = 32 * q2 + t2;
                    const float x3a = bflo(vv[t2]), x3b = bfhi(vv[t2]);
                    float ya = w0a * xa[0] + w1a * xa[1] + w2a * xa[2] + w3a * x3a, yb = w0b * xb[0] + w1b * xb[1] + w2b * xb[2] + w3b * x3b;
                    xa[0] = xa[1]; xa[1] = xa[2]; xa[2] = x3a; xb[0] = xb[1]; xb[1] = xb[2]; xb[2] = x3b;
                    ya = siluf_(ya); yb = siluf_(yb);
                    if (sec == 0) *(LAS unsigned*)(Qb + tl * 136 + c2) = pk2(ya, yb);
                    else if (sec == 1) *(LAS unsigned*)(Kb + tl * 136 + c2) = pk2(ya, yb);
                    else { const float be = sigmoidf_(BA[(size_t)(tok0 + tl) * 16 + h]); RVt[c2 * 72 + tl] = (bf16_t)f2bf(ya * be); RVt[(c2 + 1) * 72 + tl] = (bf16_t)f2bf(yb * be); }
                }
            }
        } else {
            const int t = tok0 + lane;
            const float ba = BA[(size_t)t * 16 + h], aa = BA[(size_t)t * 16 + 8 + h];
            const float xx = aa + p.in[I_EV_DTB][h];
            const float sp = xx > 20.f ? xx : log1pf(expf(xx));
            float gg = -expf(p.in[I_EV_ALOG][h]) * sp;
            gg += dpp_f<0x111>(gg); gg += dpp_f<0x112>(gg); gg += dpp_f<0x114>(gg); gg += dpp_f<0x118>(gg);
            { const float t0 = __builtin_bit_cast(float, __builtin_amdgcn_readlane(__builtin_bit_cast(int, gg), 15)), t1 = __builtin_bit_cast(float, __builtin_amdgcn_readlane(__builtin_bit_cast(int, gg), 31)),
                          t2 = __builtin_bit_cast(float, __builtin_amdgcn_readlane(__builtin_bit_cast(int, gg), 47));
              gg += (lane >= 16 ? t0 : 0.f) + (lane >= 32 ? t1 : 0.f) + (lane >= 48 ? t2 : 0.f); }
            sc_g[lane] = gg; sc_b[lane] = sigmoidf_(ba);
        }
    }
    __syncthreads();
    if (active) {
        bf16_t* QDg = (bf16_t*)(scr + G_QD) + (size_t)unit * 64 * 128;
#pragma unroll 2
        for (int rr = 0; rr < 16; ++rr) {
            const int r = w4 * 16 + rr;
            const unsigned qv = *(const LAS unsigned*)(Qb + r * 136 + 2 * lane), kv = *(const LAS unsigned*)(Kb + r * 136 + 2 * lane);
            const float q0 = bflo(qv), q1 = bfhi(qv), k0 = bflo(kv), k1 = bfhi(kv);
            const float sq = wave_sum(q0 * q0 + q1 * q1), sk = wave_sum(k0 * k0 + k1 * k1);
            const float rq = rsqrtf(sq + RMS_EPS) * 0.08838834764831845f, rk = rsqrtf(sk + RMS_EPS);
            const float gc = sc_g[r], be = sc_b[r], eg = expf(gc);
            const float qn0 = q0 * rq, qn1 = q1 * rq, kn0 = k0 * rk, kn1 = k1 * rk;
            *(LAS unsigned*)(Qb + r * 136 + 2 * lane) = pk2(qn0, qn1);
            *(LAS unsigned*)(Kb + r * 136 + 2 * lane) = pk2(kn0, kn1);
            RKt[(2 * lane) * 72 + r] = (bf16_t)f2bf(kn0 * be * eg); RKt[(2 * lane + 1) * 72 + r] = (bf16_t)f2bf(kn1 * be * eg);
            *(unsigned*)(QDg + r * 128 + 2 * lane) = pk2(qn0 * eg, qn1 * eg);
        }
    }
    __syncthreads();
    f32x4 kk[4];
    if (active) {
        {
            bf16_t* KDt = (bf16_t*)(scr + G_KDT) + (size_t)unit * 128 * 64;
            const float gl = sc_g[63];
#pragma unroll
            for (int it = 0; it < 4; ++it) { const int idx = t8 + 256 * it, f = idx >> 3, c0 = (idx & 7) * 8;
                float v[8];
#pragma unroll
                for (int i = 0; i < 8; ++i) v[i] = bf2f(Kb[(c0 + i) * 136 + f]) * expf(gl - sc_g[c0 + i]);
                u32x4 w; w.x = pk2(v[0], v[1]); w.y = pk2(v[2], v[3]); w.z = pk2(v[4], v[5]); w.w = pk2(v[6], v[7]);
                *(u32x4*)(KDt + f * 64 + c0) = w; }
        }
        const int mt = w4;
        bf16_t* QKm = (bf16_t*)(scr + G_QK) + (size_t)unit * 64 * 64;
        bf16x8 a[4];
#pragma unroll
        for (int kb = 0; kb < 4; ++kb) a[kb] = *(const LAS bf16x8*)(Kb + (16 * mt + fr) * 136 + 32 * kb + 8 * g);
#pragma unroll
        for (int nt = 0; nt < 4; ++nt) {
            f32x4 c = (f32x4){0.f, 0.f, 0.f, 0.f}, c2 = (f32x4){0.f, 0.f, 0.f, 0.f};
#pragma unroll
            for (int kb = 0; kb < 4; ++kb) { const bf16x8 bq = *(const LAS bf16x8*)(Qb + (16 * nt + fr) * 136 + 32 * kb + 8 * g), bk = *(const LAS bf16x8*)(Kb + (16 * nt + fr) * 136 + 32 * kb + 8 * g);
                c = mfma32(a[kb], bq, c); c2 = mfma32(a[kb], bk, c2); }
            const int cj = 16 * nt + fr; const float gcol = sc_g[cj];
            {
                float v[4];
#pragma unroll
                for (int r = 0; r < 4; ++r) { const int j = 16 * mt + 4 * g + r; v[r] = (cj >= j) ? expf(gcol - sc_g[j]) * c[r] : 0.f; }
                u32x2 w; w.x = pk2(v[0], v[1]); w.y = pk2(v[2], v[3]);
                *(u32x2*)(QKm + cj * 64 + 16 * mt + 4 * g) = w;
            }
#pragma unroll
            for (int r = 0; r < 4; ++r) { const int i = 16 * mt + 4 * g + r; kk[nt][r] = (i > cj) ? sc_b[i] * expf(sc_g[i] - gcol) * c2[r] : 0.f; }
        }
    }
    __syncthreads();
    if (active) {
#pragma unroll
        for (int nt = 0; nt < 4; ++nt)
#pragma unroll
            for (int r = 0; r < 4; ++r) Lm[(16 * w4 + 4 * g + r) * 68 + 16 * nt + fr] = kk[nt][r];
    }
    __syncthreads();
    if (active && w4 == 0) {
        float t[64];
#pragma unroll
        for (int i = 0; i < 64; ++i) t[i] = 0.f;
#pragma unroll
        for (int i = 0; i < 64; ++i) {
            float a0 = (i == lane) ? 1.f : 0.f, a1 = 0.f, a2 = 0.f, a3 = 0.f;
#pragma unroll
            for (int jj = 0; jj < (i + 3) / 4; ++jj) { const f32x4 lv = *(const LAS f32x4*)(Lm + i * 68 + 4 * jj);
                a0 -= lv[0] * t[4 * jj]; a1 -= lv[1] * t[4 * jj + 1]; a2 -= lv[2] * t[4 * jj + 2]; a3 -= lv[3] * t[4 * jj + 3]; }
            t[i] = (a0 + a1) + (a2 + a3);
        }
#pragma unroll
        for (int i = 0; i < 64; ++i) Tb[i * 72 + lane] = (bf16_t)f2bf(t[i]);
    }
    __syncthreads();
    if (active) {
        f32x4* U0f = (f32x4*)(scr + G_U0) + (size_t)unit * 8 * 4 * 64;
        bf16_t* Wm = (bf16_t*)(scr + G_WM) + (size_t)unit * 64 * 128;
#pragma unroll
        for (int hh = 0; hh < 2; ++hh) {
            const int ct = w4 + 4 * hh;
            bf16x8 bv[2], ak[2];
#pragma unroll
            for (int k = 0; k < 2; ++k) { bv[k] = *(const LAS bf16x8*)(RVt + (16 * ct + fr) * 72 + 32 * k + 8 * g); ak[k] = *(const LAS bf16x8*)(RKt + (16 * ct + fr) * 72 + 32 * k + 8 * g); }
#pragma unroll
            for (int mt = 0; mt < 4; ++mt) {
                f32x4 c = (f32x4){0.f, 0.f, 0.f, 0.f}, c2 = (f32x4){0.f, 0.f, 0.f, 0.f};
#pragma unroll
                for (int k = 0; k < 2; ++k) { const bf16x8 tt = *(const LAS bf16x8*)(Tb + (16 * mt + fr) * 72 + 32 * k + 8 * g); c = mfma32(tt, bv[k], c); c2 = mfma32(ak[k], tt, c2); }
                U0f[(ct * 4 + mt) * 64 + lane] = c;
                u32x2 w; w.x = pk2(-c2[0], -c2[1]); w.y = pk2(-c2[2], -c2[3]);
                *(u32x2*)(Wm + (16 * mt + fr) * 128 + 16 * ct + 4 * g) = w;
            }
        }
        if (t8 == 0) ((float*)(scr + G_CD))[unit] = expf(sc_g[63]);
    }
    __syncthreads();
}

__device__ __forceinline__ void hgrn_pre_unit(const Params& p, const Frame& F, int tc) {
    const int col = 2 * F.tid, h = col >> 7, f = col & 127;
    const float* lbl = p.in[I_LBLOG];
    float lb[2];
#pragma unroll
    for (int k = 0; k < 2; ++k) { const float l0 = lbl[col + k], l1 = lbl[1024 + col + k], l2 = lbl[2048 + col + k]; const float m = fmaxf(l0, fmaxf(l1, l2));
        const float e0 = expf(l0 - m), e1 = expf(l1 - m), e2 = expf(l2 - m); lb[k] = e0 / (e0 + e1 + e2); }
    const int t0 = tc * 16, b = t0 / SEQ, chunk = (t0 % SEQ) >> 4, bh = b * 8 + h;
    const bf16_t* H1 = (const bf16_t*)(opq(p.ws) + WS_H1);
    unsigned char* scr = opq(p.ws) + WS_SCR;
    float bc0[16], bc1[16], kk0[16], kk1[16]; unsigned iv[16];
    float cum0 = 0.f, cum1 = 0.f;
#pragma unroll
    for (int c = 0; c < 16; ++c) {
        const size_t row = (size_t)(t0 + c);
        const unsigned qv = *(const unsigned*)(H1 + row * H1LD + C_QB + col), fv = *(const unsigned*)(H1 + row * H1LD + C_FB + col);
        iv[c] = *(const unsigned*)(H1 + row * H1LD + C_IB + col);
        const float f0 = lb[0] + (1.f - lb[0]) * sigmoidf_(bflo(fv)), f1 = lb[1] + (1.f - lb[1]) * sigmoidf_(bfhi(fv));
        cum0 += logf(f0); cum1 += logf(f1);
        bc0[c] = cum0; bc1[c] = cum1; kk0[c] = 1.f - f0; kk1[c] = 1.f - f1;
        *(unsigned*)((bf16_t*)(scr + H_QD) + row * 1024 + col) = pk2(bflo(qv) * expf(cum0), bfhi(qv) * expf(cum1));
        *(unsigned*)((bf16_t*)(scr + H_KI) + row * 1024 + col) = pk2(kk0[c] * expf(-cum0), kk1[c] * expf(-cum1));
    }
    unsigned kd0[8], kd1[8], i0[8], i1[8];
#pragma unroll
    for (int c = 0; c < 16; c += 2) {
        kd0[c >> 1] = pk2(kk0[c] * expf(cum0 - bc0[c]), kk0[c + 1] * expf(cum0 - bc0[c + 1]));
        kd1[c >> 1] = pk2(kk1[c] * expf(cum1 - bc1[c]), kk1[c + 1] * expf(cum1 - bc1[c + 1]));
        i0[c >> 1] = (iv[c] & 0xffffu) | (iv[c + 1] << 16);
        i1[c >> 1] = (iv[c] >> 16) | (iv[c + 1] & 0xffff0000u);
    }
    const size_t base = ((size_t)(bh * 128 + chunk) * 128 + f) * 16;
    u32x4* kd = (u32x4*)((bf16_t*)(scr + H_KDT) + base); u32x4* it = (u32x4*)((bf16_t*)(scr + H_IT) + base);
    kd[0] = (u32x4){kd0[0], kd0[1], kd0[2], kd0[3]}; kd[1] = (u32x4){kd0[4], kd0[5], kd0[6], kd0[7]};
    kd[2] = (u32x4){kd1[0], kd1[1], kd1[2], kd1[3]}; kd[3] = (u32x4){kd1[4], kd1[5], kd1[6], kd1[7]};
    it[0] = (u32x4){i0[0], i0[1], i0[2], i0[3]}; it[1] = (u32x4){i0[4], i0[5], i0[6], i0[7]};
    it[2] = (u32x4){i1[0], i1[1], i1[2], i1[3]}; it[3] = (u32x4){i1[4], i1[5], i1[6], i1[7]};
    *(f32x2*)((float*)(scr + H_CD) + (size_t)(bh * 128 + chunk) * 128 + f) = (f32x2){expf(cum0), expf(cum1)};
}

__device__ __forceinline__ void p2_pre(const Params& p, const Frame& F0) {
    const Frame F = refresh(F0);
    for (int u = F.bid; u < 1024; u += 2 * F.G) gdn_pre_pair(p, F, u, u + F.G);
    for (int u = F.bid; u < 512; u += F.G) hgrn_pre_unit(p, F, u);
}

__device__ __forceinline__ void gdn_scan(const Params& p, const Frame& F0, int bh) {
    const Frame F = refresh(F0);
    const int lane = F.lane, fr = lane & 15, g = lane >> 4, wave = F.wave, b = bh >> 3, h = bh & 7;
    unsigned char* scr = opqg(p.ws) + WS_SCR;
    constexpr int BUFB = 62464, OFF_QD = 17408, OFF_KDT = 34816, OFF_QK = 53248;
    const bf16_t* gWM = (const bf16_t*)(scr + G_WM); const bf16_t* gQD = (const bf16_t*)(scr + G_QD);
    const bf16_t* gKDT = (const bf16_t*)(scr + G_KDT); const bf16_t* gQK = (const bf16_t*)(scr + G_QK);
    const f32x4* gU0 = (const f32x4*)(scr + G_U0); const float* gCD = (const float*)(scr + G_CD);
    bf16_t* OA = (bf16_t*)(scr + O_A);
    u32x4 rw[2], rq[2], rk[2], rqk; f32x4 u0c[4], u0n[4];
#define GS_ISSUE(u) do { _Pragma("unroll") for (int i = 0; i < 2; ++i) { const int idx = F.tid + 512 * i; \
        rw[i] = *(const u32x4*)(gWM + (size_t)(u) * 8192 + idx * 8); rq[i] = *(const u32x4*)(gQD + (size_t)(u) * 8192 + idx * 8); rk[i] = *(const u32x4*)(gKDT + (size_t)(u) * 8192 + idx * 8); } \
        rqk = *(const u32x4*)(gQK + (size_t)(u) * 4096 + F.tid * 8); \
        _Pragma("unroll") for (int mt = 0; mt < 4; ++mt) u0n[mt] = gU0[(((size_t)(u) * 8 + wave) * 4 + mt) * 64 + lane]; } while (0)
#define GS_WRITE(bufp) do { _Pragma("unroll") for (int i = 0; i < 2; ++i) { const int idx = F.tid + 512 * i; \
        *(LAS u32x4*)((bufp) + ((idx >> 4) * 136 + (idx & 15) * 8) * 2) = rw[i]; *(LAS u32x4*)((bufp) + OFF_QD + ((idx >> 4) * 136 + (idx & 15) * 8) * 2) = rq[i]; \
        *(LAS u32x4*)((bufp) + OFF_KDT + ((idx >> 3) * 72 + (idx & 7) * 8) * 2) = rk[i]; } \
        *(LAS u32x4*)((bufp) + OFF_QK + ((F.tid >> 3) * 72 + (F.tid & 7) * 8) * 2) = rqk; } while (0)
    f32x4 Sacc[8];
#pragma unroll
    for (int ft = 0; ft < 8; ++ft) Sacc[ft] = (f32x4){0.f, 0.f, 0.f, 0.f};
    GS_ISSUE(bh * 32);
    GS_WRITE(F.lds);
#pragma unroll
    for (int mt = 0; mt < 4; ++mt) u0c[mt] = u0n[mt];
    __syncthreads();
    float dec = ld_agent(gCD + bh * 32);
    for (int ci = 0; ci < 32; ++ci) {
        const int u = bh * 32 + ci;
        LAS unsigned char* buf = F.lds + (ci & 1) * BUFB;
        float decn = dec; if (ci + 1 < 32) decn = ld_agent(gCD + u + 1);
        if (ci + 1 < 32) GS_ISSUE(u + 1);
        const LAS bf16_t* WM = (const LAS bf16_t*)buf; const LAS bf16_t* QD = (const LAS bf16_t*)(buf + OFF_QD);
        const LAS bf16_t* KDT = (const LAS bf16_t*)(buf + OFF_KDT); const LAS bf16_t* QK = (const LAS bf16_t*)(buf + OFF_QK);
        bf16x8 Sbf[4];
#pragma unroll
        for (int kb = 0; kb < 4; ++kb) Sbf[kb] = pack8(Sacc[2 * kb], Sacc[2 * kb + 1]);
        f32x4 uacc[4], oacc[4];
#pragma unroll
        for (int mt = 0; mt < 4; ++mt) { uacc[mt] = u0c[mt]; oacc[mt] = (f32x4){0.f, 0.f, 0.f, 0.f}; }
        bf16x8 fa[8], fb[8];
#define GS_LD_UQ(dst, mt) do { _Pragma("unroll") for (int kb = 0; kb < 4; ++kb) { dst[kb] = frag_perm(WM + (16 * (mt) + fr) * 136, 32 * kb + 4 * g); dst[4 + kb] = frag_perm(QD + (16 * (mt) + fr) * 136, 32 * kb + 4 * g); } } while (0)
#define GS_MM_UQ(src, mt) do { _Pragma("unroll") for (int kb = 0; kb < 4; ++kb) { uacc[mt] = mfma32(src[kb], Sbf[kb], uacc[mt]); oacc[mt] = mfma32(src[4 + kb], Sbf[kb], oacc[mt]); } } while (0)
        GS_LD_UQ(fa, 0);
        GS_LD_UQ(fb, 1); __builtin_amdgcn_sched_barrier(0); GS_MM_UQ(fa, 0); __builtin_amdgcn_sched_barrier(0);
        GS_LD_UQ(fa, 2); __builtin_amdgcn_sched_barrier(0); GS_MM_UQ(fb, 1); __builtin_amdgcn_sched_barrier(0);
        GS_LD_UQ(fb, 3); __builtin_amdgcn_sched_barrier(0); GS_MM_UQ(fa, 2); __builtin_amdgcn_sched_barrier(0);
#pragma unroll
        for (int mt = 0; mt < 4; ++mt)
#pragma unroll
            for (int k = 0; k < 2; ++k) fa[2 * mt + k] = frag_perm(QK + (16 * mt + fr) * 72, 32 * k + 4 * g);
        __builtin_amdgcn_sched_barrier(0); GS_MM_UQ(fb, 3); __builtin_amdgcn_sched_barrier(0);
#undef GS_LD_UQ
#undef GS_MM_UQ
        bf16x8 ubf[2];
#pragma unroll
        for (int k = 0; k < 2; ++k) ubf[k] = pack8(uacc[2 * k], uacc[2 * k + 1]);
#pragma unroll
        for (int ft = 0; ft < 4; ++ft)
#pragma unroll
            for (int k = 0; k < 2; ++k) fb[2 * ft + k] = frag_perm(KDT + (16 * ft + fr) * 72, 32 * k + 4 * g);
        __builtin_amdgcn_sched_barrier(0);
#pragma unroll
        for (int mt = 0; mt < 4; ++mt)
#pragma unroll
            for (int k = 0; k < 2; ++k) oacc[mt] = mfma32(fa[2 * mt + k], ubf[k], oacc[mt]);
        __builtin_amdgcn_sched_barrier(0);
#pragma unroll
        for (int ft = 0; ft < 4; ++ft)
#pragma unroll
            for (int k = 0; k < 2; ++k) fa[2 * ft + k] = frag_perm(KDT + (16 * (4 + ft) + fr) * 72, 32 * k + 4 * g);
        __builtin_amdgcn_sched_barrier(0);
#pragma unroll
        for (int ft = 0; ft < 4; ++ft) {
            Sacc[ft] = Sacc[ft] * dec;
#pragma unroll
            for (int k = 0; k < 2; ++k) Sacc[ft] = mfma32(fb[2 * ft + k], ubf[k], Sacc[ft]);
        }
        __builtin_amdgcn_sched_barrier(0);
#pragma unroll
        for (int ft = 0; ft < 4; ++ft) {
            Sacc[4 + ft] = Sacc[4 + ft] * dec;
#pragma unroll
            for (int k = 0; k < 2; ++k) Sacc[4 + ft] = mfma32(fa[2 * ft + k], ubf[k], Sacc[4 + ft]);
        }
        dec = decn;
        {
            bf16_t* orow = OA + (size_t)(b * SEQ + ci * 64) * 1024 + h * 128 + 16 * wave + fr;
#pragma unroll
            for (int mt = 0; mt < 4; ++mt)
#pragma unroll
                for (int r = 0; r < 4; ++r) orow[(size_t)(16 * mt + 4 * g + r) * 1024] = (bf16_t)f2bf(oacc[mt][r]);
        }
        if (ci + 1 < 32) { GS_WRITE(F.lds + ((ci + 1) & 1) * BUFB);
#pragma unroll
            for (int mt = 0; mt < 4; ++mt) u0c[mt] = u0n[mt]; }
        asm volatile("s_waitcnt lgkmcnt(0)" ::: "memory"); __builtin_amdgcn_s_barrier();
    }
#undef GS_ISSUE
#undef GS_WRITE
}

__device__ __forceinline__ void hgrn_scan(const Params& p, const Frame& F0, int bh) {
    const Frame F = refresh(F0);
    const int lane = F.lane, fr = lane & 15, g = lane >> 4, wave = F.wave, b = bh >> 3, h = bh & 7;
    unsigned char* scr = opqg(p.ws) + WS_SCR;
    constexpr int BUFB = 61440, OFF_KI = 17408, OFF_KDT = 34816, OFF_CD = 59392;
    const bf16_t* gQD = (const bf16_t*)(scr + H_QD); const bf16_t* gKI = (const bf16_t*)(scr + H_KI);
    const bf16_t* gKDT = (const bf16_t*)(scr + H_KDT) + (size_t)bh * 128 * 128 * 16; const bf16_t* gIT = (const bf16_t*)(scr + H_IT) + (size_t)bh * 128 * 128 * 16;
    const float* gCD = (const float*)(scr + H_CD) + (size_t)bh * 128 * 128;
    bf16_t* OB = (bf16_t*)(scr + O_B);
    u32x4 rq[2], rk[2], rd[2], rc; u32x2 itn[4], itc[4];
#define HS_ISSUE(grp) do { _Pragma("unroll") for (int i = 0; i < 2; ++i) { const int idx = F.tid + 512 * i; const size_t go = (size_t)(b * SEQ + (grp) * 64 + (idx >> 4)) * 1024 + h * 128 + (idx & 15) * 8; \
        rq[i] = *(const u32x4*)(gQD + go); rk[i] = *(const u32x4*)(gKI + go); rd[i] = *(const u32x4*)(gKDT + (size_t)(grp) * 8192 + idx * 8); } \
        if (F.tid < 128) rc = *(const u32x4*)(gCD + (size_t)(grp) * 512 + F.tid * 4); \
        _Pragma("unroll") for (int sc = 0; sc < 4; ++sc) itn[sc] = *(const u32x2*)(gIT + ((size_t)((grp) * 4 + sc) * 128 + 16 * wave + fr) * 16 + 4 * g); } while (0)
#define HS_WRITE(bufp) do { _Pragma("unroll") for (int i = 0; i < 2; ++i) { const int idx = F.tid + 512 * i; \
        *(LAS u32x4*)((bufp) + ((idx >> 4) * 136 + (idx & 15) * 8) * 2) = rq[i]; *(LAS u32x4*)((bufp) + OFF_KI + ((idx >> 4) * 136 + (idx & 15) * 8) * 2) = rk[i]; \
        *(LAS u32x4*)((bufp) + OFF_KDT + ((idx >> 1) * 24 + (idx & 1) * 8) * 2) = rd[i]; } \
        if (F.tid < 128) *(LAS u32x4*)((bufp) + OFF_CD + F.tid * 16) = rc; } while (0)
    f32x4 Sacc[8];
#pragma unroll
    for (int ft = 0; ft < 8; ++ft) Sacc[ft] = (f32x4){0.f, 0.f, 0.f, 0.f};
    HS_ISSUE(0);
    HS_WRITE(F.lds);
#pragma unroll
    for (int sc = 0; sc < 4; ++sc) itc[sc] = itn[sc];
    __syncthreads();
    for (int grp = 0; grp < 32; ++grp) {
        LAS unsigned char* buf = F.lds + (grp & 1) * BUFB;
        if (grp + 1 < 32) HS_ISSUE(grp + 1);
        const LAS bf16_t* QD = (const LAS bf16_t*)buf; const LAS bf16_t* KI = (const LAS bf16_t*)(buf + OFF_KI);
        const LAS bf16_t* KDT = (const LAS bf16_t*)(buf + OFF_KDT); const LAS float* CD = (const LAS float*)(buf + OFF_CD);
#pragma unroll
        for (int sc = 0; sc < 4; ++sc) {
            bf16x8 qf[4], kf[4]; f32x4 dd[8]; bf16x4 kd[8];
#pragma unroll
            for (int kb = 0; kb < 4; ++kb) { qf[kb] = frag_perm(QD + (16 * sc + fr) * 136, 32 * kb + 4 * g); kf[kb] = frag_perm(KI + (16 * sc + fr) * 136, 32 * kb + 4 * g); }
#pragma unroll
            for (int ft = 0; ft < 8; ++ft) { dd[ft] = *(const LAS f32x4*)(CD + sc * 128 + 16 * ft + 4 * g); kd[ft] = *(const LAS bf16x4*)(KDT + ((sc * 128) + 16 * ft + fr) * 24 + 4 * g); }
            __builtin_amdgcn_sched_barrier(0);
            bf16x8 Sbf[4];
#pragma unroll
            for (int kb = 0; kb < 4; ++kb) Sbf[kb] = pack8(Sacc[2 * kb], Sacc[2 * kb + 1]);
            f32x4 o = (f32x4){0.f, 0.f, 0.f, 0.f}, pT = (f32x4){0.f, 0.f, 0.f, 0.f};
#pragma unroll
            for (int kb = 0; kb < 4; ++kb) {
                o = mfma32(qf[kb], Sbf[kb], o);
                pT = mfma32(kf[kb], qf[kb], pT);
            }
#pragma unroll
            for (int r = 0; r < 4; ++r) pT[r] = (fr >= 4 * g + r) ? pT[r] : 0.f;
            const bf16x4 itf = __builtin_bit_cast(bf16x4, itc[sc]);
            o = mfma16(pack4(pT), itf, o);
#pragma unroll
            for (int ft = 0; ft < 8; ++ft) Sacc[ft] = mfma16(kd[ft], itf, Sacc[ft] * dd[ft]);
            bf16_t* orow = OB + (size_t)(b * SEQ + grp * 64 + sc * 16) * 1024 + h * 128 + 16 * wave + fr;
#pragma unroll
            for (int r = 0; r < 4; ++r) orow[(size_t)(4 * g + r) * 1024] = (bf16_t)f2bf(o[r]);
        }
        if (grp + 1 < 32) { HS_WRITE(F.lds + ((grp + 1) & 1) * BUFB);
#pragma unroll
            for (int sc = 0; sc < 4; ++sc) itc[sc] = itn[sc]; }
        asm volatile("s_waitcnt lgkmcnt(0)" ::: "memory"); __builtin_amdgcn_s_barrier();
    }
#undef HS_ISSUE
#undef HS_WRITE
}

__device__ __forceinline__ void p4_gate(const Params& p, const Frame& F0) {
    const Frame F = refresh(F0);
    const int gw = F.bid * NWAVES + F.wave, NGW = F.G * NWAVES, hs = F.lane >> 4, e0 = (F.lane & 15) * 8;
    unsigned char* scr = opq(p.ws) + WS_SCR;
    const bf16_t* H1 = (const bf16_t*)(opq(p.ws) + WS_H1); bf16_t* OC = (bf16_t*)(opq(p.ws) + WS_OC);
    for (int m = gw; m < T; m += NGW) {
#pragma unroll
        for (int rr = 0; rr < 4; ++rr) {
            const int hh = rr * 4 + hs;
            const bool isb = hh >= 8; const int hd = hh & 7;
            const bf16_t* osrc = (const bf16_t*)(scr + (isb ? O_B : O_A)) + (size_t)m * 1024 + hd * 128 + e0;
            const bf16_t* zsrc = H1 + (size_t)m * H1LD + (isb ? C_GB : C_ZA) + hd * 128 + e0;
            const float* gsrc = (isb ? p.in[I_EV_HGRNN] : p.in[I_EV_GDNN]) + e0;
            const u32x4 ov = *(const u32x4*)osrc, zv = *(const u32x4*)zsrc;
            const f32x4 g0 = *(const f32x4*)gsrc, g1 = *(const f32x4*)(gsrc + 4);
            float x[8] = {bflo(ov.x), bfhi(ov.x), bflo(ov.y), bfhi(ov.y), bflo(ov.z), bfhi(ov.z), bflo(ov.w), bfhi(ov.w)};
            const float z[8] = {bflo(zv.x), bfhi(zv.x), bflo(zv.y), bfhi(zv.y), bflo(zv.z), bfhi(zv.z), bflo(zv.w), bfhi(zv.w)};
            const float gn[8] = {g0[0], g0[1], g0[2], g0[3], g1[0], g1[1], g1[2], g1[3]};
            float ss = 0.f;
#pragma unroll
            for (int i = 0; i < 8; ++i) ss += x[i] * x[i];
            ss = row16_sum(ss);
            const float rinv = rsqrtf(ss * (1.f / 128.f) + RMS_EPS);
#pragma unroll
            for (int i = 0; i < 8; ++i) x[i] = x[i] * rinv * gn[i] * siluf_(z[i]);
            u32x2 w; w.x = pk4_fp8(x[0] * A_PRE, x[1] * A_PRE, x[2] * A_PRE, x[3] * A_PRE); w.y = pk4_fp8(x[4] * A_PRE, x[5] * A_PRE, x[6] * A_PRE, x[7] * A_PRE);
            *(u32x2*)((unsigned char*)OC + (size_t)m * 2048 + hh * 128 + e0) = w;
        }
    }
}

constexpr int H3LD = 6144;
constexpr size_t A_QR = 0;
constexpr size_t A_KR = 32 * MiB;
constexpr size_t A_VT = 64 * MiB;
constexpr size_t A_OG = 96 * MiB;
constexpr size_t A_LSE = 120 * MiB;
constexpr size_t A_KPART = 121 * MiB;
constexpr float QSCALE = 0.08838834764831845f * 1.4426950408889634f;
__device__ __forceinline__ int head_dil_log2(int hd) { return hd < 4 ? 0 : hd < 8 ? 2 : hd < 12 ? 4 : 0; }
__device__ __forceinline__ int posp(int s, int dl) { return ((s & ((1 << dl) - 1)) << (11 - dl)) + (s >> dl); }

__device__ __forceinline__ void rope_unit(const Params& p, const Frame& F, int unit) {
    const int hh = unit & 1, st = (unit >> 1) & 31, b = unit >> 6, s0 = st * 64;
    const bf16_t* H3 = (const bf16_t*)(opq(p.ws) + WS_H1);
    unsigned char* scr = opq(p.ws) + WS_SCR;
    bf16_t* QR = (bf16_t*)(scr + A_QR); bf16_t* KR = (bf16_t*)(scr + A_KR); bf16_t* VT = (bf16_t*)(scr + A_VT); float* KPART = (float*)(scr + A_KPART);
    LAS float* KS = (LAS float*)F.lds;
    LAS bf16_t* VL = (LAS bf16_t*)(F.lds + 33280);
    const int tok2 = F.tid >> 4, pj = (F.tid & 15) * 4;
    float cs[2][4], sn[2][4];
#pragma unroll
    for (int tt = 0; tt < 2; ++tt)
#pragma unroll
        for (int i = 0; i < 4; ++i) { const float inv = powf(10000.0f, -(float)(pj + i) * (1.0f / 64.0f)); const float ang = (float)(s0 + tok2 + 32 * tt) * inv; sincosf(ang, &sn[tt][i], &cs[tt][i]); }
    for (int hi = 0; hi < 8; ++hi) {
        const int hd = hh * 8 + hi, dl = head_dil_log2(hd);
        const int qcol = hd < 12 ? hd * 128 : 4608 + (hd - 12) * 128, kcol = hd < 12 ? 1536 + hd * 128 : 5120 + (hd - 12) * 128, vcol = hd < 12 ? 3072 + hd * 128 : 5632 + (hd - 12) * 128;
        const size_t hb = (size_t)(b * 16 + hd) * 2048;
#pragma unroll
        for (int tt = 0; tt < 2; ++tt) {
            const int tl = tok2 + 32 * tt, s = s0 + tl; const size_t row = (size_t)(b * SEQ + s) * H3LD; const size_t orow = (hb + posp(s, dl)) * 128;
#pragma unroll
            for (int qk = 0; qk < 2; ++qk) {
                const bf16_t* src = H3 + row + (qk ? kcol : qcol) + pj;
                const u32x2 a = *(const u32x2*)src, c = *(const u32x2*)(src + 64);
                const float x1[4] = {bflo(a.x), bfhi(a.x), bflo(a.y), bfhi(a.y)}, x2[4] = {bflo(c.x), bfhi(c.x), bflo(c.y), bfhi(c.y)};
                float y1[4], y2[4]; const float sc = qk ? 1.0f : QSCALE;
#pragma unroll
                for (int i = 0; i < 4; ++i) { y1[i] = (x1[i] * cs[tt][i] - x2[i] * sn[tt][i]) * sc; y2[i] = (x2[i] * cs[tt][i] + x1[i] * sn[tt][i]) * sc; }
                bf16_t* dst = (qk ? KR : QR) + orow + pj;
                u32x2 w1, w2; w1.x = pk2(y1[0], y1[1]); w1.y = pk2(y1[2], y1[3]); w2.x = pk2(y2[0], y2[1]); w2.y = pk2(y2[2], y2[3]);
                *(u32x2*)dst = w1; *(u32x2*)(dst + 64) = w2;
                if (qk && hd >= 12) {
#pragma unroll
                    for (int i = 0; i < 4; ++i) { KS[tl * 129 + pj + i] = y1[i]; KS[tl * 129 + 64 + pj + i] = y2[i]; }
                }
            }
        }
#pragma unroll
        for (int i = 0; i < 2; ++i) { const int idx = F.tid + 512 * i, tl = idx >> 4, pc = idx & 15;
            *(LAS u32x4*)(VL + tl * 136 + pc * 8) = *(const u32x4*)(H3 + (size_t)(b * SEQ + s0 + tl) * H3LD + vcol + pc * 8); }
        __syncthreads();
        if (hd >= 12 && F.tid < 128) { float sum = 0.f;
#pragma unroll 8
            for (int tl = 0; tl < 64; ++tl) sum += KS[tl * 129 + F.tid];
            KPART[((size_t)(b * 4 + hd - 12) * 32 + st) * 128 + F.tid] = sum; }
        {
            const int pp = posp(s0 + F.lane, dl);
#pragma unroll 4
            for (int i = 0; i < 16; ++i) { const int d = F.wave * 16 + i; VT[((size_t)(b * 16 + hd) * 128 + d) * 2048 + pp] = VL[F.lane * 136 + d]; }
        }
        __syncthreads();
    }
}

template <int MODE>
__device__ __forceinline__ void attn_item(const Params& p, const Frame& F0, int b, int hd, int q0, int ktile_lo, int ktile_hi) {
    const Frame F = refresh(F0);
    const int lane = F.lane, fr = lane & 15, g = lane >> 4, wave = F.wave;
    unsigned char* scr = opq(p.ws) + WS_SCR;
    const size_t hb = (size_t)(b * 16 + hd);
    const bf16_t* Qg = (const bf16_t*)(scr + A_QR) + hb * 2048 * 128; const bf16_t* Kg = (const bf16_t*)(scr + A_KR) + hb * 2048 * 128; const bf16_t* Vg = (const bf16_t*)(scr + A_VT) + hb * 128 * 2048;
    constexpr int BUFB = 35840, OFF_V = 17408, OFF_KM = 71680;
    const int nq = q0 + 16 * wave + fr;
    bf16x8 qf[4];
#pragma unroll
    for (int kb = 0; kb < 4; ++kb) qf[kb] = *(const bf16x8*)(Qg + (size_t)nq * 128 + 32 * kb + 8 * g);
    unsigned selmask = 0u;
    if (MODE == 1) {
        const int qb = q0 >> 8, h = hd - 12;
        LAS float* KM = (LAS float*)(F.lds + OFF_KM);
        const float* KPART = (const float*)(scr + A_KPART) + (size_t)(b * 4 + h) * 32 * 128;
#pragma unroll
        for (int i = 0; i < 2; ++i) { const int idx = F.tid + 512 * i, jb = idx >> 7, d = idx & 127;
            KM[idx] = (KPART[(4 * jb + 0) * 128 + d] + KPART[(4 * jb + 1) * 128 + d]) + (KPART[(4 * jb + 2) * 128 + d] + KPART[(4 * jb + 3) * 128 + d]); }
        __syncthreads();
        float gate[8];
#pragma unroll
        for (int jb = 0; jb < 8; ++jb) { float s = 0.f;
#pragma unroll
            for (int kb = 0; kb < 4; ++kb) { const u32x4 qq = __builtin_bit_cast(u32x4, qf[kb]); const LAS float* km = KM + jb * 128 + 32 * kb + 8 * g;
                const f32x4 k0 = *(const LAS f32x4*)km, k1 = *(const LAS f32x4*)(km + 4);
                s += (bflo(qq.x) * k0[0] + bfhi(qq.x) * k0[1]) + (bflo(qq.y) * k0[2] + bfhi(qq.y) * k0[3]) + (bflo(qq.z) * k1[0] + bfhi(qq.z) * k1[1]) + (bflo(qq.w) * k1[2] + bfhi(qq.w) * k1[3]); }
            s += xor16_f(s); s = xor32_sum(s); gate[jb] = s; }
#pragma unroll
        for (int jb = 0; jb < 8; ++jb) { int rank = 0;
#pragma unroll
            for (int j2 = 0; j2 < 8; ++j2) if (j2 != jb && j2 < qb) rank += (gate[j2] > gate[jb] || (gate[j2] == gate[jb] && j2 < jb)) ? 1 : 0;
            if (jb < qb && rank < 3) selmask |= 1u << jb; }
        __syncthreads();
    }
    u32x4 rk[2], rv[2];
#define AT_ISSUE(kt) do { _Pragma("unroll") for (int i = 0; i < 2; ++i) { const int idx = F.tid + 512 * i; \
        rk[i] = *(const u32x4*)(Kg + (size_t)((kt) * 64 + (idx >> 4)) * 128 + (idx & 15) * 8); rv[i] = *(const u32x4*)(Vg + (size_t)(idx >> 3) * 2048 + (kt) * 64 + (idx & 7) * 8); } } while (0)
#define AT_WRITE(bufp) do { _Pragma("unroll") for (int i = 0; i < 2; ++i) { const int idx = F.tid + 512 * i; \
        *(LAS u32x4*)((bufp) + ((idx >> 4) * 136 + (idx & 15) * 8) * 2) = rk[i]; *(LAS u32x4*)((bufp) + OFF_V + ((idx >> 3) * 72 + (idx & 7) * 8) * 2) = rv[i]; } } while (0)
    f32x4 oacc[8];
#pragma unroll
    for (int dt = 0; dt < 8; ++dt) oacc[dt] = (f32x4){0.f, 0.f, 0.f, 0.f};
    float mrun = -1e30f, lrun = 0.f;
    AT_ISSUE(ktile_lo);
    AT_WRITE(F.lds);
    __syncthreads();
    for (int kt = ktile_lo; kt < ktile_hi; ++kt) {
        LAS unsigned char* buf = F.lds + ((kt - ktile_lo) & 1) * BUFB;
        if (kt + 1 < ktile_hi) AT_ISSUE(kt + 1);
        const LAS bf16_t* KL = (const LAS bf16_t*)buf; const LAS bf16_t* VL = (const LAS bf16_t*)(buf + OFF_V);
        f32x4 sT[4];
        {
            bf16x8 kf[16];
#pragma unroll
            for (int t4 = 0; t4 < 4; ++t4)
#pragma unroll
                for (int kb = 0; kb < 4; ++kb) kf[4 * t4 + kb] = *(const LAS bf16x8*)(KL + (16 * t4 + fr) * 136 + 32 * kb + 8 * g);
            __builtin_amdgcn_sched_barrier(0);
#pragma unroll
            for (int t4 = 0; t4 < 4; ++t4) { sT[t4] = (f32x4){0.f, 0.f, 0.f, 0.f};
#pragma unroll
                for (int kb = 0; kb < 4; ++kb) sT[t4] = mfma32(kf[4 * t4 + kb], qf[kb], sT[t4]); }
        }
        __builtin_amdgcn_sched_barrier(0);
        bf16x8 vf[16];
#pragma unroll
        for (int dt = 0; dt < 8; ++dt) { vf[2 * dt] = frag_perm(VL + (16 * dt + fr) * 72, 4 * g); vf[2 * dt + 1] = frag_perm(VL + (16 * dt + fr) * 72, 32 + 4 * g); }
        __builtin_amdgcn_sched_barrier(0);
        const int k0 = kt * 64; float mx = -1e30f;
        const float NEG = -__builtin_huge_valf();
#pragma unroll
        for (int t4 = 0; t4 < 4; ++t4)
#pragma unroll
            for (int r = 0; r < 4; ++r) { const int nk = k0 + 16 * t4 + 4 * g + r; bool v;
                if (MODE == 0) v = (nk <= nq) && (nq - nk <= 128);
                else v = ((k0 >> 8) == (q0 >> 8)) ? (nk <= nq) : (((selmask >> (k0 >> 8)) & 1u) != 0u);
                sT[t4][r] = v ? sT[t4][r] : NEG; mx = fmaxf(mx, sT[t4][r]); }
        mx = fmaxf(mx, xor16_f(mx)); mx = xor32_max(mx);
        const float mnew = fmaxf(mrun, mx), alpha = exp2f(mrun - mnew); mrun = mnew;
        float ps = 0.f;
#pragma unroll
        for (int t4 = 0; t4 < 4; ++t4)
#pragma unroll
            for (int r = 0; r < 4; ++r) { const float pv = exp2f(sT[t4][r] - mnew); sT[t4][r] = pv; ps += pv; }
        lrun = lrun * alpha + ps;
        const bf16x8 pb0 = pack8(sT[0], sT[1]), pb1 = pack8(sT[2], sT[3]);
#pragma unroll
        for (int dt = 0; dt < 8; ++dt) {
            oacc[dt] = oacc[dt] * alpha;
            oacc[dt] = mfma32(vf[2 * dt], pb0, oacc[dt]);
            oacc[dt] = mfma32(vf[2 * dt + 1], pb1, oacc[dt]);
        }
        if (kt + 1 < ktile_hi) AT_WRITE(F.lds + ((kt + 1 - ktile_lo) & 1) * BUFB);
        __syncthreads();
    }
#undef AT_ISSUE
#undef AT_WRITE
    lrun += xor16_f(lrun); lrun = xor32_sum(lrun);
    const float inv = 1.0f / lrun;
    if (MODE == 0) {
        bf16_t* og = (bf16_t*)(scr + A_OG) + ((size_t)(b * 12 + hd) * 2048 + nq) * 128;
#pragma unroll
        for (int dt = 0; dt < 8; ++dt) { u32x2 w; w.x = pk2(oacc[dt][0] * inv, oacc[dt][1] * inv); w.y = pk2(oacc[dt][2] * inv, oacc[dt][3] * inv); *(u32x2*)(og + 16 * dt + 4 * g) = w; }
        if (g == 0) ((float*)(scr + A_LSE))[(size_t)(b * 12 + hd) * 2048 + nq] = mrun + log2f(lrun);
    } else {
        unsigned char* oc = (opq(p.ws) + WS_OC) + (size_t)(b * SEQ + nq) * 1024 + 512 + (hd - 12) * 128;
        const float inv4 = inv * A_PRE;
#pragma unroll
        for (int dt = 0; dt < 8; ++dt) *(unsigned*)(oc + 16 * dt + 4 * g) = pk4_fp8(oacc[dt][0] * inv4, oacc[dt][1] * inv4, oacc[dt][2] * inv4, oacc[dt][3] * inv4);
    }
}

__device__ __forceinline__ void attn_phase(const Params& p, const Frame& F0) {
    const Frame F = refresh(F0);
    const int i = F.bid & 15, bhm = F.bid >> 4;
    const int nd = (i == 0) ? 7 : (i <= 2) ? 6 : (i <= 4) ? 5 : (i <= 6) ? 4 : (i <= 8) ? 3 : (i <= 10) ? 2 : (i == 11) ? 1 : 0;
    const int st = (i == 0) ? 0 : (i == 1) ? 7 : (i == 2) ? 13 : (i == 3) ? 19 : (i == 4) ? 24 : (i == 5) ? 29 : (i == 6) ? 33 : (i == 7) ? 37 : (i == 8) ? 40 : (i == 9) ? 43 : (i == 10) ? 45 : (i == 11) ? 47 : 48;
    const bool balanced = (F.G == 256);
    for (int k = 0;; ++k) {
        int it;
        if (balanced) { if (k > nd) break; it = (k == 0) ? (bhm * 16 + i) : (256 + bhm * 48 + st + k - 1); }
        else { it = F.bid + k * F.G; if (it >= 1024) break; }
        if (it < 256) { const int qt = it & 15; attn_item<1>(p, F, it >> 6, 12 + ((it >> 4) & 3), qt * 128, 0, 2 * (qt + 1)); }
        else { const int id = it - 256, qt = id & 15, hd = (id >> 4) % 12, b = (id >> 4) / 12, dl = head_dil_log2(hd); const int q0 = qt * 128, first = ((q0 & ((2048 >> dl) - 1)) == 0);
            attn_item<0>(p, F, b, hd, q0, first ? 2 * qt : 2 * qt - 2, 2 * qt + 2); }
    }
}

__device__ __forceinline__ void merge_pass(const Params& p, const Frame& F0) {
    const Frame F = refresh(F0);
    const int gw = F.bid * NWAVES + F.wave, NGW = F.G * NWAVES, hg = F.lane >> 4, d0 = (F.lane & 15) * 8;
    unsigned char* scr = opq(p.ws) + WS_SCR;
    const bf16_t* OG = (const bf16_t*)(scr + A_OG); const float* LSE = (const float*)(scr + A_LSE); bf16_t* OC = (bf16_t*)(opq(p.ws) + WS_OC);
    for (int m = gw; m < T; m += NGW) {
        const int b = m >> 11, s = m & 2047;
        float ls[3]; u32x4 ov[3];
#pragma unroll
        for (int gi = 0; gi < 3; ++gi) { const int hd = 4 * gi + hg; const size_t idx = (size_t)(b * 12 + hd) * 2048 + posp(s, 2 * gi); ls[gi] = LSE[idx]; ov[gi] = *(const u32x4*)(OG + idx * 128 + d0); }
        const float mx = fmaxf(ls[0], fmaxf(ls[1], ls[2]));
        float w[3]; float ws = 0.f;
#pragma unroll
        for (int gi = 0; gi < 3; ++gi) { w[gi] = exp2f(ls[gi] - mx); ws += w[gi]; }
        const float inv = 1.0f / ws;
        float o[8] = {0.f, 0.f, 0.f, 0.f, 0.f, 0.f, 0.f, 0.f};
#pragma unroll
        for (int gi = 0; gi < 3; ++gi) { const float wg = w[gi] * inv;
            o[0] += wg * bflo(ov[gi].x); o[1] += wg * bfhi(ov[gi].x); o[2] += wg * bflo(ov[gi].y); o[3] += wg * bfhi(ov[gi].y);
            o[4] += wg * bflo(ov[gi].z); o[5] += wg * bfhi(ov[gi].z); o[6] += wg * bflo(ov[gi].w); o[7] += wg * bfhi(ov[gi].w); }
        u32x2 wv; wv.x = pk4_fp8(o[0] * A_PRE, o[1] * A_PRE, o[2] * A_PRE, o[3] * A_PRE); wv.y = pk4_fp8(o[4] * A_PRE, o[5] * A_PRE, o[6] * A_PRE, o[7] * A_PRE);
        *(u32x2*)((unsigned char*)OC + (size_t)m * 1024 + hg * 128 + d0) = wv;
    }
}

#define GRID_SYNC() xcd_barrier((unsigned*)(opq(p.ws) + WS_CTL), (volatile LAS unsigned*)(F.lds + LDS_BYTES - 16), F.wave)
#ifndef REPMASK
#define REPMASK 0u
#endif
__device__ __forceinline__ int repn(int k) { int n = 1 + (int)(((REPMASK) >> k) & 1u); asm volatile("" : "+s"(n)); return n; }
#define RP(k) for (int _r = 0, _n = repn(k); _r < _n; ++_r)
__global__ void __launch_bounds__(NTHR, 2) mk_fwd(Params p) {
    extern __shared__ __attribute__((aligned(16))) unsigned char lds_raw[];
    Frame F; F.lds = (LAS unsigned char*)lds_raw; F.tid = 0; F.lane = 0; F.wave = __builtin_amdgcn_readfirstlane(threadIdx.x >> 6); F.G = gridDim.x; F.bid = blockIdx.x;
#define P_WS (opq(p.ws))
#define P_AB ((bf16_t*)(opq(p.ws) + WS_AB))
#define P_R (opq(p.out))
#define P_MIX ((bf16_t*)(opq(p.ws) + WS_MIX))
#define P_HID ((bf16_t*)(opq(p.ws) + WS_HID))
#define P_Y2 ((bf16_t*)(opq(p.ws) + WS_Y2))

    {
        if (threadIdx.x == 0) { volatile LAS unsigned* st = (volatile LAS unsigned*)(F.lds + LDS_BYTES - 16); st[0] = 0u; st[1] = 0u;
            (void)xb_add((unsigned*)(p.ws + WS_CTL) + XB_XCNT(xb_xcc_id()), 1u); }
        __syncthreads();
    }
    RP(0) { convert_set(p, F, 0, F.bid * NWAVES + F.wave, F.G * NWAVES); __syncthreads(); }
    RP(1) { load_w16_lds(F, p.in[I_EV_WIN], EVEN_IN, 4096); __syncthreads(); p0_xpass(p, F); __syncthreads(); }
    GRID_SYNC();

    RP(2) {
        pg8::StaticOrder S; S.init(T, 8192, F.G, F.bid);
        pg8::Gemm g{(const unsigned char*)(P_WS + WS_AB), (const unsigned char*)(P_WS + WS_WIN), 2048, (unsigned)(T * 2048), (unsigned)(8192 * 2048), SC_A16};
        pg8::EpiBf16 E{(bf16_t*)(P_WS + WS_H1), H1LD, (unsigned)(T * 8192 * 2)};
        pg8::gemm_phase(F.lds, F.wave, g, S, E);
    }
    GRID_SYNC();
    RP(3) { p2_pre(p, F); }
    GRID_SYNC();
    RP(4) { if (F.bid < 32) gdn_scan(p, F, F.bid); else if (F.bid < 64) hgrn_scan(p, F, F.bid - 32);
            else if (F.G > 64) convert_set(p, F, 1, (F.bid - 64) * NWAVES + F.wave, (F.G - 64) * NWAVES); }
    if (F.G <= 64) { convert_set(p, F, 1, F.bid * NWAVES + F.wave, F.G * NWAVES); }
    GRID_SYNC();
    RP(5) { p4_gate(p, F); }
    GRID_SYNC();
    RP(6) {
        pg8::StaticOrder S; S.init(T, 2048, F.G, F.bid);
        pg8::Gemm g{(const unsigned char*)(P_WS + WS_OC), (const unsigned char*)(P_WS + WS_WOUT), 2048, (unsigned)(T * 2048), (unsigned)(2048 * 2048), SC_A4};
        pg8::EpiBf16 E{P_MIX, 2048, (unsigned)(T * 2048 * 2)};
        pg8::gemm_phase(F.lds, F.wave, g, S, E);
    }
    GRID_SYNC();
#define MOE_BLOCK(layer, resid, mixp, outfinal, outb2) do { \
        for (int _r = 0, _n = ((layer) == 0 ? repn(7) : 1); _r < _n; ++_r) { load_w16_lds(F, p.in[I_RW], 16, 0); __syncthreads(); \
            ln_pass<true, false, (layer) != 0, true>(p, F, resid, mixp, D, nullptr, p.in[I_LNG] + (size_t)((layer) * 2 + 0) * D, p.in[I_LNB] + (size_t)((layer) * 2 + 0) * D, P_R, P_AB, layer); __syncthreads(); } \
        GRID_SYNC(); \
        const int* list = (const int*)(P_WS + WS_LIST) + (size_t)(layer) * NE * T; \
        const float* gatew = (const float*)(P_WS + WS_GATEW) + (size_t)(layer) * 2 * T; \
        RP(8) { moe_lists(p, F, layer); } \
        GRID_SYNC(); \
        { const Frame Fr = refresh(F); pg8::moe_build_table(F.lds, Fr.tid); } \
        unsigned* tcnt = (unsigned*)(P_WS + WS_CTL) + 3600 + 128 * (layer);        \
        { pg8::MoeOrder<4, false> S; S.init(F.lds, list, F.G, F.bid, 1024, tcnt); \
            pg8::Gemm g{(const unsigned char*)(P_WS + WS_ABS), (const unsigned char*)(P_WS + ((layer) ? WS_WGU1 : WS_WGU)), 2048, (unsigned)(20480 * 2048), (unsigned)(NE * 1024 * 2048), SC_A1}; \
            pg8::EpiGateUpB E{P_HID, list, gatew}; pg8::gemm_phase(F.lds, F.wave, g, S, E); } \
          \
        { pg8::MoeDownS S; S.init(F.lds, tcnt, 2048, F.G, F.bid); \
            pg8::Gemm16 g{P_HID, (const bf16_t*)(P_WS + WS_WD), 512, (unsigned)(20480 * 512 * 2), (unsigned)(NE * 2048 * 512 * 2)}; \
            pg8::EpiDown E{P_Y2, list}; pg8::gemm_phase16(F.lds, F.wave, g, S, E); } \
        GRID_SYNC(); \
        ln_pass<false, true, true, (layer) == 0>(p, F, P_R, P_Y2, D, P_Y2, p.in[I_LNG] + (size_t)((layer) * 2 + 1) * D, p.in[I_LNB] + (size_t)((layer) * 2 + 1) * D, outfinal, outb2, layer); \
    } while (0)
    MOE_BLOCK(0, p.in[I_X], P_MIX, P_R, (bf16_t*)(P_WS + WS_AB8));
    __syncthreads();
    RP(11) { convert_set(p, F, 2, F.bid * NWAVES + F.wave, F.G * NWAVES); __syncthreads(); }
    GRID_SYNC();
    RP(12) {
        pg8::StaticOrder S; S.init(T, 6144, F.G, F.bid);
        pg8::Gemm g{(const unsigned char*)(P_WS + WS_AB8), (const unsigned char*)(P_WS + WS_W3), 2048, (unsigned)(T * 2048), (unsigned)(6144 * 2048), SC_A1};
        pg8::EpiBf16 E{(bf16_t*)(P_WS + WS_H1), H3LD, (unsigned)(T * 6144 * 2)};
        pg8::gemm_phase(F.lds, F.wave, g, S, E);
    }
    GRID_SYNC();
    RP(13) { const Frame Fr = refresh(F); for (int u = Fr.bid; u < 256; u += Fr.G) rope_unit(p, Fr, u); }
    GRID_SYNC();
    RP(14) { attn_phase(p, F); }
    GRID_SYNC();
    RP(15) { merge_pass(p, F); }
    GRID_SYNC();
    RP(16) {
        pg8::StaticOrder S; S.init(T, 2048, F.G, F.bid);
        pg8::Gemm g{(const unsigned char*)(P_WS + WS_OC), (const unsigned char*)(P_WS + WS_WOUT1), 1024, (unsigned)(T * 1024), (unsigned)(2048 * 1024), SC_A4};
        pg8::EpiBf16 E{P_MIX, 2048, (unsigned)(T * 2048 * 2)};
        pg8::gemm_phase(F.lds, F.wave, g, S, E);
    }
    GRID_SYNC();
    MOE_BLOCK(1, P_R, P_MIX, p.out, (bf16_t*)nullptr);
#undef MOE_BLOCK
#undef P_WS
#undef P_AB
#undef P_R
#undef P_MIX
#undef P_HID
#undef P_Y2
}

extern "C" void kernel_launch(void* const* d_in, const int* in_sizes, int n_in, void* d_out, int out_size,
                              void* d_ws, size_t ws_size, hipStream_t stream) {
    static int grid_blocks = 0;
    if (!grid_blocks) {
        int dev = 0, cus = 0, per_cu = 0;
        (void)hipGetDevice(&dev);
        (void)hipDeviceGetAttribute(&cus, hipDeviceAttributeMultiprocessorCount, dev);
        (void)hipFuncSetAttribute((const void*)mk_fwd, hipFuncAttributeMaxDynamicSharedMemorySize, LDS_BYTES);
        (void)hipOccupancyMaxActiveBlocksPerMultiprocessor(&per_cu, (const void*)mk_fwd, NTHR, LDS_BYTES);
        if (per_cu < 1) fprintf(stderr, "kernel_launch: occupancy query says %d blocks per CU\n", per_cu);
        grid_blocks = cus;
        if (ws_size < WS_END) { fprintf(stderr, "kernel_launch: workspace too small: %zu < %zu\n", ws_size, (size_t)WS_END); grid_blocks = -1; }
        if (n_in != 18) { fprintf(stderr, "kernel_launch: expected 18 inputs, got %d\n", n_in); grid_blocks = -1; }
    }
    if (grid_blocks < 0) return;
    Params p{};
    for (int i = 0; i < 18; ++i) p.in[i] = (const float*)d_in[i];
    p.out = (float*)d_out; p.ws = (unsigned char*)d_ws;
    (void)hipMemsetAsync(d_ws, 0, 16384, stream);
    void* args[] = {&p};
    hipError_t e = hipLaunchCooperativeKernel((void*)mk_fwd, dim3(grid_blocks), dim3(NTHR), args, LDS_BYTES, stream);
    if (e != hipSuccess) fprintf(stderr, "cooperative launch failed: %s (grid %d)\n", hipGetErrorString(e), grid_blocks);
}
```

```cpp
#include <hip/hip_runtime.h>
#include <cstdio>
#include <cstdint>

#define GAS __attribute__((address_space(1)))
#define LAS __attribute__((address_space(3)))
typedef unsigned short bf16_t;
typedef short bf16x8 __attribute__((ext_vector_type(8)));
typedef short bf16x4 __attribute__((ext_vector_type(4)));
typedef float f32x4 __attribute__((ext_vector_type(4)));
typedef float f32x2 __attribute__((ext_vector_type(2)));
typedef unsigned u32x4 __attribute__((ext_vector_type(4)));
typedef unsigned u32x2 __attribute__((ext_vector_type(2)));

constexpr int NB = 4, SEQ = 2048, T = NB * SEQ, D = 2048;
constexpr int EVEN_IN = 8208, ODD_IN = 6144;
constexpr int NE = 16, DEXP = 512;
constexpr float ALPHA = 1.4142135623730951f;
constexpr float LN_EPS = 1e-5f, RMS_EPS = 1e-6f;
constexpr int NWAVES = 8, NTHR = 512;
constexpr int LDS_BYTES = 147456;

constexpr size_t MiB = 1u << 20;
constexpr size_t WS_CTL = 0;
constexpr size_t WS_LIST = 1 * MiB;
constexpr size_t WS_GATEW = 2 * MiB;
constexpr size_t WS_BA = 2 * MiB + 512 * 1024;
constexpr size_t WS_ROPE = 3 * MiB;
constexpr size_t WS_KMEAN = 4 * MiB;
constexpr size_t WS_WREG = 8 * MiB;
constexpr size_t WS_WIN = WS_WREG;
constexpr size_t WS_AB8 = WS_WREG + 16 * MiB;
constexpr size_t WS_WOUT = WS_WREG + 32 * MiB;
constexpr size_t WS_WGU = WS_WREG + 40 * MiB;
constexpr size_t WS_WD = WS_WREG + 104 * MiB;
constexpr size_t WS_AB = WS_WREG + 136 * MiB;
constexpr size_t WS_H1 = WS_AB + 32 * MiB;
constexpr size_t WS_OC = WS_H1 + 128 * MiB;
constexpr size_t WS_MIX = WS_OC + 32 * MiB;
constexpr size_t WS_SCR = WS_MIX + 32 * MiB;
constexpr size_t WS_HID = WS_SCR;
constexpr size_t WS_Y2 = WS_SCR + 20 * MiB;
constexpr size_t WS_ABS = WS_SCR + 84 * MiB;
constexpr size_t WS_END = WS_SCR + 216 * MiB;
static_assert(WS_END == 584 * MiB, "workspace map");

typedef __bf16 bf16v2_t __attribute__((ext_vector_type(2)));
__device__ __forceinline__ unsigned pk2(float lo, float hi) { const f32x2 f = {lo, hi}; return __builtin_bit_cast(unsigned, __builtin_convertvector(f, bf16v2_t)); }
__device__ __forceinline__ unsigned f2bf(float f) { return pk2(f, 0.f) & 0xffffu; }
__device__ __forceinline__ unsigned pk4_fp8(float a, float b, float c, float d) {
    a = fminf(fmaxf(a, -448.f), 448.f); b = fminf(fmaxf(b, -448.f), 448.f); c = fminf(fmaxf(c, -448.f), 448.f); d = fminf(fmaxf(d, -448.f), 448.f);
    int w = 0; w = __builtin_amdgcn_cvt_pk_fp8_f32(a, b, w, false); w = __builtin_amdgcn_cvt_pk_fp8_f32(c, d, w, true); return (unsigned)w;
}
constexpr float W_PRE = 64.f;  constexpr int SC_W = 0x79797979;
constexpr float A_PRE = 4.f;   constexpr int SC_A4 = 0x7d7d7d7d;
constexpr int SC_A1 = 0x7f7f7f7f;
constexpr float X_PRE = 16.f;  constexpr int SC_A16 = 0x7b7b7b7b;
typedef int i32x8 __attribute__((ext_vector_type(8)));
__device__ __forceinline__ float bf2f(unsigned short b) { return __builtin_bit_cast(float, (unsigned)b << 16); }
__device__ __forceinline__ float bflo(unsigned w) { return __builtin_bit_cast(float, w << 16); }
__device__ __forceinline__ float bfhi(unsigned w) { return __builtin_bit_cast(float, w & 0xffff0000u); }
__device__ __forceinline__ unsigned cvt_pk_bf16(float lo, float hi) { return pk2(lo, hi); }
template <int CTRL> __device__ __forceinline__ float dpp_f(float x) { return __builtin_bit_cast(float, __builtin_amdgcn_update_dpp(0, __builtin_bit_cast(int, x), CTRL, 0xf, 0xf, true)); }
__device__ __forceinline__ float xor16_f(float x) { return __builtin_bit_cast(float, __builtin_amdgcn_ds_swizzle(__builtin_bit_cast(int, x), 0x401f)); }
__device__ __forceinline__ float row16_sum(float v) { v += dpp_f<0xB1>(v); v += dpp_f<0x4E>(v); v += dpp_f<0x141>(v); v += dpp_f<0x140>(v); return v; }
__device__ __forceinline__ float xor32_sum(float v) { const int i = __builtin_bit_cast(int, v); const auto r = __builtin_amdgcn_permlane32_swap(i, i, false, false);
    return __builtin_bit_cast(float, (int)r[0]) + __builtin_bit_cast(float, (int)r[1]); }
__device__ __forceinline__ float xor32_max(float v) { const int i = __builtin_bit_cast(int, v); const auto r = __builtin_amdgcn_permlane32_swap(i, i, false, false);
    return fmaxf(__builtin_bit_cast(float, (int)r[0]), __builtin_bit_cast(float, (int)r[1])); }
__device__ __forceinline__ float wave_sum(float v) { v = row16_sum(v); v += xor16_f(v); return xor32_sum(v); }
__device__ __forceinline__ float sigmoidf_(float x) { return 1.0f / (1.0f + __expf(-x)); }
__device__ __forceinline__ float siluf_(float x) { return x / (1.0f + __expf(-x)); }
#define LDS_WAIT() asm volatile("s_waitcnt lgkmcnt(0)" ::: "memory")
template <class Tp> __device__ __forceinline__ Tp* opq(Tp* x) { asm volatile("" : "+s"(x)); return x; }
template <class Tp> __device__ __forceinline__ Tp* opqg(Tp* x) { GAS Tp* g = (GAS Tp*)x; asm volatile("" : "+s"(g)); return (Tp*)g; }
__device__ __forceinline__ float ld_agent(const float* p) { return __hip_atomic_load(p, __ATOMIC_RELAXED, __HIP_MEMORY_SCOPE_AGENT); }

namespace pg8 {
constexpr int BM = 256, BK = 64, HALF = 128, HTB = HALF * BK * 2, STAGE_BYTES = 8 * HTB, NXCD = 8, WGM = 8;
__device__ __forceinline__ int lds_byte(int r, int c) { const int st = (r >> 4) * 2 + (c >> 5), rr = r & 15, cc = c & 31, ob = rr * 64 + cc * 2; return st * 1024 + (ob ^ (((ob >> 9) & 1) << 5)); }
__device__ __forceinline__ void stage_rc(int b, int& R, int& C) { const int st = b / 1024, sb = b % 1024, swz = sb ^ (((sb >> 9) & 1) << 5); R = (st >> 1) * 16 + swz / 64; C = (st & 1) * 32 + (swz % 64) / 2; }
__device__ __forceinline__ int perm32(int rho) { const int n = rho >> 4, i = rho & 15; return 8 * (i >> 2) + 4 * n + (i & 3); }

struct Unit { int pm, pn, e, cnt, arow0, brow0; };
struct Gemm { const unsigned char* A; const unsigned char* Bt; int K; unsigned abytes, bbytes; int sc_a; };

struct StaticOrder {
    static constexpr bool CONTIG = true;
    int nM, nN, nwg, G, c;
    __device__ void init(int M, int N, int G_, int c_) { nM = M / BM; nN = N / BM; nwg = nM * nN; G = G_; c = c_; }
    __device__ bool next(int i, Unit& u) const {
        const long L = (long)i * G + c; if (L >= nwg) return false;
        int wgid = (int)L; { const int q = nwg / NXCD, r = nwg % NXCD, xcd = wgid % NXCD, off = wgid / NXCD; wgid = (xcd < r ? xcd * (q + 1) : r * (q + 1) + (xcd - r) * q) + off; }
        const int nig = WGM * nN, gid = wgid / nig, fm = gid * WGM, gsz = (nM - fm) < WGM ? (nM - fm) : WGM;
        u.pm = fm + ((wgid % nig) % gsz); u.pn = (wgid % nig) / gsz; u.e = 0; u.cnt = 0; u.arow0 = u.pm * BM; u.brow0 = u.pn * BM; return true;
    }
    __device__ __forceinline__ unsigned arow(const Unit& u, int r) const { return (unsigned)(u.arow0 + r); }
    __device__ __forceinline__ void done(const Unit&, int) const {}
    struct State {};
    __device__ __forceinline__ bool first(State&, Unit& u, int) const { return next(0, u); }
    __device__ __forceinline__ void issue(State&, int, int) const {}
    __device__ __forceinline__ bool fin(State&, int i, Unit& u, int) const { return next(i, u); }
};

constexpr int MOE_TAB_OFF = 131072;
constexpr int MOE_HIST_OFF = 131072 + 3072;
__device__ __forceinline__ void moe_build_table(LAS unsigned char* lds, int tid) {
    LAS int* tab = (LAS int*)(lds + MOE_TAB_OFF);
    const LAS int* cnts = (const LAS int*)(lds + MOE_HIST_OFF) + 16;
    if (tid == 0) {
        int s = 0;
#pragma unroll 1
        for (int e = 0; e < NE; ++e) { const int c = cnts[e]; const int nt = (c + 255) >> 8;
#pragma unroll 1
            for (int k = 0; k < nt; ++k) { tab[4 + 4 * (s + k)] = e; tab[4 + 4 * (s + k) + 1] = k; tab[4 + 4 * (s + k) + 2] = c; }
            s += nt; }
        tab[0] = s;
    }
    __syncthreads();
}
template <int NPN, bool GATHER>
struct MoeOrder {
    static constexpr bool CONTIG = !GATHER;
    const int* list;
    LAS const int* tab; int G, c, brows;
    unsigned* tcnt;
    __device__ void init(LAS unsigned char* lds, const int* list_, int G_, int c_, int brows_, unsigned* tcnt_ = nullptr) { list = list_; G = G_; c = c_; brows = brows_; tab = (LAS const int*)(lds + MOE_TAB_OFF); tcnt = tcnt_; }
    __device__ __forceinline__ void done(const Unit& u, int lane) const {
        if (tcnt) { asm volatile("s_waitcnt vmcnt(0)" ::: "memory"); if (lane == 0) __hip_atomic_fetch_add(tcnt + (u.arow0 >> 8), 1u, __ATOMIC_RELAXED, __HIP_MEMORY_SCOPE_AGENT); }
    }
    __device__ bool next(int i, Unit& u) const {
        int L = i * G + c; const int ntile = __builtin_amdgcn_readfirstlane(tab[0]); if (L >= ntile * NPN) return false;
        if (NPN == 4 && i == 0 && G == 256) L = (c & 7) * 32 + (c >> 3);
        const int tile = L / NPN; u.pn = L % NPN;
        u.e = __builtin_amdgcn_readfirstlane(tab[4 + 4 * tile]); u.pm = __builtin_amdgcn_readfirstlane(tab[4 + 4 * tile + 1]); u.cnt = __builtin_amdgcn_readfirstlane(tab[4 + 4 * tile + 2]);
        u.arow0 = tile * BM; u.brow0 = u.e * brows + u.pn * BM; return true;
    }
    __device__ __forceinline__ unsigned arow(const Unit& u, int r) const {
        if (!GATHER) return (unsigned)(u.arow0 + r);
        int idx = u.pm * BM + r; if (idx >= u.cnt) idx = 0;
        return (unsigned)(list[u.e * T + idx] >> 1);
    }
    struct State {};
    __device__ __forceinline__ bool first(State&, Unit& u, int) const { return next(0, u); }
    __device__ __forceinline__ void issue(State&, int, int) const {}
    __device__ __forceinline__ bool fin(State&, int i, Unit& u, int) const { return next(i, u); }
};
constexpr int MOE_Q_OFF = 131072 + 3072 + 512;
struct MoeDownS {
    static constexpr bool CONTIG = true;
    typedef __attribute__((address_space(1))) unsigned gu32;
    LAS const int* tab; LAS unsigned* slot; gu32* tcnt; int brows, G, c;
    struct State {};
    __device__ void init(LAS unsigned char* lds, unsigned* tcnt_, int brows_, int G_, int c_) { tab = (LAS const int*)(lds + MOE_TAB_OFF); slot = (LAS unsigned*)(lds + MOE_Q_OFF); tcnt = (gu32*)tcnt_; brows = brows_; G = G_; c = c_; }
    __device__ __forceinline__ unsigned nunits() const { return (unsigned)__builtin_amdgcn_readfirstlane(tab[0]) * 8u; }
    __device__ __forceinline__ unsigned qof(int k) const {
        const int nG = __builtin_amdgcn_readfirstlane(tab[0]) * 4, h = nG % G, nl = G - h;
        return (unsigned)(c >= h ? k * nl + (k >= 3 ? (k - 2) * h : 0) + (c - h) : (k + 3) * nl + k * h + c);
    }
    __device__ __forceinline__ void wait_tile(unsigned q, unsigned cv) const {
        unsigned sp = 0;
        while (cv < 32u) { __builtin_amdgcn_s_sleep(2); if (++sp > (1u << 22)) break; cv = __hip_atomic_load(tcnt + (q >> 3), __ATOMIC_RELAXED, __HIP_MEMORY_SCOPE_AGENT); }
        asm volatile("buffer_inv sc1" ::: "memory");
    }
    __device__ __forceinline__ bool decode(unsigned q, Unit& u) const {
        if (q >= nunits()) return false;
        const int tile = (int)(q >> 3); u.pn = (int)(q & 7u);
        u.e = __builtin_amdgcn_readfirstlane(tab[4 + 4 * tile]); u.pm = __builtin_amdgcn_readfirstlane(tab[4 + 4 * tile + 1]); u.cnt = __builtin_amdgcn_readfirstlane(tab[4 + 4 * tile + 2]);
        u.arow0 = tile * BM; u.brow0 = u.e * brows + u.pn * BM; return true;
    }
    __device__ __forceinline__ bool first(State&, Unit& u, int tid) const {
        const unsigned q = qof(0);
        if (tid == 0 && q < nunits()) wait_tile(q, __hip_atomic_load(tcnt + (q >> 3), __ATOMIC_RELAXED, __HIP_MEMORY_SCOPE_AGENT));
        __syncthreads();
        return decode(q, u);
    }
    __device__ __forceinline__ void issue(State&, int i, int tid) const {
        const unsigned q = qof(i);
        if (tid == 0 && q < nunits()) {
            const __amdgpu_buffer_rsrc_t rc = __builtin_amdgcn_make_buffer_rsrc((void*)tcnt, (short)0, 128 * 4, 0x00020000);
            __builtin_amdgcn_raw_ptr_buffer_load_lds(rc, (LAS void*)slot, 4, (int)((q >> 3) * 4u), 0, 0, 16);
        }
    }
    __device__ __forceinline__ bool fin(State&, int i, Unit& u, int tid) const {
        const unsigned q = qof(i);
        if (tid == 0 && q < nunits()) {
            unsigned cv; asm volatile("ds_read_b32 %0, %1\n\ts_waitcnt lgkmcnt(0)" : "=v"(cv) : "v"((unsigned)(size_t)slot) : "memory");
            wait_tile(q, cv);
        }
        return decode(q, u);
    }
    __device__ __forceinline__ unsigned arow(const Unit& u, int r) const { return (unsigned)(u.arow0 + r); }
    __device__ __forceinline__ void done(const Unit&, int) const {}
};

struct EpiBf16 {
    static constexpr bool PERM = true;
    bf16_t* O; int ldc; unsigned obytes;
    __device__ __forceinline__ void operator()(const f32x4 (&acc)[2][2][4][2], const Unit& u, int wr, int wc, int fr, int fq) const {
        const __amdgpu_buffer_rsrc_t rO = __builtin_amdgcn_make_buffer_rsrc((void*)O, (short)0, (int)obytes, 0x00020000);
        const unsigned voff = (unsigned)((wr * 64 + fr) * ldc + wc * 32 + 8 * fq) * 2u;
        const unsigned sbase = (unsigned)(u.pm * BM * ldc + u.pn * BM) * 2u;
#pragma unroll
        for (int ai = 0; ai < 2; ++ai)
#pragma unroll
            for (int m = 0; m < 4; ++m)
#pragma unroll
                for (int bj = 0; bj < 2; ++bj) { const f32x4 v0 = acc[ai][bj][m][0], v1 = acc[ai][bj][m][1];
                    u32x4 w; w.x = cvt_pk_bf16(v0[0], v0[1]); w.y = cvt_pk_bf16(v0[2], v0[3]); w.z = cvt_pk_bf16(v1[0], v1[1]); w.w = cvt_pk_bf16(v1[2], v1[3]);
                    __builtin_amdgcn_raw_buffer_store_b128(w, rO, (int)voff, (int)(sbase + (unsigned)((ai * HALF + m * 16) * ldc + bj * HALF) * 2u), 0); }
    }
};
struct EpiGateUp {
    static constexpr bool PERM = true;
    unsigned char* HID; const int* list; const float* gatew;
    __device__ __forceinline__ void operator()(const f32x4 (&acc)[2][2][4][2], const Unit& u, int wr, int wc, int fr, int fq) const {
        const int col0 = u.pn * 128 + wc * 32 + 8 * fq;
#pragma unroll
        for (int ai = 0; ai < 2; ++ai)
#pragma unroll
            for (int m = 0; m < 4; ++m) {
                const int r = ai * HALF + wr * 64 + m * 16 + fr; const int idx = u.pm * BM + r;
                float wgt = 0.f; if (idx < u.cnt) wgt = gatew[list[u.e * T + idx]] * A_PRE;
                const f32x4 g0 = acc[ai][0][m][0], g1 = acc[ai][0][m][1], u0 = acc[ai][1][m][0], u1 = acc[ai][1][m][1];
                float h[8];
#pragma unroll
                for (int i = 0; i < 4; ++i) { h[i] = siluf_(g0[i]) * u0[i] * wgt; h[4 + i] = siluf_(g1[i]) * u1[i] * wgt; }
                u32x2 w; w.x = pk4_fp8(h[0], h[1], h[2], h[3]); w.y = pk4_fp8(h[4], h[5], h[6], h[7]);
                *(u32x2*)(HID + (size_t)(u.arow0 + r) * DEXP + col0) = w;
            }
    }
};
struct EpiGateUpB {
    static constexpr bool PERM = true;
    bf16_t* HID; const int* list; const float* gatew;
    __device__ __forceinline__ void operator()(const f32x4 (&acc)[2][2][4][2], const Unit& u, int wr, int wc, int fr, int fq) const {
        const __amdgpu_buffer_rsrc_t rH = __builtin_amdgcn_make_buffer_rsrc((void*)HID, (short)0, 20480 * 512 * 2, 0x00020000);
        const __amdgpu_buffer_rsrc_t rL = __builtin_amdgcn_make_buffer_rsrc((void*)(list + (size_t)u.e * T), (short)0, T * 4, 0x00020000);
        const __amdgpu_buffer_rsrc_t rG = __builtin_amdgcn_make_buffer_rsrc((void*)gatew, (short)0, 2 * T * 4, 0x00020000);
        const unsigned voff = (unsigned)((wr * 64 + fr) * DEXP + u.pn * 128 + wc * 32 + 8 * fq) * 2u;
        const int idx0 = u.pm * BM + wr * 64 + fr;
#pragma unroll
        for (int ai = 0; ai < 2; ++ai)
#pragma unroll
            for (int m = 0; m < 4; ++m) {
                const int idx = idx0 + ai * HALF + m * 16;
                const int ent = __builtin_amdgcn_raw_buffer_load_b32(rL, idx * 4, 0, 0);
                float wgt = __builtin_bit_cast(float, __builtin_amdgcn_raw_buffer_load_b32(rG, (idx < u.cnt ? ent : 0) * 4, 0, 0)); wgt = idx < u.cnt ? wgt : 0.f;
                const f32x4 g0 = acc[ai][0][m][0], g1 = acc[ai][0][m][1], u0 = acc[ai][1][m][0], u1 = acc[ai][1][m][1];
                float h[8];
#pragma unroll
                for (int i = 0; i < 4; ++i) { h[i] = siluf_(g0[i]) * u0[i] * wgt; h[4 + i] = siluf_(g1[i]) * u1[i] * wgt; }
                u32x4 w; w.x = cvt_pk_bf16(h[0], h[1]); w.y = cvt_pk_bf16(h[2], h[3]); w.z = cvt_pk_bf16(h[4], h[5]); w.w = cvt_pk_bf16(h[6], h[7]);
                __builtin_amdgcn_raw_buffer_store_b128(w, rH, (int)voff, (int)((u.arow0 + ai * HALF + m * 16) * DEXP * 2), 16);
            }
    }
};
struct EpiDown {
    static constexpr bool PERM = true;
    bf16_t* Y2; const int* list;
    __device__ __forceinline__ void operator()(const f32x4 (&acc)[2][2][4][2], const Unit& u, int wr, int wc, int fr, int fq) const {
        const int col0 = u.pn * BM + wc * 32 + 8 * fq;
#pragma unroll
        for (int ai = 0; ai < 2; ++ai)
#pragma unroll
            for (int m = 0; m < 4; ++m) {
                const int r = ai * HALF + wr * 64 + m * 16 + fr; const int idx = u.pm * BM + r;
                if (idx < u.cnt) { const int ent = list[u.e * T + idx]; bf16_t* rowp = Y2 + (size_t)ent * D + col0;
#pragma unroll
                    for (int bj = 0; bj < 2; ++bj) { const f32x4 v0 = acc[ai][bj][m][0], v1 = acc[ai][bj][m][1];
                        u32x4 w; w.x = cvt_pk_bf16(v0[0], v0[1]); w.y = cvt_pk_bf16(v0[2], v0[3]); w.z = cvt_pk_bf16(v1[0], v1[1]); w.w = cvt_pk_bf16(v1[2], v1[3]);
                        *(u32x4*)(rowp + bj * HALF) = w; } }
            }
    }
};

constexpr int NXT_OFF = 131072 + 4096;
template <class Epi, class Sched>
__device__ __forceinline__ void gemm_phase(LAS unsigned char* lds, int wave_id, const Gemm g, const Sched& S, const Epi& E) {
    int lane; asm volatile("v_mbcnt_lo_u32_b32 %0, -1, 0\n\tv_mbcnt_hi_u32_b32 %0, -1, %0" : "=v"(lane));
    const int wid = wave_id, tid = wid * 64 + lane, wr = wid >> 2, wc = wid & 3, fr = lane & 15, fq = lane >> 4;
    const int K = g.K, nt = K / 128;
    unsigned voffB[2];
#pragma unroll
    for (int i = 0; i < 2; ++i) { int R, C; stage_rc(tid * 16 + i * 8192, R, C); const int Rb = Epi::PERM ? ((R & ~31) + perm32(R & 31)) : R; voffB[i] = (unsigned)(Rb * K + 2 * C); }
    const unsigned ldsw = (unsigned)wid * 1024u;
    const int aoff = lds_byte(wr * 64 + fr, 16 * (fq & 1)) + (fq >> 1) * 1024, boff = lds_byte(wc * 32 + fr, 16 * (fq & 1)) + (fq >> 1) * 1024;
    LAS unsigned char* ldsB = lds + 4 * HTB + boff;
    LAS unsigned char* ldsA = lds + aoff;
    const int sc_act = g.sc_a;
#define PG8_SA(b, h) (((b) * 2 + (h)) * HTB)
#define PG8_SB(b, h) ((4 + (b) * 2 + (h)) * HTB)
#define PG8_STAGE(bufoff, rsrc, soff, voff) do { _Pragma("unroll") for (int _i = 0; _i < 2; ++_i) \
        __builtin_amdgcn_raw_ptr_buffer_load_lds(rsrc, (LAS void*)(lds + (bufoff) + ldsw + _i * 8192), 16, (int)(voff)[_i], (int)(soff), 0, 0); } while (0)
#define PG8_LD32(dstv, addr) do { const u32x4 _c0 = *(const LAS u32x4*)(lds + (addr)), _c1 = *(const LAS u32x4*)(lds + (addr) + 16); dstv = (i32x8){(int)_c0.x, (int)_c0.y, (int)_c0.z, (int)_c0.w, (int)_c1.x, (int)_c1.y, (int)_c1.z, (int)_c1.w}; } while (0)
#define PG8_LDA(dst, b, h) do { _Pragma("unroll") for (int m = 0; m < 4; ++m) { const u32x4 _c0 = *(const LAS u32x4*)(ldsA + PG8_SA(b, h) + m * 2048), _c1 = *(const LAS u32x4*)(ldsA + PG8_SA(b, h) + m * 2048 + 16); \
        dst[m] = (i32x8){(int)_c0.x, (int)_c0.y, (int)_c0.z, (int)_c0.w, (int)_c1.x, (int)_c1.y, (int)_c1.z, (int)_c1.w}; } } while (0)
#define PG8_LDB(dst, b, h) do { _Pragma("unroll") for (int n = 0; n < 2; ++n) { const u32x4 _c0 = *(const LAS u32x4*)(ldsB + ((b) * 2 + (h)) * HTB + n * 2048), _c1 = *(const LAS u32x4*)(ldsB + ((b) * 2 + (h)) * HTB + n * 2048 + 16); \
        dst[n] = (i32x8){(int)_c0.x, (int)_c0.y, (int)_c0.z, (int)_c0.w, (int)_c1.x, (int)_c1.y, (int)_c1.z, (int)_c1.w}; } } while (0)
#define PG8_MMA(ai, bj, At, Bt) do { __builtin_amdgcn_sched_barrier(0); __builtin_amdgcn_s_setprio(1); _Pragma("unroll") for (int m = 0; m < 4; ++m) _Pragma("unroll") for (int n = 0; n < 2; ++n) \
        acc[ai][bj][m][n] = __builtin_amdgcn_mfma_scale_f32_16x16x128_f8f6f4(Bt[n], At[m], acc[ai][bj][m][n], 0, 0, 0, SC_W, 0, sc_act); \
        _Pragma("unroll") for (int m = 0; m < 4; ++m) asm volatile("" :: "v"(acc[ai][bj][m][0]), "v"(acc[ai][bj][m][1]));     \
        __builtin_amdgcn_s_setprio(0); __builtin_amdgcn_sched_barrier(0); } while (0)
#define PG8_WAIT_V(n) asm volatile("s_waitcnt vmcnt(" #n ")" ::: "memory")
#define PG8_WAIT_L(n) asm volatile("s_waitcnt lgkmcnt(" #n ")" ::: "memory")
#define PG8_BAR __builtin_amdgcn_s_barrier()
#define PG8_SCHED __builtin_amdgcn_sched_barrier(0)
#define PG8_AOFFS(u, o0, o1) do { _Pragma("unroll") for (int _i = 0; _i < 2; ++_i) { int _R, _C; stage_rc(tid * 16 + _i * 8192, _R, _C); \
        o0[_i] = S.arow(u, _R) * (unsigned)K + 2u * (unsigned)_C; o1[_i] = S.arow(u, HALF + _R) * (unsigned)K + 2u * (unsigned)_C; } } while (0)
    Unit cur, nxt; int ui = 0;
    if (!S.next(0, cur)) return;
    f32x4 acc[2][2][4][2];
#pragma unroll
    for (int a = 0; a < 2; ++a)
#pragma unroll
        for (int b = 0; b < 2; ++b)
#pragma unroll
            for (int m = 0; m < 4; ++m)
#pragma unroll
                for (int n = 0; n < 2; ++n) acc[a][b][m][n] = (f32x4){0.f, 0.f, 0.f, 0.f};
    i32x8 At[4], B0[2], B1[2];
    unsigned cA0[2], cA1[2];
    PG8_AOFFS(cur, cA0, cA1);
    const __amdgpu_buffer_rsrc_t rA = __builtin_amdgcn_make_buffer_rsrc((void*)g.A, (short)0, (int)g.abytes, 0x00020000);
    const __amdgpu_buffer_rsrc_t rB = __builtin_amdgcn_make_buffer_rsrc((void*)g.Bt, (short)0, (int)g.bbytes, 0x00020000);
    const unsigned kstep = (unsigned)(BK * 2);
    const unsigned hstep = (unsigned)HALF * (unsigned)K;
    unsigned cB = (unsigned)cur.brow0 * (unsigned)K;
    PG8_STAGE(PG8_SB(0, 0), rB, cB, voffB); PG8_STAGE(PG8_SB(0, 1), rB, cB + hstep, voffB); PG8_STAGE(PG8_SA(0, 0), rA, 0u, cA0); PG8_STAGE(PG8_SA(0, 1), rA, 0u, cA1);
    if (wr == 1) PG8_BAR;
    PG8_WAIT_V(2); PG8_BAR;
    PG8_STAGE(PG8_SB(1, 0), rB, cB + kstep, voffB); PG8_STAGE(PG8_SA(1, 0), rA, kstep, cA0); PG8_STAGE(PG8_SB(1, 1), rB, cB + hstep + kstep, voffB);
    PG8_WAIT_V(6); PG8_BAR;
#define PG8_PAIR(a1, a2, b2, SWITCH) do { \
            PG8_LDB(B0, 0, 0); PG8_LDB(B1, 0, 1); PG8_SCHED; PG8_LDA(At, 0, 0); PG8_STAGE(PG8_SA(1, 1), rA, a1, cA1); \
            SWITCH; \
            PG8_WAIT_V(8); PG8_WAIT_L(0); PG8_BAR; PG8_MMA(0, 0, At, B0); PG8_MMA(0, 1, At, B1); PG8_BAR; PG8_SCHED; \
            PG8_LDA(At, 0, 1); PG8_STAGE(PG8_SB(0, 0), rB, b2, voffB); PG8_STAGE(PG8_SB(0, 1), rB, (b2) + hstep, voffB); PG8_STAGE(PG8_SA(0, 0), rA, a2, cA0); \
            PG8_WAIT_V(8); PG8_WAIT_L(0); PG8_BAR; PG8_MMA(1, 0, At, B0); PG8_MMA(1, 1, At, B1); PG8_BAR; PG8_SCHED; \
            PG8_LDB(B0, 1, 0); PG8_LDB(B1, 1, 1); PG8_SCHED; PG8_LDA(At, 1, 0); PG8_STAGE(PG8_SA(0, 1), rA, a2, cA1); \
            PG8_WAIT_V(8); PG8_WAIT_L(0); PG8_BAR; PG8_MMA(0, 0, At, B0); PG8_MMA(0, 1, At, B1); PG8_BAR; PG8_SCHED; \
            PG8_LDA(At, 1, 1); PG8_STAGE(PG8_SB(1, 0), rB, (b2) + kstep, voffB); PG8_STAGE(PG8_SB(1, 1), rB, (b2) + kstep + hstep, voffB); PG8_STAGE(PG8_SA(1, 0), rA, (a2) + kstep, cA0); \
            PG8_WAIT_V(8); PG8_WAIT_L(0); PG8_BAR; PG8_MMA(1, 0, At, B0); PG8_MMA(1, 1, At, B1); PG8_BAR; PG8_SCHED; } while (0)
    for (;;) {
        const bool has_next = S.next(ui + 1, nxt);
        const unsigned nB = has_next ? (unsigned)nxt.brow0 * (unsigned)K : cB;
        unsigned dlt = 0u;
        if constexpr (Sched::CONTIG) { dlt = has_next ? (unsigned)(nxt.arow0 - cur.arow0) * (unsigned)K : 0u; }
        else { unsigned n0[2], n1[2]; if (has_next) { PG8_AOFFS(nxt, n0, n1); } else { n0[0] = cA0[0]; n0[1] = cA0[1]; n1[0] = cA1[0]; n1[1] = cA1[1]; }
          *((LAS u32x4*)(lds + NXT_OFF) + tid) = (u32x4){n0[0], n0[1], n1[0], n1[1]}; }
        for (int t = 0; t < nt - 2; t += 2) {
            const unsigned a1 = (unsigned)(t + 1) * kstep, a2 = (unsigned)(t + 2) * kstep, b2 = cB + (unsigned)(t + 2) * kstep;
            PG8_PAIR(a1, a2, b2, (void)0);
        }
        {
            const unsigned a1 = (unsigned)(nt - 1) * kstep;
            PG8_PAIR(a1, 0u, nB, do { if constexpr (Sched::CONTIG) { cA0[0] += dlt; cA0[1] += dlt; cA1[0] += dlt; cA1[1] += dlt; } else { const u32x4 _n = *((LAS u32x4*)(lds + NXT_OFF) + tid); cA0[0] = _n.x; cA0[1] = _n.y; cA1[0] = _n.z; cA1[1] = _n.w; } } while (0));
        }
        { int l2; asm volatile("v_mbcnt_lo_u32_b32 %0, -1, 0\n\tv_mbcnt_hi_u32_b32 %0, -1, %0" : "=v"(l2));
          E(acc, cur, wr, wc, l2 & 15, l2 >> 4); S.done(cur, l2); }
        if (!has_next) break;
#pragma unroll
        for (int a = 0; a < 2; ++a)
#pragma unroll
            for (int b = 0; b < 2; ++b)
#pragma unroll
                for (int m = 0; m < 4; ++m)
#pragma unroll
                    for (int n = 0; n < 2; ++n) acc[a][b][m][n] = (f32x4){0.f, 0.f, 0.f, 0.f};
        cur = nxt; cB = nB; ++ui;
    }
    PG8_WAIT_V(0);
    if (wr == 0) PG8_BAR;
    PG8_BAR;
#undef PG8_PAIR
#undef PG8_AOFFS
#undef PG8_SA
#undef PG8_SB
#undef PG8_STAGE
#undef PG8_LDA
#undef PG8_LDB
#undef PG8_MMA
#undef PG8_WAIT_V
#undef PG8_WAIT_L
#undef PG8_BAR
#undef PG8_SCHED
}
struct Gemm16 { const bf16_t* A; const bf16_t* Bt; int K; unsigned abytes, bbytes; };
struct EpiGateUp16 {
    static constexpr bool PERM = true;
    bf16_t* HID; const int* list; const float* gatew;
    __device__ __forceinline__ void operator()(const f32x4 (&acc)[2][2][4][2], const Unit& u, int wr, int wc, int fr, int fq) const {
        const int col0 = u.pn * 128 + wc * 32 + 8 * fq;
#pragma unroll
        for (int ai = 0; ai < 2; ++ai)
#pragma unroll
            for (int m = 0; m < 4; ++m) {
                const int r = ai * HALF + wr * 64 + m * 16 + fr; const int idx = u.pm * BM + r;
                float wgt = 0.f; if (idx < u.cnt) wgt = gatew[list[u.e * T + idx]];
                const f32x4 g0 = acc[ai][0][m][0], g1 = acc[ai][0][m][1], u0 = acc[ai][1][m][0], u1 = acc[ai][1][m][1];
                float h[8];
#pragma unroll
                for (int i = 0; i < 4; ++i) { h[i] = siluf_(g0[i]) * u0[i] * wgt; h[4 + i] = siluf_(g1[i]) * u1[i] * wgt; }
                u32x4 w; w.x = cvt_pk_bf16(h[0], h[1]); w.y = cvt_pk_bf16(h[2], h[3]); w.z = cvt_pk_bf16(h[4], h[5]); w.w = cvt_pk_bf16(h[6], h[7]);
                *(u32x4*)(HID + (size_t)(u.arow0 + r) * DEXP + col0) = w;
            }
    }
};
template <class Epi, class Sched>
__device__ __forceinline__ void gemm_phase16(LAS unsigned char* lds, int wave_id, const Gemm16 g, const Sched& S, const Epi& E) {
    int lane; asm volatile("v_mbcnt_lo_u32_b32 %0, -1, 0\n\tv_mbcnt_hi_u32_b32 %0, -1, %0" : "=v"(lane));
    const int wid = wave_id, tid = wid * 64 + lane, wr = wid >> 2, wc = wid & 3, fr = lane & 15, fq = lane >> 4;
    const int K = g.K, nt = K / BK;
    unsigned voffB[2];
#pragma unroll
    for (int i = 0; i < 2; ++i) { int R, C; stage_rc(tid * 16 + i * 8192, R, C); const int Rb = Epi::PERM ? ((R & ~31) + perm32(R & 31)) : R; voffB[i] = (unsigned)(Rb * K + C) * 2u; }
    const unsigned ldsw = (unsigned)wid * 1024u;
    const int aoff = lds_byte(wr * 64 + fr, fq * 8), boff = lds_byte(wc * 32 + fr, fq * 8);
#define PG8_SA(b, h) (((b) * 2 + (h)) * HTB)
#define PG8_SB(b, h) ((4 + (b) * 2 + (h)) * HTB)
#define PG8_STAGE(bufoff, rsrc, soff, voff) do { _Pragma("unroll") for (int _i = 0; _i < 2; ++_i) \
        __builtin_amdgcn_raw_ptr_buffer_load_lds(rsrc, (LAS void*)(lds + (bufoff) + ldsw + _i * 8192), 16, (int)(voff)[_i], (int)(soff), 0, 0); } while (0)
#define PG8_LDA(dst, b, h) do { _Pragma("unroll") for (int m = 0; m < 4; ++m) _Pragma("unroll") for (int k = 0; k < 2; ++k) dst[m][k] = *(const LAS bf16x8*)(lds + PG8_SA(b, h) + aoff + m * 2048 + k * 1024); } while (0)
#define PG8_LDB(dst, b, h) do { _Pragma("unroll") for (int n = 0; n < 2; ++n) _Pragma("unroll") for (int k = 0; k < 2; ++k) dst[n][k] = *(const LAS bf16x8*)(lds + PG8_SB(b, h) + boff + n * 2048 + k * 1024); } while (0)
#define PG8_MMA(ai, bj, At, Bt) do { __builtin_amdgcn_s_setprio(1); _Pragma("unroll") for (int m = 0; m < 4; ++m) _Pragma("unroll") for (int n = 0; n < 2; ++n) _Pragma("unroll") for (int k = 0; k < 2; ++k) \
        acc[ai][bj][m][n] = __builtin_amdgcn_mfma_f32_16x16x32_bf16(Bt[n][k], At[m][k], acc[ai][bj][m][n], 0, 0, 0); __builtin_amdgcn_s_setprio(0); } while (0)
#define PG8_WAIT_V(n) asm volatile("s_waitcnt vmcnt(" #n ")" ::: "memory")
#define PG8_WAIT_L(n) asm volatile("s_waitcnt lgkmcnt(" #n ")" ::: "memory")
#define PG8_BAR __builtin_amdgcn_s_barrier()
#define PG8_SCHED __builtin_amdgcn_sched_barrier(0)
#define PG8_AOFFS(u, o0, o1) do { _Pragma("unroll") for (int _i = 0; _i < 2; ++_i) { int _R, _C; stage_rc(tid * 16 + _i * 8192, _R, _C); \
        o0[_i] = (S.arow(u, _R) * (unsigned)K + (unsigned)_C) * 2u; o1[_i] = (S.arow(u, HALF + _R) * (unsigned)K + (unsigned)_C) * 2u; } } while (0)
    Unit cur, nxt; int ui = 0;
    typename Sched::State st;
    if (!S.first(st, cur, tid)) return;
    f32x4 acc[2][2][4][2];
#pragma unroll
    for (int a = 0; a < 2; ++a)
#pragma unroll
        for (int b = 0; b < 2; ++b)
#pragma unroll
            for (int m = 0; m < 4; ++m)
#pragma unroll
                for (int n = 0; n < 2; ++n) acc[a][b][m][n] = (f32x4){0.f, 0.f, 0.f, 0.f};
    bf16x8 At[4][2], B0[2][2], B1[2][2];
    unsigned cA0[2], cA1[2];
    PG8_AOFFS(cur, cA0, cA1);
    const __amdgpu_buffer_rsrc_t rA = __builtin_amdgcn_make_buffer_rsrc((void*)g.A, (short)0, (int)g.abytes, 0x00020000);
    const __amdgpu_buffer_rsrc_t rB = __builtin_amdgcn_make_buffer_rsrc((void*)g.Bt, (short)0, (int)g.bbytes, 0x00020000);
    const unsigned kstep = (unsigned)(BK * 2);
    const unsigned hstep = (unsigned)HALF * (unsigned)K * 2u;
    unsigned cB = (unsigned)cur.brow0 * (unsigned)K * 2u;
    PG8_STAGE(PG8_SB(0, 0), rB, cB, voffB); PG8_STAGE(PG8_SB(0, 1), rB, cB + hstep, voffB); PG8_STAGE(PG8_SA(0, 0), rA, 0u, cA0); PG8_STAGE(PG8_SA(0, 1), rA, 0u, cA1);
    if (wr == 1) PG8_BAR;
    PG8_WAIT_V(2); PG8_BAR;
    PG8_STAGE(PG8_SB(1, 0), rB, cB + kstep, voffB); PG8_STAGE(PG8_SA(1, 0), rA, kstep, cA0); PG8_STAGE(PG8_SB(1, 1), rB, cB + hstep + kstep, voffB);
    PG8_WAIT_V(6); PG8_BAR;
#define PG8_PAIR(a1, a2, b2, SWITCH) do { \
            PG8_LDB(B0, 0, 0); PG8_LDB(B1, 0, 1); PG8_SCHED; PG8_LDA(At, 0, 0); PG8_STAGE(PG8_SA(1, 1), rA, a1, cA1); \
            SWITCH; \
            PG8_WAIT_V(8); PG8_WAIT_L(0); PG8_BAR; PG8_MMA(0, 0, At, B0); PG8_MMA(0, 1, At, B1); PG8_BAR; PG8_SCHED; \
            PG8_LDA(At, 0, 1); PG8_STAGE(PG8_SB(0, 0), rB, b2, voffB); PG8_STAGE(PG8_SB(0, 1), rB, (b2) + hstep, voffB); PG8_STAGE(PG8_SA(0, 0), rA, a2, cA0); \
            PG8_WAIT_V(8); PG8_WAIT_L(0); PG8_BAR; PG8_MMA(1, 0, At, B0); PG8_MMA(1, 1, At, B1); PG8_BAR; PG8_SCHED; \
            PG8_LDB(B0, 1, 0); PG8_LDB(B1, 1, 1); PG8_SCHED; PG8_LDA(At, 1, 0); PG8_STAGE(PG8_SA(0, 1), rA, a2, cA1); \
            PG8_WAIT_V(8); PG8_WAIT_L(0); PG8_BAR; PG8_MMA(0, 0, At, B0); PG8_MMA(0, 1, At, B1); PG8_BAR; PG8_SCHED; \
            PG8_LDA(At, 1, 1); PG8_STAGE(PG8_SB(1, 0), rB, (b2) + kstep, voffB); PG8_STAGE(PG8_SB(1, 1), rB, (b2) + kstep + hstep, voffB); PG8_STAGE(PG8_SA(1, 0), rA, (a2) + kstep, cA0); \
            PG8_WAIT_V(8); PG8_WAIT_L(0); PG8_BAR; PG8_MMA(1, 0, At, B0); PG8_MMA(1, 1, At, B1); PG8_BAR; PG8_SCHED; } while (0)
    for (;;) {
        S.issue(st, ui + 1, tid);
        for (int t = 0; t < nt - 2; t += 2) {
            const unsigned a1 = (unsigned)(t + 1) * kstep, a2 = (unsigned)(t + 2) * kstep, b2 = cB + (unsigned)(t + 2) * kstep;
            PG8_PAIR(a1, a2, b2, (void)0);
        }
        const bool has_next = S.fin(st, ui + 1, nxt, tid);
        const unsigned nB = has_next ? (unsigned)nxt.brow0 * (unsigned)K * 2u : cB;
        {
            const unsigned a1 = (unsigned)(nt - 1) * kstep;
            PG8_PAIR(a1, 0u, nB, do { if (has_next) { PG8_AOFFS(nxt, cA0, cA1); } } while (0));
        }
        if (wr == 0) PG8_BAR;
        { int l2; asm volatile("v_mbcnt_lo_u32_b32 %0, -1, 0\n\tv_mbcnt_hi_u32_b32 %0, -1, %0" : "=v"(l2));
          E(acc, cur, wr, wc, l2 & 15, l2 >> 4); S.done(cur, l2); }
        if (!has_next) break;
#pragma unroll
        for (int a = 0; a < 2; ++a)
#pragma unroll
            for (int b = 0; b < 2; ++b)
#pragma unroll
                for (int m = 0; m < 4; ++m)
#pragma unroll
                    for (int n = 0; n < 2; ++n) acc[a][b][m][n] = (f32x4){0.f, 0.f, 0.f, 0.f};
        cur = nxt; cB = nB; ++ui;
        if (wr == 1) PG8_BAR;
    }
    PG8_WAIT_V(0);
    PG8_BAR;
#undef PG8_PAIR
#undef PG8_AOFFS
#undef PG8_SA
#undef PG8_SB
#undef PG8_STAGE
#undef PG8_LDA
#undef PG8_LDB
#undef PG8_MMA
#undef PG8_WAIT_V
#undef PG8_WAIT_L
#undef PG8_BAR
#undef PG8_SCHED
}
}

#define XB_TMO      128
#define XB_XCNT(j)  (256  + 64 * (j))
#define XB_XSUB(j)  (1280 + 64 * (j))
#define XB_XGEN(j)  (2304 + 64 * (j))
#define XB_TOP      3328
#define XB_TOPGEN   3392
#define XCD_BAR_WORDS 3456
#define XB_SPIN_CAP (1u << 20)
__device__ __forceinline__ unsigned xb_ld(unsigned* p)              { return __hip_atomic_load(p, __ATOMIC_RELAXED, __HIP_MEMORY_SCOPE_AGENT); }
__device__ __forceinline__ unsigned xb_add(unsigned* p, unsigned v) { return __hip_atomic_fetch_add(p, v, __ATOMIC_RELAXED, __HIP_MEMORY_SCOPE_AGENT); }
__device__ __forceinline__ unsigned xb_xcc_id() { return (unsigned)__builtin_amdgcn_s_getreg((3 << 11) | 20) & 0xFu; }
#define XB_SPIN(cond, bar) do { unsigned _sp = 0; while (cond) { __builtin_amdgcn_s_sleep(1); \
    if ((++_sp & 255u) == 0u) { if (xb_ld(&(bar)[XB_TMO])) break; if (_sp > XB_SPIN_CAP) { atomicAdd(&(bar)[XB_TMO], 1u); break; } } } } while (0)
__device__ __forceinline__ void xcd_barrier_complete(unsigned* bar, unsigned x, unsigned& nloc, unsigned& nx) {
    const unsigned G = gridDim.x;
    unsigned sum, cnt, mine, sp = 0u;
    for (;;) {
        sum = 0u; cnt = 0u; mine = 0u;
#pragma unroll
        for (unsigned j = 0; j < 16; ++j) { const unsigned c = xb_ld(&bar[XB_XCNT(j)]); sum += c; cnt += (c > 0u) ? 1u : 0u; mine = (j == x) ? c : mine; }
        if (sum == G) break;
        __builtin_amdgcn_s_sleep(1);
        if ((++sp & 255u) == 0u) { if (xb_ld(&bar[XB_TMO])) break; if (sp > XB_SPIN_CAP) { atomicAdd(&bar[XB_TMO], 1u); break; } }
    }
    nloc = mine > 0u ? mine : 1u; nx = cnt > 0u ? cnt : 1u;
}
__device__ __forceinline__ void xcd_barrier(unsigned* bar, volatile LAS unsigned* st, int wave) {
    asm volatile("s_waitcnt vmcnt(0) lgkmcnt(0)" ::: "memory");
    __syncthreads();
    int lane; asm volatile("v_mbcnt_lo_u32_b32 %0, -1, 0\n\tv_mbcnt_hi_u32_b32 %0, -1, %0" : "=v"(lane));
    if (wave == 0 && lane == 0) {
        __builtin_amdgcn_s_waitcnt(0);
        const unsigned x = xb_xcc_id();
        unsigned nloc = st[0], nx = st[1];
        if (nloc == 0u) { xcd_barrier_complete(bar, x, nloc, nx); st[0] = nloc; st[1] = nx; }
        const unsigned old = xb_add(&bar[XB_XSUB(x)], 1u);
        const unsigned gen = old / nloc;
        if (old + 1u == (gen + 1u) * nloc) {
            __builtin_amdgcn_fence(__ATOMIC_RELEASE, "agent");
            asm volatile("s_waitcnt vmcnt(0)" ::: "memory");
            const unsigned og = xb_add(&bar[XB_TOP], 1u);
            const unsigned tg = og / nx;
            if (og + 1u == (tg + 1u) * nx) xb_add(&bar[XB_TOPGEN], 1u);
            else XB_SPIN(xb_ld(&bar[XB_TOPGEN]) == tg, bar);
            __builtin_amdgcn_fence(__ATOMIC_ACQUIRE, "agent");
            xb_add(&bar[XB_XGEN(x)], 1u);
            asm volatile("s_waitcnt vmcnt(0)" ::: "memory");
        } else {
            XB_SPIN(xb_ld(&bar[XB_XGEN(x)]) == gen, bar);
            __builtin_amdgcn_fence(__ATOMIC_ACQUIRE, "agent");
            asm volatile("s_waitcnt vmcnt(0)" ::: "memory");
        }
    }
    __syncthreads();
}

struct Params {
    const float* in[18];
    float* out; unsigned char* ws;
};
enum { I_X = 0, I_EV_WIN, I_EV_CONV, I_EV_ALOG, I_EV_DTB, I_EV_GDNN, I_EV_HGRNN, I_LBLOG, I_EV_WOUT, I_OD_WIN, I_OD_WOUT, I_RW, I_RB, I_MG, I_MU, I_MD, I_LNG, I_LNB };

struct Frame {
    LAS unsigned char* lds;
    int tid, lane, wave, G, bid;
};
__device__ __forceinline__ Frame refresh(const Frame& F0) {
    Frame F = F0; int l; asm volatile("v_mbcnt_lo_u32_b32 %0, -1, 0\n\tv_mbcnt_hi_u32_b32 %0, -1, %0" : "=v"(l));
    F.lane = l; F.tid = F0.wave * 64 + l; return F;
}

constexpr size_t WS_W3 = WS_AB + 16 * MiB, WS_WOUT1 = WS_WOUT + 4 * MiB, WS_WGU1 = WS_WGU + 32 * MiB;
struct CDesc { const float* src; unsigned char* dst; int ld, Kd, fp8; };
__device__ __forceinline__ CDesc conv_desc(const Params& p, unsigned char* ws, int kind, int r) {
    CDesc d;
    switch (kind) {
    case 0: { const int kb = r / 256, nb = r % 256, n0 = nb * 32; const int c0 = n0 < 4096 ? n0 : n0 + 16;
        d.src = p.in[I_EV_WIN] + (size_t)(kb * 64) * EVEN_IN + c0; d.ld = EVEN_IN; d.dst = ws + WS_WIN + (size_t)n0 * 2048 + kb * 64; d.Kd = 2048; d.fp8 = 1; break; }
    case 1: { const int kb = r / 64, nb = r % 64; d.src = p.in[I_EV_WOUT] + (size_t)(kb * 64) * 2048 + nb * 32; d.ld = 2048; d.dst = ws + WS_WOUT + (size_t)(nb * 32) * 2048 + kb * 64; d.Kd = 2048; d.fp8 = 1; break; }
    case 2: case 6: { const int layer = kind == 6; const int isup = r >= 8192; if (isup) r -= 8192;
        const int e = r / 512, q = r % 512, kb = q / 16, nb = q % 16, f0 = nb * 32;
        d.src = (isup ? p.in[I_MU] : p.in[I_MG]) + (size_t)(layer * NE + e) * 2048 * 512 + (size_t)(kb * 64) * 512 + f0; d.ld = 512;
        d.dst = ws + (layer ? WS_WGU1 : WS_WGU) + (size_t)e * 1024 * 2048 + (size_t)(256 * (f0 >> 7) + 128 * isup + (f0 & 127)) * 2048 + kb * 64; d.Kd = 2048; d.fp8 = 1; break; }
    case 3: case 7: { const int layer = kind == 7; const int e = r / 512, q = r % 512, kb = q / 64, nb = q % 64;
        d.src = p.in[I_MD] + (size_t)(layer * NE + e) * 512 * 2048 + (size_t)(kb * 64) * 2048 + nb * 32; d.ld = 2048;
        d.dst = ws + WS_WD + ((size_t)e * 2048 * 512 + (size_t)(nb * 32) * 512 + kb * 64) * 2; d.Kd = 512; d.fp8 = 0; break; }
    case 4: { const int kb = r / 192, nb = r % 192; d.src = p.in[I_OD_WIN] + (size_t)(kb * 64) * ODD_IN + nb * 32; d.ld = ODD_IN; d.dst = ws + WS_W3 + (size_t)(nb * 32) * 2048 + kb * 64; d.Kd = 2048; d.fp8 = 1; break; }
    default: { const int kb = r / 64, nb = r % 64; d.src = p.in[I_OD_WOUT] + (size_t)(kb * 64) * 2048 + nb * 32; d.ld = 2048; d.dst = ws + WS_WOUT1 + (size_t)(nb * 32) * 1024 + kb * 64; d.Kd = 1024; d.fp8 = 1; break; }
    }
    return d;
}
__device__ __forceinline__ void conv_load(const CDesc& d, int lane, float (&wv)[32]) {
    const float* wp = d.src + (size_t)(lane >> 5) * d.ld + (lane & 31);
#pragma unroll
    for (int i = 0; i < 32; ++i) wv[i] = __builtin_nontemporal_load(wp + (size_t)(2 * i) * d.ld);
}
__device__ __forceinline__ void conv_store(const CDesc& d, int lane, const float (&wv)[32], LAS float* scr) {
#pragma unroll
    for (int i = 0; i < 32; ++i) scr[(2 * i + (lane >> 5)) * 33 + (lane & 31)] = wv[i];
    LDS_WAIT(); asm volatile("" ::: "memory");
    if (d.fp8) {
        const int c = lane & 3;
#pragma unroll
        for (int j = 0; j < 2; ++j) { const int n = (lane >> 2) + 16 * j; const LAS float* sp = scr + (16 * c) * 33 + n;
            u32x4 o;
            o.x = pk4_fp8(sp[0 * 33] * W_PRE, sp[1 * 33] * W_PRE, sp[2 * 33] * W_PRE, sp[3 * 33] * W_PRE);     o.y = pk4_fp8(sp[4 * 33] * W_PRE, sp[5 * 33] * W_PRE, sp[6 * 33] * W_PRE, sp[7 * 33] * W_PRE);
            o.z = pk4_fp8(sp[8 * 33] * W_PRE, sp[9 * 33] * W_PRE, sp[10 * 33] * W_PRE, sp[11 * 33] * W_PRE);   o.w = pk4_fp8(sp[12 * 33] * W_PRE, sp[13 * 33] * W_PRE, sp[14 * 33] * W_PRE, sp[15 * 33] * W_PRE);
            *(u32x4*)(d.dst + (size_t)n * d.Kd + 16 * c) = o; }
    } else {
        const int c = lane & 7;
#pragma unroll
        for (int j = 0; j < 4; ++j) { const int n = (lane >> 3) + 8 * j; const LAS float* sp = scr + (8 * c) * 33 + n;
            u32x4 o; o.x = pk2(sp[0 * 33], sp[1 * 33]); o.y = pk2(sp[2 * 33], sp[3 * 33]); o.z = pk2(sp[4 * 33], sp[5 * 33]); o.w = pk2(sp[6 * 33], sp[7 * 33]);
            *(u32x4*)(d.dst + ((size_t)n * d.Kd + 8 * c) * 2) = o; }
    }
    LDS_WAIT(); asm volatile("" ::: "memory");
}
__device__ __forceinline__ CDesc conv_item(const Params& p, unsigned char* ws, int set, int it) {
    if (set == 0) return it < 8192 ? conv_desc(p, ws, 0, it) : conv_desc(p, ws, 1, it - 8192);
    if (set == 1) { int r = it;
        if (r < 16384) return conv_desc(p, ws, 2, r); r -= 16384;
        if (r < 8192) return conv_desc(p, ws, 3, r); r -= 8192;
        if (r < 6144) return conv_desc(p, ws, 4, r); r -= 6144;
        if (r < 1024) return conv_desc(p, ws, 5, r); r -= 1024;
        return conv_desc(p, ws, 6, r); }
    return conv_desc(p, ws, 7, it);
}
__device__ __forceinline__ void convert_set(const Params& p, const Frame& F0, int set, int w, int nw) {
    const Frame F = refresh(F0);
    LAS float* scr = (LAS float*)(F.lds + F.wave * 16384);
    unsigned char* ws = opq(p.ws);
    const int N = set == 0 ? 8192 + 2048 : set == 1 ? 16384 + 8192 + 6144 + 1024 + 16384 : 8192;
    for (int it = w; it < N; it += 2 * nw) {
        const bool two = it + nw < N;
        const CDesc d0 = conv_item(p, ws, set, it), d1 = conv_item(p, ws, set, two ? it + nw : it);
        float v0[32], v1[32];
        conv_load(d0, F.lane, v0); if (two) conv_load(d1, F.lane, v1);
        conv_store(d0, F.lane, v0, scr); if (two) conv_store(d1, F.lane, v1, scr);
    }
}

__device__ __forceinline__ void load_w16_lds(const Frame& F0, const float* W, int ld, int c0) {
    const Frame F = refresh(F0);
    LAS float* l = (LAS float*)F.lds;
    for (int i = F.tid; i < 2048 * 16; i += NTHR) { const int k = i >> 4, e = i & 15; l[e * 2048 + k] = W[(size_t)k * ld + c0 + e]; }
}
__device__ __forceinline__ float dot16(const Frame& F, const f32x4 (&v)[8]) {
    const LAS f32x4* l = (const LAS f32x4*)F.lds;
    float res = 0.f;
#pragma unroll 1
    for (int e = 0; e < 16; ++e) { float s = 0.f;
#pragma unroll
        for (int j = 0; j < 8; ++j) { const f32x4 w = l[e * 512 + 64 * j + F.lane]; s += (v[j].x * w.x + v[j].y * w.y) + (v[j].z * w.z + v[j].w * w.w); }
        s = wave_sum(s); res = (F.lane == e) ? s : res; }
    return res;
}

__device__ __forceinline__ void p0_xpass(const Params& p, const Frame& F0) {
    const Frame F = refresh(F0);
    const int gw = F.bid * NWAVES + F.wave, NGW = F.G * NWAVES;
    float* BA = (float*)(opq(p.ws) + WS_BA); bf16_t* AB = (bf16_t*)(opq(p.ws) + WS_AB);
    for (int m = gw; m < T; m += NGW) {
        const f32x4* xr = (const f32x4*)(p.in[I_X] + (size_t)m * D) + F.lane;
        f32x4 v[8];
#pragma unroll
        for (int j = 0; j < 8; ++j) v[j] = xr[64 * j];
        unsigned* o = (unsigned*)((unsigned char*)AB + (size_t)m * D) + F.lane;
#pragma unroll
        for (int j = 0; j < 8; ++j) o[64 * j] = pk4_fp8(v[j].x * X_PRE, v[j].y * X_PRE, v[j].z * X_PRE, v[j].w * X_PRE);
        const float a = dot16(F, v);
        if (F.lane < 16) BA[(size_t)m * 16 + F.lane] = a;
    }
}

constexpr size_t WS_R16A = WS_OC + 16 * MiB, WS_R16B = WS_SCR + 190 * MiB;
__device__ __forceinline__ bf16_t* r16_row(unsigned char* ws, int m) { return (bf16_t*)(ws + (m < T / 2 ? WS_R16A + (size_t)m * D * 2 : WS_R16B + (size_t)(m - T / 2) * D * 2)); }
template <bool ROUTE, bool TWO, bool RES16, bool OUT16>
__device__ __forceinline__ void ln_pass(const Params& p, const Frame& F0, const float* resid, const bf16_t* add1, int ld1, const bf16_t* add2, const float* gain, const float* bias,
                                        float* outf, bf16_t* outb, int layer) {
    const Frame F = refresh(F0);
    const int TPB = (T + F.G - 1) / F.G;
    const int mbeg = ROUTE ? F.bid * TPB + F.wave : F.bid * NWAVES + F.wave, mend = ROUTE ? min(T, (F.bid + 1) * TPB) : T, mstep = ROUTE ? NWAVES : F.G * NWAVES;
    int* SEL = (int*)(opq(p.ws) + WS_CTL + 65536);
    int* HIST = (int*)(opq(p.ws) + WS_CTL + 32768);
    LAS int* lhist = (LAS int*)(F.lds + pg8::MOE_HIST_OFF);
    float* gatew = (float*)(opq(p.ws) + WS_GATEW) + (size_t)layer * 2 * T;
    if (ROUTE) { if (F.tid < NE) lhist[F.tid] = 0; __syncthreads(); }
    f32x4 gn[8], bs[8];
#pragma unroll
    for (int j = 0; j < 8; ++j) { gn[j] = ((const f32x4*)gain)[64 * j + F.lane]; bs[j] = ((const f32x4*)bias)[64 * j + F.lane]; }
    for (int m = mbeg; m < mend; m += mstep) {
        const f32x4* xr = (const f32x4*)(resid + (size_t)m * D) + F.lane;
        const u32x2* xr16 = (const u32x2*)r16_row(opq(p.ws), m) + F.lane;
        f32x4 v[8]; float s = 0.f;
#pragma unroll
        for (int j = 0; j < 8; ++j) {
            if (RES16) { const u32x2 a = xr16[64 * j]; v[j] = (f32x4){bflo(a.x), bfhi(a.x), bflo(a.y), bfhi(a.y)} * ALPHA; }
            else v[j] = xr[64 * j] * ALPHA;
            if (add1) { const u32x2 a = ((const u32x2*)(add1 + (size_t)(TWO ? 2 * m : m) * ld1))[64 * j + F.lane]; v[j].x += bflo(a.x); v[j].y += bfhi(a.x); v[j].z += bflo(a.y); v[j].w += bfhi(a.y); }
            if (TWO) { const u32x2 a = ((const u32x2*)(add2 + (size_t)(2 * m + 1) * ld1))[64 * j + F.lane]; v[j].x += bflo(a.x); v[j].y += bfhi(a.x); v[j].z += bflo(a.y); v[j].w += bfhi(a.y); }
#ifdef DBG_SANITIZE
            if (!(fabsf(v[j].x) < 1e30f)) v[j].x = 0.f; if (!(fabsf(v[j].y) < 1e30f)) v[j].y = 0.f; if (!(fabsf(v[j].z) < 1e30f)) v[j].z = 0.f; if (!(fabsf(v[j].w) < 1e30f)) v[j].w = 0.f;
#endif
            s += (v[j].x + v[j].y) + (v[j].z + v[j].w);
        }
        const float mean = wave_sum(s) * (1.f / D); float s2 = 0.f;
#pragma unroll
        for (int j = 0; j < 8; ++j) { v[j] = v[j] - mean; s2 += (v[j].x * v[j].x + v[j].y * v[j].y) + (v[j].z * v[j].z + v[j].w * v[j].w); }
        const float rstd = 1.f / sqrtf(wave_sum(s2) * (1.f / D) + LN_EPS);
#pragma unroll
        for (int j = 0; j < 8; ++j) v[j] = v[j] * rstd * gn[j] + bs[j];
        if (OUT16) { u32x2* of = (u32x2*)r16_row(opq(p.ws), m) + F.lane;
#pragma unroll
            for (int j = 0; j < 8; ++j) { u32x2 w; w.x = pk2(v[j].x, v[j].y); w.y = pk2(v[j].z, v[j].w); of[64 * j] = w; } }
        else { f32x4* of = (f32x4*)(outf + (size_t)m * D) + F.lane;
#pragma unroll
            for (int j = 0; j < 8; ++j) of[64 * j] = v[j]; }
        if (outb) {
            { unsigned* o = (unsigned*)((unsigned char*)outb + (size_t)m * D) + F.lane;
#pragma unroll
                for (int j = 0; j < 8; ++j) o[64 * j] = pk4_fp8(v[j].x, v[j].y, v[j].z, v[j].w); } }
        if (ROUTE) {
            const float lgl = dot16(F, v);
            const float scl = 1.0f / (1.0f + expf(-lgl)), bil = scl + p.in[I_RB][F.lane & 15];
            float sc[16], bi[16];
#pragma unroll
            for (int e = 0; e < 16; ++e) { sc[e] = __builtin_bit_cast(float, __builtin_amdgcn_readlane(__builtin_bit_cast(int, scl), e)); bi[e] = __builtin_bit_cast(float, __builtin_amdgcn_readlane(__builtin_bit_cast(int, bil), e)); }
            int bg = 0; float bgs = -3.0e38f;
#pragma unroll
            for (int g = 0; g < 4; ++g) { float m1 = -3.0e38f, m2 = -3.0e38f;
#pragma unroll
                for (int k = 0; k < 4; ++k) { const float x = bi[4 * g + k]; if (x > m1) { m2 = m1; m1 = x; } else if (x > m2) m2 = x; }
                const float gs = m1 + m2; if (gs > bgs) { bgs = gs; bg = g; } }
            int i1 = 0, i2 = 0; float b1 = -3.0e38f, b2 = -3.0e38f, s1 = 0.f, s2v = 0.f;
#pragma unroll
            for (int e = 0; e < 16; ++e) { if ((e >> 2) == bg) { const float x = bi[e]; if (x > b1) { b2 = b1; i2 = i1; s2v = s1; b1 = x; i1 = e; s1 = sc[e]; } else if (x > b2) { b2 = x; i2 = e; s2v = sc[e]; } } }
            if (F.lane == 0) {
                const float den = s1 + s2v;
                SEL[m] = i1 | (i2 << 8); gatew[2 * m] = s1 / den; gatew[2 * m + 1] = s2v / den;
                __hip_atomic_fetch_add(lhist + i1, 1, __ATOMIC_RELAXED, __HIP_MEMORY_SCOPE_WORKGROUP); __hip_atomic_fetch_add(lhist + i2, 1, __ATOMIC_RELAXED, __HIP_MEMORY_SCOPE_WORKGROUP);
            }
        }
    }
    if (ROUTE) { __syncthreads(); if (F.tid < NE) HIST[F.bid * NE + F.tid] = lhist[F.tid]; }
}

__device__ __forceinline__ void moe_lists(const Params& p, const Frame& F0, int layer) {
    const Frame F = refresh(F0);
    const int* SEL = (const int*)(opq(p.ws) + WS_CTL + 65536);
    const int* HIST = (const int*)(opq(p.ws) + WS_CTL + 32768);
    int* list = (int*)(opq(p.ws) + WS_LIST) + (size_t)layer * NE * T;
    LAS int* ltot = (LAS int*)(F.lds + pg8::MOE_HIST_OFF) + 16;
    LAS int* lbase = (LAS int*)(F.lds + pg8::MOE_HIST_OFF) + 32;
    if (F.tid < NE) { ltot[F.tid] = 0; lbase[F.tid] = 0; }
    __syncthreads();
    { const int e = F.tid & 15, grp = F.tid >> 4; int base = 0, tot = 0;
#pragma unroll 8
      for (int b = grp; b < F.G; b += 32) { const int h = HIST[b * NE + e]; tot += h; if (b < F.bid) base += h; }
      __hip_atomic_fetch_add(ltot + e, tot, __ATOMIC_RELAXED, __HIP_MEMORY_SCOPE_WORKGROUP); __hip_atomic_fetch_add(lbase + e, base, __ATOMIC_RELAXED, __HIP_MEMORY_SCOPE_WORKGROUP); }
    __syncthreads();
    LAS int* ltpre = (LAS int*)(F.lds + pg8::MOE_HIST_OFF) + 48;
    LAS int* lslot = (LAS int*)(F.lds + pg8::MOE_HIST_OFF) + 64;
    if (F.tid == 0) { int sacc = 0;
#pragma unroll 1
        for (int e = 0; e < NE; ++e) { ltpre[e] = sacc; sacc += (ltot[e] + 255) >> 8; } }
    __syncthreads();
    const int TPB = (T + F.G - 1) / F.G, m0 = F.bid * TPB, m1 = min(T, m0 + TPB);
    if (F.wave == 0) {
        for (int q0 = 2 * m0; q0 < 2 * m1; q0 += 64) {
            const int q = q0 + F.lane; const bool ok = q < 2 * m1;
            int e = -1; if (ok) { const int sv = SEL[q >> 1]; e = (q & 1) ? ((sv >> 8) & 255) : (sv & 255); }
            int rank = 0, cntsame = 0;
#pragma unroll 1
            for (int k = 0; k < NE; ++k) { const unsigned long long bal = __ballot(e == k); if (e == k) { rank = __popcll(bal & ((1ull << F.lane) - 1ull)); cntsame = __popcll(bal); } }
            if (ok) { const int pos = lbase[e] + rank; list[e * T + pos] = q; lslot[q - 2 * m0] = 256 * ltpre[e] + pos; }
            __builtin_amdgcn_s_waitcnt(0);
            if (ok && rank == cntsame - 1) lbase[e] += cntsame;
            __builtin_amdgcn_s_waitcnt(0);
        }
    }
    __syncthreads();
    {
        const unsigned char* AB8 = opq(p.ws) + WS_AB; unsigned char* ABS = opq(p.ws) + WS_ABS;
        const int nt_ = m1 - m0;
        for (int t0 = F.wave; t0 < nt_; t0 += 4 * NWAVES) {
            u32x4 r0[4], r1[4];
#pragma unroll
            for (int k = 0; k < 4; ++k) { const int tt = t0 + k * NWAVES; if (tt < nt_) { const u32x4* src = (const u32x4*)(AB8 + (size_t)(m0 + tt) * D) + F.lane; r0[k] = src[0]; r1[k] = src[64]; } }
#pragma unroll
            for (int k = 0; k < 4; ++k) { const int tt = t0 + k * NWAVES; if (tt < nt_) {
#pragma unroll
                for (int jj = 0; jj < 2; ++jj) { u32x4* dst = (u32x4*)(ABS + (size_t)lslot[2 * tt + jj] * D) + F.lane; dst[0] = r0[k]; dst[64] = r1[k]; } } }
        }
    }
}

constexpr int H1LD = 8192, C_ZA = 3072, C_QB = 4096, C_FB = 5120, C_IB = 6144, C_GB = 7168;
constexpr size_t G_U0 = 0;
constexpr size_t G_WM = 32 * MiB;
constexpr size_t G_QD = 48 * MiB;
constexpr size_t G_KDT = 64 * MiB;
constexpr size_t G_QK = 80 * MiB;
constexpr size_t G_CD = 88 * MiB;
constexpr size_t H_QD = 89 * MiB;
constexpr size_t H_KI = 105 * MiB;
constexpr size_t H_KDT = 121 * MiB;
constexpr size_t H_IT = 137 * MiB;
constexpr size_t H_CD = 153 * MiB;
constexpr size_t O_A = 155 * MiB;
constexpr size_t O_B = 171 * MiB;
static_assert(O_B + 16 * MiB <= 216 * MiB, "mixer-0 scratch");

__device__ __forceinline__ f32x4 mfma32(bf16x8 a, bf16x8 b, f32x4 c) { return __builtin_amdgcn_mfma_f32_16x16x32_bf16(a, b, c, 0, 0, 0); }
__device__ __forceinline__ f32x4 mfma16(bf16x4 a, bf16x4 b, f32x4 c) { const bf16x8 a8 = {a[0], a[1], a[2], a[3], 0, 0, 0, 0}, b8 = {b[0], b[1], b[2], b[3], 0, 0, 0, 0}; return __builtin_amdgcn_mfma_f32_16x16x32_bf16(a8, b8, c, 0, 0, 0); }
__device__ __forceinline__ bf16x8 pack8(f32x4 lo, f32x4 hi) {
    u32x4 w; w.x = cvt_pk_bf16(lo[0], lo[1]); w.y = cvt_pk_bf16(lo[2], lo[3]); w.z = cvt_pk_bf16(hi[0], hi[1]); w.w = cvt_pk_bf16(hi[2], hi[3]); return __builtin_bit_cast(bf16x8, w);
}
__device__ __forceinline__ bf16x4 pack4(f32x4 v) { u32x2 w; w.x = cvt_pk_bf16(v[0], v[1]); w.y = cvt_pk_bf16(v[2], v[3]); return __builtin_bit_cast(bf16x4, w); }
__device__ __forceinline__ bf16x8 frag_perm(const LAS bf16_t* rowp, int col) {
    const u32x2 lo = *(const LAS u32x2*)(rowp + col), hi = *(const LAS u32x2*)(rowp + col + 16);
    u32x4 w; w.x = lo.x; w.y = lo.y; w.z = hi.x; w.w = hi.y; return __builtin_bit_cast(bf16x8, w);
}

__device__ __forceinline__ void gdn_pre_pair(const Params& p, const Frame& F, int unit0, int unit1) {
    const int hb = F.wave >> 2, w4 = F.wave & 3, t8 = F.tid & 255, lane = F.lane, fr = lane & 15, g = lane >> 4;
    const int unit = hb ? unit1 : unit0;
    const bool active = unit < 1024;
    const int bh = unit >> 5, ci = unit & 31, b = bh >> 3, h = bh & 7;
    const int tok0 = b * SEQ + ci * 64;
    LAS unsigned char* hl = F.lds + hb * 72192;
    LAS bf16_t* Qb = (LAS bf16_t*)(hl);
    LAS bf16_t* Kb = (LAS bf16_t*)(hl + 17408);
    LAS bf16_t* RVt = (LAS bf16_t*)(hl + 34816);
    LAS bf16_t* RKt = (LAS bf16_t*)(hl + 53248);
    LAS float* sc_g = (LAS float*)(hl + 71680);
    LAS float* sc_b = sc_g + 64;
    LAS float* Lm = (LAS float*)(hl);
    LAS bf16_t* Tb = (LAS bf16_t*)(hl + 17408);
    const bf16_t* H1 = (const bf16_t*)(opq(p.ws) + WS_H1);
    const float* BA = (const float*)(opq(p.ws) + WS_BA);
    unsigned char* scr = opq(p.ws) + WS_SCR;
    if (active) {
        if (t8 < 192) {
            const int sec = t8 >> 6, c2 = (t8 & 63) * 2;
            const int col = sec * 1024 + h * 128 + c2;
            const float* cw = p.in[I_EV_CONV] + col;
            const float w0a = cw[0], w0b = cw[1], w1a = cw[3072], w1b = cw[3073], w2a = cw[6144], w2b = cw[6145], w3a = cw[9216], w3b = cw[9217];
            float xa[3], xb[3];
#pragma unroll
            for (int k = 0; k < 3; ++k) { const int s = ci * 64 - 3 + k; unsigned v = 0u; if (s >= 0) v = *(const unsigned*)(H1 + (size_t)(b * SEQ + s) * H1LD + col); xa[k] = bflo(v); xb[k] = bfhi(v); }
#pragma unroll 1
            for (int q2 = 0; q2 < 2; ++q2) {
                unsigned vv[32];
#pragma unroll
                for (int tl = 0; tl < 32; ++tl) vv[tl] = *(const unsigned*)(H1 + (size_t)(tok0 + 32 * q2 + tl) * H1LD + col);
#pragma unroll
                for (int t2 = 0; t2 < 32; ++t2) {
                    const int tl = 32 * q2 + t2;
                    const float x3a = bflo(vv[t2]), x3b = bfhi(vv[t2]);
                    float ya = w0a * xa[0] + w1a * xa[1] + w2a * xa[2] + w3a * x3a, yb = w0b * xb[0] + w1b * xb[1] + w2b * xb[2] + w3b * x3b;
                    xa[0] = xa[1]; xa[1] = xa[2]; xa[2] = x3a; xb[0] = xb[1]; xb[1] = xb[2]; xb[2] = x3b;
                    ya = siluf_(ya); yb = siluf_(yb);
                    if (sec == 0) *(LAS unsigned*)(Qb + tl * 136 + c2) = pk2(ya, yb);
                    else if (sec == 1) *(LAS unsigned*)(Kb + tl * 136 + c2) = pk2(ya, yb);
                    else { const float be = sigmoidf_(BA[(size_t)(tok0 + tl) * 16 + h]); RVt[c2 * 72 + tl] = (bf16_t)f2bf(ya * be); RVt[(c2 + 1) * 72 + tl] = (bf16_t)f2bf(yb * be); }
                }
            }
        } else {
            const int t = tok0 + lane;
            const float ba = BA[(size_t)t * 16 + h], aa = BA[(size_t)t * 16 + 8 + h];
            const float xx = aa + p.in[I_EV_DTB][h];
            const float sp = xx > 20.f ? xx : log1pf(expf(xx));
            float gg = -expf(p.in[I_EV_ALOG][h]) * sp;
            gg += dpp_f<0x111>(gg); gg += dpp_f<0x112>(gg); gg += dpp_f<0x114>(gg); gg += dpp_f<0x118>(gg);
            { const float t0 = __builtin_bit_cast(float, __builtin_amdgcn_readlane(__builtin_bit_cast(int, gg), 15)), t1 = __builtin_bit_cast(float, __builtin_amdgcn_readlane(__builtin_bit_cast(int, gg), 31)),
                          t2 = __builtin_bit_cast(float, __builtin_amdgcn_readlane(__builtin_bit_cast(int, gg), 47));
              gg += (lane >= 16 ? t0 : 0.f) + (lane >= 32 ? t1 : 0.f) + (lane >= 48 ? t2 : 0.f); }
            sc_g[lane] = gg; sc_b[lane] = sigmoidf_(ba);
        }
    }
    __syncthreads();
    if (active) {
        bf16_t* QDg = (bf16_t*)(scr + G_QD) + (size_t)unit * 64 * 128;
#pragma unroll 2
        for (int rr = 0; rr < 16; ++rr) {
            const int r = w4 * 16 + rr;
            const unsigned qv = *(const LAS unsigned*)(Qb + r * 136 + 2 * lane), kv = *(const LAS unsigned*)(Kb + r * 136 + 2 * lane);
            const float q0 = bflo(qv), q1 = bfhi(qv), k0 = bflo(kv), k1 = bfhi(kv);
            const float sq = wave_sum(q0 * q0 + q1 * q1), sk = wave_sum(k0 * k0 + k1 * k1);
            const float rq = rsqrtf(sq + RMS_EPS) * 0.08838834764831845f, rk = rsqrtf(sk + RMS_EPS);
            const float gc = sc_g[r], be = sc_b[r], eg = expf(gc);
            const float qn0 = q0 * rq, qn1 = q1 * rq, kn0 = k0 * rk, kn1 = k1 * rk;
            *(LAS unsigned*)(Qb + r * 136 + 2 * lane) = pk2(qn0, qn1);
            *(LAS unsigned*)(Kb + r * 136 + 2 * lane) = pk2(kn0, kn1);
            RKt[(2 * lane) * 72 + r] = (bf16_t)f2bf(kn0 * be * eg); RKt[(2 * lane + 1) * 72 + r] = (bf16_t)f2bf(kn1 * be * eg);
            *(unsigned*)(QDg + r * 128 + 2 * lane) = pk2(qn0 * eg, qn1 * eg);
        }
    }
    __syncthreads();
    f32x4 kk[4];
    if (active) {
        {
            bf16_t* KDt = (bf16_t*)(scr + G_KDT) + (size_t)unit * 128 * 64;
            const float gl = sc_g[63];
#pragma unroll
            for (int it = 0; it < 4; ++it) { const int idx = t8 + 256 * it, f = idx >> 3, c0 = (idx & 7) * 8;
                float v[8];
#pragma unroll
                for (int i = 0; i < 8; ++i) v[i] = bf2f(Kb[(c0 + i) * 136 + f]) * expf(gl - sc_g[c0 + i]);
                u32x4 w; w.x = pk2(v[0], v[1]); w.y = pk2(v[2], v[3]); w.z = pk2(v[4], v[5]); w.w = pk2(v[6], v[7]);
                *(u32x4*)(KDt + f * 64 + c0) = w; }
        }
        const int mt = w4;
        bf16_t* QKm = (bf16_t*)(scr + G_QK) + (size_t)unit * 64 * 64;
        bf16x8 a[4];
#pragma unroll
        for (int kb = 0; kb < 4; ++kb) a[kb] = *(const LAS bf16x8*)(Kb + (16 * mt + fr) * 136 + 32 * kb + 8 * g);
#pragma unroll
        for (int nt = 0; nt < 4; ++nt) {
            f32x4 c = (f32x4){0.f, 0.f, 0.f, 0.f}, c2 = (f32x4){0.f, 0.f, 0.f, 0.f};
#pragma unroll
            for (int kb = 0; kb < 4; ++kb) { const bf16x8 bq = *(const LAS bf16x8*)(Qb + (16 * nt + fr) * 136 + 32 * kb + 8 * g), bk = *(const LAS bf16x8*)(Kb + (16 * nt + fr) * 136 + 32 * kb + 8 * g);
                c = mfma32(a[kb], bq, c); c2 = mfma32(a[kb], bk, c2); }
            const int cj = 16 * nt + fr; const float gcol = sc_g[cj];
            {
                float v[4];
#pragma unroll
                for (int r = 0; r < 4; ++r) { const int j = 16 * mt + 4 * g + r; v[r] = (cj >= j) ? expf(gcol - sc_g[j]) * c[r] : 0.f; }
                u32x2 w; w.x = pk2(v[0], v[1]); w.y = pk2(v[2], v[3]);
                *(u32x2*)(QKm + cj * 64 + 16 * mt + 4 * g) = w;
            }
#pragma unroll
            for (int r = 0; r < 4; ++r) { const int i = 16 * mt + 4 * g + r; kk[nt][r] = (i > cj) ? sc_b[i] * expf(sc_g[i] - gcol) * c2[r] : 0.f; }
        }
    }
    __syncthreads();
    if (active) {
#pragma unroll
        for (int nt = 0; nt < 4; ++nt)
#pragma unroll
            for (int r = 0; r < 4; ++r) Lm[(16 * w4 + 4 * g + r) * 68 + 16 * nt + fr] = kk[nt][r];
    }
    __syncthreads();
    if (active && w4 == 0) {
        float t[64];
#pragma unroll
        for (int i = 0; i < 64; ++i) t[i] = 0.f;
#pragma unroll
        for (int i = 0; i < 64; ++i) {
            float a0 = (i == lane) ? 1.f : 0.f, a1 = 0.f, a2 = 0.f, a3 = 0.f;
#pragma unroll
            for (int jj = 0; jj < (i + 3) / 4; ++jj) { const f32x4 lv = *(const LAS f32x4*)(Lm + i * 68 + 4 * jj);
                a0 -= lv[0] * t[4 * jj]; a1 -= lv[1] * t[4 * jj + 1]; a2 -= lv[2] * t[4 * jj + 2]; a3 -= lv[3] * t[4 * jj + 3]; }
            t[i] = (a0 + a1) + (a2 + a3);
        }
#pragma unroll
        for (int i = 0; i < 64; ++i) Tb[i * 72 + lane] = (bf16_t)f2bf(t[i]);
    }
    __syncthreads();
    if (active) {
        f32x4* U0f = (f32x4*)(scr + G_U0) + (size_t)unit * 8 * 4 * 64;
        bf16_t* Wm = (bf16_t*)(scr + G_WM) + (size_t)unit * 64 * 128;
#pragma unroll
        for (int hh = 0; hh < 2; ++hh) {
            const int ct = w4 + 4 * hh;
            bf16x8 bv[2], ak[2];
#pragma unroll
            for (int k = 0; k < 2; ++k) { bv[k] = *(const LAS bf16x8*)(RVt + (16 * ct + fr) * 72 + 32 * k + 8 * g); ak[k] = *(const LAS bf16x8*)(RKt + (16 * ct + fr) * 72 + 32 * k + 8 * g); }
#pragma unroll
            for (int mt = 0; mt < 4; ++mt) {
                f32x4 c = (f32x4){0.f, 0.f, 0.f, 0.f}, c2 = (f32x4){0.f, 0.f, 0.f, 0.f};
#pragma unroll
                for (int k = 0; k < 2; ++k) { const bf16x8 tt = *(const LAS bf16x8*)(Tb + (16 * mt + fr) * 72 + 32 * k + 8 * g); c = mfma32(tt, bv[k], c); c2 = mfma32(ak[k], tt, c2); }
                U0f[(ct * 4 + mt) * 64 + lane] = c;
                u32x2 w; w.x = pk2(-c2[0], -c2[1]); w.y = pk2(-c2[2], -c2[3]);
                *(u32x2*)(Wm + (16 * mt + fr) * 128 + 16 * ct + 4 * g) = w;
            }
        }
        if (t8 == 0) ((float*)(scr + G_CD))[unit] = expf(sc_g[63]);
    }
    __syncthreads();
}

__device__ __forceinline__ void hgrn_pre_unit(const Params& p, const Frame& F, int tc) {
    const int col = 2 * F.tid, h = col >> 7, f = col & 127;
    const float* lbl = p.in[I_LBLOG];
    float lb[2];
#pragma unroll
    for (int k = 0; k < 2; ++k) { const float l0 = lbl[col + k], l1 = lbl[1024 + col + k], l2 = lbl[2048 + col + k]; const float m = fmaxf(l0, fmaxf(l1, l2));
        const float e0 = expf(l0 - m), e1 = expf(l1 - m), e2 = expf(l2 - m); lb[k] = e0 / (e0 + e1 + e2); }
    const int t0 = tc * 16, b = t0 / SEQ, chunk = (t0 % SEQ) >> 4, bh = b * 8 + h;
    const bf16_t* H1 = (const bf16_t*)(opq(p.ws) + WS_H1);
    unsigned char* scr = opq(p.ws) + WS_SCR;
    float bc0[16], bc1[16], kk0[16], kk1[16]; unsigned iv[16];
    float cum0 = 0.f, cum1 = 0.f;
#pragma unroll
    for (int c = 0; c < 16; ++c) {
        const size_t row = (size_t)(t0 + c);
        const unsigned qv = *(const unsigned*)(H1 + row * H1LD + C_QB + col), fv = *(const unsigned*)(H1 + row * H1LD + C_FB + col);
        iv[c] = *(const unsigned*)(H1 + row * H1LD + C_IB + col);
        const float f0 = lb[0] + (1.f - lb[0]) * sigmoidf_(bflo(fv)), f1 = lb[1] + (1.f - lb[1]) * sigmoidf_(bfhi(fv));
        cum0 += logf(f0); cum1 += logf(f1);
        bc0[c] = cum0; bc1[c] = cum1; kk0[c] = 1.f - f0; kk1[c] = 1.f - f1;
        *(unsigned*)((bf16_t*)(scr + H_QD) + row * 1024 + col) = pk2(bflo(qv) * expf(cum0), bfhi(qv) * expf(cum1));
        *(unsigned*)((bf16_t*)(scr + H_KI) + row * 1024 + col) = pk2(kk0[c] * expf(-cum0), kk1[c] * expf(-cum1));
    }
    unsigned kd0[8], kd1[8], i0[8], i1[8];
#pragma unroll
    for (int c = 0; c < 16; c += 2) {
        kd0[c >> 1] = pk2(kk0[c] * expf(cum0 - bc0[c]), kk0[c + 1] * expf(cum0 - bc0[c + 1]));
        kd1[c >> 1] = pk2(kk1[c] * expf(cum1 - bc1[c]), kk1[c + 1] * expf(cum1 - bc1[c + 1]));
        i0[c >> 1] = (iv[c] & 0xffffu) | (iv[c + 1] << 16);
        i1[c >> 1] = (iv[c] >> 16) | (iv[c + 1] & 0xffff0000u);
    }
    const size_t base = ((size_t)(bh * 128 + chunk) * 128 + f) * 16;
    u32x4* kd = (u32x4*)((bf16_t*)(scr + H_KDT) + base); u32x4* it = (u32x4*)((bf16_t*)(scr + H_IT) + base);
    kd[0] = (u32x4){kd0[0], kd0[1], kd0[2], kd0[3]}; kd[1] = (u32x4){kd0[4], kd0[5], kd0[6], kd0[7]};
    kd[2] = (u32x4){kd1[0], kd1[1], kd1[2], kd1[3]}; kd[3] = (u32x4){kd1[4], kd1[5], kd1[6], kd1[7]};
    it[0] = (u32x4){i0[0], i0[1], i0[2], i0[3]}; it[1] = (u32x4){i0[4], i0[5], i0[6], i0[7]};
    it[2] = (u32x4){i1[0], i1[1], i1[2], i1[3]}; it[3] = (u32x4){i1[4], i1[5], i1[6], i1[7]};
    *(f32x2*)((float*)(scr + H_CD) + (size_t)(bh * 128 + chunk) * 128 + f) = (f32x2){expf(cum0), expf(cum1)};
}

__device__ __forceinline__ void p2_pre(const Params& p, const Frame& F0) {
    const Frame F = refresh(F0);
    for (int u = F.bid; u < 1024; u += 2 * F.G) gdn_pre_pair(p, F, u, u + F.G);
    for (int u = F.bid; u < 512; u += F.G) hgrn_pre_unit(p, F, u);
}

__device__ __forceinline__ void gdn_scan(const Params& p, const Frame& F0, int bh) {
    const Frame F = refresh(F0);
    const int lane = F.lane, fr = lane & 15, g = lane >> 4, wave = F.wave, b = bh >> 3, h = bh & 7;
    unsigned char* scr = opqg(p.ws) + WS_SCR;
    constexpr int BUFB = 62464, OFF_QD = 17408, OFF_KDT = 34816, OFF_QK = 53248;
    const bf16_t* gWM = (const bf16_t*)(scr + G_WM); const bf16_t* gQD = (const bf16_t*)(scr + G_QD);
    const bf16_t* gKDT = (const bf16_t*)(scr + G_KDT); const bf16_t* gQK = (const bf16_t*)(scr + G_QK);
    const f32x4* gU0 = (const f32x4*)(scr + G_U0); const float* gCD = (const float*)(scr + G_CD);
    bf16_t* OA = (bf16_t*)(scr + O_A);
    u32x4 rw[2], rq[2], rk[2], rqk; f32x4 u0c[4], u0n[4];
#define GS_ISSUE(u) do { _Pragma("unroll") for (int i = 0; i < 2; ++i) { const int idx = F.tid + 512 * i; \
        rw[i] = *(const u32x4*)(gWM + (size_t)(u) * 8192 + idx * 8); rq[i] = *(const u32x4*)(gQD + (size_t)(u) * 8192 + idx * 8); rk[i] = *(const u32x4*)(gKDT + (size_t)(u) * 8192 + idx * 8); } \
        rqk = *(const u32x4*)(gQK + (size_t)(u) * 4096 + F.tid * 8); \
        _Pragma("unroll") for (int mt = 0; mt < 4; ++mt) u0n[mt] = gU0[(((size_t)(u) * 8 + wave) * 4 + mt) * 64 + lane]; } while (0)
#define GS_WRITE(bufp) do { _Pragma("unroll") for (int i = 0; i < 2; ++i) { const int idx = F.tid + 512 * i; \
        *(LAS u32x4*)((bufp) + ((idx >> 4) * 136 + (idx & 15) * 8) * 2) = rw[i]; *(LAS u32x4*)((bufp) + OFF_QD + ((idx >> 4) * 136 + (idx & 15) * 8) * 2) = rq[i]; \
        *(LAS u32x4*)((bufp) + OFF_KDT + ((idx >> 3) * 72 + (idx & 7) * 8) * 2) = rk[i]; } \
        *(LAS u32x4*)((bufp) + OFF_QK + ((F.tid >> 3) * 72 + (F.tid & 7) * 8) * 2) = rqk; } while (0)
    f32x4 Sacc[8];
#pragma unroll
    for (int ft = 0; ft < 8; ++ft) Sacc[ft] = (f32x4){0.f, 0.f, 0.f, 0.f};
    GS_ISSUE(bh * 32);
    GS_WRITE(F.lds);
#pragma unroll
    for (int mt = 0; mt < 4; ++mt) u0c[mt] = u0n[mt];
    __syncthreads();
    float dec = ld_agent(gCD + bh * 32);
    for (int ci = 0; ci < 32; ++ci) {
        const int u = bh * 32 + ci;
        LAS unsigned char* buf = F.lds + (ci & 1) * BUFB;
        float decn = dec; if (ci + 1 < 32) decn = ld_agent(gCD + u + 1);
        if (ci + 1 < 32) GS_ISSUE(u + 1);
        const LAS bf16_t* WM = (const LAS bf16_t*)buf; const LAS bf16_t* QD = (const LAS bf16_t*)(buf + OFF_QD);
        const LAS bf16_t* KDT = (const LAS bf16_t*)(buf + OFF_KDT); const LAS bf16_t* QK = (const LAS bf16_t*)(buf + OFF_QK);
        bf16x8 Sbf[4];
#pragma unroll
        for (int kb = 0; kb < 4; ++kb) Sbf[kb] = pack8(Sacc[2 * kb], Sacc[2 * kb + 1]);
        f32x4 uacc[4], oacc[4];
#pragma unroll
        for (int mt = 0; mt < 4; ++mt) { uacc[mt] = u0c[mt]; oacc[mt] = (f32x4){0.f, 0.f, 0.f, 0.f}; }
        bf16x8 fa[8], fb[8];
#define GS_LD_UQ(dst, mt) do { _Pragma("unroll") for (int kb = 0; kb < 4; ++kb) { dst[kb] = frag_perm(WM + (16 * (mt) + fr) * 136, 32 * kb + 4 * g); dst[4 + kb] = frag_perm(QD + (16 * (mt) + fr) * 136, 32 * kb + 4 * g); } } while (0)
#define GS_MM_UQ(src, mt) do { _Pragma("unroll") for (int kb = 0; kb < 4; ++kb) { uacc[mt] = mfma32(src[kb], Sbf[kb], uacc[mt]); oacc[mt] = mfma32(src[4 + kb], Sbf[kb], oacc[mt]); } } while (0)
        GS_LD_UQ(fa, 0);
        GS_LD_UQ(fb, 1); __builtin_amdgcn_sched_barrier(0); GS_MM_UQ(fa, 0); __builtin_amdgcn_sched_barrier(0);
        GS_LD_UQ(fa, 2); __builtin_amdgcn_sched_barrier(0); GS_MM_UQ(fb, 1); __builtin_amdgcn_sched_barrier(0);
        GS_LD_UQ(fb, 3); __builtin_amdgcn_sched_barrier(0); GS_MM_UQ(fa, 2); __builtin_amdgcn_sched_barrier(0);
#pragma unroll
        for (int mt = 0; mt < 4; ++mt)
#pragma unroll
            for (int k = 0; k < 2; ++k) fa[2 * mt + k] = frag_perm(QK + (16 * mt + fr) * 72, 32 * k + 4 * g);
        __builtin_amdgcn_sched_barrier(0); GS_MM_UQ(fb, 3); __builtin_amdgcn_sched_barrier(0);
#undef GS_LD_UQ
#undef GS_MM_UQ
        bf16x8 ubf[2];
#pragma unroll
        for (int k = 0; k < 2; ++k) ubf[k] = pack8(uacc[2 * k], uacc[2 * k + 1]);
#pragma unroll
        for (int ft = 0; ft < 4; ++ft)
#pragma unroll
            for (int k = 0; k < 2; ++k) fb[2 * ft + k] = frag_perm(KDT + (16 * ft + fr) * 72, 32 * k + 4 * g);
        __builtin_amdgcn_sched_barrier(0);
#pragma unroll
        for (int mt = 0; mt < 4; ++mt)
#pragma unroll
            for (int k = 0; k < 2; ++k) oacc[mt] = mfma32(fa[2 * mt + k], ubf[k], oacc[mt]);
        __builtin_amdgcn_sched_barrier(0);
#pragma unroll
        for (int ft = 0; ft < 4; ++ft)
#pragma unroll
            for (int k = 0; k < 2; ++k) fa[2 * ft + k] = frag_perm(KDT + (16 * (4 + ft) + fr) * 72, 32 * k + 4 * g);
        __builtin_amdgcn_sched_barrier(0);
#pragma unroll
        for (int ft = 0; ft < 4; ++ft) {
            Sacc[ft] = Sacc[ft] * dec;
#pragma unroll
            for (int k = 0; k < 2; ++k) Sacc[ft] = mfma32(fb[2 * ft + k], ubf[k], Sacc[ft]);
        }
        __builtin_amdgcn_sched_barrier(0);
#pragma unroll
        for (int ft = 0; ft < 4; ++ft) {
            Sacc[4 + ft] = Sacc[4 + ft] * dec;
#pragma unroll
            for (int k = 0; k < 2; ++k) Sacc[4 + ft] = mfma32(fa[2 * ft + k], ubf[k], Sacc[4 + ft]);
        }
        dec = decn;
        {
            bf16_t* orow = OA + (size_t)(b * SEQ + ci * 64) * 1024 + h * 128 + 16 * wave + fr;
#pragma unroll
            for (int mt = 0; mt < 4; ++mt)
#pragma unroll
                for (int r = 0; r < 4; ++r) orow[(size_t)(16 * mt + 4 * g + r) * 1024] = (bf16_t)f2bf(oacc[mt][r]);
        }
        if (ci + 1 < 32) { GS_WRITE(F.lds + ((ci + 1) & 1) * BUFB);
#pragma unroll
            for (int mt = 0; mt < 4; ++mt) u0c[mt] = u0n[mt]; }
        asm volatile("s_waitcnt lgkmcnt(0)" ::: "memory"); __builtin_amdgcn_s_barrier();
    }
#undef GS_ISSUE
#undef GS_WRITE
}

__device__ __forceinline__ void hgrn_scan(const Params& p, const Frame& F0, int bh) {
    const Frame F = refresh(F0);
    const int lane = F.lane, fr = lane & 15, g = lane >> 4, wave = F.wave, b = bh >> 3, h = bh & 7;
    unsigned char* scr = opqg(p.ws) + WS_SCR;
    constexpr int BUFB = 61440, OFF_KI = 17408, OFF_KDT = 34816, OFF_CD = 59392;
    const bf16_t* gQD = (const bf16_t*)(scr + H_QD); const bf16_t* gKI = (const bf16_t*)(scr + H_KI);
    const bf16_t* gKDT = (const bf16_t*)(scr + H_KDT) + (size_t)bh * 128 * 128 * 16; const bf16_t* gIT = (const bf16_t*)(scr + H_IT) + (size_t)bh * 128 * 128 * 16;
    const float* gCD = (const float*)(scr + H_CD) + (size_t)bh * 128 * 128;
    bf16_t* OB = (bf16_t*)(scr + O_B);
    u32x4 rq[2], rk[2], rd[2], rc; u32x2 itn[4], itc[4];
#define HS_ISSUE(grp) do { _Pragma("unroll") for (int i = 0; i < 2; ++i) { const int idx = F.tid + 512 * i; const size_t go = (size_t)(b * SEQ + (grp) * 64 + (idx >> 4)) * 1024 + h * 128 + (idx & 15) * 8; \
        rq[i] = *(const u32x4*)(gQD + go); rk[i] = *(const u32x4*)(gKI + go); rd[i] = *(const u32x4*)(gKDT + (size_t)(grp) * 8192 + idx * 8); } \
        if (F.tid < 128) rc = *(const u32x4*)(gCD + (size_t)(grp) * 512 + F.tid * 4); \
        _Pragma("unroll") for (int sc = 0; sc < 4; ++sc) itn[sc] = *(const u32x2*)(gIT + ((size_t)((grp) * 4 + sc) * 128 + 16 * wave + fr) * 16 + 4 * g); } while (0)
#define HS_WRITE(bufp) do { _Pragma("unroll") for (int i = 0; i < 2; ++i) { const int idx = F.tid + 512 * i; \
        *(LAS u32x4*)((bufp) + ((idx >> 4) * 136 + (idx & 15) * 8) * 2) = rq[i]; *(LAS u32x4*)((bufp) + OFF_KI + ((idx >> 4) * 136 + (idx & 15) * 8) * 2) = rk[i]; \
        *(LAS u32x4*)((bufp) + OFF_KDT + ((idx >> 1) * 24 + (idx & 1) * 8) * 2) = rd[i]; } \
        if (F.tid < 128) *(LAS u32x4*)((bufp) + OFF_CD + F.tid * 16) = rc; } while (0)
    f32x4 Sacc[8];
#pragma unroll
    for (int ft = 0; ft < 8; ++ft) Sacc[ft] = (f32x4){0.f, 0.f, 0.f, 0.f};
    HS_ISSUE(0);
    HS_WRITE(F.lds);
#pragma unroll
    for (int sc = 0; sc < 4; ++sc) itc[sc] = itn[sc];
    __syncthreads();
    for (int grp = 0; grp < 32; ++grp) {
        LAS unsigned char* buf = F.lds + (grp & 1) * BUFB;
        if (grp + 1 < 32) HS_ISSUE(grp + 1);
        const LAS bf16_t* QD = (const LAS bf16_t*)buf; const LAS bf16_t* KI = (const LAS bf16_t*)(buf + OFF_KI);
        const LAS bf16_t* KDT = (const LAS bf16_t*)(buf + OFF_KDT); const LAS float* CD = (const LAS float*)(buf + OFF_CD);
#pragma unroll
        for (int sc = 0; sc < 4; ++sc) {
            bf16x8 qf[4], kf[4]; f32x4 dd[8]; bf16x4 kd[8];
#pragma unroll
            for (int kb = 0; kb < 4; ++kb) { qf[kb] = frag_perm(QD + (16 * sc + fr) * 136, 32 * kb + 4 * g); kf[kb] = frag_perm(KI + (16 * sc + fr) * 136, 32 * kb + 4 * g); }
#pragma unroll
            for (int ft = 0; ft < 8; ++ft) { dd[ft] = *(const LAS f32x4*)(CD + sc * 128 + 16 * ft + 4 * g); kd[ft] = *(const LAS bf16x4*)(KDT + ((sc * 128) + 16 * ft + fr) * 24 + 4 * g); }
            __builtin_amdgcn_sched_barrier(0);
            bf16x8 Sbf[4];
#pragma unroll
            for (int kb = 0; kb < 4; ++kb) Sbf[kb] = pack8(Sacc[2 * kb], Sacc[2 * kb + 1]);
            f32x4 o = (f32x4){0.f, 0.f, 0.f, 0.f}, pT = (f32x4){0.f, 0.f, 0.f, 0.f};
#pragma unroll
            for (int kb = 0; kb < 4; ++kb) {
                o = mfma32(qf[kb], Sbf[kb], o);
                pT = mfma32(kf[kb], qf[kb], pT);
            }
#pragma unroll
            for (int r = 0; r < 4; ++r) pT[r] = (fr >= 4 * g + r) ? pT[r] : 0.f;
            const bf16x4 itf = __builtin_bit_cast(bf16x4, itc[sc]);
            o = mfma16(pack4(pT), itf, o);
#pragma unroll
            for (int ft = 0; ft < 8; ++ft) Sacc[ft] = mfma16(kd[ft], itf, Sacc[ft] * dd[ft]);
            bf16_t* orow = OB + (size_t)(b * SEQ + grp * 64 + sc * 16) * 1024 + h * 128 + 16 * wave + fr;
#pragma unroll
            for (int r = 0; r < 4; ++r) orow[(size_t)(4 * g + r) * 1024] = (bf16_t)f2bf(o[r]);
        }
        if (grp + 1 < 32) { HS_WRITE(F.lds + ((grp + 1) & 1) * BUFB);
#pragma unroll
            for (int sc = 0; sc < 4; ++sc) itc[sc] = itn[sc]; }
        asm volatile("s_waitcnt lgkmcnt(0)" ::: "memory"); __builtin_amdgcn_s_barrier();
    }
#undef HS_ISSUE
#undef HS_WRITE
}

__device__ __forceinline__ void p4_gate(const Params& p, const Frame& F0) {
    const Frame F = refresh(F0);
    const int gw = F.bid * NWAVES + F.wave, NGW = F.G * NWAVES, hs = F.lane >> 4, e0 = (F.lane & 15) * 8;
    unsigned char* scr = opq(p.ws) + WS_SCR;
    const bf16_t* H1 = (const bf16_t*)(opq(p.ws) + WS_H1); bf16_t* OC = (bf16_t*)(opq(p.ws) + WS_OC);
    for (int m = gw; m < T; m += NGW) {
#pragma unroll
        for (int rr = 0; rr < 4; ++rr) {
            const int hh = rr * 4 + hs;
            const bool isb = hh >= 8; const int hd = hh & 7;
            const bf16_t* osrc = (const bf16_t*)(scr + (isb ? O_B : O_A)) + (size_t)m * 1024 + hd * 128 + e0;
            const bf16_t* zsrc = H1 + (size_t)m * H1LD + (isb ? C_GB : C_ZA) + hd * 128 + e0;
            const float* gsrc = (isb ? p.in[I_EV_HGRNN] : p.in[I_EV_GDNN]) + e0;
            const u32x4 ov = *(const u32x4*)osrc, zv = *(const u32x4*)zsrc;
            const f32x4 g0 = *(const f32x4*)gsrc, g1 = *(const f32x4*)(gsrc + 4);
            float x[8] = {bflo(ov.x), bfhi(ov.x), bflo(ov.y), bfhi(ov.y), bflo(ov.z), bfhi(ov.z), bflo(ov.w), bfhi(ov.w)};
            const float z[8] = {bflo(zv.x), bfhi(zv.x), bflo(zv.y), bfhi(zv.y), bflo(zv.z), bfhi(zv.z), bflo(zv.w), bfhi(zv.w)};
            const float gn[8] = {g0[0], g0[1], g0[2], g0[3], g1[0], g1[1], g1[2], g1[3]};
            float ss = 0.f;
#pragma unroll
            for (int i = 0; i < 8; ++i) ss += x[i] * x[i];
            ss = row16_sum(ss);
            const float rinv = rsqrtf(ss * (1.f / 128.f) + RMS_EPS);
#pragma unroll
            for (int i = 0; i < 8; ++i) x[i] = x[i] * rinv * gn[i] * siluf_(z[i]);
            u32x2 w; w.x = pk4_fp8(x[0] * A_PRE, x[1] * A_PRE, x[2] * A_PRE, x[3] * A_PRE); w.y = pk4_fp8(x[4] * A_PRE, x[5] * A_PRE, x[6] * A_PRE, x[7] * A_PRE);
            *(u32x2*)((unsigned char*)OC + (size_t)m * 2048 + hh * 128 + e0) = w;
        }
    }
}

constexpr int H3LD = 6144;
constexpr size_t A_QR = 0;
constexpr size_t A_KR = 32 * MiB;
constexpr size_t A_VT = 64 * MiB;
constexpr size_t A_OG = 96 * MiB;
constexpr size_t A_LSE = 120 * MiB;
constexpr size_t A_KPART = 121 * MiB;
constexpr float QSCALE = 0.08838834764831845f * 1.4426950408889634f;
__device__ __forceinline__ int head_dil_log2(int hd) { return hd < 4 ? 0 : hd < 8 ? 2 : hd < 12 ? 4 : 0; }
__device__ __forceinline__ int posp(int s, int dl) { return ((s & ((1 << dl) - 1)) << (11 - dl)) + (s >> dl); }

__device__ __forceinline__ void rope_unit(const Params& p, const Frame& F, int unit) {
    const int hh = unit & 1, st = (unit >> 1) & 31, b = unit >> 6, s0 = st * 64;
    const bf16_t* H3 = (const bf16_t*)(opq(p.ws) + WS_H1);
    unsigned char* scr = opq(p.ws) + WS_SCR;
    bf16_t* QR = (bf16_t*)(scr + A_QR); bf16_t* KR = (bf16_t*)(scr + A_KR); bf16_t* VT = (bf16_t*)(scr + A_VT); float* KPART = (float*)(scr + A_KPART);
    LAS float* KS = (LAS float*)F.lds;
    LAS bf16_t* VL = (LAS bf16_t*)(F.lds + 33280);
    const int tok2 = F.tid >> 4, pj = (F.tid & 15) * 4;
    float cs[2][4], sn[2][4];
#pragma unroll
    for (int tt = 0; tt < 2; ++tt)
#pragma unroll
        for (int i = 0; i < 4; ++i) { const float inv = powf(10000.0f, -(float)(pj + i) * (1.0f / 64.0f)); const float ang = (float)(s0 + tok2 + 32 * tt) * inv; sincosf(ang, &sn[tt][i], &cs[tt][i]); }
    for (int hi = 0; hi < 8; ++hi) {
        const int hd = hh * 8 + hi, dl = head_dil_log2(hd);
        const int qcol = hd < 12 ? hd * 128 : 4608 + (hd - 12) * 128, kcol = hd < 12 ? 1536 + hd * 128 : 5120 + (hd - 12) * 128, vcol = hd < 12 ? 3072 + hd * 128 : 5632 + (hd - 12) * 128;
        const size_t hb = (size_t)(b * 16 + hd) * 2048;
#pragma unroll
        for (int tt = 0; tt < 2; ++tt) {
            const int tl = tok2 + 32 * tt, s = s0 + tl; const size_t row = (size_t)(b * SEQ + s) * H3LD; const size_t orow = (hb + posp(s, dl)) * 128;
#pragma unroll
            for (int qk = 0; qk < 2; ++qk) {
                const bf16_t* src = H3 + row + (qk ? kcol : qcol) + pj;
                const u32x2 a = *(const u32x2*)src, c = *(const u32x2*)(src + 64);
                const float x1[4] = {bflo(a.x), bfhi(a.x), bflo(a.y), bfhi(a.y)}, x2[4] = {bflo(c.x), bfhi(c.x), bflo(c.y), bfhi(c.y)};
                float y1[4], y2[4]; const float sc = qk ? 1.0f : QSCALE;
#pragma unroll
                for (int i = 0; i < 4; ++i) { y1[i] = (x1[i] * cs[tt][i] - x2[i] * sn[tt][i]) * sc; y2[i] = (x2[i] * cs[tt][i] + x1[i] * sn[tt][i]) * sc; }
                bf16_t* dst = (qk ? KR : QR) + orow + pj;
                u32x2 w1, w2; w1.x = pk2(y1[0], y1[1]); w1.y = pk2(y1[2], y1[3]); w2.x = pk2(y2[0], y2[1]); w2.y = pk2(y2[2], y2[3]);
                *(u32x2*)dst = w1; *(u32x2*)(dst + 64) = w2;
                if (qk && hd >= 12) {
#pragma unroll
                    for (int i = 0; i < 4; ++i) { KS[tl * 129 + pj + i] = y1[i]; KS[tl * 129 + 64 + pj + i] = y2[i]; }
                }
            }
        }
#pragma unroll
        for (int i = 0; i < 2; ++i) { const int idx = F.tid + 512 * i, tl = idx >> 4, pc = idx & 15;
            *(LAS u32x4*)(VL + tl * 136 + pc * 8) = *(const u32x4*)(H3 + (size_t)(b * SEQ + s0 + tl) * H3LD + vcol + pc * 8); }
        __syncthreads();
        if (hd >= 12 && F.tid < 128) { float sum = 0.f;
#pragma unroll 8
            for (int tl = 0; tl < 64; ++tl) sum += KS[tl * 129 + F.tid];
            KPART[((size_t)(b * 4 + hd - 12) * 32 + st) * 128 + F.tid] = sum; }
        {
            const int pp = posp(s0 + F.lane, dl);
#pragma unroll 4
            for (int i = 0; i < 16; ++i) { const int d = F.wave * 16 + i; VT[((size_t)(b * 16 + hd) * 128 + d) * 2048 + pp] = VL[F.lane * 136 + d]; }
        }
        __syncthreads();
    }
}

template <int MODE>
__device__ __forceinline__ void attn_item(const Params& p, const Frame& F0, int b, int hd, int q0, int ktile_lo, int ktile_hi) {
    const Frame F = refresh(F0);
    const int lane = F.lane, fr = lane & 15, g = lane >> 4, wave = F.wave;
    unsigned char* scr = opq(p.ws) + WS_SCR;
    const size_t hb = (size_t)(b * 16 + hd);
    const bf16_t* Qg = (const bf16_t*)(scr + A_QR) + hb * 2048 * 128; const bf16_t* Kg = (const bf16_t*)(scr + A_KR) + hb * 2048 * 128; const bf16_t* Vg = (const bf16_t*)(scr + A_VT) + hb * 128 * 2048;
    constexpr int BUFB = 35840, OFF_V = 17408, OFF_KM = 71680;
    const int nq = q0 + 16 * wave + fr;
    bf16x8 qf[4];
#pragma unroll
    for (int kb = 0; kb < 4; ++kb) qf[kb] = *(const bf16x8*)(Qg + (size_t)nq * 128 + 32 * kb + 8 * g);
    unsigned selmask = 0u;
    if (MODE == 1) {
        const int qb = q0 >> 8, h = hd - 12;
        LAS float* KM = (LAS float*)(F.lds + OFF_KM);
        const float* KPART = (const float*)(scr + A_KPART) + (size_t)(b * 4 + h) * 32 * 128;
#pragma unroll
        for (int i = 0; i < 2; ++i) { const int idx = F.tid + 512 * i, jb = idx >> 7, d = idx & 127;
            KM[idx] = (KPART[(4 * jb + 0) * 128 + d] + KPART[(4 * jb + 1) * 128 + d]) + (KPART[(4 * jb + 2) * 128 + d] + KPART[(4 * jb + 3) * 128 + d]); }
        __syncthreads();
        float gate[8];
#pragma unroll
        for (int jb = 0; jb < 8; ++jb) { float s = 0.f;
#pragma unroll
            for (int kb = 0; kb < 4; ++kb) { const u32x4 qq = __builtin_bit_cast(u32x4, qf[kb]); const LAS float* km = KM + jb * 128 + 32 * kb + 8 * g;
                const f32x4 k0 = *(const LAS f32x4*)km, k1 = *(const LAS f32x4*)(km + 4);
                s += (bflo(qq.x) * k0[0] + bfhi(qq.x) * k0[1]) + (bflo(qq.y) * k0[2] + bfhi(qq.y) * k0[3]) + (bflo(qq.z) * k1[0] + bfhi(qq.z) * k1[1]) + (bflo(qq.w) * k1[2] + bfhi(qq.w) * k1[3]); }
            s += xor16_f(s); s = xor32_sum(s); gate[jb] = s; }
#pragma unroll
        for (int jb = 0; jb < 8; ++jb) { int rank = 0;
#pragma unroll
            for (int j2 = 0; j2 < 8; ++j2) if (j2 != jb && j2 < qb) rank += (gate[j2] > gate[jb] || (gate[j2] == gate[jb] && j2 < jb)) ? 1 : 0;
            if (jb < qb && rank < 3) selmask |= 1u << jb; }
        __syncthreads();
    }
    u32x4 rk[2], rv[2];
#define AT_ISSUE(kt) do { _Pragma("unroll") for (int i = 0; i < 2; ++i) { const int idx = F.tid + 512 * i; \
        rk[i] = *(const u32x4*)(Kg + (size_t)((kt) * 64 + (idx >> 4)) * 128 + (idx & 15) * 8); rv[i] = *(const u32x4*)(Vg + (size_t)(idx >> 3) * 2048 + (kt) * 64 + (idx & 7) * 8); } } while (0)
#define AT_WRITE(bufp) do { _Pragma("unroll") for (int i = 0; i < 2; ++i) { const int idx = F.tid + 512 * i; \
        *(LAS u32x4*)((bufp) + ((idx >> 4) * 136 + (idx & 15) * 8) * 2) = rk[i]; *(LAS u32x4*)((bufp) + OFF_V + ((idx >> 3) * 72 + (idx & 7) * 8) * 2) = rv[i]; } } while (0)
    f32x4 oacc[8];
#pragma unroll
    for (int dt = 0; dt < 8; ++dt) oacc[dt] = (f32x4){0.f, 0.f, 0.f, 0.f};
    float mrun = -1e30f, lrun = 0.f;
    AT_ISSUE(ktile_lo);
    AT_WRITE(F.lds);
    __syncthreads();
    for (int kt = ktile_lo; kt < ktile_hi; ++kt) {
        LAS unsigned char* buf = F.lds + ((kt - ktile_lo) & 1) * BUFB;
        if (kt + 1 < ktile_hi) AT_ISSUE(kt + 1);
        const LAS bf16_t* KL = (const LAS bf16_t*)buf; const LAS bf16_t* VL = (const LAS bf16_t*)(buf + OFF_V);
        f32x4 sT[4];
        {
            bf16x8 kf[16];
#pragma unroll
            for (int t4 = 0; t4 < 4; ++t4)
#pragma unroll
                for (int kb = 0; kb < 4; ++kb) kf[4 * t4 + kb] = *(const LAS bf16x8*)(KL + (16 * t4 + fr) * 136 + 32 * kb + 8 * g);
            __builtin_amdgcn_sched_barrier(0);
#pragma unroll
            for (int t4 = 0; t4 < 4; ++t4) { sT[t4] = (f32x4){0.f, 0.f, 0.f, 0.f};
#pragma unroll
                for (int kb = 0; kb < 4; ++kb) sT[t4] = mfma32(kf[4 * t4 + kb], qf[kb], sT[t4]); }
        }
        __builtin_amdgcn_sched_barrier(0);
        bf16x8 vf[16];
#pragma unroll
        for (int dt = 0; dt < 8; ++dt) { vf[2 * dt] = frag_perm(VL + (16 * dt + fr) * 72, 4 * g); vf[2 * dt + 1] = frag_perm(VL + (16 * dt + fr) * 72, 32 + 4 * g); }
        __builtin_amdgcn_sched_barrier(0);
        const int k0 = kt * 64; float mx = -1e30f;
        const float NEG = -__builtin_huge_valf();
#pragma unroll
        for (int t4 = 0; t4 < 4; ++t4)
#pragma unroll
            for (int r = 0; r < 4; ++r) { const int nk = k0 + 16 * t4 + 4 * g + r; bool v;
                if (MODE == 0) v = (nk <= nq) && (nq - nk <= 128);
                else v = ((k0 >> 8) == (q0 >> 8)) ? (nk <= nq) : (((selmask >> (k0 >> 8)) & 1u) != 0u);
                sT[t4][r] = v ? sT[t4][r] : NEG; mx = fmaxf(mx, sT[t4][r]); }
        mx = fmaxf(mx, xor16_f(mx)); mx = xor32_max(mx);
        const float mnew = fmaxf(mrun, mx), alpha = exp2f(mrun - mnew); mrun = mnew;
        float ps = 0.f;
#pragma unroll
        for (int t4 = 0; t4 < 4; ++t4)
#pragma unroll
            for (int r = 0; r < 4; ++r) { const float pv = exp2f(sT[t4][r] - mnew); sT[t4][r] = pv; ps += pv; }
        lrun = lrun * alpha + ps;
        const bf16x8 pb0 = pack8(sT[0], sT[1]), pb1 = pack8(sT[2], sT[3]);
#pragma unroll
        for (int dt = 0; dt < 8; ++dt) {
            oacc[dt] = oacc[dt] * alpha;
            oacc[dt] = mfma32(vf[2 * dt], pb0, oacc[dt]);
            oacc[dt] = mfma32(vf[2 * dt + 1], pb1, oacc[dt]);
        }
        if (kt + 1 < ktile_hi) AT_WRITE(F.lds + ((kt + 1 - ktile_lo) & 1) * BUFB);
        __syncthreads();
    }
#undef AT_ISSUE
#undef AT_WRITE
    lrun += xor16_f(lrun); lrun = xor32_sum(lrun);
    const float inv = 1.0f / lrun;
    if (MODE == 0) {
        bf16_t* og = (bf16_t*)(scr + A_OG) + ((size_t)(b * 12 + hd) * 2048 + nq) * 128;
#pragma unroll
        for (int dt = 0; dt < 8; ++dt) { u32x2 w; w.x = pk2(oacc[dt][0] * inv, oacc[dt][1] * inv); w.y = pk2(oacc[dt][2] * inv, oacc[dt][3] * inv); *(u32x2*)(og + 16 * dt + 4 * g) = w; }
        if (g == 0) ((float*)(scr + A_LSE))[(size_t)(b * 12 + hd) * 2048 + nq] = mrun + log2f(lrun);
    } else {
        unsigned char* oc = (opq(p.ws) + WS_OC) + (size_t)(b * SEQ + nq) * 1024 + 512 + (hd - 12) * 128;
        const float inv4 = inv * A_PRE;
#pragma unroll
        for (int dt = 0; dt < 8; ++dt) *(unsigned*)(oc + 16 * dt + 4 * g) = pk4_fp8(oacc[dt][0] * inv4, oacc[dt][1] * inv4, oacc[dt][2] * inv4, oacc[dt][3] * inv4);
    }
}

__device__ __forceinline__ void attn_phase(const Params& p, const Frame& F0) {
    const Frame F = refresh(F0);
    const int i = F.bid & 15, bhm = F.bid >> 4;
    const int nd = (i == 0) ? 7 : (i <= 2) ? 6 : (i <= 4) ? 5 : (i <= 6) ? 4 : (i <= 8) ? 3 : (i <= 10) ? 2 : (i == 11) ? 1 : 0;
    const int st = (i == 0) ? 0 : (i == 1) ? 7 : (i == 2) ? 13 : (i == 3) ? 19 : (i == 4) ? 24 : (i == 5) ? 29 : (i == 6) ? 33 : (i == 7) ? 37 : (i == 8) ? 40 : (i == 9) ? 43 : (i == 10) ? 45 : (i == 11) ? 47 : 48;
    const bool balanced = (F.G == 256);
    for (int k = 0;; ++k) {
        int it;
        if (balanced) { if (k > nd) break; it = (k == 0) ? (bhm * 16 + i) : (256 + bhm * 48 + st + k - 1); }
        else { it = F.bid + k * F.G; if (it >= 1024) break; }
        if (it < 256) { const int qt = it & 15; attn_item<1>(p, F, it >> 6, 12 + ((it >> 4) & 3), qt * 128, 0, 2 * (qt + 1)); }
        else { const int id = it - 256, qt = id & 15, hd = (id >> 4) % 12, b = (id >> 4) / 12, dl = head_dil_log2(hd); const int q0 = qt * 128, first = ((q0 & ((2048 >> dl) - 1)) == 0);
            attn_item<0>(p, F, b, hd, q0, first ? 2 * qt : 2 * qt - 2, 2 * qt + 2); }
    }
}

__device__ __forceinline__ void merge_pass(const Params& p, const Frame& F0) {
    const Frame F = refresh(F0);
    const int gw = F.bid * NWAVES + F.wave, NGW = F.G * NWAVES, hg = F.lane >> 4, d0 = (F.lane & 15) * 8;
    unsigned char* scr = opq(p.ws) + WS_SCR;
    const bf16_t* OG = (const bf16_t*)(scr + A_OG); const float* LSE = (const float*)(scr + A_LSE); bf16_t* OC = (bf16_t*)(opq(p.ws) + WS_OC);
    for (int m = gw; m < T; m += NGW) {
        const int b = m >> 11, s = m & 2047;
        float ls[3]; u32x4 ov[3];
#pragma unroll
        for (int gi = 0; gi < 3; ++gi) { const int hd = 4 * gi + hg; const size_t idx = (size_t)(b * 12 + hd) * 2048 + posp(s, 2 * gi); ls[gi] = LSE[idx]; ov[gi] = *(const u32x4*)(OG + idx * 128 + d0); }
        const float mx = fmaxf(ls[0], fmaxf(ls[1], ls[2]));
        float w[3]; float ws = 0.f;
#pragma unroll
        for (int gi = 0; gi < 3; ++gi) { w[gi] = exp2f(ls[gi] - mx); ws += w[gi]; }
        const float inv = 1.0f / ws;
        float o[8] = {0.f, 0.f, 0.f, 0.f, 0.f, 0.f, 0.f, 0.f};
#pragma unroll
        for (int gi = 0; gi < 3; ++gi) { const float wg = w[gi] * inv;
            o[0] += wg * bflo(ov[gi].x); o[1] += wg * bfhi(ov[gi].x); o[2] += wg * bflo(ov[gi].y); o[3] += wg * bfhi(ov[gi].y);
            o[4] += wg * bflo(ov[gi].z); o[5] += wg * bfhi(ov[gi].z); o[6] += wg * bflo(ov[gi].w); o[7] += wg * bfhi(ov[gi].w); }
        u32x2 wv; wv.x = pk4_fp8(o[0] * A_PRE, o[1] * A_PRE, o[2] * A_PRE, o[3] * A_PRE); wv.y = pk4_fp8(o[4] * A_PRE, o[5] * A_PRE, o[6] * A_PRE, o[7] * A_PRE);
        *(u32x2*)((unsigned char*)OC + (size_t)m * 1024 + hg * 128 + d0) = wv;
    }
}

#define GRID_SYNC() xcd_barrier((unsigned*)(opq(p.ws) + WS_CTL), (volatile LAS unsigned*)(F.lds + LDS_BYTES - 16), F.wave)
#ifndef REPMASK
#define REPMASK 0u
#endif
__device__ __forceinline__ int repn(int k) { int n = 1 + (int)(((REPMASK) >> k) & 1u); asm volatile("" : "+s"(n)); return n; }
#define RP(k) for (int _r = 0, _n = repn(k); _r < _n; ++_r)
__global__ void __launch_bounds__(NTHR, 2) mk_fwd(Params p) {
    extern __shared__ __attribute__((aligned(16))) unsigned char lds_raw[];
    Frame F; F.lds = (LAS unsigned char*)lds_raw; F.tid = 0; F.lane = 0; F.wave = __builtin_amdgcn_readfirstlane(threadIdx.x >> 6); F.G = gridDim.x; F.bid = blockIdx.x;
#define P_WS (opq(p.ws))
#define P_AB ((bf16_t*)(opq(p.ws) + WS_AB))
#define P_R (opq(p.out))
#define P_MIX ((bf16_t*)(opq(p.ws) + WS_MIX))
#define P_HID ((bf16_t*)(opq(p.ws) + WS_HID))
#define P_Y2 ((bf16_t*)(opq(p.ws) + WS_Y2))

    {
        if (threadIdx.x == 0) { volatile LAS unsigned* st = (volatile LAS unsigned*)(F.lds + LDS_BYTES - 16); st[0] = 0u; st[1] = 0u;
            (void)xb_add((unsigned*)(p.ws + WS_CTL) + XB_XCNT(xb_xcc_id()), 1u); }
        __syncthreads();
    }
    RP(0) { convert_set(p, F, 0, F.bid * NWAVES + F.wave, F.G * NWAVES); __syncthreads(); }
    RP(1) { load_w16_lds(F, p.in[I_EV_WIN], EVEN_IN, 4096); __syncthreads(); p0_xpass(p, F); __syncthreads(); }
    GRID_SYNC();

    RP(2) {
        pg8::StaticOrder S; S.init(T, 8192, F.G, F.bid);
        pg8::Gemm g{(const unsigned char*)(P_WS + WS_AB), (const unsigned char*)(P_WS + WS_WIN), 2048, (unsigned)(T * 2048), (unsigned)(8192 * 2048), SC_A16};
        pg8::EpiBf16 E{(bf16_t*)(P_WS + WS_H1), H1LD, (unsigned)(T * 8192 * 2)};
        pg8::gemm_phase(F.lds, F.wave, g, S, E);
    }
    GRID_SYNC();
    RP(3) { p2_pre(p, F); }
    GRID_SYNC();
    RP(4) { if (F.bid < 32) gdn_scan(p, F, F.bid); else if (F.bid < 64) hgrn_scan(p, F, F.bid - 32);
            else if (F.G > 64) convert_set(p, F, 1, (F.bid - 64) * NWAVES + F.wave, (F.G - 64) * NWAVES); }
    if (F.G <= 64) { convert_set(p, F, 1, F.bid * NWAVES + F.wave, F.G * NWAVES); }
    GRID_SYNC();
    RP(5) { p4_gate(p, F); }
    GRID_SYNC();
    RP(6) {
        pg8::StaticOrder S; S.init(T, 2048, F.G, F.bid);
        pg8::Gemm g{(const unsigned char*)(P_WS + WS_OC), (const unsigned char*)(P_WS + WS_WOUT), 2048, (unsigned)(T * 2048), (unsigned)(2048 * 2048), SC_A4};
        pg8::EpiBf16 E{P_MIX, 2048, (unsigned)(T * 2048 * 2)};
        pg8::gemm_phase(F.lds, F.wave, g, S, E);
    }
    GRID_SYNC();
#define MOE_BLOCK(layer, resid, mixp, outfinal, outb2) do { \
        for (int _r = 0, _n = ((layer) == 0 ? repn(7) : 1); _r < _n; ++_r) { load_w16_lds(F, p.in[I_RW], 16, 0); __syncthreads(); \
            ln_pass<true, false, (layer) != 0, true>(p, F, resid, mixp, D, nullptr, p.in[I_LNG] + (size_t)((layer) * 2 + 0) * D, p.in[I_LNB] + (size_t)((layer) * 2 + 0) * D, P_R, P_AB, layer); __syncthreads(); } \
        GRID_SYNC(); \
        const int* list = (const int*)(P_WS + WS_LIST) + (size_t)(layer) * NE * T; \
        const float* gatew = (const float*)(P_WS + WS_GATEW) + (size_t)(layer) * 2 * T; \
        RP(8) { moe_lists(p, F, layer); } \
        GRID_SYNC(); \
        { const Frame Fr = refresh(F); pg8::moe_build_table(F.lds, Fr.tid); } \
        unsigned* tcnt = (unsigned*)(P_WS + WS_CTL) + 3600 + 128 * (layer);        \
        { pg8::MoeOrder<4, false> S; S.init(F.lds, list, F.G, F.bid, 1024, tcnt); \
            pg8::Gemm g{(const unsigned char*)(P_WS + WS_ABS), (const unsigned char*)(P_WS + ((layer) ? WS_WGU1 : WS_WGU)), 2048, (unsigned)(20480 * 2048), (unsigned)(NE * 1024 * 2048), SC_A1}; \
            pg8::EpiGateUpB E{P_HID, list, gatew}; pg8::gemm_phase(F.lds, F.wave, g, S, E); } \
          \
        { pg8::MoeDownS S; S.init(F.lds, tcnt, 2048, F.G, F.bid); \
            pg8::Gemm16 g{P_HID, (const bf16_t*)(P_WS + WS_WD), 512, (unsigned)(20480 * 512 * 2), (unsigned)(NE * 2048 * 512 * 2)}; \
            pg8::EpiDown E{P_Y2, list}; pg8::gemm_phase16(F.lds, F.wave, g, S, E); } \
        GRID_SYNC(); \
        ln_pass<false, true, true, (layer) == 0>(p, F, P_R, P_Y2, D, P_Y2, p.in[I_LNG] + (size_t)((layer) * 2 + 1) * D, p.in[I_LNB] + (size_t)((layer) * 2 + 1) * D, outfinal, outb2, layer); \
    } while (0)
    MOE_BLOCK(0, p.in[I_X], P_MIX, P_R, (bf16_t*)(P_WS + WS_AB8));
    __syncthreads();
    RP(11) { convert_set(p, F, 2, F.bid * NWAVES + F.wave, F.G * NWAVES); __syncthreads(); }
    GRID_SYNC();
    RP(12) {
        pg8::StaticOrder S; S.init(T, 6144, F.G, F.bid);
        pg8::Gemm g{(const unsigned char*)(P_WS + WS_AB8), (const unsigned char*)(P_WS + WS_W3), 2048, (unsigned)(T * 2048), (unsigned)(6144 * 2048), SC_A1};
        pg8::EpiBf16 E{(bf16_t*)(P_WS + WS_H1), H3LD, (unsigned)(T * 6144 * 2)};
        pg8::gemm_phase(F.lds, F.wave, g, S, E);
    }
    GRID_SYNC();
    RP(13) { const Frame Fr = refresh(F); for (int u = Fr.bid; u < 256; u += Fr.G) rope_unit(p, Fr, u); }
    GRID_SYNC();
    RP(14) { attn_phase(p, F); }
    GRID_SYNC();
    RP(15) { merge_pass(p, F); }
    GRID_SYNC();
    RP(16) {
        pg8::StaticOrder S; S.init(T, 2048, F.G, F.bid);
        pg8::Gemm g{(const unsigned char*)(P_WS + WS_OC), (const unsigned char*)(P_WS + WS_WOUT1), 1024, (unsigned)(T * 1024), (unsigned)(2048 * 1024), SC_A4};
        pg8::EpiBf16 E{P_MIX, 2048, (unsigned)(T * 2048 * 2)};
        pg8::gemm_phase(F.lds, F.wave, g, S, E);
    }
    GRID_SYNC();
    MOE_BLOCK(1, P_R, P_MIX, p.out, (bf16_t*)nullptr);
#undef MOE_BLOCK
#undef P_WS
#undef P_AB
#undef P_R
#undef P_MIX
#undef P_HID
#undef P_Y2
}

extern "C" void kernel_launch(void* const* d_in, const int* in_sizes, int n_in, void* d_out, int out_size,
                              void* d_ws, size_t ws_size, hipStream_t stream) {
    static int grid_blocks = 0;
    if (!grid_blocks) {
        int dev = 0, cus = 0, per_cu = 0;
        (void)hipGetDevice(&dev);
        (void)hipDeviceGetAttribute(&cus, hipDeviceAttributeMultiprocessorCount, dev);
        (void)hipFuncSetAttribute((const void*)mk_fwd, hipFuncAttributeMaxDynamicSharedMemorySize, LDS_BYTES);
        (void)hipOccupancyMaxActiveBlocksPerMultiprocessor(&per_cu, (const void*)mk_fwd, NTHR, LDS_BYTES);
        if (per_cu < 1) fprintf(stderr, "kernel_launch: occupancy query says %d blocks per CU\n", per_cu);
        grid_blocks = cus;
        if (ws_size < WS_END) { fprintf(stderr, "kernel_launch: workspace too small: %zu < %zu\n", ws_size, (size_t)WS_END); grid_blocks = -1; }
        if (n_in != 18) { fprintf(stderr, "kernel_launch: expected 18 inputs, got %d\n", n_in); grid_blocks = -1; }
    }
    if (grid_blocks < 0) return;
    Params p{};
    for (int i = 0; i < 18; ++i) p.in[i] = (const float*)d_in[i];
    p.out = (float*)d_out; p.ws = (unsigned char*)d_ws;
    (void)hipMemsetAsync(d_ws, 0, 16384, stream);
    void* args[] = {&p};
    hipError_t e = hipLaunchCooperativeKernel((void*)mk_fwd, dim3(grid_blocks), dim3(NTHR), args, LDS_BYTES, stream);
    if (e != hipSuccess) fprintf(stderr, "cooperative launch failed: %s (grid %d)\n", hipGetErrorString(e), grid_blocks);
}
```

```cpp
#include <hip/hip_runtime.h>
#include <cstdio>
#include <cstdint>

#define GAS __attribute__((address_space(1)))
#define LAS __attribute__((address_space(3)))
typedef unsigned short bf16_t;
typedef short bf16x8 __attribute__((ext_vector_type(8)));
typedef short bf16x4 __attribute__((ext_vector_type(4)));
typedef float f32x4 __attribute__((ext_vector_type(4)));
typedef float f32x2 __attribute__((ext_vector_type(2)));
typedef unsigned u32x4 __attribute__((ext_vector_type(4)));
typedef unsigned u32x2 __attribute__((ext_vector_type(2)));

constexpr int NB = 4, SEQ = 2048, T = NB * SEQ, D = 2048;
constexpr int EVEN_IN = 8208, ODD_IN = 6144;
constexpr int NE = 16, DEXP = 512;
constexpr float ALPHA = 1.4142135623730951f;
constexpr float LN_EPS = 1e-5f, RMS_EPS = 1e-6f;
constexpr int NWAVES = 8, NTHR = 512;
constexpr int LDS_BYTES = 147456;

constexpr size_t MiB = 1u << 20;
constexpr size_t WS_CTL = 0;
constexpr size_t WS_LIST = 1 * MiB;
constexpr size_t WS_GATEW = 2 * MiB;
constexpr size_t WS_BA = 2 * MiB + 512 * 1024;
constexpr size_t WS_ROPE = 3 * MiB;
constexpr size_t WS_KMEAN = 4 * MiB;
constexpr size_t WS_WREG = 8 * MiB;
constexpr size_t WS_WIN = WS_WREG;
constexpr size_t WS_AB8 = WS_WREG + 16 * MiB;
constexpr size_t WS_WOUT = WS_WREG + 32 * MiB;
constexpr size_t WS_WGU = WS_WREG + 40 * MiB;
constexpr size_t WS_WD = WS_WREG + 104 * MiB;
constexpr size_t WS_AB = WS_WREG + 136 * MiB;
constexpr size_t WS_H1 = WS_AB + 32 * MiB;
constexpr size_t WS_OC = WS_H1 + 128 * MiB;
constexpr size_t WS_MIX = WS_OC + 32 * MiB;
constexpr size_t WS_SCR = WS_MIX + 32 * MiB;
constexpr size_t WS_HID = WS_SCR;
constexpr size_t WS_Y2 = WS_SCR + 20 * MiB;
constexpr size_t WS_ABS = WS_SCR + 84 * MiB;
constexpr size_t WS_END = WS_SCR + 216 * MiB;
static_assert(WS_END == 584 * MiB, "workspace map");

typedef __bf16 bf16v2_t __attribute__((ext_vector_type(2)));
__device__ __forceinline__ unsigned pk2(float lo, float hi) { const f32x2 f = {lo, hi}; return __builtin_bit_cast(unsigned, __builtin_convertvector(f, bf16v2_t)); }
__device__ __forceinline__ unsigned f2bf(float f) { return pk2(f, 0.f) & 0xffffu; }
__device__ __forceinline__ unsigned pk4_fp8(float a, float b, float c, float d) {
    a = fminf(fmaxf(a, -448.f), 448.f); b = fminf(fmaxf(b, -448.f), 448.f); c = fminf(fmaxf(c, -448.f), 448.f); d = fminf(fmaxf(d, -448.f), 448.f);
    int w = 0; w = __builtin_amdgcn_cvt_pk_fp8_f32(a, b, w, false); w = __builtin_amdgcn_cvt_pk_fp8_f32(c, d, w, true); return (unsigned)w;
}
constexpr float W_PRE = 64.f;  constexpr int SC_W = 0x79797979;
constexpr float A_PRE = 4.f;   constexpr int SC_A4 = 0x7d7d7d7d;
constexpr int SC_A1 = 0x7f7f7f7f;
constexpr float X_PRE = 16.f;  constexpr int SC_A16 = 0x7b7b7b7b;
typedef int i32x8 __attribute__((ext_vector_type(8)));
__device__ __forceinline__ float bf2f(unsigned short b) { return __builtin_bit_cast(float, (unsigned)b << 16); }
__device__ __forceinline__ float bflo(unsigned w) { return __builtin_bit_cast(float, w << 16); }
__device__ __forceinline__ float bfhi(unsigned w) { return __builtin_bit_cast(float, w & 0xffff0000u); }
__device__ __forceinline__ unsigned cvt_pk_bf16(float lo, float hi) { return pk2(lo, hi); }
template <int CTRL> __device__ __forceinline__ float dpp_f(float x) { return __builtin_bit_cast(float, __builtin_amdgcn_update_dpp(0, __builtin_bit_cast(int, x), CTRL, 0xf, 0xf, true)); }
__device__ __forceinline__ float xor16_f(float x) { return __builtin_bit_cast(float, __builtin_amdgcn_ds_swizzle(__builtin_bit_cast(int, x), 0x401f)); }
__device__ __forceinline__ float row16_sum(float v) { v += dpp_f<0xB1>(v); v += dpp_f<0x4E>(v); v += dpp_f<0x141>(v); v += dpp_f<0x140>(v); return v; }
__device__ __forceinline__ float xor32_sum(float v) { const int i = __builtin_bit_cast(int, v); const auto r = __builtin_amdgcn_permlane32_swap(i, i, false, false);
    return __builtin_bit_cast(float, (int)r[0]) + __builtin_bit_cast(float, (int)r[1]); }
__device__ __forceinline__ float xor32_max(float v) { const int i = __builtin_bit_cast(int, v); const auto r = __builtin_amdgcn_permlane32_swap(i, i, false, false);
    return fmaxf(__builtin_bit_cast(float, (int)r[0]), __builtin_bit_cast(float, (int)r[1])); }
__device__ __forceinline__ float wave_sum(float v) { v = row16_sum(v); v += xor16_f(v); return xor32_sum(v); }
__device__ __forceinline__ float sigmoidf_(float x) { return 1.0f / (1.0f + __expf(-x)); }
__device__ __forceinline__ float siluf_(float x) { return x / (1.0f + __expf(-x)); }
#define LDS_WAIT() asm volatile("s_waitcnt lgkmcnt(0)" ::: "memory")
template <class Tp> __device__ __forceinline__ Tp* opq(Tp* x) { asm volatile("" : "+s"(x)); return x; }
template <class Tp> __device__ __forceinline__ Tp* opqg(Tp* x) { GAS Tp* g = (GAS Tp*)x; asm volatile("" : "+s"(g)); return (Tp*)g; }
__device__ __forceinline__ float ld_agent(const float* p) { return __hip_atomic_load(p, __ATOMIC_RELAXED, __HIP_MEMORY_SCOPE_AGENT); }

namespace pg8 {
constexpr int BM = 256, BK = 64, HALF = 128, HTB = HALF * BK * 2, STAGE_BYTES = 8 * HTB, NXCD = 8, WGM = 8;
__device__ __forceinline__ int lds_byte(int r, int c) { const int st = (r >> 4) * 2 + (c >> 5), rr = r & 15, cc = c & 31, ob = rr * 64 + cc * 2; return st * 1024 + (ob ^ (((ob >> 9) & 1) << 5)); }
__device__ __forceinline__ void stage_rc(int b, int& R, int& C) { const int st = b / 1024, sb = b % 1024, swz = sb ^ (((sb >> 9) & 1) << 5); R = (st >> 1) * 16 + swz / 64; C = (st & 1) * 32 + (swz % 64) / 2; }
__device__ __forceinline__ int perm32(int rho) { const int n = rho >> 4, i = rho & 15; return 8 * (i >> 2) + 4 * n + (i & 3); }

struct Unit { int pm, pn, e, cnt, arow0, brow0; };
struct Gemm { const unsigned char* A; const unsigned char* Bt; int K; unsigned abytes, bbytes; int sc_a; };

struct StaticOrder {
    static constexpr bool CONTIG = true;
    int nM, nN, nwg, G, c;
    __device__ void init(int M, int N, int G_, int c_) { nM = M / BM; nN = N / BM; nwg = nM * nN; G = G_; c = c_; }
    __device__ bool next(int i, Unit& u) const {
        const long L = (long)i * G + c; if (L >= nwg) return false;
        int wgid = (int)L; { const int q = nwg / NXCD, r = nwg % NXCD, xcd = wgid % NXCD, off = wgid / NXCD; wgid = (xcd < r ? xcd * (q + 1) : r * (q + 1) + (xcd - r) * q) + off; }
        const int nig = WGM * nN, gid = wgid / nig, fm = gid * WGM, gsz = (nM - fm) < WGM ? (nM - fm) : WGM;
        u.pm = fm + ((wgid % nig) % gsz); u.pn = (wgid % nig) / gsz; u.e = 0; u.cnt = 0; u.arow0 = u.pm * BM; u.brow0 = u.pn * BM; return true;
    }
    __device__ __forceinline__ unsigned arow(const Unit& u, int r) const { return (unsigned)(u.arow0 + r); }
    __device__ __forceinline__ void done(const Unit&, int) const {}
    struct State {};
    __device__ __forceinline__ bool first(State&, Unit& u, int) const { return next(0, u); }
    __device__ __forceinline__ void issue(State&, int, int) const {}
    __device__ __forceinline__ bool fin(State&, int i, Unit& u, int) const { return next(i, u); }
};

constexpr int MOE_TAB_OFF = 131072;
constexpr int MOE_HIST_OFF = 131072 + 3072;
__device__ __forceinline__ void moe_build_table(LAS unsigned char* lds, int tid) {
    LAS int* tab = (LAS int*)(lds + MOE_TAB_OFF);
    const LAS int* cnts = (const LAS int*)(lds + MOE_HIST_OFF) + 16;
    if (tid == 0) {
        int s = 0;
#pragma unroll 1
        for (int e = 0; e < NE; ++e) { const int c = cnts[e]; const int nt = (c + 255) >> 8;
#pragma unroll 1
            for (int k = 0; k < nt; ++k) { tab[4 + 4 * (s + k)] = e; tab[4 + 4 * (s + k) + 1] = k; tab[4 + 4 * (s + k) + 2] = c; }
            s += nt; }
        tab[0] = s;
    }
    __syncthreads();
}
template <int NPN, bool GATHER>
struct MoeOrder {
    static constexpr bool CONTIG = !GATHER;
    const int* list;
    LAS const int* tab; int G, c, brows;
    unsigned* tcnt;
    __device__ void init(LAS unsigned char* lds, const int* list_, int G_, int c_, int brows_, unsigned* tcnt_ = nullptr) { list = list_; G = G_; c = c_; brows = brows_; tab = (LAS const int*)(lds + MOE_TAB_OFF); tcnt = tcnt_; }
    __device__ __forceinline__ void done(const Unit& u, int lane) const {
        if (tcnt) { asm volatile("s_waitcnt vmcnt(0)" ::: "memory"); if (lane == 0) __hip_atomic_fetch_add(tcnt + (u.arow0 >> 8), 1u, __ATOMIC_RELAXED, __HIP_MEMORY_SCOPE_AGENT); }
    }
    __device__ bool next(int i, Unit& u) const {
        int L = i * G + c; const int ntile = __builtin_amdgcn_readfirstlane(tab[0]); if (L >= ntile * NPN) return false;
        if (NPN == 4 && i == 0 && G == 256) L = (c & 7) * 32 + (c >> 3);
        const int tile = L / NPN; u.pn = L % NPN;
        u.e = __builtin_amdgcn_readfirstlane(tab[4 + 4 * tile]); u.pm = __builtin_amdgcn_readfirstlane(tab[4 + 4 * tile + 1]); u.cnt = __builtin_amdgcn_readfirstlane(tab[4 + 4 * tile + 2]);
        u.arow0 = tile * BM; u.brow0 = u.e * brows + u.pn * BM; return true;
    }
    __device__ __forceinline__ unsigned arow(const Unit& u, int r) const {
        if (!GATHER) return (unsigned)(u.arow0 + r);
        int idx = u.pm * BM + r; if (idx >= u.cnt) idx = 0;
        return (unsigned)(list[u.e * T + idx] >> 1);
    }
    struct State {};
    __device__ __forceinline__ bool first(State&, Unit& u, int) const { return next(0, u); }
    __device__ __forceinline__ void issue(State&, int, int) const {}
    __device__ __forceinline__ bool fin(State&, int i, Unit& u, int) const { return next(i, u); }
};
constexpr int MOE_Q_OFF = 131072 + 3072 + 512;
struct MoeDownS {
    static constexpr bool CONTIG = true;
    typedef __attribute__((address_space(1))) unsigned gu32;
    LAS const int* tab; LAS unsigned* slot; gu32* tcnt; int brows, G, c;
    struct State {};
    __device__ void init(LAS unsigned char* lds, unsigned* tcnt_, int brows_, int G_, int c_) { tab = (LAS const int*)(lds + MOE_TAB_OFF); slot = (LAS unsigned*)(lds + MOE_Q_OFF); tcnt = (gu32*)tcnt_; brows = brows_; G = G_; c = c_; }
    __device__ __forceinline__ unsigned nunits() const { return (unsigned)__builtin_amdgcn_readfirstlane(tab[0]) * 8u; }
    __device__ __forceinline__ unsigned qof(int k) const {
        const int nG = __builtin_amdgcn_readfirstlane(tab[0]) * 4, h = nG % G, nl = G - h;
        return (unsigned)(c >= h ? k * nl + (k >= 3 ? (k - 2) * h : 0) + (c - h) : (k + 3) * nl + k * h + c);
    }
    __device__ __forceinline__ void wait_tile(unsigned q, unsigned cv) const {
        unsigned sp = 0;
        while (cv < 32u) { __builtin_amdgcn_s_sleep(2); if (++sp > (1u << 22)) break; cv = __hip_atomic_load(tcnt + (q >> 3), __ATOMIC_RELAXED, __HIP_MEMORY_SCOPE_AGENT); }
        asm volatile("buffer_inv sc1" ::: "memory");
    }
    __device__ __forceinline__ bool decode(unsigned q, Unit& u) const {
        if (q >= nunits()) return false;
        const int tile = (int)(q >> 3); u.pn = (int)(q & 7u);
        u.e = __builtin_amdgcn_readfirstlane(tab[4 + 4 * tile]); u.pm = __builtin_amdgcn_readfirstlane(tab[4 + 4 * tile + 1]); u.cnt = __builtin_amdgcn_readfirstlane(tab[4 + 4 * tile + 2]);
        u.arow0 = tile * BM; u.brow0 = u.e * brows + u.pn * BM; return true;
    }
    __device__ __forceinline__ bool first(State&, Unit& u, int tid) const {
        const unsigned q = qof(0);
        if (tid == 0 && q < nunits()) wait_tile(q, __hip_atomic_load(tcnt + (q >> 3), __ATOMIC_RELAXED, __HIP_MEMORY_SCOPE_AGENT));
        __syncthreads();
        return decode(q, u);
    }
    __device__ __forceinline__ void issue(State&, int i, int tid) const {
        const unsigned q = qof(i);
        if (tid == 0 && q < nunits()) {
            const __amdgpu_buffer_rsrc_t rc = __builtin_amdgcn_make_buffer_rsrc((void*)tcnt, (short)0, 128 * 4, 0x00020000);
            __builtin_amdgcn_raw_ptr_buffer_load_lds(rc, (LAS void*)slot, 4, (int)((q >> 3) * 4u), 0, 0, 16);
        }
    }
    __device__ __forceinline__ bool fin(State&, int i, Unit& u, int tid) const {
        const unsigned q = qof(i);
        if (tid == 0 && q < nunits()) {
            unsigned cv; asm volatile("ds_read_b32 %0, %1\n\ts_waitcnt lgkmcnt(0)" : "=v"(cv) : "v"((unsigned)(size_t)slot) : "memory");
            wait_tile(q, cv);
        }
        return decode(q, u);
    }
    __device__ __forceinline__ unsigned arow(const Unit& u, int r) const { return (unsigned)(u.arow0 + r); }
    __device__ __forceinline__ void done(const Unit&, int) const {}
};

struct EpiBf16 {
    static constexpr bool PERM = true;
    bf16_t* O; int ldc; unsigned obytes;
    __device__ __forceinline__ void operator()(const f32x4 (&acc)[2][2][4][2], const Unit& u, int wr, int wc, int fr, int fq) const {
        const __amdgpu_buffer_rsrc_t rO = __builtin_amdgcn_make_buffer_rsrc((void*)O, (short)0, (int)obytes, 0x00020000);
        const unsigned voff = (unsigned)((wr * 64 + fr) * ldc + wc * 32 + 8 * fq) * 2u;
        const unsigned sbase = (unsigned)(u.pm * BM * ldc + u.pn * BM) * 2u;
#pragma unroll
        for (int ai = 0; ai < 2; ++ai)
#pragma unroll
            for (int m = 0; m < 4; ++m)
#pragma unroll
                for (int bj = 0; bj < 2; ++bj) { const f32x4 v0 = acc[ai][bj][m][0], v1 = acc[ai][bj][m][1];
                    u32x4 w; w.x = cvt_pk_bf16(v0[0], v0[1]); w.y = cvt_pk_bf16(v0[2], v0[3]); w.z = cvt_pk_bf16(v1[0], v1[1]); w.w = cvt_pk_bf16(v1[2], v1[3]);
                    __builtin_amdgcn_raw_buffer_store_b128(w, rO, (int)voff, (int)(sbase + (unsigned)((ai * HALF + m * 16) * ldc + bj * HALF) * 2u), 0); }
    }
};
struct EpiGateUp {
    static constexpr bool PERM = true;
    unsigned char* HID; const int* list; const float* gatew;
    __device__ __forceinline__ void operator()(const f32x4 (&acc)[2][2][4][2], const Unit& u, int wr, int wc, int fr, int fq) const {
        const int col0 = u.pn * 128 + wc * 32 + 8 * fq;
#pragma unroll
        for (int ai = 0; ai < 2; ++ai)
#pragma unroll
            for (int m = 0; m < 4; ++m) {
                const int r = ai * HALF + wr * 64 + m * 16 + fr; const int idx = u.pm * BM + r;
                float wgt = 0.f; if (idx < u.cnt) wgt = gatew[list[u.e * T + idx]] * A_PRE;
                const f32x4 g0 = acc[ai][0][m][0], g1 = acc[ai][0][m][1], u0 = acc[ai][1][m][0], u1 = acc[ai][1][m][1];
                float h[8];
#pragma unroll
                for (int i = 0; i < 4; ++i) { h[i] = siluf_(g0[i]) * u0[i] * wgt; h[4 + i] = siluf_(g1[i]) * u1[i] * wgt; }
                u32x2 w; w.x = pk4_fp8(h[0], h[1], h[2], h[3]); w.y = pk4_fp8(h[4], h[5], h[6], h[7]);
                *(u32x2*)(HID + (size_t)(u.arow0 + r) * DEXP + col0) = w;
            }
    }
};
struct EpiGateUpB {
    static constexpr bool PERM = true;
    bf16_t* HID; const int* list; const float* gatew;
    __device__ __forceinline__ void operator()(const f32x4 (&acc)[2][2][4][2], const Unit& u, int wr, int wc, int fr, int fq) const {
        const __amdgpu_buffer_rsrc_t rH = __builtin_amdgcn_make_buffer_rsrc((void*)HID, (short)0, 20480 * 512 * 2, 0x00020000);
        const __amdgpu_buffer_rsrc_t rL = __builtin_amdgcn_make_buffer_rsrc((void*)(list + (size_t)u.e * T), (short)0, T * 4, 0x00020000);
        const __amdgpu_buffer_rsrc_t rG = __builtin_amdgcn_make_buffer_rsrc((void*)gatew, (short)0, 2 * T * 4, 0x00020000);
        const unsigned voff = (unsigned)((wr * 64 + fr) * DEXP + u.pn * 128 + wc * 32 + 8 * fq) * 2u;
        const int idx0 = u.pm * BM + wr * 64 + fr;
#pragma unroll
        for (int ai = 0; ai < 2; ++ai)
#pragma unroll
            for (int m = 0; m < 4; ++m) {
                const int idx = idx0 + ai * HALF + m * 16;
                const int ent = __builtin_amdgcn_raw_buffer_load_b32(rL, idx * 4, 0, 0);
                float wgt = __builtin_bit_cast(float, __builtin_amdgcn_raw_buffer_load_b32(rG, (idx < u.cnt ? ent : 0) * 4, 0, 0)); wgt = idx < u.cnt ? wgt : 0.f;
                const f32x4 g0 = acc[ai][0][m][0], g1 = acc[ai][0][m][1], u0 = acc[ai][1][m][0], u1 = acc[ai][1][m][1];
                float h[8];
#pragma unroll
                for (int i = 0; i < 4; ++i) { h[i] = siluf_(g0[i]) * u0[i] * wgt; h[4 + i] = siluf_(g1[i]) * u1[i] * wgt; }
                u32x4 w; w.x = cvt_pk_bf16(h[0], h[1]); w.y = cvt_pk_bf16(h[2], h[3]); w.z = cvt_pk_bf16(h[4], h[5]); w.w = cvt_pk_bf16(h[6], h[7]);
                __builtin_amdgcn_raw_buffer_store_b128(w, rH, (int)voff, (int)((u.arow0 + ai * HALF + m * 16) * DEXP * 2), 16);
            }
    }
};
struct EpiDown {
    static constexpr bool PERM = true;
    bf16_t* Y2; const int* list;
    __device__ __forceinline__ void operator()(const f32x4 (&acc)[2][2][4][2], const Unit& u, int wr, int wc, int fr, int fq) const {
        const int col0 = u.pn * BM + wc * 32 + 8 * fq;
#pragma unroll
        for (int ai = 0; ai < 2; ++ai)
#pragma unroll
            for (int m = 0; m < 4; ++m) {
                const int r = ai * HALF + wr * 64 + m * 16 + fr; const int idx = u.pm * BM + r;
                if (idx < u.cnt) { const int ent = list[u.e * T + idx]; bf16_t* rowp = Y2 + (size_t)ent * D + col0;
#pragma unroll
                    for (int bj = 0; bj < 2; ++bj) { const f32x4 v0 = acc[ai][bj][m][0], v1 = acc[ai][bj][m][1];
                        u32x4 w; w.x = cvt_pk_bf16(v0[0], v0[1]); w.y = cvt_pk_bf16(v0[2], v0[3]); w.z = cvt_pk_bf16(v1[0], v1[1]); w.w = cvt_pk_bf16(v1[2], v1[3]);
                        *(u32x4*)(rowp + bj * HALF) = w; } }
            }
    }
};

constexpr int NXT_OFF = 131072 + 4096;
template <class Epi, class Sched>
__device__ __forceinline__ void gemm_phase(LAS unsigned char* lds, int wave_id, const Gemm g, const Sched& S, const Epi& E) {
    int lane; asm volatile("v_mbcnt_lo_u32_b32 %0, -1, 0\n\tv_mbcnt_hi_u32_b32 %0, -1, %0" : "=v"(lane));
    const int wid = wave_id, tid = wid * 64 + lane, wr = wid >> 2, wc = wid & 3, fr = lane & 15, fq = lane >> 4;
    const int K = g.K, nt = K / 128;
    unsigned voffB[2];
#pragma unroll
    for (int i = 0; i < 2; ++i) { int R, C; stage_rc(tid * 16 + i * 8192, R, C); const int Rb = Epi::PERM ? ((R & ~31) + perm32(R & 31)) : R; voffB[i] = (unsigned)(Rb * K + 2 * C); }
    const unsigned ldsw = (unsigned)wid * 1024u;
    const int aoff = lds_byte(wr * 64 + fr, 16 * (fq & 1)) + (fq >> 1) * 1024, boff = lds_byte(wc * 32 + fr, 16 * (fq & 1)) + (fq >> 1) * 1024;
    LAS unsigned char* ldsB = lds + 4 * HTB + boff;
    LAS unsigned char* ldsA = lds + aoff;
    const int sc_act = g.sc_a;
#define PG8_SA(b, h) (((b) * 2 + (h)) * HTB)
#define PG8_SB(b, h) ((4 + (b) * 2 + (h)) * HTB)
#define PG8_STAGE(bufoff, rsrc, soff, voff) do { _Pragma("unroll") for (int _i = 0; _i < 2; ++_i) \
        __builtin_amdgcn_raw_ptr_buffer_load_lds(rsrc, (LAS void*)(lds + (bufoff) + ldsw + _i * 8192), 16, (int)(voff)[_i], (int)(soff), 0, 0); } while (0)
#define PG8_LD32(dstv, addr) do { const u32x4 _c0 = *(const LAS u32x4*)(lds + (addr)), _c1 = *(const LAS u32x4*)(lds + (addr) + 16); dstv = (i32x8){(int)_c0.x, (int)_c0.y, (int)_c0.z, (int)_c0.w, (int)_c1.x, (int)_c1.y, (int)_c1.z, (int)_c1.w}; } while (0)
#define PG8_LDA(dst, b, h) do { _Pragma("unroll") for (int m = 0; m < 4; ++m) { const u32x4 _c0 = *(const LAS u32x4*)(ldsA + PG8_SA(b, h) + m * 2048), _c1 = *(const LAS u32x4*)(ldsA + PG8_SA(b, h) + m * 2048 + 16); \
        dst[m] = (i32x8){(int)_c0.x, (int)_c0.y, (int)_c0.z, (int)_c0.w, (int)_c1.x, (int)_c1.y, (int)_c1.z, (int)_c1.w}; } } while (0)
#define PG8_LDB(dst, b, h) do { _Pragma("unroll") for (int n = 0; n < 2; ++n) { const u32x4 _c0 = *(const LAS u32x4*)(ldsB + ((b) * 2 + (h)) * HTB + n * 2048), _c1 = *(const LAS u32x4*)(ldsB + ((b) * 2 + (h)) * HTB + n * 2048 + 16); \
        dst[n] = (i32x8){(int)_c0.x, (int)_c0.y, (int)_c0.z, (int)_c0.w, (int)_c1.x, (int)_c1.y, (int)_c1.z, (int)_c1.w}; } } while (0)
#define PG8_MMA(ai, bj, At, Bt) do { __builtin_amdgcn_sched_barrier(0); __builtin_amdgcn_s_setprio(1); _Pragma("unroll") for (int m = 0; m < 4; ++m) _Pragma("unroll") for (int n = 0; n < 2; ++n) \
        acc[ai][bj][m][n] = __builtin_amdgcn_mfma_scale_f32_16x16x128_f8f6f4(Bt[n], At[m], acc[ai][bj][m][n], 0, 0, 0, SC_W, 0, sc_act); \
        _Pragma("unroll") for (int m = 0; m < 4; ++m) asm volatile("" :: "v"(acc[ai][bj][m][0]), "v"(acc[ai][bj][m][1]));     \
        __builtin_amdgcn_s_setprio(0); __builtin_amdgcn_sched_barrier(0); } while (0)
#define PG8_WAIT_V(n) asm volatile("s_waitcnt vmcnt(" #n ")" ::: "memory")
#define PG8_WAIT_L(n) asm volatile("s_waitcnt lgkmcnt(" #n ")" ::: "memory")
#define PG8_BAR __builtin_amdgcn_s_barrier()
#define PG8_SCHED __builtin_amdgcn_sched_barrier(0)
#define PG8_AOFFS(u, o0, o1) do { _Pragma("unroll") for (int _i = 0; _i < 2; ++_i) { int _R, _C; stage_rc(tid * 16 + _i * 8192, _R, _C); \
        o0[_i] = S.arow(u, _R) * (unsigned)K + 2u * (unsigned)_C; o1[_i] = S.arow(u, HALF + _R) * (unsigned)K + 2u * (unsigned)_C; } } while (0)
    Unit cur, nxt; int ui = 0;
    if (!S.next(0, cur)) return;
    f32x4 acc[2][2][4][2];
#pragma unroll
    for (int a = 0; a < 2; ++a)
#pragma unroll
        for (int b = 0; b < 2; ++b)
#pragma unroll
            for (int m = 0; m < 4; ++m)
#pragma unroll
                for (int n = 0; n < 2; ++n) acc[a][b][m][n] = (f32x4){0.f, 0.f, 0.f, 0.f};
    i32x8 At[4], B0[2], B1[2];
    unsigned cA0[2], cA1[2];
    PG8_AOFFS(cur, cA0, cA1);
    const __amdgpu_buffer_rsrc_t rA = __builtin_amdgcn_make_buffer_rsrc((void*)g.A, (short)0, (int)g.abytes, 0x00020000);
    const __amdgpu_buffer_rsrc_t rB = __builtin_amdgcn_make_buffer_rsrc((void*)g.Bt, (short)0, (int)g.bbytes, 0x00020000);
    const unsigned kstep = (unsigned)(BK * 2);
    const unsigned hstep = (unsigned)HALF * (unsigned)K;
    unsigned cB = (unsigned)cur.brow0 * (unsigned)K;
    PG8_STAGE(PG8_SB(0, 0), rB, cB, voffB); PG8_STAGE(PG8_SB(0, 1), rB, cB + hstep, voffB); PG8_STAGE(PG8_SA(0, 0), rA, 0u, cA0); PG8_STAGE(PG8_SA(0, 1), rA, 0u, cA1);
    if (wr == 1) PG8_BAR;
    PG8_WAIT_V(2); PG8_BAR;
    PG8_STAGE(PG8_SB(1, 0), rB, cB + kstep, voffB); PG8_STAGE(PG8_SA(1, 0), rA, kstep, cA0); PG8_STAGE(PG8_SB(1, 1), rB, cB + hstep + kstep, voffB);
    PG8_WAIT_V(6); PG8_BAR;
#define PG8_PAIR(a1, a2, b2, SWITCH) do { \
            PG8_LDB(B0, 0, 0); PG8_LDB(B1, 0, 1); PG8_SCHED; PG8_LDA(At, 0, 0); PG8_STAGE(PG8_SA(1, 1), rA, a1, cA1); \
            SWITCH; \
            PG8_WAIT_V(8); PG8_WAIT_L(0); PG8_BAR; PG8_MMA(0, 0, At, B0); PG8_MMA(0, 1, At, B1); PG8_BAR; PG8_SCHED; \
            PG8_LDA(At, 0, 1); PG8_STAGE(PG8_SB(0, 0), rB, b2, voffB); PG8_STAGE(PG8_SB(0, 1), rB, (b2) + hstep, voffB); PG8_STAGE(PG8_SA(0, 0), rA, a2, cA0); \
            PG8_WAIT_V(8); PG8_WAIT_L(0); PG8_BAR; PG8_MMA(1, 0, At, B0); PG8_MMA(1, 1, At, B1); PG8_BAR; PG8_SCHED; \
            PG8_LDB(B0, 1, 0); PG8_LDB(B1, 1, 1); PG8_SCHED; PG8_LDA(At, 1, 0); PG8_STAGE(PG8_SA(0, 1), rA, a2, cA1); \
            PG8_WAIT_V(8); PG8_WAIT_L(0); PG8_BAR; PG8_MMA(0, 0, At, B0); PG8_MMA(0, 1, At, B1); PG8_BAR; PG8_SCHED; \
            PG8_LDA(At, 1, 1); PG8_STAGE(PG8_SB(1, 0), rB, (b2) + kstep, voffB); PG8_STAGE(PG8_SB(1, 1), rB, (b2) + kstep + hstep, voffB); PG8_STAGE(PG8_SA(1, 0), rA, (a2) + kstep, cA0); \
            PG8_WAIT_V(8); PG8_WAIT_L(0); PG8_BAR; PG8_MMA(1, 0, At, B0); PG8_MMA(1, 1, At, B1); PG8_BAR; PG8_SCHED; } while (0)
    for (;;) {
        const bool has_next = S.next(ui + 1, nxt);
        const unsigned nB = has_next ? (unsigned)nxt.brow0 * (unsigned)K : cB;
        unsigned dlt = 0u;
        if constexpr (Sched::CONTIG) { dlt = has_next ? (unsigned)(nxt.arow0 - cur.arow0) * (unsigned)K : 0u; }
        else { unsigned n0[2], n1[2]; if (has_next) { PG8_AOFFS(nxt, n0, n1); } else { n0[0] = cA0[0]; n0[1] = cA0[1]; n1[0] = cA1[0]; n1[1] = cA1[1]; }
          *((LAS u32x4*)(lds + NXT_OFF) + tid) = (u32x4){n0[0], n0[1], n1[0], n1[1]}; }
        for (int t = 0; t < nt - 2; t += 2) {
            const unsigned a1 = (unsigned)(t + 1) * kstep, a2 = (unsigned)(t + 2) * kstep, b2 = cB + (unsigned)(t + 2) * kstep;
            PG8_PAIR(a1, a2, b2, (void)0);
        }
        {
            const unsigned a1 = (unsigned)(nt - 1) * kstep;
            PG8_PAIR(a1, 0u, nB, do { if constexpr (Sched::CONTIG) { cA0[0] += dlt; cA0[1] += dlt; cA1[0] += dlt; cA1[1] += dlt; } else { const u32x4 _n = *((LAS u32x4*)(lds + NXT_OFF) + tid); cA0[0] = _n.x; cA0[1] = _n.y; cA1[0] = _n.z; cA1[1] = _n.w; } } while (0));
        }
        { int l2; asm volatile("v_mbcnt_lo_u32_b32 %0, -1, 0\n\tv_mbcnt_hi_u32_b32 %0, -1, %0" : "=v"(l2));
          E(acc, cur, wr, wc, l2 & 15, l2 >> 4); S.done(cur, l2); }
        if (!has_next) break;
#pragma unroll
        for (int a = 0; a < 2; ++a)
#pragma unroll
            for (int b = 0; b < 2; ++b)
#pragma unroll
                for (int m = 0; m < 4; ++m)
#pragma unroll
                    for (int n = 0; n < 2; ++n) acc[a][b][m][n] = (f32x4){0.f, 0.f, 0.f, 0.f};
        cur = nxt; cB = nB; ++ui;
    }
    PG8_WAIT_V(0);
    if (wr == 0) PG8_BAR;
    PG8_BAR;
#undef PG8_PAIR
#undef PG8_AOFFS
#undef PG8_SA
#undef PG8_SB
#undef PG8_STAGE
#undef PG8_LDA
#undef PG8_LDB
#undef PG8_MMA
#undef PG8_WAIT_V
#undef PG8_WAIT_L
#undef PG8_BAR
#undef PG8_SCHED
}
struct Gemm16 { const bf16_t* A; const bf16_t* Bt; int K; unsigned abytes, bbytes; };
struct EpiGateUp16 {
    static constexpr bool PERM = true;
    bf16_t* HID; const int* list; const float* gatew;
    __device__ __forceinline__ void operator()(const f32x4 (&acc)[2][2][4][2], const Unit& u, int wr, int wc, int fr, int fq) const {
        const int col0 = u.pn * 128 + wc * 32 + 8 * fq;
#pragma unroll
        for (int ai = 0; ai < 2; ++ai)
#pragma unroll
            for (int m = 0; m < 4; ++m) {
                const int r = ai * HALF + wr * 64 + m * 16 + fr; const int idx = u.pm * BM + r;
                float wgt = 0.f; if (idx < u.cnt) wgt = gatew[list[u.e * T + idx]];
                const f32x4 g0 = acc[ai][0][m][0], g1 = acc[ai][0][m][1], u0 = acc[ai][1][m][0], u1 = acc[ai][1][m][1];
                float h[8];
#pragma unroll
                for (int i = 0; i < 4; ++i) { h[i] = siluf_(g0[i]) * u0[i] * wgt; h[4 + i] = siluf_(g1[i]) * u1[i] * wgt; }
                u32x4 w; w.x = cvt_pk_bf16(h[0], h[1]); w.y = cvt_pk_bf16(h[2], h[3]); w.z = cvt_pk_bf16(h[4], h[5]); w.w = cvt_pk_bf16(h[6], h[7]);
                *(u32x4*)(HID + (size_t)(u.arow0 + r) * DEXP + col0) = w;
            }
    }
};
template <class Epi, class Sched>
__device__ __forceinline__ void gemm_phase16(LAS unsigned char* lds, int wave_id, const Gemm16 g, const Sched& S, const Epi& E) {
    int lane; asm volatile("v_mbcnt_lo_u32_b32 %0, -1, 0\n\tv_mbcnt_hi_u32_b32 %0, -1, %0" : "=v"(lane));
    const int wid = wave_id, tid = wid * 64 + lane, wr = wid >> 2, wc = wid & 3, fr = lane & 15, fq = lane >> 4;
    const int K = g.K, nt = K / BK;
    unsigned voffB[2];
#pragma unroll
    for (int i = 0; i < 2; ++i) { int R, C; stage_rc(tid * 16 + i * 8192, R, C); const int Rb = Epi::PERM ? ((R & ~31) + perm32(R & 31)) : R; voffB[i] = (unsigned)(Rb * K + C) * 2u; }
    const unsigned ldsw = (unsigned)wid * 1024u;
    const int aoff = lds_byte(wr * 64 + fr, fq * 8), boff = lds_byte(wc * 32 + fr, fq * 8);
#define PG8_SA(b, h) (((b) * 2 + (h)) * HTB)
#define PG8_SB(b, h) ((4 + (b) * 2 + (h)) * HTB)
#define PG8_STAGE(bufoff, rsrc, soff, voff) do { _Pragma("unroll") for (int _i = 0; _i < 2; ++_i) \
        __builtin_amdgcn_raw_ptr_buffer_load_lds(rsrc, (LAS void*)(lds + (bufoff) + ldsw + _i * 8192), 16, (int)(voff)[_i], (int)(soff), 0, 0); } while (0)
#define PG8_LDA(dst, b, h) do { _Pragma("unroll") for (int m = 0; m < 4; ++m) _Pragma("unroll") for (int k = 0; k < 2; ++k) dst[m][k] = *(const LAS bf16x8*)(lds + PG8_SA(b, h) + aoff + m * 2048 + k * 1024); } while (0)
#define PG8_LDB(dst, b, h) do { _Pragma("unroll") for (int n = 0; n < 2; ++n) _Pragma("unroll") for (int k = 0; k < 2; ++k) dst[n][k] = *(const LAS bf16x8*)(lds + PG8_SB(b, h) + boff + n * 2048 + k * 1024); } while (0)
#define PG8_MMA(ai, bj, At, Bt) do { __builtin_amdgcn_s_setprio(1); _Pragma("unroll") for (int m = 0; m < 4; ++m) _Pragma("unroll") for (int n = 0; n < 2; ++n) _Pragma("unroll") for (int k = 0; k < 2; ++k) \
        acc[ai][bj][m][n] = __builtin_amdgcn_mfma_f32_16x16x32_bf16(Bt[n][k], At[m][k], acc[ai][bj][m][n], 0, 0, 0); __builtin_amdgcn_s_setprio(0); } while (0)
#define PG8_WAIT_V(n) asm volatile("s_waitcnt vmcnt(" #n ")" ::: "memory")
#define PG8_WAIT_L(n) asm volatile("s_waitcnt lgkmcnt(" #n ")" ::: "memory")
#define PG8_BAR __builtin_amdgcn_s_barrier()
#define PG8_SCHED __builtin_amdgcn_sched_barrier(0)
#define PG8_AOFFS(u, o0, o1) do { _Pragma("unroll") for (int _i = 0; _i < 2; ++_i) { int _R, _C; stage_rc(tid * 16 + _i * 8192, _R, _C); \
        o0[_i] = (S.arow(u, _R) * (unsigned)K + (unsigned)_C) * 2u; o1[_i] = (S.arow(u, HALF + _R) * (unsigned)K + (unsigned)_C) * 2u; } } while (0)
    Unit cur, nxt; int ui = 0;
    typename Sched::State st;
    if (!S.first(st, cur, tid)) return;
    f32x4 acc[2][2][4][2];
#pragma unroll
    for (int a = 0; a < 2; ++a)
#pragma unroll
        for (int b = 0; b < 2; ++b)
#pragma unroll
            for (int m = 0; m < 4; ++m)
#pragma unroll
                for (int n = 0; n < 2; ++n) acc[a][b][m][n] = (f32x4){0.f, 0.f, 0.f, 0.f};
    bf16x8 At[4][2], B0[2][2], B1[2][2];
    unsigned cA0[2], cA1[2];
    PG8_AOFFS(cur, cA0, cA1);
    const __amdgpu_buffer_rsrc_t rA = __builtin_amdgcn_make_buffer_rsrc((void*)g.A, (short)0, (int)g.abytes, 0x00020000);
    const __amdgpu_buffer_rsrc_t rB = __builtin_amdgcn_make_buffer_rsrc((void*)g.Bt, (short)0, (int)g.bbytes, 0x00020000);
    const unsigned kstep = (unsigned)(BK * 2);
    const unsigned hstep = (unsigned)HALF * (unsigned)K * 2u;
    unsigned cB = (unsigned)cur.brow0 * (unsigned)K * 2u;
    PG8_STAGE(PG8_SB(0, 0), rB, cB, voffB); PG8_STAGE(PG8_SB(0, 1), rB, cB + hstep, voffB); PG8_STAGE(PG8_SA(0, 0), rA, 0u, cA0); PG8_STAGE(PG8_SA(0, 1), rA, 0u, cA1);
    if (wr == 1) PG8_BAR;
    PG8_WAIT_V(2); PG8_BAR;
    PG8_STAGE(PG8_SB(1, 0), rB, cB + kstep, voffB); PG8_STAGE(PG8_SA(1, 0), rA, kstep, cA0); PG8_STAGE(PG8_SB(1, 1), rB, cB + hstep + kstep, voffB);
    PG8_WAIT_V(6); PG8_BAR;
#define PG8_PAIR(a1, a2, b2, SWITCH) do { \
            PG8_LDB(B0, 0, 0); PG8_LDB(B1, 0, 1); PG8_SCHED; PG8_LDA(At, 0, 0); PG8_STAGE(PG8_SA(1, 1), rA, a1, cA1); \
            SWITCH; \
            PG8_WAIT_V(8); PG8_WAIT_L(0); PG8_BAR; PG8_MMA(0, 0, At, B0); PG8_MMA(0, 1, At, B1); PG8_BAR; PG8_SCHED; \
            PG8_LDA(At, 0, 1); PG8_STAGE(PG8_SB(0, 0), rB, b2, voffB); PG8_STAGE(PG8_SB(0, 1), rB, (b2) + hstep, voffB); PG8_STAGE(PG8_SA(0, 0), rA, a2, cA0); \
            PG8_WAIT_V(8); PG8_WAIT_L(0); PG8_BAR; PG8_MMA(1, 0, At, B0); PG8_MMA(1, 1, At, B1); PG8_BAR; PG8_SCHED; \
            PG8_LDB(B0, 1, 0); PG8_LDB(B1, 1, 1); PG8_SCHED; PG8_LDA(At, 1, 0); PG8_STAGE(PG8_SA(0, 1), rA, a2, cA1); \
            PG8_WAIT_V(8); PG8_WAIT_L(0); PG8_BAR; PG8_MMA(0, 0, At, B0); PG8_MMA(0, 1, At, B1); PG8_BAR; PG8_SCHED; \
            PG8_LDA(At, 1, 1); PG8_STAGE(PG8_SB(1, 0), rB, (b2) + kstep, voffB); PG8_STAGE(PG8_SB(1, 1), rB, (b2) + kstep + hstep, voffB); PG8_STAGE(PG8_SA(1, 0), rA, (a2) + kstep, cA0); \
            PG8_WAIT_V(8); PG8_WAIT_L(0); PG8_BAR; PG8_MMA(1, 0, At, B0); PG8_MMA(1, 1, At, B1); PG8_BAR; PG8_SCHED; } while (0)
    for (;;) {
        S.issue(st, ui + 1, tid);
        for (int t = 0; t < nt - 2; t += 2) {
            const unsigned a1 = (unsigned)(t + 1) * kstep, a2 = (unsigned)(t + 2) * kstep, b2 = cB + (unsigned)(t + 2) * kstep;
            PG8_PAIR(a1, a2, b2, (void)0);
        }
        const bool has_next = S.fin(st, ui + 1, nxt, tid);
        const unsigned nB = has_next ? (unsigned)nxt.brow0 * (unsigned)K * 2u : cB;
        {
            const unsigned a1 = (unsigned)(nt - 1) * kstep;
            PG8_PAIR(a1, 0u, nB, do { if (has_next) { PG8_AOFFS(nxt, cA0, cA1); } } while (0));
        }
        if (wr == 0) PG8_BAR;
        { int l2; asm volatile("v_mbcnt_lo_u32_b32 %0, -1, 0\n\tv_mbcnt_hi_u32_b32 %0, -1, %0" : "=v"(l2));
          E(acc, cur, wr, wc, l2 & 15, l2 >> 4); S.done(cur, l2); }
        if (!has_next) break;
#pragma unroll
        for (int a = 0; a < 2; ++a)
#pragma unroll
            for (int b = 0; b < 2; ++b)
#pragma unroll
                for (int m = 0; m < 4; ++m)
#pragma unroll
                    for (int n = 0; n < 2; ++n) acc[a][b][m][n] = (f32x4){0.f, 0.f, 0.f, 0.f};
        cur = nxt; cB = nB; ++ui;
        if (wr == 1) PG8_BAR;
    }
    PG8_WAIT_V(0);
    PG8_BAR;
#undef PG8_PAIR
#undef PG8_AOFFS
#undef PG8_SA
#undef PG8_SB
#undef PG8_STAGE
#undef PG8_LDA
#undef PG8_LDB
#undef PG8_MMA
#undef PG8_WAIT_V
#undef PG8_WAIT_L
#undef PG8_BAR
#undef PG8_SCHED
}
}

#define XB_TMO      128
#define XB_XCNT(j)  (256  + 64 * (j))
#define XB_XSUB(j)  (1280 + 64 * (j))
#define XB_XGEN(j)  (2304 + 64 * (j))
#define XB_TOP      3328
#define XB_TOPGEN   3392
#define XCD_BAR_WORDS 3456
#define XB_SPIN_CAP (1u << 20)
__device__ __forceinline__ unsigned xb_ld(unsigned* p)              { return __hip_atomic_load(p, __ATOMIC_RELAXED, __HIP_MEMORY_SCOPE_AGENT); }
__device__ __forceinline__ unsigned xb_add(unsigned* p, unsigned v) { return __hip_atomic_fetch_add(p, v, __ATOMIC_RELAXED, __HIP_MEMORY_SCOPE_AGENT); }
__device__ __forceinline__ unsigned xb_xcc_id() { return (unsigned)__builtin_amdgcn_s_getreg((3 << 11) | 20) & 0xFu; }
#define XB_SPIN(cond, bar) do { unsigned _sp = 0; while (cond) { __builtin_amdgcn_s_sleep(1); \
    if ((++_sp & 255u) == 0u) { if (xb_ld(&(bar)[XB_TMO])) break; if (_sp > XB_SPIN_CAP) { atomicAdd(&(bar)[XB_TMO], 1u); break; } } } } while (0)
__device__ __forceinline__ void xcd_barrier_complete(unsigned* bar, unsigned x, unsigned& nloc, unsigned& nx) {
    const unsigned G = gridDim.x;
    unsigned sum, cnt, mine, sp = 0u;
    for (;;) {
        sum = 0u; cnt = 0u; mine = 0u;
#pragma unroll
        for (unsigned j = 0; j < 16; ++j) { const unsigned c = xb_ld(&bar[XB_XCNT(j)]); sum += c; cnt += (c > 0u) ? 1u : 0u; mine = (j == x) ? c : mine; }
        if (sum == G) break;
        __builtin_amdgcn_s_sleep(1);
        if ((++sp & 255u) == 0u) { if (xb_ld(&bar[XB_TMO])) break; if (sp > XB_SPIN_CAP) { atomicAdd(&bar[XB_TMO], 1u); break; } }
    }
    nloc = mine > 0u ? mine : 1u; nx = cnt > 0u ? cnt : 1u;
}
__device__ __forceinline__ void xcd_barrier(unsigned* bar, volatile LAS unsigned* st, int wave) {
    asm volatile("s_waitcnt vmcnt(0) lgkmcnt(0)" ::: "memory");
    __syncthreads();
    int lane; asm volatile("v_mbcnt_lo_u32_b32 %0, -1, 0\n\tv_mbcnt_hi_u32_b32 %0, -1, %0" : "=v"(lane));
    if (wave == 0 && lane == 0) {
        __builtin_amdgcn_s_waitcnt(0);
        const unsigned x = xb_xcc_id();
        unsigned nloc = st[0], nx = st[1];
        if (nloc == 0u) { xcd_barrier_complete(bar, x, nloc, nx); st[0] = nloc; st[1] = nx; }
        const unsigned old = xb_add(&bar[XB_XSUB(x)], 1u);
        const unsigned gen = old / nloc;
        if (old + 1u == (gen + 1u) * nloc) {
            __builtin_amdgcn_fence(__ATOMIC_RELEASE, "agent");
            asm volatile("s_waitcnt vmcnt(0)" ::: "memory");
            const unsigned og = xb_add(&bar[XB_TOP], 1u);
            const unsigned tg = og / nx;
            if (og + 1u == (tg + 1u) * nx) xb_add(&bar[XB_TOPGEN], 1u);
            else XB_SPIN(xb_ld(&bar[XB_TOPGEN]) == tg, bar);
            __builtin_amdgcn_fence(__ATOMIC_ACQUIRE, "agent");
            xb_add(&bar[XB_XGEN(x)], 1u);
            asm volatile("s_waitcnt vmcnt(0)" ::: "memory");
        } else {
            XB_SPIN(xb_ld(&bar[XB_XGEN(x)]) == gen, bar);
            __builtin_amdgcn_fence(__ATOMIC_ACQUIRE, "agent");
            asm volatile("s_waitcnt vmcnt(0)" ::: "memory");
        }
    }
    __syncthreads();
}

struct Params {
    const float* in[18];
    float* out; unsigned char* ws;
};
enum { I_X = 0, I_EV_WIN, I_EV_CONV, I_EV_ALOG, I_EV_DTB, I_EV_GDNN, I_EV_HGRNN, I_LBLOG, I_EV_WOUT, I_OD_WIN, I_OD_WOUT, I_RW, I_RB, I_MG, I_MU, I_MD, I_LNG, I_LNB };

struct Frame {
    LAS unsigned char* lds;
    int tid, lane, wave, G, bid;
};
__device__ __forceinline__ Frame refresh(const Frame& F0) {
    Frame F = F0; int l; asm volatile("v_mbcnt_lo_u32_b32 %0, -1, 0\n\tv_mbcnt_hi_u32_b32 %0, -1, %0" : "=v"(l));
    F.lane = l; F.tid = F0.wave * 64 + l; return F;
}

constexpr size_t WS_W3 = WS_AB + 16 * MiB, WS_WOUT1 = WS_WOUT + 4 * MiB, WS_WGU1 = WS_WGU + 32 * MiB;
struct CDesc { const float* src; unsigned char* dst; int ld, Kd, fp8; };
__device__ __forceinline__ CDesc conv_desc(const Params& p, unsigned char* ws, int kind, int r) {
    CDesc d;
    switch (kind) {
    case 0: { const int kb = r / 256, nb = r % 256, n0 = nb * 32; const int c0 = n0 < 4096 ? n0 : n0 + 16;
        d.src = p.in[I_EV_WIN] + (size_t)(kb * 64) * EVEN_IN + c0; d.ld = EVEN_IN; d.dst = ws + WS_WIN + (size_t)n0 * 2048 + kb * 64; d.Kd = 2048; d.fp8 = 1; break; }
    case 1: { const int kb = r / 64, nb = r % 64; d.src = p.in[I_EV_WOUT] + (size_t)(kb * 64) * 2048 + nb * 32; d.ld = 2048; d.dst = ws + WS_WOUT + (size_t)(nb * 32) * 2048 + kb * 64; d.Kd = 2048; d.fp8 = 1; break; }
    case 2: case 6: { const int layer = kind == 6; const int isup = r >= 8192; if (isup) r -= 8192;
        const int e = r / 512, q = r % 512, kb = q / 16, nb = q % 16, f0 = nb * 32;
        d.src = (isup ? p.in[I_MU] : p.in[I_MG]) + (size_t)(layer * NE + e) * 2048 * 512 + (size_t)(kb * 64) * 512 + f0; d.ld = 512;
        d.dst = ws + (layer ? WS_WGU1 : WS_WGU) + (size_t)e * 1024 * 2048 + (size_t)(256 * (f0 >> 7) + 128 * isup + (f0 & 127)) * 2048 + kb * 64; d.Kd = 2048; d.fp8 = 1; break; }
    case 3: case 7: { const int layer = kind == 7; const int e = r / 512, q = r % 512, kb = q / 64, nb = q % 64;
        d.src = p.in[I_MD] + (size_t)(layer * NE + e) * 512 * 2048 + (size_t)(kb * 64) * 2048 + nb * 32; d.ld = 2048;
        d.dst = ws + WS_WD + ((size_t)e * 2048 * 512 + (size_t)(nb * 32) * 512 + kb * 64) * 2; d.Kd = 512; d.fp8 = 0; break; }
    case 4: { const int kb = r / 192, nb = r % 192; d.src = p.in[I_OD_WIN] + (size_t)(kb * 64) * ODD_IN + nb * 32; d.ld = ODD_IN; d.dst = ws + WS_W3 + (size_t)(nb * 32) * 2048 + kb * 64; d.Kd = 2048; d.fp8 = 1; break; }
    default: { const int kb = r / 64, nb = r % 64; d.src = p.in[I_OD_WOUT] + (size_t)(kb * 64) * 2048 + nb * 32; d.ld = 2048; d.dst = ws + WS_WOUT1 + (size_t)(nb * 32) * 1024 + kb * 64; d.Kd = 1024; d.fp8 = 1; break; }
    }
    return d;
}
__device__ __forceinline__ void conv_load(const CDesc& d, int lane, float (&wv)[32]) {
    const float* wp = d.src + (size_t)(lane >> 5) * d.ld + (lane & 31);
#pragma unroll
    for (int i = 0; i < 32; ++i) wv[i] = __builtin_nontemporal_load(wp + (size_t)(2 * i) * d.ld);
}
__device__ __forceinline__ void conv_store(const CDesc& d, int lane, const float (&wv)[32], LAS float* scr) {
#pragma unroll
    for (int i = 0; i < 32; ++i) scr[(2 * i + (lane >> 5)) * 33 + (lane & 31)] = wv[i];
    LDS_WAIT(); asm volatile("" ::: "memory");
    if (d.fp8) {
        const int c = lane & 3;
#pragma unroll
        for (int j = 0; j < 2; ++j) { const int n = (lane >> 2) + 16 * j; const LAS float* sp = scr + (16 * c) * 33 + n;
            u32x4 o;
            o.x = pk4_fp8(sp[0 * 33] * W_PRE, sp[1 * 33] * W_PRE, sp[2 * 33] * W_PRE, sp[3 * 33] * W_PRE);     o.y = pk4_fp8(sp[4 * 33] * W_PRE, sp[5 * 33] * W_PRE, sp[6 * 33] * W_PRE, sp[7 * 33] * W_PRE);
            o.z = pk4_fp8(sp[8 * 33] * W_PRE, sp[9 * 33] * W_PRE, sp[10 * 33] * W_PRE, sp[11 * 33] * W_PRE);   o.w = pk4_fp8(sp[12 * 33] * W_PRE, sp[13 * 33] * W_PRE, sp[14 * 33] * W_PRE, sp[15 * 33] * W_PRE);
            *(u32x4*)(d.dst + (size_t)n * d.Kd + 16 * c) = o; }
    } else {
        const int c = lane & 7;
#pragma unroll
        for (int j = 0; j < 4; ++j) { const int n = (lane >> 3) + 8 * j; const LAS float* sp = scr + (8 * c) * 33 + n;
            u32x4 o; o.x = pk2(sp[0 * 33], sp[1 * 33]); o.y = pk2(sp[2 * 33], sp[3 * 33]); o.z = pk2(sp[4 * 33], sp[5 * 33]); o.w = pk2(sp[6 * 33], sp[7 * 33]);
            *(u32x4*)(d.dst + ((size_t)n * d.Kd + 8 * c) * 2) = o; }
    }
    LDS_WAIT(); asm volatile("" ::: "memory");
}
__device__ __forceinline__ CDesc conv_item(const Params& p, unsigned char* ws, int set, int it) {
    if (set == 0) return it < 8192 ? conv_desc(p, ws, 0, it) : conv_desc(p, ws, 1, it - 8192);
    if (set == 1) { int r = it;
        if (r < 16384) return conv_desc(p, ws, 2, r); r -= 16384;
        if (r < 8192) return conv_desc(p, ws, 3, r); r -= 8192;
        if (r < 6144) return conv_desc(p, ws, 4, r); r -= 6144;
        if (r < 1024) return conv_desc(p, ws, 5, r); r -= 1024;
        return conv_desc(p, ws, 6, r); }
    return conv_desc(p, ws, 7, it);
}
__device__ __forceinline__ void convert_set(const Params& p, const Frame& F0, int set, int w, int nw) {
    const Frame F = refresh(F0);
    LAS float* scr = (LAS float*)(F.lds + F.wave * 16384);
    unsigned char* ws = opq(p.ws);
    const int N = set == 0 ? 8192 + 2048 : set == 1 ? 16384 + 8192 + 6144 + 1024 + 16384 : 8192;
    for (int it = w; it < N; it += 2 * nw) {
        const bool two = it + nw < N;
        const CDesc d0 = conv_item(p, ws, set, it), d1 = conv_item(p, ws, set, two ? it + nw : it);
        float v0[32], v1[32];
        conv_load(d0, F.lane, v0); if (two) conv_load(d1, F.lane, v1);
        conv_store(d0, F.lane, v0, scr); if (two) conv_store(d1, F.lane, v1, scr);
    }
}

__device__ __forceinline__ void load_w16_lds(const Frame& F0, const float* W, int ld, int c0) {
    const Frame F = refresh(F0);
    LAS float* l = (LAS float*)F.lds;
    for (int i = F.tid; i < 2048 * 16; i += NTHR) { const int k = i >> 4, e = i & 15; l[e * 2048 + k] = W[(size_t)k * ld + c0 + e]; }
}
__device__ __forceinline__ float dot16(const Frame& F, const f32x4 (&v)[8]) {
    const LAS f32x4* l = (const LAS f32x4*)F.lds;
    float res = 0.f;
#pragma unroll 1
    for (int e = 0; e < 16; ++e) { float s = 0.f;
#pragma unroll
        for (int j = 0; j < 8; ++j) { const f32x4 w = l[e * 512 + 64 * j + F.lane]; s += (v[j].x * w.x + v[j].y * w.y) + (v[j].z * w.z + v[j].w * w.w); }
        s = wave_sum(s); res = (F.lane == e) ? s : res; }
    return res;
}

__device__ __forceinline__ void p0_xpass(const Params& p, const Frame& F0) {
    const Frame F = refresh(F0);
    const int gw = F.bid * NWAVES + F.wave, NGW = F.G * NWAVES;
    float* BA = (float*)(opq(p.ws) + WS_BA); bf16_t* AB = (bf16_t*)(opq(p.ws) + WS_AB);
    for (int m = gw; m < T; m += NGW) {
        const f32x4* xr = (const f32x4*)(p.in[I_X] + (size_t)m * D) + F.lane;
        f32x4 v[8];
#pragma unroll
        for (int j = 0; j < 8; ++j) v[j] = xr[64 * j];
        unsigned* o = (unsigned*)((unsigned char*)AB + (size_t)m * D) + F.lane;
#pragma unroll
        for (int j = 0; j < 8; ++j) o[64 * j] = pk4_fp8(v[j].x * X_PRE, v[j].y * X_PRE, v[j].z * X_PRE, v[j].w * X_PRE);
        const float a = dot16(F, v);
        if (F.lane < 16) BA[(size_t)m * 16 + F.lane] = a;
    }
}

constexpr size_t WS_R16A = WS_OC + 16 * MiB, WS_R16B = WS_SCR + 190 * MiB;
__device__ __forceinline__ bf16_t* r16_row(unsigned char* ws, int m) { return (bf16_t*)(ws + (m < T / 2 ? WS_R16A + (size_t)m * D * 2 : WS_R16B + (size_t)(m - T / 2) * D * 2)); }
template <bool ROUTE, bool TWO, bool RES16, bool OUT16>
__device__ __forceinline__ void ln_pass(const Params& p, const Frame& F0, const float* resid, const bf16_t* add1, int ld1, const bf16_t* add2, const float* gain, const float* bias,
                                        float* outf, bf16_t* outb, int layer) {
    const Frame F = refresh(F0);
    const int TPB = (T + F.G - 1) / F.G;
    const int mbeg = ROUTE ? F.bid * TPB + F.wave : F.bid * NWAVES + F.wave, mend = ROUTE ? min(T, (F.bid + 1) * TPB) : T, mstep = ROUTE ? NWAVES : F.G * NWAVES;
    int* SEL = (int*)(opq(p.ws) + WS_CTL + 65536);
    int* HIST = (int*)(opq(p.ws) + WS_CTL + 32768);
    LAS int* lhist = (LAS int*)(F.lds + pg8::MOE_HIST_OFF);
    float* gatew = (float*)(opq(p.ws) + WS_GATEW) + (size_t)layer * 2 * T;
    if (ROUTE) { if (F.tid < NE) lhist[F.tid] = 0; __syncthreads(); }
    f32x4 gn[8], bs[8];
#pragma unroll
    for (int j = 0; j < 8; ++j) { gn[j] = ((const f32x4*)gain)[64 * j + F.lane]; bs[j] = ((const f32x4*)bias)[64 * j + F.lane]; }
    for (int m = mbeg; m < mend; m += mstep) {
        const f32x4* xr = (const f32x4*)(resid + (size_t)m * D) + F.lane;
        const u32x2* xr16 = (const u32x2*)r16_row(opq(p.ws), m) + F.lane;
        f32x4 v[8]; float s = 0.f;
#pragma unroll
        for (int j = 0; j < 8; ++j) {
            if (RES16) { const u32x2 a = xr16[64 * j]; v[j] = (f32x4){bflo(a.x), bfhi(a.x), bflo(a.y), bfhi(a.y)} * ALPHA; }
            else v[j] = xr[64 * j] * ALPHA;
            if (add1) { const u32x2 a = ((const u32x2*)(add1 + (size_t)(TWO ? 2 * m : m) * ld1))[64 * j + F.lane]; v[j].x += bflo(a.x); v[j].y += bfhi(a.x); v[j].z += bflo(a.y); v[j].w += bfhi(a.y); }
            if (TWO) { const u32x2 a = ((const u32x2*)(add2 + (size_t)(2 * m + 1) * ld1))[64 * j + F.lane]; v[j].x += bflo(a.x); v[j].y += bfhi(a.x); v[j].z += bflo(a.y); v[j].w += bfhi(a.y); }
#ifdef DBG_SANITIZE
            if (!(fabsf(v[j].x) < 1e30f)) v[j].x = 0.f; if (!(fabsf(v[j].y) < 1e30f)) v[j].y = 0.f; if (!(fabsf(v[j].z) < 1e30f)) v[j].z = 0.f; if (!(fabsf(v[j].w) < 1e30f)) v[j].w = 0.f;
#endif
            s += (v[j].x + v[j].y) + (v[j].z + v[j].w);
        }
        const float mean = wave_sum(s) * (1.f / D); float s2 = 0.f;
#pragma unroll
        for (int j = 0; j < 8; ++j) { v[j] = v[j] - mean; s2 += (v[j].x * v[j].x + v[j].y * v[j].y) + (v[j].z * v[j].z + v[j].w * v[j].w); }
        const float rstd = 1.f / sqrtf(wave_sum(s2) * (1.f / D) + LN_EPS);
#pragma unroll
        for (int j = 0; j < 8; ++j) v[j] = v[j] * rstd * gn[j] + bs[j];
        if (OUT16) { u32x2* of = (u32x2*)r16_row(opq(p.ws), m) + F.lane;
#pragma unroll
            for (int j = 0; j < 8; ++j) { u32x2 w; w.x = pk2(v[j].x, v[j].y); w.y = pk2(v[j].z, v[j].w); of[64 * j] = w; } }
        else { f32x4* of = (f32x4*)(outf + (size_t)m * D) + F.lane;
#pragma unroll
            for (int j = 0; j < 8; ++j) of[64 * j] = v[j]; }
        if (outb) {
            { unsigned* o = (unsigned*)((unsigned char*)outb + (size_t)m * D) + F.lane;
#pragma unroll
                for (int j = 0; j < 8; ++j) o[64 * j] = pk4_fp8(v[j].x, v[j].y, v[j].z, v[j].w); } }
        if (ROUTE) {
            const float lgl = dot16(F, v);
            const float scl = 1.0f / (1.0f + expf(-lgl)), bil = scl + p.in[I_RB][F.lane & 15];
            float sc[16], bi[16];
#pragma unroll
            for (int e = 0; e < 16; ++e) { sc[e] = __builtin_bit_cast(float, __builtin_amdgcn_readlane(__builtin_bit_cast(int, scl), e)); bi[e] = __builtin_bit_cast(float, __builtin_amdgcn_readlane(__builtin_bit_cast(int, bil), e)); }
            int bg = 0; float bgs = -3.0e38f;
#pragma unroll
            for (int g = 0; g < 4; ++g) { float m1 = -3.0e38f, m2 = -3.0e38f;
#pragma unroll
                for (int k = 0; k < 4; ++k) { const float x = bi[4 * g + k]; if (x > m1) { m2 = m1; m1 = x; } else if (x > m2) m2 = x; }
                const float gs = m1 + m2; if (gs > bgs) { bgs = gs; bg = g; } }
            int i1 = 0, i2 = 0; float b1 = -3.0e38f, b2 = -3.0e38f, s1 = 0.f, s2v = 0.f;
#pragma unroll
            for (int e = 0; e < 16; ++e) { if ((e >> 2) == bg) { const float x = bi[e]; if (x > b1) { b2 = b1; i2 = i1; s2v = s1; b1 = x; i1 = e; s1 = sc[e]; } else if (x > b2) { b2 = x; i2 = e; s2v = sc[e]; } } }
            if (F.lane == 0) {
                const float den = s1 + s2v;
                SEL[m] = i1 | (i2 << 8); gatew[2 * m] = s1 / den; gatew[2 * m + 1] = s2v / den;
                __hip_atomic_fetch_add(lhist + i1, 1, __ATOMIC_RELAXED, __HIP_MEMORY_SCOPE_WORKGROUP); __hip_atomic_fetch_add(lhist + i2, 1, __ATOMIC_RELAXED, __HIP_MEMORY_SCOPE_WORKGROUP);
            }
        }
    }
    if (ROUTE) { __syncthreads(); if (F.tid < NE) HIST[F.bid * NE + F.tid] = lhist[F.tid]; }
}

__device__ __forceinline__ void moe_lists(const Params& p, const Frame& F0, int layer) {
    const Frame F = refresh(F0);
    const int* SEL = (const int*)(opq(p.ws) + WS_CTL + 65536);
    const int* HIST = (const int*)(opq(p.ws) + WS_CTL + 32768);
    int* list = (int*)(opq(p.ws) + WS_LIST) + (size_t)layer * NE * T;
    LAS int* ltot = (LAS int*)(F.lds + pg8::MOE_HIST_OFF) + 16;
    LAS int* lbase = (LAS int*)(F.lds + pg8::MOE_HIST_OFF) + 32;
    if (F.tid < NE) { ltot[F.tid] = 0; lbase[F.tid] = 0; }
    __syncthreads();
    { const int e = F.tid & 15, grp = F.tid >> 4; int base = 0, tot = 0;
#pragma unroll 8
      for (int b = grp; b < F.G; b += 32) { const int h = HIST[b * NE + e]; tot += h; if (b < F.bid) base += h; }
      __hip_atomic_fetch_add(ltot + e, tot, __ATOMIC_RELAXED, __HIP_MEMORY_SCOPE_WORKGROUP); __hip_atomic_fetch_add(lbase + e, base, __ATOMIC_RELAXED, __HIP_MEMORY_SCOPE_WORKGROUP); }
    __syncthreads();
    LAS int* ltpre = (LAS int*)(F.lds + pg8::MOE_HIST_OFF) + 48;
    LAS int* lslot = (LAS int*)(F.lds + pg8::MOE_HIST_OFF) + 64;
    if (F.tid == 0) { int sacc = 0;
#pragma unroll 1
        for (int e = 0; e < NE; ++e) { ltpre[e] = sacc; sacc += (ltot[e] + 255) >> 8; } }
    __syncthreads();
    const int TPB = (T + F.G - 1) / F.G, m0 = F.bid * TPB, m1 = min(T, m0 + TPB);
    if (F.wave == 0) {
        for (int q0 = 2 * m0; q0 < 2 * m1; q0 += 64) {
            const int q = q0 + F.lane; const bool ok = q < 2 * m1;
            int e = -1; if (ok) { const int sv = SEL[q >> 1]; e = (q & 1) ? ((sv >> 8) & 255) : (sv & 255); }
            int rank = 0, cntsame = 0;
#pragma unroll 1
            for (int k = 0; k < NE; ++k) { const unsigned long long bal = __ballot(e == k); if (e == k) { rank = __popcll(bal & ((1ull << F.lane) - 1ull)); cntsame = __popcll(bal); } }
            if (ok) { const int pos = lbase[e] + rank; list[e * T + pos] = q; lslot[q - 2 * m0] = 256 * ltpre[e] + pos; }
            __builtin_amdgcn_s_waitcnt(0);
            if (ok && rank == cntsame - 1) lbase[e] += cntsame;
            __builtin_amdgcn_s_waitcnt(0);
        }
    }
    __syncthreads();
    {
        const unsigned char* AB8 = opq(p.ws) + WS_AB; unsigned char* ABS = opq(p.ws) + WS_ABS;
        const int nt_ = m1 - m0;
        for (int t0 = F.wave; t0 < nt_; t0 += 4 * NWAVES) {
            u32x4 r0[4], r1[4];
#pragma unroll
            for (int k = 0; k < 4; ++k) { const int tt = t0 + k * NWAVES; if (tt < nt_) { const u32x4* src = (const u32x4*)(AB8 + (size_t)(m0 + tt) * D) + F.lane; r0[k] = src[0]; r1[k] = src[64]; } }
#pragma unroll
            for (int k = 0; k < 4; ++k) { const int tt = t0 + k * NWAVES; if (tt < nt_) {
#pragma unroll
                for (int jj = 0; jj < 2; ++jj) { u32x4* dst = (u32x4*)(ABS + (size_t)lslot[2 * tt + jj] * D) + F.lane; dst[0] = r0[k]; dst[64] = r1[k]; } } }
        }
    }
}

constexpr int H1LD = 8192, C_ZA = 3072, C_QB = 4096, C_FB = 5120, C_IB = 6144, C_GB = 7168;
constexpr size_t G_U0 = 0;
constexpr size_t G_WM = 32 * MiB;
constexpr size_t G_QD = 48 * MiB;
constexpr size_t G_KDT = 64 * MiB;
constexpr size_t G_QK = 80 * MiB;
constexpr size_t G_CD = 88 * MiB;
constexpr size_t H_QD = 89 * MiB;
constexpr size_t H_KI = 105 * MiB;
constexpr size_t H_KDT = 121 * MiB;
constexpr size_t H_IT = 137 * MiB;
constexpr size_t H_CD = 153 * MiB;
constexpr size_t O_A = 155 * MiB;
constexpr size_t O_B = 171 * MiB;
static_assert(O_B + 16 * MiB <= 216 * MiB, "mixer-0 scratch");

__device__ __forceinline__ f32x4 mfma32(bf16x8 a, bf16x8 b, f32x4 c) { return __builtin_amdgcn_mfma_f32_16x16x32_bf16(a, b, c, 0, 0, 0); }
__device__ __forceinline__ f32x4 mfma16(bf16x4 a, bf16x4 b, f32x4 c) { const bf16x8 a8 = {a[0], a[1], a[2], a[3], 0, 0, 0, 0}, b8 = {b[0], b[1], b[2], b[3], 0, 0, 0, 0}; return __builtin_amdgcn_mfma_f32_16x16x32_bf16(a8, b8, c, 0, 0, 0); }
__device__ __forceinline__ bf16x8 pack8(f32x4 lo, f32x4 hi) {
    u32x4 w; w.x = cvt_pk_bf16(lo[0], lo[1]); w.y = cvt_pk_bf16(lo[2], lo[3]); w.z = cvt_pk_bf16(hi[0], hi[1]); w.w = cvt_pk_bf16(hi[2], hi[3]); return __builtin_bit_cast(bf16x8, w);
}
__device__ __forceinline__ bf16x4 pack4(f32x4 v) { u32x2 w; w.x = cvt_pk_bf16(v[0], v[1]); w.y = cvt_pk_bf16(v[2], v[3]); return __builtin_bit_cast(bf16x4, w); }
__device__ __forceinline__ bf16x8 frag_perm(const LAS bf16_t* rowp, int col) {
    const u32x2 lo = *(const LAS u32x2*)(rowp + col), hi = *(const LAS u32x2*)(rowp + col + 16);
    u32x4 w; w.x = lo.x; w.y = lo.y; w.z = hi.x; w.w = hi.y; return __builtin_bit_cast(bf16x8, w);
}

__device__ __forceinline__ void gdn_pre_pair(const Params& p, const Frame& F, int unit0, int unit1) {
    const int hb = F.wave >> 2, w4 = F.wave & 3, t8 = F.tid & 255, lane = F.lane, fr = lane & 15, g = lane >> 4;
    const int unit = hb ? unit1 : unit0;
    const bool active = unit < 1024;
    const int bh = unit >> 5, ci = unit & 31, b = bh >> 3, h = bh & 7;
    const int tok0 = b * SEQ + ci * 64;
    LAS unsigned char* hl = F.lds + hb * 72192;
    LAS bf16_t* Qb = (LAS bf16_t*)(hl);
    LAS bf16_t* Kb = (LAS bf16_t*)(hl + 17408);
    LAS bf16_t* RVt = (LAS bf16_t*)(hl + 34816);
    LAS bf16_t* RKt = (LAS bf16_t*)(hl + 53248);
    LAS float* sc_g = (LAS float*)(hl + 71680);
    LAS float* sc_b = sc_g + 64;
    LAS float* Lm = (LAS float*)(hl);
    LAS bf16_t* Tb = (LAS bf16_t*)(hl + 17408);
    const bf16_t* H1 = (const bf16_t*)(opq(p.ws) + WS_H1);
    const float* BA = (const float*)(opq(p.ws) + WS_BA);
    unsigned char* scr = opq(p.ws) + WS_SCR;
    if (active) {
        if (t8 < 192) {
            const int sec = t8 >> 6, c2 = (t8 & 63) * 2;
            const int col = sec * 1024 + h * 128 + c2;
            const float* cw = p.in[I_EV_CONV] + col;
            const float w0a = cw[0], w0b = cw[1], w1a = cw[3072], w1b = cw[3073], w2a = cw[6144], w2b = cw[6145], w3a = cw[9216], w3b = cw[9217];
            float xa[3], xb[3];
#pragma unroll
            for (int k = 0; k < 3; ++k) { const int s = ci * 64 - 3 + k; unsigned v = 0u; if (s >= 0) v = *(const unsigned*)(H1 + (size_t)(b * SEQ + s) * H1LD + col); xa[k] = bflo(v); xb[k] = bfhi(v); }
#pragma unroll 1
            for (int q2 = 0; q2 < 2; ++q2) {
                unsigned vv[32];
#pragma unroll
                for (int tl = 0; tl < 32; ++tl) vv[tl] = *(const unsigned*)(H1 + (size_t)(tok0 + 32 * q2 + tl) * H1LD + col);
#pragma unroll
                for (int t2 = 0; t2 < 32; ++t2) {
                    const int tl = 32 * q2 + t2;
                    const float x3a = bflo(vv[t2]), x3b = bfhi(vv[t2]);
                    float ya = w0a * xa[0] + w1a * xa[1] + w2a * xa[2] + w3a * x3a, yb = w0b * xb[0] + w1b * xb[1] + w2b * xb[2] + w3b * x3b;
                    xa[0] = xa[1]; xa[1] = xa[2]; xa[2] = x3a; xb[0] = xb[1]; xb[1] = xb[2]; xb[2] = x3b;
                    ya = siluf_(ya); yb = siluf_(yb);
                    if (sec == 0) *(LAS unsigned*)(Qb + tl * 136 + c2) = pk2(ya, yb);
                    else if (sec == 1) *(LAS unsigned*)(Kb + tl * 136 + c2) = pk2(ya, yb);
                    else { const float be = sigmoidf_(BA[(size_t)(tok0 + tl) * 16 + h]); RVt[c2 * 72 + tl] = (bf16_t)f2bf(ya * be); RVt[(c2 + 1) * 72 + tl] = (bf16_t)f2bf(yb * be); }
                }
            }
        } else {
            const int t = tok0 + lane;
            const float ba = BA[(size_t)t * 16 + h], aa = BA[(size_t)t * 16 + 8 + h];
            const float xx = aa + p.in[I_EV_DTB][h];
            const float sp = xx > 20.f ? xx : log1pf(expf(xx));
            float gg = -expf(p.in[I_EV_ALOG][h]) * sp;
            gg += dpp_f<0x111>(gg); gg += dpp_f<0x112>(gg); gg += dpp_f<0x114>(gg); gg += dpp_f<0x118>(gg);
            { const float t0 = __builtin_bit_cast(float, __builtin_amdgcn_readlane(__builtin_bit_cast(int, gg), 15)), t1 = __builtin_bit_cast(float, __builtin_amdgcn_readlane(__builtin_bit_cast(int, gg), 31)),
                          t2 = __builtin_bit_cast(float, __builtin_amdgcn_readlane(__builtin_bit_cast(int, gg), 47));
              gg += (lane >= 16 ? t0 : 0.f) + (lane >= 32 ? t1 : 0.f) + (lane >= 48 ? t2 : 0.f); }
            sc_g[lane] = gg; sc_b[lane] = sigmoidf_(ba);
        }
    }
    __syncthreads();
    if (active) {
        bf16_t* QDg = (bf16_t*)(scr + G_QD) + (size_t)unit * 64 * 128;
#pragma unroll 2
        for (int rr = 0; rr < 16; ++rr) {
            const int r = w4 * 16 + rr;
            const unsigned qv = *(const LAS unsigned*)(Qb + r * 136 + 2 * lane), kv = *(const LAS unsigned*)(Kb + r * 136 + 2 * lane);
            const float q0 = bflo(qv), q1 = bfhi(qv), k0 = bflo(kv), k1 = bfhi(kv);
            const float sq = wave_sum(q0 * q0 + q1 * q1), sk = wave_sum(k0 * k0 + k1 * k1);
            const float rq = rsqrtf(sq + RMS_EPS) * 0.08838834764831845f, rk = rsqrtf(sk + RMS_EPS);
            const float gc = sc_g[r], be = sc_b[r], eg = expf(gc);
            const float qn0 = q0 * rq, qn1 = q1 * rq, kn0 = k0 * rk, kn1 = k1 * rk;
            *(LAS unsigned*)(Qb + r * 136 + 2 * lane) = pk2(qn0, qn1);
            *(LAS unsigned*)(Kb + r * 136 + 2 * lane) = pk2(kn0, kn1);
            RKt[(2 * lane) * 72 + r] = (bf16_t)f2bf(kn0 * be * eg); RKt[(2 * lane + 1) * 72 + r] = (bf16_t)f2bf(kn1 * be * eg);
            *(unsigned*)(QDg + r * 128 + 2 * lane) = pk2(qn0 * eg, qn1 * eg);
        }
    }
    __syncthreads();
    f32x4 kk[4];
    if (active) {
        {
            bf16_t* KDt = (bf16_t*)(scr + G_KDT) + (size_t)unit * 128 * 64;
            const float gl = sc_g[63];
#pragma unroll
            for (int it = 0; it < 4; ++it) { const int idx = t8 + 256 * it, f = idx >> 3, c0 = (idx & 7) * 8;
                float v[8];
#pragma unroll
                for (int i = 0; i < 8; ++i) v[i] = bf2f(Kb[(c0 + i) * 136 + f]) * expf(gl - sc_g[c0 + i]);
                u32x4 w; w.x = pk2(v[0], v[1]); w.y = pk2(v[2], v[3]); w.z = pk2(v[4], v[5]); w.w = pk2(v[6], v[7]);
                *(u32x4*)(KDt + f * 64 + c0) = w; }
        }
        const int mt = w4;
        bf16_t* QKm = (bf16_t*)(scr + G_QK) + (size_t)unit * 64 * 64;
        bf16x8 a[4];
#pragma unroll
        for (int kb = 0; kb < 4; ++kb) a[kb] = *(const LAS bf16x8*)(Kb + (16 * mt + fr) * 136 + 32 * kb + 8 * g);
#pragma unroll
        for (int nt = 0; nt < 4; ++nt) {
            f32x4 c = (f32x4){0.f, 0.f, 0.f, 0.f}, c2 = (f32x4){0.f, 0.f, 0.f, 0.f};
#pragma unroll
            for (int kb = 0; kb < 4; ++kb) { const bf16x8 bq = *(const LAS bf16x8*)(Qb + (16 * nt + fr) * 136 + 32 * kb + 8 * g), bk = *(const LAS bf16x8*)(Kb + (16 * nt + fr) * 136 + 32 * kb + 8 * g);
                c = mfma32(a[kb], bq, c); c2 = mfma32(a[kb], bk, c2); }
            const int cj = 16 * nt + fr; const float gcol = sc_g[cj];
            {
                float v[4];
#pragma unroll
                for (int r = 0; r < 4; ++r) { const int j = 16 * mt + 4 * g + r; v[r] = (cj >= j) ? expf(gcol - sc_g[j]) * c[r] : 0.f; }
                u32x2 w; w.x = pk2(v[0], v[1]); w.y = pk2(v[2], v[3]);
                *(u32x2*)(QKm + cj * 64 + 16 * mt + 4 * g) = w;
            }
#pragma unroll
            for (int r = 0; r < 4; ++r) { const int i = 16 * mt + 4 * g + r; kk[nt][r] = (i > cj) ? sc_b[i] * expf(sc_g[i] - gcol) * c2[r] : 0.f; }
        }
    }
    __syncthreads();
    if (active) {
#pragma unroll
        for (int nt = 0; nt < 4; ++nt)
#pragma unroll
            for (int r = 0; r < 4; ++r) Lm[(16 * w4 + 4 * g + r) * 68 + 16 * nt + fr] = kk[nt][r];
    }
    __syncthreads();
    if (active && w4 == 0) {
        float t[64];
#pragma unroll
        for (int i = 0; i < 64; ++i) t[i] = 0.f;
#pragma unroll
        for (int i = 0; i < 64; ++i) {
            float a0 = (i == lane) ? 1.f : 0.f, a1 = 0.f, a2 = 0.f, a3 = 0.f;
#pragma unroll
            for (int jj = 0; jj < (i + 3) / 4; ++jj) { const f32x4 lv = *(const LAS f32x4*)(Lm + i * 68 + 4 * jj);
                a0 -= lv[0] * t[4 * jj]; a1 -= lv[1] * t[4 * jj + 1]; a2 -= lv[2] * t[4 * jj + 2]; a3 -= lv[3] * t[4 * jj + 3]; }
            t[i] = (a0 + a1) + (a2 + a3);
        }
#pragma unroll
        for (int i = 0; i < 64; ++i) Tb[i * 72 + lane] = (bf16_t)f2bf(t[i]);
    }
    __syncthreads();
    if (active) {
        f32x4* U0f = (f32x4*)(scr + G_U0) + (size_t)unit * 8 * 4 * 64;
        bf16_t* Wm = (bf16_t*)(scr + G_WM) + (size_t)unit * 64 * 128;
#pragma unroll
        for (int hh = 0; hh < 2; ++hh) {
            const int ct = w4 + 4 * hh;
            bf16x8 bv[2], ak[2];
#pragma unroll
            for (int k = 0; k < 2; ++k) { bv[k] = *(const LAS bf16x8*)(RVt + (16 * ct + fr) * 72 + 32 * k + 8 * g); ak[k] = *(const LAS bf16x8*)(RKt + (16 * ct + fr) * 72 + 32 * k + 8 * g); }
#pragma unroll
            for (int mt = 0; mt < 4; ++mt) {
                f32x4 c = (f32x4){0.f, 0.f, 0.f, 0.f}, c2 = (f32x4){0.f, 0.f, 0.f, 0.f};
#pragma unroll
                for (int k = 0; k < 2; ++k) { const bf16x8 tt = *(const LAS bf16x8*)(Tb + (16 * mt + fr) * 72 + 32 * k + 8 * g); c = mfma32(tt, bv[k], c); c2 = mfma32(ak[k], tt, c2); }
                U0f[(ct * 4 + mt) * 64 + lane] = c;
                u32x2 w; w.x = pk2(-c2[0], -c2[1]); w.y = pk2(-c2[2], -c2[3]);
                *(u32x2*)(Wm + (16 * mt + fr) * 128 + 16 * ct + 4 * g) = w;
            }
        }
        if (t8 == 0) ((float*)(scr + G_CD))[unit] = expf(sc_g[63]);
    }
    __syncthreads();
}

__device__ __forceinline__ void hgrn_pre_unit(const Params& p, const Frame& F, int tc) {
    const int col = 2 * F.tid, h = col >> 7, f = col & 127;
    const float* lbl = p.in[I_LBLOG];
    float lb[2];
#pragma unroll
    for (int k = 0; k < 2; ++k) { const float l0 = lbl[col + k], l1 = lbl[1024 + col + k], l2 = lbl[2048 + col + k]; const float m = fmaxf(l0, fmaxf(l1, l2));
        const float e0 = expf(l0 - m), e1 = expf(l1 - m), e2 = expf(l2 - m); lb[k] = e0 / (e0 + e1 + e2); }
    const int t0 = tc * 16, b = t0 / SEQ, chunk = (t0 % SEQ) >> 4, bh = b * 8 + h;
    const bf16_t* H1 = (const bf16_t*)(opq(p.ws) + WS_H1);
    unsigned char* scr = opq(p.ws) + WS_SCR;
    float bc0[16], bc1[16], kk0[16], kk1[16]; unsigned iv[16];
    float cum0 = 0.f, cum1 = 0.f;
#pragma unroll
    for (int c = 0; c < 16; ++c) {
        const size_t row = (size_t)(t0 + c);
        const unsigned qv = *(const unsigned*)(H1 + row * H1LD + C_QB + col), fv = *(const unsigned*)(H1 + row * H1LD + C_FB + col);
        iv[c] = *(const unsigned*)(H1 + row * H1LD + C_IB + col);
        const float f0 = lb[0] + (1.f - lb[0]) * sigmoidf_(bflo(fv)), f1 = lb[1] + (1.f - lb[1]) * sigmoidf_(bfhi(fv));
        cum0 += logf(f0); cum1 += logf(f1);
        bc0[c] = cum0; bc1[c] = cum1; kk0[c] = 1.f - f0; kk1[c] = 1.f - f1;
        *(unsigned*)((bf16_t*)(scr + H_QD) + row * 1024 + col) = pk2(bflo(qv) * expf(cum0), bfhi(qv) * expf(cum1));
        *(unsigned*)((bf16_t*)(scr + H_KI) + row * 1024 + col) = pk2(kk0[c] * expf(-cum0), kk1[c] * expf(-cum1));
    }
    unsigned kd0[8], kd1[8], i0[8], i1[8];
#pragma unroll
    for (int c = 0; c < 16; c += 2) {
        kd0[c >> 1] = pk2(kk0[c] * expf(cum0 - bc0[c]), kk0[c + 1] * expf(cum0 - bc0[c + 1]));
        kd1[c >> 1] = pk2(kk1[c] * expf(cum1 - bc1[c]), kk1[c + 1] * expf(cum1 - bc1[c + 1]));
        i0[c >> 1] = (iv[c] & 0xffffu) | (iv[c + 1] << 16);
        i1[c >> 1] = (iv[c] >> 16) | (iv[c + 1] & 0xffff0000u);
    }
    const size_t base = ((size_t)(bh * 128 + chunk) * 128 + f) * 16;
    u32x4* kd = (u32x4*)((bf16_t*)(scr + H_KDT) + base); u32x4* it = (u32x4*)((bf16_t*)(scr + H_IT) + base);
    kd[0] = (u32x4){kd0[0], kd0[1], kd0[2], kd0[3]}; kd[1] = (u32x4){kd0[4], kd0[5], kd0[6], kd0[7]};
    kd[2] = (u32x4){kd1[0], kd1[1], kd1[2], kd1[3]}; kd[3] = (u32x4){kd1[4], kd1[5], kd1[6], kd1[7]};
    it[0] = (u32x4){i0[0], i0[1], i0[2], i0[3]}; it[1] = (u32x4){i0[4], i0[5], i0[6], i0[7]};
    it[2] = (u32x4){i1[0], i1[1], i1[2], i1[3]}; it[3] = (u32x4){i1[4], i1[5], i1[6], i1[7]};
    *(f32x2*)((float*)(scr + H_CD) + (size_t)(bh * 128 + chunk) * 128 + f) = (f32x2){expf(cum0), expf(cum1)};
}

__device__ __forceinline__ void p2_pre(const Params& p, const Frame& F0) {
    const Frame F = refresh(F0);
    for (int u = F.bid; u < 1024; u += 2 * F.G) gdn_pre_pair(p, F, u, u + F.G);
    for (int u = F.bid; u < 512; u += F.G) hgrn_pre_unit(p, F, u);
}

__device__ __forceinline__ void gdn_scan(const Params& p, const Frame& F0, int bh) {
    const Frame F = refresh(F0);
    const int lane = F.lane, fr = lane & 15, g = lane >> 4, wave = F.wave, b = bh >> 3, h = bh & 7;
    unsigned char* scr = opqg(p.ws) + WS_SCR;
    constexpr int BUFB = 62464, OFF_QD = 17408, OFF_KDT = 34816, OFF_QK = 53248;
    const bf16_t* gWM = (const bf16_t*)(scr + G_WM); const bf16_t* gQD = (const bf16_t*)(scr + G_QD);
    const bf16_t* gKDT = (const bf16_t*)(scr + G_KDT); const bf16_t* gQK = (const bf16_t*)(scr + G_QK);
    const f32x4* gU0 = (const f32x4*)(scr + G_U0); const float* gCD = (const float*)(scr + G_CD);
    bf16_t* OA = (bf16_t*)(scr + O_A);
    u32x4 rw[2], rq[2], rk[2], rqk; f32x4 u0c[4], u0n[4];
#define GS_ISSUE(u) do { _Pragma("unroll") for (int i = 0; i < 2; ++i) { const int idx = F.tid + 512 * i; \
        rw[i] = *(const u32x4*)(gWM + (size_t)(u) * 8192 + idx * 8); rq[i] = *(const u32x4*)(gQD + (size_t)(u) * 8192 + idx * 8); rk[i] = *(const u32x4*)(gKDT + (size_t)(u) * 8192 + idx * 8); } \
        rqk = *(const u32x4*)(gQK + (size_t)(u) * 4096 + F.tid * 8); \
        _Pragma("unroll") for (int mt = 0; mt < 4; ++mt) u0n[mt] = gU0[(((size_t)(u) * 8 + wave) * 4 + mt) * 64 + lane]; } while (0)
#define GS_WRITE(bufp) do { _Pragma("unroll") for (int i = 0; i < 2; ++i) { const int idx = F.tid + 512 * i; \
        *(LAS u32x4*)((bufp) + ((idx >> 4) * 136 + (idx & 15) * 8) * 2) = rw[i]; *(LAS u32x4*)((bufp) + OFF_QD + ((idx >> 4) * 136 + (idx & 15) * 8) * 2) = rq[i]; \
        *(LAS u32x4*)((bufp) + OFF_KDT + ((idx >> 3) * 72 + (idx & 7) * 8) * 2) = rk[i]; } \
        *(LAS u32x4*)((bufp) + OFF_QK + ((F.tid >> 3) * 72 + (F.tid & 7) * 8) * 2) = rqk; } while (0)
    f32x4 Sacc[8];
#pragma unroll
    for (int ft = 0; ft < 8; ++ft) Sacc[ft] = (f32x4){0.f, 0.f, 0.f, 0.f};
    GS_ISSUE(bh * 32);
    GS_WRITE(F.lds);
#pragma unroll
    for (int mt = 0; mt < 4; ++mt) u0c[mt] = u0n[mt];
    __syncthreads();
    float dec = ld_agent(gCD + bh * 32);
    for (int ci = 0; ci < 32; ++ci) {
        const int u = bh * 32 + ci;
        LAS unsigned char* buf = F.lds + (ci & 1) * BUFB;
        float decn = dec; if (ci + 1 < 32) decn = ld_agent(gCD + u + 1);
        if (ci + 1 < 32) GS_ISSUE(u + 1);
        const LAS bf16_t* WM = (const LAS bf16_t*)buf; const LAS bf16_t* QD = (const LAS bf16_t*)(buf + OFF_QD);
        const LAS bf16_t* KDT = (const LAS bf16_t*)(buf + OFF_KDT); const LAS bf16_t* QK = (const LAS bf16_t*)(buf + OFF_QK);
        bf16x8 Sbf[4];
#pragma unroll
        for (int kb = 0; kb < 4; ++kb) Sbf[kb] = pack8(Sacc[2 * kb], Sacc[2 * kb + 1]);
        f32x4 uacc[4], oacc[4];
#pragma unroll
        for (int mt = 0; mt < 4; ++mt) { uacc[mt] = u0c[mt]; oacc[mt] = (f32x4){0.f, 0.f, 0.f, 0.f}; }
        bf16x8 fa[8], fb[8];
#define GS_LD_UQ(dst, mt) do { _Pragma("unroll") for (int kb = 0; kb < 4; ++kb) { dst[kb] = frag_perm(WM + (16 * (mt) + fr) * 136, 32 * kb + 4 * g); dst[4 + kb] = frag_perm(QD + (16 * (mt) + fr) * 136, 32 * kb + 4 * g); } } while (0)
#define GS_MM_UQ(src, mt) do { _Pragma("unroll") for (int kb = 0; kb < 4; ++kb) { uacc[mt] = mfma32(src[kb], Sbf[kb], uacc[mt]); oacc[mt] = mfma32(src[4 + kb], Sbf[kb], oacc[mt]); } } while (0)
        GS_LD_UQ(fa, 0);
        GS_LD_UQ(fb, 1); __builtin_amdgcn_sched_barrier(0); GS_MM_UQ(fa, 0); __builtin_amdgcn_sched_barrier(0);
        GS_LD_UQ(fa, 2); __builtin_amdgcn_sched_barrier(0); GS_MM_UQ(fb, 1); __builtin_amdgcn_sched_barrier(0);
        GS_LD_UQ(fb, 3); __builtin_amdgcn_sched_barrier(0); GS_MM_UQ(fa, 2); __builtin_amdgcn_sched_barrier(0);
#pragma unroll
        for (int mt = 0; mt < 4; ++mt)
#pragma unroll
            for (int k = 0; k < 2; ++k) fa[2 * mt + k] = frag_perm(QK + (16 * mt + fr) * 72, 32 * k + 4 * g);
        __builtin_amdgcn_sched_barrier(0); GS_MM_UQ(fb, 3); __builtin_amdgcn_sched_barrier(0);
#undef GS_LD_UQ
#undef GS_MM_UQ
        bf16x8 ubf[2];
#pragma unroll
        for (int k = 0; k < 2; ++k) ubf[k] = pack8(uacc[2 * k], uacc[2 * k + 1]);
#pragma unroll
        for (int ft = 0; ft < 4; ++ft)
#pragma unroll
            for (int k = 0; k < 2; ++k) fb[2 * ft + k] = frag_perm(KDT + (16 * ft + fr) * 72, 32 * k + 4 * g);
        __builtin_amdgcn_sched_barrier(0);
#pragma unroll
        for (int mt = 0; mt < 4; ++mt)
#pragma unroll
            for (int k = 0; k < 2; ++k) oacc[mt] = mfma32(fa[2 * mt + k], ubf[k], oacc[mt]);
        __builtin_amdgcn_sched_barrier(0);
#pragma unroll
        for (int ft = 0; ft < 4; ++ft)
#pragma unroll
            for (int k = 0; k < 2; ++k) fa[2 * ft + k] = frag_perm(KDT + (16 * (4 + ft) + fr) * 72, 32 * k + 4 * g);
        __builtin_amdgcn_sched_barrier(0);
#pragma unroll
        for (int ft = 0; ft < 4; ++ft) {
            Sacc[ft] = Sacc[ft] * dec;
#pragma unroll
            for (int k = 0; k < 2; ++k) Sacc[ft] = mfma32(fb[2 * ft + k], ubf[k], Sacc[ft]);
        }
        __builtin_amdgcn_sched_barrier(0);
#pragma unroll
        for (int ft = 0; ft < 4; ++ft) {
            Sacc[4 + ft] = Sacc[4 + ft] * dec;
#pragma unroll
            for (int k = 0; k < 2; ++k) Sacc[4 + ft] = mfma32(fa[2 * ft + k], ubf[k], Sacc[4 + ft]);
        }
        dec = decn;
        {
            bf16_t* orow = OA + (size_t)(b * SEQ + ci * 64) * 1024 + h * 128 + 16 * wave + fr;
#pragma unroll
            for (int mt = 0; mt < 4; ++mt)
#pragma unroll
                for (int r = 0; r < 4; ++r) orow[(size_t)(16 * mt + 4 * g + r) * 1024] = (bf16_t)f2bf(oacc[mt][r]);
        }
        if (ci + 1 < 32) { GS_WRITE(F.lds + ((ci + 1) & 1) * BUFB);
#pragma unroll
            for (int mt = 0; mt < 4; ++mt) u0c[mt] = u0n[mt]; }
        asm volatile("s_waitcnt lgkmcnt(0)" ::: "memory"); __builtin_amdgcn_s_barrier();
    }
#undef GS_ISSUE
#undef GS_WRITE
}

__device__ __forceinline__ void hgrn_scan(const Params& p, const Frame& F0, int bh) {
    const Frame F = refresh(F0);
    const int lane = F.lane, fr = lane & 15, g = lane >> 4, wave = F.wave, b = bh >> 3, h = bh & 7;
    unsigned char* scr = opqg(p.ws) + WS_SCR;
    constexpr int BUFB = 61440, OFF_KI = 17408, OFF_KDT = 34816, OFF_CD = 59392;
    const bf16_t* gQD = (const bf16_t*)(scr + H_QD); const bf16_t* gKI = (const bf16_t*)(scr + H_KI);
    const bf16_t* gKDT = (const bf16_t*)(scr + H_KDT) + (size_t)bh * 128 * 128 * 16; const bf16_t* gIT = (const bf16_t*)(scr + H_IT) + (size_t)bh * 128 * 128 * 16;
    const float* gCD = (const float*)(scr + H_CD) + (size_t)bh * 128 * 128;
    bf16_t* OB = (bf16_t*)(scr + O_B);
    u32x4 rq[2], rk[2], rd[2], rc; u32x2 itn[4], itc[4];
#define HS_ISSUE(grp) do { _Pragma("unroll") for (int i = 0; i < 2; ++i) { const int idx = F.tid + 512 * i; const size_t go = (size_t)(b * SEQ + (grp) * 64 + (idx >> 4)) * 1024 + h * 128 + (idx & 15) * 8; \
        rq[i] = *(const u32x4*)(gQD + go); rk[i] = *(const u32x4*)(gKI + go); rd[i] = *(const u32x4*)(gKDT + (size_t)(grp) * 8192 + idx * 8); } \
        if (F.tid < 128) rc = *(const u32x4*)(gCD + (size_t)(grp) * 512 + F.tid * 4); \
        _Pragma("unroll") for (int sc = 0; sc < 4; ++sc) itn[sc] = *(const u32x2*)(gIT + ((size_t)((grp) * 4 + sc) * 128 + 16 * wave + fr) * 16 + 4 * g); } while (0)
#define HS_WRITE(bufp) do { _Pragma("unroll") for (int i = 0; i < 2; ++i) { const int idx = F.tid + 512 * i; \
        *(LAS u32x4*)((bufp) + ((idx >> 4) * 136 + (idx & 15) * 8) * 2) = rq[i]; *(LAS u32x4*)((bufp) + OFF_KI + ((idx >> 4) * 136 + (idx & 15) * 8) * 2) = rk[i]; \
        *(LAS u32x4*)((bufp) + OFF_KDT + ((idx >> 1) * 24 + (idx & 1) * 8) * 2) = rd[i]; } \
        if (F.tid < 128) *(LAS u32x4*)((bufp) + OFF_CD + F.tid * 16) = rc; } while (0)
    f32x4 Sacc[8];
#pragma unroll
    for (int ft = 0; ft < 8; ++ft) Sacc[ft] = (f32x4){0.f, 0.f, 0.f, 0.f};
    HS_ISSUE(0);
    HS_WRITE(F.lds);
#pragma unroll
    for (int sc = 0; sc < 4; ++sc) itc[sc] = itn[sc];
    __syncthreads();
    for (int grp = 0; grp < 32; ++grp) {
        LAS unsigned char* buf = F.lds + (grp & 1) * BUFB;
        if (grp + 1 < 32) HS_ISSUE(grp + 1);
        const LAS bf16_t* QD = (const LAS bf16_t*)buf; const LAS bf16_t* KI = (const LAS bf16_t*)(buf + OFF_KI);
        const LAS bf16_t* KDT = (const LAS bf16_t*)(buf + OFF_KDT); const LAS float* CD = (const LAS float*)(buf + OFF_CD);
#pragma unroll
        for (int sc = 0; sc < 4; ++sc) {
            bf16x8 qf[4], kf[4]; f32x4 dd[8]; bf16x4 kd[8];
#pragma unroll
            for (int kb = 0; kb < 4; ++kb) { qf[kb] = frag_perm(QD + (16 * sc + fr) * 136, 32 * kb + 4 * g); kf[kb] = frag_perm(KI + (16 * sc + fr) * 136, 32 * kb + 4 * g); }
#pragma unroll
            for (int ft = 0; ft < 8; ++ft) { dd[ft] = *(const LAS f32x4*)(CD + sc * 128 + 16 * ft + 4 * g); kd[ft] = *(const LAS bf16x4*)(KDT + ((sc * 128) + 16 * ft + fr) * 24 + 4 * g); }
            __builtin_amdgcn_sched_barrier(0);
            bf16x8 Sbf[4];
#pragma unroll
            for (int kb = 0; kb < 4; ++kb) Sbf[kb] = pack8(Sacc[2 * kb], Sacc[2 * kb + 1]);
            f32x4 o = (f32x4){0.f, 0.f, 0.f, 0.f}, pT = (f32x4){0.f, 0.f, 0.f, 0.f};
#pragma unroll
            for (int kb = 0; kb < 4; ++kb) {
                o = mfma32(qf[kb], Sbf[kb], o);
                pT = mfma32(kf[kb], qf[kb], pT);
            }
#pragma unroll
            for (int r = 0; r < 4; ++r) pT[r] = (fr >= 4 * g + r) ? pT[r] : 0.f;
            const bf16x4 itf = __builtin_bit_cast(bf16x4, itc[sc]);
            o = mfma16(pack4(pT), itf, o);
#pragma unroll
            for (int ft = 0; ft < 8; ++ft) Sacc[ft] = mfma16(kd[ft], itf, Sacc[ft] * dd[ft]);
            bf16_t* orow = OB + (size_t)(b * SEQ + grp * 64 + sc * 16) * 1024 + h * 128 + 16 * wave + fr;
#pragma unroll
            for (int r = 0; r < 4; ++r) orow[(size_t)(4 * g + r) * 1024] = (bf16_t)f2bf(o[r]);
        }
        if (grp + 1 < 32) { HS_WRITE(F.lds + ((grp + 1) & 1) * BUFB);
#pragma unroll
            for (int sc = 0; sc < 4; ++sc) itc[sc] = itn[sc]; }
        asm volatile("s_waitcnt lgkmcnt(0)" ::: "memory"); __builtin_amdgcn_s_barrier();
    }
#undef HS_ISSUE
#undef HS_WRITE
}

__device__ __forceinline__ void p4_gate(const Params& p, const Frame& F0) {
    const Frame F = refresh(F0);
    const int gw = F.bid * NWAVES + F.wave, NGW = F.G * NWAVES, hs = F.lane >> 4, e0 = (F.lane & 15) * 8;
    unsigned char* scr = opq(p.ws) + WS_SCR;
    const bf16_t* H1 = (const bf16_t*)(opq(p.ws) + WS_H1); bf16_t* OC = (bf16_t*)(opq(p.ws) + WS_OC);
    for (int m = gw; m < T; m += NGW) {
#pragma unroll
        for (int rr = 0; rr < 4; ++rr) {
            const int hh = rr * 4 + hs;
            const bool isb = hh >= 8; const int hd = hh & 7;
            const bf16_t* osrc = (const bf16_t*)(scr + (isb ? O_B : O_A)) + (size_t)m * 1024 + hd * 128 + e0;
            const bf16_t* zsrc = H1 + (size_t)m * H1LD + (isb ? C_GB : C_ZA) + hd * 128 + e0;
            const float* gsrc = (isb ? p.in[I_EV_HGRNN] : p.in[I_EV_GDNN]) + e0;
            const u32x4 ov = *(const u32x4*)osrc, zv = *(const u32x4*)zsrc;
            const f32x4 g0 = *(const f32x4*)gsrc, g1 = *(const f32x4*)(gsrc + 4);
            float x[8] = {bflo(ov.x), bfhi(ov.x), bflo(ov.y), bfhi(ov.y), bflo(ov.z), bfhi(ov.z), bflo(ov.w), bfhi(ov.w)};
            const float z[8] = {bflo(zv.x), bfhi(zv.x), bflo(zv.y), bfhi(zv.y), bflo(zv.z), bfhi(zv.z), bflo(zv.w), bfhi(zv.w)};
            const float gn[8] = {g0[0], g0[1], g0[2], g0[3], g1[0], g1[1], g1[2], g1[3]};
            float ss = 0.f;
#pragma unroll
            for (int i = 0; i < 8; ++i) ss += x[i] * x[i];
            ss = row16_sum(ss);
            const float rinv = rsqrtf(ss * (1.f / 128.f) + RMS_EPS);
#pragma unroll
            for (int i = 0; i < 8; ++i) x[i] = x[i] * rinv * gn[i] * siluf_(z[i]);
            u32x2 w; w.x = pk4_fp8(x[0] * A_PRE, x[1] * A_PRE, x[2] * A_PRE, x[3] * A_PRE); w.y = pk4_fp8(x[4] * A_PRE, x[5] * A_PRE, x[6] * A_PRE, x[7] * A_PRE);
            *(u32x2*)((unsigned char*)OC + (size_t)m * 2048 + hh * 128 + e0) = w;
        }
    }
}

constexpr int H3LD = 6144;
constexpr size_t A_QR = 0;
constexpr size_t A_KR = 32 * MiB;
constexpr size_t A_VT = 64 * MiB;
constexpr size_t A_OG = 96 * MiB;
constexpr size_t A_LSE = 120 * MiB;
constexpr size_t A_KPART = 121 * MiB;
constexpr float QSCALE = 0.08838834764831845f * 1.4426950408889634f;
__device__ __forceinline__ int head_dil_log2(int hd) { return hd < 4 ? 0 : hd < 8 ? 2 : hd < 12 ? 4 : 0; }
__device__ __forceinline__ int posp(int s, int dl) { return ((s & ((1 << dl) - 1)) << (11 - dl)) + (s >> dl); }

__device__ __forceinline__ void rope_unit(const Params& p, const Frame& F, int unit) {
    const int hh = unit & 1, st = (unit >> 1) & 31, b = unit >> 6, s0 = st * 64;
    const bf16_t* H3 = (const bf16_t*)(opq(p.ws) + WS_H1);
    unsigned char* scr = opq(p.ws) + WS_SCR;
    bf16_t* QR = (bf16_t*)(scr + A_QR); bf16_t* KR = (bf16_t*)(scr + A_KR); bf16_t* VT = (bf16_t*)(scr + A_VT); float* KPART = (float*)(scr + A_KPART);
    LAS float* KS = (LAS float*)F.lds;
    LAS bf16_t* VL = (LAS bf16_t*)(F.lds + 33280);
    const int tok2 = F.tid >> 4, pj = (F.tid & 15) * 4;
    float cs[2][4], sn[2][4];
#pragma unroll
    for (int tt = 0; tt < 2; ++tt)
#pragma unroll
        for (int i = 0; i < 4; ++i) { const float inv = powf(10000.0f, -(float)(pj + i) * (1.0f / 64.0f)); const float ang = (float)(s0 + tok2 + 32 * tt) * inv; sincosf(ang, &sn[tt][i], &cs[tt][i]); }
    u32x2 na[2][2], nc[2][2]; u32x4 nv[2];
#define RP_LOAD(hi_) do { const int hd_ = hh * 8 + (hi_); \
        const int qcol_ = hd_ < 12 ? hd_ * 128 : 4608 + (hd_ - 12) * 128, kcol_ = hd_ < 12 ? 1536 + hd_ * 128 : 5120 + (hd_ - 12) * 128, vcol_ = hd_ < 12 ? 3072 + hd_ * 128 : 5632 + (hd_ - 12) * 128; \
        _Pragma("unroll") for (int tt = 0; tt < 2; ++tt) { const size_t row_ = (size_t)(b * SEQ + s0 + tok2 + 32 * tt) * H3LD; \
            _Pragma("unroll") for (int qk = 0; qk < 2; ++qk) { const bf16_t* src_ = H3 + row_ + (qk ? kcol_ : qcol_) + pj; na[tt][qk] = *(const u32x2*)src_; nc[tt][qk] = *(const u32x2*)(src_ + 64); } } \
        _Pragma("unroll") for (int i = 0; i < 2; ++i) { const int idx = F.tid + 512 * i; nv[i] = *(const u32x4*)(H3 + (size_t)(b * SEQ + s0 + (idx >> 4)) * H3LD + vcol_ + (idx & 15) * 8); } } while (0)
    RP_LOAD(0);
    for (int hi = 0; hi < 8; ++hi) {
        const int hd = hh * 8 + hi, dl = head_dil_log2(hd);
        const size_t hb = (size_t)(b * 16 + hd) * 2048;
        u32x2 ca[2][2], cc[2][2]; u32x4 cv[2];
#pragma unroll
        for (int tt = 0; tt < 2; ++tt)
#pragma unroll
            for (int qk = 0; qk < 2; ++qk) { ca[tt][qk] = na[tt][qk]; cc[tt][qk] = nc[tt][qk]; }
        cv[0] = nv[0]; cv[1] = nv[1];
        if (hi + 1 < 8) RP_LOAD(hi + 1);
#pragma unroll
        for (int tt = 0; tt < 2; ++tt) {
            const int tl = tok2 + 32 * tt, s = s0 + tl; const size_t orow = (hb + posp(s, dl)) * 128;
#pragma unroll
            for (int qk = 0; qk < 2; ++qk) {
                const u32x2 a = ca[tt][qk], c = cc[tt][qk];
                const float x1[4] = {bflo(a.x), bfhi(a.x), bflo(a.y), bfhi(a.y)}, x2[4] = {bflo(c.x), bfhi(c.x), bflo(c.y), bfhi(c.y)};
                float y1[4], y2[4]; const float sc = qk ? 1.0f : QSCALE;
#pragma unroll
                for (int i = 0; i < 4; ++i) { y1[i] = (x1[i] * cs[tt][i] - x2[i] * sn[tt][i]) * sc; y2[i] = (x2[i] * cs[tt][i] + x1[i] * sn[tt][i]) * sc; }
                bf16_t* dst = (qk ? KR : QR) + orow + pj;
                u32x2 w1, w2; w1.x = pk2(y1[0], y1[1]); w1.y = pk2(y1[2], y1[3]); w2.x = pk2(y2[0], y2[1]); w2.y = pk2(y2[2], y2[3]);
                *(u32x2*)dst = w1; *(u32x2*)(dst + 64) = w2;
                if (qk && hd >= 12) {
#pragma unroll
                    for (int i = 0; i < 4; ++i) { KS[tl * 129 + pj + i] = y1[i]; KS[tl * 129 + 64 + pj + i] = y2[i]; }
                }
            }
        }
#pragma unroll
        for (int i = 0; i < 2; ++i) { const int idx = F.tid + 512 * i, tl = idx >> 4, pc = idx & 15;
            *(LAS u32x4*)(VL + tl * 136 + pc * 8) = cv[i]; }
        asm volatile("s_waitcnt lgkmcnt(0)" ::: "memory"); __builtin_amdgcn_s_barrier();
        if (hd >= 12 && F.tid < 128) { float sum = 0.f;
#pragma unroll 8
            for (int tl = 0; tl < 64; ++tl) sum += KS[tl * 129 + F.tid];
            KPART[((size_t)(b * 4 + hd - 12) * 32 + st) * 128 + F.tid] = sum; }
        {
            const int pp = posp(s0 + F.lane, dl);
#pragma unroll 4
            for (int i = 0; i < 16; ++i) { const int d = F.wave * 16 + i; VT[((size_t)(b * 16 + hd) * 128 + d) * 2048 + pp] = VL[F.lane * 136 + d]; }
        }
        asm volatile("s_waitcnt lgkmcnt(0)" ::: "memory"); __builtin_amdgcn_s_barrier();
    }
#undef RP_LOAD
}

template <int MODE>
__device__ __forceinline__ void attn_item(const Params& p, const Frame& F0, int b, int hd, int q0, int ktile_lo, int ktile_hi) {
    const Frame F = refresh(F0);
    const int lane = F.lane, fr = lane & 15, g = lane >> 4, wave = F.wave;
    unsigned char* scr = opq(p.ws) + WS_SCR;
    const size_t hb = (size_t)(b * 16 + hd);
    const bf16_t* Qg = (const bf16_t*)(scr + A_QR) + hb * 2048 * 128; const bf16_t* Kg = (const bf16_t*)(scr + A_KR) + hb * 2048 * 128; const bf16_t* Vg = (const bf16_t*)(scr + A_VT) + hb * 128 * 2048;
    constexpr int BUFB = 35840, OFF_V = 17408, OFF_KM = 71680;
    const int nq = q0 + 16 * wave + fr;
    bf16x8 qf[4];
#pragma unroll
    for (int kb = 0; kb < 4; ++kb) qf[kb] = *(const bf16x8*)(Qg + (size_t)nq * 128 + 32 * kb + 8 * g);
    unsigned selmask = 0u;
    if (MODE == 1) {
        const int qb = q0 >> 8, h = hd - 12;
        LAS float* KM = (LAS float*)(F.lds + OFF_KM);
        const float* KPART = (const float*)(scr + A_KPART) + (size_t)(b * 4 + h) * 32 * 128;
#pragma unroll
        for (int i = 0; i < 2; ++i) { const int idx = F.tid + 512 * i, jb = idx >> 7, d = idx & 127;
            KM[idx] = (KPART[(4 * jb + 0) * 128 + d] + KPART[(4 * jb + 1) * 128 + d]) + (KPART[(4 * jb + 2) * 128 + d] + KPART[(4 * jb + 3) * 128 + d]); }
        __syncthreads();
        float gate[8];
#pragma unroll
        for (int jb = 0; jb < 8; ++jb) { float s = 0.f;
#pragma unroll
            for (int kb = 0; kb < 4; ++kb) { const u32x4 qq = __builtin_bit_cast(u32x4, qf[kb]); const LAS float* km = KM + jb * 128 + 32 * kb + 8 * g;
                const f32x4 k0 = *(const LAS f32x4*)km, k1 = *(const LAS f32x4*)(km + 4);
                s += (bflo(qq.x) * k0[0] + bfhi(qq.x) * k0[1]) + (bflo(qq.y) * k0[2] + bfhi(qq.y) * k0[3]) + (bflo(qq.z) * k1[0] + bfhi(qq.z) * k1[1]) + (bflo(qq.w) * k1[2] + bfhi(qq.w) * k1[3]); }
            s += xor16_f(s); s = xor32_sum(s); gate[jb] = s; }
#pragma unroll
        for (int jb = 0; jb < 8; ++jb) { int rank = 0;
#pragma unroll
            for (int j2 = 0; j2 < 8; ++j2) if (j2 != jb && j2 < qb) rank += (gate[j2] > gate[jb] || (gate[j2] == gate[jb] && j2 < jb)) ? 1 : 0;
            if (jb < qb && rank < 3) selmask |= 1u << jb; }
        __syncthreads();
    }
    u32x4 rk[2], rv[2];
#define AT_ISSUE(kt) do { _Pragma("unroll") for (int i = 0; i < 2; ++i) { const int idx = F.tid + 512 * i; \
        rk[i] = *(const u32x4*)(Kg + (size_t)((kt) * 64 + (idx >> 4)) * 128 + (idx & 15) * 8); rv[i] = *(const u32x4*)(Vg + (size_t)(idx >> 3) * 2048 + (kt) * 64 + (idx & 7) * 8); } } while (0)
#define AT_WRITE(bufp) do { _Pragma("unroll") for (int i = 0; i < 2; ++i) { const int idx = F.tid + 512 * i; \
        *(LAS u32x4*)((bufp) + ((idx >> 4) * 136 + (idx & 15) * 8) * 2) = rk[i]; *(LAS u32x4*)((bufp) + OFF_V + ((idx >> 3) * 72 + (idx & 7) * 8) * 2) = rv[i]; } } while (0)
    f32x4 oacc[8];
#pragma unroll
    for (int dt = 0; dt < 8; ++dt) oacc[dt] = (f32x4){0.f, 0.f, 0.f, 0.f};
    float mrun = -1e30f, lrun = 0.f;
    AT_ISSUE(ktile_lo);
    AT_WRITE(F.lds);
    __syncthreads();
    for (int kt = ktile_lo; kt < ktile_hi; ++kt) {
        LAS unsigned char* buf = F.lds + ((kt - ktile_lo) & 1) * BUFB;
        if (kt + 1 < ktile_hi) AT_ISSUE(kt + 1);
        const LAS bf16_t* KL = (const LAS bf16_t*)buf; const LAS bf16_t* VL = (const LAS bf16_t*)(buf + OFF_V);
        f32x4 sT[4];
        {
            bf16x8 kf[16];
#pragma unroll
            for (int t4 = 0; t4 < 4; ++t4)
#pragma unroll
                for (int kb = 0; kb < 4; ++kb) kf[4 * t4 + kb] = *(const LAS bf16x8*)(KL + (16 * t4 + fr) * 136 + 32 * kb + 8 * g);
            __builtin_amdgcn_sched_barrier(0);
#pragma unroll
            for (int t4 = 0; t4 < 4; ++t4) { sT[t4] = (f32x4){0.f, 0.f, 0.f, 0.f};
#pragma unroll
                for (int kb = 0; kb < 4; ++kb) sT[t4] = mfma32(kf[4 * t4 + kb], qf[kb], sT[t4]); }
        }
        __builtin_amdgcn_sched_barrier(0);
        bf16x8 vf[16];
#pragma unroll
        for (int dt = 0; dt < 8; ++dt) { vf[2 * dt] = frag_perm(VL + (16 * dt + fr) * 72, 4 * g); vf[2 * dt + 1] = frag_perm(VL + (16 * dt + fr) * 72, 32 + 4 * g); }
        __builtin_amdgcn_sched_barrier(0);
        const int k0 = kt * 64; float mx = -1e30f;
        const float NEG = -__builtin_huge_valf();
#pragma unroll
        for (int t4 = 0; t4 < 4; ++t4)
#pragma unroll
            for (int r = 0; r < 4; ++r) { const int nk = k0 + 16 * t4 + 4 * g + r; bool v;
                if (MODE == 0) v = (nk <= nq) && (nq - nk <= 128);
                else v = ((k0 >> 8) == (q0 >> 8)) ? (nk <= nq) : (((selmask >> (k0 >> 8)) & 1u) != 0u);
                sT[t4][r] = v ? sT[t4][r] : NEG; mx = fmaxf(mx, sT[t4][r]); }
        mx = fmaxf(mx, xor16_f(mx)); mx = xor32_max(mx);
        const float mnew = fmaxf(mrun, mx), alpha = exp2f(mrun - mnew); mrun = mnew;
        float ps = 0.f;
#pragma unroll
        for (int t4 = 0; t4 < 4; ++t4)
#pragma unroll
            for (int r = 0; r < 4; ++r) { const float pv = exp2f(sT[t4][r] - mnew); sT[t4][r] = pv; ps += pv; }
        lrun = lrun * alpha + ps;
        const bf16x8 pb0 = pack8(sT[0], sT[1]), pb1 = pack8(sT[2], sT[3]);
#pragma unroll
        for (int dt = 0; dt < 8; ++dt) {
            oacc[dt] = oacc[dt] * alpha;
            oacc[dt] = mfma32(vf[2 * dt], pb0, oacc[dt]);
            oacc[dt] = mfma32(vf[2 * dt + 1], pb1, oacc[dt]);
        }
        if (kt + 1 < ktile_hi) AT_WRITE(F.lds + ((kt + 1 - ktile_lo) & 1) * BUFB);
        __syncthreads();
    }
#undef AT_ISSUE
#undef AT_WRITE
    lrun += xor16_f(lrun); lrun = xor32_sum(lrun);
    const float inv = 1.0f / lrun;
    if (MODE == 0) {
        bf16_t* og = (bf16_t*)(scr + A_OG) + ((size_t)(b * 12 + hd) * 2048 + nq) * 128;
#pragma unroll
        for (int dt = 0; dt < 8; ++dt) { u32x2 w; w.x = pk2(oacc[dt][0] * inv, oacc[dt][1] * inv); w.y = pk2(oacc[dt][2] * inv, oacc[dt][3] * inv); *(u32x2*)(og + 16 * dt + 4 * g) = w; }
        if (g == 0) ((float*)(scr + A_LSE))[(size_t)(b * 12 + hd) * 2048 + nq] = mrun + log2f(lrun);
    } else {
        unsigned char* oc = (opq(p.ws) + WS_OC) + (size_t)(b * SEQ + nq) * 1024 + 512 + (hd - 12) * 128;
        const float inv4 = inv * A_PRE;
#pragma unroll
        for (int dt = 0; dt < 8; ++dt) *(unsigned*)(oc + 16 * dt + 4 * g) = pk4_fp8(oacc[dt][0] * inv4, oacc[dt][1] * inv4, oacc[dt][2] * inv4, oacc[dt][3] * inv4);
    }
}

__device__ __forceinline__ void attn_phase(const Params& p, const Frame& F0) {
    const Frame F = refresh(F0);
    const int i = F.bid & 15, bhm = F.bid >> 4;
    const int nd = (i == 0) ? 7 : (i <= 2) ? 6 : (i <= 4) ? 5 : (i <= 6) ? 4 : (i <= 8) ? 3 : (i <= 10) ? 2 : (i == 11) ? 1 : 0;
    const int st = (i == 0) ? 0 : (i == 1) ? 7 : (i == 2) ? 13 : (i == 3) ? 19 : (i == 4) ? 24 : (i == 5) ? 29 : (i == 6) ? 33 : (i == 7) ? 37 : (i == 8) ? 40 : (i == 9) ? 43 : (i == 10) ? 45 : (i == 11) ? 47 : 48;
    const bool balanced = (F.G == 256);
    for (int k = 0;; ++k) {
        int it;
        if (balanced) { if (k > nd) break; it = (k == 0) ? (bhm * 16 + i) : (256 + bhm * 48 + st + k - 1); }
        else { it = F.bid + k * F.G; if (it >= 1024) break; }
        if (it < 256) { const int qt = it & 15; attn_item<1>(p, F, it >> 6, 12 + ((it >> 4) & 3), qt * 128, 0, 2 * (qt + 1)); }
        else { const int id = it - 256, qt = id & 15, hd = (id >> 4) % 12, b = (id >> 4) / 12, dl = head_dil_log2(hd); const int q0 = qt * 128, first = ((q0 & ((2048 >> dl) - 1)) == 0);
            attn_item<0>(p, F, b, hd, q0, first ? 2 * qt : 2 * qt - 2, 2 * qt + 2); }
    }
}

__device__ __forceinline__ void merge_pass(const Params& p, const Frame& F0) {
    const Frame F = refresh(F0);
    const int gw = F.bid * NWAVES + F.wave, NGW = F.G * NWAVES, hg = F.lane >> 4, d0 = (F.lane & 15) * 8;
    unsigned char* scr = opq(p.ws) + WS_SCR;
    const bf16_t* OG = (const bf16_t*)(scr + A_OG); const float* LSE = (const float*)(scr + A_LSE); bf16_t* OC = (bf16_t*)(opq(p.ws) + WS_OC);
    for (int m = gw; m < T; m += NGW) {
        const int b = m >> 11, s = m & 2047;
        float ls[3]; u32x4 ov[3];
#pragma unroll
        for (int gi = 0; gi < 3; ++gi) { const int hd = 4 * gi + hg; const size_t idx = (size_t)(b * 12 + hd) * 2048 + posp(s, 2 * gi); ls[gi] = LSE[idx]; ov[gi] = *(const u32x4*)(OG + idx * 128 + d0); }
        const float mx = fmaxf(ls[0], fmaxf(ls[1], ls[2]));
        float w[3]; float ws = 0.f;
#pragma unroll
        for (int gi = 0; gi < 3; ++gi) { w[gi] = exp2f(ls[gi] - mx); ws += w[gi]; }
        const float inv = 1.0f / ws;
        float o[8] = {0.f, 0.f, 0.f, 0.f, 0.f, 0.f, 0.f, 0.f};
#pragma unroll
        for (int gi = 0; gi < 3; ++gi) { const float wg = w[gi] * inv;
            o[0] += wg * bflo(ov[gi].x); o[1] += wg * bfhi(ov[gi].x); o[2] += wg * bflo(ov[gi].y); o[3] += wg * bfhi(ov[gi].y);
            o[4] += wg * bflo(ov[gi].z); o[5] += wg * bfhi(ov[gi].z); o[6] += wg * bflo(ov[gi].w); o[7] += wg * bfhi(ov[gi].w); }
        u32x2 wv; wv.x = pk4_fp8(o[0] * A_PRE, o[1] * A_PRE, o[2] * A_PRE, o[3] * A_PRE); wv.y = pk4_fp8(o[4] * A_PRE, o[5] * A_PRE, o[6] * A_PRE, o[7] * A_PRE);
        *(u32x2*)((unsigned char*)OC + (size_t)m * 1024 + hg * 128 + d0) = wv;
    }
}

#define GRID_SYNC() xcd_barrier((unsigned*)(opq(p.ws) + WS_CTL), (volatile LAS unsigned*)(F.lds + LDS_BYTES - 16), F.wave)
#ifndef REPMASK
#define REPMASK 0u
#endif
__device__ __forceinline__ int repn(int k) { int n = 1 + (int)(((REPMASK) >> k) & 1u); asm volatile("" : "+s"(n)); return n; }
#define RP(k) for (int _r = 0, _n = repn(k); _r < _n; ++_r)
__global__ void __launch_bounds__(NTHR, 2) mk_fwd(Params p) {
    extern __shared__ __attribute__((aligned(16))) unsigned char lds_raw[];
    Frame F; F.lds = (LAS unsigned char*)lds_raw; F.tid = 0; F.lane = 0; F.wave = __builtin_amdgcn_readfirstlane(threadIdx.x >> 6); F.G = gridDim.x; F.bid = blockIdx.x;
#define P_WS (opq(p.ws))
#define P_AB ((bf16_t*)(opq(p.ws) + WS_AB))
#define P_R (opq(p.out))
#define P_MIX ((bf16_t*)(opq(p.ws) + WS_MIX))
#define P_HID ((bf16_t*)(opq(p.ws) + WS_HID))
#define P_Y2 ((bf16_t*)(opq(p.ws) + WS_Y2))

    {
        if (threadIdx.x == 0) { volatile LAS unsigned* st = (volatile LAS unsigned*)(F.lds + LDS_BYTES - 16); st[0] = 0u; st[1] = 0u;
            (void)xb_add((unsigned*)(p.ws + WS_CTL) + XB_XCNT(xb_xcc_id()), 1u); }
        __syncthreads();
    }
    RP(0) { convert_set(p, F, 0, F.bid * NWAVES + F.wave, F.G * NWAVES); __syncthreads(); }
    RP(1) { load_w16_lds(F, p.in[I_EV_WIN], EVEN_IN, 4096); __syncthreads(); p0_xpass(p, F); __syncthreads(); }
    GRID_SYNC();

    RP(2) {
        pg8::StaticOrder S; S.init(T, 8192, F.G, F.bid);
        pg8::Gemm g{(const unsigned char*)(P_WS + WS_AB), (const unsigned char*)(P_WS + WS_WIN), 2048, (unsigned)(T * 2048), (unsigned)(8192 * 2048), SC_A16};
        pg8::EpiBf16 E{(bf16_t*)(P_WS + WS_H1), H1LD, (unsigned)(T * 8192 * 2)};
        pg8::gemm_phase(F.lds, F.wave, g, S, E);
    }
    GRID_SYNC();
    RP(3) { p2_pre(p, F); }
    GRID_SYNC();
    RP(4) { if (F.bid < 32) gdn_scan(p, F, F.bid); else if (F.bid < 64) hgrn_scan(p, F, F.bid - 32);
            else if (F.G > 64) convert_set(p, F, 1, (F.bid - 64) * NWAVES + F.wave, (F.G - 64) * NWAVES); }
    if (F.G <= 64) { convert_set(p, F, 1, F.bid * NWAVES + F.wave, F.G * NWAVES); }
    GRID_SYNC();
    RP(5) { p4_gate(p, F); }
    GRID_SYNC();
    RP(6) {
        pg8::StaticOrder S; S.init(T, 2048, F.G, F.bid);
        pg8::Gemm g{(const unsigned char*)(P_WS + WS_OC), (const unsigned char*)(P_WS + WS_WOUT), 2048, (unsigned)(T * 2048), (unsigned)(2048 * 2048), SC_A4};
        pg8::EpiBf16 E{P_MIX, 2048, (unsigned)(T * 2048 * 2)};
        pg8::gemm_phase(F.lds, F.wave, g, S, E);
    }
    GRID_SYNC();
#define MOE_BLOCK(layer, resid, mixp, outfinal, outb2) do { \
        for (int _r = 0, _n = ((layer) == 0 ? repn(7) : 1); _r < _n; ++_r) { load_w16_lds(F, p.in[I_RW], 16, 0); __syncthreads(); \
            ln_pass<true, false, (layer) != 0, true>(p, F, resid, mixp, D, nullptr, p.in[I_LNG] + (size_t)((layer) * 2 + 0) * D, p.in[I_LNB] + (size_t)((layer) * 2 + 0) * D, P_R, P_AB, layer); __syncthreads(); } \
        GRID_SYNC(); \
        const int* list = (const int*)(P_WS + WS_LIST) + (size_t)(layer) * NE * T; \
        const float* gatew = (const float*)(P_WS + WS_GATEW) + (size_t)(layer) * 2 * T; \
        RP(8) { moe_lists(p, F, layer); } \
        GRID_SYNC(); \
        { const Frame Fr = refresh(F); pg8::moe_build_table(F.lds, Fr.tid); } \
        unsigned* tcnt = (unsigned*)(P_WS + WS_CTL) + 3600 + 128 * (layer);        \
        { pg8::MoeOrder<4, false> S; S.init(F.lds, list, F.G, F.bid, 1024, tcnt); \
            pg8::Gemm g{(const unsigned char*)(P_WS + WS_ABS), (const unsigned char*)(P_WS + ((layer) ? WS_WGU1 : WS_WGU)), 2048, (unsigned)(20480 * 2048), (unsigned)(NE * 1024 * 2048), SC_A1}; \
            pg8::EpiGateUpB E{P_HID, list, gatew}; pg8::gemm_phase(F.lds, F.wave, g, S, E); } \
          \
        { pg8::MoeDownS S; S.init(F.lds, tcnt, 2048, F.G, F.bid); \
            pg8::Gemm16 g{P_HID, (const bf16_t*)(P_WS + WS_WD), 512, (unsigned)(20480 * 512 * 2), (unsigned)(NE * 2048 * 512 * 2)}; \
            pg8::EpiDown E{P_Y2, list}; pg8::gemm_phase16(F.lds, F.wave, g, S, E); } \
        GRID_SYNC(); \
        ln_pass<false, true, true, (layer) == 0>(p, F, P_R, P_Y2, D, P_Y2, p.in[I_LNG] + (size_t)((layer) * 2 + 1) * D, p.in[I_LNB] + (size_t)((layer) * 2 + 1) * D, outfinal, outb2, layer); \
    } while (0)
    MOE_BLOCK(0, p.in[I_X], P_MIX, P_R, (bf16_t*)(P_WS + WS_AB8));
    __syncthreads();
    RP(11) { convert_set(p, F, 2, F.bid * NWAVES + F.wave, F.G * NWAVES); __syncthreads(); }
    GRID_SYNC();
    RP(12) {
        pg8::StaticOrder S; S.init(T, 6144, F.G, F.bid);
        pg8::Gemm g{(const unsigned char*)(P_WS + WS_AB8), (const unsigned char*)(P_WS + WS_W3), 2048, (unsigned)(T * 2048), (unsigned)(6144 * 2048), SC_A1};
        pg8::EpiBf16 E{(bf16_t*)(P_WS + WS_H1), H3LD, (unsigned)(T * 6144 * 2)};
        pg8::gemm_phase(F.lds, F.wave, g, S, E);
    }
    GRID_SYNC();
    RP(13) { const Frame Fr = refresh(F); for (int u = Fr.bid; u < 256; u += Fr.G) rope_unit(p, Fr, u); }
    GRID_SYNC();
    RP(14) { attn_phase(p, F); }
    GRID_SYNC();
    RP(15) { merge_pass(p, F); }
    GRID_SYNC();
    RP(16) {
        pg8::StaticOrder S; S.init(T, 2048, F.G, F.bid);
        pg8::Gemm g{(const unsigned char*)(P_WS + WS_OC), (const unsigned char*)(P_WS + WS_WOUT1), 1024, (unsigned)(T * 1024), (unsigned)(2048 * 1024), SC_A4};
        pg8::EpiBf16 E{P_MIX, 2048, (unsigned)(T * 2048 * 2)};
        pg8::gemm_phase(F.lds, F.wave, g, S, E);
    }
    GRID_SYNC();
    MOE_BLOCK(1, P_R, P_MIX, p.out, (bf16_t*)nullptr);
#undef MOE_BLOCK
#undef P_WS
#undef P_AB
#undef P_R
#undef P_MIX
#undef P_HID
#undef P_Y2
}

extern "C" void kernel_launch(void* const* d_in, const int* in_sizes, int n_in, void* d_out, int out_size,
                              void* d_ws, size_t ws_size, hipStream_t stream) {
    static int grid_blocks = 0;
    if (!grid_blocks) {
        int dev = 0, cus = 0, per_cu = 0;
        (void)hipGetDevice(&dev);
        (void)hipDeviceGetAttribute(&cus, hipDeviceAttributeMultiprocessorCount, dev);
        (void)hipFuncSetAttribute((const void*)mk_fwd, hipFuncAttributeMaxDynamicSharedMemorySize, LDS_BYTES);
        (void)hipOccupancyMaxActiveBlocksPerMultiprocessor(&per_cu, (const void*)mk_fwd, NTHR, LDS_BYTES);
        if (per_cu < 1) fprintf(stderr, "kernel_launch: occupancy query says %d blocks per CU\n", per_cu);
        grid_blocks = cus;
        if (ws_size < WS_END) { fprintf(stderr, "kernel_launch: workspace too small: %zu < %zu\n", ws_size, (size_t)WS_END); grid_blocks = -1; }
        if (n_in != 18) { fprintf(stderr, "kernel_launch: expected 18 inputs, got %d\n", n_in); grid_blocks = -1; }
    }
    if (grid_blocks < 0) return;
    Params p{};
    for (int i = 0; i < 18; ++i) p.in[i] = (const float*)d_in[i];
    p.out = (float*)d_out; p.ws = (unsigned char*)d_ws;
    (void)hipMemsetAsync(d_ws, 0, 16384, stream);
    void* args[] = {&p};
    hipError_t e = hipLaunchCooperativeKernel((void*)mk_fwd, dim3(grid_blocks), dim3(NTHR), args, LDS_BYTES, stream);
    if (e != hipSuccess) fprintf(stderr, "cooperative launch failed: %s (grid %d)\n", hipGetErrorString(e), grid_blocks);
}
```

```cpp
#include <hip/hip_runtime.h>
#include <cstdio>
#include <cstdint>

#define GAS __attribute__((address_space(1)))
#define LAS __attribute__((address_space(3)))
typedef unsigned short bf16_t;
typedef short bf16x8 __attribute__((ext_vector_type(8)));
typedef short bf16x4 __attribute__((ext_vector_type(4)));
typedef float f32x4 __attribute__((ext_vector_type(4)));
typedef float f32x2 __attribute__((ext_vector_type(2)));
typedef unsigned u32x4 __attribute__((ext_vector_type(4)));
typedef unsigned u32x2 __attribute__((ext_vector_type(2)));

constexpr int NB = 4, SEQ = 2048, T = NB * SEQ, D = 2048;
constexpr int EVEN_IN = 8208, ODD_IN = 6144;
constexpr int NE = 16, DEXP = 512;
constexpr float ALPHA = 1.4142135623730951f;
constexpr float LN_EPS = 1e-5f, RMS_EPS = 1e-6f;
constexpr int NWAVES = 8, NTHR = 512;
constexpr int LDS_BYTES = 147456;

constexpr size_t MiB = 1u << 20;
constexpr size_t WS_CTL = 0;
constexpr size_t WS_LIST = 1 * MiB;
constexpr size_t WS_GATEW = 2 * MiB;
constexpr size_t WS_BA = 2 * MiB + 512 * 1024;
constexpr size_t WS_ROPE = 3 * MiB;
constexpr size_t WS_KMEAN = 4 * MiB;
constexpr size_t WS_WREG = 8 * MiB;
constexpr size_t WS_WIN = WS_WREG;
constexpr size_t WS_AB8 = WS_WREG + 16 * MiB;
constexpr size_t WS_WOUT = WS_WREG + 32 * MiB;
constexpr size_t WS_WGU = WS_WREG + 40 * MiB;
constexpr size_t WS_WD = WS_WREG + 104 * MiB;
constexpr size_t WS_AB = WS_WREG + 136 * MiB;
constexpr size_t WS_H1 = WS_AB + 32 * MiB;
constexpr size_t WS_OC = WS_H1 + 128 * MiB;
constexpr size_t WS_MIX = WS_OC + 32 * MiB;
constexpr size_t WS_SCR = WS_MIX + 32 * MiB;
constexpr size_t WS_HID = WS_SCR;
constexpr size_t WS_Y2 = WS_SCR + 20 * MiB;
constexpr size_t WS_ABS = WS_SCR + 84 * MiB;
constexpr size_t WS_END = WS_SCR + 216 * MiB;
static_assert(WS_END == 584 * MiB, "workspace map");

typedef __bf16 bf16v2_t __attribute__((ext_vector_type(2)));
__device__ __forceinline__ unsigned pk2(float lo, float hi) { const f32x2 f = {lo, hi}; return __builtin_bit_cast(unsigned, __builtin_convertvector(f, bf16v2_t)); }
__device__ __forceinline__ unsigned f2bf(float f) { return pk2(f, 0.f) & 0xffffu; }
__device__ __forceinline__ unsigned pk4_fp8(float a, float b, float c, float d) {
    a = fminf(fmaxf(a, -448.f), 448.f); b = fminf(fmaxf(b, -448.f), 448.f); c = fminf(fmaxf(c, -448.f), 448.f); d = fminf(fmaxf(d, -448.f), 448.f);
    int w = 0; w = __builtin_amdgcn_cvt_pk_fp8_f32(a, b, w, false); w = __builtin_amdgcn_cvt_pk_fp8_f32(c, d, w, true); return (unsigned)w;
}
constexpr float W_PRE = 64.f;  constexpr int SC_W = 0x79797979;
constexpr float A_PRE = 4.f;   constexpr int SC_A4 = 0x7d7d7d7d;
constexpr int SC_A1 = 0x7f7f7f7f;
constexpr float X_PRE = 16.f;  constexpr int SC_A16 = 0x7b7b7b7b;
typedef int i32x8 __attribute__((ext_vector_type(8)));
__device__ __forceinline__ float bf2f(unsigned short b) { return __builtin_bit_cast(float, (unsigned)b << 16); }
__device__ __forceinline__ float bflo(unsigned w) { return __builtin_bit_cast(float, w << 16); }
__device__ __forceinline__ float bfhi(unsigned w) { return __builtin_bit_cast(float, w & 0xffff0000u); }
__device__ __forceinline__ unsigned cvt_pk_bf16(float lo, float hi) { return pk2(lo, hi); }
template <int CTRL> __device__ __forceinline__ float dpp_f(float x) { return __builtin_bit_cast(float, __builtin_amdgcn_update_dpp(0, __builtin_bit_cast(int, x), CTRL, 0xf, 0xf, true)); }
__device__ __forceinline__ float xor16_f(float x) { return __builtin_bit_cast(float, __builtin_amdgcn_ds_swizzle(__builtin_bit_cast(int, x), 0x401f)); }
__device__ __forceinline__ float row16_sum(float v) { v += dpp_f<0xB1>(v); v += dpp_f<0x4E>(v); v += dpp_f<0x141>(v); v += dpp_f<0x140>(v); return v; }
__device__ __forceinline__ float xor32_sum(float v) { const int i = __builtin_bit_cast(int, v); const auto r = __builtin_amdgcn_permlane32_swap(i, i, false, false);
    return __builtin_bit_cast(float, (int)r[0]) + __builtin_bit_cast(float, (int)r[1]); }
__device__ __forceinline__ float xor32_max(float v) { const int i = __builtin_bit_cast(int, v); const auto r = __builtin_amdgcn_permlane32_swap(i, i, false, false);
    return fmaxf(__builtin_bit_cast(float, (int)r[0]), __builtin_bit_cast(float, (int)r[1])); }
__device__ __forceinline__ float wave_sum(float v) { v = row16_sum(v); v += xor16_f(v); return xor32_sum(v); }
__device__ __forceinline__ float sigmoidf_(float x) { return 1.0f / (1.0f + __expf(-x)); }
__device__ __forceinline__ float siluf_(float x) { return x / (1.0f + __expf(-x)); }
#define LDS_WAIT() asm volatile("s_waitcnt lgkmcnt(0)" ::: "memory")
template <class Tp> __device__ __forceinline__ Tp* opq(Tp* x) { asm volatile("" : "+s"(x)); return x; }
template <class Tp> __device__ __forceinline__ Tp* opqg(Tp* x) { GAS Tp* g = (GAS Tp*)x; asm volatile("" : "+s"(g)); return (Tp*)g; }
__device__ __forceinline__ float ld_agent(const float* p) { return __hip_atomic_load(p, __ATOMIC_RELAXED, __HIP_MEMORY_SCOPE_AGENT); }

namespace pg8 {
constexpr int BM = 256, BK = 64, HALF = 128, HTB = HALF * BK * 2, STAGE_BYTES = 8 * HTB, NXCD = 8, WGM = 8;
__device__ __forceinline__ int lds_byte(int r, int c) { const int st = (r >> 4) * 2 + (c >> 5), rr = r & 15, cc = c & 31, ob = rr * 64 + cc * 2; return st * 1024 + (ob ^ (((ob >> 9) & 1) << 5)); }
__device__ __forceinline__ void stage_rc(int b, int& R, int& C) { const int st = b / 1024, sb = b % 1024, swz = sb ^ (((sb >> 9) & 1) << 5); R = (st >> 1) * 16 + swz / 64; C = (st & 1) * 32 + (swz % 64) / 2; }
__device__ __forceinline__ int perm32(int rho) { const int n = rho >> 4, i = rho & 15; return 8 * (i >> 2) + 4 * n + (i & 3); }

struct Unit { int pm, pn, e, cnt, arow0, brow0; };
struct Gemm { const unsigned char* A; const unsigned char* Bt; int K; unsigned abytes, bbytes; int sc_a; };

struct StaticOrder {
    static constexpr bool CONTIG = true;
    int nM, nN, nwg, G, c;
    __device__ void init(int M, int N, int G_, int c_) { nM = M / BM; nN = N / BM; nwg = nM * nN; G = G_; c = c_; }
    __device__ bool next(int i, Unit& u) const {
        const long L = (long)i * G + c; if (L >= nwg) return false;
        int wgid = (int)L; { const int q = nwg / NXCD, r = nwg % NXCD, xcd = wgid % NXCD, off = wgid / NXCD; wgid = (xcd < r ? xcd * (q + 1) : r * (q + 1) + (xcd - r) * q) + off; }
        const int nig = WGM * nN, gid = wgid / nig, fm = gid * WGM, gsz = (nM - fm) < WGM ? (nM - fm) : WGM;
        u.pm = fm + ((wgid % nig) % gsz); u.pn = (wgid % nig) / gsz; u.e = 0; u.cnt = 0; u.arow0 = u.pm * BM; u.brow0 = u.pn * BM; return true;
    }
    __device__ __forceinline__ unsigned arow(const Unit& u, int r) const { return (unsigned)(u.arow0 + r); }
    __device__ __forceinline__ void done(const Unit&, int) const {}
    struct State {};
    __device__ __forceinline__ bool first(State&, Unit& u, int) const { return next(0, u); }
    __device__ __forceinline__ void issue(State&, int, int) const {}
    __device__ __forceinline__ bool fin(State&, int i, Unit& u, int) const { return next(i, u); }
};

constexpr int MOE_TAB_OFF = 131072;
constexpr int MOE_HIST_OFF = 131072 + 3072;
__device__ __forceinline__ void moe_build_table(LAS unsigned char* lds, int tid) {
    LAS int* tab = (LAS int*)(lds + MOE_TAB_OFF);
    const LAS int* cnts = (const LAS int*)(lds + MOE_HIST_OFF) + 16;
    if (tid == 0) {
        int s = 0;
#pragma unroll 1
        for (int e = 0; e < NE; ++e) { const int c = cnts[e]; const int nt = (c + 255) >> 8;
#pragma unroll 1
            for (int k = 0; k < nt; ++k) { tab[4 + 4 * (s + k)] = e; tab[4 + 4 * (s + k) + 1] = k; tab[4 + 4 * (s + k) + 2] = c; }
            s += nt; }
        tab[0] = s;
    }
    __syncthreads();
}
template <int NPN, bool GATHER>
struct MoeOrder {
    static constexpr bool CONTIG = !GATHER;
    const int* list;
    LAS const int* tab; int G, c, brows;
    unsigned* tcnt;
    __device__ void init(LAS unsigned char* lds, const int* list_, int G_, int c_, int brows_, unsigned* tcnt_ = nullptr) { list = list_; G = G_; c = c_; brows = brows_; tab = (LAS const int*)(lds + MOE_TAB_OFF); tcnt = tcnt_; }
    __device__ __forceinline__ void done(const Unit& u, int lane) const {
        if (tcnt) { asm volatile("s_waitcnt vmcnt(0)" ::: "memory"); if (lane == 0) __hip_atomic_fetch_add(tcnt + (u.arow0 >> 8), 1u, __ATOMIC_RELAXED, __HIP_MEMORY_SCOPE_AGENT); }
    }
    __device__ bool next(int i, Unit& u) const {
        int L = i * G + c; const int ntile = __builtin_amdgcn_readfirstlane(tab[0]); if (L >= ntile * NPN) return false;
        if (NPN == 4 && i == 0 && G == 256) L = (c & 7) * 32 + (c >> 3);
        const int tile = L / NPN; u.pn = L % NPN;
        u.e = __builtin_amdgcn_readfirstlane(tab[4 + 4 * tile]); u.pm = __builtin_amdgcn_readfirstlane(tab[4 + 4 * tile + 1]); u.cnt = __builtin_amdgcn_readfirstlane(tab[4 + 4 * tile + 2]);
        u.arow0 = tile * BM; u.brow0 = u.e * brows + u.pn * BM; return true;
    }
    __device__ __forceinline__ unsigned arow(const Unit& u, int r) const {
        if (!GATHER) return (unsigned)(u.arow0 + r);
        int idx = u.pm * BM + r; if (idx >= u.cnt) idx = 0;
        return (unsigned)(list[u.e * T + idx] >> 1);
    }
    struct State {};
    __device__ __forceinline__ bool first(State&, Unit& u, int) const { return next(0, u); }
    __device__ __forceinline__ void issue(State&, int, int) const {}
    __device__ __forceinline__ bool fin(State&, int i, Unit& u, int) const { return next(i, u); }
};
constexpr int MOE_Q_OFF = 131072 + 3072 + 512;
struct MoeDownS {
    static constexpr bool CONTIG = true;
    typedef __attribute__((address_space(1))) unsigned gu32;
    LAS const int* tab; LAS unsigned* slot; gu32* tcnt; int brows, G, c;
    struct State {};
    __device__ void init(LAS unsigned char* lds, unsigned* tcnt_, int brows_, int G_, int c_) { tab = (LAS const int*)(lds + MOE_TAB_OFF); slot = (LAS unsigned*)(lds + MOE_Q_OFF); tcnt = (gu32*)tcnt_; brows = brows_; G = G_; c = c_; }
    __device__ __forceinline__ unsigned nunits() const { return (unsigned)__builtin_amdgcn_readfirstlane(tab[0]) * 8u; }
    __device__ __forceinline__ unsigned qof(int k) const {
        const int nG = __builtin_amdgcn_readfirstlane(tab[0]) * 4, h = nG % G, nl = G - h;
        return (unsigned)(c >= h ? k * nl + (k >= 3 ? (k - 2) * h : 0) + (c - h) : (k + 3) * nl + k * h + c);
    }
    __device__ __forceinline__ void wait_tile(unsigned q, unsigned cv) const {
        unsigned sp = 0;
        while (cv < 32u) { __builtin_amdgcn_s_sleep(2); if (++sp > (1u << 22)) break; cv = __hip_atomic_load(tcnt + (q >> 3), __ATOMIC_RELAXED, __HIP_MEMORY_SCOPE_AGENT); }
        asm volatile("buffer_inv sc1" ::: "memory");
    }
    __device__ __forceinline__ bool decode(unsigned q, Unit& u) const {
        if (q >= nunits()) return false;
        const int tile = (int)(q >> 3); u.pn = (int)(q & 7u);
        u.e = __builtin_amdgcn_readfirstlane(tab[4 + 4 * tile]); u.pm = __builtin_amdgcn_readfirstlane(tab[4 + 4 * tile + 1]); u.cnt = __builtin_amdgcn_readfirstlane(tab[4 + 4 * tile + 2]);
        u.arow0 = tile * BM; u.brow0 = u.e * brows + u.pn * BM; return true;
    }
    __device__ __forceinline__ bool first(State&, Unit& u, int tid) const {
        const unsigned q = qof(0);
        if (tid == 0 && q < nunits()) wait_tile(q, __hip_atomic_load(tcnt + (q >> 3), __ATOMIC_RELAXED, __HIP_MEMORY_SCOPE_AGENT));
        __syncthreads();
        return decode(q, u);
    }
    __device__ __forceinline__ void issue(State&, int i, int tid) const {
        const unsigned q = qof(i);
        if (tid == 0 && q < nunits()) {
            const __amdgpu_buffer_rsrc_t rc = __builtin_amdgcn_make_buffer_rsrc((void*)tcnt, (short)0, 128 * 4, 0x00020000);
            __builtin_amdgcn_raw_ptr_buffer_load_lds(rc, (LAS void*)slot, 4, (int)((q >> 3) * 4u), 0, 0, 16);
        }
    }
    __device__ __forceinline__ bool fin(State&, int i, Unit& u, int tid) const {
        const unsigned q = qof(i);
        if (tid == 0 && q < nunits()) {
            unsigned cv; asm volatile("ds_read_b32 %0, %1\n\ts_waitcnt lgkmcnt(0)" : "=v"(cv) : "v"((unsigned)(size_t)slot) : "memory");
            wait_tile(q, cv);
        }
        return decode(q, u);
    }
    __device__ __forceinline__ unsigned arow(const Unit& u, int r) const { return (unsigned)(u.arow0 + r); }
    __device__ __forceinline__ void done(const Unit&, int) const {}
};

struct EpiBf16 {
    static constexpr bool PERM = true;
    bf16_t* O; int ldc; unsigned obytes;
    __device__ __forceinline__ void operator()(const f32x4 (&acc)[2][2][4][2], const Unit& u, int wr, int wc, int fr, int fq) const {
        const __amdgpu_buffer_rsrc_t rO = __builtin_amdgcn_make_buffer_rsrc((void*)O, (short)0, (int)obytes, 0x00020000);
        const unsigned voff = (unsigned)((wr * 64 + fr) * ldc + wc * 32 + 8 * fq) * 2u;
        const unsigned sbase = (unsigned)(u.pm * BM * ldc + u.pn * BM) * 2u;
#pragma unroll
        for (int ai = 0; ai < 2; ++ai)
#pragma unroll
            for (int m = 0; m < 4; ++m)
#pragma unroll
                for (int bj = 0; bj < 2; ++bj) { const f32x4 v0 = acc[ai][bj][m][0], v1 = acc[ai][bj][m][1];
                    u32x4 w; w.x = cvt_pk_bf16(v0[0], v0[1]); w.y = cvt_pk_bf16(v0[2], v0[3]); w.z = cvt_pk_bf16(v1[0], v1[1]); w.w = cvt_pk_bf16(v1[2], v1[3]);
                    __builtin_amdgcn_raw_buffer_store_b128(w, rO, (int)voff, (int)(sbase + (unsigned)((ai * HALF + m * 16) * ldc + bj * HALF) * 2u), 0); }
    }
};
struct EpiGateUp {
    static constexpr bool PERM = true;
    unsigned char* HID; const int* list; const float* gatew;
    __device__ __forceinline__ void operator()(const f32x4 (&acc)[2][2][4][2], const Unit& u, int wr, int wc, int fr, int fq) const {
        const int col0 = u.pn * 128 + wc * 32 + 8 * fq;
#pragma unroll
        for (int ai = 0; ai < 2; ++ai)
#pragma unroll
            for (int m = 0; m < 4; ++m) {
                const int r = ai * HALF + wr * 64 + m * 16 + fr; const int idx = u.pm * BM + r;
                float wgt = 0.f; if (idx < u.cnt) wgt = gatew[list[u.e * T + idx]] * A_PRE;
                const f32x4 g0 = acc[ai][0][m][0], g1 = acc[ai][0][m][1], u0 = acc[ai][1][m][0], u1 = acc[ai][1][m][1];
                float h[8];
#pragma unroll
                for (int i = 0; i < 4; ++i) { h[i] = siluf_(g0[i]) * u0[i] * wgt; h[4 + i] = siluf_(g1[i]) * u1[i] * wgt; }
                u32x2 w; w.x = pk4_fp8(h[0], h[1], h[2], h[3]); w.y = pk4_fp8(h[4], h[5], h[6], h[7]);
                *(u32x2*)(HID + (size_t)(u.arow0 + r) * DEXP + col0) = w;
            }
    }
};
struct EpiGateUpB {
    static constexpr bool PERM = true;
    bf16_t* HID; const int* list; const float* gatew;
    __device__ __forceinline__ void operator()(const f32x4 (&acc)[2][2][4][2], const Unit& u, int wr, int wc, int fr, int fq) const {
        const __amdgpu_buffer_rsrc_t rH = __builtin_amdgcn_make_buffer_rsrc((void*)HID, (short)0, 20480 * 512 * 2, 0x00020000);
        const __amdgpu_buffer_rsrc_t rL = __builtin_amdgcn_make_buffer_rsrc((void*)(list + (size_t)u.e * T), (short)0, T * 4, 0x00020000);
        const __amdgpu_buffer_rsrc_t rG = __builtin_amdgcn_make_buffer_rsrc((void*)gatew, (short)0, 2 * T * 4, 0x00020000);
        const unsigned voff = (unsigned)((wr * 64 + fr) * DEXP + u.pn * 128 + wc * 32 + 8 * fq) * 2u;
        const int idx0 = u.pm * BM + wr * 64 + fr;
#pragma unroll
        for (int ai = 0; ai < 2; ++ai)
#pragma unroll
            for (int m = 0; m < 4; ++m) {
                const int idx = idx0 + ai * HALF + m * 16;
                const int ent = __builtin_amdgcn_raw_buffer_load_b32(rL, idx * 4, 0, 0);
                float wgt = __builtin_bit_cast(float, __builtin_amdgcn_raw_buffer_load_b32(rG, (idx < u.cnt ? ent : 0) * 4, 0, 0)); wgt = idx < u.cnt ? wgt : 0.f;
                const f32x4 g0 = acc[ai][0][m][0], g1 = acc[ai][0][m][1], u0 = acc[ai][1][m][0], u1 = acc[ai][1][m][1];
                float h[8];
#pragma unroll
                for (int i = 0; i < 4; ++i) { h[i] = siluf_(g0[i]) * u0[i] * wgt; h[4 + i] = siluf_(g1[i]) * u1[i] * wgt; }
                u32x4 w; w.x = cvt_pk_bf16(h[0], h[1]); w.y = cvt_pk_bf16(h[2], h[3]); w.z = cvt_pk_bf16(h[4], h[5]); w.w = cvt_pk_bf16(h[6], h[7]);
                __builtin_amdgcn_raw_buffer_store_b128(w, rH, (int)voff, (int)((u.arow0 + ai * HALF + m * 16) * DEXP * 2), 16);
            }
    }
};
struct EpiDown {
    static constexpr bool PERM = true;
    bf16_t* Y2; const int* list;
    __device__ __forceinline__ void operator()(const f32x4 (&acc)[2][2][4][2], const Unit& u, int wr, int wc, int fr, int fq) const {
        const int col0 = u.pn * BM + wc * 32 + 8 * fq;
#pragma unroll
        for (int ai = 0; ai < 2; ++ai)
#pragma unroll
            for (int m = 0; m < 4; ++m) {
                const int r = ai * HALF + wr * 64 + m * 16 + fr; const int idx = u.pm * BM + r;
                if (idx < u.cnt) { const int ent = list[u.e * T + idx]; bf16_t* rowp = Y2 + (size_t)ent * D + col0;
#pragma unroll
                    for (int bj = 0; bj < 2; ++bj) { const f32x4 v0 = acc[ai][bj][m][0], v1 = acc[ai][bj][m][1];
                        u32x4 w; w.x = cvt_pk_bf16(v0[0], v0[1]); w.y = cvt_pk_bf16(v0[2], v0[3]); w.z = cvt_pk_bf16(v1[0], v1[1]); w.w = cvt_pk_bf16(v1[2], v1[3]);
                        *(u32x4*)(rowp + bj * HALF) = w; } }
            }
    }
};

constexpr int NXT_OFF = 131072 + 4096;
template <class Epi, class Sched>
__device__ __forceinline__ void gemm_phase(LAS unsigned char* lds, int wave_id, const Gemm g, const Sched& S, const Epi& E) {
    int lane; asm volatile("v_mbcnt_lo_u32_b32 %0, -1, 0\n\tv_mbcnt_hi_u32_b32 %0, -1, %0" : "=v"(lane));
    const int wid = wave_id, tid = wid * 64 + lane, wr = wid >> 2, wc = wid & 3, fr = lane & 15, fq = lane >> 4;
    const int K = g.K, nt = K / 128;
    unsigned voffB[2];
#pragma unroll
    for (int i = 0; i < 2; ++i) { int R, C; stage_rc(tid * 16 + i * 8192, R, C); const int Rb = Epi::PERM ? ((R & ~31) + perm32(R & 31)) : R; voffB[i] = (unsigned)(Rb * K + 2 * C); }
    const unsigned ldsw = (unsigned)wid * 1024u;
    const int aoff = lds_byte(wr * 64 + fr, 16 * (fq & 1)) + (fq >> 1) * 1024, boff = lds_byte(wc * 32 + fr, 16 * (fq & 1)) + (fq >> 1) * 1024;
    LAS unsigned char* ldsB = lds + 4 * HTB + boff;
    LAS unsigned char* ldsA = lds + aoff;
    const int sc_act = g.sc_a;
#define PG8_SA(b, h) (((b) * 2 + (h)) * HTB)
#define PG8_SB(b, h) ((4 + (b) * 2 + (h)) * HTB)
#define PG8_STAGE(bufoff, rsrc, soff, voff) do { _Pragma("unroll") for (int _i = 0; _i < 2; ++_i) \
        __builtin_amdgcn_raw_ptr_buffer_load_lds(rsrc, (LAS void*)(lds + (bufoff) + ldsw + _i * 8192), 16, (int)(voff)[_i], (int)(soff), 0, 0); } while (0)
#define PG8_LD32(dstv, addr) do { const u32x4 _c0 = *(const LAS u32x4*)(lds + (addr)), _c1 = *(const LAS u32x4*)(lds + (addr) + 16); dstv = (i32x8){(int)_c0.x, (int)_c0.y, (int)_c0.z, (int)_c0.w, (int)_c1.x, (int)_c1.y, (int)_c1.z, (int)_c1.w}; } while (0)
#define PG8_LDA(dst, b, h) do { _Pragma("unroll") for (int m = 0; m < 4; ++m) { const u32x4 _c0 = *(const LAS u32x4*)(ldsA + PG8_SA(b, h) + m * 2048), _c1 = *(const LAS u32x4*)(ldsA + PG8_SA(b, h) + m * 2048 + 16); \
        dst[m] = (i32x8){(int)_c0.x, (int)_c0.y, (int)_c0.z, (int)_c0.w, (int)_c1.x, (int)_c1.y, (int)_c1.z, (int)_c1.w}; } } while (0)
#define PG8_LDB(dst, b, h) do { _Pragma("unroll") for (int n = 0; n < 2; ++n) { const u32x4 _c0 = *(const LAS u32x4*)(ldsB + ((b) * 2 + (h)) * HTB + n * 2048), _c1 = *(const LAS u32x4*)(ldsB + ((b) * 2 + (h)) * HTB + n * 2048 + 16); \
        dst[n] = (i32x8){(int)_c0.x, (int)_c0.y, (int)_c0.z, (int)_c0.w, (int)_c1.x, (int)_c1.y, (int)_c1.z, (int)_c1.w}; } } while (0)
#define PG8_MMA(ai, bj, At, Bt) do { __builtin_amdgcn_sched_barrier(0); __builtin_amdgcn_s_setprio(1); _Pragma("unroll") for (int m = 0; m < 4; ++m) _Pragma("unroll") for (int n = 0; n < 2; ++n) \
        acc[ai][bj][m][n] = __builtin_amdgcn_mfma_scale_f32_16x16x128_f8f6f4(Bt[n], At[m], acc[ai][bj][m][n], 0, 0, 0, SC_W, 0, sc_act); \
        _Pragma("unroll") for (int m = 0; m < 4; ++m) asm volatile("" :: "v"(acc[ai][bj][m][0]), "v"(acc[ai][bj][m][1]));     \
        __builtin_amdgcn_s_setprio(0); __builtin_amdgcn_sched_barrier(0); } while (0)
#define PG8_WAIT_V(n) asm volatile("s_waitcnt vmcnt(" #n ")" ::: "memory")
#define PG8_WAIT_L(n) asm volatile("s_waitcnt lgkmcnt(" #n ")" ::: "memory")
#define PG8_BAR __builtin_amdgcn_s_barrier()
#define PG8_SCHED __builtin_amdgcn_sched_barrier(0)
#define PG8_AOFFS(u, o0, o1) do { _Pragma("unroll") for (int _i = 0; _i < 2; ++_i) { int _R, _C; stage_rc(tid * 16 + _i * 8192, _R, _C); \
        o0[_i] = S.arow(u, _R) * (unsigned)K + 2u * (unsigned)_C; o1[_i] = S.arow(u, HALF + _R) * (unsigned)K + 2u * (unsigned)_C; } } while (0)
    Unit cur, nxt; int ui = 0;
    if (!S.next(0, cur)) return;
    f32x4 acc[2][2][4][2];
#pragma unroll
    for (int a = 0; a < 2; ++a)
#pragma unroll
        for (int b = 0; b < 2; ++b)
#pragma unroll
            for (int m = 0; m < 4; ++m)
#pragma unroll
                for (int n = 0; n < 2; ++n) acc[a][b][m][n] = (f32x4){0.f, 0.f, 0.f, 0.f};
    i32x8 At[4], B0[2], B1[2];
    unsigned cA0[2], cA1[2];
    PG8_AOFFS(cur, cA0, cA1);
    const __amdgpu_buffer_rsrc_t rA = __builtin_amdgcn_make_buffer_rsrc((void*)g.A, (short)0, (int)g.abytes, 0x00020000);
    const __amdgpu_buffer_rsrc_t rB = __builtin_amdgcn_make_buffer_rsrc((void*)g.Bt, (short)0, (int)g.bbytes, 0x00020000);
    const unsigned kstep = (unsigned)(BK * 2);
    const unsigned hstep = (unsigned)HALF * (unsigned)K;
    unsigned cB = (unsigned)cur.brow0 * (unsigned)K;
    PG8_STAGE(PG8_SB(0, 0), rB, cB, voffB); PG8_STAGE(PG8_SB(0, 1), rB, cB + hstep, voffB); PG8_STAGE(PG8_SA(0, 0), rA, 0u, cA0); PG8_STAGE(PG8_SA(0, 1), rA, 0u, cA1);
    if (wr == 1) PG8_BAR;
    PG8_WAIT_V(2); PG8_BAR;
    PG8_STAGE(PG8_SB(1, 0), rB, cB + kstep, voffB); PG8_STAGE(PG8_SA(1, 0), rA, kstep, cA0); PG8_STAGE(PG8_SB(1, 1), rB, cB + hstep + kstep, voffB);
    PG8_WAIT_V(6); PG8_BAR;
#define PG8_PAIR(a1, a2, b2, SWITCH) do { \
            PG8_LDB(B0, 0, 0); PG8_LDB(B1, 0, 1); PG8_SCHED; PG8_LDA(At, 0, 0); PG8_STAGE(PG8_SA(1, 1), rA, a1, cA1); \
            SWITCH; \
            PG8_WAIT_V(8); PG8_WAIT_L(0); PG8_BAR; PG8_MMA(0, 0, At, B0); PG8_MMA(0, 1, At, B1); PG8_BAR; PG8_SCHED; \
            PG8_LDA(At, 0, 1); PG8_STAGE(PG8_SB(0, 0), rB, b2, voffB); PG8_STAGE(PG8_SB(0, 1), rB, (b2) + hstep, voffB); PG8_STAGE(PG8_SA(0, 0), rA, a2, cA0); \
            PG8_WAIT_V(8); PG8_WAIT_L(0); PG8_BAR; PG8_MMA(1, 0, At, B0); PG8_MMA(1, 1, At, B1); PG8_BAR; PG8_SCHED; \
            PG8_LDB(B0, 1, 0); PG8_LDB(B1, 1, 1); PG8_SCHED; PG8_LDA(At, 1, 0); PG8_STAGE(PG8_SA(0, 1), rA, a2, cA1); \
            PG8_WAIT_V(8); PG8_WAIT_L(0); PG8_BAR; PG8_MMA(0, 0, At, B0); PG8_MMA(0, 1, At, B1); PG8_BAR; PG8_SCHED; \
            PG8_LDA(At, 1, 1); PG8_STAGE(PG8_SB(1, 0), rB, (b2) + kstep, voffB); PG8_STAGE(PG8_SB(1, 1), rB, (b2) + kstep + hstep, voffB); PG8_STAGE(PG8_SA(1, 0), rA, (a2) + kstep, cA0); \
            PG8_WAIT_V(8); PG8_WAIT_L(0); PG8_BAR; PG8_MMA(1, 0, At, B0); PG8_MMA(1, 1, At, B1); PG8_BAR; PG8_SCHED; } while (0)
    for (;;) {
        const bool has_next = S.next(ui + 1, nxt);
        const unsigned nB = has_next ? (unsigned)nxt.brow0 * (unsigned)K : cB;
        unsigned dlt = 0u;
        if constexpr (Sched::CONTIG) { dlt = has_next ? (unsigned)(nxt.arow0 - cur.arow0) * (unsigned)K : 0u; }
        else { unsigned n0[2], n1[2]; if (has_next) { PG8_AOFFS(nxt, n0, n1); } else { n0[0] = cA0[0]; n0[1] = cA0[1]; n1[0] = cA1[0]; n1[1] = cA1[1]; }
          *((LAS u32x4*)(lds + NXT_OFF) + tid) = (u32x4){n0[0], n0[1], n1[0], n1[1]}; }
        for (int t = 0; t < nt - 2; t += 2) {
            const unsigned a1 = (unsigned)(t + 1) * kstep, a2 = (unsigned)(t + 2) * kstep, b2 = cB + (unsigned)(t + 2) * kstep;
            PG8_PAIR(a1, a2, b2, (void)0);
        }
        {
            const unsigned a1 = (unsigned)(nt - 1) * kstep;
            PG8_PAIR(a1, 0u, nB, do { if constexpr (Sched::CONTIG) { cA0[0] += dlt; cA0[1] += dlt; cA1[0] += dlt; cA1[1] += dlt; } else { const u32x4 _n = *((LAS u32x4*)(lds + NXT_OFF) + tid); cA0[0] = _n.x; cA0[1] = _n.y; cA1[0] = _n.z; cA1[1] = _n.w; } } while (0));
        }
        { int l2; asm volatile("v_mbcnt_lo_u32_b32 %0, -1, 0\n\tv_mbcnt_hi_u32_b32 %0, -1, %0" : "=v"(l2));
          E(acc, cur, wr, wc, l2 & 15, l2 >> 4); S.done(cur, l2); }
        if (!has_next) break;
#pragma unroll
        for (int a = 0; a < 2; ++a)
#pragma unroll
            for (int b = 0; b < 2; ++b)
#pragma unroll
                for (int m = 0; m < 4; ++m)
#pragma unroll
                    for (int n = 0; n < 2; ++n) acc[a][b][m][n] = (f32x4){0.f, 0.f, 0.f, 0.f};
        cur = nxt; cB = nB; ++ui;
    }
    PG8_WAIT_V(0);
    if (wr == 0) PG8_BAR;
    PG8_BAR;
#undef PG8_PAIR
#undef PG8_AOFFS
#undef PG8_SA
#undef PG8_SB
#undef PG8_STAGE
#undef PG8_LDA
#undef PG8_LDB
#undef PG8_MMA
#undef PG8_WAIT_V
#undef PG8_WAIT_L
#undef PG8_BAR
#undef PG8_SCHED
}
struct Gemm16 { const bf16_t* A; const bf16_t* Bt; int K; unsigned abytes, bbytes; };
struct EpiGateUp16 {
    static constexpr bool PERM = true;
    bf16_t* HID; const int* list; const float* gatew;
    __device__ __forceinline__ void operator()(const f32x4 (&acc)[2][2][4][2], const Unit& u, int wr, int wc, int fr, int fq) const {
        const int col0 = u.pn * 128 + wc * 32 + 8 * fq;
#pragma unroll
        for (int ai = 0; ai < 2; ++ai)
#pragma unroll
            for (int m = 0; m < 4; ++m) {
                const int r = ai * HALF + wr * 64 + m * 16 + fr; const int idx = u.pm * BM + r;
                float wgt = 0.f; if (idx < u.cnt) wgt = gatew[list[u.e * T + idx]];
                const f32x4 g0 = acc[ai][0][m][0], g1 = acc[ai][0][m][1], u0 = acc[ai][1][m][0], u1 = acc[ai][1][m][1];
                float h[8];
#pragma unroll
                for (int i = 0; i < 4; ++i) { h[i] = siluf_(g0[i]) * u0[i] * wgt; h[4 + i] = siluf_(g1[i]) * u1[i] * wgt; }
                u32x4 w; w.x = cvt_pk_bf16(h[0], h[1]); w.y = cvt_pk_bf16(h[2], h[3]); w.z = cvt_pk_bf16(h[4], h[5]); w.w = cvt_pk_bf16(h[6], h[7]);
                *(u32x4*)(HID + (size_t)(u.arow0 + r) * DEXP + col0) = w;
            }
    }
};
template <class Epi, class Sched>
__device__ __forceinline__ void gemm_phase16(LAS unsigned char* lds, int wave_id, const Gemm16 g, const Sched& S, const Epi& E) {
    int lane; asm volatile("v_mbcnt_lo_u32_b32 %0, -1, 0\n\tv_mbcnt_hi_u32_b32 %0, -1, %0" : "=v"(lane));
    const int wid = wave_id, tid = wid * 64 + lane, wr = wid >> 2, wc = wid & 3, fr = lane & 15, fq = lane >> 4;
    const int K = g.K, nt = K / BK;
    unsigned voffB[2];
#pragma unroll
    for (int i = 0; i < 2; ++i) { int R, C; stage_rc(tid * 16 + i * 8192, R, C); const int Rb = Epi::PERM ? ((R & ~31) + perm32(R & 31)) : R; voffB[i] = (unsigned)(Rb * K + C) * 2u; }
    const unsigned ldsw = (unsigned)wid * 1024u;
    const int aoff = lds_byte(wr * 64 + fr, fq * 8), boff = lds_byte(wc * 32 + fr, fq * 8);
#define PG8_SA(b, h) (((b) * 2 + (h)) * HTB)
#define PG8_SB(b, h) ((4 + (b) * 2 + (h)) * HTB)
#define PG8_STAGE(bufoff, rsrc, soff, voff) do { _Pragma("unroll") for (int _i = 0; _i < 2; ++_i) \
        __builtin_amdgcn_raw_ptr_buffer_load_lds(rsrc, (LAS void*)(lds + (bufoff) + ldsw + _i * 8192), 16, (int)(voff)[_i], (int)(soff), 0, 0); } while (0)
#define PG8_LDA(dst, b, h) do { _Pragma("unroll") for (int m = 0; m < 4; ++m) _Pragma("unroll") for (int k = 0; k < 2; ++k) dst[m][k] = *(const LAS bf16x8*)(lds + PG8_SA(b, h) + aoff + m * 2048 + k * 1024); } while (0)
#define PG8_LDB(dst, b, h) do { _Pragma("unroll") for (int n = 0; n < 2; ++n) _Pragma("unroll") for (int k = 0; k < 2; ++k) dst[n][k] = *(const LAS bf16x8*)(lds + PG8_SB(b, h) + boff + n * 2048 + k * 1024); } while (0)
#define PG8_MMA(ai, bj, At, Bt) do { __builtin_amdgcn_s_setprio(1); _Pragma("unroll") for (int m = 0; m < 4; ++m) _Pragma("unroll") for (int n = 0; n < 2; ++n) _Pragma("unroll") for (int k = 0; k < 2; ++k) \
        acc[ai][bj][m][n] = __builtin_amdgcn_mfma_f32_16x16x32_bf16(Bt[n][k], At[m][k], acc[ai][bj][m][n], 0, 0, 0); __builtin_amdgcn_s_setprio(0); } while (0)
#define PG8_WAIT_V(n) asm volatile("s_waitcnt vmcnt(" #n ")" ::: "memory")
#define PG8_WAIT_L(n) asm volatile("s_waitcnt lgkmcnt(" #n ")" ::: "memory")
#define PG8_BAR __builtin_amdgcn_s_barrier()
#define PG8_SCHED __builtin_amdgcn_sched_barrier(0)
#define PG8_AOFFS(u, o0, o1) do { _Pragma("unroll") for (int _i = 0; _i < 2; ++_i) { int _R, _C; stage_rc(tid * 16 + _i * 8192, _R, _C); \
        o0[_i] = (S.arow(u, _R) * (unsigned)K + (unsigned)_C) * 2u; o1[_i] = (S.arow(u, HALF + _R) * (unsigned)K + (unsigned)_C) * 2u; } } while (0)
    Unit cur, nxt; int ui = 0;
    typename Sched::State st;
    if (!S.first(st, cur, tid)) return;
    f32x4 acc[2][2][4][2];
#pragma unroll
    for (int a = 0; a < 2; ++a)
#pragma unroll
        for (int b = 0; b < 2; ++b)
#pragma unroll
            for (int m = 0; m < 4; ++m)
#pragma unroll
                for (int n = 0; n < 2; ++n) acc[a][b][m][n] = (f32x4){0.f, 0.f, 0.f, 0.f};
    bf16x8 At[4][2], B0[2][2], B1[2][2];
    unsigned cA0[2], cA1[2];
    PG8_AOFFS(cur, cA0, cA1);
    const __amdgpu_buffer_rsrc_t rA = __builtin_amdgcn_make_buffer_rsrc((void*)g.A, (short)0, (int)g.abytes, 0x00020000);
    const __amdgpu_buffer_rsrc_t rB = __builtin_amdgcn_make_buffer_rsrc((void*)g.Bt, (short)0, (int)g.bbytes, 0x00020000);
    const unsigned kstep = (unsigned)(BK * 2);
    const unsigned hstep = (unsigned)HALF * (unsigned)K * 2u;
    unsigned cB = (unsigned)cur.brow0 * (unsigned)K * 2u;
    PG8_STAGE(PG8_SB(0, 0), rB, cB, voffB); PG8_STAGE(PG8_SB(0, 1), rB, cB + hstep, voffB); PG8_STAGE(PG8_SA(0, 0), rA, 0u, cA0); PG8_STAGE(PG8_SA(0, 1), rA, 0u, cA1);
    if (wr == 1) PG8_BAR;
    PG8_WAIT_V(2); PG8_BAR;
    PG8_STAGE(PG8_SB(1, 0), rB, cB + kstep, voffB); PG8_STAGE(PG8_SA(1, 0), rA, kstep, cA0); PG8_STAGE(PG8_SB(1, 1), rB, cB + hstep + kstep, voffB);
    PG8_WAIT_V(6); PG8_BAR;
#define PG8_PAIR(a1, a2, b2, SWITCH) do { \
            PG8_LDB(B0, 0, 0); PG8_LDB(B1, 0, 1); PG8_SCHED; PG8_LDA(At, 0, 0); PG8_STAGE(PG8_SA(1, 1), rA, a1, cA1); \
            SWITCH; \
            PG8_WAIT_V(8); PG8_WAIT_L(0); PG8_BAR; PG8_MMA(0, 0, At, B0); PG8_MMA(0, 1, At, B1); PG8_BAR; PG8_SCHED; \
            PG8_LDA(At, 0, 1); PG8_STAGE(PG8_SB(0, 0), rB, b2, voffB); PG8_STAGE(PG8_SB(0, 1), rB, (b2) + hstep, voffB); PG8_STAGE(PG8_SA(0, 0), rA, a2, cA0); \
            PG8_WAIT_V(8); PG8_WAIT_L(0); PG8_BAR; PG8_MMA(1, 0, At, B0); PG8_MMA(1, 1, At, B1); PG8_BAR; PG8_SCHED; \
            PG8_LDB(B0, 1, 0); PG8_LDB(B1, 1, 1); PG8_SCHED; PG8_LDA(At, 1, 0); PG8_STAGE(PG8_SA(0, 1), rA, a2, cA1); \
            PG8_WAIT_V(8); PG8_WAIT_L(0); PG8_BAR; PG8_MMA(0, 0, At, B0); PG8_MMA(0, 1, At, B1); PG8_BAR; PG8_SCHED; \
            PG8_LDA(At, 1, 1); PG8_STAGE(PG8_SB(1, 0), rB, (b2) + kstep, voffB); PG8_STAGE(PG8_SB(1, 1), rB, (b2) + kstep + hstep, voffB); PG8_STAGE(PG8_SA(1, 0), rA, (a2) + kstep, cA0); \
            PG8_WAIT_V(8); PG8_WAIT_L(0); PG8_BAR; PG8_MMA(1, 0, At, B0); PG8_MMA(1, 1, At, B1); PG8_BAR; PG8_SCHED; } while (0)
    for (;;) {
        S.issue(st, ui + 1, tid);
        for (int t = 0; t < nt - 2; t += 2) {
            const unsigned a1 = (unsigned)(t + 1) * kstep, a2 = (unsigned)(t + 2) * kstep, b2 = cB + (unsigned)(t + 2) * kstep;
            PG8_PAIR(a1, a2, b2, (void)0);
        }
        const bool has_next = S.fin(st, ui + 1, nxt, tid);
        const unsigned nB = has_next ? (unsigned)nxt.brow0 * (unsigned)K * 2u : cB;
        {
            const unsigned a1 = (unsigned)(nt - 1) * kstep;
            PG8_PAIR(a1, 0u, nB, do { if (has_next) { PG8_AOFFS(nxt, cA0, cA1); } } while (0));
        }
        if (wr == 0) PG8_BAR;
        { int l2; asm volatile("v_mbcnt_lo_u32_b32 %0, -1, 0\n\tv_mbcnt_hi_u32_b32 %0, -1, %0" : "=v"(l2));
          E(acc, cur, wr, wc, l2 & 15, l2 >> 4); S.done(cur, l2); }
        if (!has_next) break;
#pragma unroll
        for (int a = 0; a < 2; ++a)
#pragma unroll
            for (int b = 0; b < 2; ++b)
#pragma unroll
                for (int m = 0; m < 4; ++m)
#pragma unroll
                    for (int n = 0; n < 2; ++n) acc[a][b][m][n] = (f32x4){0.f, 0.f, 0.f, 0.f};
        cur = nxt; cB = nB; ++ui;
        if (wr == 1) PG8_BAR;
    }
    PG8_WAIT_V(0);
    PG8_BAR;
#undef PG8_PAIR
#undef PG8_AOFFS
#undef PG8_SA
#undef PG8_SB
#undef PG8_STAGE
#undef PG8_LDA
#undef PG8_LDB
#undef PG8_MMA
#undef PG8_WAIT_V
#undef PG8_WAIT_L
#undef PG8_BAR
#undef PG8_SCHED
}
}

#define XB_TMO      128
#define XB_XCNT(j)  (256  + 64 * (j))
#define XB_XSUB(j)  (1280 + 64 * (j))
#define XB_XGEN(j)  (2304 + 64 * (j))
#define XB_TOP      3328
#define XB_TOPGEN   3392
#define XCD_BAR_WORDS 3456
#define XB_SPIN_CAP (1u << 20)
__device__ __forceinline__ unsigned xb_ld(unsigned* p)              { return __hip_atomic_load(p, __ATOMIC_RELAXED, __HIP_MEMORY_SCOPE_AGENT); }
__device__ __forceinline__ unsigned xb_add(unsigned* p, unsigned v) { return __hip_atomic_fetch_add(p, v, __ATOMIC_RELAXED, __HIP_MEMORY_SCOPE_AGENT); }
__device__ __forceinline__ unsigned xb_xcc_id() { return (unsigned)__builtin_amdgcn_s_getreg((3 << 11) | 20) & 0xFu; }
#define XB_SPIN(cond, bar) do { unsigned _sp = 0; while (cond) { __builtin_amdgcn_s_sleep(1); \
    if ((++_sp & 255u) == 0u) { if (xb_ld(&(bar)[XB_TMO])) break; if (_sp > XB_SPIN_CAP) { atomicAdd(&(bar)[XB_TMO], 1u); break; } } } } while (0)
__device__ __forceinline__ void xcd_barrier_complete(unsigned* bar, unsigned x, unsigned& nloc, unsigned& nx) {
    const unsigned G = gridDim.x;
    unsigned sum, cnt, mine, sp = 0u;
    for (;;) {
        sum = 0u; cnt = 0u; mine = 0u;
#pragma unroll
        for (unsigned j = 0; j < 16; ++j) { const unsigned c = xb_ld(&bar[XB_XCNT(j)]); sum += c; cnt += (c > 0u) ? 1u : 0u; mine = (j == x) ? c : mine; }
        if (sum == G) break;
        __builtin_amdgcn_s_sleep(1);
        if ((++sp & 255u) == 0u) { if (xb_ld(&bar[XB_TMO])) break; if (sp > XB_SPIN_CAP) { atomicAdd(&bar[XB_TMO], 1u); break; } }
    }
    nloc = mine > 0u ? mine : 1u; nx = cnt > 0u ? cnt : 1u;
}
__device__ __forceinline__ void xcd_barrier(unsigned* bar, volatile LAS unsigned* st, int wave) {
    asm volatile("s_waitcnt vmcnt(0) lgkmcnt(0)" ::: "memory");
    __syncthreads();
    int lane; asm volatile("v_mbcnt_lo_u32_b32 %0, -1, 0\n\tv_mbcnt_hi_u32_b32 %0, -1, %0" : "=v"(lane));
    if (wave == 0 && lane == 0) {
        __builtin_amdgcn_s_waitcnt(0);
        const unsigned x = xb_xcc_id();
        unsigned nloc = st[0], nx = st[1];
        if (nloc == 0u) { xcd_barrier_complete(bar, x, nloc, nx); st[0] = nloc; st[1] = nx; }
        const unsigned old = xb_add(&bar[XB_XSUB(x)], 1u);
        const unsigned gen = old / nloc;
        if (old + 1u == (gen + 1u) * nloc) {
            __builtin_amdgcn_fence(__ATOMIC_RELEASE, "agent");
            asm volatile("s_waitcnt vmcnt(0)" ::: "memory");
            const unsigned og = xb_add(&bar[XB_TOP], 1u);
            const unsigned tg = og / nx;
            if (og + 1u == (tg + 1u) * nx) xb_add(&bar[XB_TOPGEN], 1u);
            else XB_SPIN(xb_ld(&bar[XB_TOPGEN]) == tg, bar);
            __builtin_amdgcn_fence(__ATOMIC_ACQUIRE, "agent");
            xb_add(&bar[XB_XGEN(x)], 1u);
            asm volatile("s_waitcnt vmcnt(0)" ::: "memory");
        } else {
            XB_SPIN(xb_ld(&bar[XB_XGEN(x)]) == gen, bar);
            __builtin_amdgcn_fence(__ATOMIC_ACQUIRE, "agent");
            asm volatile("s_waitcnt vmcnt(0)" ::: "memory");
        }
    }
    __syncthreads();
}

struct Params {
    const float* in[18];
    float* out; unsigned char* ws;
};
enum { I_X = 0, I_EV_WIN, I_EV_CONV, I_EV_ALOG, I_EV_DTB, I_EV_GDNN, I_EV_HGRNN, I_LBLOG, I_EV_WOUT, I_OD_WIN, I_OD_WOUT, I_RW, I_RB, I_MG, I_MU, I_MD, I_LNG, I_LNB };

struct Frame {
    LAS unsigned char* lds;
    int tid, lane, wave, G, bid;
};
__device__ __forceinline__ Frame refresh(const Frame& F0) {
    Frame F = F0; int l; asm volatile("v_mbcnt_lo_u32_b32 %0, -1, 0\n\tv_mbcnt_hi_u32_b32 %0, -1, %0" : "=v"(l));
    F.lane = l; F.tid = F0.wave * 64 + l; return F;
}

constexpr size_t WS_W3 = WS_AB + 16 * MiB, WS_WOUT1 = WS_WOUT + 4 * MiB, WS_WGU1 = WS_WGU + 32 * MiB;
struct CDesc { const float* src; unsigned char* dst; int ld, Kd, fp8; };
__device__ __forceinline__ CDesc conv_desc(const Params& p, unsigned char* ws, int kind, int r) {
    CDesc d;
    switch (kind) {
    case 0: { const int kb = r / 256, nb = r % 256, n0 = nb * 32; const int c0 = n0 < 4096 ? n0 : n0 + 16;
        d.src = p.in[I_EV_WIN] + (size_t)(kb * 64) * EVEN_IN + c0; d.ld = EVEN_IN; d.dst = ws + WS_WIN + (size_t)n0 * 2048 + kb * 64; d.Kd = 2048; d.fp8 = 1; break; }
    case 1: { const int kb = r / 64, nb = r % 64; d.src = p.in[I_EV_WOUT] + (size_t)(kb * 64) * 2048 + nb * 32; d.ld = 2048; d.dst = ws + WS_WOUT + (size_t)(nb * 32) * 2048 + kb * 64; d.Kd = 2048; d.fp8 = 1; break; }
    case 2: case 6: { const int layer = kind == 6; const int isup = r >= 8192; if (isup) r -= 8192;
        const int e = r / 512, q = r % 512, kb = q / 16, nb = q % 16, f0 = nb * 32;
        d.src = (isup ? p.in[I_MU] : p.in[I_MG]) + (size_t)(layer * NE + e) * 2048 * 512 + (size_t)(kb * 64) * 512 + f0; d.ld = 512;
        d.dst = ws + (layer ? WS_WGU1 : WS_WGU) + (size_t)e * 1024 * 2048 + (size_t)(256 * (f0 >> 7) + 128 * isup + (f0 & 127)) * 2048 + kb * 64; d.Kd = 2048; d.fp8 = 1; break; }
    case 3: case 7: { const int layer = kind == 7; const int e = r / 512, q = r % 512, kb = q / 64, nb = q % 64;
        d.src = p.in[I_MD] + (size_t)(layer * NE + e) * 512 * 2048 + (size_t)(kb * 64) * 2048 + nb * 32; d.ld = 2048;
        d.dst = ws + WS_WD + ((size_t)e * 2048 * 512 + (size_t)(nb * 32) * 512 + kb * 64) * 2; d.Kd = 512; d.fp8 = 0; break; }
    case 4: { const int kb = r / 192, nb = r % 192; d.src = p.in[I_OD_WIN] + (size_t)(kb * 64) * ODD_IN + nb * 32; d.ld = ODD_IN; d.dst = ws + WS_W3 + (size_t)(nb * 32) * 2048 + kb * 64; d.Kd = 2048; d.fp8 = 1; break; }
    default: { const int kb = r / 64, nb = r % 64; d.src = p.in[I_OD_WOUT] + (size_t)(kb * 64) * 2048 + nb * 32; d.ld = 2048; d.dst = ws + WS_WOUT1 + (size_t)(nb * 32) * 1024 + kb * 64; d.Kd = 1024; d.fp8 = 1; break; }
    }
    return d;
}
__device__ __forceinline__ void conv_load(const CDesc& d, int lane, float (&wv)[32]) {
    const float* wp = d.src + (size_t)(lane >> 5) * d.ld + (lane & 31);
#pragma unroll
    for (int i = 0; i < 32; ++i) wv[i] = __builtin_nontemporal_load(wp + (size_t)(2 * i) * d.ld);
}
__device__ __forceinline__ void conv_store(const CDesc& d, int lane, const float (&wv)[32], LAS float* scr) {
#pragma unroll
    for (int i = 0; i < 32; ++i) scr[(2 * i + (lane >> 5)) * 33 + (lane & 31)] = wv[i];
    LDS_WAIT(); asm volatile("" ::: "memory");
    if (d.fp8) {
        const int c = lane & 3;
#pragma unroll
        for (int j = 0; j < 2; ++j) { const int n = (lane >> 2) + 16 * j; const LAS float* sp = scr + (16 * c) * 33 + n;
            u32x4 o;
            o.x = pk4_fp8(sp[0 * 33] * W_PRE, sp[1 * 33] * W_PRE, sp[2 * 33] * W_PRE, sp[3 * 33] * W_PRE);     o.y = pk4_fp8(sp[4 * 33] * W_PRE, sp[5 * 33] * W_PRE, sp[6 * 33] * W_PRE, sp[7 * 33] * W_PRE);
            o.z = pk4_fp8(sp[8 * 33] * W_PRE, sp[9 * 33] * W_PRE, sp[10 * 33] * W_PRE, sp[11 * 33] * W_PRE);   o.w = pk4_fp8(sp[12 * 33] * W_PRE, sp[13 * 33] * W_PRE, sp[14 * 33] * W_PRE, sp[15 * 33] * W_PRE);
            *(u32x4*)(d.dst + (size_t)n * d.Kd + 16 * c) = o; }
    } else {
        const int c = lane & 7;
#pragma unroll
        for (int j = 0; j < 4; ++j) { const int n = (lane >> 3) + 8 * j; const LAS float* sp = scr + (8 * c) * 33 + n;
            u32x4 o; o.x = pk2(sp[0 * 33], sp[1 * 33]); o.y = pk2(sp[2 * 33], sp[3 * 33]); o.z = pk2(sp[4 * 33], sp[5 * 33]); o.w = pk2(sp[6 * 33], sp[7 * 33]);
            *(u32x4*)(d.dst + ((size_t)n * d.Kd + 8 * c) * 2) = o; }
    }
    LDS_WAIT(); asm volatile("" ::: "memory");
}
__device__ __forceinline__ CDesc conv_item(const Params& p, unsigned char* ws, int set, int it) {
    if (set == 0) return it < 8192 ? conv_desc(p, ws, 0, it) : conv_desc(p, ws, 1, it - 8192);
    if (set == 1) { int r = it;
        if (r < 16384) return conv_desc(p, ws, 2, r); r -= 16384;
        if (r < 8192) return conv_desc(p, ws, 3, r); r -= 8192;
        if (r < 6144) return conv_desc(p, ws, 4, r); r -= 6144;
        if (r < 1024) return conv_desc(p, ws, 5, r); r -= 1024;
        return conv_desc(p, ws, 6, r); }
    return conv_desc(p, ws, 7, it);
}
__device__ __forceinline__ void convert_set(const Params& p, const Frame& F0, int set, int w, int nw) {
    const Frame F = refresh(F0);
    LAS float* scr = (LAS float*)(F.lds + F.wave * 16384);
    unsigned char* ws = opq(p.ws);
    const int N = set == 0 ? 8192 + 2048 : set == 1 ? 16384 + 8192 + 6144 + 1024 + 16384 : 8192;
    for (int it = w; it < N; it += 2 * nw) {
        const bool two = it + nw < N;
        const CDesc d0 = conv_item(p, ws, set, it), d1 = conv_item(p, ws, set, two ? it + nw : it);
        float v0[32], v1[32];
        conv_load(d0, F.lane, v0); if (two) conv_load(d1, F.lane, v1);
        conv_store(d0, F.lane, v0, scr); if (two) conv_store(d1, F.lane, v1, scr);
    }
}

__device__ __forceinline__ void load_w16_lds(const Frame& F0, const float* W, int ld, int c0) {
    const Frame F = refresh(F0);
    LAS float* l = (LAS float*)F.lds;
    for (int i = F.tid; i < 2048 * 16; i += NTHR) { const int k = i >> 4, e = i & 15; l[e * 2048 + k] = W[(size_t)k * ld + c0 + e]; }
}
__device__ __forceinline__ float dot16(const Frame& F, const f32x4 (&v)[8]) {
    const LAS f32x4* l = (const LAS f32x4*)F.lds;
    float res = 0.f;
#pragma unroll 1
    for (int e = 0; e < 16; ++e) { float s = 0.f;
#pragma unroll
        for (int j = 0; j < 8; ++j) { const f32x4 w = l[e * 512 + 64 * j + F.lane]; s += (v[j].x * w.x + v[j].y * w.y) + (v[j].z * w.z + v[j].w * w.w); }
        s = wave_sum(s); res = (F.lane == e) ? s : res; }
    return res;
}

__device__ __forceinline__ void p0_xpass(const Params& p, const Frame& F0) {
    const Frame F = refresh(F0);
    const int gw = F.bid * NWAVES + F.wave, NGW = F.G * NWAVES;
    float* BA = (float*)(opq(p.ws) + WS_BA); bf16_t* AB = (bf16_t*)(opq(p.ws) + WS_AB);
    for (int m = gw; m < T; m += NGW) {
        const f32x4* xr = (const f32x4*)(p.in[I_X] + (size_t)m * D) + F.lane;
        f32x4 v[8];
#pragma unroll
        for (int j = 0; j < 8; ++j) v[j] = xr[64 * j];
        unsigned* o = (unsigned*)((unsigned char*)AB + (size_t)m * D) + F.lane;
#pragma unroll
        for (int j = 0; j < 8; ++j) o[64 * j] = pk4_fp8(v[j].x * X_PRE, v[j].y * X_PRE, v[j].z * X_PRE, v[j].w * X_PRE);
        const float a = dot16(F, v);
        if (F.lane < 16) BA[(size_t)m * 16 + F.lane] = a;
    }
}

constexpr size_t WS_R16A = WS_OC + 16 * MiB, WS_R16B = WS_SCR + 190 * MiB;
__device__ __forceinline__ bf16_t* r16_row(unsigned char* ws, int m) { return (bf16_t*)(ws + (m < T / 2 ? WS_R16A + (size_t)m * D * 2 : WS_R16B + (size_t)(m - T / 2) * D * 2)); }
template <bool ROUTE, bool TWO, bool RES16, bool OUT16>
__device__ __forceinline__ void ln_pass(const Params& p, const Frame& F0, const float* resid, const bf16_t* add1, int ld1, const bf16_t* add2, const float* gain, const float* bias,
                                        float* outf, bf16_t* outb, int layer) {
    const Frame F = refresh(F0);
    const int TPB = (T + F.G - 1) / F.G;
    const int mbeg = ROUTE ? F.bid * TPB + F.wave : F.bid * NWAVES + F.wave, mend = ROUTE ? min(T, (F.bid + 1) * TPB) : T, mstep = ROUTE ? NWAVES : F.G * NWAVES;
    int* SEL = (int*)(opq(p.ws) + WS_CTL + 65536);
    int* HIST = (int*)(opq(p.ws) + WS_CTL + 32768);
    LAS int* lhist = (LAS int*)(F.lds + pg8::MOE_HIST_OFF);
    float* gatew = (float*)(opq(p.ws) + WS_GATEW) + (size_t)layer * 2 * T;
    if (ROUTE) { if (F.tid < NE) lhist[F.tid] = 0; __syncthreads(); }
    f32x4 gn[8], bs[8];
#pragma unroll
    for (int j = 0; j < 8; ++j) { gn[j] = ((const f32x4*)gain)[64 * j + F.lane]; bs[j] = ((const f32x4*)bias)[64 * j + F.lane]; }
    for (int m = mbeg; m < mend; m += mstep) {
        const f32x4* xr = (const f32x4*)(resid + (size_t)m * D) + F.lane;
        const u32x2* xr16 = (const u32x2*)r16_row(opq(p.ws), m) + F.lane;
        f32x4 v[8]; float s = 0.f;
#pragma unroll
        for (int j = 0; j < 8; ++j) {
            if (RES16) { const u32x2 a = xr16[64 * j]; v[j] = (f32x4){bflo(a.x), bfhi(a.x), bflo(a.y), bfhi(a.y)} * ALPHA; }
            else v[j] = xr[64 * j] * ALPHA;
            if (add1) { const u32x2 a = ((const u32x2*)(add1 + (size_t)(TWO ? 2 * m : m) * ld1))[64 * j + F.lane]; v[j].x += bflo(a.x); v[j].y += bfhi(a.x); v[j].z += bflo(a.y); v[j].w += bfhi(a.y); }
            if (TWO) { const u32x2 a = ((const u32x2*)(add2 + (size_t)(2 * m + 1) * ld1))[64 * j + F.lane]; v[j].x += bflo(a.x); v[j].y += bfhi(a.x); v[j].z += bflo(a.y); v[j].w += bfhi(a.y); }
#ifdef DBG_SANITIZE
            if (!(fabsf(v[j].x) < 1e30f)) v[j].x = 0.f; if (!(fabsf(v[j].y) < 1e30f)) v[j].y = 0.f; if (!(fabsf(v[j].z) < 1e30f)) v[j].z = 0.f; if (!(fabsf(v[j].w) < 1e30f)) v[j].w = 0.f;
#endif
            s += (v[j].x + v[j].y) + (v[j].z + v[j].w);
        }
        const float mean = wave_sum(s) * (1.f / D); float s2 = 0.f;
#pragma unroll
        for (int j = 0; j < 8; ++j) { v[j] = v[j] - mean; s2 += (v[j].x * v[j].x + v[j].y * v[j].y) + (v[j].z * v[j].z + v[j].w * v[j].w); }
        const float rstd = 1.f / sqrtf(wave_sum(s2) * (1.f / D) + LN_EPS);
#pragma unroll
        for (int j = 0; j < 8; ++j) v[j] = v[j] * rstd * gn[j] + bs[j];
        if (OUT16) { u32x2* of = (u32x2*)r16_row(opq(p.ws), m) + F.lane;
#pragma unroll
            for (int j = 0; j < 8; ++j) { u32x2 w; w.x = pk2(v[j].x, v[j].y); w.y = pk2(v[j].z, v[j].w); of[64 * j] = w; } }
        else { f32x4* of = (f32x4*)(outf + (size_t)m * D) + F.lane;
#pragma unroll
            for (int j = 0; j < 8; ++j) of[64 * j] = v[j]; }
        if (outb) {
            { unsigned* o = (unsigned*)((unsigned char*)outb + (size_t)m * D) + F.lane;
#pragma unroll
                for (int j = 0; j < 8; ++j) o[64 * j] = pk4_fp8(v[j].x, v[j].y, v[j].z, v[j].w); } }
        if (ROUTE) {
            const float lgl = dot16(F, v);
            const float scl = 1.0f / (1.0f + expf(-lgl)), bil = scl + p.in[I_RB][F.lane & 15];
            float sc[16], bi[16];
#pragma unroll
            for (int e = 0; e < 16; ++e) { sc[e] = __builtin_bit_cast(float, __builtin_amdgcn_readlane(__builtin_bit_cast(int, scl), e)); bi[e] = __builtin_bit_cast(float, __builtin_amdgcn_readlane(__builtin_bit_cast(int, bil), e)); }
            int bg = 0; float bgs = -3.0e38f;
#pragma unroll
            for (int g = 0; g < 4; ++g) { float m1 = -3.0e38f, m2 = -3.0e38f;
#pragma unroll
                for (int k = 0; k < 4; ++k) { const float x = bi[4 * g + k]; if (x > m1) { m2 = m1; m1 = x; } else if (x > m2) m2 = x; }
                const float gs = m1 + m2; if (gs > bgs) { bgs = gs; bg = g; } }
            int i1 = 0, i2 = 0; float b1 = -3.0e38f, b2 = -3.0e38f, s1 = 0.f, s2v = 0.f;
#pragma unroll
            for (int e = 0; e < 16; ++e) { if ((e >> 2) == bg) { const float x = bi[e]; if (x > b1) { b2 = b1; i2 = i1; s2v = s1; b1 = x; i1 = e; s1 = sc[e]; } else if (x > b2) { b2 = x; i2 = e; s2v = sc[e]; } } }
            if (F.lane == 0) {
                const float den = s1 + s2v;
                SEL[m] = i1 | (i2 << 8); gatew[2 * m] = s1 / den; gatew[2 * m + 1] = s2v / den;
                __hip_atomic_fetch_add(lhist + i1, 1, __ATOMIC_RELAXED, __HIP_MEMORY_SCOPE_WORKGROUP); __hip_atomic_fetch_add(lhist + i2, 1, __ATOMIC_RELAXED, __HIP_MEMORY_SCOPE_WORKGROUP);
            }
        }
    }
    if (ROUTE) { __syncthreads(); if (F.tid < NE) HIST[F.bid * NE + F.tid] = lhist[F.tid]; }
}

__device__ __forceinline__ void moe_lists(const Params& p, const Frame& F0, int layer) {
    const Frame F = refresh(F0);
    const int* SEL = (const int*)(opq(p.ws) + WS_CTL + 65536);
    const int* HIST = (const int*)(opq(p.ws) + WS_CTL + 32768);
    int* list = (int*)(opq(p.ws) + WS_LIST) + (size_t)layer * NE * T;
    LAS int* ltot = (LAS int*)(F.lds + pg8::MOE_HIST_OFF) + 16;
    LAS int* lbase = (LAS int*)(F.lds + pg8::MOE_HIST_OFF) + 32;
    if (F.tid < NE) { ltot[F.tid] = 0; lbase[F.tid] = 0; }
    __syncthreads();
    { const int e = F.tid & 15, grp = F.tid >> 4; int base = 0, tot = 0;
#pragma unroll 8
      for (int b = grp; b < F.G; b += 32) { const int h = HIST[b * NE + e]; tot += h; if (b < F.bid) base += h; }
      __hip_atomic_fetch_add(ltot + e, tot, __ATOMIC_RELAXED, __HIP_MEMORY_SCOPE_WORKGROUP); __hip_atomic_fetch_add(lbase + e, base, __ATOMIC_RELAXED, __HIP_MEMORY_SCOPE_WORKGROUP); }
    __syncthreads();
    LAS int* ltpre = (LAS int*)(F.lds + pg8::MOE_HIST_OFF) + 48;
    LAS int* lslot = (LAS int*)(F.lds + pg8::MOE_HIST_OFF) + 64;
    if (F.tid == 0) { int sacc = 0;
#pragma unroll 1
        for (int e = 0; e < NE; ++e) { ltpre[e] = sacc; sacc += (ltot[e] + 255) >> 8; } }
    __syncthreads();
    const int TPB = (T + F.G - 1) / F.G, m0 = F.bid * TPB, m1 = min(T, m0 + TPB);
    if (F.wave == 0) {
        for (int q0 = 2 * m0; q0 < 2 * m1; q0 += 64) {
            const int q = q0 + F.lane; const bool ok = q < 2 * m1;
            int e = -1; if (ok) { const int sv = SEL[q >> 1]; e = (q & 1) ? ((sv >> 8) & 255) : (sv & 255); }
            int rank = 0, cntsame = 0;
#pragma unroll 1
            for (int k = 0; k < NE; ++k) { const unsigned long long bal = __ballot(e == k); if (e == k) { rank = __popcll(bal & ((1ull << F.lane) - 1ull)); cntsame = __popcll(bal); } }
            if (ok) { const int pos = lbase[e] + rank; list[e * T + pos] = q; lslot[q - 2 * m0] = 256 * ltpre[e] + pos; }
            __builtin_amdgcn_s_waitcnt(0);
            if (ok && rank == cntsame - 1) lbase[e] += cntsame;
            __builtin_amdgcn_s_waitcnt(0);
        }
    }
    __syncthreads();
    {
        const unsigned char* AB8 = opq(p.ws) + WS_AB; unsigned char* ABS = opq(p.ws) + WS_ABS;
        const int nt_ = m1 - m0;
        for (int t0 = F.wave; t0 < nt_; t0 += 4 * NWAVES) {
            u32x4 r0[4], r1[4];
#pragma unroll
            for (int k = 0; k < 4; ++k) { const int tt = t0 + k * NWAVES; if (tt < nt_) { const u32x4* src = (const u32x4*)(AB8 + (size_t)(m0 + tt) * D) + F.lane; r0[k] = src[0]; r1[k] = src[64]; } }
#pragma unroll
            for (int k = 0; k < 4; ++k) { const int tt = t0 + k * NWAVES; if (tt < nt_) {
#pragma unroll
                for (int jj = 0; jj < 2; ++jj) { u32x4* dst = (u32x4*)(ABS + (size_t)lslot[2 * tt + jj] * D) + F.lane; dst[0] = r0[k]; dst[64] = r1[k]; } } }
        }
    }
}

constexpr int H1LD = 8192, C_ZA = 3072, C_QB = 4096, C_FB = 5120, C_IB = 6144, C_GB = 7168;
constexpr size_t G_U0 = 0;
constexpr size_t G_WM = 32 * MiB;
constexpr size_t G_QD = 48 * MiB;
constexpr size_t G_KDT = 64 * MiB;
constexpr size_t G_QK = 80 * MiB;
constexpr size_t G_CD = 88 * MiB;
constexpr size_t H_QD = 89 * MiB;
constexpr size_t H_KI = 105 * MiB;
constexpr size_t H_KDT = 121 * MiB;
constexpr size_t H_IT = 137 * MiB;
constexpr size_t H_CD = 153 * MiB;
constexpr size_t O_A = 155 * MiB;
constexpr size_t O_B = 171 * MiB;
static_assert(O_B + 16 * MiB <= 216 * MiB, "mixer-0 scratch");

__device__ __forceinline__ f32x4 mfma32(bf16x8 a, bf16x8 b, f32x4 c) { return __builtin_amdgcn_mfma_f32_16x16x32_bf16(a, b, c, 0, 0, 0); }
__device__ __forceinline__ f32x4 mfma16(bf16x4 a, bf16x4 b, f32x4 c) { const bf16x8 a8 = {a[0], a[1], a[2], a[3], 0, 0, 0, 0}, b8 = {b[0], b[1], b[2], b[3], 0, 0, 0, 0}; return __builtin_amdgcn_mfma_f32_16x16x32_bf16(a8, b8, c, 0, 0, 0); }
__device__ __forceinline__ bf16x8 pack8(f32x4 lo, f32x4 hi) {
    u32x4 w; w.x = cvt_pk_bf16(lo[0], lo[1]); w.y = cvt_pk_bf16(lo[2], lo[3]); w.z = cvt_pk_bf16(hi[0], hi[1]); w.w = cvt_pk_bf16(hi[2], hi[3]); return __builtin_bit_cast(bf16x8, w);
}
__device__ __forceinline__ bf16x4 pack4(f32x4 v) { u32x2 w; w.x = cvt_pk_bf16(v[0], v[1]); w.y = cvt_pk_bf16(v[2], v[3]); return __builtin_bit_cast(bf16x4, w); }
__device__ __forceinline__ bf16x8 frag_perm(const LAS bf16_t* rowp, int col) {
    const u32x2 lo = *(const LAS u32x2*)(rowp + col), hi = *(const LAS u32x2*)(rowp + col + 16);
    u32x4 w; w.x = lo.x; w.y = lo.y; w.z = hi.x; w.w = hi.y; return __builtin_bit_cast(bf16x8, w);
}

__device__ __forceinline__ void gdn_pre_pair(const Params& p, const Frame& F, int unit0, int unit1) {
    const int hb = F.wave >> 2, w4 = F.wave & 3, t8 = F.tid & 255, lane = F.lane, fr = lane & 15, g = lane >> 4;
    const int unit = hb ? unit1 : unit0;
    const bool active = unit < 1024;
    const int bh = unit >> 5, ci = unit & 31, b = bh >> 3, h = bh & 7;
    const int tok0 = b * SEQ + ci * 64;
    LAS unsigned char* hl = F.lds + hb * 72192;
    LAS bf16_t* Qb = (LAS bf16_t*)(hl);
    LAS bf16_t* Kb = (LAS bf16_t*)(hl + 17408);
    LAS bf16_t* RVt = (LAS bf16_t*)(hl + 34816);
    LAS bf16_t* RKt = (LAS bf16_t*)(hl + 53248);
    LAS float* sc_g = (LAS float*)(hl + 71680);
    LAS float* sc_b = sc_g + 64;
    LAS float* Lm = (LAS float*)(hl);
    LAS bf16_t* Tb = (LAS bf16_t*)(hl + 17408);
    const bf16_t* H1 = (const bf16_t*)(opq(p.ws) + WS_H1);
    const float* BA = (const float*)(opq(p.ws) + WS_BA);
    unsigned char* scr = opq(p.ws) + WS_SCR;
    if (active) {
        if (t8 < 192) {
            const int sec = t8 >> 6, c2 = (t8 & 63) * 2;
            const int col = sec * 1024 + h * 128 + c2;
            const float* cw = p.in[I_EV_CONV] + col;
            const float w0a = cw[0], w0b = cw[1], w1a = cw[3072], w1b = cw[3073], w2a = cw[6144], w2b = cw[6145], w3a = cw[9216], w3b = cw[9217];
            float xa[3], xb[3];
#pragma unroll
            for (int k = 0; k < 3; ++k) { const int s = ci * 64 - 3 + k; unsigned v = 0u; if (s >= 0) v = *(const unsigned*)(H1 + (size_t)(b * SEQ + s) * H1LD + col); xa[k] = bflo(v); xb[k] = bfhi(v); }
#pragma unroll 1
            for (int q2 = 0; q2 < 2; ++q2) {
                unsigned vv[32];
#pragma unroll
                for (int tl = 0; tl < 32; ++tl) vv[tl] = *(const unsigned*)(H1 + (size_t)(tok0 + 32 * q2 + tl) * H1LD + col);
#pragma unroll
                for (int t2 = 0; t2 < 32; ++t2) {
                    const int tl = 32 * q2 + t2;
                    const float x3a = bflo(vv[t2]), x3b = bfhi(vv[t2]);
                    float ya = w0a * xa[0] + w1a * xa[1] + w2a * xa[2] + w3a * x3a, yb = w0b * xb[0] + w1b * xb[1] + w2b * xb[2] + w3b * x3b;
                    xa[0] = xa[1]; xa[1] = xa[2]; xa[2] = x3a; xb[0] = xb[1]; xb[1] = xb[2]; xb[2] = x3b;
                    ya = siluf_(ya); yb = siluf_(yb);
                    if (sec == 0) *(LAS unsigned*)(Qb + tl * 136 + c2) = pk2(ya, yb);
                    else if (sec == 1) *(LAS unsigned*)(Kb + tl * 136 + c2) = pk2(ya, yb);
                    else { const float be = sigmoidf_(BA[(size_t)(tok0 + tl) * 16 + h]); RVt[c2 * 72 + tl] = (bf16_t)f2bf(ya * be); RVt[(c2 + 1) * 72 + tl] = (bf16_t)f2bf(yb * be); }
                }
            }
        } else {
            const int t = tok0 + lane;
            const float ba = BA[(size_t)t * 16 + h], aa = BA[(size_t)t * 16 + 8 + h];
            const float xx = aa + p.in[I_EV_DTB][h];
            const float sp = xx > 20.f ? xx : log1pf(expf(xx));
            float gg = -expf(p.in[I_EV_ALOG][h]) * sp;
            gg += dpp_f<0x111>(gg); gg += dpp_f<0x112>(gg); gg += dpp_f<0x114>(gg); gg += dpp_f<0x118>(gg);
            { const float t0 = __builtin_bit_cast(float, __builtin_amdgcn_readlane(__builtin_bit_cast(int, gg), 15)), t1 = __builtin_bit_cast(float, __builtin_amdgcn_readlane(__builtin_bit_cast(int, gg), 31)),
                          t2 = __builtin_bit_cast(float, __builtin_amdgcn_readlane(__builtin_bit_cast(int, gg), 47));
              gg += (lane >= 16 ? t0 : 0.f) + (lane >= 32 ? t1 : 0.f) + (lane >= 48 ? t2 : 0.f); }
            sc_g[lane] = gg; sc_b[lane] = sigmoidf_(ba);
        }
    }
    __syncthreads();
    if (active) {
        bf16_t* QDg = (bf16_t*)(scr + G_QD) + (size_t)unit * 64 * 128;
#pragma unroll 2
        for (int rr = 0; rr < 16; ++rr) {
            const int r = w4 * 16 + rr;
            const unsigned qv = *(const LAS unsigned*)(Qb + r * 136 + 2 * lane), kv = *(const LAS unsigned*)(Kb + r * 136 + 2 * lane);
            const float q0 = bflo(qv), q1 = bfhi(qv), k0 = bflo(kv), k1 = bfhi(kv);
            const float sq = wave_sum(q0 * q0 + q1 * q1), sk = wave_sum(k0 * k0 + k1 * k1);
            const float rq = rsqrtf(sq + RMS_EPS) * 0.08838834764831845f, rk = rsqrtf(sk + RMS_EPS);
            const float gc = sc_g[r], be = sc_b[r], eg = expf(gc);
            const float qn0 = q0 * rq, qn1 = q1 * rq, kn0 = k0 * rk, kn1 = k1 * rk;
            *(LAS unsigned*)(Qb + r * 136 + 2 * lane) = pk2(qn0, qn1);
            *(LAS unsigned*)(Kb + r * 136 + 2 * lane) = pk2(kn0, kn1);
            RKt[(2 * lane) * 72 + r] = (bf16_t)f2bf(kn0 * be * eg); RKt[(2 * lane + 1) * 72 + r] = (bf16_t)f2bf(kn1 * be * eg);
            *(unsigned*)(QDg + r * 128 + 2 * lane) = pk2(qn0 * eg, qn1 * eg);
        }
    }
    __syncthreads();
    f32x4 kk[4];
    if (active) {
        {
            bf16_t* KDt = (bf16_t*)(scr + G_KDT) + (size_t)unit * 128 * 64;
            const float gl = sc_g[63];
#pragma unroll
            for (int it = 0; it < 4; ++it) { const int idx = t8 + 256 * it, f = idx >> 3, c0 = (idx & 7) * 8;
                float v[8];
#pragma unroll
                for (int i = 0; i < 8; ++i) v[i] = bf2f(Kb[(c0 + i) * 136 + f]) * expf(gl - sc_g[c0 + i]);
                u32x4 w; w.x = pk2(v[0], v[1]); w.y = pk2(v[2], v[3]); w.z = pk2(v[4], v[5]); w.w = pk2(v[6], v[7]);
                *(u32x4*)(KDt + f * 64 + c0) = w; }
        }
        const int mt = w4;
        bf16_t* QKm = (bf16_t*)(scr + G_QK) + (size_t)unit * 64 * 64;
        bf16x8 a[4];
#pragma unroll
        for (int kb = 0; kb < 4; ++kb) a[kb] = *(const LAS bf16x8*)(Kb + (16 * mt + fr) * 136 + 32 * kb + 8 * g);
#pragma unroll
        for (int nt = 0; nt < 4; ++nt) {
            f32x4 c = (f32x4){0.f, 0.f, 0.f, 0.f}, c2 = (f32x4){0.f, 0.f, 0.f, 0.f};
#pragma unroll
            for (int kb = 0; kb < 4; ++kb) { const bf16x8 bq = *(const LAS bf16x8*)(Qb + (16 * nt + fr) * 136 + 32 * kb + 8 * g), bk = *(const LAS bf16x8*)(Kb + (16 * nt + fr) * 136 + 32 * kb + 8 * g);
                c = mfma32(a[kb], bq, c); c2 = mfma32(a[kb], bk, c2); }
            const int cj = 16 * nt + fr; const float gcol = sc_g[cj];
            {
                float v[4];
#pragma unroll
                for (int r = 0; r < 4; ++r) { const int j = 16 * mt + 4 * g + r; v[r] = (cj >= j) ? expf(gcol - sc_g[j]) * c[r] : 0.f; }
                u32x2 w; w.x = pk2(v[0], v[1]); w.y = pk2(v[2], v[3]);
                *(u32x2*)(QKm + cj * 64 + 16 * mt + 4 * g) = w;
            }
#pragma unroll
            for (int r = 0; r < 4; ++r) { const int i = 16 * mt + 4 * g + r; kk[nt][r] = (i > cj) ? sc_b[i] * expf(sc_g[i] - gcol) * c2[r] : 0.f; }
        }
    }
    __syncthreads();
    if (active) {
#pragma unroll
        for (int nt = 0; nt < 4; ++nt)
#pragma unroll
            for (int r = 0; r < 4; ++r) Lm[(16 * w4 + 4 * g + r) * 68 + 16 * nt + fr] = kk[nt][r];
    }
    __syncthreads();
    if (active && w4 == 0) {
        float t[64];
#pragma unroll
        for (int i = 0; i < 64; ++i) t[i] = 0.f;
#pragma unroll
        for (int i = 0; i < 64; ++i) {
            float a0 = (i == lane) ? 1.f : 0.f, a1 = 0.f, a2 = 0.f, a3 = 0.f;
#pragma unroll
            for (int jj = 0; jj < (i + 3) / 4; ++jj) { const f32x4 lv = *(const LAS f32x4*)(Lm + i * 68 + 4 * jj);
                a0 -= lv[0] * t[4 * jj]; a1 -= lv[1] * t[4 * jj + 1]; a2 -= lv[2] * t[4 * jj + 2]; a3 -= lv[3] * t[4 * jj + 3]; }
            t[i] = (a0 + a1) + (a2 + a3);
        }
#pragma unroll
        for (int i = 0; i < 64; ++i) Tb[i * 72 + lane] = (bf16_t)f2bf(t[i]);
    }
    __syncthreads();
    if (active) {
        f32x4* U0f = (f32x4*)(scr + G_U0) + (size_t)unit * 8 * 4 * 64;
        bf16_t* Wm = (bf16_t*)(scr + G_WM) + (size_t)unit * 64 * 128;
#pragma unroll
        for (int hh = 0; hh < 2; ++hh) {
            const int ct = w4 + 4 * hh;
            bf16x8 bv[2], ak[2];
#pragma unroll
            for (int k = 0; k < 2; ++k) { bv[k] = *(const LAS bf16x8*)(RVt + (16 * ct + fr) * 72 + 32 * k + 8 * g); ak[k] = *(const LAS bf16x8*)(RKt + (16 * ct + fr) * 72 + 32 * k + 8 * g); }
#pragma unroll
            for (int mt = 0; mt < 4; ++mt) {
                f32x4 c = (f32x4){0.f, 0.f, 0.f, 0.f}, c2 = (f32x4){0.f, 0.f, 0.f, 0.f};
#pragma unroll
                for (int k = 0; k < 2; ++k) { const bf16x8 tt = *(const LAS bf16x8*)(Tb + (16 * mt + fr) * 72 + 32 * k + 8 * g); c = mfma32(tt, bv[k], c); c2 = mfma32(ak[k], tt, c2); }
                U0f[(ct * 4 + mt) * 64 + lane] = c;
                u32x2 w; w.x = pk2(-c2[0], -c2[1]); w.y = pk2(-c2[2], -c2[3]);
                *(u32x2*)(Wm + (16 * mt + fr) * 128 + 16 * ct + 4 * g) = w;
            }
        }
        if (t8 == 0) ((float*)(scr + G_CD))[unit] = expf(sc_g[63]);
    }
    __syncthreads();
}

__device__ __forceinline__ void hgrn_pre_unit(const Params& p, const Frame& F, int tc) {
    const int col = 2 * F.tid, h = col >> 7, f = col & 127;
    const float* lbl = p.in[I_LBLOG];
    float lb[2];
#pragma unroll
    for (int k = 0; k < 2; ++k) { const float l0 = lbl[col + k], l1 = lbl[1024 + col + k], l2 = lbl[2048 + col + k]; const float m = fmaxf(l0, fmaxf(l1, l2));
        const float e0 = expf(l0 - m), e1 = expf(l1 - m), e2 = expf(l2 - m); lb[k] = e0 / (e0 + e1 + e2); }
    const int t0 = tc * 16, b = t0 / SEQ, chunk = (t0 % SEQ) >> 4, bh = b * 8 + h;
    const bf16_t* H1 = (const bf16_t*)(opq(p.ws) + WS_H1);
    unsigned char* scr = opq(p.ws) + WS_SCR;
    float bc0[16], bc1[16], kk0[16], kk1[16]; unsigned iv[16];
    float cum0 = 0.f, cum1 = 0.f;
#pragma unroll
    for (int c = 0; c < 16; ++c) {
        const size_t row = (size_t)(t0 + c);
        const unsigned qv = *(const unsigned*)(H1 + row * H1LD + C_QB + col), fv = *(const unsigned*)(H1 + row * H1LD + C_FB + col);
        iv[c] = *(const unsigned*)(H1 + row * H1LD + C_IB + col);
        const float f0 = lb[0] + (1.f - lb[0]) * sigmoidf_(bflo(fv)), f1 = lb[1] + (1.f - lb[1]) * sigmoidf_(bfhi(fv));
        cum0 += logf(f0); cum1 += logf(f1);
        bc0[c] = cum0; bc1[c] = cum1; kk0[c] = 1.f - f0; kk1[c] = 1.f - f1;
        *(unsigned*)((bf16_t*)(scr + H_QD) + row * 1024 + col) = pk2(bflo(qv) * expf(cum0), bfhi(qv) * expf(cum1));
        *(unsigned*)((bf16_t*)(scr + H_KI) + row * 1024 + col) = pk2(kk0[c] * expf(-cum0), kk1[c] * expf(-cum1));
    }
    unsigned kd0[8], kd1[8], i0[8], i1[8];
#pragma unroll
    for (int c = 0; c < 16; c += 2) {
        kd0[c >> 1] = pk2(kk0[c] * expf(cum0 - bc0[c]), kk0[c + 1] * expf(cum0 - bc0[c + 1]));
        kd1[c >> 1] = pk2(kk1[c] * expf(cum1 - bc1[c]), kk1[c + 1] * expf(cum1 - bc1[c + 1]));
        i0[c >> 1] = (iv[c] & 0xffffu) | (iv[c + 1] << 16);
        i1[c >> 1] = (iv[c] >> 16) | (iv[c + 1] & 0xffff0000u);
    }
    const size_t base = ((size_t)(bh * 128 + chunk) * 128 + f) * 16;
    u32x4* kd = (u32x4*)((bf16_t*)(scr + H_KDT) + base); u32x4* it = (u32x4*)((bf16_t*)(scr + H_IT) + base);
    kd[0] = (u32x4){kd0[0], kd0[1], kd0[2], kd0[3]}; kd[1] = (u32x4){kd0[4], kd0[5], kd0[6], kd0[7]};
    kd[2] = (u32x4){kd1[0], kd1[1], kd1[2], kd1[3]}; kd[3] = (u32x4){kd1[4], kd1[5], kd1[6], kd1[7]};
    it[0] = (u32x4){i0[0], i0[1], i0[2], i0[3]}; it[1] = (u32x4){i0[4], i0[5], i0[6], i0[7]};
    it[2] = (u32x4){i1[0], i1[1], i1[2], i1[3]}; it[3] = (u32x4){i1[4], i1[5], i1[6], i1[7]};
    *(f32x2*)((float*)(scr + H_CD) + (size_t)(bh * 128 + chunk) * 128 + f) = (f32x2){expf(cum0), expf(cum1)};
}

__device__ __forceinline__ void p2_pre(const Params& p, const Frame& F0) {
    const Frame F = refresh(F0);
    for (int u = F.bid; u < 1024; u += 2 * F.G) gdn_pre_pair(p, F, u, u + F.G);
    for (int u = F.bid; u < 512; u += F.G) hgrn_pre_unit(p, F, u);
}

__device__ __forceinline__ void gdn_scan(const Params& p, const Frame& F0, int bh) {
    const Frame F = refresh(F0);
    const int lane = F.lane, fr = lane & 15, g = lane >> 4, wave = F.wave, b = bh >> 3, h = bh & 7;
    unsigned char* scr = opqg(p.ws) + WS_SCR;
    constexpr int BUFB = 62464, OFF_QD = 17408, OFF_KDT = 34816, OFF_QK = 53248;
    const bf16_t* gWM = (const bf16_t*)(scr + G_WM); const bf16_t* gQD = (const bf16_t*)(scr + G_QD);
    const bf16_t* gKDT = (const bf16_t*)(scr + G_KDT); const bf16_t* gQK = (const bf16_t*)(scr + G_QK);
    const f32x4* gU0 = (const f32x4*)(scr + G_U0); const float* gCD = (const float*)(scr + G_CD);
    bf16_t* OA = (bf16_t*)(scr + O_A);
    u32x4 rw[2], rq[2], rk[2], rqk; f32x4 u0c[4], u0n[4];
#define GS_ISSUE(u) do { _Pragma("unroll") for (int i = 0; i < 2; ++i) { const int idx = F.tid + 512 * i; \
        rw[i] = *(const u32x4*)(gWM + (size_t)(u) * 8192 + idx * 8); rq[i] = *(const u32x4*)(gQD + (size_t)(u) * 8192 + idx * 8); rk[i] = *(const u32x4*)(gKDT + (size_t)(u) * 8192 + idx * 8); } \
        rqk = *(const u32x4*)(gQK + (size_t)(u) * 4096 + F.tid * 8); \
        _Pragma("unroll") for (int mt = 0; mt < 4; ++mt) u0n[mt] = gU0[(((size_t)(u) * 8 + wave) * 4 + mt) * 64 + lane]; } while (0)
#define GS_WRITE(bufp) do { _Pragma("unroll") for (int i = 0; i < 2; ++i) { const int idx = F.tid + 512 * i; \
        *(LAS u32x4*)((bufp) + ((idx >> 4) * 136 + (idx & 15) * 8) * 2) = rw[i]; *(LAS u32x4*)((bufp) + OFF_QD + ((idx >> 4) * 136 + (idx & 15) * 8) * 2) = rq[i]; \
        *(LAS u32x4*)((bufp) + OFF_KDT + ((idx >> 3) * 72 + (idx & 7) * 8) * 2) = rk[i]; } \
        *(LAS u32x4*)((bufp) + OFF_QK + ((F.tid >> 3) * 72 + (F.tid & 7) * 8) * 2) = rqk; } while (0)
    f32x4 Sacc[8];
#pragma unroll
    for (int ft = 0; ft < 8; ++ft) Sacc[ft] = (f32x4){0.f, 0.f, 0.f, 0.f};
    GS_ISSUE(bh * 32);
    GS_WRITE(F.lds);
#pragma unroll
    for (int mt = 0; mt < 4; ++mt) u0c[mt] = u0n[mt];
    __syncthreads();
    float dec = ld_agent(gCD + bh * 32);
    for (int ci = 0; ci < 32; ++ci) {
        const int u = bh * 32 + ci;
        LAS unsigned char* buf = F.lds + (ci & 1) * BUFB;
        float decn = dec; if (ci + 1 < 32) decn = ld_agent(gCD + u + 1);
        if (ci + 1 < 32) GS_ISSUE(u + 1);
        const LAS bf16_t* WM = (const LAS bf16_t*)buf; const LAS bf16_t* QD = (const LAS bf16_t*)(buf + OFF_QD);
        const LAS bf16_t* KDT = (const LAS bf16_t*)(buf + OFF_KDT); const LAS bf16_t* QK = (const LAS bf16_t*)(buf + OFF_QK);
        bf16x8 Sbf[4];
#pragma unroll
        for (int kb = 0; kb < 4; ++kb) Sbf[kb] = pack8(Sacc[2 * kb], Sacc[2 * kb + 1]);
        f32x4 uacc[4], oacc[4];
#pragma unroll
        for (int mt = 0; mt < 4; ++mt) { uacc[mt] = u0c[mt]; oacc[mt] = (f32x4){0.f, 0.f, 0.f, 0.f}; }
        bf16x8 fa[8], fb[8];
#define GS_LD_UQ(dst, mt) do { _Pragma("unroll") for (int kb = 0; kb < 4; ++kb) { dst[kb] = frag_perm(WM + (16 * (mt) + fr) * 136, 32 * kb + 4 * g); dst[4 + kb] = frag_perm(QD + (16 * (mt) + fr) * 136, 32 * kb + 4 * g); } } while (0)
#define GS_MM_UQ(src, mt) do { _Pragma("unroll") for (int kb = 0; kb < 4; ++kb) { uacc[mt] = mfma32(src[kb], Sbf[kb], uacc[mt]); oacc[mt] = mfma32(src[4 + kb], Sbf[kb], oacc[mt]); } } while (0)
        GS_LD_UQ(fa, 0);
        GS_LD_UQ(fb, 1); __builtin_amdgcn_sched_barrier(0); GS_MM_UQ(fa, 0); __builtin_amdgcn_sched_barrier(0);
        GS_LD_UQ(fa, 2); __builtin_amdgcn_sched_barrier(0); GS_MM_UQ(fb, 1); __builtin_amdgcn_sched_barrier(0);
        GS_LD_UQ(fb, 3); __builtin_amdgcn_sched_barrier(0); GS_MM_UQ(fa, 2); __builtin_amdgcn_sched_barrier(0);
#pragma unroll
        for (int mt = 0; mt < 4; ++mt)
#pragma unroll
            for (int k = 0; k < 2; ++k) fa[2 * mt + k] = frag_perm(QK + (16 * mt + fr) * 72, 32 * k + 4 * g);
        __builtin_amdgcn_sched_barrier(0); GS_MM_UQ(fb, 3); __builtin_amdgcn_sched_barrier(0);
#undef GS_LD_UQ
#undef GS_MM_UQ
        bf16x8 ubf[2];
#pragma unroll
        for (int k = 0; k < 2; ++k) ubf[k] = pack8(uacc[2 * k], uacc[2 * k + 1]);
#pragma unroll
        for (int ft = 0; ft < 4; ++ft)
#pragma unroll
            for (int k = 0; k < 2; ++k) fb[2 * ft + k] = frag_perm(KDT + (16 * ft + fr) * 72, 32 * k + 4 * g);
        __builtin_amdgcn_sched_barrier(0);
#pragma unroll
        for (int mt = 0; mt < 4; ++mt)
#pragma unroll
            for (int k = 0; k < 2; ++k) oacc[mt] = mfma32(fa[2 * mt + k], ubf[k], oacc[mt]);
        __builtin_amdgcn_sched_barrier(0);
#pragma unroll
        for (int ft = 0; ft < 4; ++ft)
#pragma unroll
            for (int k = 0; k < 2; ++k) fa[2 * ft + k] = frag_perm(KDT + (16 * (4 + ft) + fr) * 72, 32 * k + 4 * g);
        __builtin_amdgcn_sched_barrier(0);
#pragma unroll
        for (int ft = 0; ft < 4; ++ft) {
            Sacc[ft] = Sacc[ft] * dec;
#pragma unroll
            for (int k = 0; k < 2; ++k) Sacc[ft] = mfma32(fb[2 * ft + k], ubf[k], Sacc[ft]);
        }
        __builtin_amdgcn_sched_barrier(0);
#pragma unroll
        for (int ft = 0; ft < 4; ++ft) {
            Sacc[4 + ft] = Sacc[4 + ft] * dec;
#pragma unroll
            for (int k = 0; k < 2; ++k) Sacc[4 + ft] = mfma32(fa[2 * ft + k], ubf[k], Sacc[4 + ft]);
        }
        dec = decn;
        {
            bf16_t* orow = OA + (size_t)(b * SEQ + ci * 64) * 1024 + h * 128 + 16 * wave + fr;
#pragma unroll
            for (int mt = 0; mt < 4; ++mt)
#pragma unroll
                for (int r = 0; r < 4; ++r) orow[(size_t)(16 * mt + 4 * g + r) * 1024] = (bf16_t)f2bf(oacc[mt][r]);
        }
        if (ci + 1 < 32) { GS_WRITE(F.lds + ((ci + 1) & 1) * BUFB);
#pragma unroll
            for (int mt = 0; mt < 4; ++mt) u0c[mt] = u0n[mt]; }
        asm volatile("s_waitcnt lgkmcnt(0)" ::: "memory"); __builtin_amdgcn_s_barrier();
    }
#undef GS_ISSUE
#undef GS_WRITE
}

__device__ __forceinline__ void hgrn_scan(const Params& p, const Frame& F0, int bh) {
    const Frame F = refresh(F0);
    const int lane = F.lane, fr = lane & 15, g = lane >> 4, wave = F.wave, b = bh >> 3, h = bh & 7;
    unsigned char* scr = opqg(p.ws) + WS_SCR;
    constexpr int BUFB = 61440, OFF_KI = 17408, OFF_KDT = 34816, OFF_CD = 59392;
    const bf16_t* gQD = (const bf16_t*)(scr + H_QD); const bf16_t* gKI = (const bf16_t*)(scr + H_KI);
    const bf16_t* gKDT = (const bf16_t*)(scr + H_KDT) + (size_t)bh * 128 * 128 * 16; const bf16_t* gIT = (const bf16_t*)(scr + H_IT) + (size_t)bh * 128 * 128 * 16;
    const float* gCD = (const float*)(scr + H_CD) + (size_t)bh * 128 * 128;
    bf16_t* OB = (bf16_t*)(scr + O_B);
    u32x4 rq[2], rk[2], rd[2], rc; u32x2 itn[4], itc[4];
#define HS_ISSUE(grp) do { _Pragma("unroll") for (int i = 0; i < 2; ++i) { const int idx = F.tid + 512 * i; const size_t go = (size_t)(b * SEQ + (grp) * 64 + (idx >> 4)) * 1024 + h * 128 + (idx & 15) * 8; \
        rq[i] = *(const u32x4*)(gQD + go); rk[i] = *(const u32x4*)(gKI + go); rd[i] = *(const u32x4*)(gKDT + (size_t)(grp) * 8192 + idx * 8); } \
        if (F.tid < 128) rc = *(const u32x4*)(gCD + (size_t)(grp) * 512 + F.tid * 4); \
        _Pragma("unroll") for (int sc = 0; sc < 4; ++sc) itn[sc] = *(const u32x2*)(gIT + ((size_t)((grp) * 4 + sc) * 128 + 16 * wave + fr) * 16 + 4 * g); } while (0)
#define HS_WRITE(bufp) do { _Pragma("unroll") for (int i = 0; i < 2; ++i) { const int idx = F.tid + 512 * i; \
        *(LAS u32x4*)((bufp) + ((idx >> 4) * 136 + (idx & 15) * 8) * 2) = rq[i]; *(LAS u32x4*)((bufp) + OFF_KI + ((idx >> 4) * 136 + (idx & 15) * 8) * 2) = rk[i]; \
        *(LAS u32x4*)((bufp) + OFF_KDT + ((idx >> 1) * 24 + (idx & 1) * 8) * 2) = rd[i]; } \
        if (F.tid < 128) *(LAS u32x4*)((bufp) + OFF_CD + F.tid * 16) = rc; } while (0)
    f32x4 Sacc[8];
#pragma unroll
    for (int ft = 0; ft < 8; ++ft) Sacc[ft] = (f32x4){0.f, 0.f, 0.f, 0.f};
    HS_ISSUE(0);
    HS_WRITE(F.lds);
#pragma unroll
    for (int sc = 0; sc < 4; ++sc) itc[sc] = itn[sc];
    __syncthreads();
    for (int grp = 0; grp < 32; ++grp) {
        LAS unsigned char* buf = F.lds + (grp & 1) * BUFB;
        if (grp + 1 < 32) HS_ISSUE(grp + 1);
        const LAS bf16_t* QD = (const LAS bf16_t*)buf; const LAS bf16_t* KI = (const LAS bf16_t*)(buf + OFF_KI);
        const LAS bf16_t* KDT = (const LAS bf16_t*)(buf + OFF_KDT); const LAS float* CD = (const LAS float*)(buf + OFF_CD);
        bf16x8 qfA[4], kfA[4], qfB[4], kfB[4];
#define HS_LDS(sc, X) do { _Pragma("unroll") for (int kb = 0; kb < 4; ++kb) { qf##X[kb] = frag_perm(QD + (16 * (sc) + fr) * 136, 32 * kb + 4 * g); kf##X[kb] = frag_perm(KI + (16 * (sc) + fr) * 136, 32 * kb + 4 * g); } \
            } while (0)
#define HS_SUB(sc, X) do { \
            f32x4 dd[8]; bf16x4 kd[8];        \
            _Pragma("unroll") for (int ft = 0; ft < 8; ++ft) { dd[ft] = *(const LAS f32x4*)(CD + (sc) * 128 + 16 * ft + 4 * g); kd[ft] = *(const LAS bf16x4*)(KDT + (((sc) * 128) + 16 * ft + fr) * 24 + 4 * g); } \
            bf16x8 Sbf[4]; \
            _Pragma("unroll") for (int kb = 0; kb < 4; ++kb) Sbf[kb] = pack8(Sacc[2 * kb], Sacc[2 * kb + 1]); \
            f32x4 o = (f32x4){0.f, 0.f, 0.f, 0.f}, pT = (f32x4){0.f, 0.f, 0.f, 0.f}; \
            _Pragma("unroll") for (int kb = 0; kb < 4; ++kb) { o = mfma32(qf##X[kb], Sbf[kb], o); pT = mfma32(kf##X[kb], qf##X[kb], pT); } \
            _Pragma("unroll") for (int r = 0; r < 4; ++r) pT[r] = (fr >= 4 * g + r) ? pT[r] : 0.f; \
            const bf16x4 itf = __builtin_bit_cast(bf16x4, itc[sc]); \
            o = mfma16(pack4(pT), itf, o); \
            _Pragma("unroll") for (int ft = 0; ft < 8; ++ft) Sacc[ft] = mfma16(kd[ft], itf, Sacc[ft] * dd[ft]); \
            bf16_t* orow = OB + (size_t)(b * SEQ + grp * 64 + (sc) * 16) * 1024 + h * 128 + 16 * wave + fr; \
            _Pragma("unroll") for (int r = 0; r < 4; ++r) orow[(size_t)(4 * g + r) * 1024] = (bf16_t)f2bf(o[r]); \
        } while (0)
        HS_LDS(0, A); __builtin_amdgcn_sched_barrier(0);
        HS_LDS(1, B); __builtin_amdgcn_sched_barrier(0); HS_SUB(0, A); __builtin_amdgcn_sched_barrier(0);
        HS_LDS(2, A); __builtin_amdgcn_sched_barrier(0); HS_SUB(1, B); __builtin_amdgcn_sched_barrier(0);
        HS_LDS(3, B); __builtin_amdgcn_sched_barrier(0); HS_SUB(2, A); __builtin_amdgcn_sched_barrier(0);
        HS_SUB(3, B);
#undef HS_LDS
#undef HS_SUB
        if (grp + 1 < 32) { HS_WRITE(F.lds + ((grp + 1) & 1) * BUFB);
#pragma unroll
            for (int sc = 0; sc < 4; ++sc) itc[sc] = itn[sc]; }
        asm volatile("s_waitcnt lgkmcnt(0)" ::: "memory"); __builtin_amdgcn_s_barrier();
    }
#undef HS_ISSUE
#undef HS_WRITE
}

__device__ __forceinline__ void p4_gate(const Params& p, const Frame& F0) {
    const Frame F = refresh(F0);
    const int gw = F.bid * NWAVES + F.wave, NGW = F.G * NWAVES, hs = F.lane >> 4, e0 = (F.lane & 15) * 8;
    unsigned char* scr = opq(p.ws) + WS_SCR;
    const bf16_t* H1 = (const bf16_t*)(opq(p.ws) + WS_H1); bf16_t* OC = (bf16_t*)(opq(p.ws) + WS_OC);
    for (int m = gw; m < T; m += NGW) {
#pragma unroll
        for (int rr = 0; rr < 4; ++rr) {
            const int hh = rr * 4 + hs;
            const bool isb = hh >= 8; const int hd = hh & 7;
            const bf16_t* osrc = (const bf16_t*)(scr + (isb ? O_B : O_A)) + (size_t)m * 1024 + hd * 128 + e0;
            const bf16_t* zsrc = H1 + (size_t)m * H1LD + (isb ? C_GB : C_ZA) + hd * 128 + e0;
            const float* gsrc = (isb ? p.in[I_EV_HGRNN] : p.in[I_EV_GDNN]) + e0;
            const u32x4 ov = *(const u32x4*)osrc, zv = *(const u32x4*)zsrc;
            const f32x4 g0 = *(const f32x4*)gsrc, g1 = *(const f32x4*)(gsrc + 4);
            float x[8] = {bflo(ov.x), bfhi(ov.x), bflo(ov.y), bfhi(ov.y), bflo(ov.z), bfhi(ov.z), bflo(ov.w), bfhi(ov.w)};
            const float z[8] = {bflo(zv.x), bfhi(zv.x), bflo(zv.y), bfhi(zv.y), bflo(zv.z), bfhi(zv.z), bflo(zv.w), bfhi(zv.w)};
            const float gn[8] = {g0[0], g0[1], g0[2], g0[3], g1[0], g1[1], g1[2], g1[3]};
            float ss = 0.f;
#pragma unroll
            for (int i = 0; i < 8; ++i) ss += x[i] * x[i];
            ss = row16_sum(ss);
            const float rinv = rsqrtf(ss * (1.f / 128.f) + RMS_EPS);
#pragma unroll
            for (int i = 0; i < 8; ++i) x[i] = x[i] * rinv * gn[i] * siluf_(z[i]);
            u32x2 w; w.x = pk4_fp8(x[0] * A_PRE, x[1] * A_PRE, x[2] * A_PRE, x[3] * A_PRE); w.y = pk4_fp8(x[4] * A_PRE, x[5] * A_PRE, x[6] * A_PRE, x[7] * A_PRE);
            *(u32x2*)((unsigned char*)OC + (size_t)m * 2048 + hh * 128 + e0) = w;
        }
    }
}

constexpr int H3LD = 6144;
constexpr size_t A_QR = 0;
constexpr size_t A_KR = 32 * MiB;
constexpr size_t A_VT = 64 * MiB;
constexpr size_t A_OG = 96 * MiB;
constexpr size_t A_LSE = 120 * MiB;
constexpr size_t A_KPART = 121 * MiB;
constexpr float QSCALE = 0.08838834764831845f * 1.4426950408889634f;
__device__ __forceinline__ int head_dil_log2(int hd) { return hd < 4 ? 0 : hd < 8 ? 2 : hd < 12 ? 4 : 0; }
__device__ __forceinline__ int posp(int s, int dl) { return ((s & ((1 << dl) - 1)) << (11 - dl)) + (s >> dl); }

__device__ __forceinline__ void rope_unit(const Params& p, const Frame& F, int unit) {
    const int hh = unit & 1, st = (unit >> 1) & 31, b = unit >> 6, s0 = st * 64;
    const bf16_t* H3 = (const bf16_t*)(opq(p.ws) + WS_H1);
    unsigned char* scr = opq(p.ws) + WS_SCR;
    bf16_t* QR = (bf16_t*)(scr + A_QR); bf16_t* KR = (bf16_t*)(scr + A_KR); bf16_t* VT = (bf16_t*)(scr + A_VT); float* KPART = (float*)(scr + A_KPART);
    LAS float* KS = (LAS float*)F.lds;
    LAS bf16_t* VL = (LAS bf16_t*)(F.lds + 33280);
    const int tok2 = F.tid >> 4, pj = (F.tid & 15) * 4;
    float cs[2][4], sn[2][4];
#pragma unroll
    for (int tt = 0; tt < 2; ++tt)
#pragma unroll
        for (int i = 0; i < 4; ++i) { const float inv = powf(10000.0f, -(float)(pj + i) * (1.0f / 64.0f)); const float ang = (float)(s0 + tok2 + 32 * tt) * inv; sincosf(ang, &sn[tt][i], &cs[tt][i]); }
    u32x2 na[2][2], nc[2][2]; u32x4 nv[2];
#define RP_LOAD(hi_) do { const int hd_ = hh * 8 + (hi_); \
        const int qcol_ = hd_ < 12 ? hd_ * 128 : 4608 + (hd_ - 12) * 128, kcol_ = hd_ < 12 ? 1536 + hd_ * 128 : 5120 + (hd_ - 12) * 128, vcol_ = hd_ < 12 ? 3072 + hd_ * 128 : 5632 + (hd_ - 12) * 128; \
        _Pragma("unroll") for (int tt = 0; tt < 2; ++tt) { const size_t row_ = (size_t)(b * SEQ + s0 + tok2 + 32 * tt) * H3LD; \
            _Pragma("unroll") for (int qk = 0; qk < 2; ++qk) { const bf16_t* src_ = H3 + row_ + (qk ? kcol_ : qcol_) + pj; na[tt][qk] = *(const u32x2*)src_; nc[tt][qk] = *(const u32x2*)(src_ + 64); } } \
        _Pragma("unroll") for (int i = 0; i < 2; ++i) { const int idx = F.tid + 512 * i; nv[i] = *(const u32x4*)(H3 + (size_t)(b * SEQ + s0 + (idx >> 4)) * H3LD + vcol_ + (idx & 15) * 8); } } while (0)
    RP_LOAD(0);
    for (int hi = 0; hi < 8; ++hi) {
        const int hd = hh * 8 + hi, dl = head_dil_log2(hd);
        const size_t hb = (size_t)(b * 16 + hd) * 2048;
        u32x2 ca[2][2], cc[2][2]; u32x4 cv[2];
#pragma unroll
        for (int tt = 0; tt < 2; ++tt)
#pragma unroll
            for (int qk = 0; qk < 2; ++qk) { ca[tt][qk] = na[tt][qk]; cc[tt][qk] = nc[tt][qk]; }
        cv[0] = nv[0]; cv[1] = nv[1];
        if (hi + 1 < 8) RP_LOAD(hi + 1);
#pragma unroll
        for (int tt = 0; tt < 2; ++tt) {
            const int tl = tok2 + 32 * tt, s = s0 + tl; const size_t orow = (hb + posp(s, dl)) * 128;
#pragma unroll
            for (int qk = 0; qk < 2; ++qk) {
                const u32x2 a = ca[tt][qk], c = cc[tt][qk];
                const float x1[4] = {bflo(a.x), bfhi(a.x), bflo(a.y), bfhi(a.y)}, x2[4] = {bflo(c.x), bfhi(c.x), bflo(c.y), bfhi(c.y)};
                float y1[4], y2[4]; const float sc = qk ? 1.0f : QSCALE;
#pragma unroll
                for (int i = 0; i < 4; ++i) { y1[i] = (x1[i] * cs[tt][i] - x2[i] * sn[tt][i]) * sc; y2[i] = (x2[i] * cs[tt][i] + x1[i] * sn[tt][i]) * sc; }
                bf16_t* dst = (qk ? KR : QR) + orow + pj;
                u32x2 w1, w2; w1.x = pk2(y1[0], y1[1]); w1.y = pk2(y1[2], y1[3]); w2.x = pk2(y2[0], y2[1]); w2.y = pk2(y2[2], y2[3]);
                *(u32x2*)dst = w1; *(u32x2*)(dst + 64) = w2;
                if (qk && hd >= 12) {
#pragma unroll
                    for (int i = 0; i < 4; ++i) { KS[tl * 129 + pj + i] = y1[i]; KS[tl * 129 + 64 + pj + i] = y2[i]; }
                }
            }
        }
#pragma unroll
        for (int i = 0; i < 2; ++i) { const int idx = F.tid + 512 * i, tl = idx >> 4, pc = idx & 15;
            *(LAS u32x4*)(VL + tl * 136 + pc * 8) = cv[i]; }
        asm volatile("s_waitcnt lgkmcnt(0)" ::: "memory"); __builtin_amdgcn_s_barrier();
        if (hd >= 12 && F.tid < 128) { float sum = 0.f;
#pragma unroll 8
            for (int tl = 0; tl < 64; ++tl) sum += KS[tl * 129 + F.tid];
            KPART[((size_t)(b * 4 + hd - 12) * 32 + st) * 128 + F.tid] = sum; }
        {
            const int pp = posp(s0 + F.lane, dl);
#pragma unroll 4
            for (int i = 0; i < 16; ++i) { const int d = F.wave * 16 + i; VT[((size_t)(b * 16 + hd) * 128 + d) * 2048 + pp] = VL[F.lane * 136 + d]; }
        }
        asm volatile("s_waitcnt lgkmcnt(0)" ::: "memory"); __builtin_amdgcn_s_barrier();
    }
#undef RP_LOAD
}

template <int MODE>
__device__ __forceinline__ void attn_item(const Params& p, const Frame& F0, int b, int hd, int q0, int ktile_lo, int ktile_hi) {
    const Frame F = refresh(F0);
    const int lane = F.lane, fr = lane & 15, g = lane >> 4, wave = F.wave;
    unsigned char* scr = opq(p.ws) + WS_SCR;
    const size_t hb = (size_t)(b * 16 + hd);
    const bf16_t* Qg = (const bf16_t*)(scr + A_QR) + hb * 2048 * 128; const bf16_t* Kg = (const bf16_t*)(scr + A_KR) + hb * 2048 * 128; const bf16_t* Vg = (const bf16_t*)(scr + A_VT) + hb * 128 * 2048;
    constexpr int BUFB = 35840, OFF_V = 17408, OFF_KM = 71680;
    const int nq = q0 + 16 * wave + fr;
    bf16x8 qf[4];
#pragma unroll
    for (int kb = 0; kb < 4; ++kb) qf[kb] = *(const bf16x8*)(Qg + (size_t)nq * 128 + 32 * kb + 8 * g);
    unsigned selmask = 0u;
    if (MODE == 1) {
        const int qb = q0 >> 8, h = hd - 12;
        LAS float* KM = (LAS float*)(F.lds + OFF_KM);
        const float* KPART = (const float*)(scr + A_KPART) + (size_t)(b * 4 + h) * 32 * 128;
#pragma unroll
        for (int i = 0; i < 2; ++i) { const int idx = F.tid + 512 * i, jb = idx >> 7, d = idx & 127;
            KM[idx] = (KPART[(4 * jb + 0) * 128 + d] + KPART[(4 * jb + 1) * 128 + d]) + (KPART[(4 * jb + 2) * 128 + d] + KPART[(4 * jb + 3) * 128 + d]); }
        __syncthreads();
        float gate[8];
#pragma unroll
        for (int jb = 0; jb < 8; ++jb) { float s = 0.f;
#pragma unroll
            for (int kb = 0; kb < 4; ++kb) { const u32x4 qq = __builtin_bit_cast(u32x4, qf[kb]); const LAS float* km = KM + jb * 128 + 32 * kb + 8 * g;
                const f32x4 k0 = *(const LAS f32x4*)km, k1 = *(const LAS f32x4*)(km + 4);
                s += (bflo(qq.x) * k0[0] + bfhi(qq.x) * k0[1]) + (bflo(qq.y) * k0[2] + bfhi(qq.y) * k0[3]) + (bflo(qq.z) * k1[0] + bfhi(qq.z) * k1[1]) + (bflo(qq.w) * k1[2] + bfhi(qq.w) * k1[3]); }
            s += xor16_f(s); s = xor32_sum(s); gate[jb] = s; }
#pragma unroll
        for (int jb = 0; jb < 8; ++jb) { int rank = 0;
#pragma unroll
            for (int j2 = 0; j2 < 8; ++j2) if (j2 != jb && j2 < qb) rank += (gate[j2] > gate[jb] || (gate[j2] == gate[jb] && j2 < jb)) ? 1 : 0;
            if (jb < qb && rank < 3) selmask |= 1u << jb; }
        __syncthreads();
    }
    u32x4 rk[2], rv[2];
#define AT_ISSUE(kt) do { _Pragma("unroll") for (int i = 0; i < 2; ++i) { const int idx = F.tid + 512 * i; \
        rk[i] = *(const u32x4*)(Kg + (size_t)((kt) * 64 + (idx >> 4)) * 128 + (idx & 15) * 8); rv[i] = *(const u32x4*)(Vg + (size_t)(idx >> 3) * 2048 + (kt) * 64 + (idx & 7) * 8); } } while (0)
#define AT_WRITE(bufp) do { _Pragma("unroll") for (int i = 0; i < 2; ++i) { const int idx = F.tid + 512 * i; \
        *(LAS u32x4*)((bufp) + ((idx >> 4) * 136 + (idx & 15) * 8) * 2) = rk[i]; *(LAS u32x4*)((bufp) + OFF_V + ((idx >> 3) * 72 + (idx & 7) * 8) * 2) = rv[i]; } } while (0)
    f32x4 oacc[8];
#pragma unroll
    for (int dt = 0; dt < 8; ++dt) oacc[dt] = (f32x4){0.f, 0.f, 0.f, 0.f};
    float mrun = -1e30f, lrun = 0.f;
    AT_ISSUE(ktile_lo);
    AT_WRITE(F.lds);
    __syncthreads();
    for (int kt = ktile_lo; kt < ktile_hi; ++kt) {
        LAS unsigned char* buf = F.lds + ((kt - ktile_lo) & 1) * BUFB;
        if (kt + 1 < ktile_hi) AT_ISSUE(kt + 1);
        const LAS bf16_t* KL = (const LAS bf16_t*)buf; const LAS bf16_t* VL = (const LAS bf16_t*)(buf + OFF_V);
        f32x4 sT[4];
        {
            bf16x8 kf[16];
#pragma unroll
            for (int t4 = 0; t4 < 4; ++t4)
#pragma unroll
                for (int kb = 0; kb < 4; ++kb) kf[4 * t4 + kb] = *(const LAS bf16x8*)(KL + (16 * t4 + fr) * 136 + 32 * kb + 8 * g);
            __builtin_amdgcn_sched_barrier(0);
#pragma unroll
            for (int t4 = 0; t4 < 4; ++t4) { sT[t4] = (f32x4){0.f, 0.f, 0.f, 0.f};
#pragma unroll
                for (int kb = 0; kb < 4; ++kb) sT[t4] = mfma32(kf[4 * t4 + kb], qf[kb], sT[t4]); }
        }
        __builtin_amdgcn_sched_barrier(0);
        bf16x8 vf[16];
#pragma unroll
        for (int dt = 0; dt < 8; ++dt) { vf[2 * dt] = frag_perm(VL + (16 * dt + fr) * 72, 4 * g); vf[2 * dt + 1] = frag_perm(VL + (16 * dt + fr) * 72, 32 + 4 * g); }
        __builtin_amdgcn_sched_barrier(0);
        const int k0 = kt * 64; float mx = -1e30f;
        const float NEG = -__builtin_huge_valf();
#pragma unroll
        for (int t4 = 0; t4 < 4; ++t4)
#pragma unroll
            for (int r = 0; r < 4; ++r) { const int nk = k0 + 16 * t4 + 4 * g + r; bool v;
                if (MODE == 0) v = (nk <= nq) && (nq - nk <= 128);
                else v = ((k0 >> 8) == (q0 >> 8)) ? (nk <= nq) : (((selmask >> (k0 >> 8)) & 1u) != 0u);
                sT[t4][r] = v ? sT[t4][r] : NEG; mx = fmaxf(mx, sT[t4][r]); }
        mx = fmaxf(mx, xor16_f(mx)); mx = xor32_max(mx);
        const float mnew = fmaxf(mrun, mx), alpha = exp2f(mrun - mnew); mrun = mnew;
        float ps = 0.f;
#pragma unroll
        for (int t4 = 0; t4 < 4; ++t4)
#pragma unroll
            for (int r = 0; r < 4; ++r) { const float pv = exp2f(sT[t4][r] - mnew); sT[t4][r] = pv; ps += pv; }
        lrun = lrun * alpha + ps;
        const bf16x8 pb0 = pack8(sT[0], sT[1]), pb1 = pack8(sT[2], sT[3]);
#pragma unroll
        for (int dt = 0; dt < 8; ++dt) {
            oacc[dt] = oacc[dt] * alpha;
            oacc[dt] = mfma32(vf[2 * dt], pb0, oacc[dt]);
            oacc[dt] = mfma32(vf[2 * dt + 1], pb1, oacc[dt]);
        }
        if (kt + 1 < ktile_hi) AT_WRITE(F.lds + ((kt + 1 - ktile_lo) & 1) * BUFB);
        __syncthreads();
    }
#undef AT_ISSUE
#undef AT_WRITE
    lrun += xor16_f(lrun); lrun = xor32_sum(lrun);
    const float inv = 1.0f / lrun;
    if (MODE == 0) {
        bf16_t* og = (bf16_t*)(scr + A_OG) + ((size_t)(b * 12 + hd) * 2048 + nq) * 128;
#pragma unroll
        for (int dt = 0; dt < 8; ++dt) { u32x2 w; w.x = pk2(oacc[dt][0] * inv, oacc[dt][1] * inv); w.y = pk2(oacc[dt][2] * inv, oacc[dt][3] * inv); *(u32x2*)(og + 16 * dt + 4 * g) = w; }
        if (g == 0) ((float*)(scr + A_LSE))[(size_t)(b * 12 + hd) * 2048 + nq] = mrun + log2f(lrun);
    } else {
        unsigned char* oc = (opq(p.ws) + WS_OC) + (size_t)(b * SEQ + nq) * 1024 + 512 + (hd - 12) * 128;
        const float inv4 = inv * A_PRE;
#pragma unroll
        for (int dt = 0; dt < 8; ++dt) *(unsigned*)(oc + 16 * dt + 4 * g) = pk4_fp8(oacc[dt][0] * inv4, oacc[dt][1] * inv4, oacc[dt][2] * inv4, oacc[dt][3] * inv4);
    }
}

__device__ __forceinline__ void attn_phase(const Params& p, const Frame& F0) {
    const Frame F = refresh(F0);
    const int i = F.bid & 15, bhm = F.bid >> 4;
    const int nd = (i == 0) ? 7 : (i <= 2) ? 6 : (i <= 4) ? 5 : (i <= 6) ? 4 : (i <= 8) ? 3 : (i <= 10) ? 2 : (i == 11) ? 1 : 0;
    const int st = (i == 0) ? 0 : (i == 1) ? 7 : (i == 2) ? 13 : (i == 3) ? 19 : (i == 4) ? 24 : (i == 5) ? 29 : (i == 6) ? 33 : (i == 7) ? 37 : (i == 8) ? 40 : (i == 9) ? 43 : (i == 10) ? 45 : (i == 11) ? 47 : 48;
    const bool balanced = (F.G == 256);
    for (int k = 0;; ++k) {
        int it;
        if (balanced) { if (k > nd) break; it = (k == 0) ? (bhm * 16 + i) : (256 + bhm * 48 + st + k - 1); }
        else { it = F.bid + k * F.G; if (it >= 1024) break; }
        if (it < 256) { const int qt = it & 15; attn_item<1>(p, F, it >> 6, 12 + ((it >> 4) & 3), qt * 128, 0, 2 * (qt + 1)); }
        else { const int id = it - 256, qt = id & 15, hd = (id >> 4) % 12, b = (id >> 4) / 12, dl = head_dil_log2(hd); const int q0 = qt * 128, first = ((q0 & ((2048 >> dl) - 1)) == 0);
            attn_item<0>(p, F, b, hd, q0, first ? 2 * qt : 2 * qt - 2, 2 * qt + 2); }
    }
}

__device__ __forceinline__ void merge_pass(const Params& p, const Frame& F0) {
    const Frame F = refresh(F0);
    const int gw = F.bid * NWAVES + F.wave, NGW = F.G * NWAVES, hg = F.lane >> 4, d0 = (F.lane & 15) * 8;
    unsigned char* scr = opq(p.ws) + WS_SCR;
    const bf16_t* OG = (const bf16_t*)(scr + A_OG); const float* LSE = (const float*)(scr + A_LSE); bf16_t* OC = (bf16_t*)(opq(p.ws) + WS_OC);
    for (int m = gw; m < T; m += NGW) {
        const int b = m >> 11, s = m & 2047;
        float ls[3]; u32x4 ov[3];
#pragma unroll
        for (int gi = 0; gi < 3; ++gi) { const int hd = 4 * gi + hg; const size_t idx = (size_t)(b * 12 + hd) * 2048 + posp(s, 2 * gi); ls[gi] = LSE[idx]; ov[gi] = *(const u32x4*)(OG + idx * 128 + d0); }
        const float mx = fmaxf(ls[0], fmaxf(ls[1], ls[2]));
        float w[3]; float ws = 0.f;
#pragma unroll
        for (int gi = 0; gi < 3; ++gi) { w[gi] = exp2f(ls[gi] - mx); ws += w[gi]; }
        const float inv = 1.0f / ws;
        float o[8] = {0.f, 0.f, 0.f, 0.f, 0.f, 0.f, 0.f, 0.f};
#pragma unroll
        for (int gi = 0; gi < 3; ++gi) { const float wg = w[gi] * inv;
            o[0] += wg * bflo(ov[gi].x); o[1] += wg * bfhi(ov[gi].x); o[2] += wg * bflo(ov[gi].y); o[3] += wg * bfhi(ov[gi].y);
            o[4] += wg * bflo(ov[gi].z); o[5] += wg * bfhi(ov[gi].z); o[6] += wg * bflo(ov[gi].w); o[7] += wg * bfhi(ov[gi].w); }
        u32x2 wv; wv.x = pk4_fp8(o[0] * A_PRE, o[1] * A_PRE, o[2] * A_PRE, o[3] * A_PRE); wv.y = pk4_fp8(o[4] * A_PRE, o[5] * A_PRE, o[6] * A_PRE, o[7] * A_PRE);
        *(u32x2*)((unsigned char*)OC + (size_t)m * 1024 + hg * 128 + d0) = wv;
    }
}

#define GRID_SYNC() xcd_barrier((unsigned*)(opq(p.ws) + WS_CTL), (volatile LAS unsigned*)(F.lds + LDS_BYTES - 16), F.wave)
#ifndef REPMASK
#define REPMASK 0u
#endif
__device__ __forceinline__ int repn(int k) { int n = 1 + (int)(((REPMASK) >> k) & 1u); asm volatile("" : "+s"(n)); return n; }
#define RP(k) for (int _r = 0, _n = repn(k); _r < _n; ++_r)
__global__ void __launch_bounds__(NTHR, 2) mk_fwd(Params p) {
    extern __shared__ __attribute__((aligned(16))) unsigned char lds_raw[];
    Frame F; F.lds = (LAS unsigned char*)lds_raw; F.tid = 0; F.lane = 0; F.wave = __builtin_amdgcn_readfirstlane(threadIdx.x >> 6); F.G = gridDim.x; F.bid = blockIdx.x;
#define P_WS (opq(p.ws))
#define P_AB ((bf16_t*)(opq(p.ws) + WS_AB))
#define P_R (opq(p.out))
#define P_MIX ((bf16_t*)(opq(p.ws) + WS_MIX))
#define P_HID ((bf16_t*)(opq(p.ws) + WS_HID))
#define P_Y2 ((bf16_t*)(opq(p.ws) + WS_Y2))

    {
        if (threadIdx.x == 0) { volatile LAS unsigned* st = (volatile LAS unsigned*)(F.lds + LDS_BYTES - 16); st[0] = 0u; st[1] = 0u;
            (void)xb_add((unsigned*)(p.ws + WS_CTL) + XB_XCNT(xb_xcc_id()), 1u); }
        __syncthreads();
    }
    RP(0) { convert_set(p, F, 0, F.bid * NWAVES + F.wave, F.G * NWAVES); __syncthreads(); }
    RP(1) { load_w16_lds(F, p.in[I_EV_WIN], EVEN_IN, 4096); __syncthreads(); p0_xpass(p, F); __syncthreads(); }
    GRID_SYNC();

    RP(2) {
        pg8::StaticOrder S; S.init(T, 8192, F.G, F.bid);
        pg8::Gemm g{(const unsigned char*)(P_WS + WS_AB), (const unsigned char*)(P_WS + WS_WIN), 2048, (unsigned)(T * 2048), (unsigned)(8192 * 2048), SC_A16};
        pg8::EpiBf16 E{(bf16_t*)(P_WS + WS_H1), H1LD, (unsigned)(T * 8192 * 2)};
        pg8::gemm_phase(F.lds, F.wave, g, S, E);
    }
    GRID_SYNC();
    RP(3) { p2_pre(p, F); }
    GRID_SYNC();
    RP(4) { if (F.bid < 32) gdn_scan(p, F, F.bid); else if (F.bid < 64) hgrn_scan(p, F, F.bid - 32);
            else if (F.G > 64) convert_set(p, F, 1, (F.bid - 64) * NWAVES + F.wave, (F.G - 64) * NWAVES); }
    if (F.G <= 64) { convert_set(p, F, 1, F.bid * NWAVES + F.wave, F.G * NWAVES); }
    GRID_SYNC();
    RP(5) { p4_gate(p, F); }
    GRID_SYNC();
    RP(6) {
        pg8::StaticOrder S; S.init(T, 2048, F.G, F.bid);
        pg8::Gemm g{(const unsigned char*)(P_WS + WS_OC), (const unsigned char*)(P_WS + WS_WOUT), 2048, (unsigned)(T * 2048), (unsigned)(2048 * 2048), SC_A4};
        pg8::EpiBf16 E{P_MIX, 2048, (unsigned)(T * 2048 * 2)};
        pg8::gemm_phase(F.lds, F.wave, g, S, E);
    }
    GRID_SYNC();
#define MOE_BLOCK(layer, resid, mixp, outfinal, outb2) do { \
        for (int _r = 0, _n = ((layer) == 0 ? repn(7) : 1); _r < _n; ++_r) { load_w16_lds(F, p.in[I_RW], 16, 0); __syncthreads(); \
            ln_pass<true, false, (layer) != 0, true>(p, F, resid, mixp, D, nullptr, p.in[I_LNG] + (size_t)((layer) * 2 + 0) * D, p.in[I_LNB] + (size_t)((layer) * 2 + 0) * D, P_R, P_AB, layer); __syncthreads(); } \
        GRID_SYNC(); \
        const int* list = (const int*)(P_WS + WS_LIST) + (size_t)(layer) * NE * T; \
        const float* gatew = (const float*)(P_WS + WS_GATEW) + (size_t)(layer) * 2 * T; \
        RP(8) { moe_lists(p, F, layer); } \
        GRID_SYNC(); \
        { const Frame Fr = refresh(F); pg8::moe_build_table(F.lds, Fr.tid); } \
        unsigned* tcnt = (unsigned*)(P_WS + WS_CTL) + 3600 + 128 * (layer);        \
        { pg8::MoeOrder<4, false> S; S.init(F.lds, list, F.G, F.bid, 1024, tcnt); \
            pg8::Gemm g{(const unsigned char*)(P_WS + WS_ABS), (const unsigned char*)(P_WS + ((layer) ? WS_WGU1 : WS_WGU)), 2048, (unsigned)(20480 * 2048), (unsigned)(NE * 1024 * 2048), SC_A1}; \
            pg8::EpiGateUpB E{P_HID, list, gatew}; pg8::gemm_phase(F.lds, F.wave, g, S, E); } \
          \
        { pg8::MoeDownS S; S.init(F.lds, tcnt, 2048, F.G, F.bid); \
            pg8::Gemm16 g{P_HID, (const bf16_t*)(P_WS + WS_WD), 512, (unsigned)(20480 * 512 * 2), (unsigned)(NE * 2048 * 512 * 2)}; \
            pg8::EpiDown E{P_Y2, list}; pg8::gemm_phase16(F.lds, F.wave, g, S, E); } \
        GRID_SYNC(); \
        ln_pass<false, true, true, (layer) == 0>(p, F, P_R, P_Y2, D, P_Y2, p.in[I_LNG] + (size_t)((layer) * 2 + 1) * D, p.in[I_LNB] + (size_t)((layer) * 2 + 1) * D, outfinal, outb2, layer); \
    } while (0)
    MOE_BLOCK(0, p.in[I_X], P_MIX, P_R, (bf16_t*)(P_WS + WS_AB8));
    __syncthreads();
    RP(11) { convert_set(p, F, 2, F.bid * NWAVES + F.wave, F.G * NWAVES); __syncthreads(); }
    GRID_SYNC();
    RP(12) {
        pg8::StaticOrder S; S.init(T, 6144, F.G, F.bid);
        pg8::Gemm g{(const unsigned char*)(P_WS + WS_AB8), (const unsigned char*)(P_WS + WS_W3), 2048, (unsigned)(T * 2048), (unsigned)(6144 * 2048), SC_A1};
        pg8::EpiBf16 E{(bf16_t*)(P_WS + WS_H1), H3LD, (unsigned)(T * 6144 * 2)};
        pg8::gemm_phase(F.lds, F.wave, g, S, E);
    }
    GRID_SYNC();
    RP(13) { const Frame Fr = refresh(F); for (int u = Fr.bid; u < 256; u += Fr.G) rope_unit(p, Fr, u); }
    GRID_SYNC();
    RP(14) { attn_phase(p, F); }
    GRID_SYNC();
    RP(15) { merge_pass(p, F); }
    GRID_SYNC();
    RP(16) {
        pg8::StaticOrder S; S.init(T, 2048, F.G, F.bid);
        pg8::Gemm g{(const unsigned char*)(P_WS + WS_OC), (const unsigned char*)(P_WS + WS_WOUT1), 1024, (unsigned)(T * 1024), (unsigned)(2048 * 1024), SC_A4};
        pg8::EpiBf16 E{P_MIX, 2048, (unsigned)(T * 2048 * 2)};
        pg8::gemm_phase(F.lds, F.wave, g, S, E);
    }
    GRID_SYNC();
    MOE_BLOCK(1, P_R, P_MIX, p.out, (bf16_t*)nullptr);
#undef MOE_BLOCK
#undef P_WS
#undef P_AB
#undef P_R
#undef P_MIX
#undef P_HID
#undef P_Y2
}

extern "C" void kernel_launch(void* const* d_in, const int* in_sizes, int n_in, void* d_out, int out_size,
                              void* d_ws, size_t ws_size, hipStream_t stream) {
    static int grid_blocks = 0;
    if (!grid_blocks) {
        int dev = 0, cus = 0, per_cu = 0;
        (void)hipGetDevice(&dev);
        (void)hipDeviceGetAttribute(&cus, hipDeviceAttributeMultiprocessorCount, dev);
        (void)hipFuncSetAttribute((const void*)mk_fwd, hipFuncAttributeMaxDynamicSharedMemorySize, LDS_BYTES);
        (void)hipOccupancyMaxActiveBlocksPerMultiprocessor(&per_cu, (const void*)mk_fwd, NTHR, LDS_BYTES);
        if (per_cu < 1) fprintf(stderr, "kernel_launch: occupancy query says %d blocks per CU\n", per_cu);
        grid_blocks = cus;
        if (ws_size < WS_END) { fprintf(stderr, "kernel_launch: workspace too small: %zu < %zu\n", ws_size, (size_t)WS_END); grid_blocks = -1; }
        if (n_in != 18) { fprintf(stderr, "kernel_launch: expected 18 inputs, got %d\n", n_in); grid_blocks = -1; }
    }
    if (grid_blocks < 0) return;
    Params p{};
    for (int i = 0; i < 18; ++i) p.in[i] = (const float*)d_in[i];
    p.out = (float*)d_out; p.ws = (unsigned char*)d_ws;
    (void)hipMemsetAsync(d_ws, 0, 16384, stream);
    void* args[] = {&p};
    hipError_t e = hipLaunchCooperativeKernel((void*)mk_fwd, dim3(grid_blocks), dim3(NTHR), args, LDS_BYTES, stream);
    if (e != hipSuccess) fprintf(stderr, "cooperative launch failed: %s (grid %d)\n", hipGetErrorString(e), grid_blocks);
}
```

```cpp
#include <hip/hip_runtime.h>
#include <cstdio>
#include <cstdint>

#define GAS __attribute__((address_space(1)))
#define LAS __attribute__((address_space(3)))
typedef unsigned short bf16_t;
typedef short bf16x8 __attribute__((ext_vector_type(8)));
typedef short bf16x4 __attribute__((ext_vector_type(4)));
typedef float f32x4 __attribute__((ext_vector_type(4)));
typedef float f32x2 __attribute__((ext_vector_type(2)));
typedef unsigned u32x4 __attribute__((ext_vector_type(4)));
typedef unsigned u32x2 __attribute__((ext_vector_type(2)));

constexpr int NB = 4, SEQ = 2048, T = NB * SEQ, D = 2048;
constexpr int EVEN_IN = 8208, ODD_IN = 6144;
constexpr int NE = 16, DEXP = 512;
constexpr float ALPHA = 1.4142135623730951f;
constexpr float LN_EPS = 1e-5f, RMS_EPS = 1e-6f;
constexpr int NWAVES = 8, NTHR = 512;
constexpr int LDS_BYTES = 147456;

constexpr size_t MiB = 1u << 20;
constexpr size_t WS_CTL = 0;
constexpr size_t WS_LIST = 1 * MiB;
constexpr size_t WS_GATEW = 2 * MiB;
constexpr size_t WS_BA = 2 * MiB + 512 * 1024;
constexpr size_t WS_ROPE = 3 * MiB;
constexpr size_t WS_KMEAN = 4 * MiB;
constexpr size_t WS_WREG = 8 * MiB;
constexpr size_t WS_WIN = WS_WREG;
constexpr size_t WS_AB8 = WS_WREG + 16 * MiB;
constexpr size_t WS_WOUT = WS_WREG + 32 * MiB;
constexpr size_t WS_WGU = WS_WREG + 40 * MiB;
constexpr size_t WS_WD = WS_WREG + 104 * MiB;
constexpr size_t WS_AB = WS_WREG + 136 * MiB;
constexpr size_t WS_H1 = WS_AB + 32 * MiB;
constexpr size_t WS_OC = WS_H1 + 128 * MiB;
constexpr size_t WS_MIX = WS_OC + 32 * MiB;
constexpr size_t WS_SCR = WS_MIX + 32 * MiB;
constexpr size_t WS_HID = WS_SCR;
constexpr size_t WS_Y2 = WS_SCR + 20 * MiB;
constexpr size_t WS_ABS = WS_SCR + 84 * MiB;
constexpr size_t WS_END = WS_SCR + 216 * MiB;
static_assert(WS_END == 584 * MiB, "workspace map");

typedef __bf16 bf16v2_t __attribute__((ext_vector_type(2)));
__device__ __forceinline__ unsigned pk2(float lo, float hi) { const f32x2 f = {lo, hi}; return __builtin_bit_cast(unsigned, __builtin_convertvector(f, bf16v2_t)); }
__device__ __forceinline__ unsigned f2bf(float f) { return pk2(f, 0.f) & 0xffffu; }
__device__ __forceinline__ unsigned pk4_fp8(float a, float b, float c, float d) {
    a = fminf(fmaxf(a, -448.f), 448.f); b = fminf(fmaxf(b, -448.f), 448.f); c = fminf(fmaxf(c, -448.f), 448.f); d = fminf(fmaxf(d, -448.f), 448.f);
    int w = 0; w = __builtin_amdgcn_cvt_pk_fp8_f32(a, b, w, false); w = __builtin_amdgcn_cvt_pk_fp8_f32(c, d, w, true); return (unsigned)w;
}
constexpr float W_PRE = 64.f;  constexpr int SC_W = 0x79797979;
constexpr float A_PRE = 4.f;   constexpr int SC_A4 = 0x7d7d7d7d;
constexpr int SC_A1 = 0x7f7f7f7f;
constexpr float X_PRE = 16.f;  constexpr int SC_A16 = 0x7b7b7b7b;
typedef int i32x8 __attribute__((ext_vector_type(8)));
__device__ __forceinline__ float bf2f(unsigned short b) { return __builtin_bit_cast(float, (unsigned)b << 16); }
__device__ __forceinline__ float bflo(unsigned w) { return __builtin_bit_cast(float, w << 16); }
__device__ __forceinline__ float bfhi(unsigned w) { return __builtin_bit_cast(float, w & 0xffff0000u); }
__device__ __forceinline__ unsigned cvt_pk_bf16(float lo, float hi) { return pk2(lo, hi); }
template <int CTRL> __device__ __forceinline__ float dpp_f(float x) { return __builtin_bit_cast(float, __builtin_amdgcn_update_dpp(0, __builtin_bit_cast(int, x), CTRL, 0xf, 0xf, true)); }
__device__ __forceinline__ float xor16_f(float x) { return __builtin_bit_cast(float, __builtin_amdgcn_ds_swizzle(__builtin_bit_cast(int, x), 0x401f)); }
__device__ __forceinline__ float row16_sum(float v) { v += dpp_f<0xB1>(v); v += dpp_f<0x4E>(v); v += dpp_f<0x141>(v); v += dpp_f<0x140>(v); return v; }
__device__ __forceinline__ float xor32_sum(float v) { const int i = __builtin_bit_cast(int, v); const auto r = __builtin_amdgcn_permlane32_swap(i, i, false, false);
    return __builtin_bit_cast(float, (int)r[0]) + __builtin_bit_cast(float, (int)r[1]); }
__device__ __forceinline__ float xor32_max(float v) { const int i = __builtin_bit_cast(int, v); const auto r = __builtin_amdgcn_permlane32_swap(i, i, false, false);
    return fmaxf(__builtin_bit_cast(float, (int)r[0]), __builtin_bit_cast(float, (int)r[1])); }
__device__ __forceinline__ float wave_sum(float v) { v = row16_sum(v); v += xor16_f(v); return xor32_sum(v); }
__device__ __forceinline__ float sigmoidf_(float x) { return 1.0f / (1.0f + __expf(-x)); }
__device__ __forceinline__ float siluf_(float x) { return x / (1.0f + __expf(-x)); }
#define LDS_WAIT() asm volatile("s_waitcnt lgkmcnt(0)" ::: "memory")
template <class Tp> __device__ __forceinline__ Tp* opq(Tp* x) { asm volatile("" : "+s"(x)); return x; }
template <class Tp> __device__ __forceinline__ Tp* opqg(Tp* x) { GAS Tp* g = (GAS Tp*)x; asm volatile("" : "+s"(g)); return (Tp*)g; }
__device__ __forceinline__ float ld_agent(const float* p) { return __hip_atomic_load(p, __ATOMIC_RELAXED, __HIP_MEMORY_SCOPE_AGENT); }

namespace pg8 {
constexpr int BM = 256, BK = 64, HALF = 128, HTB = HALF * BK * 2, STAGE_BYTES = 8 * HTB, NXCD = 8, WGM = 8;
__device__ __forceinline__ int lds_byte(int r, int c) { const int st = (r >> 4) * 2 + (c >> 5), rr = r & 15, cc = c & 31, ob = rr * 64 + cc * 2; return st * 1024 + (ob ^ (((ob >> 9) & 1) << 5)); }
__device__ __forceinline__ void stage_rc(int b, int& R, int& C) { const int st = b / 1024, sb = b % 1024, swz = sb ^ (((sb >> 9) & 1) << 5); R = (st >> 1) * 16 + swz / 64; C = (st & 1) * 32 + (swz % 64) / 2; }
__device__ __forceinline__ int perm32(int rho) { const int n = rho >> 4, i = rho & 15; return 8 * (i >> 2) + 4 * n + (i & 3); }

struct Unit { int pm, pn, e, cnt, arow0, brow0; };
struct Gemm { const unsigned char* A; const unsigned char* Bt; int K; unsigned abytes, bbytes; int sc_a; };

struct StaticOrder {
    static constexpr bool CONTIG = true;
    int nM, nN, nwg, G, c;
    __device__ void init(int M, int N, int G_, int c_) { nM = M / BM; nN = N / BM; nwg = nM * nN; G = G_; c = c_; }
    __device__ bool next(int i, Unit& u) const {
        const long L = (long)i * G + c; if (L >= nwg) return false;
        int wgid = (int)L; { const int q = nwg / NXCD, r = nwg % NXCD, xcd = wgid % NXCD, off = wgid / NXCD; wgid = (xcd < r ? xcd * (q + 1) : r * (q + 1) + (xcd - r) * q) + off; }
        const int nig = WGM * nN, gid = wgid / nig, fm = gid * WGM, gsz = (nM - fm) < WGM ? (nM - fm) : WGM;
        u.pm = fm + ((wgid % nig) % gsz); u.pn = (wgid % nig) / gsz; u.e = 0; u.cnt = 0; u.arow0 = u.pm * BM; u.brow0 = u.pn * BM; return true;
    }
    __device__ __forceinline__ unsigned arow(const Unit& u, int r) const { return (unsigned)(u.arow0 + r); }
    __device__ __forceinline__ void done(const Unit&, int) const {}
    struct State {};
    __device__ __forceinline__ bool first(State&, Unit& u, int) const { return next(0, u); }
    __device__ __forceinline__ void issue(State&, int, int) const {}
    __device__ __forceinline__ bool fin(State&, int i, Unit& u, int) const { return next(i, u); }
};

constexpr int MOE_TAB_OFF = 131072;
constexpr int MOE_HIST_OFF = 131072 + 3072;
__device__ __forceinline__ void moe_build_table(LAS unsigned char* lds, int tid) {
    LAS int* tab = (LAS int*)(lds + MOE_TAB_OFF);
    const LAS int* cnts = (const LAS int*)(lds + MOE_HIST_OFF) + 16;
    if (tid == 0) {
        int s = 0;
#pragma unroll 1
        for (int e = 0; e < NE; ++e) { const int c = cnts[e]; const int nt = (c + 255) >> 8;
#pragma unroll 1
            for (int k = 0; k < nt; ++k) { tab[4 + 4 * (s + k)] = e; tab[4 + 4 * (s + k) + 1] = k; tab[4 + 4 * (s + k) + 2] = c; }
            s += nt; }
        tab[0] = s;
    }
    __syncthreads();
}
template <int NPN, bool GATHER>
struct MoeOrder {
    static constexpr bool CONTIG = !GATHER;
    const int* list;
    LAS const int* tab; int G, c, brows;
    unsigned* tcnt;
    __device__ void init(LAS unsigned char* lds, const int* list_, int G_, int c_, int brows_, unsigned* tcnt_ = nullptr) { list = list_; G = G_; c = c_; brows = brows_; tab = (LAS const int*)(lds + MOE_TAB_OFF); tcnt = tcnt_; }
    __device__ __forceinline__ void done(const Unit& u, int lane) const {
        if (tcnt) { asm volatile("s_waitcnt vmcnt(0)" ::: "memory"); if (lane == 0) __hip_atomic_fetch_add(tcnt + (u.arow0 >> 8), 1u, __ATOMIC_RELAXED, __HIP_MEMORY_SCOPE_AGENT); }
    }
    __device__ bool next(int i, Unit& u) const {
        int L = i * G + c; const int ntile = __builtin_amdgcn_readfirstlane(tab[0]); if (L >= ntile * NPN) return false;
        if (NPN == 4 && i == 0 && G == 256) L = (c & 7) * 32 + (c >> 3);
        const int tile = L / NPN; u.pn = L % NPN;
        u.e = __builtin_amdgcn_readfirstlane(tab[4 + 4 * tile]); u.pm = __builtin_amdgcn_readfirstlane(tab[4 + 4 * tile + 1]); u.cnt = __builtin_amdgcn_readfirstlane(tab[4 + 4 * tile + 2]);
        u.arow0 = tile * BM; u.brow0 = u.e * brows + u.pn * BM; return true;
    }
    __device__ __forceinline__ unsigned arow(const Unit& u, int r) const {
        if (!GATHER) return (unsigned)(u.arow0 + r);
        int idx = u.pm * BM + r; if (idx >= u.cnt) idx = 0;
        return (unsigned)(list[u.e * T + idx] >> 1);
    }
    struct State {};
    __device__ __forceinline__ bool first(State&, Unit& u, int) const { return next(0, u); }
    __device__ __forceinline__ void issue(State&, int, int) const {}
    __device__ __forceinline__ bool fin(State&, int i, Unit& u, int) const { return next(i, u); }
};
constexpr int MOE_Q_OFF = 131072 + 3072 + 512;
struct MoeDownS {
    static constexpr bool CONTIG = true;
    typedef __attribute__((address_space(1))) unsigned gu32;
    LAS const int* tab; LAS unsigned* slot; gu32* tcnt; int brows, G, c;
    struct State {};
    __device__ void init(LAS unsigned char* lds, unsigned* tcnt_, int brows_, int G_, int c_) { tab = (LAS const int*)(lds + MOE_TAB_OFF); slot = (LAS unsigned*)(lds + MOE_Q_OFF); tcnt = (gu32*)tcnt_; brows = brows_; G = G_; c = c_; }
    __device__ __forceinline__ unsigned nunits() const { return (unsigned)__builtin_amdgcn_readfirstlane(tab[0]) * 8u; }
    __device__ __forceinline__ unsigned qof(int k) const {
        const int nG = __builtin_amdgcn_readfirstlane(tab[0]) * 4, h = nG % G, nl = G - h;
        return (unsigned)(c >= h ? k * nl + (k >= 3 ? (k - 2) * h : 0) + (c - h) : (k + 3) * nl + k * h + c);
    }
    __device__ __forceinline__ void wait_tile(unsigned q, unsigned cv) const {
        unsigned sp = 0;
        while (cv < 32u) { __builtin_amdgcn_s_sleep(2); if (++sp > (1u << 22)) break; cv = __hip_atomic_load(tcnt + (q >> 3), __ATOMIC_RELAXED, __HIP_MEMORY_SCOPE_AGENT); }
        asm volatile("buffer_inv sc1" ::: "memory");
    }
    __device__ __forceinline__ bool decode(unsigned q, Unit& u) const {
        if (q >= nunits()) return false;
        const int tile = (int)(q >> 3); u.pn = (int)(q & 7u);
        u.e = __builtin_amdgcn_readfirstlane(tab[4 + 4 * tile]); u.pm = __builtin_amdgcn_readfirstlane(tab[4 + 4 * tile + 1]); u.cnt = __builtin_amdgcn_readfirstlane(tab[4 + 4 * tile + 2]);
        u.arow0 = tile * BM; u.brow0 = u.e * brows + u.pn * BM; return true;
    }
    __device__ __forceinline__ bool first(State&, Unit& u, int tid) const {
        const unsigned q = qof(0);
        if (tid == 0 && q < nunits()) wait_tile(q, __hip_atomic_load(tcnt + (q >> 3), __ATOMIC_RELAXED, __HIP_MEMORY_SCOPE_AGENT));
        __syncthreads();
        return decode(q, u);
    }
    __device__ __forceinline__ void issue(State&, int i, int tid) const {
        const unsigned q = qof(i);
        if (tid == 0 && q < nunits()) {
            const __amdgpu_buffer_rsrc_t rc = __builtin_amdgcn_make_buffer_rsrc((void*)tcnt, (short)0, 128 * 4, 0x00020000);
            __builtin_amdgcn_raw_ptr_buffer_load_lds(rc, (LAS void*)slot, 4, (int)((q >> 3) * 4u), 0, 0, 16);
        }
    }
    __device__ __forceinline__ bool fin(State&, int i, Unit& u, int tid) const {
        const unsigned q = qof(i);
        if (tid == 0 && q < nunits()) {
            unsigned cv; asm volatile("ds_read_b32 %0, %1\n\ts_waitcnt lgkmcnt(0)" : "=v"(cv) : "v"((unsigned)(size_t)slot) : "memory");
            wait_tile(q, cv);
        }
        return decode(q, u);
    }
    __device__ __forceinline__ unsigned arow(const Unit& u, int r) const { return (unsigned)(u.arow0 + r); }
    __device__ __forceinline__ void done(const Unit&, int) const {}
};

struct EpiBf16 {
    static constexpr bool PERM = true;
    bf16_t* O; int ldc; unsigned obytes;
    __device__ __forceinline__ void operator()(const f32x4 (&acc)[2][2][4][2], const Unit& u, int wr, int wc, int fr, int fq) const {
        const __amdgpu_buffer_rsrc_t rO = __builtin_amdgcn_make_buffer_rsrc((void*)O, (short)0, (int)obytes, 0x00020000);
        const unsigned voff = (unsigned)((wr * 64 + fr) * ldc + wc * 32 + 8 * fq) * 2u;
        const unsigned sbase = (unsigned)(u.pm * BM * ldc + u.pn * BM) * 2u;
#pragma unroll
        for (int ai = 0; ai < 2; ++ai)
#pragma unroll
            for (int m = 0; m < 4; ++m)
#pragma unroll
                for (int bj = 0; bj < 2; ++bj) { const f32x4 v0 = acc[ai][bj][m][0], v1 = acc[ai][bj][m][1];
                    u32x4 w; w.x = cvt_pk_bf16(v0[0], v0[1]); w.y = cvt_pk_bf16(v0[2], v0[3]); w.z = cvt_pk_bf16(v1[0], v1[1]); w.w = cvt_pk_bf16(v1[2], v1[3]);
                    __builtin_amdgcn_raw_buffer_store_b128(w, rO, (int)voff, (int)(sbase + (unsigned)((ai * HALF + m * 16) * ldc + bj * HALF) * 2u), 0); }
    }
};
struct EpiGateUp {
    static constexpr bool PERM = true;
    unsigned char* HID; const int* list; const float* gatew;
    __device__ __forceinline__ void operator()(const f32x4 (&acc)[2][2][4][2], const Unit& u, int wr, int wc, int fr, int fq) const {
        const int col0 = u.pn * 128 + wc * 32 + 8 * fq;
#pragma unroll
        for (int ai = 0; ai < 2; ++ai)
#pragma unroll
            for (int m = 0; m < 4; ++m) {
                const int r = ai * HALF + wr * 64 + m * 16 + fr; const int idx = u.pm * BM + r;
                float wgt = 0.f; if (idx < u.cnt) wgt = gatew[list[u.e * T + idx]] * A_PRE;
                const f32x4 g0 = acc[ai][0][m][0], g1 = acc[ai][0][m][1], u0 = acc[ai][1][m][0], u1 = acc[ai][1][m][1];
                float h[8];
#pragma unroll
                for (int i = 0; i < 4; ++i) { h[i] = siluf_(g0[i]) * u0[i] * wgt; h[4 + i] = siluf_(g1[i]) * u1[i] * wgt; }
                u32x2 w; w.x = pk4_fp8(h[0], h[1], h[2], h[3]); w.y = pk4_fp8(h[4], h[5], h[6], h[7]);
                *(u32x2*)(HID + (size_t)(u.arow0 + r) * DEXP + col0) = w;
            }
    }
};
struct EpiGateUpB {
    static constexpr bool PERM = true;
    bf16_t* HID; const int* list; const float* gatew;
    __device__ __forceinline__ void operator()(const f32x4 (&acc)[2][2][4][2], const Unit& u, int wr, int wc, int fr, int fq) const {
        const __amdgpu_buffer_rsrc_t rH = __builtin_amdgcn_make_buffer_rsrc((void*)HID, (short)0, 20480 * 512 * 2, 0x00020000);
        const __amdgpu_buffer_rsrc_t rL = __builtin_amdgcn_make_buffer_rsrc((void*)(list + (size_t)u.e * T), (short)0, T * 4, 0x00020000);
        const __amdgpu_buffer_rsrc_t rG = __builtin_amdgcn_make_buffer_rsrc((void*)gatew, (short)0, 2 * T * 4, 0x00020000);
        const unsigned voff = (unsigned)((wr * 64 + fr) * DEXP + u.pn * 128 + wc * 32 + 8 * fq) * 2u;
        const int idx0 = u.pm * BM + wr * 64 + fr;
#pragma unroll
        for (int ai = 0; ai < 2; ++ai)
#pragma unroll
            for (int m = 0; m < 4; ++m) {
                const int idx = idx0 + ai * HALF + m * 16;
                const int ent = __builtin_amdgcn_raw_buffer_load_b32(rL, idx * 4, 0, 0);
                float wgt = __builtin_bit_cast(float, __builtin_amdgcn_raw_buffer_load_b32(rG, (idx < u.cnt ? ent : 0) * 4, 0, 0)); wgt = idx < u.cnt ? wgt : 0.f;
                const f32x4 g0 = acc[ai][0][m][0], g1 = acc[ai][0][m][1], u0 = acc[ai][1][m][0], u1 = acc[ai][1][m][1];
                float h[8];
#pragma unroll
                for (int i = 0; i < 4; ++i) { h[i] = siluf_(g0[i]) * u0[i] * wgt; h[4 + i] = siluf_(g1[i]) * u1[i] * wgt; }
                u32x4 w; w.x = cvt_pk_bf16(h[0], h[1]); w.y = cvt_pk_bf16(h[2], h[3]); w.z = cvt_pk_bf16(h[4], h[5]); w.w = cvt_pk_bf16(h[6], h[7]);
                __builtin_amdgcn_raw_buffer_store_b128(w, rH, (int)voff, (int)((u.arow0 + ai * HALF + m * 16) * DEXP * 2), 16);
            }
    }
};
struct EpiDown {
    static constexpr bool PERM = true;
    bf16_t* Y2; const int* list;
    __device__ __forceinline__ void operator()(const f32x4 (&acc)[2][2][4][2], const Unit& u, int wr, int wc, int fr, int fq) const {
        const int col0 = u.pn * BM + wc * 32 + 8 * fq;
#pragma unroll
        for (int ai = 0; ai < 2; ++ai)
#pragma unroll
            for (int m = 0; m < 4; ++m) {
                const int r = ai * HALF + wr * 64 + m * 16 + fr; const int idx = u.pm * BM + r;
                if (idx < u.cnt) { const int ent = list[u.e * T + idx]; bf16_t* rowp = Y2 + (size_t)ent * D + col0;
#pragma unroll
                    for (int bj = 0; bj < 2; ++bj) { const f32x4 v0 = acc[ai][bj][m][0], v1 = acc[ai][bj][m][1];
                        u32x4 w; w.x = cvt_pk_bf16(v0[0], v0[1]); w.y = cvt_pk_bf16(v0[2], v0[3]); w.z = cvt_pk_bf16(v1[0], v1[1]); w.w = cvt_pk_bf16(v1[2], v1[3]);
                        *(u32x4*)(rowp + bj * HALF) = w; } }
            }
    }
};

constexpr int NXT_OFF = 131072 + 4096;
template <class Epi, class Sched>
__device__ __forceinline__ void gemm_phase(LAS unsigned char* lds, int wave_id, const Gemm g, const Sched& S, const Epi& E) {
    int lane; asm volatile("v_mbcnt_lo_u32_b32 %0, -1, 0\n\tv_mbcnt_hi_u32_b32 %0, -1, %0" : "=v"(lane));
    const int wid = wave_id, tid = wid * 64 + lane, wr = wid >> 2, wc = wid & 3, fr = lane & 15, fq = lane >> 4;
    const int K = g.K, nt = K / 128;
    unsigned voffB[2];
#pragma unroll
    for (int i = 0; i < 2; ++i) { int R, C; stage_rc(tid * 16 + i * 8192, R, C); const int Rb = Epi::PERM ? ((R & ~31) + perm32(R & 31)) : R; voffB[i] = (unsigned)(Rb * K + 2 * C); }
    const unsigned ldsw = (unsigned)wid * 1024u;
    const int aoff = lds_byte(wr * 64 + fr, 16 * (fq & 1)) + (fq >> 1) * 1024, boff = lds_byte(wc * 32 + fr, 16 * (fq & 1)) + (fq >> 1) * 1024;
    LAS unsigned char* ldsB = lds + 4 * HTB + boff;
    LAS unsigned char* ldsA = lds + aoff;
    const int sc_act = g.sc_a;
#define PG8_SA(b, h) (((b) * 2 + (h)) * HTB)
#define PG8_SB(b, h) ((4 + (b) * 2 + (h)) * HTB)
#define PG8_STAGE(bufoff, rsrc, soff, voff) do { _Pragma("unroll") for (int _i = 0; _i < 2; ++_i) \
        __builtin_amdgcn_raw_ptr_buffer_load_lds(rsrc, (LAS void*)(lds + (bufoff) + ldsw + _i * 8192), 16, (int)(voff)[_i], (int)(soff), 0, 0); } while (0)
#define PG8_LD32(dstv, addr) do { const u32x4 _c0 = *(const LAS u32x4*)(lds + (addr)), _c1 = *(const LAS u32x4*)(lds + (addr) + 16); dstv = (i32x8){(int)_c0.x, (int)_c0.y, (int)_c0.z, (int)_c0.w, (int)_c1.x, (int)_c1.y, (int)_c1.z, (int)_c1.w}; } while (0)
#define PG8_LDA(dst, b, h) do { _Pragma("unroll") for (int m = 0; m < 4; ++m) { const u32x4 _c0 = *(const LAS u32x4*)(ldsA + PG8_SA(b, h) + m * 2048), _c1 = *(const LAS u32x4*)(ldsA + PG8_SA(b, h) + m * 2048 + 16); \
        dst[m] = (i32x8){(int)_c0.x, (int)_c0.y, (int)_c0.z, (int)_c0.w, (int)_c1.x, (int)_c1.y, (int)_c1.z, (int)_c1.w}; } } while (0)
#define PG8_LDB(dst, b, h) do { _Pragma("unroll") for (int n = 0; n < 2; ++n) { const u32x4 _c0 = *(const LAS u32x4*)(ldsB + ((b) * 2 + (h)) * HTB + n * 2048), _c1 = *(const LAS u32x4*)(ldsB + ((b) * 2 + (h)) * HTB + n * 2048 + 16); \
        dst[n] = (i32x8){(int)_c0.x, (int)_c0.y, (int)_c0.z, (int)_c0.w, (int)_c1.x, (int)_c1.y, (int)_c1.z, (int)_c1.w}; } } while (0)
#define PG8_MMA(ai, bj, At, Bt) do { __builtin_amdgcn_sched_barrier(0); __builtin_amdgcn_s_setprio(1); _Pragma("unroll") for (int m = 0; m < 4; ++m) _Pragma("unroll") for (int n = 0; n < 2; ++n) \
        acc[ai][bj][m][n] = __builtin_amdgcn_mfma_scale_f32_16x16x128_f8f6f4(Bt[n], At[m], acc[ai][bj][m][n], 0, 0, 0, SC_W, 0, sc_act); \
        _Pragma("unroll") for (int m = 0; m < 4; ++m) asm volatile("" :: "v"(acc[ai][bj][m][0]), "v"(acc[ai][bj][m][1]));     \
        __builtin_amdgcn_s_setprio(0); __builtin_amdgcn_sched_barrier(0); } while (0)
#define PG8_WAIT_V(n) asm volatile("s_waitcnt vmcnt(" #n ")" ::: "memory")
#define PG8_WAIT_L(n) asm volatile("s_waitcnt lgkmcnt(" #n ")" ::: "memory")
#define PG8_BAR __builtin_amdgcn_s_barrier()
#define PG8_SCHED __builtin_amdgcn_sched_barrier(0)
#define PG8_AOFFS(u, o0, o1) do { _Pragma("unroll") for (int _i = 0; _i < 2; ++_i) { int _R, _C; stage_rc(tid * 16 + _i * 8192, _R, _C); \
        o0[_i] = S.arow(u, _R) * (unsigned)K + 2u * (unsigned)_C; o1[_i] = S.arow(u, HALF + _R) * (unsigned)K + 2u * (unsigned)_C; } } while (0)
    Unit cur, nxt; int ui = 0;
    if (!S.next(0, cur)) return;
    f32x4 acc[2][2][4][2];
#pragma unroll
    for (int a = 0; a < 2; ++a)
#pragma unroll
        for (int b = 0; b < 2; ++b)
#pragma unroll
            for (int m = 0; m < 4; ++m)
#pragma unroll
                for (int n = 0; n < 2; ++n) acc[a][b][m][n] = (f32x4){0.f, 0.f, 0.f, 0.f};
    i32x8 At[4], B0[2], B1[2];
    unsigned cA0[2], cA1[2];
    PG8_AOFFS(cur, cA0, cA1);
    const __amdgpu_buffer_rsrc_t rA = __builtin_amdgcn_make_buffer_rsrc((void*)g.A, (short)0, (int)g.abytes, 0x00020000);
    const __amdgpu_buffer_rsrc_t rB = __builtin_amdgcn_make_buffer_rsrc((void*)g.Bt, (short)0, (int)g.bbytes, 0x00020000);
    const unsigned kstep = (unsigned)(BK * 2);
    const unsigned hstep = (unsigned)HALF * (unsigned)K;
    unsigned cB = (unsigned)cur.brow0 * (unsigned)K;
    PG8_STAGE(PG8_SB(0, 0), rB, cB, voffB); PG8_STAGE(PG8_SB(0, 1), rB, cB + hstep, voffB); PG8_STAGE(PG8_SA(0, 0), rA, 0u, cA0); PG8_STAGE(PG8_SA(0, 1), rA, 0u, cA1);
    if (wr == 1) PG8_BAR;
    PG8_WAIT_V(2); PG8_BAR;
    PG8_STAGE(PG8_SB(1, 0), rB, cB + kstep, voffB); PG8_STAGE(PG8_SA(1, 0), rA, kstep, cA0); PG8_STAGE(PG8_SB(1, 1), rB, cB + hstep + kstep, voffB);
    PG8_WAIT_V(6); PG8_BAR;
#define PG8_PAIR(a1, a2, b2, SWITCH) do { \
            PG8_LDB(B0, 0, 0); PG8_LDB(B1, 0, 1); PG8_SCHED; PG8_LDA(At, 0, 0); PG8_STAGE(PG8_SA(1, 1), rA, a1, cA1); \
            SWITCH; \
            PG8_WAIT_V(8); PG8_WAIT_L(0); PG8_BAR; PG8_MMA(0, 0, At, B0); PG8_MMA(0, 1, At, B1); PG8_BAR; PG8_SCHED; \
            PG8_LDA(At, 0, 1); PG8_STAGE(PG8_SB(0, 0), rB, b2, voffB); PG8_STAGE(PG8_SB(0, 1), rB, (b2) + hstep, voffB); PG8_STAGE(PG8_SA(0, 0), rA, a2, cA0); \
            PG8_WAIT_V(8); PG8_WAIT_L(0); PG8_BAR; PG8_MMA(1, 0, At, B0); PG8_MMA(1, 1, At, B1); PG8_BAR; PG8_SCHED; \
            PG8_LDB(B0, 1, 0); PG8_LDB(B1, 1, 1); PG8_SCHED; PG8_LDA(At, 1, 0); PG8_STAGE(PG8_SA(0, 1), rA, a2, cA1); \
            PG8_WAIT_V(8); PG8_WAIT_L(0); PG8_BAR; PG8_MMA(0, 0, At, B0); PG8_MMA(0, 1, At, B1); PG8_BAR; PG8_SCHED; \
            PG8_LDA(At, 1, 1); PG8_STAGE(PG8_SB(1, 0), rB, (b2) + kstep, voffB); PG8_STAGE(PG8_SB(1, 1), rB, (b2) + kstep + hstep, voffB); PG8_STAGE(PG8_SA(1, 0), rA, (a2) + kstep, cA0); \
            PG8_WAIT_V(8); PG8_WAIT_L(0); PG8_BAR; PG8_MMA(1, 0, At, B0); PG8_MMA(1, 1, At, B1); PG8_BAR; PG8_SCHED; } while (0)
    for (;;) {
        const bool has_next = S.next(ui + 1, nxt);
        const unsigned nB = has_next ? (unsigned)nxt.brow0 * (unsigned)K : cB;
        unsigned dlt = 0u;
        if constexpr (Sched::CONTIG) { dlt = has_next ? (unsigned)(nxt.arow0 - cur.arow0) * (unsigned)K : 0u; }
        else { unsigned n0[2], n1[2]; if (has_next) { PG8_AOFFS(nxt, n0, n1); } else { n0[0] = cA0[0]; n0[1] = cA0[1]; n1[0] = cA1[0]; n1[1] = cA1[1]; }
          *((LAS u32x4*)(lds + NXT_OFF) + tid) = (u32x4){n0[0], n0[1], n1[0], n1[1]}; }
        for (int t = 0; t < nt - 2; t += 2) {
            const unsigned a1 = (unsigned)(t + 1) * kstep, a2 = (unsigned)(t + 2) * kstep, b2 = cB + (unsigned)(t + 2) * kstep;
            PG8_PAIR(a1, a2, b2, (void)0);
        }
        {
            const unsigned a1 = (unsigned)(nt - 1) * kstep;
            PG8_PAIR(a1, 0u, nB, do { if constexpr (Sched::CONTIG) { cA0[0] += dlt; cA0[1] += dlt; cA1[0] += dlt; cA1[1] += dlt; } else { const u32x4 _n = *((LAS u32x4*)(lds + NXT_OFF) + tid); cA0[0] = _n.x; cA0[1] = _n.y; cA1[0] = _n.z; cA1[1] = _n.w; } } while (0));
        }
        { int l2; asm volatile("v_mbcnt_lo_u32_b32 %0, -1, 0\n\tv_mbcnt_hi_u32_b32 %0, -1, %0" : "=v"(l2));
          E(acc, cur, wr, wc, l2 & 15, l2 >> 4); S.done(cur, l2); }
        if (!has_next) break;
#pragma unroll
        for (int a = 0; a < 2; ++a)
#pragma unroll
            for (int b = 0; b < 2; ++b)
#pragma unroll
                for (int m = 0; m < 4; ++m)
#pragma unroll
                    for (int n = 0; n < 2; ++n) acc[a][b][m][n] = (f32x4){0.f, 0.f, 0.f, 0.f};
        cur = nxt; cB = nB; ++ui;
    }
    PG8_WAIT_V(0);
    if (wr == 0) PG8_BAR;
    PG8_BAR;
#undef PG8_PAIR
#undef PG8_AOFFS
#undef PG8_SA
#undef PG8_SB
#undef PG8_STAGE
#undef PG8_LDA
#undef PG8_LDB
#undef PG8_MMA
#undef PG8_WAIT_V
#undef PG8_WAIT_L
#undef PG8_BAR
#undef PG8_SCHED
}
struct Gemm16 { const bf16_t* A; const bf16_t* Bt; int K; unsigned abytes, bbytes; };
struct EpiGateUp16 {
    static constexpr bool PERM = true;
    bf16_t* HID; const int* list; const float* gatew;
    __device__ __forceinline__ void operator()(const f32x4 (&acc)[2][2][4][2], const Unit& u, int wr, int wc, int fr, int fq) const {
        const int col0 = u.pn * 128 + wc * 32 + 8 * fq;
#pragma unroll
        for (int ai = 0; ai < 2; ++ai)
#pragma unroll
            for (int m = 0; m < 4; ++m) {
                const int r = ai * HALF + wr * 64 + m * 16 + fr; const int idx = u.pm * BM + r;
                float wgt = 0.f; if (idx < u.cnt) wgt = gatew[list[u.e * T + idx]];
                const f32x4 g0 = acc[ai][0][m][0], g1 = acc[ai][0][m][1], u0 = acc[ai][1][m][0], u1 = acc[ai][1][m][1];
                float h[8];
#pragma unroll
                for (int i = 0; i < 4; ++i) { h[i] = siluf_(g0[i]) * u0[i] * wgt; h[4 + i] = siluf_(g1[i]) * u1[i] * wgt; }
                u32x4 w; w.x = cvt_pk_bf16(h[0], h[1]); w.y = cvt_pk_bf16(h[2], h[3]); w.z = cvt_pk_bf16(h[4], h[5]); w.w = cvt_pk_bf16(h[6], h[7]);
                *(u32x4*)(HID + (size_t)(u.arow0 + r) * DEXP + col0) = w;
            }
    }
};
template <class Epi, class Sched>
__device__ __forceinline__ void gemm_phase16(LAS unsigned char* lds, int wave_id, const Gemm16 g, const Sched& S, const Epi& E) {
    int lane; asm volatile("v_mbcnt_lo_u32_b32 %0, -1, 0\n\tv_mbcnt_hi_u32_b32 %0, -1, %0" : "=v"(lane));
    const int wid = wave_id, tid = wid * 64 + lane, wr = wid >> 2, wc = wid & 3, fr = lane & 15, fq = lane >> 4;
    const int K = g.K, nt = K / BK;
    unsigned voffB[2];
#pragma unroll
    for (int i = 0; i < 2; ++i) { int R, C; stage_rc(tid * 16 + i * 8192, R, C); const int Rb = Epi::PERM ? ((R & ~31) + perm32(R & 31)) : R; voffB[i] = (unsigned)(Rb * K + C) * 2u; }
    const unsigned ldsw = (unsigned)wid * 1024u;
    const int aoff = lds_byte(wr * 64 + fr, fq * 8), boff = lds_byte(wc * 32 + fr, fq * 8);
#define PG8_SA(b, h) (((b) * 2 + (h)) * HTB)
#define PG8_SB(b, h) ((4 + (b) * 2 + (h)) * HTB)
#define PG8_STAGE(bufoff, rsrc, soff, voff) do { _Pragma("unroll") for (int _i = 0; _i < 2; ++_i) \
        __builtin_amdgcn_raw_ptr_buffer_load_lds(rsrc, (LAS void*)(lds + (bufoff) + ldsw + _i * 8192), 16, (int)(voff)[_i], (int)(soff), 0, 0); } while (0)
#define PG8_LDA(dst, b, h) do { _Pragma("unroll") for (int m = 0; m < 4; ++m) _Pragma("unroll") for (int k = 0; k < 2; ++k) dst[m][k] = *(const LAS bf16x8*)(lds + PG8_SA(b, h) + aoff + m * 2048 + k * 1024); } while (0)
#define PG8_LDB(dst, b, h) do { _Pragma("unroll") for (int n = 0; n < 2; ++n) _Pragma("unroll") for (int k = 0; k < 2; ++k) dst[n][k] = *(const LAS bf16x8*)(lds + PG8_SB(b, h) + boff + n * 2048 + k * 1024); } while (0)
#define PG8_MMA(ai, bj, At, Bt) do { __builtin_amdgcn_s_setprio(1); _Pragma("unroll") for (int m = 0; m < 4; ++m) _Pragma("unroll") for (int n = 0; n < 2; ++n) _Pragma("unroll") for (int k = 0; k < 2; ++k) \
        acc[ai][bj][m][n] = __builtin_amdgcn_mfma_f32_16x16x32_bf16(Bt[n][k], At[m][k], acc[ai][bj][m][n], 0, 0, 0); __builtin_amdgcn_s_setprio(0); } while (0)
#define PG8_WAIT_V(n) asm volatile("s_waitcnt vmcnt(" #n ")" ::: "memory")
#define PG8_WAIT_L(n) asm volatile("s_waitcnt lgkmcnt(" #n ")" ::: "memory")
#define PG8_BAR __builtin_amdgcn_s_barrier()
#define PG8_SCHED __builtin_amdgcn_sched_barrier(0)
#define PG8_AOFFS(u, o0, o1) do { _Pragma("unroll") for (int _i = 0; _i < 2; ++_i) { int _R, _C; stage_rc(tid * 16 + _i * 8192, _R, _C); \
        o0[_i] = (S.arow(u, _R) * (unsigned)K + (unsigned)_C) * 2u; o1[_i] = (S.arow(u, HALF + _R) * (unsigned)K + (unsigned)_C) * 2u; } } while (0)
    Unit cur, nxt; int ui = 0;
    typename Sched::State st;
    if (!S.first(st, cur, tid)) return;
    f32x4 acc[2][2][4][2];
#pragma unroll
    for (int a = 0; a < 2; ++a)
#pragma unroll
        for (int b = 0; b < 2; ++b)
#pragma unroll
            for (int m = 0; m < 4; ++m)
#pragma unroll
                for (int n = 0; n < 2; ++n) acc[a][b][m][n] = (f32x4){0.f, 0.f, 0.f, 0.f};
    bf16x8 At[4][2], B0[2][2], B1[2][2];
    unsigned cA0[2], cA1[2];
    PG8_AOFFS(cur, cA0, cA1);
    const __amdgpu_buffer_rsrc_t rA = __builtin_amdgcn_make_buffer_rsrc((void*)g.A, (short)0, (int)g.abytes, 0x00020000);
    const __amdgpu_buffer_rsrc_t rB = __builtin_amdgcn_make_buffer_rsrc((void*)g.Bt, (short)0, (int)g.bbytes, 0x00020000);
    const unsigned kstep = (unsigned)(BK * 2);
    const unsigned hstep = (unsigned)HALF * (unsigned)K * 2u;
    unsigned cB = (unsigned)cur.brow0 * (unsigned)K * 2u;
    PG8_STAGE(PG8_SB(0, 0), rB, cB, voffB); PG8_STAGE(PG8_SB(0, 1), rB, cB + hstep, voffB); PG8_STAGE(PG8_SA(0, 0), rA, 0u, cA0); PG8_STAGE(PG8_SA(0, 1), rA, 0u, cA1);
    if (wr == 1) PG8_BAR;
    PG8_WAIT_V(2); PG8_BAR;
    PG8_STAGE(PG8_SB(1, 0), rB, cB + kstep, voffB); PG8_STAGE(PG8_SA(1, 0), rA, kstep, cA0); PG8_STAGE(PG8_SB(1, 1), rB, cB + hstep + kstep, voffB);
    PG8_WAIT_V(6); PG8_BAR;
#define PG8_PAIR(a1, a2, b2, SWITCH) do { \
            PG8_LDB(B0, 0, 0); PG8_LDB(B1, 0, 1); PG8_SCHED; PG8_LDA(At, 0, 0); PG8_STAGE(PG8_SA(1, 1), rA, a1, cA1); \
            SWITCH; \
            PG8_WAIT_V(8); PG8_WAIT_L(0); PG8_BAR; PG8_MMA(0, 0, At, B0); PG8_MMA(0, 1, At, B1); PG8_BAR; PG8_SCHED; \
            PG8_LDA(At, 0, 1); PG8_STAGE(PG8_SB(0, 0), rB, b2, voffB); PG8_STAGE(PG8_SB(0, 1), rB, (b2) + hstep, voffB); PG8_STAGE(PG8_SA(0, 0), rA, a2, cA0); \
            PG8_WAIT_V(8); PG8_WAIT_L(0); PG8_BAR; PG8_MMA(1, 0, At, B0); PG8_MMA(1, 1, At, B1); PG8_BAR; PG8_SCHED; \
            PG8_LDB(B0, 1, 0); PG8_LDB(B1, 1, 1); PG8_SCHED; PG8_LDA(At, 1, 0); PG8_STAGE(PG8_SA(0, 1), rA, a2, cA1); \
            PG8_WAIT_V(8); PG8_WAIT_L(0); PG8_BAR; PG8_MMA(0, 0, At, B0); PG8_MMA(0, 1, At, B1); PG8_BAR; PG8_SCHED; \
            PG8_LDA(At, 1, 1); PG8_STAGE(PG8_SB(1, 0), rB, (b2) + kstep, voffB); PG8_STAGE(PG8_SB(1, 1), rB, (b2) + kstep + hstep, voffB); PG8_STAGE(PG8_SA(1, 0), rA, (a2) + kstep, cA0); \
            PG8_WAIT_V(8); PG8_WAIT_L(0); PG8_BAR; PG8_MMA(1, 0, At, B0); PG8_MMA(1, 1, At, B1); PG8_BAR; PG8_SCHED; } while (0)
    for (;;) {
        S.issue(st, ui + 1, tid);
        for (int t = 0; t < nt - 2; t += 2) {
            const unsigned a1 = (unsigned)(t + 1) * kstep, a2 = (unsigned)(t + 2) * kstep, b2 = cB + (unsigned)(t + 2) * kstep;
            PG8_PAIR(a1, a2, b2, (void)0);
        }
        const bool has_next = S.fin(st, ui + 1, nxt, tid);
        const unsigned nB = has_next ? (unsigned)nxt.brow0 * (unsigned)K * 2u : cB;
        {
            const unsigned a1 = (unsigned)(nt - 1) * kstep;
            PG8_PAIR(a1, 0u, nB, do { if (has_next) { PG8_AOFFS(nxt, cA0, cA1); } } while (0));
        }
        if (wr == 0) PG8_BAR;
        { int l2; asm volatile("v_mbcnt_lo_u32_b32 %0, -1, 0\n\tv_mbcnt_hi_u32_b32 %0, -1, %0" : "=v"(l2));
          E(acc, cur, wr, wc, l2 & 15, l2 >> 4); S.done(cur, l2); }
        if (!has_next) break;
#pragma unroll
        for (int a = 0; a < 2; ++a)
#pragma unroll
            for (int b = 0; b < 2; ++b)
#pragma unroll
                for (int m = 0; m < 4; ++m)
#pragma unroll
                    for (int n = 0; n < 2; ++n) acc[a][b][m][n] = (f32x4){0.f, 0.f, 0.f, 0.f};
        cur = nxt; cB = nB; ++ui;
        if (wr == 1) PG8_BAR;
    }
    PG8_WAIT_V(0);
    PG8_BAR;
#undef PG8_PAIR
#undef PG8_AOFFS
#undef PG8_SA
#undef PG8_SB
#undef PG8_STAGE
#undef PG8_LDA
#undef PG8_LDB
#undef PG8_MMA
#undef PG8_WAIT_V
#undef PG8_WAIT_L
#undef PG8_BAR
#undef PG8_SCHED
}
}

#define XB_TMO      128
#define XB_XCNT(j)  (256  + 64 * (j))
#define XB_XSUB(j)  (1280 + 64 * (j))
#define XB_XGEN(j)  (2304 + 64 * (j))
#define XB_TOP      3328
#define XB_TOPGEN   3392
#define XCD_BAR_WORDS 3456
#define XB_SPIN_CAP (1u << 20)
__device__ __forceinline__ unsigned xb_ld(unsigned* p)              { return __hip_atomic_load(p, __ATOMIC_RELAXED, __HIP_MEMORY_SCOPE_AGENT); }
__device__ __forceinline__ unsigned xb_add(unsigned* p, unsigned v) { return __hip_atomic_fetch_add(p, v, __ATOMIC_RELAXED, __HIP_MEMORY_SCOPE_AGENT); }
__device__ __forceinline__ unsigned xb_xcc_id() { return (unsigned)__builtin_amdgcn_s_getreg((3 << 11) | 20) & 0xFu; }
#define XB_SPIN(cond, bar) do { unsigned _sp = 0; while (cond) { __builtin_amdgcn_s_sleep(1); \
    if ((++_sp & 255u) == 0u) { if (xb_ld(&(bar)[XB_TMO])) break; if (_sp > XB_SPIN_CAP) { atomicAdd(&(bar)[XB_TMO], 1u); break; } } } } while (0)
__device__ __forceinline__ void xcd_barrier_complete(unsigned* bar, unsigned x, unsigned& nloc, unsigned& nx) {
    const unsigned G = gridDim.x;
    unsigned sum, cnt, mine, sp = 0u;
    for (;;) {
        sum = 0u; cnt = 0u; mine = 0u;
#pragma unroll
        for (unsigned j = 0; j < 16; ++j) { const unsigned c = xb_ld(&bar[XB_XCNT(j)]); sum += c; cnt += (c > 0u) ? 1u : 0u; mine = (j == x) ? c : mine; }
        if (sum == G) break;
        __builtin_amdgcn_s_sleep(1);
        if ((++sp & 255u) == 0u) { if (xb_ld(&bar[XB_TMO])) break; if (sp > XB_SPIN_CAP) { atomicAdd(&bar[XB_TMO], 1u); break; } }
    }
    nloc = mine > 0u ? mine : 1u; nx = cnt > 0u ? cnt : 1u;
}
__device__ __forceinline__ void xcd_barrier(unsigned* bar, volatile LAS unsigned* st, int wave) {
    asm volatile("s_waitcnt vmcnt(0) lgkmcnt(0)" ::: "memory");
    __syncthreads();
    int lane; asm volatile("v_mbcnt_lo_u32_b32 %0, -1, 0\n\tv_mbcnt_hi_u32_b32 %0, -1, %0" : "=v"(lane));
    if (wave == 0 && lane == 0) {
        __builtin_amdgcn_s_waitcnt(0);
        const unsigned x = xb_xcc_id();
        unsigned nloc = st[0], nx = st[1];
        if (nloc == 0u) { xcd_barrier_complete(bar, x, nloc, nx); st[0] = nloc; st[1] = nx; }
        const unsigned old = xb_add(&bar[XB_XSUB(x)], 1u);
        const unsigned gen = old / nloc;
        if (old + 1u == (gen + 1u) * nloc) {
            __builtin_amdgcn_fence(__ATOMIC_RELEASE, "agent");
            asm volatile("s_waitcnt vmcnt(0)" ::: "memory");
            const unsigned og = xb_add(&bar[XB_TOP], 1u);
            const unsigned tg = og / nx;
            if (og + 1u == (tg + 1u) * nx) xb_add(&bar[XB_TOPGEN], 1u);
            else XB_SPIN(xb_ld(&bar[XB_TOPGEN]) == tg, bar);
            __builtin_amdgcn_fence(__ATOMIC_ACQUIRE, "agent");
            xb_add(&bar[XB_XGEN(x)], 1u);
            asm volatile("s_waitcnt vmcnt(0)" ::: "memory");
        } else {
            XB_SPIN(xb_ld(&bar[XB_XGEN(x)]) == gen, bar);
            __builtin_amdgcn_fence(__ATOMIC_ACQUIRE, "agent");
            asm volatile("s_waitcnt vmcnt(0)" ::: "memory");
        }
    }
    __syncthreads();
}

struct Params {
    const float* in[18];
    float* out; unsigned char* ws;
};
enum { I_X = 0, I_EV_WIN, I_EV_CONV, I_EV_ALOG, I_EV_DTB, I_EV_GDNN, I_EV_HGRNN, I_LBLOG, I_EV_WOUT, I_OD_WIN, I_OD_WOUT, I_RW, I_RB, I_MG, I_MU, I_MD, I_LNG, I_LNB };

struct Frame {
    LAS unsigned char* lds;
    int tid, lane, wave, G, bid;
};
__device__ __forceinline__ Frame refresh(const Frame& F0) {
    Frame F = F0; int l; asm volatile("v_mbcnt_lo_u32_b32 %0, -1, 0\n\tv_mbcnt_hi_u32_b32 %0, -1, %0" : "=v"(l));
    F.lane = l; F.tid = F0.wave * 64 + l; return F;
}

constexpr size_t WS_W3 = WS_AB + 16 * MiB, WS_WOUT1 = WS_WOUT + 4 * MiB, WS_WGU1 = WS_WGU + 32 * MiB;
struct CDesc { const float* src; unsigned char* dst; int ld, Kd, fp8; };
__device__ __forceinline__ CDesc conv_desc(const Params& p, unsigned char* ws, int kind, int r) {
    CDesc d;
    switch (kind) {
    case 0: { const int kb = r / 256, nb = r % 256, n0 = nb * 32; const int c0 = n0 < 4096 ? n0 : n0 + 16;
        d.src = p.in[I_EV_WIN] + (size_t)(kb * 64) * EVEN_IN + c0; d.ld = EVEN_IN; d.dst = ws + WS_WIN + (size_t)n0 * 2048 + kb * 64; d.Kd = 2048; d.fp8 = 1; break; }
    case 1: { const int kb = r / 64, nb = r % 64; d.src = p.in[I_EV_WOUT] + (size_t)(kb * 64) * 2048 + nb * 32; d.ld = 2048; d.dst = ws + WS_WOUT + (size_t)(nb * 32) * 2048 + kb * 64; d.Kd = 2048; d.fp8 = 1; break; }
    case 2: case 6: { const int layer = kind == 6; const int isup = r >= 8192; if (isup) r -= 8192;
        const int e = r / 512, q = r % 512, kb = q / 16, nb = q % 16, f0 = nb * 32;
        d.src = (isup ? p.in[I_MU] : p.in[I_MG]) + (size_t)(layer * NE + e) * 2048 * 512 + (size_t)(kb * 64) * 512 + f0; d.ld = 512;
        d.dst = ws + (layer ? WS_WGU1 : WS_WGU) + (size_t)e * 1024 * 2048 + (size_t)(256 * (f0 >> 7) + 128 * isup + (f0 & 127)) * 2048 + kb * 64; d.Kd = 2048; d.fp8 = 1; break; }
    case 3: case 7: { const int layer = kind == 7; const int e = r / 512, q = r % 512, kb = q / 64, nb = q % 64;
        d.src = p.in[I_MD] + (size_t)(layer * NE + e) * 512 * 2048 + (size_t)(kb * 64) * 2048 + nb * 32; d.ld = 2048;
        d.dst = ws + WS_WD + ((size_t)e * 2048 * 512 + (size_t)(nb * 32) * 512 + kb * 64) * 2; d.Kd = 512; d.fp8 = 0; break; }
    case 4: { const int kb = r / 192, nb = r % 192; d.src = p.in[I_OD_WIN] + (size_t)(kb * 64) * ODD_IN + nb * 32; d.ld = ODD_IN; d.dst = ws + WS_W3 + (size_t)(nb * 32) * 2048 + kb * 64; d.Kd = 2048; d.fp8 = 1; break; }
    default: { const int kb = r / 64, nb = r % 64; d.src = p.in[I_OD_WOUT] + (size_t)(kb * 64) * 2048 + nb * 32; d.ld = 2048; d.dst = ws + WS_WOUT1 + (size_t)(nb * 32) * 1024 + kb * 64; d.Kd = 1024; d.fp8 = 1; break; }
    }
    return d;
}
__device__ __forceinline__ void conv_load(const CDesc& d, int lane, float (&wv)[32]) {
    const float* wp = d.src + (size_t)(lane >> 5) * d.ld + (lane & 31);
#pragma unroll
    for (int i = 0; i < 32; ++i) wv[i] = __builtin_nontemporal_load(wp + (size_t)(2 * i) * d.ld);
}
__device__ __forceinline__ void conv_store(const CDesc& d, int lane, const float (&wv)[32], LAS float* scr) {
#pragma unroll
    for (int i = 0; i < 32; ++i) scr[(2 * i + (lane >> 5)) * 33 + (lane & 31)] = wv[i];
    LDS_WAIT(); asm volatile("" ::: "memory");
    if (d.fp8) {
        const int c = lane & 3;
#pragma unroll
        for (int j = 0; j < 2; ++j) { const int n = (lane >> 2) + 16 * j; const LAS float* sp = scr + (16 * c) * 33 + n;
            u32x4 o;
            o.x = pk4_fp8(sp[0 * 33] * W_PRE, sp[1 * 33] * W_PRE, sp[2 * 33] * W_PRE, sp[3 * 33] * W_PRE);     o.y = pk4_fp8(sp[4 * 33] * W_PRE, sp[5 * 33] * W_PRE, sp[6 * 33] * W_PRE, sp[7 * 33] * W_PRE);
            o.z = pk4_fp8(sp[8 * 33] * W_PRE, sp[9 * 33] * W_PRE, sp[10 * 33] * W_PRE, sp[11 * 33] * W_PRE);   o.w = pk4_fp8(sp[12 * 33] * W_PRE, sp[13 * 33] * W_PRE, sp[14 * 33] * W_PRE, sp[15 * 33] * W_PRE);
            *(u32x4*)(d.dst + (size_t)n * d.Kd + 16 * c) = o; }
    } else {
        const int c = lane & 7;
#pragma unroll
        for (int j = 0; j < 4; ++j) { const int n = (lane >> 3) + 8 * j; const LAS float* sp = scr + (8 * c) * 33 + n;
            u32x4 o; o.x = pk2(sp[0 * 33], sp[1 * 33]); o.y = pk2(sp[2 * 33], sp[3 * 33]); o.z = pk2(sp[4 * 33], sp[5 * 33]); o.w = pk2(sp[6 * 33], sp[7 * 33]);
            *(u32x4*)(d.dst + ((size_t)n * d.Kd + 8 * c) * 2) = o; }
    }
    LDS_WAIT(); asm volatile("" ::: "memory");
}
__device__ __forceinline__ CDesc conv_item(const Params& p, unsigned char* ws, int set, int it) {
    if (set == 0) return it < 8192 ? conv_desc(p, ws, 0, it) : conv_desc(p, ws, 1, it - 8192);
    if (set == 1) { int r = it;
        if (r < 16384) return conv_desc(p, ws, 2, r); r -= 16384;
        if (r < 8192) return conv_desc(p, ws, 3, r); r -= 8192;
        if (r < 6144) return conv_desc(p, ws, 4, r); r -= 6144;
        if (r < 1024) return conv_desc(p, ws, 5, r); r -= 1024;
        return conv_desc(p, ws, 6, r); }
    return conv_desc(p, ws, 7, it);
}
__device__ __forceinline__ void convert_set(const Params& p, const Frame& F0, int set, int w, int nw) {
    const Frame F = refresh(F0);
    LAS float* scr = (LAS float*)(F.lds + F.wave * 16384);
    unsigned char* ws = opq(p.ws);
    const int N = set == 0 ? 8192 + 2048 : set == 1 ? 16384 + 8192 + 6144 + 1024 + 16384 : 8192;
    for (int it = w; it < N; it += 2 * nw) {
        const bool two = it + nw < N;
        const CDesc d0 = conv_item(p, ws, set, it), d1 = conv_item(p, ws, set, two ? it + nw : it);
        float v0[32], v1[32];
        conv_load(d0, F.lane, v0); if (two) conv_load(d1, F.lane, v1);
        conv_store(d0, F.lane, v0, scr); if (two) conv_store(d1, F.lane, v1, scr);
    }
}

__device__ __forceinline__ void load_w16_lds(const Frame& F0, const float* W, int ld, int c0) {
    const Frame F = refresh(F0);
    LAS float* l = (LAS float*)F.lds;
    for (int i = F.tid; i < 2048 * 16; i += NTHR) { const int k = i >> 4, e = i & 15; l[e * 2048 + k] = W[(size_t)k * ld + c0 + e]; }
}
__device__ __forceinline__ float dot16(const Frame& F, const f32x4 (&v)[8]) {
    const LAS f32x4* l = (const LAS f32x4*)F.lds;
    float res = 0.f;
#pragma unroll 1
    for (int e = 0; e < 16; ++e) { float s = 0.f;
#pragma unroll
        for (int j = 0; j < 8; ++j) { const f32x4 w = l[e * 512 + 64 * j + F.lane]; s += (v[j].x * w.x + v[j].y * w.y) + (v[j].z * w.z + v[j].w * w.w); }
        s = wave_sum(s); res = (F.lane == e) ? s : res; }
    return res;
}

__device__ __forceinline__ void p0_xpass(const Params& p, const Frame& F0) {
    const Frame F = refresh(F0);
    const int gw = F.bid * NWAVES + F.wave, NGW = F.G * NWAVES;
    float* BA = (float*)(opq(p.ws) + WS_BA); bf16_t* AB = (bf16_t*)(opq(p.ws) + WS_AB);
    for (int m = gw; m < T; m += NGW) {
        const f32x4* xr = (const f32x4*)(p.in[I_X] + (size_t)m * D) + F.lane;
        f32x4 v[8];
#pragma unroll
        for (int j = 0; j < 8; ++j) v[j] = xr[64 * j];
        unsigned* o = (unsigned*)((unsigned char*)AB + (size_t)m * D) + F.lane;
#pragma unroll
        for (int j = 0; j < 8; ++j) o[64 * j] = pk4_fp8(v[j].x * X_PRE, v[j].y * X_PRE, v[j].z * X_PRE, v[j].w * X_PRE);
        const float a = dot16(F, v);
        if (F.lane < 16) BA[(size_t)m * 16 + F.lane] = a;
    }
}

constexpr size_t WS_R16A = WS_OC + 16 * MiB, WS_R16B = WS_SCR + 190 * MiB;
__device__ __forceinline__ bf16_t* r16_row(unsigned char* ws, int m) { return (bf16_t*)(ws + (m < T / 2 ? WS_R16A + (size_t)m * D * 2 : WS_R16B + (size_t)(m - T / 2) * D * 2)); }
template <bool ROUTE, bool TWO, bool RES16, bool OUT16>
__device__ __forceinline__ void ln_pass(const Params& p, const Frame& F0, const float* resid, const bf16_t* add1, int ld1, const bf16_t* add2, const float* gain, const float* bias,
                                        float* outf, bf16_t* outb, int layer) {
    const Frame F = refresh(F0);
    const int TPB = (T + F.G - 1) / F.G;
    const int mbeg = ROUTE ? F.bid * TPB + F.wave : F.bid * NWAVES + F.wave, mend = ROUTE ? min(T, (F.bid + 1) * TPB) : T, mstep = ROUTE ? NWAVES : F.G * NWAVES;
    int* SEL = (int*)(opq(p.ws) + WS_CTL + 65536);
    int* HIST = (int*)(opq(p.ws) + WS_CTL + 32768);
    LAS int* lhist = (LAS int*)(F.lds + pg8::MOE_HIST_OFF);
    float* gatew = (float*)(opq(p.ws) + WS_GATEW) + (size_t)layer * 2 * T;
    if (ROUTE) { if (F.tid < NE) lhist[F.tid] = 0; __syncthreads(); }
    f32x4 gn[8], bs[8];
#pragma unroll
    for (int j = 0; j < 8; ++j) { gn[j] = ((const f32x4*)gain)[64 * j + F.lane]; bs[j] = ((const f32x4*)bias)[64 * j + F.lane]; }
    f32x4 nxf[8]; u32x2 nx16[8], na1[8], na2[8];
    const GAS float* residg = (const GAS float*)resid; const GAS bf16_t* add1g = (const GAS bf16_t*)add1; const GAS bf16_t* add2g = (const GAS bf16_t*)add2;
#define LN_LOAD(mm) do { const GAS f32x4* xr = (const GAS f32x4*)(residg + (size_t)(mm) * D) + F.lane; const GAS u32x2* xr16 = (const GAS u32x2*)r16_row(opqg(p.ws), (mm)) + F.lane; \
        _Pragma("unroll") for (int j = 0; j < 8; ++j) { \
            if (RES16) nx16[j] = xr16[64 * j]; else nxf[j] = xr[64 * j]; \
            if (add1) na1[j] = ((const GAS u32x2*)(add1g + (size_t)(TWO ? 2 * (mm) : (mm)) * ld1))[64 * j + F.lane]; \
            if (TWO) na2[j] = ((const GAS u32x2*)(add2g + (size_t)(2 * (mm) + 1) * ld1))[64 * j + F.lane]; } } while (0)
    if (mbeg < mend) LN_LOAD(mbeg);
    for (int m = mbeg; m < mend; m += mstep) {
        f32x4 v[8]; float s = 0.f;
#pragma unroll
        for (int j = 0; j < 8; ++j) {
            if (RES16) { const u32x2 a = nx16[j]; v[j] = (f32x4){bflo(a.x), bfhi(a.x), bflo(a.y), bfhi(a.y)} * ALPHA; }
            else v[j] = nxf[j] * ALPHA;
            if (add1) { const u32x2 a = na1[j]; v[j].x += bflo(a.x); v[j].y += bfhi(a.x); v[j].z += bflo(a.y); v[j].w += bfhi(a.y); }
            if (TWO) { const u32x2 a = na2[j]; v[j].x += bflo(a.x); v[j].y += bfhi(a.x); v[j].z += bflo(a.y); v[j].w += bfhi(a.y); }
#ifdef DBG_SANITIZE
            if (!(fabsf(v[j].x) < 1e30f)) v[j].x = 0.f; if (!(fabsf(v[j].y) < 1e30f)) v[j].y = 0.f; if (!(fabsf(v[j].z) < 1e30f)) v[j].z = 0.f; if (!(fabsf(v[j].w) < 1e30f)) v[j].w = 0.f;
#endif
            s += (v[j].x + v[j].y) + (v[j].z + v[j].w);
        }
        if (m + mstep < mend) LN_LOAD(m + mstep);
        const float mean = wave_sum(s) * (1.f / D); float s2 = 0.f;
#pragma unroll
        for (int j = 0; j < 8; ++j) { v[j] = v[j] - mean; s2 += (v[j].x * v[j].x + v[j].y * v[j].y) + (v[j].z * v[j].z + v[j].w * v[j].w); }
        const float rstd = 1.f / sqrtf(wave_sum(s2) * (1.f / D) + LN_EPS);
#pragma unroll
        for (int j = 0; j < 8; ++j) v[j] = v[j] * rstd * gn[j] + bs[j];
        if (OUT16) { u32x2* of = (u32x2*)r16_row(opq(p.ws), m) + F.lane;
#pragma unroll
            for (int j = 0; j < 8; ++j) { u32x2 w; w.x = pk2(v[j].x, v[j].y); w.y = pk2(v[j].z, v[j].w); of[64 * j] = w; } }
        else { f32x4* of = (f32x4*)(outf + (size_t)m * D) + F.lane;
#pragma unroll
            for (int j = 0; j < 8; ++j) of[64 * j] = v[j]; }
        if (outb) {
            { unsigned* o = (unsigned*)((unsigned char*)outb + (size_t)m * D) + F.lane;
#pragma unroll
                for (int j = 0; j < 8; ++j) o[64 * j] = pk4_fp8(v[j].x, v[j].y, v[j].z, v[j].w); } }
        if (ROUTE) {
            const float lgl = dot16(F, v);
            const float scl = 1.0f / (1.0f + expf(-lgl)), bil = scl + p.in[I_RB][F.lane & 15];
            float sc[16], bi[16];
#pragma unroll
            for (int e = 0; e < 16; ++e) { sc[e] = __builtin_bit_cast(float, __builtin_amdgcn_readlane(__builtin_bit_cast(int, scl), e)); bi[e] = __builtin_bit_cast(float, __builtin_amdgcn_readlane(__builtin_bit_cast(int, bil), e)); }
            int bg = 0; float bgs = -3.0e38f;
#pragma unroll
            for (int g = 0; g < 4; ++g) { float m1 = -3.0e38f, m2 = -3.0e38f;
#pragma unroll
                for (int k = 0; k < 4; ++k) { const float x = bi[4 * g + k]; if (x > m1) { m2 = m1; m1 = x; } else if (x > m2) m2 = x; }
                const float gs = m1 + m2; if (gs > bgs) { bgs = gs; bg = g; } }
            int i1 = 0, i2 = 0; float b1 = -3.0e38f, b2 = -3.0e38f, s1 = 0.f, s2v = 0.f;
#pragma unroll
            for (int e = 0; e < 16; ++e) { if ((e >> 2) == bg) { const float x = bi[e]; if (x > b1) { b2 = b1; i2 = i1; s2v = s1; b1 = x; i1 = e; s1 = sc[e]; } else if (x > b2) { b2 = x; i2 = e; s2v = sc[e]; } } }
            if (F.lane == 0) {
                const float den = s1 + s2v;
                SEL[m] = i1 | (i2 << 8); gatew[2 * m] = s1 / den; gatew[2 * m + 1] = s2v / den;
                __hip_atomic_fetch_add(lhist + i1, 1, __ATOMIC_RELAXED, __HIP_MEMORY_SCOPE_WORKGROUP); __hip_atomic_fetch_add(lhist + i2, 1, __ATOMIC_RELAXED, __HIP_MEMORY_SCOPE_WORKGROUP);
            }
        }
    }
#undef LN_LOAD
    if (ROUTE) { __syncthreads(); if (F.tid < NE) HIST[F.bid * NE + F.tid] = lhist[F.tid]; }
}

__device__ __forceinline__ void moe_lists(const Params& p, const Frame& F0, int layer) {
    const Frame F = refresh(F0);
    const int* SEL = (const int*)(opq(p.ws) + WS_CTL + 65536);
    const int* HIST = (const int*)(opq(p.ws) + WS_CTL + 32768);
    int* list = (int*)(opq(p.ws) + WS_LIST) + (size_t)layer * NE * T;
    LAS int* ltot = (LAS int*)(F.lds + pg8::MOE_HIST_OFF) + 16;
    LAS int* lbase = (LAS int*)(F.lds + pg8::MOE_HIST_OFF) + 32;
    if (F.tid < NE) { ltot[F.tid] = 0; lbase[F.tid] = 0; }
    __syncthreads();
    { const int e = F.tid & 15, grp = F.tid >> 4; int base = 0, tot = 0;
#pragma unroll 8
      for (int b = grp; b < F.G; b += 32) { const int h = HIST[b * NE + e]; tot += h; if (b < F.bid) base += h; }
      __hip_atomic_fetch_add(ltot + e, tot, __ATOMIC_RELAXED, __HIP_MEMORY_SCOPE_WORKGROUP); __hip_atomic_fetch_add(lbase + e, base, __ATOMIC_RELAXED, __HIP_MEMORY_SCOPE_WORKGROUP); }
    __syncthreads();
    LAS int* ltpre = (LAS int*)(F.lds + pg8::MOE_HIST_OFF) + 48;
    LAS int* lslot = (LAS int*)(F.lds + pg8::MOE_HIST_OFF) + 64;
    if (F.tid == 0) { int sacc = 0;
#pragma unroll 1
        for (int e = 0; e < NE; ++e) { ltpre[e] = sacc; sacc += (ltot[e] + 255) >> 8; } }
    __syncthreads();
    const int TPB = (T + F.G - 1) / F.G, m0 = F.bid * TPB, m1 = min(T, m0 + TPB);
    if (F.wave == 0) {
        for (int q0 = 2 * m0; q0 < 2 * m1; q0 += 64) {
            const int q = q0 + F.lane; const bool ok = q < 2 * m1;
            int e = -1; if (ok) { const int sv = SEL[q >> 1]; e = (q & 1) ? ((sv >> 8) & 255) : (sv & 255); }
            int rank = 0, cntsame = 0;
#pragma unroll 1
            for (int k = 0; k < NE; ++k) { const unsigned long long bal = __ballot(e == k); if (e == k) { rank = __popcll(bal & ((1ull << F.lane) - 1ull)); cntsame = __popcll(bal); } }
            if (ok) { const int pos = lbase[e] + rank; list[e * T + pos] = q; lslot[q - 2 * m0] = 256 * ltpre[e] + pos; }
            __builtin_amdgcn_s_waitcnt(0);
            if (ok && rank == cntsame - 1) lbase[e] += cntsame;
            __builtin_amdgcn_s_waitcnt(0);
        }
    }
    __syncthreads();
    {
        const unsigned char* AB8 = opq(p.ws) + WS_AB; unsigned char* ABS = opq(p.ws) + WS_ABS;
        const int nt_ = m1 - m0;
        for (int t0 = F.wave; t0 < nt_; t0 += 4 * NWAVES) {
            u32x4 r0[4], r1[4];
#pragma unroll
            for (int k = 0; k < 4; ++k) { const int tt = t0 + k * NWAVES; if (tt < nt_) { const u32x4* src = (const u32x4*)(AB8 + (size_t)(m0 + tt) * D) + F.lane; r0[k] = src[0]; r1[k] = src[64]; } }
#pragma unroll
            for (int k = 0; k < 4; ++k) { const int tt = t0 + k * NWAVES; if (tt < nt_) {
#pragma unroll
                for (int jj = 0; jj < 2; ++jj) { u32x4* dst = (u32x4*)(ABS + (size_t)lslot[2 * tt + jj] * D) + F.lane; dst[0] = r0[k]; dst[64] = r1[k]; } } }
        }
    }
}

constexpr int H1LD = 8192, C_ZA = 3072, C_QB = 4096, C_FB = 5120, C_IB = 6144, C_GB = 7168;
constexpr size_t G_U0 = 0;
constexpr size_t G_WM = 32 * MiB;
constexpr size_t G_QD = 48 * MiB;
constexpr size_t G_KDT = 64 * MiB;
constexpr size_t G_QK = 80 * MiB;
constexpr size_t G_CD = 88 * MiB;
constexpr size_t H_QD = 89 * MiB;
constexpr size_t H_KI = 105 * MiB;
constexpr size_t H_KDT = 121 * MiB;
constexpr size_t H_IT = 137 * MiB;
constexpr size_t H_CD = 153 * MiB;
constexpr size_t O_A = 155 * MiB;
constexpr size_t O_B = 171 * MiB;
static_assert(O_B + 16 * MiB <= 216 * MiB, "mixer-0 scratch");

__device__ __forceinline__ f32x4 mfma32(bf16x8 a, bf16x8 b, f32x4 c) { return __builtin_amdgcn_mfma_f32_16x16x32_bf16(a, b, c, 0, 0, 0); }
__device__ __forceinline__ f32x4 mfma16(bf16x4 a, bf16x4 b, f32x4 c) { const bf16x8 a8 = {a[0], a[1], a[2], a[3], 0, 0, 0, 0}, b8 = {b[0], b[1], b[2], b[3], 0, 0, 0, 0}; return __builtin_amdgcn_mfma_f32_16x16x32_bf16(a8, b8, c, 0, 0, 0); }
__device__ __forceinline__ bf16x8 pack8(f32x4 lo, f32x4 hi) {
    u32x4 w; w.x = cvt_pk_bf16(lo[0], lo[1]); w.y = cvt_pk_bf16(lo[2], lo[3]); w.z = cvt_pk_bf16(hi[0], hi[1]); w.w = cvt_pk_bf16(hi[2], hi[3]); return __builtin_bit_cast(bf16x8, w);
}
__device__ __forceinline__ bf16x4 pack4(f32x4 v) { u32x2 w; w.x = cvt_pk_bf16(v[0], v[1]); w.y = cvt_pk_bf16(v[2], v[3]); return __builtin_bit_cast(bf16x4, w); }
__device__ __forceinline__ bf16x8 frag_perm(const LAS bf16_t* rowp, int col) {
    const u32x2 lo = *(const LAS u32x2*)(rowp + col), hi = *(const LAS u32x2*)(rowp + col + 16);
    u32x4 w; w.x = lo.x; w.y = lo.y; w.z = hi.x; w.w = hi.y; return __builtin_bit_cast(bf16x8, w);
}

__device__ __forceinline__ void gdn_pre_pair(const Params& p, const Frame& F, int unit0, int unit1) {
    const int hb = F.wave >> 2, w4 = F.wave & 3, t8 = F.tid & 255, lane = F.lane, fr = lane & 15, g = lane >> 4;
    const int unit = hb ? unit1 : unit0;
    const bool active = unit < 1024;
    const int bh = unit >> 5, ci = unit & 31, b = bh >> 3, h = bh & 7;
    const int tok0 = b * SEQ + ci * 64;
    LAS unsigned char* hl = F.lds + hb * 72192;
    LAS bf16_t* Qb = (LAS bf16_t*)(hl);
    LAS bf16_t* Kb = (LAS bf16_t*)(hl + 17408);
    LAS bf16_t* RVt = (LAS bf16_t*)(hl + 34816);
    LAS bf16_t* RKt = (LAS bf16_t*)(hl + 53248);
    LAS float* sc_g = (LAS float*)(hl + 71680);
    LAS float* sc_b = sc_g + 64;
    LAS float* Lm = (LAS float*)(hl);
    LAS bf16_t* Tb = (LAS bf16_t*)(hl + 17408);
    const bf16_t* H1 = (const bf16_t*)(opq(p.ws) + WS_H1);
    const float* BA = (const float*)(opq(p.ws) + WS_BA);
    unsigned char* scr = opq(p.ws) + WS_SCR;
    if (active) {
        if (t8 < 192) {
            const int sec = t8 >> 6, c2 = (t8 & 63) * 2;
            const int col = sec * 1024 + h * 128 + c2;
            const float* cw = p.in[I_EV_CONV] + col;
            const float w0a = cw[0], w0b = cw[1], w1a = cw[3072], w1b = cw[3073], w2a = cw[6144], w2b = cw[6145], w3a = cw[9216], w3b = cw[9217];
            float xa[3], xb[3];
#pragma unroll
            for (int k = 0; k < 3; ++k) { const int s = ci * 64 - 3 + k; unsigned v = 0u; if (s >= 0) v = *(const unsigned*)(H1 + (size_t)(b * SEQ + s) * H1LD + col); xa[k] = bflo(v); xb[k] = bfhi(v); }
#pragma unroll 1
            for (int q2 = 0; q2 < 2; ++q2) {
                unsigned vv[32];
#pragma unroll
                for (int tl = 0; tl < 32; ++tl) vv[tl] = *(const unsigned*)(H1 + (size_t)(tok0 + 32 * q2 + tl) * H1LD + col);
#pragma unroll
                for (int t2 = 0; t2 < 32; ++t2) {
                    const int tl = 32 * q2 + t2;
                    const float x3a = bflo(vv[t2]), x3b = bfhi(vv[t2]);
                    float ya = w0a * xa[0] + w1a * xa[1] + w2a * xa[2] + w3a * x3a, yb = w0b * xb[0] + w1b * xb[1] + w2b * xb[2] + w3b * x3b;
                    xa[0] = xa[1]; xa[1] = xa[2]; xa[2] = x3a; xb[0] = xb[1]; xb[1] = xb[2]; xb[2] = x3b;
                    ya = siluf_(ya); yb = siluf_(yb);
                    if (sec == 0) *(LAS unsigned*)(Qb + tl * 136 + c2) = pk2(ya, yb);
                    else if (sec == 1) *(LAS unsigned*)(Kb + tl * 136 + c2) = pk2(ya, yb);
                    else { const float be = sigmoidf_(BA[(size_t)(tok0 + tl) * 16 + h]); RVt[c2 * 72 + tl] = (bf16_t)f2bf(ya * be); RVt[(c2 + 1) * 72 + tl] = (bf16_t)f2bf(yb * be); }
                }
            }
        } else {
            const int t = tok0 + lane;
            const float ba = BA[(size_t)t * 16 + h], aa = BA[(size_t)t * 16 + 8 + h];
            const float xx = aa + p.in[I_EV_DTB][h];
            const float sp = xx > 20.f ? xx : log1pf(expf(xx));
            float gg = -expf(p.in[I_EV_ALOG][h]) * sp;
            gg += dpp_f<0x111>(gg); gg += dpp_f<0x112>(gg); gg += dpp_f<0x114>(gg); gg += dpp_f<0x118>(gg);
            { const float t0 = __builtin_bit_cast(float, __builtin_amdgcn_readlane(__builtin_bit_cast(int, gg), 15)), t1 = __builtin_bit_cast(float, __builtin_amdgcn_readlane(__builtin_bit_cast(int, gg), 31)),
                          t2 = __builtin_bit_cast(float, __builtin_amdgcn_readlane(__builtin_bit_cast(int, gg), 47));
              gg += (lane >= 16 ? t0 : 0.f) + (lane >= 32 ? t1 : 0.f) + (lane >= 48 ? t2 : 0.f); }
            sc_g[lane] = gg; sc_b[lane] = sigmoidf_(ba);
        }
    }
    __syncthreads();
    if (active) {
        bf16_t* QDg = (bf16_t*)(scr + G_QD) + (size_t)unit * 64 * 128;
#pragma unroll 2
        for (int rr = 0; rr < 16; ++rr) {
            const int r = w4 * 16 + rr;
            const unsigned qv = *(const LAS unsigned*)(Qb + r * 136 + 2 * lane), kv = *(const LAS unsigned*)(Kb + r * 136 + 2 * lane);
            const float q0 = bflo(qv), q1 = bfhi(qv), k0 = bflo(kv), k1 = bfhi(kv);
            const float sq = wave_sum(q0 * q0 + q1 * q1), sk = wave_sum(k0 * k0 + k1 * k1);
            const float rq = rsqrtf(sq + RMS_EPS) * 0.08838834764831845f, rk = rsqrtf(sk + RMS_EPS);
            const float gc = sc_g[r], be = sc_b[r], eg = expf(gc);
            const float qn0 = q0 * rq, qn1 = q1 * rq, kn0 = k0 * rk, kn1 = k1 * rk;
            *(LAS unsigned*)(Qb + r * 136 + 2 * lane) = pk2(qn0, qn1);
            *(LAS unsigned*)(Kb + r * 136 + 2 * lane) = pk2(kn0, kn1);
            RKt[(2 * lane) * 72 + r] = (bf16_t)f2bf(kn0 * be * eg); RKt[(2 * lane + 1) * 72 + r] = (bf16_t)f2bf(kn1 * be * eg);
            *(unsigned*)(QDg + r * 128 + 2 * lane) = pk2(qn0 * eg, qn1 * eg);
        }
    }
    __syncthreads();
    f32x4 kk[4];
    if (active) {
        {
            bf16_t* KDt = (bf16_t*)(scr + G_KDT) + (size_t)unit * 128 * 64;
            const float gl = sc_g[63];
#pragma unroll
            for (int it = 0; it < 4; ++it) { const int idx = t8 + 256 * it, f = idx >> 3, c0 = (idx & 7) * 8;
                float v[8];
#pragma unroll
                for (int i = 0; i < 8; ++i) v[i] = bf2f(Kb[(c0 + i) * 136 + f]) * expf(gl - sc_g[c0 + i]);
                u32x4 w; w.x = pk2(v[0], v[1]); w.y = pk2(v[2], v[3]); w.z = pk2(v[4], v[5]); w.w = pk2(v[6], v[7]);
                *(u32x4*)(KDt + f * 64 + c0) = w; }
        }
        const int mt = w4;
        bf16_t* QKm = (bf16_t*)(scr + G_QK) + (size_t)unit * 64 * 64;
        bf16x8 a[4];
#pragma unroll
        for (int kb = 0; kb < 4; ++kb) a[kb] = *(const LAS bf16x8*)(Kb + (16 * mt + fr) * 136 + 32 * kb + 8 * g);
#pragma unroll
        for (int nt = 0; nt < 4; ++nt) {
            f32x4 c = (f32x4){0.f, 0.f, 0.f, 0.f}, c2 = (f32x4){0.f, 0.f, 0.f, 0.f};
#pragma unroll
            for (int kb = 0; kb < 4; ++kb) { const bf16x8 bq = *(const LAS bf16x8*)(Qb + (16 * nt + fr) * 136 + 32 * kb + 8 * g), bk = *(const LAS bf16x8*)(Kb + (16 * nt + fr) * 136 + 32 * kb + 8 * g);
                c = mfma32(a[kb], bq, c); c2 = mfma32(a[kb], bk, c2); }
            const int cj = 16 * nt + fr; const float gcol = sc_g[cj];
            {
                float v[4];
#pragma unroll
                for (int r = 0; r < 4; ++r) { const int j = 16 * mt + 4 * g + r; v[r] = (cj >= j) ? expf(gcol - sc_g[j]) * c[r] : 0.f; }
                u32x2 w; w.x = pk2(v[0], v[1]); w.y = pk2(v[2], v[3]);
                *(u32x2*)(QKm + cj * 64 + 16 * mt + 4 * g) = w;
            }
#pragma unroll
            for (int r = 0; r < 4; ++r) { const int i = 16 * mt + 4 * g + r; kk[nt][r] = (i > cj) ? sc_b[i] * expf(sc_g[i] - gcol) * c2[r] : 0.f; }
        }
    }
    __syncthreads();
    if (active) {
#pragma unroll
        for (int nt = 0; nt < 4; ++nt)
#pragma unroll
            for (int r = 0; r < 4; ++r) Lm[(16 * w4 + 4 * g + r) * 68 + 16 * nt + fr] = kk[nt][r];
    }
    __syncthreads();
    if (active && w4 == 0) {
        float t[64];
#pragma unroll
        for (int i = 0; i < 64; ++i) t[i] = 0.f;
#pragma unroll
        for (int i = 0; i < 64; ++i) {
            float a0 = (i == lane) ? 1.f : 0.f, a1 = 0.f, a2 = 0.f, a3 = 0.f;
#pragma unroll
            for (int jj = 0; jj < (i + 3) / 4; ++jj) { const f32x4 lv = *(const LAS f32x4*)(Lm + i * 68 + 4 * jj);
                a0 -= lv[0] * t[4 * jj]; a1 -= lv[1] * t[4 * jj + 1]; a2 -= lv[2] * t[4 * jj + 2]; a3 -= lv[3] * t[4 * jj + 3]; }
            t[i] = (a0 + a1) + (a2 + a3);
        }
#pragma unroll
        for (int i = 0; i < 64; ++i) Tb[i * 72 + lane] = (bf16_t)f2bf(t[i]);
    }
    __syncthreads();
    if (active) {
        f32x4* U0f = (f32x4*)(scr + G_U0) + (size_t)unit * 8 * 4 * 64;
        bf16_t* Wm = (bf16_t*)(scr + G_WM) + (size_t)unit * 64 * 128;
#pragma unroll
        for (int hh = 0; hh < 2; ++hh) {
            const int ct = w4 + 4 * hh;
            bf16x8 bv[2], ak[2];
#pragma unroll
            for (int k = 0; k < 2; ++k) { bv[k] = *(const LAS bf16x8*)(RVt + (16 * ct + fr) * 72 + 32 * k + 8 * g); ak[k] = *(const LAS bf16x8*)(RKt + (16 * ct + fr) * 72 + 32 * k + 8 * g); }
#pragma unroll
            for (int mt = 0; mt < 4; ++mt) {
                f32x4 c = (f32x4){0.f, 0.f, 0.f, 0.f}, c2 = (f32x4){0.f, 0.f, 0.f, 0.f};
#pragma unroll
                for (int k = 0; k < 2; ++k) { const bf16x8 tt = *(const LAS bf16x8*)(Tb + (16 * mt + fr) * 72 + 32 * k + 8 * g); c = mfma32(tt, bv[k], c); c2 = mfma32(ak[k], tt, c2); }
                U0f[(ct * 4 + mt) * 64 + lane] = c;
                u32x2 w; w.x = pk2(-c2[0], -c2[1]); w.y = pk2(-c2[2], -c2[3]);
                *(u32x2*)(Wm + (16 * mt + fr) * 128 + 16 * ct + 4 * g) = w;
            }
        }
        if (t8 == 0) ((float*)(scr + G_CD))[unit] = expf(sc_g[63]);
    }
    __syncthreads();
}

__device__ __forceinline__ void hgrn_pre_unit(const Params& p, const Frame& F, int tc) {
    const int col = 2 * F.tid, h = col >> 7, f = col & 127;
    const float* lbl = p.in[I_LBLOG];
    float lb[2];
#pragma unroll
    for (int k = 0; k < 2; ++k) { const float l0 = lbl[col + k], l1 = lbl[1024 + col + k], l2 = lbl[2048 + col + k]; const float m = fmaxf(l0, fmaxf(l1, l2));
        const float e0 = expf(l0 - m), e1 = expf(l1 - m), e2 = expf(l2 - m); lb[k] = e0 / (e0 + e1 + e2); }
    const int t0 = tc * 16, b = t0 / SEQ, chunk = (t0 % SEQ) >> 4, bh = b * 8 + h;
    const bf16_t* H1 = (const bf16_t*)(opq(p.ws) + WS_H1);
    unsigned char* scr = opq(p.ws) + WS_SCR;
    float bc0[16], bc1[16], kk0[16], kk1[16]; unsigned iv[16];
    float cum0 = 0.f, cum1 = 0.f;
#pragma unroll
    for (int c = 0; c < 16; ++c) {
        const size_t row = (size_t)(t0 + c);
        const unsigned qv = *(const unsigned*)(H1 + row * H1LD + C_QB + col), fv = *(const unsigned*)(H1 + row * H1LD + C_FB + col);
        iv[c] = *(const unsigned*)(H1 + row * H1LD + C_IB + col);
        const float f0 = lb[0] + (1.f - lb[0]) * sigmoidf_(bflo(fv)), f1 = lb[1] + (1.f - lb[1]) * sigmoidf_(bfhi(fv));
        cum0 += logf(f0); cum1 += logf(f1);
        bc0[c] = cum0; bc1[c] = cum1; kk0[c] = 1.f - f0; kk1[c] = 1.f - f1;
        *(unsigned*)((bf16_t*)(scr + H_QD) + row * 1024 + col) = pk2(bflo(qv) * expf(cum0), bfhi(qv) * expf(cum1));
        *(unsigned*)((bf16_t*)(scr + H_KI) + row * 1024 + col) = pk2(kk0[c] * expf(-cum0), kk1[c] * expf(-cum1));
    }
    unsigned kd0[8], kd1[8], i0[8], i1[8];
#pragma unroll
    for (int c = 0; c < 16; c += 2) {
        kd0[c >> 1] = pk2(kk0[c] * expf(cum0 - bc0[c]), kk0[c + 1] * expf(cum0 - bc0[c + 1]));
        kd1[c >> 1] = pk2(kk1[c] * expf(cum1 - bc1[c]), kk1[c + 1] * expf(cum1 - bc1[c + 1]));
        i0[c >> 1] = (iv[c] & 0xffffu) | (iv[c + 1] << 16);
        i1[c >> 1] = (iv[c] >> 16) | (iv[c + 1] & 0xffff0000u);
    }
    const size_t base = ((size_t)(bh * 128 + chunk) * 128 + f) * 16;
    u32x4* kd = (u32x4*)((bf16_t*)(scr + H_KDT) + base); u32x4* it = (u32x4*)((bf16_t*)(scr + H_IT) + base);
    kd[0] = (u32x4){kd0[0], kd0[1], kd0[2], kd0[3]}; kd[1] = (u32x4){kd0[4], kd0[5], kd0[6], kd0[7]};
    kd[2] = (u32x4){kd1[0], kd1[1], kd1[2], kd1[3]}; kd[3] = (u32x4){kd1[4], kd1[5], kd1[6], kd1[7]};
    it[0] = (u32x4){i0[0], i0[1], i0[2], i0[3]}; it[1] = (u32x4){i0[4], i0[5], i0[6], i0[7]};
    it[2] = (u32x4){i1[0], i1[1], i1[2], i1[3]}; it[3] = (u32x4){i1[4], i1[5], i1[6], i1[7]};
    *(f32x2*)((float*)(scr + H_CD) + (size_t)(bh * 128 + chunk) * 128 + f) = (f32x2){expf(cum0), expf(cum1)};
}

__device__ __forceinline__ void p2_pre(const Params& p, const Frame& F0) {
    const Frame F = refresh(F0);
    for (int u = F.bid; u < 1024; u += 2 * F.G) gdn_pre_pair(p, F, u, u + F.G);
    for (int u = F.bid; u < 512; u += F.G) hgrn_pre_unit(p, F, u);
}

__device__ __forceinline__ void gdn_scan(const Params& p, const Frame& F0, int bh) {
    const Frame F = refresh(F0);
    const int lane = F.lane, fr = lane & 15, g = lane >> 4, wave = F.wave, b = bh >> 3, h = bh & 7;
    unsigned char* scr = opqg(p.ws) + WS_SCR;
    constexpr int BUFB = 62464, OFF_QD = 17408, OFF_KDT = 34816, OFF_QK = 53248;
    const bf16_t* gWM = (const bf16_t*)(scr + G_WM); const bf16_t* gQD = (const bf16_t*)(scr + G_QD);
    const bf16_t* gKDT = (const bf16_t*)(scr + G_KDT); const bf16_t* gQK = (const bf16_t*)(scr + G_QK);
    const f32x4* gU0 = (const f32x4*)(scr + G_U0); const float* gCD = (const float*)(scr + G_CD);
    bf16_t* OA = (bf16_t*)(scr + O_A);
    u32x4 rw[2], rq[2], rk[2], rqk; f32x4 u0c[4], u0n[4];
#define GS_ISSUE(u) do { _Pragma("unroll") for (int i = 0; i < 2; ++i) { const int idx = F.tid + 512 * i; \
        rw[i] = *(const u32x4*)(gWM + (size_t)(u) * 8192 + idx * 8); rq[i] = *(const u32x4*)(gQD + (size_t)(u) * 8192 + idx * 8); rk[i] = *(const u32x4*)(gKDT + (size_t)(u) * 8192 + idx * 8); } \
        rqk = *(const u32x4*)(gQK + (size_t)(u) * 4096 + F.tid * 8); \
        _Pragma("unroll") for (int mt = 0; mt < 4; ++mt) u0n[mt] = gU0[(((size_t)(u) * 8 + wave) * 4 + mt) * 64 + lane]; } while (0)
#define GS_WRITE(bufp) do { _Pragma("unroll") for (int i = 0; i < 2; ++i) { const int idx = F.tid + 512 * i; \
        *(LAS u32x4*)((bufp) + ((idx >> 4) * 136 + (idx & 15) * 8) * 2) = rw[i]; *(LAS u32x4*)((bufp) + OFF_QD + ((idx >> 4) * 136 + (idx & 15) * 8) * 2) = rq[i]; \
        *(LAS u32x4*)((bufp) + OFF_KDT + ((idx >> 3) * 72 + (idx & 7) * 8) * 2) = rk[i]; } \
        *(LAS u32x4*)((bufp) + OFF_QK + ((F.tid >> 3) * 72 + (F.tid & 7) * 8) * 2) = rqk; } while (0)
    f32x4 Sacc[8];
#pragma unroll
    for (int ft = 0; ft < 8; ++ft) Sacc[ft] = (f32x4){0.f, 0.f, 0.f, 0.f};
    GS_ISSUE(bh * 32);
    GS_WRITE(F.lds);
#pragma unroll
    for (int mt = 0; mt < 4; ++mt) u0c[mt] = u0n[mt];
    __syncthreads();
    float dec = ld_agent(gCD + bh * 32);
    for (int ci = 0; ci < 32; ++ci) {
        const int u = bh * 32 + ci;
        LAS unsigned char* buf = F.lds + (ci & 1) * BUFB;
        float decn = dec; if (ci + 1 < 32) decn = ld_agent(gCD + u + 1);
        if (ci + 1 < 32) GS_ISSUE(u + 1);
        const LAS bf16_t* WM = (const LAS bf16_t*)buf; const LAS bf16_t* QD = (const LAS bf16_t*)(buf + OFF_QD);
        const LAS bf16_t* KDT = (const LAS bf16_t*)(buf + OFF_KDT); const LAS bf16_t* QK = (const LAS bf16_t*)(buf + OFF_QK);
        bf16x8 Sbf[4];
#pragma unroll
        for (int kb = 0; kb < 4; ++kb) Sbf[kb] = pack8(Sacc[2 * kb], Sacc[2 * kb + 1]);
        f32x4 uacc[4], oacc[4];
#pragma unroll
        for (int mt = 0; mt < 4; ++mt) { uacc[mt] = u0c[mt]; oacc[mt] = (f32x4){0.f, 0.f, 0.f, 0.f}; }
        bf16x8 fa[8], fb[8];
#define GS_LD_UQ(dst, mt) do { _Pragma("unroll") for (int kb = 0; kb < 4; ++kb) { dst[kb] = frag_perm(WM + (16 * (mt) + fr) * 136, 32 * kb + 4 * g); dst[4 + kb] = frag_perm(QD + (16 * (mt) + fr) * 136, 32 * kb + 4 * g); } } while (0)
#define GS_MM_UQ(src, mt) do { _Pragma("unroll") for (int kb = 0; kb < 4; ++kb) { uacc[mt] = mfma32(src[kb], Sbf[kb], uacc[mt]); oacc[mt] = mfma32(src[4 + kb], Sbf[kb], oacc[mt]); } } while (0)
        GS_LD_UQ(fa, 0);
        GS_LD_UQ(fb, 1); __builtin_amdgcn_sched_barrier(0); GS_MM_UQ(fa, 0); __builtin_amdgcn_sched_barrier(0);
        GS_LD_UQ(fa, 2); __builtin_amdgcn_sched_barrier(0); GS_MM_UQ(fb, 1); __builtin_amdgcn_sched_barrier(0);
        GS_LD_UQ(fb, 3); __builtin_amdgcn_sched_barrier(0); GS_MM_UQ(fa, 2); __builtin_amdgcn_sched_barrier(0);
#pragma unroll
        for (int mt = 0; mt < 4; ++mt)
#pragma unroll
            for (int k = 0; k < 2; ++k) fa[2 * mt + k] = frag_perm(QK + (16 * mt + fr) * 72, 32 * k + 4 * g);
        __builtin_amdgcn_sched_barrier(0); GS_MM_UQ(fb, 3); __builtin_amdgcn_sched_barrier(0);
#undef GS_LD_UQ
#undef GS_MM_UQ
        bf16x8 ubf[2];
#pragma unroll
        for (int k = 0; k < 2; ++k) ubf[k] = pack8(uacc[2 * k], uacc[2 * k + 1]);
#pragma unroll
        for (int ft = 0; ft < 4; ++ft)
#pragma unroll
            for (int k = 0; k < 2; ++k) fb[2 * ft + k] = frag_perm(KDT + (16 * ft + fr) * 72, 32 * k + 4 * g);
        __builtin_amdgcn_sched_barrier(0);
#pragma unroll
        for (int mt = 0; mt < 4; ++mt)
#pragma unroll
            for (int k = 0; k < 2; ++k) oacc[mt] = mfma32(fa[2 * mt + k], ubf[k], oacc[mt]);
        __builtin_amdgcn_sched_barrier(0);
#pragma unroll
        for (int ft = 0; ft < 4; ++ft)
#pragma unroll
            for (int k = 0; k < 2; ++k) fa[2 * ft + k] = frag_perm(KDT + (16 * (4 + ft) + fr) * 72, 32 * k + 4 * g);
        __builtin_amdgcn_sched_barrier(0);
#pragma unroll
        for (int ft = 0; ft < 4; ++ft) {
            Sacc[ft] = Sacc[ft] * dec;
#pragma unroll
            for (int k = 0; k < 2; ++k) Sacc[ft] = mfma32(fb[2 * ft + k], ubf[k], Sacc[ft]);
        }
        __builtin_amdgcn_sched_barrier(0);
#pragma unroll
        for (int ft = 0; ft < 4; ++ft) {
            Sacc[4 + ft] = Sacc[4 + ft] * dec;
#pragma unroll
            for (int k = 0; k < 2; ++k) Sacc[4 + ft] = mfma32(fa[2 * ft + k], ubf[k], Sacc[4 + ft]);
        }
        dec = decn;
        {
            bf16_t* orow = OA + (size_t)(b * SEQ + ci * 64) * 1024 + h * 128 + 16 * wave + fr;
#pragma unroll
            for (int mt = 0; mt < 4; ++mt)
#pragma unroll
                for (int r = 0; r < 4; ++r) orow[(size_t)(16 * mt + 4 * g + r) * 1024] = (bf16_t)f2bf(oacc[mt][r]);
        }
        if (ci + 1 < 32) { GS_WRITE(F.lds + ((ci + 1) & 1) * BUFB);
#pragma unroll
            for (int mt = 0; mt < 4; ++mt) u0c[mt] = u0n[mt]; }
        asm volatile("s_waitcnt lgkmcnt(0)" ::: "memory"); __builtin_amdgcn_s_barrier();
    }
#undef GS_ISSUE
#undef GS_WRITE
}

__device__ __forceinline__ void hgrn_scan(const Params& p, const Frame& F0, int bh) {
    const Frame F = refresh(F0);
    const int lane = F.lane, fr = lane & 15, g = lane >> 4, wave = F.wave, b = bh >> 3, h = bh & 7;
    unsigned char* scr = opqg(p.ws) + WS_SCR;
    constexpr int BUFB = 61440, OFF_KI = 17408, OFF_KDT = 34816, OFF_CD = 59392;
    const bf16_t* gQD = (const bf16_t*)(scr + H_QD); const bf16_t* gKI = (const bf16_t*)(scr + H_KI);
    const bf16_t* gKDT = (const bf16_t*)(scr + H_KDT) + (size_t)bh * 128 * 128 * 16; const bf16_t* gIT = (const bf16_t*)(scr + H_IT) + (size_t)bh * 128 * 128 * 16;
    const float* gCD = (const float*)(scr + H_CD) + (size_t)bh * 128 * 128;
    bf16_t* OB = (bf16_t*)(scr + O_B);
    u32x4 rq[2], rk[2], rd[2], rc; u32x2 itn[4], itc[4];
#define HS_ISSUE(grp) do { _Pragma("unroll") for (int i = 0; i < 2; ++i) { const int idx = F.tid + 512 * i; const size_t go = (size_t)(b * SEQ + (grp) * 64 + (idx >> 4)) * 1024 + h * 128 + (idx & 15) * 8; \
        rq[i] = *(const u32x4*)(gQD + go); rk[i] = *(const u32x4*)(gKI + go); rd[i] = *(const u32x4*)(gKDT + (size_t)(grp) * 8192 + idx * 8); } \
        if (F.tid < 128) rc = *(const u32x4*)(gCD + (size_t)(grp) * 512 + F.tid * 4); \
        _Pragma("unroll") for (int sc = 0; sc < 4; ++sc) itn[sc] = *(const u32x2*)(gIT + ((size_t)((grp) * 4 + sc) * 128 + 16 * wave + fr) * 16 + 4 * g); } while (0)
#define HS_WRITE(bufp) do { _Pragma("unroll") for (int i = 0; i < 2; ++i) { const int idx = F.tid + 512 * i; \
        *(LAS u32x4*)((bufp) + ((idx >> 4) * 136 + (idx & 15) * 8) * 2) = rq[i]; *(LAS u32x4*)((bufp) + OFF_KI + ((idx >> 4) * 136 + (idx & 15) * 8) * 2) = rk[i]; \
        *(LAS u32x4*)((bufp) + OFF_KDT + ((idx >> 1) * 24 + (idx & 1) * 8) * 2) = rd[i]; } \
        if (F.tid < 128) *(LAS u32x4*)((bufp) + OFF_CD + F.tid * 16) = rc; } while (0)
    f32x4 Sacc[8];
#pragma unroll
    for (int ft = 0; ft < 8; ++ft) Sacc[ft] = (f32x4){0.f, 0.f, 0.f, 0.f};
    HS_ISSUE(0);
    HS_WRITE(F.lds);
#pragma unroll
    for (int sc = 0; sc < 4; ++sc) itc[sc] = itn[sc];
    __syncthreads();
    for (int grp = 0; grp < 32; ++grp) {
        LAS unsigned char* buf = F.lds + (grp & 1) * BUFB;
        if (grp + 1 < 32) HS_ISSUE(grp + 1);
        const LAS bf16_t* QD = (const LAS bf16_t*)buf; const LAS bf16_t* KI = (const LAS bf16_t*)(buf + OFF_KI);
        const LAS bf16_t* KDT = (const LAS bf16_t*)(buf + OFF_KDT); const LAS float* CD = (const LAS float*)(buf + OFF_CD);
        bf16x8 qfA[4], kfA[4], qfB[4], kfB[4];
#define HS_LDS(sc, X) do { _Pragma("unroll") for (int kb = 0; kb < 4; ++kb) { qf##X[kb] = frag_perm(QD + (16 * (sc) + fr) * 136, 32 * kb + 4 * g); kf##X[kb] = frag_perm(KI + (16 * (sc) + fr) * 136, 32 * kb + 4 * g); } \
            } while (0)
#define HS_SUB(sc, X) do { \
            f32x4 dd[8]; bf16x4 kd[8];        \
            _Pragma("unroll") for (int ft = 0; ft < 8; ++ft) { dd[ft] = *(const LAS f32x4*)(CD + (sc) * 128 + 16 * ft + 4 * g); kd[ft] = *(const LAS bf16x4*)(KDT + (((sc) * 128) + 16 * ft + fr) * 24 + 4 * g); } \
            bf16x8 Sbf[4]; \
            _Pragma("unroll") for (int kb = 0; kb < 4; ++kb) Sbf[kb] = pack8(Sacc[2 * kb], Sacc[2 * kb + 1]); \
            f32x4 o = (f32x4){0.f, 0.f, 0.f, 0.f}, pT = (f32x4){0.f, 0.f, 0.f, 0.f}; \
            _Pragma("unroll") for (int kb = 0; kb < 4; ++kb) { o = mfma32(qf##X[kb], Sbf[kb], o); pT = mfma32(kf##X[kb], qf##X[kb], pT); } \
            _Pragma("unroll") for (int r = 0; r < 4; ++r) pT[r] = (fr >= 4 * g + r) ? pT[r] : 0.f; \
            const bf16x4 itf = __builtin_bit_cast(bf16x4, itc[sc]); \
            o = mfma16(pack4(pT), itf, o); \
            _Pragma("unroll") for (int ft = 0; ft < 8; ++ft) Sacc[ft] = mfma16(kd[ft], itf, Sacc[ft] * dd[ft]); \
            bf16_t* orow = OB + (size_t)(b * SEQ + grp * 64 + (sc) * 16) * 1024 + h * 128 + 16 * wave + fr; \
            _Pragma("unroll") for (int r = 0; r < 4; ++r) orow[(size_t)(4 * g + r) * 1024] = (bf16_t)f2bf(o[r]); \
        } while (0)
        HS_LDS(0, A); __builtin_amdgcn_sched_barrier(0);
        HS_LDS(1, B); __builtin_amdgcn_sched_barrier(0); HS_SUB(0, A); __builtin_amdgcn_sched_barrier(0);
        HS_LDS(2, A); __builtin_amdgcn_sched_barrier(0); HS_SUB(1, B); __builtin_amdgcn_sched_barrier(0);
        HS_LDS(3, B); __builtin_amdgcn_sched_barrier(0); HS_SUB(2, A); __builtin_amdgcn_sched_barrier(0);
        HS_SUB(3, B);
#undef HS_LDS
#undef HS_SUB
        if (grp + 1 < 32) { HS_WRITE(F.lds + ((grp + 1) & 1) * BUFB);
#pragma unroll
            for (int sc = 0; sc < 4; ++sc) itc[sc] = itn[sc]; }
        asm volatile("s_waitcnt lgkmcnt(0)" ::: "memory"); __builtin_amdgcn_s_barrier();
    }
#undef HS_ISSUE
#undef HS_WRITE
}

__device__ __forceinline__ void p4_gate(const Params& p, const Frame& F0) {
    const Frame F = refresh(F0);
    const int gw = F.bid * NWAVES + F.wave, NGW = F.G * NWAVES, hs = F.lane >> 4, e0 = (F.lane & 15) * 8;
    unsigned char* scr = opq(p.ws) + WS_SCR;
    const bf16_t* H1 = (const bf16_t*)(opq(p.ws) + WS_H1); bf16_t* OC = (bf16_t*)(opq(p.ws) + WS_OC);
    for (int m = gw; m < T; m += NGW) {
#pragma unroll
        for (int rr = 0; rr < 4; ++rr) {
            const int hh = rr * 4 + hs;
            const bool isb = hh >= 8; const int hd = hh & 7;
            const bf16_t* osrc = (const bf16_t*)(scr + (isb ? O_B : O_A)) + (size_t)m * 1024 + hd * 128 + e0;
            const bf16_t* zsrc = H1 + (size_t)m * H1LD + (isb ? C_GB : C_ZA) + hd * 128 + e0;
            const float* gsrc = (isb ? p.in[I_EV_HGRNN] : p.in[I_EV_GDNN]) + e0;
            const u32x4 ov = *(const u32x4*)osrc, zv = *(const u32x4*)zsrc;
            const f32x4 g0 = *(const f32x4*)gsrc, g1 = *(const f32x4*)(gsrc + 4);
            float x[8] = {bflo(ov.x), bfhi(ov.x), bflo(ov.y), bfhi(ov.y), bflo(ov.z), bfhi(ov.z), bflo(ov.w), bfhi(ov.w)};
            const float z[8] = {bflo(zv.x), bfhi(zv.x), bflo(zv.y), bfhi(zv.y), bflo(zv.z), bfhi(zv.z), bflo(zv.w), bfhi(zv.w)};
            const float gn[8] = {g0[0], g0[1], g0[2], g0[3], g1[0], g1[1], g1[2], g1[3]};
            float ss = 0.f;
#pragma unroll
            for (int i = 0; i < 8; ++i) ss += x[i] * x[i];
            ss = row16_sum(ss);
            const float rinv = rsqrtf(ss * (1.f / 128.f) + RMS_EPS);
#pragma unroll
            for (int i = 0; i < 8; ++i) x[i] = x[i] * rinv * gn[i] * siluf_(z[i]);
            u32x2 w; w.x = pk4_fp8(x[0] * A_PRE, x[1] * A_PRE, x[2] * A_PRE, x[3] * A_PRE); w.y = pk4_fp8(x[4] * A_PRE, x[5] * A_PRE, x[6] * A_PRE, x[7] * A_PRE);
            *(u32x2*)((unsigned char*)OC + (size_t)m * 2048 + hh * 128 + e0) = w;
        }
    }
}

constexpr int H3LD = 6144;
constexpr size_t A_QR = 0;
constexpr size_t A_KR = 32 * MiB;
constexpr size_t A_VT = 64 * MiB;
constexpr size_t A_OG = 96 * MiB;
constexpr size_t A_LSE = 120 * MiB;
constexpr size_t A_KPART = 121 * MiB;
constexpr float QSCALE = 0.08838834764831845f * 1.4426950408889634f;
__device__ __forceinline__ int head_dil_log2(int hd) { return hd < 4 ? 0 : hd < 8 ? 2 : hd < 12 ? 4 : 0; }
__device__ __forceinline__ int posp(int s, int dl) { return ((s & ((1 << dl) - 1)) << (11 - dl)) + (s >> dl); }

__device__ __forceinline__ void rope_unit(const Params& p, const Frame& F, int unit) {
    const int hh = unit & 1, st = (unit >> 1) & 31, b = unit >> 6, s0 = st * 64;
    const bf16_t* H3 = (const bf16_t*)(opq(p.ws) + WS_H1);
    unsigned char* scr = opq(p.ws) + WS_SCR;
    bf16_t* QR = (bf16_t*)(scr + A_QR); bf16_t* KR = (bf16_t*)(scr + A_KR); bf16_t* VT = (bf16_t*)(scr + A_VT); float* KPART = (float*)(scr + A_KPART);
    LAS float* KS = (LAS float*)F.lds;
    LAS bf16_t* VL = (LAS bf16_t*)(F.lds + 33280);
    const int tok2 = F.tid >> 4, pj = (F.tid & 15) * 4;
    float cs[2][4], sn[2][4];
#pragma unroll
    for (int tt = 0; tt < 2; ++tt)
#pragma unroll
        for (int i = 0; i < 4; ++i) { const float inv = powf(10000.0f, -(float)(pj + i) * (1.0f / 64.0f)); const float ang = (float)(s0 + tok2 + 32 * tt) * inv; sincosf(ang, &sn[tt][i], &cs[tt][i]); }
    u32x2 na[2][2], nc[2][2]; u32x4 nv[2];
#define RP_LOAD(hi_) do { const int hd_ = hh * 8 + (hi_); \
        const int qcol_ = hd_ < 12 ? hd_ * 128 : 4608 + (hd_ - 12) * 128, kcol_ = hd_ < 12 ? 1536 + hd_ * 128 : 5120 + (hd_ - 12) * 128, vcol_ = hd_ < 12 ? 3072 + hd_ * 128 : 5632 + (hd_ - 12) * 128; \
        _Pragma("unroll") for (int tt = 0; tt < 2; ++tt) { const size_t row_ = (size_t)(b * SEQ + s0 + tok2 + 32 * tt) * H3LD; \
            _Pragma("unroll") for (int qk = 0; qk < 2; ++qk) { const bf16_t* src_ = H3 + row_ + (qk ? kcol_ : qcol_) + pj; na[tt][qk] = *(const u32x2*)src_; nc[tt][qk] = *(const u32x2*)(src_ + 64); } } \
        _Pragma("unroll") for (int i = 0; i < 2; ++i) { const int idx = F.tid + 512 * i; nv[i] = *(const u32x4*)(H3 + (size_t)(b * SEQ + s0 + (idx >> 4)) * H3LD + vcol_ + (idx & 15) * 8); } } while (0)
    RP_LOAD(0);
    for (int hi = 0; hi < 8; ++hi) {
        const int hd = hh * 8 + hi, dl = head_dil_log2(hd);
        const size_t hb = (size_t)(b * 16 + hd) * 2048;
        u32x2 ca[2][2], cc[2][2]; u32x4 cv[2];
#pragma unroll
        for (int tt = 0; tt < 2; ++tt)
#pragma unroll
            for (int qk = 0; qk < 2; ++qk) { ca[tt][qk] = na[tt][qk]; cc[tt][qk] = nc[tt][qk]; }
        cv[0] = nv[0]; cv[1] = nv[1];
        if (hi + 1 < 8) RP_LOAD(hi + 1);
#pragma unroll
        for (int tt = 0; tt < 2; ++tt) {
            const int tl = tok2 + 32 * tt, s = s0 + tl; const size_t orow = (hb + posp(s, dl)) * 128;
#pragma unroll
            for (int qk = 0; qk < 2; ++qk) {
                const u32x2 a = ca[tt][qk], c = cc[tt][qk];
                const float x1[4] = {bflo(a.x), bfhi(a.x), bflo(a.y), bfhi(a.y)}, x2[4] = {bflo(c.x), bfhi(c.x), bflo(c.y), bfhi(c.y)};
                float y1[4], y2[4]; const float sc = qk ? 1.0f : QSCALE;
#pragma unroll
                for (int i = 0; i < 4; ++i) { y1[i] = (x1[i] * cs[tt][i] - x2[i] * sn[tt][i]) * sc; y2[i] = (x2[i] * cs[tt][i] + x1[i] * sn[tt][i]) * sc; }
                bf16_t* dst = (qk ? KR : QR) + orow + pj;
                u32x2 w1, w2; w1.x = pk2(y1[0], y1[1]); w1.y = pk2(y1[2], y1[3]); w2.x = pk2(y2[0], y2[1]); w2.y = pk2(y2[2], y2[3]);
                *(u32x2*)dst = w1; *(u32x2*)(dst + 64) = w2;
                if (qk && hd >= 12) {
#pragma unroll
                    for (int i = 0; i < 4; ++i) { KS[tl * 129 + pj + i] = y1[i]; KS[tl * 129 + 64 + pj + i] = y2[i]; }
                }
            }
        }
#pragma unroll
        for (int i = 0; i < 2; ++i) { const int idx = F.tid + 512 * i, tl = idx >> 4, pc = idx & 15;
            *(LAS u32x4*)(VL + tl * 136 + pc * 8) = cv[i]; }
        asm volatile("s_waitcnt lgkmcnt(0)" ::: "memory"); __builtin_amdgcn_s_barrier();
        if (hd >= 12 && F.tid < 128) { float sum = 0.f;
#pragma unroll 8
            for (int tl = 0; tl < 64; ++tl) sum += KS[tl * 129 + F.tid];
            KPART[((size_t)(b * 4 + hd - 12) * 32 + st) * 128 + F.tid] = sum; }
        {
            const int pp = posp(s0 + F.lane, dl);
#pragma unroll 4
            for (int i = 0; i < 16; ++i) { const int d = F.wave * 16 + i; VT[((size_t)(b * 16 + hd) * 128 + d) * 2048 + pp] = VL[F.lane * 136 + d]; }
        }
        asm volatile("s_waitcnt lgkmcnt(0)" ::: "memory"); __builtin_amdgcn_s_barrier();
    }
#undef RP_LOAD
}

template <int MODE>
__device__ __forceinline__ void attn_item(const Params& p, const Frame& F0, int b, int hd, int q0, int ktile_lo, int ktile_hi) {
    const Frame F = refresh(F0);
    const int lane = F.lane, fr = lane & 15, g = lane >> 4, wave = F.wave;
    unsigned char* scr = opq(p.ws) + WS_SCR;
    const size_t hb = (size_t)(b * 16 + hd);
    const bf16_t* Qg = (const bf16_t*)(scr + A_QR) + hb * 2048 * 128; const bf16_t* Kg = (const bf16_t*)(scr + A_KR) + hb * 2048 * 128; const bf16_t* Vg = (const bf16_t*)(scr + A_VT) + hb * 128 * 2048;
    constexpr int BUFB = 35840, OFF_V = 17408, OFF_KM = 71680;
    const int nq = q0 + 16 * wave + fr;
    bf16x8 qf[4];
#pragma unroll
    for (int kb = 0; kb < 4; ++kb) qf[kb] = *(const bf16x8*)(Qg + (size_t)nq * 128 + 32 * kb + 8 * g);
    unsigned selmask = 0u;
    if (MODE == 1) {
        const int qb = q0 >> 8, h = hd - 12;
        LAS float* KM = (LAS float*)(F.lds + OFF_KM);
        const float* KPART = (const float*)(scr + A_KPART) + (size_t)(b * 4 + h) * 32 * 128;
#pragma unroll
        for (int i = 0; i < 2; ++i) { const int idx = F.tid + 512 * i, jb = idx >> 7, d = idx & 127;
            KM[idx] = (KPART[(4 * jb + 0) * 128 + d] + KPART[(4 * jb + 1) * 128 + d]) + (KPART[(4 * jb + 2) * 128 + d] + KPART[(4 * jb + 3) * 128 + d]); }
        __syncthreads();
        float gate[8];
#pragma unroll
        for (int jb = 0; jb < 8; ++jb) { float s = 0.f;
#pragma unroll
            for (int kb = 0; kb < 4; ++kb) { const u32x4 qq = __builtin_bit_cast(u32x4, qf[kb]); const LAS float* km = KM + jb * 128 + 32 * kb + 8 * g;
                const f32x4 k0 = *(const LAS f32x4*)km, k1 = *(const LAS f32x4*)(km + 4);
                s += (bflo(qq.x) * k0[0] + bfhi(qq.x) * k0[1]) + (bflo(qq.y) * k0[2] + bfhi(qq.y) * k0[3]) + (bflo(qq.z) * k1[0] + bfhi(qq.z) * k1[1]) + (bflo(qq.w) * k1[2] + bfhi(qq.w) * k1[3]); }
            s += xor16_f(s); s = xor32_sum(s); gate[jb] = s; }
#pragma unroll
        for (int jb = 0; jb < 8; ++jb) { int rank = 0;
#pragma unroll
            for (int j2 = 0; j2 < 8; ++j2) if (j2 != jb && j2 < qb) rank += (gate[j2] > gate[jb] || (gate[j2] == gate[jb] && j2 < jb)) ? 1 : 0;
            if (jb < qb && rank < 3) selmask |= 1u << jb; }
        __syncthreads();
    }
    u32x4 rk[2], rv[2];
#define AT_ISSUE(kt) do { _Pragma("unroll") for (int i = 0; i < 2; ++i) { const int idx = F.tid + 512 * i; \
        rk[i] = *(const u32x4*)(Kg + (size_t)((kt) * 64 + (idx >> 4)) * 128 + (idx & 15) * 8); rv[i] = *(const u32x4*)(Vg + (size_t)(idx >> 3) * 2048 + (kt) * 64 + (idx & 7) * 8); } } while (0)
#define AT_WRITE(bufp) do { _Pragma("unroll") for (int i = 0; i < 2; ++i) { const int idx = F.tid + 512 * i; \
        *(LAS u32x4*)((bufp) + ((idx >> 4) * 136 + (idx & 15) * 8) * 2) = rk[i]; *(LAS u32x4*)((bufp) + OFF_V + ((idx >> 3) * 72 + (idx & 7) * 8) * 2) = rv[i]; } } while (0)
    f32x4 oacc[8];
#pragma unroll
    for (int dt = 0; dt < 8; ++dt) oacc[dt] = (f32x4){0.f, 0.f, 0.f, 0.f};
    float mrun = -1e30f, lrun = 0.f;
    AT_ISSUE(ktile_lo);
    AT_WRITE(F.lds);
    __syncthreads();
    for (int kt = ktile_lo; kt < ktile_hi; ++kt) {
        LAS unsigned char* buf = F.lds + ((kt - ktile_lo) & 1) * BUFB;
        if (kt + 1 < ktile_hi) AT_ISSUE(kt + 1);
        const LAS bf16_t* KL = (const LAS bf16_t*)buf; const LAS bf16_t* VL = (const LAS bf16_t*)(buf + OFF_V);
        f32x4 sT[4];
        {
            bf16x8 kf[16];
#pragma unroll
            for (int t4 = 0; t4 < 4; ++t4)
#pragma unroll
                for (int kb = 0; kb < 4; ++kb) kf[4 * t4 + kb] = *(const LAS bf16x8*)(KL + (16 * t4 + fr) * 136 + 32 * kb + 8 * g);
            __builtin_amdgcn_sched_barrier(0);
#pragma unroll
            for (int t4 = 0; t4 < 4; ++t4) { sT[t4] = (f32x4){0.f, 0.f, 0.f, 0.f};
#pragma unroll
                for (int kb = 0; kb < 4; ++kb) sT[t4] = mfma32(kf[4 * t4 + kb], qf[kb], sT[t4]); }
        }
        __builtin_amdgcn_sched_barrier(0);
        bf16x8 vf[16];
#pragma unroll
        for (int dt = 0; dt < 8; ++dt) { vf[2 * dt] = frag_perm(VL + (16 * dt + fr) * 72, 4 * g); vf[2 * dt + 1] = frag_perm(VL + (16 * dt + fr) * 72, 32 + 4 * g); }
        __builtin_amdgcn_sched_barrier(0);
        const int k0 = kt * 64; float mx = -1e30f;
        const float NEG = -__builtin_huge_valf();
#pragma unroll
        for (int t4 = 0; t4 < 4; ++t4)
#pragma unroll
            for (int r = 0; r < 4; ++r) { const int nk = k0 + 16 * t4 + 4 * g + r; bool v;
                if (MODE == 0) v = (nk <= nq) && (nq - nk <= 128);
                else v = ((k0 >> 8) == (q0 >> 8)) ? (nk <= nq) : (((selmask >> (k0 >> 8)) & 1u) != 0u);
                sT[t4][r] = v ? sT[t4][r] : NEG; mx = fmaxf(mx, sT[t4][r]); }
        mx = fmaxf(mx, xor16_f(mx)); mx = xor32_max(mx);
        const float mnew = fmaxf(mrun, mx), alpha = exp2f(mrun - mnew); mrun = mnew;
        float ps = 0.f;
#pragma unroll
        for (int t4 = 0; t4 < 4; ++t4)
#pragma unroll
            for (int r = 0; r < 4; ++r) { const float pv = exp2f(sT[t4][r] - mnew); sT[t4][r] = pv; ps += pv; }
        lrun = lrun * alpha + ps;
        const bf16x8 pb0 = pack8(sT[0], sT[1]), pb1 = pack8(sT[2], sT[3]);
#pragma unroll
        for (int dt = 0; dt < 8; ++dt) {
            oacc[dt] = oacc[dt] * alpha;
            oacc[dt] = mfma32(vf[2 * dt], pb0, oacc[dt]);
            oacc[dt] = mfma32(vf[2 * dt + 1], pb1, oacc[dt]);
        }
        if (kt + 1 < ktile_hi) AT_WRITE(F.lds + ((kt + 1 - ktile_lo) & 1) * BUFB);
        __syncthreads();
    }
#undef AT_ISSUE
#undef AT_WRITE
    lrun += xor16_f(lrun); lrun = xor32_sum(lrun);
    const float inv = 1.0f / lrun;
    if (MODE == 0) {
        bf16_t* og = (bf16_t*)(scr + A_OG) + ((size_t)(b * 12 + hd) * 2048 + nq) * 128;
#pragma unroll
        for (int dt = 0; dt < 8; ++dt) { u32x2 w; w.x = pk2(oacc[dt][0] * inv, oacc[dt][1] * inv); w.y = pk2(oacc[dt][2] * inv, oacc[dt][3] * inv); *(u32x2*)(og + 16 * dt + 4 * g) = w; }
        if (g == 0) ((float*)(scr + A_LSE))[(size_t)(b * 12 + hd) * 2048 + nq] = mrun + log2f(lrun);
    } else {
        unsigned char* oc = (opq(p.ws) + WS_OC) + (size_t)(b * SEQ + nq) * 1024 + 512 + (hd - 12) * 128;
        const float inv4 = inv * A_PRE;
#pragma unroll
        for (int dt = 0; dt < 8; ++dt) *(unsigned*)(oc + 16 * dt + 4 * g) = pk4_fp8(oacc[dt][0] * inv4, oacc[dt][1] * inv4, oacc[dt][2] * inv4, oacc[dt][3] * inv4);
    }
}

__device__ __forceinline__ void attn_phase(const Params& p, const Frame& F0) {
    const Frame F = refresh(F0);
    const int i = F.bid & 15, bhm = F.bid >> 4;
    const int nd = (i == 0) ? 7 : (i <= 2) ? 6 : (i <= 4) ? 5 : (i <= 6) ? 4 : (i <= 8) ? 3 : (i <= 10) ? 2 : (i == 11) ? 1 : 0;
    const int st = (i == 0) ? 0 : (i == 1) ? 7 : (i == 2) ? 13 : (i == 3) ? 19 : (i == 4) ? 24 : (i == 5) ? 29 : (i == 6) ? 33 : (i == 7) ? 37 : (i == 8) ? 40 : (i == 9) ? 43 : (i == 10) ? 45 : (i == 11) ? 47 : 48;
    const bool balanced = (F.G == 256);
    for (int k = 0;; ++k) {
        int it;
        if (balanced) { if (k > nd) break; it = (k == 0) ? (bhm * 16 + i) : (256 + bhm * 48 + st + k - 1); }
        else { it = F.bid + k * F.G; if (it >= 1024) break; }
        if (it < 256) { const int qt = it & 15; attn_item<1>(p, F, it >> 6, 12 + ((it >> 4) & 3), qt * 128, 0, 2 * (qt + 1)); }
        else { const int id = it - 256, qt = id & 15, hd = (id >> 4) % 12, b = (id >> 4) / 12, dl = head_dil_log2(hd); const int q0 = qt * 128, first = ((q0 & ((2048 >> dl) - 1)) == 0);
            attn_item<0>(p, F, b, hd, q0, first ? 2 * qt : 2 * qt - 2, 2 * qt + 2); }
    }
}

__device__ __forceinline__ void merge_pass(const Params& p, const Frame& F0) {
    const Frame F = refresh(F0);
    const int gw = F.bid * NWAVES + F.wave, NGW = F.G * NWAVES, hg = F.lane >> 4, d0 = (F.lane & 15) * 8;
    unsigned char* scr = opq(p.ws) + WS_SCR;
    const bf16_t* OG = (const bf16_t*)(scr + A_OG); const float* LSE = (const float*)(scr + A_LSE); bf16_t* OC = (bf16_t*)(opq(p.ws) + WS_OC);
    for (int m = gw; m < T; m += NGW) {
        const int b = m >> 11, s = m & 2047;
        float ls[3]; u32x4 ov[3];
#pragma unroll
        for (int gi = 0; gi < 3; ++gi) { const int hd = 4 * gi + hg; const size_t idx = (size_t)(b * 12 + hd) * 2048 + posp(s, 2 * gi); ls[gi] = LSE[idx]; ov[gi] = *(const u32x4*)(OG + idx * 128 + d0); }
        const float mx = fmaxf(ls[0], fmaxf(ls[1], ls[2]));
        float w[3]; float ws = 0.f;
#pragma unroll
        for (int gi = 0; gi < 3; ++gi) { w[gi] = exp2f(ls[gi] - mx); ws += w[gi]; }
        const float inv = 1.0f / ws;
        float o[8] = {0.f, 0.f, 0.f, 0.f, 0.f, 0.f, 0.f, 0.f};
#pragma unroll
        for (int gi = 0; gi < 3; ++gi) { const float wg = w[gi] * inv;
            o[0] += wg * bflo(ov[gi].x); o[1] += wg * bfhi(ov[gi].x); o[2] += wg * bflo(ov[gi].y); o[3] += wg * bfhi(ov[gi].y);
            o[4] += wg * bflo(ov[gi].z); o[5] += wg * bfhi(ov[gi].z); o[6] += wg * bflo(ov[gi].w); o[7] += wg * bfhi(ov[gi].w); }
        u32x2 wv; wv.x = pk4_fp8(o[0] * A_PRE, o[1] * A_PRE, o[2] * A_PRE, o[3] * A_PRE); wv.y = pk4_fp8(o[4] * A_PRE, o[5] * A_PRE, o[6] * A_PRE, o[7] * A_PRE);
        *(u32x2*)((unsigned char*)OC + (size_t)m * 1024 + hg * 128 + d0) = wv;
    }
}

#define GRID_SYNC() xcd_barrier((unsigned*)(opq(p.ws) + WS_CTL), (volatile LAS unsigned*)(F.lds + LDS_BYTES - 16), F.wave)
#ifndef REPMASK
#define REPMASK 0u
#endif
__device__ __forceinline__ int repn(int k) { int n = 1 + (int)(((REPMASK) >> k) & 1u); asm volatile("" : "+s"(n)); return n; }
#define RP(k) for (int _r = 0, _n = repn(k); _r < _n; ++_r)
__global__ void __launch_bounds__(NTHR, 2) mk_fwd(Params p) {
    extern __shared__ __attribute__((aligned(16))) unsigned char lds_raw[];
    Frame F; F.lds = (LAS unsigned char*)lds_raw; F.tid = 0; F.lane = 0; F.wave = __builtin_amdgcn_readfirstlane(threadIdx.x >> 6); F.G = gridDim.x; F.bid = blockIdx.x;
#define P_WS (opq(p.ws))
#define P_AB ((bf16_t*)(opq(p.ws) + WS_AB))
#define P_R (opq(p.out))
#define P_MIX ((bf16_t*)(opq(p.ws) + WS_MIX))
#define P_HID ((bf16_t*)(opq(p.ws) + WS_HID))
#define P_Y2 ((bf16_t*)(opq(p.ws) + WS_Y2))

    {
        if (threadIdx.x == 0) { volatile LAS unsigned* st = (volatile LAS unsigned*)(F.lds + LDS_BYTES - 16); st[0] = 0u; st[1] = 0u;
            (void)xb_add((unsigned*)(p.ws + WS_CTL) + XB_XCNT(xb_xcc_id()), 1u); }
        __syncthreads();
    }
    RP(0) { convert_set(p, F, 0, F.bid * NWAVES + F.wave, F.G * NWAVES); __syncthreads(); }
    RP(1) { load_w16_lds(F, p.in[I_EV_WIN], EVEN_IN, 4096); __syncthreads(); p0_xpass(p, F); __syncthreads(); }
    GRID_SYNC();

    RP(2) {
        pg8::StaticOrder S; S.init(T, 8192, F.G, F.bid);
        pg8::Gemm g{(const unsigned char*)(P_WS + WS_AB), (const unsigned char*)(P_WS + WS_WIN), 2048, (unsigned)(T * 2048), (unsigned)(8192 * 2048), SC_A16};
        pg8::EpiBf16 E{(bf16_t*)(P_WS + WS_H1), H1LD, (unsigned)(T * 8192 * 2)};
        pg8::gemm_phase(F.lds, F.wave, g, S, E);
    }
    GRID_SYNC();
    RP(3) { p2_pre(p, F); }
    GRID_SYNC();
    RP(4) { if (F.bid < 32) gdn_scan(p, F, F.bid); else if (F.bid < 64) hgrn_scan(p, F, F.bid - 32);
            else if (F.G > 64) convert_set(p, F, 1, (F.bid - 64) * NWAVES + F.wave, (F.G - 64) * NWAVES); }
    if (F.G <= 64) { convert_set(p, F, 1, F.bid * NWAVES + F.wave, F.G * NWAVES); }
    GRID_SYNC();
    RP(5) { p4_gate(p, F); }
    GRID_SYNC();
    RP(6) {
        pg8::StaticOrder S; S.init(T, 2048, F.G, F.bid);
        pg8::Gemm g{(const unsigned char*)(P_WS + WS_OC), (const unsigned char*)(P_WS + WS_WOUT), 2048, (unsigned)(T * 2048), (unsigned)(2048 * 2048), SC_A4};
        pg8::EpiBf16 E{P_MIX, 2048, (unsigned)(T * 2048 * 2)};
        pg8::gemm_phase(F.lds, F.wave, g, S, E);
    }
    GRID_SYNC();
#define MOE_BLOCK(layer, resid, mixp, outfinal, outb2) do { \
        for (int _r = 0, _n = ((layer) == 0 ? repn(7) : 1); _r < _n; ++_r) { load_w16_lds(F, p.in[I_RW], 16, 0); __syncthreads(); \
            ln_pass<true, false, (layer) != 0, true>(p, F, resid, mixp, D, nullptr, p.in[I_LNG] + (size_t)((layer) * 2 + 0) * D, p.in[I_LNB] + (size_t)((layer) * 2 + 0) * D, P_R, P_AB, layer); __syncthreads(); } \
        GRID_SYNC(); \
        const int* list = (const int*)(P_WS + WS_LIST) + (size_t)(layer) * NE * T; \
        const float* gatew = (const float*)(P_WS + WS_GATEW) + (size_t)(layer) * 2 * T; \
        RP(8) { moe_lists(p, F, layer); } \
        GRID_SYNC(); \
        { const Frame Fr = refresh(F); pg8::moe_build_table(F.lds, Fr.tid); } \
        unsigned* tcnt = (unsigned*)(P_WS + WS_CTL) + 3600 + 128 * (layer);        \
        { pg8::MoeOrder<4, false> S; S.init(F.lds, list, F.G, F.bid, 1024, tcnt); \
            pg8::Gemm g{(const unsigned char*)(P_WS + WS_ABS), (const unsigned char*)(P_WS + ((layer) ? WS_WGU1 : WS_WGU)), 2048, (unsigned)(20480 * 2048), (unsigned)(NE * 1024 * 2048), SC_A1}; \
            pg8::EpiGateUpB E{P_HID, list, gatew}; pg8::gemm_phase(F.lds, F.wave, g, S, E); } \
          \
        { pg8::MoeDownS S; S.init(F.lds, tcnt, 2048, F.G, F.bid); \
            pg8::Gemm16 g{P_HID, (const bf16_t*)(P_WS + WS_WD), 512, (unsigned)(20480 * 512 * 2), (unsigned)(NE * 2048 * 512 * 2)}; \
            pg8::EpiDown E{P_Y2, list}; pg8::gemm_phase16(F.lds, F.wave, g, S, E); } \
        GRID_SYNC(); \
        ln_pass<false, true, true, (layer) == 0>(p, F, P_R, P_Y2, D, P_Y2, p.in[I_LNG] + (size_t)((layer) * 2 + 1) * D, p.in[I_LNB] + (size_t)((layer) * 2 + 1) * D, outfinal, outb2, layer); \
    } while (0)
    MOE_BLOCK(0, p.in[I_X], P_MIX, P_R, (bf16_t*)(P_WS + WS_AB8));
    __syncthreads();
    RP(11) { convert_set(p, F, 2, F.bid * NWAVES + F.wave, F.G * NWAVES); __syncthreads(); }
    GRID_SYNC();
    RP(12) {
        pg8::StaticOrder S; S.init(T, 6144, F.G, F.bid);
        pg8::Gemm g{(const unsigned char*)(P_WS + WS_AB8), (const unsigned char*)(P_WS + WS_W3), 2048, (unsigned)(T * 2048), (unsigned)(6144 * 2048), SC_A1};
        pg8::EpiBf16 E{(bf16_t*)(P_WS + WS_H1), H3LD, (unsigned)(T * 6144 * 2)};
        pg8::gemm_phase(F.lds, F.wave, g, S, E);
    }
    GRID_SYNC();
    RP(13) { const Frame Fr = refresh(F); for (int u = Fr.bid; u < 256; u += Fr.G) rope_unit(p, Fr, u); }
    GRID_SYNC();
    RP(14) { attn_phase(p, F); }
    GRID_SYNC();
    RP(15) { merge_pass(p, F); }
    GRID_SYNC();
    RP(16) {
        pg8::StaticOrder S; S.init(T, 2048, F.G, F.bid);
        pg8::Gemm g{(const unsigned char*)(P_WS + WS_OC), (const unsigned char*)(P_WS + WS_WOUT1), 1024, (unsigned)(T * 1024), (unsigned)(2048 * 1024), SC_A4};
        pg8::EpiBf16 E{P_MIX, 2048, (unsigned)(T * 2048 * 2)};
        pg8::gemm_phase(F.lds, F.wave, g, S, E);
    }
    GRID_SYNC();
    MOE_BLOCK(1, P_R, P_MIX, p.out, (bf16_t*)nullptr);
#undef MOE_BLOCK
#undef P_WS
#undef P_AB
#undef P_R
#undef P_MIX
#undef P_HID
#undef P_Y2
}

extern "C" void kernel_launch(void* const* d_in, const int* in_sizes, int n_in, void* d_out, int out_size,
                              void* d_ws, size_t ws_size, hipStream_t stream) {
    static int grid_blocks = 0;
    if (!grid_blocks) {
        int dev = 0, cus = 0, per_cu = 0;
        (void)hipGetDevice(&dev);
        (void)hipDeviceGetAttribute(&cus, hipDeviceAttributeMultiprocessorCount, dev);
        (void)hipFuncSetAttribute((const void*)mk_fwd, hipFuncAttributeMaxDynamicSharedMemorySize, LDS_BYTES);
        (void)hipOccupancyMaxActiveBlocksPerMultiprocessor(&per_cu, (const void*)mk_fwd, NTHR, LDS_BYTES);
        if (per_cu < 1) fprintf(stderr, "kernel_launch: occupancy query says %d blocks per CU\n", per_cu);
        grid_blocks = cus;
        if (ws_size < WS_END) { fprintf(stderr, "kernel_launch: workspace too small: %zu < %zu\n", ws_size, (size_t)WS_END); grid_blocks = -1; }
        if (n_in != 18) { fprintf(stderr, "kernel_launch: expected 18 inputs, got %d\n", n_in); grid_blocks = -1; }
    }
    if (grid_blocks < 0) return;
    Params p{};
    for (int i = 0; i < 18; ++i) p.in[i] = (const float*)d_in[i];
    p.out = (float*)d_out; p.ws = (unsigned char*)d_ws;
    (void)hipMemsetAsync(d_ws, 0, 16384, stream);
    void* args[] = {&p};
    hipError_t e = hipLaunchCooperativeKernel((void*)mk_fwd, dim3(grid_blocks), dim3(NTHR), args, LDS_BYTES, stream);
    if (e != hipSuccess) fprintf(stderr, "cooperative launch failed: %s (grid %d)\n", hipGetErrorString(e), grid_blocks);
}
```

```cpp
#include <hip/hip_runtime.h>
#include <cstdio>
#include <cstdint>

#define GAS __attribute__((address_space(1)))
#define LAS __attribute__((address_space(3)))
typedef unsigned short bf16_t;
typedef short bf16x8 __attribute__((ext_vector_type(8)));
typedef short bf16x4 __attribute__((ext_vector_type(4)));
typedef float f32x4 __attribute__((ext_vector_type(4)));
typedef float f32x2 __attribute__((ext_vector_type(2)));
typedef unsigned u32x4 __attribute__((ext_vector_type(4)));
typedef unsigned u32x2 __attribute__((ext_vector_type(2)));

constexpr int NB = 4, SEQ = 2048, T = NB * SEQ, D = 2048;
constexpr int EVEN_IN = 8208, ODD_IN = 6144;
constexpr int NE = 16, DEXP = 512;
constexpr float ALPHA = 1.4142135623730951f;
constexpr float LN_EPS = 1e-5f, RMS_EPS = 1e-6f;
constexpr int NWAVES = 8, NTHR = 512;
constexpr int LDS_BYTES = 147456;

constexpr size_t MiB = 1u << 20;
constexpr size_t WS_CTL = 0;
constexpr size_t WS_LIST = 1 * MiB;
constexpr size_t WS_GATEW = 2 * MiB;
constexpr size_t WS_BA = 2 * MiB + 512 * 1024;
constexpr size_t WS_ROPE = 3 * MiB;
constexpr size_t WS_KMEAN = 4 * MiB;
constexpr size_t WS_WREG = 8 * MiB;
constexpr size_t WS_WIN = WS_WREG;
constexpr size_t WS_AB8 = WS_WREG + 16 * MiB;
constexpr size_t WS_WOUT = WS_WREG + 32 * MiB;
constexpr size_t WS_WGU = WS_WREG + 40 * MiB;
constexpr size_t WS_WD = WS_WREG + 104 * MiB;
constexpr size_t WS_AB = WS_WREG + 136 * MiB;
constexpr size_t WS_H1 = WS_AB + 32 * MiB;
constexpr size_t WS_OC = WS_H1 + 128 * MiB;
constexpr size_t WS_MIX = WS_OC + 32 * MiB;
constexpr size_t WS_SCR = WS_MIX + 32 * MiB;
constexpr size_t WS_HID = WS_SCR;
constexpr size_t WS_Y2 = WS_SCR + 20 * MiB;
constexpr size_t WS_ABS = WS_SCR + 84 * MiB;
constexpr size_t WS_END = WS_SCR + 216 * MiB;
static_assert(WS_END == 584 * MiB, "workspace map");

typedef __bf16 bf16v2_t __attribute__((ext_vector_type(2)));
__device__ __forceinline__ unsigned pk2(float lo, float hi) { const f32x2 f = {lo, hi}; return __builtin_bit_cast(unsigned, __builtin_convertvector(f, bf16v2_t)); }
__device__ __forceinline__ unsigned f2bf(float f) { return pk2(f, 0.f) & 0xffffu; }
__device__ __forceinline__ unsigned pk4_fp8(float a, float b, float c, float d) {
    a = fminf(fmaxf(a, -448.f), 448.f); b = fminf(fmaxf(b, -448.f), 448.f); c = fminf(fmaxf(c, -448.f), 448.f); d = fminf(fmaxf(d, -448.f), 448.f);
    int w = 0; w = __builtin_amdgcn_cvt_pk_fp8_f32(a, b, w, false); w = __builtin_amdgcn_cvt_pk_fp8_f32(c, d, w, true); return (unsigned)w;
}
constexpr float W_PRE = 64.f;  constexpr int SC_W = 0x79797979;
constexpr float A_PRE = 4.f;   constexpr int SC_A4 = 0x7d7d7d7d;
constexpr int SC_A1 = 0x7f7f7f7f;
constexpr float X_PRE = 16.f;  constexpr int SC_A16 = 0x7b7b7b7b;
typedef int i32x8 __attribute__((ext_vector_type(8)));
__device__ __forceinline__ float bf2f(unsigned short b) { return __builtin_bit_cast(float, (unsigned)b << 16); }
__device__ __forceinline__ float bflo(unsigned w) { return __builtin_bit_cast(float, w << 16); }
__device__ __forceinline__ float bfhi(unsigned w) { return __builtin_bit_cast(float, w & 0xffff0000u); }
__device__ __forceinline__ unsigned cvt_pk_bf16(float lo, float hi) { return pk2(lo, hi); }
template <int CTRL> __device__ __forceinline__ float dpp_f(float x) { return __builtin_bit_cast(float, __builtin_amdgcn_update_dpp(0, __builtin_bit_cast(int, x), CTRL, 0xf, 0xf, true)); }
__device__ __forceinline__ float xor16_f(float x) { return __builtin_bit_cast(float, __builtin_amdgcn_ds_swizzle(__builtin_bit_cast(int, x), 0x401f)); }
__device__ __forceinline__ float row16_sum(float v) { v += dpp_f<0xB1>(v); v += dpp_f<0x4E>(v); v += dpp_f<0x141>(v); v += dpp_f<0x140>(v); return v; }
__device__ __forceinline__ float xor32_sum(float v) { const int i = __builtin_bit_cast(int, v); const auto r = __builtin_amdgcn_permlane32_swap(i, i, false, false);
    return __builtin_bit_cast(float, (int)r[0]) + __builtin_bit_cast(float, (int)r[1]); }
__device__ __forceinline__ float xor32_max(float v) { const int i = __builtin_bit_cast(int, v); const auto r = __builtin_amdgcn_permlane32_swap(i, i, false, false);
    return fmaxf(__builtin_bit_cast(float, (int)r[0]), __builtin_bit_cast(float, (int)r[1])); }
__device__ __forceinline__ float wave_sum(float v) { v = row16_sum(v); v += xor16_f(v); return xor32_sum(v); }
__device__ __forceinline__ float sigmoidf_(float x) { return 1.0f / (1.0f + __expf(-x)); }
__device__ __forceinline__ float siluf_(float x) { return x / (1.0f + __expf(-x)); }
#define LDS_WAIT() asm volatile("s_waitcnt lgkmcnt(0)" ::: "memory")
template <class Tp> __device__ __forceinline__ Tp* opq(Tp* x) { asm volatile("" : "+s"(x)); return x; }
template <class Tp> __device__ __forceinline__ Tp* opqg(Tp* x) { GAS Tp* g = (GAS Tp*)x; asm volatile("" : "+s"(g)); return (Tp*)g; }
__device__ __forceinline__ float ld_agent(const float* p) { return __hip_atomic_load(p, __ATOMIC_RELAXED, __HIP_MEMORY_SCOPE_AGENT); }

namespace pg8 {
constexpr int BM = 256, BK = 64, HALF = 128, HTB = HALF * BK * 2, STAGE_BYTES = 8 * HTB, NXCD = 8, WGM = 8;
__device__ __forceinline__ int lds_byte(int r, int c) { const int st = (r >> 4) * 2 + (c >> 5), rr = r & 15, cc = c & 31, ob = rr * 64 + cc * 2; return st * 1024 + (ob ^ (((ob >> 9) & 1) << 5)); }
__device__ __forceinline__ void stage_rc(int b, int& R, int& C) { const int st = b / 1024, sb = b % 1024, swz = sb ^ (((sb >> 9) & 1) << 5); R = (st >> 1) * 16 + swz / 64; C = (st & 1) * 32 + (swz % 64) / 2; }
__device__ __forceinline__ int perm32(int rho) { const int n = rho >> 4, i = rho & 15; return 8 * (i >> 2) + 4 * n + (i & 3); }

struct Unit { int pm, pn, e, cnt, arow0, brow0; };
struct Gemm { const unsigned char* A; const unsigned char* Bt; int K; unsigned abytes, bbytes; int sc_a; };

struct StaticOrder {
    static constexpr bool CONTIG = true;
    int nM, nN, nwg, G, c;
    __device__ void init(int M, int N, int G_, int c_) { nM = M / BM; nN = N / BM; nwg = nM * nN; G = G_; c = c_; }
    __device__ bool next(int i, Unit& u) const {
        const long L = (long)i * G + c; if (L >= nwg) return false;
        int wgid = (int)L; { const int q = nwg / NXCD, r = nwg % NXCD, xcd = wgid % NXCD, off = wgid / NXCD; wgid = (xcd < r ? xcd * (q + 1) : r * (q + 1) + (xcd - r) * q) + off; }
        const int nig = WGM * nN, gid = wgid / nig, fm = gid * WGM, gsz = (nM - fm) < WGM ? (nM - fm) : WGM;
        u.pm = fm + ((wgid % nig) % gsz); u.pn = (wgid % nig) / gsz; u.e = 0; u.cnt = 0; u.arow0 = u.pm * BM; u.brow0 = u.pn * BM; return true;
    }
    __device__ __forceinline__ unsigned arow(const Unit& u, int r) const { return (unsigned)(u.arow0 + r); }
    __device__ __forceinline__ void done(const Unit&, int) const {}
    struct State {};
    __device__ __forceinline__ bool first(State&, Unit& u, int) const { return next(0, u); }
    __device__ __forceinline__ void issue(State&, int, int) const {}
    __device__ __forceinline__ bool fin(State&, int i, Unit& u, int) const { return next(i, u); }
};

constexpr int MOE_TAB_OFF = 131072;
constexpr int MOE_HIST_OFF = 131072 + 3072;
__device__ __forceinline__ void moe_build_table(LAS unsigned char* lds, int tid) {
    LAS int* tab = (LAS int*)(lds + MOE_TAB_OFF);
    const LAS int* cnts = (const LAS int*)(lds + MOE_HIST_OFF) + 16;
    if (tid == 0) {
        int s = 0;
#pragma unroll 1
        for (int e = 0; e < NE; ++e) { const int c = cnts[e]; const int nt = (c + 255) >> 8;
#pragma unroll 1
            for (int k = 0; k < nt; ++k) { tab[4 + 4 * (s + k)] = e; tab[4 + 4 * (s + k) + 1] = k; tab[4 + 4 * (s + k) + 2] = c; }
            s += nt; }
        tab[0] = s;
    }
    __syncthreads();
}
template <int NPN, bool GATHER>
struct MoeOrder {
    static constexpr bool CONTIG = !GATHER;
    const int* list;
    LAS const int* tab; int G, c, brows;
    unsigned* tcnt;
    __device__ void init(LAS unsigned char* lds, const int* list_, int G_, int c_, int brows_, unsigned* tcnt_ = nullptr) { list = list_; G = G_; c = c_; brows = brows_; tab = (LAS const int*)(lds + MOE_TAB_OFF); tcnt = tcnt_; }
    __device__ __forceinline__ void done(const Unit& u, int lane) const {
        if (tcnt) { asm volatile("s_waitcnt vmcnt(0)" ::: "memory"); if (lane == 0) __hip_atomic_fetch_add(tcnt + (u.arow0 >> 8), 1u, __ATOMIC_RELAXED, __HIP_MEMORY_SCOPE_AGENT); }
    }
    __device__ bool next(int i, Unit& u) const {
        int L = i * G + c; const int ntile = __builtin_amdgcn_readfirstlane(tab[0]); if (L >= ntile * NPN) return false;
        if (NPN == 4 && i == 0 && G == 256) L = (c & 7) * 32 + (c >> 3);
        const int tile = L / NPN; u.pn = L % NPN;
        u.e = __builtin_amdgcn_readfirstlane(tab[4 + 4 * tile]); u.pm = __builtin_amdgcn_readfirstlane(tab[4 + 4 * tile + 1]); u.cnt = __builtin_amdgcn_readfirstlane(tab[4 + 4 * tile + 2]);
        u.arow0 = tile * BM; u.brow0 = u.e * brows + u.pn * BM; return true;
    }
    __device__ __forceinline__ unsigned arow(const Unit& u, int r) const {
        if (!GATHER) return (unsigned)(u.arow0 + r);
        int idx = u.pm * BM + r; if (idx >= u.cnt) idx = 0;
        return (unsigned)(list[u.e * T + idx] >> 1);
    }
    struct State {};
    __device__ __forceinline__ bool first(State&, Unit& u, int) const { return next(0, u); }
    __device__ __forceinline__ void issue(State&, int, int) const {}
    __device__ __forceinline__ bool fin(State&, int i, Unit& u, int) const { return next(i, u); }
};
constexpr int MOE_Q_OFF = 131072 + 3072 + 512;
struct MoeDownS {
    static constexpr bool CONTIG = true;
    typedef __attribute__((address_space(1))) unsigned gu32;
    LAS const int* tab; LAS unsigned* slot; gu32* tcnt; int brows, G, c;
    struct State {};
    __device__ void init(LAS unsigned char* lds, unsigned* tcnt_, int brows_, int G_, int c_) { tab = (LAS const int*)(lds + MOE_TAB_OFF); slot = (LAS unsigned*)(lds + MOE_Q_OFF); tcnt = (gu32*)tcnt_; brows = brows_; G = G_; c = c_; }
    __device__ __forceinline__ unsigned nunits() const { return (unsigned)__builtin_amdgcn_readfirstlane(tab[0]) * 8u; }
    __device__ __forceinline__ unsigned qof(int k) const {
        const int nG = __builtin_amdgcn_readfirstlane(tab[0]) * 4, h = nG % G, nl = G - h;
        return (unsigned)(c >= h ? k * nl + (k >= 3 ? (k - 2) * h : 0) + (c - h) : (k + 3) * nl + k * h + c);
    }
    __device__ __forceinline__ void wait_tile(unsigned q, unsigned cv) const {
        unsigned sp = 0;
        while (cv < 32u) { __builtin_amdgcn_s_sleep(2); if (++sp > (1u << 22)) break; cv = __hip_atomic_load(tcnt + (q >> 3), __ATOMIC_RELAXED, __HIP_MEMORY_SCOPE_AGENT); }
        asm volatile("buffer_inv sc1" ::: "memory");
    }
    __device__ __forceinline__ bool decode(unsigned q, Unit& u) const {
        if (q >= nunits()) return false;
        const int tile = (int)(q >> 3); u.pn = (int)(q & 7u);
        u.e = __builtin_amdgcn_readfirstlane(tab[4 + 4 * tile]); u.pm = __builtin_amdgcn_readfirstlane(tab[4 + 4 * tile + 1]); u.cnt = __builtin_amdgcn_readfirstlane(tab[4 + 4 * tile + 2]);
        u.arow0 = tile * BM; u.brow0 = u.e * brows + u.pn * BM; return true;
    }
    __device__ __forceinline__ bool first(State&, Unit& u, int tid) const {
        const unsigned q = qof(0);
        if (tid == 0 && q < nunits()) wait_tile(q, __hip_atomic_load(tcnt + (q >> 3), __ATOMIC_RELAXED, __HIP_MEMORY_SCOPE_AGENT));
        __syncthreads();
        return decode(q, u);
    }
    __device__ __forceinline__ void issue(State&, int i, int tid) const {
        const unsigned q = qof(i);
        if (tid == 0 && q < nunits()) {
            const __amdgpu_buffer_rsrc_t rc = __builtin_amdgcn_make_buffer_rsrc((void*)tcnt, (short)0, 128 * 4, 0x00020000);
            __builtin_amdgcn_raw_ptr_buffer_load_lds(rc, (LAS void*)slot, 4, (int)((q >> 3) * 4u), 0, 0, 16);
        }
    }
    __device__ __forceinline__ bool fin(State&, int i, Unit& u, int tid) const {
        const unsigned q = qof(i);
        if (tid == 0 && q < nunits()) {
            unsigned cv; asm volatile("ds_read_b32 %0, %1\n\ts_waitcnt lgkmcnt(0)" : "=v"(cv) : "v"((unsigned)(size_t)slot) : "memory");
            wait_tile(q, cv);
        }
        return decode(q, u);
    }
    __device__ __forceinline__ unsigned arow(const Unit& u, int r) const { return (unsigned)(u.arow0 + r); }
    __device__ __forceinline__ void done(const Unit&, int) const {}
};

struct EpiBf16 {
    static constexpr bool PERM = true;
    bf16_t* O; int ldc; unsigned obytes;
    __device__ __forceinline__ void operator()(const f32x4 (&acc)[2][2][4][2], const Unit& u, int wr, int wc, int fr, int fq) const {
        const __amdgpu_buffer_rsrc_t rO = __builtin_amdgcn_make_buffer_rsrc((void*)O, (short)0, (int)obytes, 0x00020000);
        const unsigned voff = (unsigned)((wr * 64 + fr) * ldc + wc * 32 + 8 * fq) * 2u;
        const unsigned sbase = (unsigned)(u.pm * BM * ldc + u.pn * BM) * 2u;
#pragma unroll
        for (int ai = 0; ai < 2; ++ai)
#pragma unroll
            for (int m = 0; m < 4; ++m)
#pragma unroll
                for (int bj = 0; bj < 2; ++bj) { const f32x4 v0 = acc[ai][bj][m][0], v1 = acc[ai][bj][m][1];
                    u32x4 w; w.x = cvt_pk_bf16(v0[0], v0[1]); w.y = cvt_pk_bf16(v0[2], v0[3]); w.z = cvt_pk_bf16(v1[0], v1[1]); w.w = cvt_pk_bf16(v1[2], v1[3]);
                    __builtin_amdgcn_raw_buffer_store_b128(w, rO, (int)voff, (int)(sbase + (unsigned)((ai * HALF + m * 16) * ldc + bj * HALF) * 2u), 0); }
    }
};
struct EpiGateUp {
    static constexpr bool PERM = true;
    unsigned char* HID; const int* list; const float* gatew;
    __device__ __forceinline__ void operator()(const f32x4 (&acc)[2][2][4][2], const Unit& u, int wr, int wc, int fr, int fq) const {
        const int col0 = u.pn * 128 + wc * 32 + 8 * fq;
#pragma unroll
        for (int ai = 0; ai < 2; ++ai)
#pragma unroll
            for (int m = 0; m < 4; ++m) {
                const int r = ai * HALF + wr * 64 + m * 16 + fr; const int idx = u.pm * BM + r;
                float wgt = 0.f; if (idx < u.cnt) wgt = gatew[list[u.e * T + idx]] * A_PRE;
                const f32x4 g0 = acc[ai][0][m][0], g1 = acc[ai][0][m][1], u0 = acc[ai][1][m][0], u1 = acc[ai][1][m][1];
                float h[8];
#pragma unroll
                for (int i = 0; i < 4; ++i) { h[i] = siluf_(g0[i]) * u0[i] * wgt; h[4 + i] = siluf_(g1[i]) * u1[i] * wgt; }
                u32x2 w; w.x = pk4_fp8(h[0], h[1], h[2], h[3]); w.y = pk4_fp8(h[4], h[5], h[6], h[7]);
                *(u32x2*)(HID + (size_t)(u.arow0 + r) * DEXP + col0) = w;
            }
    }
};
struct EpiGateUpB {
    static constexpr bool PERM = true;
    bf16_t* HID; const int* list; const float* gatew;
    __device__ __forceinline__ void operator()(const f32x4 (&acc)[2][2][4][2], const Unit& u, int wr, int wc, int fr, int fq) const {
        const __amdgpu_buffer_rsrc_t rH = __builtin_amdgcn_make_buffer_rsrc((void*)HID, (short)0, 20480 * 512 * 2, 0x00020000);
        const __amdgpu_buffer_rsrc_t rL = __builtin_amdgcn_make_buffer_rsrc((void*)(list + (size_t)u.e * T), (short)0, T * 4, 0x00020000);
        const __amdgpu_buffer_rsrc_t rG = __builtin_amdgcn_make_buffer_rsrc((void*)gatew, (short)0, 2 * T * 4, 0x00020000);
        const unsigned voff = (unsigned)((wr * 64 + fr) * DEXP + u.pn * 128 + wc * 32 + 8 * fq) * 2u;
        const int idx0 = u.pm * BM + wr * 64 + fr;
#pragma unroll
        for (int ai = 0; ai < 2; ++ai)
#pragma unroll
            for (int m = 0; m < 4; ++m) {
                const int idx = idx0 + ai * HALF + m * 16;
                const int ent = __builtin_amdgcn_raw_buffer_load_b32(rL, idx * 4, 0, 0);
                float wgt = __builtin_bit_cast(float, __builtin_amdgcn_raw_buffer_load_b32(rG, (idx < u.cnt ? ent : 0) * 4, 0, 0)); wgt = idx < u.cnt ? wgt : 0.f;
                const f32x4 g0 = acc[ai][0][m][0], g1 = acc[ai][0][m][1], u0 = acc[ai][1][m][0], u1 = acc[ai][1][m][1];
                float h[8];
#pragma unroll
                for (int i = 0; i < 4; ++i) { h[i] = siluf_(g0[i]) * u0[i] * wgt; h[4 + i] = siluf_(g1[i]) * u1[i] * wgt; }
                u32x4 w; w.x = cvt_pk_bf16(h[0], h[1]); w.y = cvt_pk_bf16(h[2], h[3]); w.z = cvt_pk_bf16(h[4], h[5]); w.w = cvt_pk_bf16(h[6], h[7]);
                __builtin_amdgcn_raw_buffer_store_b128(w, rH, (int)voff, (int)((u.arow0 + ai * HALF + m * 16) * DEXP * 2), 16);
            }
    }
};
struct EpiDown {
    static constexpr bool PERM = true;
    bf16_t* Y2; const int* list;
    __device__ __forceinline__ void operator()(const f32x4 (&acc)[2][2][4][2], const Unit& u, int wr, int wc, int fr, int fq) const {
        const int col0 = u.pn * BM + wc * 32 + 8 * fq;
#pragma unroll
        for (int ai = 0; ai < 2; ++ai)
#pragma unroll
            for (int m = 0; m < 4; ++m) {
                const int r = ai * HALF + wr * 64 + m * 16 + fr; const int idx = u.pm * BM + r;
                if (idx < u.cnt) { const int ent = list[u.e * T + idx]; bf16_t* rowp = Y2 + (size_t)ent * D + col0;
#pragma unroll
                    for (int bj = 0; bj < 2; ++bj) { const f32x4 v0 = acc[ai][bj][m][0], v1 = acc[ai][bj][m][1];
                        u32x4 w; w.x = cvt_pk_bf16(v0[0], v0[1]); w.y = cvt_pk_bf16(v0[2], v0[3]); w.z = cvt_pk_bf16(v1[0], v1[1]); w.w = cvt_pk_bf16(v1[2], v1[3]);
                        *(u32x4*)(rowp + bj * HALF) = w; } }
            }
    }
};

constexpr int NXT_OFF = 131072 + 4096;
template <class Epi, class Sched>
__device__ __forceinline__ void gemm_phase(LAS unsigned char* lds, int wave_id, const Gemm g, const Sched& S, const Epi& E) {
    int lane; asm volatile("v_mbcnt_lo_u32_b32 %0, -1, 0\n\tv_mbcnt_hi_u32_b32 %0, -1, %0" : "=v"(lane));
    const int wid = wave_id, tid = wid * 64 + lane, wr = wid >> 2, wc = wid & 3, fr = lane & 15, fq = lane >> 4;
    const int K = g.K, nt = K / 128;
    unsigned voffB[2];
#pragma unroll
    for (int i = 0; i < 2; ++i) { int R, C; stage_rc(tid * 16 + i * 8192, R, C); const int Rb = Epi::PERM ? ((R & ~31) + perm32(R & 31)) : R; voffB[i] = (unsigned)(Rb * K + 2 * C); }
    const unsigned ldsw = (unsigned)wid * 1024u;
    const int aoff = lds_byte(wr * 64 + fr, 16 * (fq & 1)) + (fq >> 1) * 1024, boff = lds_byte(wc * 32 + fr, 16 * (fq & 1)) + (fq >> 1) * 1024;
    LAS unsigned char* ldsB = lds + 4 * HTB + boff;
    LAS unsigned char* ldsA = lds + aoff;
    const int sc_act = g.sc_a;
#define PG8_SA(b, h) (((b) * 2 + (h)) * HTB)
#define PG8_SB(b, h) ((4 + (b) * 2 + (h)) * HTB)
#define PG8_STAGE(bufoff, rsrc, soff, voff) do { _Pragma("unroll") for (int _i = 0; _i < 2; ++_i) \
        __builtin_amdgcn_raw_ptr_buffer_load_lds(rsrc, (LAS void*)(lds + (bufoff) + ldsw + _i * 8192), 16, (int)(voff)[_i], (int)(soff), 0, 0); } while (0)
#define PG8_LD32(dstv, addr) do { const u32x4 _c0 = *(const LAS u32x4*)(lds + (addr)), _c1 = *(const LAS u32x4*)(lds + (addr) + 16); dstv = (i32x8){(int)_c0.x, (int)_c0.y, (int)_c0.z, (int)_c0.w, (int)_c1.x, (int)_c1.y, (int)_c1.z, (int)_c1.w}; } while (0)
#define PG8_LDA(dst, b, h) do { _Pragma("unroll") for (int m = 0; m < 4; ++m) { const u32x4 _c0 = *(const LAS u32x4*)(ldsA + PG8_SA(b, h) + m * 2048), _c1 = *(const LAS u32x4*)(ldsA + PG8_SA(b, h) + m * 2048 + 16); \
        dst[m] = (i32x8){(int)_c0.x, (int)_c0.y, (int)_c0.z, (int)_c0.w, (int)_c1.x, (int)_c1.y, (int)_c1.z, (int)_c1.w}; } } while (0)
#define PG8_LDB(dst, b, h) do { _Pragma("unroll") for (int n = 0; n < 2; ++n) { const u32x4 _c0 = *(const LAS u32x4*)(ldsB + ((b) * 2 + (h)) * HTB + n * 2048), _c1 = *(const LAS u32x4*)(ldsB + ((b) * 2 + (h)) * HTB + n * 2048 + 16); \
        dst[n] = (i32x8){(int)_c0.x, (int)_c0.y, (int)_c0.z, (int)_c0.w, (int)_c1.x, (int)_c1.y, (int)_c1.z, (int)_c1.w}; } } while (0)
#define PG8_MMA(ai, bj, At, Bt) do { __builtin_amdgcn_sched_barrier(0); __builtin_amdgcn_s_setprio(1); _Pragma("unroll") for (int m = 0; m < 4; ++m) _Pragma("unroll") for (int n = 0; n < 2; ++n) \
        acc[ai][bj][m][n] = __builtin_amdgcn_mfma_scale_f32_16x16x128_f8f6f4(Bt[n], At[m], acc[ai][bj][m][n], 0, 0, 0, SC_W, 0, sc_act); \
        _Pragma("unroll") for (int m = 0; m < 4; ++m) asm volatile("" :: "v"(acc[ai][bj][m][0]), "v"(acc[ai][bj][m][1]));     \
        __builtin_amdgcn_s_setprio(0); __builtin_amdgcn_sched_barrier(0); } while (0)
#define PG8_WAIT_V(n) asm volatile("s_waitcnt vmcnt(" #n ")" ::: "memory")
#define PG8_WAIT_L(n) asm volatile("s_waitcnt lgkmcnt(" #n ")" ::: "memory")
#define PG8_BAR __builtin_amdgcn_s_barrier()
#define PG8_SCHED __builtin_amdgcn_sched_barrier(0)
#define PG8_AOFFS(u, o0, o1) do { _Pragma("unroll") for (int _i = 0; _i < 2; ++_i) { int _R, _C; stage_rc(tid * 16 + _i * 8192, _R, _C); \
        o0[_i] = S.arow(u, _R) * (unsigned)K + 2u * (unsigned)_C; o1[_i] = S.arow(u, HALF + _R) * (unsigned)K + 2u * (unsigned)_C; } } while (0)
    Unit cur, nxt; int ui = 0;
    if (!S.next(0, cur)) return;
    f32x4 acc[2][2][4][2];
#pragma unroll
    for (int a = 0; a < 2; ++a)
#pragma unroll
        for (int b = 0; b < 2; ++b)
#pragma unroll
            for (int m = 0; m < 4; ++m)
#pragma unroll
                for (int n = 0; n < 2; ++n) acc[a][b][m][n] = (f32x4){0.f, 0.f, 0.f, 0.f};
    i32x8 At[4], B0[2], B1[2];
    unsigned cA0[2], cA1[2];
    PG8_AOFFS(cur, cA0, cA1);
    const __amdgpu_buffer_rsrc_t rA = __builtin_amdgcn_make_buffer_rsrc((void*)g.A, (short)0, (int)g.abytes, 0x00020000);
    const __amdgpu_buffer_rsrc_t rB = __builtin_amdgcn_make_buffer_rsrc((void*)g.Bt, (short)0, (int)g.bbytes, 0x00020000);
    const unsigned kstep = (unsigned)(BK * 2);
    const unsigned hstep = (unsigned)HALF * (unsigned)K;
    unsigned cB = (unsigned)cur.brow0 * (unsigned)K;
    PG8_STAGE(PG8_SB(0, 0), rB, cB, voffB); PG8_STAGE(PG8_SB(0, 1), rB, cB + hstep, voffB); PG8_STAGE(PG8_SA(0, 0), rA, 0u, cA0); PG8_STAGE(PG8_SA(0, 1), rA, 0u, cA1);
    if (wr == 1) PG8_BAR;
    PG8_WAIT_V(2); PG8_BAR;
    PG8_STAGE(PG8_SB(1, 0), rB, cB + kstep, voffB); PG8_STAGE(PG8_SA(1, 0), rA, kstep, cA0); PG8_STAGE(PG8_SB(1, 1), rB, cB + hstep + kstep, voffB);
    PG8_WAIT_V(6); PG8_BAR;
#define PG8_PAIR(a1, a2, b2, SWITCH) do { \
            PG8_LDB(B0, 0, 0); PG8_LDB(B1, 0, 1); PG8_SCHED; PG8_LDA(At, 0, 0); PG8_STAGE(PG8_SA(1, 1), rA, a1, cA1); \
            SWITCH; \
            PG8_WAIT_V(8); PG8_WAIT_L(0); PG8_BAR; PG8_MMA(0, 0, At, B0); PG8_MMA(0, 1, At, B1); PG8_BAR; PG8_SCHED; \
            PG8_LDA(At, 0, 1); PG8_STAGE(PG8_SB(0, 0), rB, b2, voffB); PG8_STAGE(PG8_SB(0, 1), rB, (b2) + hstep, voffB); PG8_STAGE(PG8_SA(0, 0), rA, a2, cA0); \
            PG8_WAIT_V(8); PG8_WAIT_L(0); PG8_BAR; PG8_MMA(1, 0, At, B0); PG8_MMA(1, 1, At, B1); PG8_BAR; PG8_SCHED; \
            PG8_LDB(B0, 1, 0); PG8_LDB(B1, 1, 1); PG8_SCHED; PG8_LDA(At, 1, 0); PG8_STAGE(PG8_SA(0, 1), rA, a2, cA1); \
            PG8_WAIT_V(8); PG8_WAIT_L(0); PG8_BAR; PG8_MMA(0, 0, At, B0); PG8_MMA(0, 1, At, B1); PG8_BAR; PG8_SCHED; \
            PG8_LDA(At, 1, 1); PG8_STAGE(PG8_SB(1, 0), rB, (b2) + kstep, voffB); PG8_STAGE(PG8_SB(1, 1), rB, (b2) + kstep + hstep, voffB); PG8_STAGE(PG8_SA(1, 0), rA, (a2) + kstep, cA0); \
            PG8_WAIT_V(8); PG8_WAIT_L(0); PG8_BAR; PG8_MMA(1, 0, At, B0); PG8_MMA(1, 1, At, B1); PG8_BAR; PG8_SCHED; } while (0)
    for (;;) {
        const bool has_next = S.next(ui + 1, nxt);
        const unsigned nB = has_next ? (unsigned)nxt.brow0 * (unsigned)K : cB;
        unsigned dlt = 0u;
        if constexpr (Sched::CONTIG) { dlt = has_next ? (unsigned)(nxt.arow0 - cur.arow0) * (unsigned)K : 0u; }
        else { unsigned n0[2], n1[2]; if (has_next) { PG8_AOFFS(nxt, n0, n1); } else { n0[0] = cA0[0]; n0[1] = cA0[1]; n1[0] = cA1[0]; n1[1] = cA1[1]; }
          *((LAS u32x4*)(lds + NXT_OFF) + tid) = (u32x4){n0[0], n0[1], n1[0], n1[1]}; }
        for (int t = 0; t < nt - 2; t += 2) {
            const unsigned a1 = (unsigned)(t + 1) * kstep, a2 = (unsigned)(t + 2) * kstep, b2 = cB + (unsigned)(t + 2) * kstep;
            PG8_PAIR(a1, a2, b2, (void)0);
        }
        {
            const unsigned a1 = (unsigned)(nt - 1) * kstep;
            PG8_PAIR(a1, 0u, nB, do { if constexpr (Sched::CONTIG) { cA0[0] += dlt; cA0[1] += dlt; cA1[0] += dlt; cA1[1] += dlt; } else { const u32x4 _n = *((LAS u32x4*)(lds + NXT_OFF) + tid); cA0[0] = _n.x; cA0[1] = _n.y; cA1[0] = _n.z; cA1[1] = _n.w; } } while (0));
        }
        { int l2; asm volatile("v_mbcnt_lo_u32_b32 %0, -1, 0\n\tv_mbcnt_hi_u32_b32 %0, -1, %0" : "=v"(l2));
          E(acc, cur, wr, wc, l2 & 15, l2 >> 4); S.done(cur, l2); }
        if (!has_next) break;
#pragma unroll
        for (int a = 0; a < 2; ++a)
#pragma unroll
            for (int b = 0; b < 2; ++b)
#pragma unroll
                for (int m = 0; m < 4; ++m)
#pragma unroll
                    for (int n = 0; n < 2; ++n) acc[a][b][m][n] = (f32x4){0.f, 0.f, 0.f, 0.f};
        cur = nxt; cB = nB; ++ui;
    }
    PG8_WAIT_V(0);
    if (wr == 0) PG8_BAR;
    PG8_BAR;
#undef PG8_PAIR
#undef PG8_AOFFS
#undef PG8_SA
#undef PG8_SB
#undef PG8_STAGE
#undef PG8_LDA
#undef PG8_LDB
#undef PG8_MMA
#undef PG8_WAIT_V
#undef PG8_WAIT_L
#undef PG8_BAR
#undef PG8_SCHED
}
struct Gemm16 { const bf16_t* A; const bf16_t* Bt; int K; unsigned abytes, bbytes; };
struct EpiGateUp16 {
    static constexpr bool PERM = true;
    bf16_t* HID; const int* list; const float* gatew;
    __device__ __forceinline__ void operator()(const f32x4 (&acc)[2][2][4][2], const Unit& u, int wr, int wc, int fr, int fq) const {
        const int col0 = u.pn * 128 + wc * 32 + 8 * fq;
#pragma unroll
        for (int ai = 0; ai < 2; ++ai)
#pragma unroll
            for (int m = 0; m < 4; ++m) {
                const int r = ai * HALF + wr * 64 + m * 16 + fr; const int idx = u.pm * BM + r;
                float wgt = 0.f; if (idx < u.cnt) wgt = gatew[list[u.e * T + idx]];
                const f32x4 g0 = acc[ai][0][m][0], g1 = acc[ai][0][m][1], u0 = acc[ai][1][m][0], u1 = acc[ai][1][m][1];
                float h[8];
#pragma unroll
                for (int i = 0; i < 4; ++i) { h[i] = siluf_(g0[i]) * u0[i] * wgt; h[4 + i] = siluf_(g1[i]) * u1[i] * wgt; }
                u32x4 w; w.x = cvt_pk_bf16(h[0], h[1]); w.y = cvt_pk_bf16(h[2], h[3]); w.z = cvt_pk_bf16(h[4], h[5]); w.w = cvt_pk_bf16(h[6], h[7]);
                *(u32x4*)(HID + (size_t)(u.arow0 + r) * DEXP + col0) = w;
            }
    }
};
template <class Epi, class Sched>
__device__ __forceinline__ void gemm_phase16(LAS unsigned char* lds, int wave_id, const Gemm16 g, const Sched& S, const Epi& E) {
    int lane; asm volatile("v_mbcnt_lo_u32_b32 %0, -1, 0\n\tv_mbcnt_hi_u32_b32 %0, -1, %0" : "=v"(lane));
    const int wid = wave_id, tid = wid * 64 + lane, wr = wid >> 2, wc = wid & 3, fr = lane & 15, fq = lane >> 4;
    const int K = g.K, nt = K / BK;
    unsigned voffB[2];
#pragma unroll
    for (int i = 0; i < 2; ++i) { int R, C; stage_rc(tid * 16 + i * 8192, R, C); const int Rb = Epi::PERM ? ((R & ~31) + perm32(R & 31)) : R; voffB[i] = (unsigned)(Rb * K + C) * 2u; }
    const unsigned ldsw = (unsigned)wid * 1024u;
    const int aoff = lds_byte(wr * 64 + fr, fq * 8), boff = lds_byte(wc * 32 + fr, fq * 8);
#define PG8_SA(b, h) (((b) * 2 + (h)) * HTB)
#define PG8_SB(b, h) ((4 + (b) * 2 + (h)) * HTB)
#define PG8_STAGE(bufoff, rsrc, soff, voff) do { _Pragma("unroll") for (int _i = 0; _i < 2; ++_i) \
        __builtin_amdgcn_raw_ptr_buffer_load_lds(rsrc, (LAS void*)(lds + (bufoff) + ldsw + _i * 8192), 16, (int)(voff)[_i], (int)(soff), 0, 0); } while (0)
#define PG8_LDA(dst, b, h) do { _Pragma("unroll") for (int m = 0; m < 4; ++m) _Pragma("unroll") for (int k = 0; k < 2; ++k) dst[m][k] = *(const LAS bf16x8*)(lds + PG8_SA(b, h) + aoff + m * 2048 + k * 1024); } while (0)
#define PG8_LDB(dst, b, h) do { _Pragma("unroll") for (int n = 0; n < 2; ++n) _Pragma("unroll") for (int k = 0; k < 2; ++k) dst[n][k] = *(const LAS bf16x8*)(lds + PG8_SB(b, h) + boff + n * 2048 + k * 1024); } while (0)
#define PG8_MMA(ai, bj, At, Bt) do { __builtin_amdgcn_s_setprio(1); _Pragma("unroll") for (int m = 0; m < 4; ++m) _Pragma("unroll") for (int n = 0; n < 2; ++n) _Pragma("unroll") for (int k = 0; k < 2; ++k) \
        acc[ai][bj][m][n] = __builtin_amdgcn_mfma_f32_16x16x32_bf16(Bt[n][k], At[m][k], acc[ai][bj][m][n], 0, 0, 0); __builtin_amdgcn_s_setprio(0); } while (0)
#define PG8_WAIT_V(n) asm volatile("s_waitcnt vmcnt(" #n ")" ::: "memory")
#define PG8_WAIT_L(n) asm volatile("s_waitcnt lgkmcnt(" #n ")" ::: "memory")
#define PG8_BAR __builtin_amdgcn_s_barrier()
#define PG8_SCHED __builtin_amdgcn_sched_barrier(0)
#define PG8_AOFFS(u, o0, o1) do { _Pragma("unroll") for (int _i = 0; _i < 2; ++_i) { int _R, _C; stage_rc(tid * 16 + _i * 8192, _R, _C); \
        o0[_i] = (S.arow(u, _R) * (unsigned)K + (unsigned)_C) * 2u; o1[_i] = (S.arow(u, HALF + _R) * (unsigned)K + (unsigned)_C) * 2u; } } while (0)
    Unit cur, nxt; int ui = 0;
    typename Sched::State st;
    if (!S.first(st, cur, tid)) return;
    f32x4 acc[2][2][4][2];
#pragma unroll
    for (int a = 0; a < 2; ++a)
#pragma unroll
        for (int b = 0; b < 2; ++b)
#pragma unroll
            for (int m = 0; m < 4; ++m)
#pragma unroll
                for (int n = 0; n < 2; ++n) acc[a][b][m][n] = (f32x4){0.f, 0.f, 0.f, 0.f};
    bf16x8 At[4][2], B0[2][2], B1[2][2];
    unsigned cA0[2], cA1[2];
    PG8_AOFFS(cur, cA0, cA1);
    const __amdgpu_buffer_rsrc_t rA = __builtin_amdgcn_make_buffer_rsrc((void*)g.A, (short)0, (int)g.abytes, 0x00020000);
    const __amdgpu_buffer_rsrc_t rB = __builtin_amdgcn_make_buffer_rsrc((void*)g.Bt, (short)0, (int)g.bbytes, 0x00020000);
    const unsigned kstep = (unsigned)(BK * 2);
    const unsigned hstep = (unsigned)HALF * (unsigned)K * 2u;
    unsigned cB = (unsigned)cur.brow0 * (unsigned)K * 2u;
    PG8_STAGE(PG8_SB(0, 0), rB, cB, voffB); PG8_STAGE(PG8_SB(0, 1), rB, cB + hstep, voffB); PG8_STAGE(PG8_SA(0, 0), rA, 0u, cA0); PG8_STAGE(PG8_SA(0, 1), rA, 0u, cA1);
    if (wr == 1) PG8_BAR;
    PG8_WAIT_V(2); PG8_BAR;
    PG8_STAGE(PG8_SB(1, 0), rB, cB + kstep, voffB); PG8_STAGE(PG8_SA(1, 0), rA, kstep, cA0); PG8_STAGE(PG8_SB(1, 1), rB, cB + hstep + kstep, voffB);
    PG8_WAIT_V(6); PG8_BAR;
#define PG8_PAIR(a1, a2, b2, SWITCH) do { \
            PG8_LDB(B0, 0, 0); PG8_LDB(B1, 0, 1); PG8_SCHED; PG8_LDA(At, 0, 0); PG8_STAGE(PG8_SA(1, 1), rA, a1, cA1); \
            SWITCH; \
            PG8_WAIT_V(8); PG8_WAIT_L(0); PG8_BAR; PG8_MMA(0, 0, At, B0); PG8_MMA(0, 1, At, B1); PG8_BAR; PG8_SCHED; \
            PG8_LDA(At, 0, 1); PG8_STAGE(PG8_SB(0, 0), rB, b2, voffB); PG8_STAGE(PG8_SB(0, 1), rB, (b2) + hstep, voffB); PG8_STAGE(PG8_SA(0, 0), rA, a2, cA0); \
            PG8_WAIT_V(8); PG8_WAIT_L(0); PG8_BAR; PG8_MMA(1, 0, At, B0); PG8_MMA(1, 1, At, B1); PG8_BAR; PG8_SCHED; \
            PG8_LDB(B0, 1, 0); PG8_LDB(B1, 1, 1); PG8_SCHED; PG8_LDA(At, 1, 0); PG8_STAGE(PG8_SA(0, 1), rA, a2, cA1); \
            PG8_WAIT_V(8); PG8_WAIT_L(0); PG8_BAR; PG8_MMA(0, 0, At, B0); PG8_MMA(0, 1, At, B1); PG8_BAR; PG8_SCHED; \
            PG8_LDA(At, 1, 1); PG8_STAGE(PG8_SB(1, 0), rB, (b2) + kstep, voffB); PG8_STAGE(PG8_SB(1, 1), rB, (b2) + kstep + hstep, voffB); PG8_STAGE(PG8_SA(1, 0), rA, (a2) + kstep, cA0); \
            PG8_WAIT_V(8); PG8_WAIT_L(0); PG8_BAR; PG8_MMA(1, 0, At, B0); PG8_MMA(1, 1, At, B1); PG8_BAR; PG8_SCHED; } while (0)
    for (;;) {
        S.issue(st, ui + 1, tid);
        for (int t = 0; t < nt - 2; t += 2) {
            const unsigned a1 = (unsigned)(t + 1) * kstep, a2 = (unsigned)(t + 2) * kstep, b2 = cB + (unsigned)(t + 2) * kstep;
            PG8_PAIR(a1, a2, b2, (void)0);
        }
        const bool has_next = S.fin(st, ui + 1, nxt, tid);
        const unsigned nB = has_next ? (unsigned)nxt.brow0 * (unsigned)K * 2u : cB;
        {
            const unsigned a1 = (unsigned)(nt - 1) * kstep;
            PG8_PAIR(a1, 0u, nB, do { if (has_next) { PG8_AOFFS(nxt, cA0, cA1); } } while (0));
        }
        if (wr == 0) PG8_BAR;
        { int l2; asm volatile("v_mbcnt_lo_u32_b32 %0, -1, 0\n\tv_mbcnt_hi_u32_b32 %0, -1, %0" : "=v"(l2));
          E(acc, cur, wr, wc, l2 & 15, l2 >> 4); S.done(cur, l2); }
        if (!has_next) break;
#pragma unroll
        for (int a = 0; a < 2; ++a)
#pragma unroll
            for (int b = 0; b < 2; ++b)
#pragma unroll
                for (int m = 0; m < 4; ++m)
#pragma unroll
                    for (int n = 0; n < 2; ++n) acc[a][b][m][n] = (f32x4){0.f, 0.f, 0.f, 0.f};
        cur = nxt; cB = nB; ++ui;
        if (wr == 1) PG8_BAR;
    }
    PG8_WAIT_V(0);
    PG8_BAR;
#undef PG8_PAIR
#undef PG8_AOFFS
#undef PG8_SA
#undef PG8_SB
#undef PG8_STAGE
#undef PG8_LDA
#undef PG8_LDB
#undef PG8_MMA
#undef PG8_WAIT_V
#undef PG8_WAIT_L
#undef PG8_BAR
#undef PG8_SCHED
}
}

#define XB_TMO      128
#define XB_XCNT(j)  (256  + 64 * (j))
#define XB_XSUB(j)  (1280 + 64 * (j))
#define XB_XGEN(j)  (2304 + 64 * (j))
#define XB_TOP      3328
#define XB_TOPGEN   3392
#define XCD_BAR_WORDS 3456
#define XB_SPIN_CAP (1u << 20)
__device__ __forceinline__ unsigned xb_ld(unsigned* p)              { return __hip_atomic_load(p, __ATOMIC_RELAXED, __HIP_MEMORY_SCOPE_AGENT); }
__device__ __forceinline__ unsigned xb_add(unsigned* p, unsigned v) { return __hip_atomic_fetch_add(p, v, __ATOMIC_RELAXED, __HIP_MEMORY_SCOPE_AGENT); }
__device__ __forceinline__ unsigned xb_xcc_id() { return (unsigned)__builtin_amdgcn_s_getreg((3 << 11) | 20) & 0xFu; }
#define XB_SPIN(cond, bar) do { unsigned _sp = 0; while (cond) { __builtin_amdgcn_s_sleep(1); \
    if ((++_sp & 255u) == 0u) { if (xb_ld(&(bar)[XB_TMO])) break; if (_sp > XB_SPIN_CAP) { atomicAdd(&(bar)[XB_TMO], 1u); break; } } } } while (0)
__device__ __forceinline__ void xcd_barrier_complete(unsigned* bar, unsigned x, unsigned& nloc, unsigned& nx) {
    const unsigned G = gridDim.x;
    unsigned sum, cnt, mine, sp = 0u;
    for (;;) {
        sum = 0u; cnt = 0u; mine = 0u;
#pragma unroll
        for (unsigned j = 0; j < 16; ++j) { const unsigned c = xb_ld(&bar[XB_XCNT(j)]); sum += c; cnt += (c > 0u) ? 1u : 0u; mine = (j == x) ? c : mine; }
        if (sum == G) break;
        __builtin_amdgcn_s_sleep(1);
        if ((++sp & 255u) == 0u) { if (xb_ld(&bar[XB_TMO])) break; if (sp > XB_SPIN_CAP) { atomicAdd(&bar[XB_TMO], 1u); break; } }
    }
    nloc = mine > 0u ? mine : 1u; nx = cnt > 0u ? cnt : 1u;
}
__device__ __forceinline__ void xcd_barrier(unsigned* bar, volatile LAS unsigned* st, int wave) {
    asm volatile("s_waitcnt vmcnt(0) lgkmcnt(0)" ::: "memory");
    __syncthreads();
    int lane; asm volatile("v_mbcnt_lo_u32_b32 %0, -1, 0\n\tv_mbcnt_hi_u32_b32 %0, -1, %0" : "=v"(lane));
    if (wave == 0 && lane == 0) {
        __builtin_amdgcn_s_waitcnt(0);
        const unsigned x = xb_xcc_id();
        unsigned nloc = st[0], nx = st[1];
        if (nloc == 0u) { xcd_barrier_complete(bar, x, nloc, nx); st[0] = nloc; st[1] = nx; }
        const unsigned old = xb_add(&bar[XB_XSUB(x)], 1u);
        const unsigned gen = old / nloc;
        if (old + 1u == (gen + 1u) * nloc) {
            __builtin_amdgcn_fence(__ATOMIC_RELEASE, "agent");
            asm volatile("s_waitcnt vmcnt(0)" ::: "memory");
            const unsigned og = xb_add(&bar[XB_TOP], 1u);
            const unsigned tg = og / nx;
            if (og + 1u == (tg + 1u) * nx) xb_add(&bar[XB_TOPGEN], 1u);
            else XB_SPIN(xb_ld(&bar[XB_TOPGEN]) == tg, bar);
            __builtin_amdgcn_fence(__ATOMIC_ACQUIRE, "agent");
            xb_add(&bar[XB_XGEN(x)], 1u);
            asm volatile("s_waitcnt vmcnt(0)" ::: "memory");
        } else {
            XB_SPIN(xb_ld(&bar[XB_XGEN(x)]) == gen, bar);
            __builtin_amdgcn_fence(__ATOMIC_ACQUIRE, "agent");
            asm volatile("s_waitcnt vmcnt(0)" ::: "memory");
        }
    }
    __syncthreads();
}

struct Params {
    const float* in[18];
    float* out; unsigned char* ws;
};
enum { I_X = 0, I_EV_WIN, I_EV_CONV, I_EV_ALOG, I_EV_DTB, I_EV_GDNN, I_EV_HGRNN, I_LBLOG, I_EV_WOUT, I_OD_WIN, I_OD_WOUT, I_RW, I_RB, I_MG, I_MU, I_MD, I_LNG, I_LNB };

struct Frame {
    LAS unsigned char* lds;
    int tid, lane, wave, G, bid;
};
__device__ __forceinline__ Frame refresh(const Frame& F0) {
    Frame F = F0; int l; asm volatile("v_mbcnt_lo_u32_b32 %0, -1, 0\n\tv_mbcnt_hi_u32_b32 %0, -1, %0" : "=v"(l));
    F.lane = l; F.tid = F0.wave * 64 + l; return F;
}

constexpr size_t WS_W3 = WS_AB + 16 * MiB, WS_WOUT1 = WS_WOUT + 4 * MiB, WS_WGU1 = WS_WGU + 32 * MiB;
struct CDesc { const float* src; unsigned char* dst; int ld, Kd, fp8; };
__device__ __forceinline__ CDesc conv_desc(const Params& p, unsigned char* ws, int kind, int r) {
    CDesc d;
    switch (kind) {
    case 0: { const int kb = r / 256, nb = r % 256, n0 = nb * 32; const int c0 = n0 < 4096 ? n0 : n0 + 16;
        d.src = p.in[I_EV_WIN] + (size_t)(kb * 64) * EVEN_IN + c0; d.ld = EVEN_IN; d.dst = ws + WS_WIN + (size_t)n0 * 2048 + kb * 64; d.Kd = 2048; d.fp8 = 1; break; }
    case 1: { const int kb = r / 64, nb = r % 64; d.src = p.in[I_EV_WOUT] + (size_t)(kb * 64) * 2048 + nb * 32; d.ld = 2048; d.dst = ws + WS_WOUT + (size_t)(nb * 32) * 2048 + kb * 64; d.Kd = 2048; d.fp8 = 1; break; }
    case 2: case 6: { const int layer = kind == 6; const int isup = r >= 8192; if (isup) r -= 8192;
        const int e = r / 512, q = r % 512, kb = q / 16, nb = q % 16, f0 = nb * 32;
        d.src = (isup ? p.in[I_MU] : p.in[I_MG]) + (size_t)(layer * NE + e) * 2048 * 512 + (size_t)(kb * 64) * 512 + f0; d.ld = 512;
        d.dst = ws + (layer ? WS_WGU1 : WS_WGU) + (size_t)e * 1024 * 2048 + (size_t)(256 * (f0 >> 7) + 128 * isup + (f0 & 127)) * 2048 + kb * 64; d.Kd = 2048; d.fp8 = 1; break; }
    case 3: case 7: { const int layer = kind == 7; const int e = r / 512, q = r % 512, kb = q / 64, nb = q % 64;
        d.src = p.in[I_MD] + (size_t)(layer * NE + e) * 512 * 2048 + (size_t)(kb * 64) * 2048 + nb * 32; d.ld = 2048;
        d.dst = ws + WS_WD + ((size_t)e * 2048 * 512 + (size_t)(nb * 32) * 512 + kb * 64) * 2; d.Kd = 512; d.fp8 = 0; break; }
    case 4: { const int kb = r / 192, nb = r % 192; d.src = p.in[I_OD_WIN] + (size_t)(kb * 64) * ODD_IN + nb * 32; d.ld = ODD_IN; d.dst = ws + WS_W3 + (size_t)(nb * 32) * 2048 + kb * 64; d.Kd = 2048; d.fp8 = 1; break; }
    default: { const int kb = r / 64, nb = r % 64; d.src = p.in[I_OD_WOUT] + (size_t)(kb * 64) * 2048 + nb * 32; d.ld = 2048; d.dst = ws + WS_WOUT1 + (size_t)(nb * 32) * 1024 + kb * 64; d.Kd = 1024; d.fp8 = 1; break; }
    }
    return d;
}
__device__ __forceinline__ void conv_load(const CDesc& d, int lane, float (&wv)[32]) {
    const float* wp = d.src + (size_t)(lane >> 5) * d.ld + (lane & 31);
#pragma unroll
    for (int i = 0; i < 32; ++i) wv[i] = __builtin_nontemporal_load(wp + (size_t)(2 * i) * d.ld);
}
__device__ __forceinline__ void conv_store(const CDesc& d, int lane, const float (&wv)[32], LAS float* scr) {
#pragma unroll
    for (int i = 0; i < 32; ++i) scr[(2 * i + (lane >> 5)) * 33 + (lane & 31)] = wv[i];
    LDS_WAIT(); asm volatile("" ::: "memory");
    if (d.fp8) {
        const int c = lane & 3;
#pragma unroll
        for (int j = 0; j < 2; ++j) { const int n = (lane >> 2) + 16 * j; const LAS float* sp = scr + (16 * c) * 33 + n;
            u32x4 o;
            o.x = pk4_fp8(sp[0 * 33] * W_PRE, sp[1 * 33] * W_PRE, sp[2 * 33] * W_PRE, sp[3 * 33] * W_PRE);     o.y = pk4_fp8(sp[4 * 33] * W_PRE, sp[5 * 33] * W_PRE, sp[6 * 33] * W_PRE, sp[7 * 33] * W_PRE);
            o.z = pk4_fp8(sp[8 * 33] * W_PRE, sp[9 * 33] * W_PRE, sp[10 * 33] * W_PRE, sp[11 * 33] * W_PRE);   o.w = pk4_fp8(sp[12 * 33] * W_PRE, sp[13 * 33] * W_PRE, sp[14 * 33] * W_PRE, sp[15 * 33] * W_PRE);
            *(u32x4*)(d.dst + (size_t)n * d.Kd + 16 * c) = o; }
    } else {
        const int c = lane & 7;
#pragma unroll
        for (int j = 0; j < 4; ++j) { const int n = (lane >> 3) + 8 * j; const LAS float* sp = scr + (8 * c) * 33 + n;
            u32x4 o; o.x = pk2(sp[0 * 33], sp[1 * 33]); o.y = pk2(sp[2 * 33], sp[3 * 33]); o.z = pk2(sp[4 * 33], sp[5 * 33]); o.w = pk2(sp[6 * 33], sp[7 * 33]);
            *(u32x4*)(d.dst + ((size_t)n * d.Kd + 8 * c) * 2) = o; }
    }
    LDS_WAIT(); asm volatile("" ::: "memory");
}
__device__ __forceinline__ CDesc conv_item(const Params& p, unsigned char* ws, int set, int it) {
    if (set == 0) return it < 8192 ? conv_desc(p, ws, 0, it) : conv_desc(p, ws, 1, it - 8192);
    if (set == 1) { int r = it;
        if (r < 16384) return conv_desc(p, ws, 2, r); r -= 16384;
        if (r < 8192) return conv_desc(p, ws, 3, r); r -= 8192;
        if (r < 6144) return conv_desc(p, ws, 4, r); r -= 6144;
        if (r < 1024) return conv_desc(p, ws, 5, r); r -= 1024;
        return conv_desc(p, ws, 6, r); }
    return conv_desc(p, ws, 7, it);
}
__device__ __forceinline__ void convert_set(const Params& p, const Frame& F0, int set, int w, int nw) {
    const Frame F = refresh(F0);
    LAS float* scr = (LAS float*)(F.lds + F.wave * 16384);
    unsigned char* ws = opq(p.ws);
    const int N = set == 0 ? 8192 + 2048 : set == 1 ? 16384 + 8192 + 6144 + 1024 + 16384 : 8192;
    for (int it = w; it < N; it += 2 * nw) {
        const bool two = it + nw < N;
        const CDesc d0 = conv_item(p, ws, set, it), d1 = conv_item(p, ws, set, two ? it + nw : it);
        float v0[32], v1[32];
        conv_load(d0, F.lane, v0); if (two) conv_load(d1, F.lane, v1);
        conv_store(d0, F.lane, v0, scr); if (two) conv_store(d1, F.lane, v1, scr);
    }
}

__device__ __forceinline__ void load_w16_lds(const Frame& F0, const float* W, int ld, int c0) {
    const Frame F = refresh(F0);
    LAS float* l = (LAS float*)F.lds;
    for (int i = F.tid; i < 2048 * 16; i += NTHR) { const int k = i >> 4, e = i & 15; l[e * 2048 + k] = W[(size_t)k * ld + c0 + e]; }
}
__device__ __forceinline__ float dot16(const Frame& F, const f32x4 (&v)[8]) {
    const LAS f32x4* l = (const LAS f32x4*)F.lds;
    float res = 0.f;
#pragma unroll 1
    for (int e = 0; e < 16; ++e) { float s = 0.f;
#pragma unroll
        for (int j = 0; j < 8; ++j) { const f32x4 w = l[e * 512 + 64 * j + F.lane]; s += (v[j].x * w.x + v[j].y * w.y) + (v[j].z * w.z + v[j].w * w.w); }
        s = wave_sum(s); res = (F.lane == e) ? s : res; }
    return res;
}

__device__ __forceinline__ void p0_xpass(const Params& p, const Frame& F0) {
    const Frame F = refresh(F0);
    const int gw = F.bid * NWAVES + F.wave, NGW = F.G * NWAVES;
    float* BA = (float*)(opq(p.ws) + WS_BA); bf16_t* AB = (bf16_t*)(opq(p.ws) + WS_AB);
    for (int m = gw; m < T; m += NGW) {
        const f32x4* xr = (const f32x4*)(p.in[I_X] + (size_t)m * D) + F.lane;
        f32x4 v[8];
#pragma unroll
        for (int j = 0; j < 8; ++j) v[j] = xr[64 * j];
        unsigned* o = (unsigned*)((unsigned char*)AB + (size_t)m * D) + F.lane;
#pragma unroll
        for (int j = 0; j < 8; ++j) o[64 * j] = pk4_fp8(v[j].x * X_PRE, v[j].y * X_PRE, v[j].z * X_PRE, v[j].w * X_PRE);
        const float a = dot16(F, v);
        if (F.lane < 16) BA[(size_t)m * 16 + F.lane] = a;
    }
}

constexpr size_t WS_R16A = WS_OC + 16 * MiB, WS_R16B = WS_SCR + 190 * MiB;
__device__ __forceinline__ bf16_t* r16_row(unsigned char* ws, int m) { return (bf16_t*)(ws + (m < T / 2 ? WS_R16A + (size_t)m * D * 2 : WS_R16B + (size_t)(m - T / 2) * D * 2)); }
template <bool ROUTE, bool TWO, bool RES16, bool OUT16>
__device__ __forceinline__ void ln_pass(const Params& p, const Frame& F0, const float* resid, const bf16_t* add1, int ld1, const bf16_t* add2, const float* gain, const float* bias,
                                        float* outf, bf16_t* outb, int layer) {
    const Frame F = refresh(F0);
    const int TPB = (T + F.G - 1) / F.G;
    const int mbeg = ROUTE ? F.bid * TPB + F.wave : F.bid * NWAVES + F.wave, mend = ROUTE ? min(T, (F.bid + 1) * TPB) : T, mstep = ROUTE ? NWAVES : F.G * NWAVES;
    int* SEL = (int*)(opq(p.ws) + WS_CTL + 65536);
    int* HIST = (int*)(opq(p.ws) + WS_CTL + 32768);
    LAS int* lhist = (LAS int*)(F.lds + pg8::MOE_HIST_OFF);
    float* gatew = (float*)(opq(p.ws) + WS_GATEW) + (size_t)layer * 2 * T;
    if (ROUTE) { if (F.tid < NE) lhist[F.tid] = 0; __syncthreads(); }
    f32x4 gn[8], bs[8];
#pragma unroll
    for (int j = 0; j < 8; ++j) { gn[j] = ((const f32x4*)gain)[64 * j + F.lane]; bs[j] = ((const f32x4*)bias)[64 * j + F.lane]; }
    f32x4 nxf[8]; u32x2 nx16[8], na1[8], na2[8];
    const GAS float* residg = (const GAS float*)resid; const GAS bf16_t* add1g = (const GAS bf16_t*)add1; const GAS bf16_t* add2g = (const GAS bf16_t*)add2;
#define LN_LOAD(mm) do { const GAS f32x4* xr = (const GAS f32x4*)(residg + (size_t)(mm) * D) + F.lane; const GAS u32x2* xr16 = (const GAS u32x2*)r16_row(opqg(p.ws), (mm)) + F.lane; \
        _Pragma("unroll") for (int j = 0; j < 8; ++j) { \
            if (RES16) nx16[j] = xr16[64 * j]; else nxf[j] = xr[64 * j]; \
            if (add1) na1[j] = ((const GAS u32x2*)(add1g + (size_t)(TWO ? 2 * (mm) : (mm)) * ld1))[64 * j + F.lane]; \
            if (TWO) na2[j] = ((const GAS u32x2*)(add2g + (size_t)(2 * (mm) + 1) * ld1))[64 * j + F.lane]; } } while (0)
    if (mbeg < mend) LN_LOAD(mbeg);
    for (int m = mbeg; m < mend; m += mstep) {
        f32x4 v[8]; float s = 0.f;
#pragma unroll
        for (int j = 0; j < 8; ++j) {
            if (RES16) { const u32x2 a = nx16[j]; v[j] = (f32x4){bflo(a.x), bfhi(a.x), bflo(a.y), bfhi(a.y)} * ALPHA; }
            else v[j] = nxf[j] * ALPHA;
            if (add1) { const u32x2 a = na1[j]; v[j].x += bflo(a.x); v[j].y += bfhi(a.x); v[j].z += bflo(a.y); v[j].w += bfhi(a.y); }
            if (TWO) { const u32x2 a = na2[j]; v[j].x += bflo(a.x); v[j].y += bfhi(a.x); v[j].z += bflo(a.y); v[j].w += bfhi(a.y); }
#ifdef DBG_SANITIZE
            if (!(fabsf(v[j].x) < 1e30f)) v[j].x = 0.f; if (!(fabsf(v[j].y) < 1e30f)) v[j].y = 0.f; if (!(fabsf(v[j].z) < 1e30f)) v[j].z = 0.f; if (!(fabsf(v[j].w) < 1e30f)) v[j].w = 0.f;
#endif
            s += (v[j].x + v[j].y) + (v[j].z + v[j].w);
        }
        if (m + mstep < mend) LN_LOAD(m + mstep);
        const float mean = wave_sum(s) * (1.f / D); float s2 = 0.f;
#pragma unroll
        for (int j = 0; j < 8; ++j) { v[j] = v[j] - mean; s2 += (v[j].x * v[j].x + v[j].y * v[j].y) + (v[j].z * v[j].z + v[j].w * v[j].w); }
        const float rstd = 1.f / sqrtf(wave_sum(s2) * (1.f / D) + LN_EPS);
#pragma unroll
        for (int j = 0; j < 8; ++j) v[j] = v[j] * rstd * gn[j] + bs[j];
        if (OUT16) { u32x2* of = (u32x2*)r16_row(opq(p.ws), m) + F.lane;
#pragma unroll
            for (int j = 0; j < 8; ++j) { u32x2 w; w.x = pk2(v[j].x, v[j].y); w.y = pk2(v[j].z, v[j].w); of[64 * j] = w; } }
        else { f32x4* of = (f32x4*)(outf + (size_t)m * D) + F.lane;
#pragma unroll
            for (int j = 0; j < 8; ++j) of[64 * j] = v[j]; }
        if (outb) {
            { unsigned* o = (unsigned*)((unsigned char*)outb + (size_t)m * D) + F.lane;
#pragma unroll
                for (int j = 0; j < 8; ++j) o[64 * j] = pk4_fp8(v[j].x, v[j].y, v[j].z, v[j].w); } }
        if (ROUTE) {
            const float lgl = dot16(F, v);
            const float scl = 1.0f / (1.0f + expf(-lgl)), bil = scl + p.in[I_RB][F.lane & 15];
            float sc[16], bi[16];
#pragma unroll
            for (int e = 0; e < 16; ++e) { sc[e] = __builtin_bit_cast(float, __builtin_amdgcn_readlane(__builtin_bit_cast(int, scl), e)); bi[e] = __builtin_bit_cast(float, __builtin_amdgcn_readlane(__builtin_bit_cast(int, bil), e)); }
            int bg = 0; float bgs = -3.0e38f;
#pragma unroll
            for (int g = 0; g < 4; ++g) { float m1 = -3.0e38f, m2 = -3.0e38f;
#pragma unroll
                for (int k = 0; k < 4; ++k) { const float x = bi[4 * g + k]; if (x > m1) { m2 = m1; m1 = x; } else if (x > m2) m2 = x; }
                const float gs = m1 + m2; if (gs > bgs) { bgs = gs; bg = g; } }
            int i1 = 0, i2 = 0; float b1 = -3.0e38f, b2 = -3.0e38f, s1 = 0.f, s2v = 0.f;
#pragma unroll
            for (int e = 0; e < 16; ++e) { if ((e >> 2) == bg) { const float x = bi[e]; if (x > b1) { b2 = b1; i2 = i1; s2v = s1; b1 = x; i1 = e; s1 = sc[e]; } else if (x > b2) { b2 = x; i2 = e; s2v = sc[e]; } } }
            if (F.lane == 0) {
                const float den = s1 + s2v;
                SEL[m] = i1 | (i2 << 8); gatew[2 * m] = s1 / den; gatew[2 * m + 1] = s2v / den;
                __hip_atomic_fetch_add(lhist + i1, 1, __ATOMIC_RELAXED, __HIP_MEMORY_SCOPE_WORKGROUP); __hip_atomic_fetch_add(lhist + i2, 1, __ATOMIC_RELAXED, __HIP_MEMORY_SCOPE_WORKGROUP);
            }
        }
    }
#undef LN_LOAD
    if (ROUTE) { __syncthreads(); if (F.tid < NE) HIST[F.bid * NE + F.tid] = lhist[F.tid]; }
}

__device__ __forceinline__ void moe_lists(const Params& p, const Frame& F0, int layer) {
    const Frame F = refresh(F0);
    const int* SEL = (const int*)(opq(p.ws) + WS_CTL + 65536);
    const int* HIST = (const int*)(opq(p.ws) + WS_CTL + 32768);
    int* list = (int*)(opq(p.ws) + WS_LIST) + (size_t)layer * NE * T;
    LAS int* ltot = (LAS int*)(F.lds + pg8::MOE_HIST_OFF) + 16;
    LAS int* lbase = (LAS int*)(F.lds + pg8::MOE_HIST_OFF) + 32;
    if (F.tid < NE) { ltot[F.tid] = 0; lbase[F.tid] = 0; }
    __syncthreads();
    { const int e = F.tid & 15, grp = F.tid >> 4; int base = 0, tot = 0;
#pragma unroll 8
      for (int b = grp; b < F.G; b += 32) { const int h = HIST[b * NE + e]; tot += h; if (b < F.bid) base += h; }
      __hip_atomic_fetch_add(ltot + e, tot, __ATOMIC_RELAXED, __HIP_MEMORY_SCOPE_WORKGROUP); __hip_atomic_fetch_add(lbase + e, base, __ATOMIC_RELAXED, __HIP_MEMORY_SCOPE_WORKGROUP); }
    __syncthreads();
    LAS int* ltpre = (LAS int*)(F.lds + pg8::MOE_HIST_OFF) + 48;
    LAS int* lslot = (LAS int*)(F.lds + pg8::MOE_HIST_OFF) + 64;
    if (F.tid == 0) { int sacc = 0;
#pragma unroll 1
        for (int e = 0; e < NE; ++e) { ltpre[e] = sacc; sacc += (ltot[e] + 255) >> 8; } }
    __syncthreads();
    const int TPB = (T + F.G - 1) / F.G, m0 = F.bid * TPB, m1 = min(T, m0 + TPB);
    if (F.wave == 0) {
        for (int q0 = 2 * m0; q0 < 2 * m1; q0 += 64) {
            const int q = q0 + F.lane; const bool ok = q < 2 * m1;
            int e = -1; if (ok) { const int sv = SEL[q >> 1]; e = (q & 1) ? ((sv >> 8) & 255) : (sv & 255); }
            int rank = 0, cntsame = 0;
#pragma unroll 1
            for (int k = 0; k < NE; ++k) { const unsigned long long bal = __ballot(e == k); if (e == k) { rank = __popcll(bal & ((1ull << F.lane) - 1ull)); cntsame = __popcll(bal); } }
            if (ok) { const int pos = lbase[e] + rank; list[e * T + pos] = q; lslot[q - 2 * m0] = 256 * ltpre[e] + pos; }
            __builtin_amdgcn_s_waitcnt(0);
            if (ok && rank == cntsame - 1) lbase[e] += cntsame;
            __builtin_amdgcn_s_waitcnt(0);
        }
    }
    __syncthreads();
    {
        const unsigned char* AB8 = opq(p.ws) + WS_AB; unsigned char* ABS = opq(p.ws) + WS_ABS;
        const int nt_ = m1 - m0;
        for (int t0 = F.wave; t0 < nt_; t0 += 4 * NWAVES) {
            u32x4 r0[4], r1[4];
#pragma unroll
            for (int k = 0; k < 4; ++k) { const int tt = t0 + k * NWAVES; if (tt < nt_) { const u32x4* src = (const u32x4*)(AB8 + (size_t)(m0 + tt) * D) + F.lane; r0[k] = src[0]; r1[k] = src[64]; } }
#pragma unroll
            for (int k = 0; k < 4; ++k) { const int tt = t0 + k * NWAVES; if (tt < nt_) {
#pragma unroll
                for (int jj = 0; jj < 2; ++jj) { u32x4* dst = (u32x4*)(ABS + (size_t)lslot[2 * tt + jj] * D) + F.lane; dst[0] = r0[k]; dst[64] = r1[k]; } } }
        }
    }
}

constexpr int H1LD = 8192, C_ZA = 3072, C_QB = 4096, C_FB = 5120, C_IB = 6144, C_GB = 7168;
constexpr size_t G_U0 = 0;
constexpr size_t G_WM = 32 * MiB;
constexpr size_t G_QD = 48 * MiB;
constexpr size_t G_KDT = 64 * MiB;
constexpr size_t G_QK = 80 * MiB;
constexpr size_t G_CD = 88 * MiB;
constexpr size_t H_QD = 89 * MiB;
constexpr size_t H_KI = 105 * MiB;
constexpr size_t H_KDT = 121 * MiB;
constexpr size_t H_IT = 137 * MiB;
constexpr size_t H_CD = 153 * MiB;
constexpr size_t O_A = 155 * MiB;
constexpr size_t O_B = 171 * MiB;
static_assert(O_B + 16 * MiB <= 216 * MiB, "mixer-0 scratch");

__device__ __forceinline__ f32x4 mfma32(bf16x8 a, bf16x8 b, f32x4 c) { return __builtin_amdgcn_mfma_f32_16x16x32_bf16(a, b, c, 0, 0, 0); }
__device__ __forceinline__ f32x4 mfma16(bf16x4 a, bf16x4 b, f32x4 c) { const bf16x8 a8 = {a[0], a[1], a[2], a[3], 0, 0, 0, 0}, b8 = {b[0], b[1], b[2], b[3], 0, 0, 0, 0}; return __builtin_amdgcn_mfma_f32_16x16x32_bf16(a8, b8, c, 0, 0, 0); }
__device__ __forceinline__ bf16x8 pack8(f32x4 lo, f32x4 hi) {
    u32x4 w; w.x = cvt_pk_bf16(lo[0], lo[1]); w.y = cvt_pk_bf16(lo[2], lo[3]); w.z = cvt_pk_bf16(hi[0], hi[1]); w.w = cvt_pk_bf16(hi[2], hi[3]); return __builtin_bit_cast(bf16x8, w);
}
__device__ __forceinline__ bf16x4 pack4(f32x4 v) { u32x2 w; w.x = cvt_pk_bf16(v[0], v[1]); w.y = cvt_pk_bf16(v[2], v[3]); return __builtin_bit_cast(bf16x4, w); }
__device__ __forceinline__ bf16x8 frag_perm(const LAS bf16_t* rowp, int col) {
    const u32x2 lo = *(const LAS u32x2*)(rowp + col), hi = *(const LAS u32x2*)(rowp + col + 16);
    u32x4 w; w.x = lo.x; w.y = lo.y; w.z = hi.x; w.w = hi.y; return __builtin_bit_cast(bf16x8, w);
}

__device__ __forceinline__ void gdn_pre_pair(const Params& p, const Frame& F, int unit0, int unit1) {
    const int hb = F.wave >> 2, w4 = F.wave & 3, t8 = F.tid & 255, lane = F.lane, fr = lane & 15, g = lane >> 4;
    const int unit = hb ? unit1 : unit0;
    const bool active = unit < 1024;
    const int bh = unit >> 5, ci = unit & 31, b = bh >> 3, h = bh & 7;
    const int tok0 = b * SEQ + ci * 64;
    LAS unsigned char* hl = F.lds + hb * 72192;
    LAS bf16_t* Qb = (LAS bf16_t*)(hl);
    LAS bf16_t* Kb = (LAS bf16_t*)(hl + 17408);
    LAS bf16_t* RVt = (LAS bf16_t*)(hl + 34816);
    LAS bf16_t* RKt = (LAS bf16_t*)(hl + 53248);
    LAS float* sc_g = (LAS float*)(hl + 71680);
    LAS float* sc_b = sc_g + 64;
    LAS float* Lm = (LAS float*)(hl);
    LAS bf16_t* Tb = (LAS bf16_t*)(hl + 17408);
    const bf16_t* H1 = (const bf16_t*)(opq(p.ws) + WS_H1);
    const float* BA = (const float*)(opq(p.ws) + WS_BA);
    unsigned char* scr = opq(p.ws) + WS_SCR;
    if (active) {
        if (t8 < 192) {
            const int sec = t8 >> 6, c2 = (t8 & 63) * 2;
            const int col = sec * 1024 + h * 128 + c2;
            const float* cw = p.in[I_EV_CONV] + col;
            const float w0a = cw[0], w0b = cw[1], w1a = cw[3072], w1b = cw[3073], w2a = cw[6144], w2b = cw[6145], w3a = cw[9216], w3b = cw[9217];
            float xa[3], xb[3];
#pragma unroll
            for (int k = 0; k < 3; ++k) { const int s = ci * 64 - 3 + k; unsigned v = 0u; if (s >= 0) v = *(const unsigned*)(H1 + (size_t)(b * SEQ + s) * H1LD + col); xa[k] = bflo(v); xb[k] = bfhi(v); }
#pragma unroll 1
            for (int q2 = 0; q2 < 2; ++q2) {
                unsigned vv[32];
                if (sec == 2) { sc_b[32 * q2 + (lane & 31)] = sigmoidf_(BA[(size_t)(tok0 + 32 * q2 + (lane & 31)) * 16 + h]); LDS_WAIT(); }
#pragma unroll
                for (int tl = 0; tl < 32; ++tl) vv[tl] = *(const unsigned*)(H1 + (size_t)(tok0 + 32 * q2 + tl) * H1LD + col);
#pragma unroll
                for (int t2 = 0; t2 < 32; ++t2) {
                    const int tl = 32 * q2 + t2;
                    const float x3a = bflo(vv[t2]), x3b = bfhi(vv[t2]);
                    float ya = w0a * xa[0] + w1a * xa[1] + w2a * xa[2] + w3a * x3a, yb = w0b * xb[0] + w1b * xb[1] + w2b * xb[2] + w3b * x3b;
                    xa[0] = xa[1]; xa[1] = xa[2]; xa[2] = x3a; xb[0] = xb[1]; xb[1] = xb[2]; xb[2] = x3b;
                    ya = siluf_(ya); yb = siluf_(yb);
                    if (sec == 0) *(LAS unsigned*)(Qb + tl * 136 + c2) = pk2(ya, yb);
                    else if (sec == 1) *(LAS unsigned*)(Kb + tl * 136 + c2) = pk2(ya, yb);
                    else { const float be = sc_b[tl]; RVt[c2 * 72 + tl] = (bf16_t)f2bf(ya * be); RVt[(c2 + 1) * 72 + tl] = (bf16_t)f2bf(yb * be); }
                }
            }
        } else {
            const int t = tok0 + lane;
            const float ba = BA[(size_t)t * 16 + h], aa = BA[(size_t)t * 16 + 8 + h];
            const float xx = aa + p.in[I_EV_DTB][h];
            const float sp = xx > 20.f ? xx : __logf(1.f + __expf(xx));
            float gg = -expf(p.in[I_EV_ALOG][h]) * sp;
            gg += dpp_f<0x111>(gg); gg += dpp_f<0x112>(gg); gg += dpp_f<0x114>(gg); gg += dpp_f<0x118>(gg);
            { const float t0 = __builtin_bit_cast(float, __builtin_amdgcn_readlane(__builtin_bit_cast(int, gg), 15)), t1 = __builtin_bit_cast(float, __builtin_amdgcn_readlane(__builtin_bit_cast(int, gg), 31)),
                          t2 = __builtin_bit_cast(float, __builtin_amdgcn_readlane(__builtin_bit_cast(int, gg), 47));
              gg += (lane >= 16 ? t0 : 0.f) + (lane >= 32 ? t1 : 0.f) + (lane >= 48 ? t2 : 0.f); }
            sc_g[lane] = gg; sc_b[lane] = sigmoidf_(ba);
        }
    }
    __syncthreads();
    if (active) {
        bf16_t* QDg = (bf16_t*)(scr + G_QD) + (size_t)unit * 64 * 128;
#pragma unroll 2
        for (int rr = 0; rr < 16; ++rr) {
            const int r = w4 * 16 + rr;
            const unsigned qv = *(const LAS unsigned*)(Qb + r * 136 + 2 * lane), kv = *(const LAS unsigned*)(Kb + r * 136 + 2 * lane);
            const float q0 = bflo(qv), q1 = bfhi(qv), k0 = bflo(kv), k1 = bfhi(kv);
            const float sq = wave_sum(q0 * q0 + q1 * q1), sk = wave_sum(k0 * k0 + k1 * k1);
            const float rq = rsqrtf(sq + RMS_EPS) * 0.08838834764831845f, rk = rsqrtf(sk + RMS_EPS);
            const float gc = sc_g[r], be = sc_b[r], eg = expf(gc);
            const float qn0 = q0 * rq, qn1 = q1 * rq, kn0 = k0 * rk, kn1 = k1 * rk;
            *(LAS unsigned*)(Qb + r * 136 + 2 * lane) = pk2(qn0, qn1);
            *(LAS unsigned*)(Kb + r * 136 + 2 * lane) = pk2(kn0, kn1);
            RKt[(2 * lane) * 72 + r] = (bf16_t)f2bf(kn0 * be * eg); RKt[(2 * lane + 1) * 72 + r] = (bf16_t)f2bf(kn1 * be * eg);
            *(unsigned*)(QDg + r * 128 + 2 * lane) = pk2(qn0 * eg, qn1 * eg);
        }
    }
    __syncthreads();
    f32x4 kk[4];
    if (active) {
        {
            bf16_t* KDt = (bf16_t*)(scr + G_KDT) + (size_t)unit * 128 * 64;
            const float gl = sc_g[63];
#pragma unroll
            for (int it = 0; it < 4; ++it) { const int idx = t8 + 256 * it, f = idx >> 3, c0 = (idx & 7) * 8;
                float v[8];
#pragma unroll
                for (int i = 0; i < 8; ++i) v[i] = bf2f(Kb[(c0 + i) * 136 + f]) * expf(gl - sc_g[c0 + i]);
                u32x4 w; w.x = pk2(v[0], v[1]); w.y = pk2(v[2], v[3]); w.z = pk2(v[4], v[5]); w.w = pk2(v[6], v[7]);
                *(u32x4*)(KDt + f * 64 + c0) = w; }
        }
        const int mt = w4;
        bf16_t* QKm = (bf16_t*)(scr + G_QK) + (size_t)unit * 64 * 64;
        bf16x8 a[4];
#pragma unroll
        for (int kb = 0; kb < 4; ++kb) a[kb] = *(const LAS bf16x8*)(Kb + (16 * mt + fr) * 136 + 32 * kb + 8 * g);
#pragma unroll
        for (int nt = 0; nt < 4; ++nt) {
            f32x4 c = (f32x4){0.f, 0.f, 0.f, 0.f}, c2 = (f32x4){0.f, 0.f, 0.f, 0.f};
#pragma unroll
            for (int kb = 0; kb < 4; ++kb) { const bf16x8 bq = *(const LAS bf16x8*)(Qb + (16 * nt + fr) * 136 + 32 * kb + 8 * g), bk = *(const LAS bf16x8*)(Kb + (16 * nt + fr) * 136 + 32 * kb + 8 * g);
                c = mfma32(a[kb], bq, c); c2 = mfma32(a[kb], bk, c2); }
            const int cj = 16 * nt + fr; const float gcol = sc_g[cj];
            {
                float v[4];
#pragma unroll
                for (int r = 0; r < 4; ++r) { const int j = 16 * mt + 4 * g + r; v[r] = (cj >= j) ? expf(gcol - sc_g[j]) * c[r] : 0.f; }
                u32x2 w; w.x = pk2(v[0], v[1]); w.y = pk2(v[2], v[3]);
                *(u32x2*)(QKm + cj * 64 + 16 * mt + 4 * g) = w;
            }
#pragma unroll
            for (int r = 0; r < 4; ++r) { const int i = 16 * mt + 4 * g + r; kk[nt][r] = (i > cj) ? sc_b[i] * expf(sc_g[i] - gcol) * c2[r] : 0.f; }
        }
    }
    __syncthreads();
    if (active) {
#pragma unroll
        for (int nt = 0; nt < 4; ++nt)
#pragma unroll
            for (int r = 0; r < 4; ++r) Lm[(16 * w4 + 4 * g + r) * 68 + 16 * nt + fr] = kk[nt][r];
    }
    __syncthreads();
    if (active && w4 == 0) {
        float t[64];
#pragma unroll
        for (int i = 0; i < 64; ++i) t[i] = 0.f;
#pragma unroll
        for (int i = 0; i < 64; ++i) {
            float a0 = (i == lane) ? 1.f : 0.f, a1 = 0.f, a2 = 0.f, a3 = 0.f;
#pragma unroll
            for (int jj = 0; jj < (i + 3) / 4; ++jj) { const f32x4 lv = *(const LAS f32x4*)(Lm + i * 68 + 4 * jj);
                a0 -= lv[0] * t[4 * jj]; a1 -= lv[1] * t[4 * jj + 1]; a2 -= lv[2] * t[4 * jj + 2]; a3 -= lv[3] * t[4 * jj + 3]; }
            t[i] = (a0 + a1) + (a2 + a3);
        }
#pragma unroll
        for (int i = 0; i < 64; ++i) Tb[i * 72 + lane] = (bf16_t)f2bf(t[i]);
    }
    __syncthreads();
    if (active) {
        f32x4* U0f = (f32x4*)(scr + G_U0) + (size_t)unit * 8 * 4 * 64;
        bf16_t* Wm = (bf16_t*)(scr + G_WM) + (size_t)unit * 64 * 128;
#pragma unroll
        for (int hh = 0; hh < 2; ++hh) {
            const int ct = w4 + 4 * hh;
            bf16x8 bv[2], ak[2];
#pragma unroll
            for (int k = 0; k < 2; ++k) { bv[k] = *(const LAS bf16x8*)(RVt + (16 * ct + fr) * 72 + 32 * k + 8 * g); ak[k] = *(const LAS bf16x8*)(RKt + (16 * ct + fr) * 72 + 32 * k + 8 * g); }
#pragma unroll
            for (int mt = 0; mt < 4; ++mt) {
                f32x4 c = (f32x4){0.f, 0.f, 0.f, 0.f}, c2 = (f32x4){0.f, 0.f, 0.f, 0.f};
#pragma unroll
                for (int k = 0; k < 2; ++k) { const bf16x8 tt = *(const LAS bf16x8*)(Tb + (16 * mt + fr) * 72 + 32 * k + 8 * g); c = mfma32(tt, bv[k], c); c2 = mfma32(ak[k], tt, c2); }
                U0f[(ct * 4 + mt) * 64 + lane] = c;
                u32x2 w; w.x = pk2(-c2[0], -c2[1]); w.y = pk2(-c2[2], -c2[3]);
                *(u32x2*)(Wm + (16 * mt + fr) * 128 + 16 * ct + 4 * g) = w;
            }
        }
        if (t8 == 0) ((float*)(scr + G_CD))[unit] = expf(sc_g[63]);
    }
    __syncthreads();
}

__device__ __forceinline__ void hgrn_pre_unit(const Params& p, const Frame& F, int tc) {
    const int col = 2 * F.tid, h = col >> 7, f = col & 127;
    const float* lbl = p.in[I_LBLOG];
    float lb[2];
#pragma unroll
    for (int k = 0; k < 2; ++k) { const float l0 = lbl[col + k], l1 = lbl[1024 + col + k], l2 = lbl[2048 + col + k]; const float m = fmaxf(l0, fmaxf(l1, l2));
        const float e0 = expf(l0 - m), e1 = expf(l1 - m), e2 = expf(l2 - m); lb[k] = e0 / (e0 + e1 + e2); }
    const int t0 = tc * 16, b = t0 / SEQ, chunk = (t0 % SEQ) >> 4, bh = b * 8 + h;
    const bf16_t* H1 = (const bf16_t*)(opq(p.ws) + WS_H1);
    unsigned char* scr = opq(p.ws) + WS_SCR;
    float bc0[16], bc1[16], kk0[16], kk1[16]; unsigned iv[16];
    float cum0 = 0.f, cum1 = 0.f;
    unsigned qva[16], fva[16];
#pragma unroll
    for (int c = 0; c < 16; ++c) { const size_t row = (size_t)(t0 + c);
        qva[c] = *(const unsigned*)(H1 + row * H1LD + C_QB + col); fva[c] = *(const unsigned*)(H1 + row * H1LD + C_FB + col); iv[c] = *(const unsigned*)(H1 + row * H1LD + C_IB + col); }
#pragma unroll
    for (int c = 0; c < 16; ++c) {
        const size_t row = (size_t)(t0 + c);
        const unsigned qv = qva[c], fv = fva[c];
        const float f0 = lb[0] + (1.f - lb[0]) * sigmoidf_(bflo(fv)), f1 = lb[1] + (1.f - lb[1]) * sigmoidf_(bfhi(fv));
        cum0 += logf(f0); cum1 += logf(f1);
        bc0[c] = cum0; bc1[c] = cum1; kk0[c] = 1.f - f0; kk1[c] = 1.f - f1;
        *(unsigned*)((bf16_t*)(scr + H_QD) + row * 1024 + col) = pk2(bflo(qv) * expf(cum0), bfhi(qv) * expf(cum1));
        *(unsigned*)((bf16_t*)(scr + H_KI) + row * 1024 + col) = pk2(kk0[c] * expf(-cum0), kk1[c] * expf(-cum1));
    }
    unsigned kd0[8], kd1[8], i0[8], i1[8];
#pragma unroll
    for (int c = 0; c < 16; c += 2) {
        kd0[c >> 1] = pk2(kk0[c] * expf(cum0 - bc0[c]), kk0[c + 1] * expf(cum0 - bc0[c + 1]));
        kd1[c >> 1] = pk2(kk1[c] * expf(cum1 - bc1[c]), kk1[c + 1] * expf(cum1 - bc1[c + 1]));
        i0[c >> 1] = (iv[c] & 0xffffu) | (iv[c + 1] << 16);
        i1[c >> 1] = (iv[c] >> 16) | (iv[c + 1] & 0xffff0000u);
    }
    const size_t base = ((size_t)(bh * 128 + chunk) * 128 + f) * 16;
    u32x4* kd = (u32x4*)((bf16_t*)(scr + H_KDT) + base); u32x4* it = (u32x4*)((bf16_t*)(scr + H_IT) + base);
    kd[0] = (u32x4){kd0[0], kd0[1], kd0[2], kd0[3]}; kd[1] = (u32x4){kd0[4], kd0[5], kd0[6], kd0[7]};
    kd[2] = (u32x4){kd1[0], kd1[1], kd1[2], kd1[3]}; kd[3] = (u32x4){kd1[4], kd1[5], kd1[6], kd1[7]};
    it[0] = (u32x4){i0[0], i0[1], i0[2], i0[3]}; it[1] = (u32x4){i0[4], i0[5], i0[6], i0[7]};
    it[2] = (u32x4){i1[0], i1[1], i1[2], i1[3]}; it[3] = (u32x4){i1[4], i1[5], i1[6], i1[7]};
    *(f32x2*)((float*)(scr + H_CD) + (size_t)(bh * 128 + chunk) * 128 + f) = (f32x2){expf(cum0), expf(cum1)};
}

__device__ __forceinline__ void p2_pre(const Params& p, const Frame& F0) {
    const Frame F = refresh(F0);
    for (int u = F.bid; u < 1024; u += 2 * F.G) gdn_pre_pair(p, F, u, u + F.G);
    for (int u = F.bid; u < 512; u += F.G) hgrn_pre_unit(p, F, u);
}

__device__ __forceinline__ void gdn_scan(const Params& p, const Frame& F0, int bh) {
    const Frame F = refresh(F0);
    const int lane = F.lane, fr = lane & 15, g = lane >> 4, wave = F.wave, b = bh >> 3, h = bh & 7;
    unsigned char* scr = opqg(p.ws) + WS_SCR;
    constexpr int BUFB = 62464, OFF_QD = 17408, OFF_KDT = 34816, OFF_QK = 53248;
    const bf16_t* gWM = (const bf16_t*)(scr + G_WM); const bf16_t* gQD = (const bf16_t*)(scr + G_QD);
    const bf16_t* gKDT = (const bf16_t*)(scr + G_KDT); const bf16_t* gQK = (const bf16_t*)(scr + G_QK);
    const f32x4* gU0 = (const f32x4*)(scr + G_U0); const float* gCD = (const float*)(scr + G_CD);
    bf16_t* OA = (bf16_t*)(scr + O_A);
    u32x4 rw[2], rq[2], rk[2], rqk; f32x4 u0c[4], u0n[4];
#define GS_ISSUE(u) do { _Pragma("unroll") for (int i = 0; i < 2; ++i) { const int idx = F.tid + 512 * i; \
        rw[i] = *(const u32x4*)(gWM + (size_t)(u) * 8192 + idx * 8); rq[i] = *(const u32x4*)(gQD + (size_t)(u) * 8192 + idx * 8); rk[i] = *(const u32x4*)(gKDT + (size_t)(u) * 8192 + idx * 8); } \
        rqk = *(const u32x4*)(gQK + (size_t)(u) * 4096 + F.tid * 8); \
        _Pragma("unroll") for (int mt = 0; mt < 4; ++mt) u0n[mt] = gU0[(((size_t)(u) * 8 + wave) * 4 + mt) * 64 + lane]; } while (0)
#define GS_WRITE(bufp) do { _Pragma("unroll") for (int i = 0; i < 2; ++i) { const int idx = F.tid + 512 * i; \
        *(LAS u32x4*)((bufp) + ((idx >> 4) * 136 + (idx & 15) * 8) * 2) = rw[i]; *(LAS u32x4*)((bufp) + OFF_QD + ((idx >> 4) * 136 + (idx & 15) * 8) * 2) = rq[i]; \
        *(LAS u32x4*)((bufp) + OFF_KDT + ((idx >> 3) * 72 + (idx & 7) * 8) * 2) = rk[i]; } \
        *(LAS u32x4*)((bufp) + OFF_QK + ((F.tid >> 3) * 72 + (F.tid & 7) * 8) * 2) = rqk; } while (0)
    f32x4 Sacc[8];
#pragma unroll
    for (int ft = 0; ft < 8; ++ft) Sacc[ft] = (f32x4){0.f, 0.f, 0.f, 0.f};
    GS_ISSUE(bh * 32);
    GS_WRITE(F.lds);
#pragma unroll
    for (int mt = 0; mt < 4; ++mt) u0c[mt] = u0n[mt];
    __syncthreads();
    float dec = ld_agent(gCD + bh * 32);
    for (int ci = 0; ci < 32; ++ci) {
        const int u = bh * 32 + ci;
        LAS unsigned char* buf = F.lds + (ci & 1) * BUFB;
        float decn = dec; if (ci + 1 < 32) decn = ld_agent(gCD + u + 1);
        if (ci + 1 < 32) GS_ISSUE(u + 1);
        const LAS bf16_t* WM = (const LAS bf16_t*)buf; const LAS bf16_t* QD = (const LAS bf16_t*)(buf + OFF_QD);
        const LAS bf16_t* KDT = (const LAS bf16_t*)(buf + OFF_KDT); const LAS bf16_t* QK = (const LAS bf16_t*)(buf + OFF_QK);
        bf16x8 Sbf[4];
#pragma unroll
        for (int kb = 0; kb < 4; ++kb) Sbf[kb] = pack8(Sacc[2 * kb], Sacc[2 * kb + 1]);
        f32x4 uacc[4], oacc[4];
#pragma unroll
        for (int mt = 0; mt < 4; ++mt) { uacc[mt] = u0c[mt]; oacc[mt] = (f32x4){0.f, 0.f, 0.f, 0.f}; }
        bf16x8 fa[8], fb[8];
#define GS_LD_UQ(dst, mt) do { _Pragma("unroll") for (int kb = 0; kb < 4; ++kb) { dst[kb] = frag_perm(WM + (16 * (mt) + fr) * 136, 32 * kb + 4 * g); dst[4 + kb] = frag_perm(QD + (16 * (mt) + fr) * 136, 32 * kb + 4 * g); } } while (0)
#define GS_MM_UQ(src, mt) do { _Pragma("unroll") for (int kb = 0; kb < 4; ++kb) { uacc[mt] = mfma32(src[kb], Sbf[kb], uacc[mt]); oacc[mt] = mfma32(src[4 + kb], Sbf[kb], oacc[mt]); } } while (0)
        GS_LD_UQ(fa, 0);
        GS_LD_UQ(fb, 1); __builtin_amdgcn_sched_barrier(0); GS_MM_UQ(fa, 0); __builtin_amdgcn_sched_barrier(0);
        GS_LD_UQ(fa, 2); __builtin_amdgcn_sched_barrier(0); GS_MM_UQ(fb, 1); __builtin_amdgcn_sched_barrier(0);
        GS_LD_UQ(fb, 3); __builtin_amdgcn_sched_barrier(0); GS_MM_UQ(fa, 2); __builtin_amdgcn_sched_barrier(0);
#pragma unroll
        for (int mt = 0; mt < 4; ++mt)
#pragma unroll
            for (int k = 0; k < 2; ++k) fa[2 * mt + k] = frag_perm(QK + (16 * mt + fr) * 72, 32 * k + 4 * g);
        __builtin_amdgcn_sched_barrier(0); GS_MM_UQ(fb, 3); __builtin_amdgcn_sched_barrier(0);
#undef GS_LD_UQ
#undef GS_MM_UQ
        bf16x8 ubf[2];
#pragma unroll
        for (int k = 0; k < 2; ++k) ubf[k] = pack8(uacc[2 * k], uacc[2 * k + 1]);
#pragma unroll
        for (int ft = 0; ft < 4; ++ft)
#pragma unroll
            for (int k = 0; k < 2; ++k) fb[2 * ft + k] = frag_perm(KDT + (16 * ft + fr) * 72, 32 * k + 4 * g);
        __builtin_amdgcn_sched_barrier(0);
#pragma unroll
        for (int mt = 0; mt < 4; ++mt)
#pragma unroll
            for (int k = 0; k < 2; ++k) oacc[mt] = mfma32(fa[2 * mt + k], ubf[k], oacc[mt]);
        __builtin_amdgcn_sched_barrier(0);
#pragma unroll
        for (int ft = 0; ft < 4; ++ft)
#pragma unroll
            for (int k = 0; k < 2; ++k) fa[2 * ft + k] = frag_perm(KDT + (16 * (4 + ft) + fr) * 72, 32 * k + 4 * g);
        __builtin_amdgcn_sched_barrier(0);
#pragma unroll
        for (int ft = 0; ft < 4; ++ft) {
            Sacc[ft] = Sacc[ft] * dec;
#pragma unroll
            for (int k = 0; k < 2; ++k) Sacc[ft] = mfma32(fb[2 * ft + k], ubf[k], Sacc[ft]);
        }
        __builtin_amdgcn_sched_barrier(0);
#pragma unroll
        for (int ft = 0; ft < 4; ++ft) {
            Sacc[4 + ft] = Sacc[4 + ft] * dec;
#pragma unroll
            for (int k = 0; k < 2; ++k) Sacc[4 + ft] = mfma32(fa[2 * ft + k], ubf[k], Sacc[4 + ft]);
        }
        dec = decn;
        {
            bf16_t* orow = OA + (size_t)(b * SEQ + ci * 64) * 1024 + h * 128 + 16 * wave + fr;
#pragma unroll
            for (int mt = 0; mt < 4; ++mt)
#pragma unroll
                for (int r = 0; r < 4; ++r) orow[(size_t)(16 * mt + 4 * g + r) * 1024] = (bf16_t)f2bf(oacc[mt][r]);
        }
        if (ci + 1 < 32) { GS_WRITE(F.lds + ((ci + 1) & 1) * BUFB);
#pragma unroll
            for (int mt = 0; mt < 4; ++mt) u0c[mt] = u0n[mt]; }
        asm volatile("s_waitcnt lgkmcnt(0)" ::: "memory"); __builtin_amdgcn_s_barrier();
    }
#undef GS_ISSUE
#undef GS_WRITE
}

__device__ __forceinline__ void hgrn_scan(const Params& p, const Frame& F0, int bh) {
    const Frame F = refresh(F0);
    const int lane = F.lane, fr = lane & 15, g = lane >> 4, wave = F.wave, b = bh >> 3, h = bh & 7;
    unsigned char* scr = opqg(p.ws) + WS_SCR;
    constexpr int BUFB = 61440, OFF_KI = 17408, OFF_KDT = 34816, OFF_CD = 59392;
    const bf16_t* gQD = (const bf16_t*)(scr + H_QD); const bf16_t* gKI = (const bf16_t*)(scr + H_KI);
    const bf16_t* gKDT = (const bf16_t*)(scr + H_KDT) + (size_t)bh * 128 * 128 * 16; const bf16_t* gIT = (const bf16_t*)(scr + H_IT) + (size_t)bh * 128 * 128 * 16;
    const float* gCD = (const float*)(scr + H_CD) + (size_t)bh * 128 * 128;
    bf16_t* OB = (bf16_t*)(scr + O_B);
    u32x4 rq[2], rk[2], rd[2], rc; u32x2 itn[4], itc[4];
#define HS_ISSUE(grp) do { _Pragma("unroll") for (int i = 0; i < 2; ++i) { const int idx = F.tid + 512 * i; const size_t go = (size_t)(b * SEQ + (grp) * 64 + (idx >> 4)) * 1024 + h * 128 + (idx & 15) * 8; \
        rq[i] = *(const u32x4*)(gQD + go); rk[i] = *(const u32x4*)(gKI + go); rd[i] = *(const u32x4*)(gKDT + (size_t)(grp) * 8192 + idx * 8); } \
        if (F.tid < 128) rc = *(const u32x4*)(gCD + (size_t)(grp) * 512 + F.tid * 4); \
        _Pragma("unroll") for (int sc = 0; sc < 4; ++sc) itn[sc] = *(const u32x2*)(gIT + ((size_t)((grp) * 4 + sc) * 128 + 16 * wave + fr) * 16 + 4 * g); } while (0)
#define HS_WRITE(bufp) do { _Pragma("unroll") for (int i = 0; i < 2; ++i) { const int idx = F.tid + 512 * i; \
        *(LAS u32x4*)((bufp) + ((idx >> 4) * 136 + (idx & 15) * 8) * 2) = rq[i]; *(LAS u32x4*)((bufp) + OFF_KI + ((idx >> 4) * 136 + (idx & 15) * 8) * 2) = rk[i]; \
        *(LAS u32x4*)((bufp) + OFF_KDT + ((idx >> 1) * 24 + (idx & 1) * 8) * 2) = rd[i]; } \
        if (F.tid < 128) *(LAS u32x4*)((bufp) + OFF_CD + F.tid * 16) = rc; } while (0)
    f32x4 Sacc[8];
#pragma unroll
    for (int ft = 0; ft < 8; ++ft) Sacc[ft] = (f32x4){0.f, 0.f, 0.f, 0.f};
    HS_ISSUE(0);
    HS_WRITE(F.lds);
#pragma unroll
    for (int sc = 0; sc < 4; ++sc) itc[sc] = itn[sc];
    __syncthreads();
    for (int grp = 0; grp < 32; ++grp) {
        LAS unsigned char* buf = F.lds + (grp & 1) * BUFB;
        if (grp + 1 < 32) HS_ISSUE(grp + 1);
        const LAS bf16_t* QD = (const LAS bf16_t*)buf; const LAS bf16_t* KI = (const LAS bf16_t*)(buf + OFF_KI);
        const LAS bf16_t* KDT = (const LAS bf16_t*)(buf + OFF_KDT); const LAS float* CD = (const LAS float*)(buf + OFF_CD);
        bf16x8 qfA[4], kfA[4], qfB[4], kfB[4];
#define HS_LDS(sc, X) do { _Pragma("unroll") for (int kb = 0; kb < 4; ++kb) { qf##X[kb] = frag_perm(QD + (16 * (sc) + fr) * 136, 32 * kb + 4 * g); kf##X[kb] = frag_perm(KI + (16 * (sc) + fr) * 136, 32 * kb + 4 * g); } \
            } while (0)
#define HS_SUB(sc, X) do { \
            f32x4 dd[8]; bf16x4 kd[8];        \
            _Pragma("unroll") for (int ft = 0; ft < 8; ++ft) { dd[ft] = *(const LAS f32x4*)(CD + (sc) * 128 + 16 * ft + 4 * g); kd[ft] = *(const LAS bf16x4*)(KDT + (((sc) * 128) + 16 * ft + fr) * 24 + 4 * g); } \
            bf16x8 Sbf[4]; \
            _Pragma("unroll") for (int kb = 0; kb < 4; ++kb) Sbf[kb] = pack8(Sacc[2 * kb], Sacc[2 * kb + 1]); \
            f32x4 o = (f32x4){0.f, 0.f, 0.f, 0.f}, pT = (f32x4){0.f, 0.f, 0.f, 0.f}; \
            _Pragma("unroll") for (int kb = 0; kb < 4; ++kb) { o = mfma32(qf##X[kb], Sbf[kb], o); pT = mfma32(kf##X[kb], qf##X[kb], pT); } \
            _Pragma("unroll") for (int r = 0; r < 4; ++r) pT[r] = (fr >= 4 * g + r) ? pT[r] : 0.f; \
            const bf16x4 itf = __builtin_bit_cast(bf16x4, itc[sc]); \
            o = mfma16(pack4(pT), itf, o); \
            _Pragma("unroll") for (int ft = 0; ft < 8; ++ft) Sacc[ft] = mfma16(kd[ft], itf, Sacc[ft] * dd[ft]); \
            bf16_t* orow = OB + (size_t)(b * SEQ + grp * 64 + (sc) * 16) * 1024 + h * 128 + 16 * wave + fr; \
            _Pragma("unroll") for (int r = 0; r < 4; ++r) orow[(size_t)(4 * g + r) * 1024] = (bf16_t)f2bf(o[r]); \
        } while (0)
        HS_LDS(0, A); __builtin_amdgcn_sched_barrier(0);
        HS_LDS(1, B); __builtin_amdgcn_sched_barrier(0); HS_SUB(0, A); __builtin_amdgcn_sched_barrier(0);
        HS_LDS(2, A); __builtin_amdgcn_sched_barrier(0); HS_SUB(1, B); __builtin_amdgcn_sched_barrier(0);
        HS_LDS(3, B); __builtin_amdgcn_sched_barrier(0); HS_SUB(2, A); __builtin_amdgcn_sched_barrier(0);
        HS_SUB(3, B);
#undef HS_LDS
#undef HS_SUB
        if (grp + 1 < 32) { HS_WRITE(F.lds + ((grp + 1) & 1) * BUFB);
#pragma unroll
            for (int sc = 0; sc < 4; ++sc) itc[sc] = itn[sc]; }
        asm volatile("s_waitcnt lgkmcnt(0)" ::: "memory"); __builtin_amdgcn_s_barrier();
    }
#undef HS_ISSUE
#undef HS_WRITE
}

__device__ __forceinline__ void p4_gate(const Params& p, const Frame& F0) {
    const Frame F = refresh(F0);
    const int gw = F.bid * NWAVES + F.wave, NGW = F.G * NWAVES, hs = F.lane >> 4, e0 = (F.lane & 15) * 8;
    unsigned char* scr = opq(p.ws) + WS_SCR;
    const bf16_t* H1 = (const bf16_t*)(opq(p.ws) + WS_H1); bf16_t* OC = (bf16_t*)(opq(p.ws) + WS_OC);
    for (int m = gw; m < T; m += NGW) {
#pragma unroll
        for (int rr = 0; rr < 4; ++rr) {
            const int hh = rr * 4 + hs;
            const bool isb = hh >= 8; const int hd = hh & 7;
            const bf16_t* osrc = (const bf16_t*)(scr + (isb ? O_B : O_A)) + (size_t)m * 1024 + hd * 128 + e0;
            const bf16_t* zsrc = H1 + (size_t)m * H1LD + (isb ? C_GB : C_ZA) + hd * 128 + e0;
            const float* gsrc = (isb ? p.in[I_EV_HGRNN] : p.in[I_EV_GDNN]) + e0;
            const u32x4 ov = *(const u32x4*)osrc, zv = *(const u32x4*)zsrc;
            const f32x4 g0 = *(const f32x4*)gsrc, g1 = *(const f32x4*)(gsrc + 4);
            float x[8] = {bflo(ov.x), bfhi(ov.x), bflo(ov.y), bfhi(ov.y), bflo(ov.z), bfhi(ov.z), bflo(ov.w), bfhi(ov.w)};
            const float z[8] = {bflo(zv.x), bfhi(zv.x), bflo(zv.y), bfhi(zv.y), bflo(zv.z), bfhi(zv.z), bflo(zv.w), bfhi(zv.w)};
            const float gn[8] = {g0[0], g0[1], g0[2], g0[3], g1[0], g1[1], g1[2], g1[3]};
            float ss = 0.f;
#pragma unroll
            for (int i = 0; i < 8; ++i) ss += x[i] * x[i];
            ss = row16_sum(ss);
            const float rinv = rsqrtf(ss * (1.f / 128.f) + RMS_EPS);
#pragma unroll
            for (int i = 0; i < 8; ++i) x[i] = x[i] * rinv * gn[i] * siluf_(z[i]);
            u32x2 w; w.x = pk4_fp8(x[0] * A_PRE, x[1] * A_PRE, x[2] * A_PRE, x[3] * A_PRE); w.y = pk4_fp8(x[4] * A_PRE, x[5] * A_PRE, x[6] * A_PRE, x[7] * A_PRE);
            *(u32x2*)((unsigned char*)OC + (size_t)m * 2048 + hh * 128 + e0) = w;
        }
    }
}

constexpr int H3LD = 6144;
constexpr size_t A_QR = 0;
constexpr size_t A_KR = 32 * MiB;
constexpr size_t A_VT = 64 * MiB;
constexpr size_t A_OG = 96 * MiB;
constexpr size_t A_LSE = 120 * MiB;
constexpr size_t A_KPART = 121 * MiB;
constexpr float QSCALE = 0.08838834764831845f * 1.4426950408889634f;
__device__ __forceinline__ int head_dil_log2(int hd) { return hd < 4 ? 0 : hd < 8 ? 2 : hd < 12 ? 4 : 0; }
__device__ __forceinline__ int posp(int s, int dl) { return ((s & ((1 << dl) - 1)) << (11 - dl)) + (s >> dl); }

__device__ __forceinline__ void rope_unit(const Params& p, const Frame& F, int unit) {
    const int hh = unit & 1, st = (unit >> 1) & 31, b = unit >> 6, s0 = st * 64;
    const bf16_t* H3 = (const bf16_t*)(opq(p.ws) + WS_H1);
    unsigned char* scr = opq(p.ws) + WS_SCR;
    bf16_t* QR = (bf16_t*)(scr + A_QR); bf16_t* KR = (bf16_t*)(scr + A_KR); bf16_t* VT = (bf16_t*)(scr + A_VT); float* KPART = (float*)(scr + A_KPART);
    LAS float* KS = (LAS float*)F.lds;
    LAS bf16_t* VL = (LAS bf16_t*)(F.lds + 33280);
    const int tok2 = F.tid >> 4, pj = (F.tid & 15) * 4;
    float cs[2][4], sn[2][4];
#pragma unroll
    for (int tt = 0; tt < 2; ++tt)
#pragma unroll
        for (int i = 0; i < 4; ++i) { const float inv = powf(10000.0f, -(float)(pj + i) * (1.0f / 64.0f)); const float ang = (float)(s0 + tok2 + 32 * tt) * inv; sincosf(ang, &sn[tt][i], &cs[tt][i]); }
    u32x2 na[2][2], nc[2][2]; u32x4 nv[2];
#define RP_LOAD(hi_) do { const int hd_ = hh * 8 + (hi_); \
        const int qcol_ = hd_ < 12 ? hd_ * 128 : 4608 + (hd_ - 12) * 128, kcol_ = hd_ < 12 ? 1536 + hd_ * 128 : 5120 + (hd_ - 12) * 128, vcol_ = hd_ < 12 ? 3072 + hd_ * 128 : 5632 + (hd_ - 12) * 128; \
        _Pragma("unroll") for (int tt = 0; tt < 2; ++tt) { const size_t row_ = (size_t)(b * SEQ + s0 + tok2 + 32 * tt) * H3LD; \
            _Pragma("unroll") for (int qk = 0; qk < 2; ++qk) { const bf16_t* src_ = H3 + row_ + (qk ? kcol_ : qcol_) + pj; na[tt][qk] = *(const u32x2*)src_; nc[tt][qk] = *(const u32x2*)(src_ + 64); } } \
        _Pragma("unroll") for (int i = 0; i < 2; ++i) { const int idx = F.tid + 512 * i; nv[i] = *(const u32x4*)(H3 + (size_t)(b * SEQ + s0 + (idx >> 4)) * H3LD + vcol_ + (idx & 15) * 8); } } while (0)
    RP_LOAD(0);
    for (int hi = 0; hi < 8; ++hi) {
        const int hd = hh * 8 + hi, dl = head_dil_log2(hd);
        const size_t hb = (size_t)(b * 16 + hd) * 2048;
        u32x2 ca[2][2], cc[2][2]; u32x4 cv[2];
#pragma unroll
        for (int tt = 0; tt < 2; ++tt)
#pragma unroll
            for (int qk = 0; qk < 2; ++qk) { ca[tt][qk] = na[tt][qk]; cc[tt][qk] = nc[tt][qk]; }
        cv[0] = nv[0]; cv[1] = nv[1];
        if (hi + 1 < 8) RP_LOAD(hi + 1);
#pragma unroll
        for (int tt = 0; tt < 2; ++tt) {
            const int tl = tok2 + 32 * tt, s = s0 + tl; const size_t orow = (hb + posp(s, dl)) * 128;
#pragma unroll
            for (int qk = 0; qk < 2; ++qk) {
                const u32x2 a = ca[tt][qk], c = cc[tt][qk];
                const float x1[4] = {bflo(a.x), bfhi(a.x), bflo(a.y), bfhi(a.y)}, x2[4] = {bflo(c.x), bfhi(c.x), bflo(c.y), bfhi(c.y)};
                float y1[4], y2[4]; const float sc = qk ? 1.0f : QSCALE;
#pragma unroll
                for (int i = 0; i < 4; ++i) { y1[i] = (x1[i] * cs[tt][i] - x2[i] * sn[tt][i]) * sc; y2[i] = (x2[i] * cs[tt][i] + x1[i] * sn[tt][i]) * sc; }
                bf16_t* dst = (qk ? KR : QR) + orow + pj;
                u32x2 w1, w2; w1.x = pk2(y1[0], y1[1]); w1.y = pk2(y1[2], y1[3]); w2.x = pk2(y2[0], y2[1]); w2.y = pk2(y2[2], y2[3]);
                *(u32x2*)dst = w1; *(u32x2*)(dst + 64) = w2;
                if (qk && hd >= 12) {
#pragma unroll
                    for (int i = 0; i < 4; ++i) { KS[tl * 129 + pj + i] = y1[i]; KS[tl * 129 + 64 + pj + i] = y2[i]; }
                }
            }
        }
#pragma unroll
        for (int i = 0; i < 2; ++i) { const int idx = F.tid + 512 * i, tl = idx >> 4, pc = idx & 15;
            *(LAS u32x4*)(VL + tl * 136 + pc * 8) = cv[i]; }
        asm volatile("s_waitcnt lgkmcnt(0)" ::: "memory"); __builtin_amdgcn_s_barrier();
        if (hd >= 12 && F.tid < 128) { float sum = 0.f;
#pragma unroll 8
            for (int tl = 0; tl < 64; ++tl) sum += KS[tl * 129 + F.tid];
            KPART[((size_t)(b * 4 + hd - 12) * 32 + st) * 128 + F.tid] = sum; }
        {
            const int pp = posp(s0 + F.lane, dl);
#pragma unroll 4
            for (int i = 0; i < 16; ++i) { const int d = F.wave * 16 + i; VT[((size_t)(b * 16 + hd) * 128 + d) * 2048 + pp] = VL[F.lane * 136 + d]; }
        }
        asm volatile("s_waitcnt lgkmcnt(0)" ::: "memory"); __builtin_amdgcn_s_barrier();
    }
#undef RP_LOAD
}

template <int MODE>
__device__ __forceinline__ void attn_item(const Params& p, const Frame& F0, int b, int hd, int q0, int ktile_lo, int ktile_hi) {
    const Frame F = refresh(F0);
    const int lane = F.lane, fr = lane & 15, g = lane >> 4, wave = F.wave;
    unsigned char* scr = opq(p.ws) + WS_SCR;
    const size_t hb = (size_t)(b * 16 + hd);
    const bf16_t* Qg = (const bf16_t*)(scr + A_QR) + hb * 2048 * 128; const bf16_t* Kg = (const bf16_t*)(scr + A_KR) + hb * 2048 * 128; const bf16_t* Vg = (const bf16_t*)(scr + A_VT) + hb * 128 * 2048;
    constexpr int BUFB = 35840, OFF_V = 17408, OFF_KM = 71680;
    const int nq = q0 + 16 * wave + fr;
    bf16x8 qf[4];
#pragma unroll
    for (int kb = 0; kb < 4; ++kb) qf[kb] = *(const bf16x8*)(Qg + (size_t)nq * 128 + 32 * kb + 8 * g);
    unsigned selmask = 0u;
    if (MODE == 1) {
        const int qb = q0 >> 8, h = hd - 12;
        LAS float* KM = (LAS float*)(F.lds + OFF_KM);
        const float* KPART = (const float*)(scr + A_KPART) + (size_t)(b * 4 + h) * 32 * 128;
#pragma unroll
        for (int i = 0; i < 2; ++i) { const int idx = F.tid + 512 * i, jb = idx >> 7, d = idx & 127;
            KM[idx] = (KPART[(4 * jb + 0) * 128 + d] + KPART[(4 * jb + 1) * 128 + d]) + (KPART[(4 * jb + 2) * 128 + d] + KPART[(4 * jb + 3) * 128 + d]); }
        __syncthreads();
        float gate[8];
#pragma unroll
        for (int jb = 0; jb < 8; ++jb) { float s = 0.f;
#pragma unroll
            for (int kb = 0; kb < 4; ++kb) { const u32x4 qq = __builtin_bit_cast(u32x4, qf[kb]); const LAS float* km = KM + jb * 128 + 32 * kb + 8 * g;
                const f32x4 k0 = *(const LAS f32x4*)km, k1 = *(const LAS f32x4*)(km + 4);
                s += (bflo(qq.x) * k0[0] + bfhi(qq.x) * k0[1]) + (bflo(qq.y) * k0[2] + bfhi(qq.y) * k0[3]) + (bflo(qq.z) * k1[0] + bfhi(qq.z) * k1[1]) + (bflo(qq.w) * k1[2] + bfhi(qq.w) * k1[3]); }
            s += xor16_f(s); s = xor32_sum(s); gate[jb] = s; }
#pragma unroll
        for (int jb = 0; jb < 8; ++jb) { int rank = 0;
#pragma unroll
            for (int j2 = 0; j2 < 8; ++j2) if (j2 != jb && j2 < qb) rank += (gate[j2] > gate[jb] || (gate[j2] == gate[jb] && j2 < jb)) ? 1 : 0;
            if (jb < qb && rank < 3) selmask |= 1u << jb; }
        __syncthreads();
    }
    u32x4 rk[2], rv[2];
#define AT_ISSUE(kt) do { _Pragma("unroll") for (int i = 0; i < 2; ++i) { const int idx = F.tid + 512 * i; \
        rk[i] = *(const u32x4*)(Kg + (size_t)((kt) * 64 + (idx >> 4)) * 128 + (idx & 15) * 8); rv[i] = *(const u32x4*)(Vg + (size_t)(idx >> 3) * 2048 + (kt) * 64 + (idx & 7) * 8); } } while (0)
#define AT_WRITE(bufp) do { _Pragma("unroll") for (int i = 0; i < 2; ++i) { const int idx = F.tid + 512 * i; \
        *(LAS u32x4*)((bufp) + ((idx >> 4) * 136 + (idx & 15) * 8) * 2) = rk[i]; *(LAS u32x4*)((bufp) + OFF_V + ((idx >> 3) * 72 + (idx & 7) * 8) * 2) = rv[i]; } } while (0)
    f32x4 oacc[8];
#pragma unroll
    for (int dt = 0; dt < 8; ++dt) oacc[dt] = (f32x4){0.f, 0.f, 0.f, 0.f};
    float mrun = -1e30f, lrun = 0.f;
    AT_ISSUE(ktile_lo);
    AT_WRITE(F.lds);
    __syncthreads();
    for (int kt = ktile_lo; kt < ktile_hi; ++kt) {
        LAS unsigned char* buf = F.lds + ((kt - ktile_lo) & 1) * BUFB;
        if (kt + 1 < ktile_hi) AT_ISSUE(kt + 1);
        const LAS bf16_t* KL = (const LAS bf16_t*)buf; const LAS bf16_t* VL = (const LAS bf16_t*)(buf + OFF_V);
        f32x4 sT[4];
        {
            bf16x8 kf[16];
#pragma unroll
            for (int t4 = 0; t4 < 4; ++t4)
#pragma unroll
                for (int kb = 0; kb < 4; ++kb) kf[4 * t4 + kb] = *(const LAS bf16x8*)(KL + (16 * t4 + fr) * 136 + 32 * kb + 8 * g);
            __builtin_amdgcn_sched_barrier(0);
#pragma unroll
            for (int t4 = 0; t4 < 4; ++t4) { sT[t4] = (f32x4){0.f, 0.f, 0.f, 0.f};
#pragma unroll
                for (int kb = 0; kb < 4; ++kb) sT[t4] = mfma32(kf[4 * t4 + kb], qf[kb], sT[t4]); }
        }
        __builtin_amdgcn_sched_barrier(0);
        bf16x8 vf[16];
#pragma unroll
        for (int dt = 0; dt < 8; ++dt) { vf[2 * dt] = frag_perm(VL + (16 * dt + fr) * 72, 4 * g); vf[2 * dt + 1] = frag_perm(VL + (16 * dt + fr) * 72, 32 + 4 * g); }
        __builtin_amdgcn_sched_barrier(0);
        const int k0 = kt * 64; float mx = -1e30f;
        const float NEG = -__builtin_huge_valf();
#pragma unroll
        for (int t4 = 0; t4 < 4; ++t4)
#pragma unroll
            for (int r = 0; r < 4; ++r) { const int nk = k0 + 16 * t4 + 4 * g + r; bool v;
                if (MODE == 0) v = (nk <= nq) && (nq - nk <= 128);
                else v = ((k0 >> 8) == (q0 >> 8)) ? (nk <= nq) : (((selmask >> (k0 >> 8)) & 1u) != 0u);
                sT[t4][r] = v ? sT[t4][r] : NEG; mx = fmaxf(mx, sT[t4][r]); }
        mx = fmaxf(mx, xor16_f(mx)); mx = xor32_max(mx);
        const float mnew = fmaxf(mrun, mx), alpha = exp2f(mrun - mnew); mrun = mnew;
        float ps = 0.f;
#pragma unroll
        for (int t4 = 0; t4 < 4; ++t4)
#pragma unroll
            for (int r = 0; r < 4; ++r) { const float pv = exp2f(sT[t4][r] - mnew); sT[t4][r] = pv; ps += pv; }
        lrun = lrun * alpha + ps;
        const bf16x8 pb0 = pack8(sT[0], sT[1]), pb1 = pack8(sT[2], sT[3]);
#pragma unroll
        for (int dt = 0; dt < 8; ++dt) {
            oacc[dt] = oacc[dt] * alpha;
            oacc[dt] = mfma32(vf[2 * dt], pb0, oacc[dt]);
            oacc[dt] = mfma32(vf[2 * dt + 1], pb1, oacc[dt]);
        }
        if (kt + 1 < ktile_hi) AT_WRITE(F.lds + ((kt + 1 - ktile_lo) & 1) * BUFB);
        __syncthreads();
    }
#undef AT_ISSUE
#undef AT_WRITE
    lrun += xor16_f(lrun); lrun = xor32_sum(lrun);
    const float inv = 1.0f / lrun;
    if (MODE == 0) {
        bf16_t* og = (bf16_t*)(scr + A_OG) + ((size_t)(b * 12 + hd) * 2048 + nq) * 128;
#pragma unroll
        for (int dt = 0; dt < 8; ++dt) { u32x2 w; w.x = pk2(oacc[dt][0] * inv, oacc[dt][1] * inv); w.y = pk2(oacc[dt][2] * inv, oacc[dt][3] * inv); *(u32x2*)(og + 16 * dt + 4 * g) = w; }
        if (g == 0) ((float*)(scr + A_LSE))[(size_t)(b * 12 + hd) * 2048 + nq] = mrun + log2f(lrun);
    } else {
        unsigned char* oc = (opq(p.ws) + WS_OC) + (size_t)(b * SEQ + nq) * 1024 + 512 + (hd - 12) * 128;
        const float inv4 = inv * A_PRE;
#pragma unroll
        for (int dt = 0; dt < 8; ++dt) *(unsigned*)(oc + 16 * dt + 4 * g) = pk4_fp8(oacc[dt][0] * inv4, oacc[dt][1] * inv4, oacc[dt][2] * inv4, oacc[dt][3] * inv4);
    }
}

__device__ __forceinline__ void attn_phase(const Params& p, const Frame& F0) {
    const Frame F = refresh(F0);
    const int i = F.bid & 15, bhm = F.bid >> 4;
    const int nd = (i == 0) ? 7 : (i <= 2) ? 6 : (i <= 4) ? 5 : (i <= 6) ? 4 : (i <= 8) ? 3 : (i <= 10) ? 2 : (i == 11) ? 1 : 0;
    const int st = (i == 0) ? 0 : (i == 1) ? 7 : (i == 2) ? 13 : (i == 3) ? 19 : (i == 4) ? 24 : (i == 5) ? 29 : (i == 6) ? 33 : (i == 7) ? 37 : (i == 8) ? 40 : (i == 9) ? 43 : (i == 10) ? 45 : (i == 11) ? 47 : 48;
    const bool balanced = (F.G == 256);
    for (int k = 0;; ++k) {
        int it;
        if (balanced) { if (k > nd) break; it = (k == 0) ? (bhm * 16 + i) : (256 + bhm * 48 + st + k - 1); }
        else { it = F.bid + k * F.G; if (it >= 1024) break; }
        if (it < 256) { const int qt = it & 15; attn_item<1>(p, F, it >> 6, 12 + ((it >> 4) & 3), qt * 128, 0, 2 * (qt + 1)); }
        else { const int id = it - 256, qt = id & 15, hd = (id >> 4) % 12, b = (id >> 4) / 12, dl = head_dil_log2(hd); const int q0 = qt * 128, first = ((q0 & ((2048 >> dl) - 1)) == 0);
            attn_item<0>(p, F, b, hd, q0, first ? 2 * qt : 2 * qt - 2, 2 * qt + 2); }
    }
}

__device__ __forceinline__ void merge_pass(const Params& p, const Frame& F0) {
    const Frame F = refresh(F0);
    const int gw = F.bid * NWAVES + F.wave, NGW = F.G * NWAVES, hg = F.lane >> 4, d0 = (F.lane & 15) * 8;
    unsigned char* scr = opq(p.ws) + WS_SCR;
    const bf16_t* OG = (const bf16_t*)(scr + A_OG); const float* LSE = (const float*)(scr + A_LSE); bf16_t* OC = (bf16_t*)(opq(p.ws) + WS_OC);
    for (int m = gw; m < T; m += NGW) {
        const int b = m >> 11, s = m & 2047;
        float ls[3]; u32x4 ov[3];
#pragma unroll
        for (int gi = 0; gi < 3; ++gi) { const int hd = 4 * gi + hg; const size_t idx = (size_t)(b * 12 + hd) * 2048 + posp(s, 2 * gi); ls[gi] = LSE[idx]; ov[gi] = *(const u32x4*)(OG + idx * 128 + d0); }
        const float mx = fmaxf(ls[0], fmaxf(ls[1], ls[2]));
        float w[3]; float ws = 0.f;
#pragma unroll
        for (int gi = 0; gi < 3; ++gi) { w[gi] = exp2f(ls[gi] - mx); ws += w[gi]; }
        const float inv = 1.0f / ws;
        float o[8] = {0.f, 0.f, 0.f, 0.f, 0.f, 0.f, 0.f, 0.f};
#pragma unroll
        for (int gi = 0; gi < 3; ++gi) { const float wg = w[gi] * inv;
            o[0] += wg * bflo(ov[gi].x); o[1] += wg * bfhi(ov[gi].x); o[2] += wg * bflo(ov[gi].y); o[3] += wg * bfhi(ov[gi].y);
            o[4] += wg * bflo(ov[gi].z); o[5] += wg * bfhi(ov[gi].z); o[6] += wg * bflo(ov[gi].w); o[7] += wg * bfhi(ov[gi].w); }
        u32x2 wv; wv.x = pk4_fp8(o[0] * A_PRE, o[1] * A_PRE, o[2] * A_PRE, o[3] * A_PRE); wv.y = pk4_fp8(o[4] * A_PRE, o[5] * A_PRE, o[6] * A_PRE, o[7] * A_PRE);
        *(u32x2*)((unsigned char*)OC + (size_t)m * 1024 + hg * 128 + d0) = wv;
    }
}

#define GRID_SYNC() xcd_barrier((unsigned*)(opq(p.ws) + WS_CTL), (volatile LAS unsigned*)(F.lds + LDS_BYTES - 16), F.wave)
#ifndef REPMASK
#define REPMASK 0u
#endif
__device__ __forceinline__ int repn(int k) { int n = 1 + (int)(((REPMASK) >> k) & 1u); asm volatile("" : "+s"(n)); return n; }
#define RP(k) for (int _r = 0, _n = repn(k); _r < _n; ++_r)
__global__ void __launch_bounds__(NTHR, 2) mk_fwd(Params p) {
    extern __shared__ __attribute__((aligned(16))) unsigned char lds_raw[];
    Frame F; F.lds = (LAS unsigned char*)lds_raw; F.tid = 0; F.lane = 0; F.wave = __builtin_amdgcn_readfirstlane(threadIdx.x >> 6); F.G = gridDim.x; F.bid = blockIdx.x;
#define P_WS (opq(p.ws))
#define P_AB ((bf16_t*)(opq(p.ws) + WS_AB))
#define P_R (opq(p.out))
#define P_MIX ((bf16_t*)(opq(p.ws) + WS_MIX))
#define P_HID ((bf16_t*)(opq(p.ws) + WS_HID))
#define P_Y2 ((bf16_t*)(opq(p.ws) + WS_Y2))

    {
        if (threadIdx.x == 0) { volatile LAS unsigned* st = (volatile LAS unsigned*)(F.lds + LDS_BYTES - 16); st[0] = 0u; st[1] = 0u;
            (void)xb_add((unsigned*)(p.ws + WS_CTL) + XB_XCNT(xb_xcc_id()), 1u); }
        __syncthreads();
    }
    RP(0) { convert_set(p, F, 0, F.bid * NWAVES + F.wave, F.G * NWAVES); __syncthreads(); }
    RP(1) { load_w16_lds(F, p.in[I_EV_WIN], EVEN_IN, 4096); __syncthreads(); p0_xpass(p, F); __syncthreads(); }
    GRID_SYNC();

    RP(2) {
        pg8::StaticOrder S; S.init(T, 8192, F.G, F.bid);
        pg8::Gemm g{(const unsigned char*)(P_WS + WS_AB), (const unsigned char*)(P_WS + WS_WIN), 2048, (unsigned)(T * 2048), (unsigned)(8192 * 2048), SC_A16};
        pg8::EpiBf16 E{(bf16_t*)(P_WS + WS_H1), H1LD, (unsigned)(T * 8192 * 2)};
        pg8::gemm_phase(F.lds, F.wave, g, S, E);
    }
    GRID_SYNC();
    RP(3) { p2_pre(p, F); }
    GRID_SYNC();
    RP(4) { if (F.bid < 32) gdn_scan(p, F, F.bid); else if (F.bid < 64) hgrn_scan(p, F, F.bid - 32);
            else if (F.G > 64) convert_set(p, F, 1, (F.bid - 64) * NWAVES + F.wave, (F.G - 64) * NWAVES); }
    if (F.G <= 64) { convert_set(p, F, 1, F.bid * NWAVES + F.wave, F.G * NWAVES); }
    GRID_SYNC();
    RP(5) { p4_gate(p, F); }
    GRID_SYNC();
    RP(6) {
        pg8::StaticOrder S; S.init(T, 2048, F.G, F.bid);
        pg8::Gemm g{(const unsigned char*)(P_WS + WS_OC), (const unsigned char*)(P_WS + WS_WOUT), 2048, (unsigned)(T * 2048), (unsigned)(2048 * 2048), SC_A4};
        pg8::EpiBf16 E{P_MIX, 2048, (unsigned)(T * 2048 * 2)};
        pg8::gemm_phase(F.lds, F.wave, g, S, E);
    }
    GRID_SYNC();
#define MOE_BLOCK(layer, resid, mixp, outfinal, outb2) do { \
        for (int _r = 0, _n = ((layer) == 0 ? repn(7) : 1); _r < _n; ++_r) { load_w16_lds(F, p.in[I_RW], 16, 0); __syncthreads(); \
            ln_pass<true, false, (layer) != 0, true>(p, F, resid, mixp, D, nullptr, p.in[I_LNG] + (size_t)((layer) * 2 + 0) * D, p.in[I_LNB] + (size_t)((layer) * 2 + 0) * D, P_R, P_AB, layer); __syncthreads(); } \
        GRID_SYNC(); \
        const int* list = (const int*)(P_WS + WS_LIST) + (size_t)(layer) * NE * T; \
        const float* gatew = (const float*)(P_WS + WS_GATEW) + (size_t)(layer) * 2 * T; \
        RP(8) { moe_lists(p, F, layer); } \
        GRID_SYNC(); \
        { const Frame Fr = refresh(F); pg8::moe_build_table(F.lds, Fr.tid); } \
        unsigned* tcnt = (unsigned*)(P_WS + WS_CTL) + 3600 + 128 * (layer);        \
        { pg8::MoeOrder<4, false> S; S.init(F.lds, list, F.G, F.bid, 1024, tcnt); \
            pg8::Gemm g{(const unsigned char*)(P_WS + WS_ABS), (const unsigned char*)(P_WS + ((layer) ? WS_WGU1 : WS_WGU)), 2048, (unsigned)(20480 * 2048), (unsigned)(NE * 1024 * 2048), SC_A1}; \
            pg8::EpiGateUpB E{P_HID, list, gatew}; pg8::gemm_phase(F.lds, F.wave, g, S, E); } \
          \
        { pg8::MoeDownS S; S.init(F.lds, tcnt, 2048, F.G, F.bid); \
            pg8::Gemm16 g{P_HID, (const bf16_t*)(P_WS + WS_WD), 512, (unsigned)(20480 * 512 * 2), (unsigned)(NE * 2048 * 512 * 2)}; \
            pg8::EpiDown E{P_Y2, list}; pg8::gemm_phase16(F.lds, F.wave, g, S, E); } \
        GRID_SYNC(); \
        ln_pass<false, true, true, (layer) == 0>(p, F, P_R, P_Y2, D, P_Y2, p.in[I_LNG] + (size_t)((layer) * 2 + 1) * D, p.in[I_LNB] + (size_t)((layer) * 2 + 1) * D, outfinal, outb2, layer); \
    } while (0)
    MOE_BLOCK(0, p.in[I_X], P_MIX, P_R, (bf16_t*)(P_WS + WS_AB8));
    __syncthreads();
    RP(11) { convert_set(p, F, 2, F.bid * NWAVES + F.wave, F.G * NWAVES); __syncthreads(); }
    GRID_SYNC();
    RP(12) {
        pg8::StaticOrder S; S.init(T, 6144, F.G, F.bid);
        pg8::Gemm g{(const unsigned char*)(P_WS + WS_AB8), (const unsigned char*)(P_WS + WS_W3), 2048, (unsigned)(T * 2048), (unsigned)(6144 * 2048), SC_A1};
        pg8::EpiBf16 E{(bf16_t*)(P_WS + WS_H1), H3LD, (unsigned)(T * 6144 * 2)};
        pg8::gemm_phase(F.lds, F.wave, g, S, E);
    }
    GRID_SYNC();
    RP(13) { const Frame Fr = refresh(F); for (int u = Fr.bid; u < 256; u += Fr.G) rope_unit(p, Fr, u); }
    GRID_SYNC();
    RP(14) { attn_phase(p, F); }
    GRID_SYNC();
    RP(15) { merge_pass(p, F); }
    GRID_SYNC();
    RP(16) {
        pg8::StaticOrder S; S.init(T, 2048, F.G, F.bid);
        pg8::Gemm g{(const unsigned char*)(P_WS + WS_OC), (const unsigned char*)(P_WS + WS_WOUT1), 1024, (unsigned)(T * 1024), (unsigned)(2048 * 1024), SC_A4};
        pg8::EpiBf16 E{P_MIX, 2048, (unsigned)(T * 2048 * 2)};
        pg8::gemm_phase(F.lds, F.wave, g, S, E);
    }
    GRID_SYNC();
    MOE_BLOCK(1, P_R, P_MIX, p.out, (bf16_t*)nullptr);
#undef MOE_BLOCK
#undef P_WS
#undef P_AB
#undef P_R
#undef P_MIX
#undef P_HID
#undef P_Y2
}

extern "C" void kernel_launch(void* const* d_in, const int* in_sizes, int n_in, void* d_out, int out_size,
                              void* d_ws, size_t ws_size, hipStream_t stream) {
    static int grid_blocks = 0;
    if (!grid_blocks) {
        int dev = 0, cus = 0, per_cu = 0;
        (void)hipGetDevice(&dev);
        (void)hipDeviceGetAttribute(&cus, hipDeviceAttributeMultiprocessorCount, dev);
        (void)hipFuncSetAttribute((const void*)mk_fwd, hipFuncAttributeMaxDynamicSharedMemorySize, LDS_BYTES);
        (void)hipOccupancyMaxActiveBlocksPerMultiprocessor(&per_cu, (const void*)mk_fwd, NTHR, LDS_BYTES);
        if (per_cu < 1) fprintf(stderr, "kernel_launch: occupancy query says %d blocks per CU\n", per_cu);
        grid_blocks = cus;
        if (ws_size < WS_END) { fprintf(stderr, "kernel_launch: workspace too small: %zu < %zu\n", ws_size, (size_t)WS_END); grid_blocks = -1; }
        if (n_in != 18) { fprintf(stderr, "kernel_launch: expected 18 inputs, got %d\n", n_in); grid_blocks = -1; }
    }
    if (grid_blocks < 0) return;
    Params p{};
    for (int i = 0; i < 18; ++i) p.in[i] = (const float*)d_in[i];
    p.out = (float*)d_out; p.ws = (unsigned char*)d_ws;
    (void)hipMemsetAsync(d_ws, 0, 16384, stream);
    void* args[] = {&p};
    hipError_t e = hipLaunchCooperativeKernel((void*)mk_fwd, dim3(grid_blocks), dim3(NTHR), args, LDS_BYTES, stream);
    if (e != hipSuccess) fprintf(stderr, "cooperative launch failed: %s (grid %d)\n", hipGetErrorString(e), grid_blocks);
}
```

```cpp
#include <hip/hip_runtime.h>
#include <cstdio>
#include <cstdint>

#define GAS __attribute__((address_space(1)))
#define LAS __attribute__((address_space(3)))
typedef unsigned short bf16_t;
typedef short bf16x8 __attribute__((ext_vector_type(8)));
typedef short bf16x4 __attribute__((ext_vector_type(4)));
typedef float f32x4 __attribute__((ext_vector_type(4)));
typedef float f32x2 __attribute__((ext_vector_type(2)));
typedef unsigned u32x4 __attribute__((ext_vector_type(4)));
typedef unsigned u32x2 __attribute__((ext_vector_type(2)));

constexpr int NB = 4, SEQ = 2048, T = NB * SEQ, D = 2048;
constexpr int EVEN_IN = 8208, ODD_IN = 6144;
constexpr int NE = 16, DEXP = 512;
constexpr float ALPHA = 1.4142135623730951f;
constexpr float LN_EPS = 1e-5f, RMS_EPS = 1e-6f;
constexpr int NWAVES = 8, NTHR = 512;
constexpr int LDS_BYTES = 147456;

constexpr size_t MiB = 1u << 20;
constexpr size_t WS_CTL = 0;
constexpr size_t WS_LIST = 1 * MiB;
constexpr size_t WS_GATEW = 2 * MiB;
constexpr size_t WS_BA = 2 * MiB + 512 * 1024;
constexpr size_t WS_ROPE = 3 * MiB;
constexpr size_t WS_KMEAN = 4 * MiB;
constexpr size_t WS_WREG = 8 * MiB;
constexpr size_t WS_WIN = WS_WREG;
constexpr size_t WS_AB8 = WS_WREG + 16 * MiB;
constexpr size_t WS_WOUT = WS_WREG + 32 * MiB;
constexpr size_t WS_WGU = WS_WREG + 40 * MiB;
constexpr size_t WS_WD = WS_WREG + 104 * MiB;
constexpr size_t WS_AB = WS_WREG + 136 * MiB;
constexpr size_t WS_H1 = WS_AB + 32 * MiB;
constexpr size_t WS_OC = WS_H1 + 128 * MiB;
constexpr size_t WS_MIX = WS_OC + 32 * MiB;
constexpr size_t WS_SCR = WS_MIX + 32 * MiB;
constexpr size_t WS_HID = WS_SCR;
constexpr size_t WS_Y2 = WS_SCR + 20 * MiB;
constexpr size_t WS_ABS = WS_SCR + 84 * MiB;
constexpr size_t WS_END = WS_SCR + 216 * MiB;
static_assert(WS_END == 584 * MiB, "workspace map");

typedef __bf16 bf16v2_t __attribute__((ext_vector_type(2)));
__device__ __forceinline__ unsigned pk2(float lo, float hi) { const f32x2 f = {lo, hi}; return __builtin_bit_cast(unsigned, __builtin_convertvector(f, bf16v2_t)); }
__device__ __forceinline__ unsigned f2bf(float f) { return pk2(f, 0.f) & 0xffffu; }
__device__ __forceinline__ unsigned pk4_fp8(float a, float b, float c, float d) {
    a = fminf(fmaxf(a, -448.f), 448.f); b = fminf(fmaxf(b, -448.f), 448.f); c = fminf(fmaxf(c, -448.f), 448.f); d = fminf(fmaxf(d, -448.f), 448.f);
    int w = 0; w = __builtin_amdgcn_cvt_pk_fp8_f32(a, b, w, false); w = __builtin_amdgcn_cvt_pk_fp8_f32(c, d, w, true); return (unsigned)w;
}
constexpr float W_PRE = 64.f;  constexpr int SC_W = 0x79797979;
constexpr float A_PRE = 4.f;   constexpr int SC_A4 = 0x7d7d7d7d;
constexpr int SC_A1 = 0x7f7f7f7f;
constexpr float X_PRE = 16.f;  constexpr int SC_A16 = 0x7b7b7b7b;
typedef int i32x8 __attribute__((ext_vector_type(8)));
__device__ __forceinline__ float bf2f(unsigned short b) { return __builtin_bit_cast(float, (unsigned)b << 16); }
__device__ __forceinline__ float bflo(unsigned w) { return __builtin_bit_cast(float, w << 16); }
__device__ __forceinline__ float bfhi(unsigned w) { return __builtin_bit_cast(float, w & 0xffff0000u); }
__device__ __forceinline__ unsigned cvt_pk_bf16(float lo, float hi) { return pk2(lo, hi); }
template <int CTRL> __device__ __forceinline__ float dpp_f(float x) { return __builtin_bit_cast(float, __builtin_amdgcn_update_dpp(0, __builtin_bit_cast(int, x), CTRL, 0xf, 0xf, true)); }
__device__ __forceinline__ float xor16_f(float x) { return __builtin_bit_cast(float, __builtin_amdgcn_ds_swizzle(__builtin_bit_cast(int, x), 0x401f)); }
__device__ __forceinline__ float row16_sum(float v) { v += dpp_f<0xB1>(v); v += dpp_f<0x4E>(v); v += dpp_f<0x141>(v); v += dpp_f<0x140>(v); return v; }
__device__ __forceinline__ float xor32_sum(float v) { const int i = __builtin_bit_cast(int, v); const auto r = __builtin_amdgcn_permlane32_swap(i, i, false, false);
    return __builtin_bit_cast(float, (int)r[0]) + __builtin_bit_cast(float, (int)r[1]); }
__device__ __forceinline__ float xor32_max(float v) { const int i = __builtin_bit_cast(int, v); const auto r = __builtin_amdgcn_permlane32_swap(i, i, false, false);
    return fmaxf(__builtin_bit_cast(float, (int)r[0]), __builtin_bit_cast(float, (int)r[1])); }
__device__ __forceinline__ float wave_sum(float v) { v = row16_sum(v); v += xor16_f(v); return xor32_sum(v); }
__device__ __forceinline__ float sigmoidf_(float x) { return 1.0f / (1.0f + __expf(-x)); }
__device__ __forceinline__ float siluf_(float x) { return x / (1.0f + __expf(-x)); }
#define LDS_WAIT() asm volatile("s_waitcnt lgkmcnt(0)" ::: "memory")
template <class Tp> __device__ __forceinline__ Tp* opq(Tp* x) { asm volatile("" : "+s"(x)); return x; }
template <class Tp> __device__ __forceinline__ Tp* opqg(Tp* x) { GAS Tp* g = (GAS Tp*)x; asm volatile("" : "+s"(g)); return (Tp*)g; }
__device__ __forceinline__ float ld_agent(const float* p) { return __hip_atomic_load(p, __ATOMIC_RELAXED, __HIP_MEMORY_SCOPE_AGENT); }

namespace pg8 {
constexpr int BM = 256, BK = 64, HALF = 128, HTB = HALF * BK * 2, STAGE_BYTES = 8 * HTB, NXCD = 8, WGM = 8;
__device__ __forceinline__ int lds_byte(int r, int c) { const int st = (r >> 4) * 2 + (c >> 5), rr = r & 15, cc = c & 31, ob = rr * 64 + cc * 2; return st * 1024 + (ob ^ (((ob >> 9) & 1) << 5)); }
__device__ __forceinline__ void stage_rc(int b, int& R, int& C) { const int st = b / 1024, sb = b % 1024, swz = sb ^ (((sb >> 9) & 1) << 5); R = (st >> 1) * 16 + swz / 64; C = (st & 1) * 32 + (swz % 64) / 2; }
__device__ __forceinline__ int perm32(int rho) { const int n = rho >> 4, i = rho & 15; return 8 * (i >> 2) + 4 * n + (i & 3); }

struct Unit { int pm, pn, e, cnt, arow0, brow0; };
struct Gemm { const unsigned char* A; const unsigned char* Bt; int K; unsigned abytes, bbytes; int sc_a; };

struct StaticOrder {
    static constexpr bool CONTIG = true;
    int nM, nN, nwg, G, c;
    __device__ void init(int M, int N, int G_, int c_) { nM = M / BM; nN = N / BM; nwg = nM * nN; G = G_; c = c_; }
    __device__ bool next(int i, Unit& u) const {
        const long L = (long)i * G + c; if (L >= nwg) return false;
        int wgid = (int)L; { const int q = nwg / NXCD, r = nwg % NXCD, xcd = wgid % NXCD, off = wgid / NXCD; wgid = (xcd < r ? xcd * (q + 1) : r * (q + 1) + (xcd - r) * q) + off; }
        const int nig = WGM * nN, gid = wgid / nig, fm = gid * WGM, gsz = (nM - fm) < WGM ? (nM - fm) : WGM;
        u.pm = fm + ((wgid % nig) % gsz); u.pn = (wgid % nig) / gsz; u.e = 0; u.cnt = 0; u.arow0 = u.pm * BM; u.brow0 = u.pn * BM; return true;
    }
    __device__ __forceinline__ unsigned arow(const Unit& u, int r) const { return (unsigned)(u.arow0 + r); }
    __device__ __forceinline__ void done(const Unit&, int) const {}
    struct State {};
    __device__ __forceinline__ bool first(State&, Unit& u, int) const { return next(0, u); }
    __device__ __forceinline__ void issue(State&, int, int) const {}
    __device__ __forceinline__ bool fin(State&, int i, Unit& u, int) const { return next(i, u); }
};

constexpr int MOE_TAB_OFF = 131072;
constexpr int MOE_HIST_OFF = 131072 + 3072;
__device__ __forceinline__ void moe_build_table(LAS unsigned char* lds, int tid) {
    LAS int* tab = (LAS int*)(lds + MOE_TAB_OFF);
    const LAS int* cnts = (const LAS int*)(lds + MOE_HIST_OFF) + 16;
    if (tid == 0) {
        int s = 0;
#pragma unroll 1
        for (int e = 0; e < NE; ++e) { const int c = cnts[e]; const int nt = (c + 255) >> 8;
#pragma unroll 1
            for (int k = 0; k < nt; ++k) { tab[4 + 4 * (s + k)] = e; tab[4 + 4 * (s + k) + 1] = k; tab[4 + 4 * (s + k) + 2] = c; }
            s += nt; }
        tab[0] = s;
    }
    __syncthreads();
}
template <int NPN, bool GATHER>
struct MoeOrder {
    static constexpr bool CONTIG = !GATHER;
    const int* list;
    LAS const int* tab; int G, c, brows;
    unsigned* tcnt;
    __device__ void init(LAS unsigned char* lds, const int* list_, int G_, int c_, int brows_, unsigned* tcnt_ = nullptr) { list = list_; G = G_; c = c_; brows = brows_; tab = (LAS const int*)(lds + MOE_TAB_OFF); tcnt = tcnt_; }
    __device__ __forceinline__ void done(const Unit& u, int lane) const {
        if (tcnt) { asm volatile("s_waitcnt vmcnt(0)" ::: "memory"); if (lane == 0) __hip_atomic_fetch_add(tcnt + (u.arow0 >> 8), 1u, __ATOMIC_RELAXED, __HIP_MEMORY_SCOPE_AGENT); }
    }
    __device__ bool next(int i, Unit& u) const {
        int L = i * G + c; const int ntile = __builtin_amdgcn_readfirstlane(tab[0]); if (L >= ntile * NPN) return false;
        if (NPN == 4 && i == 0 && G == 256) L = (c & 7) * 32 + (c >> 3);
        const int tile = L / NPN; u.pn = L % NPN;
        u.e = __builtin_amdgcn_readfirstlane(tab[4 + 4 * tile]); u.pm = __builtin_amdgcn_readfirstlane(tab[4 + 4 * tile + 1]); u.cnt = __builtin_amdgcn_readfirstlane(tab[4 + 4 * tile + 2]);
        u.arow0 = tile * BM; u.brow0 = u.e * brows + u.pn * BM; return true;
    }
    __device__ __forceinline__ unsigned arow(const Unit& u, int r) const {
        if (!GATHER) return (unsigned)(u.arow0 + r);
        int idx = u.pm * BM + r; if (idx >= u.cnt) idx = 0;
        return (unsigned)(list[u.e * T + idx] >> 1);
    }
    struct State {};
    __device__ __forceinline__ bool first(State&, Unit& u, int) const { return next(0, u); }
    __device__ __forceinline__ void issue(State&, int, int) const {}
    __device__ __forceinline__ bool fin(State&, int i, Unit& u, int) const { return next(i, u); }
};
constexpr int MOE_Q_OFF = 131072 + 3072 + 512;
struct MoeDownS {
    static constexpr bool CONTIG = true;
    typedef __attribute__((address_space(1))) unsigned gu32;
    LAS const int* tab; LAS unsigned* slot; gu32* tcnt; int brows, G, c;
    struct State {};
    __device__ void init(LAS unsigned char* lds, unsigned* tcnt_, int brows_, int G_, int c_) { tab = (LAS const int*)(lds + MOE_TAB_OFF); slot = (LAS unsigned*)(lds + MOE_Q_OFF); tcnt = (gu32*)tcnt_; brows = brows_; G = G_; c = c_; }
    __device__ __forceinline__ unsigned nunits() const { return (unsigned)__builtin_amdgcn_readfirstlane(tab[0]) * 8u; }
    __device__ __forceinline__ unsigned qof(int k) const {
        const int nG = __builtin_amdgcn_readfirstlane(tab[0]) * 4, h = nG % G, nl = G - h;
        return (unsigned)(c >= h ? k * nl + (k >= 3 ? (k - 2) * h : 0) + (c - h) : (k + 3) * nl + k * h + c);
    }
    __device__ __forceinline__ void wait_tile(unsigned q, unsigned cv) const {
        unsigned sp = 0;
        while (cv < 32u) { __builtin_amdgcn_s_sleep(2); if (++sp > (1u << 22)) break; cv = __hip_atomic_load(tcnt + (q >> 3), __ATOMIC_RELAXED, __HIP_MEMORY_SCOPE_AGENT); }
        asm volatile("buffer_inv sc1" ::: "memory");
    }
    __device__ __forceinline__ bool decode(unsigned q, Unit& u) const {
        if (q >= nunits()) return false;
        const int tile = (int)(q >> 3); u.pn = (int)(q & 7u);
        u.e = __builtin_amdgcn_readfirstlane(tab[4 + 4 * tile]); u.pm = __builtin_amdgcn_readfirstlane(tab[4 + 4 * tile + 1]); u.cnt = __builtin_amdgcn_readfirstlane(tab[4 + 4 * tile + 2]);
        u.arow0 = tile * BM; u.brow0 = u.e * brows + u.pn * BM; return true;
    }
    __device__ __forceinline__ bool first(State&, Unit& u, int tid) const {
        const unsigned q = qof(0);
        if (tid == 0 && q < nunits()) wait_tile(q, __hip_atomic_load(tcnt + (q >> 3), __ATOMIC_RELAXED, __HIP_MEMORY_SCOPE_AGENT));
        __syncthreads();
        return decode(q, u);
    }
    __device__ __forceinline__ void issue(State&, int i, int tid) const {
        const unsigned q = qof(i);
        if (tid == 0 && q < nunits()) {
            const __amdgpu_buffer_rsrc_t rc = __builtin_amdgcn_make_buffer_rsrc((void*)tcnt, (short)0, 128 * 4, 0x00020000);
            __builtin_amdgcn_raw_ptr_buffer_load_lds(rc, (LAS void*)slot, 4, (int)((q >> 3) * 4u), 0, 0, 16);
        }
    }
    __device__ __forceinline__ bool fin(State&, int i, Unit& u, int tid) const {
        const unsigned q = qof(i);
        if (tid == 0 && q < nunits()) {
            unsigned cv; asm volatile("ds_read_b32 %0, %1\n\ts_waitcnt lgkmcnt(0)" : "=v"(cv) : "v"((unsigned)(size_t)slot) : "memory");
            wait_tile(q, cv);
        }
        return decode(q, u);
    }
    __device__ __forceinline__ unsigned arow(const Unit& u, int r) const { return (unsigned)(u.arow0 + r); }
    __device__ __forceinline__ void done(const Unit&, int) const {}
};

struct EpiBf16 {
    static constexpr bool PERM = true;
    bf16_t* O; int ldc; unsigned obytes;
    __device__ __forceinline__ void operator()(const f32x4 (&acc)[2][2][4][2], const Unit& u, int wr, int wc, int fr, int fq) const {
        const __amdgpu_buffer_rsrc_t rO = __builtin_amdgcn_make_buffer_rsrc((void*)O, (short)0, (int)obytes, 0x00020000);
        const unsigned voff = (unsigned)((wr * 64 + fr) * ldc + wc * 32 + 8 * fq) * 2u;
        const unsigned sbase = (unsigned)(u.pm * BM * ldc + u.pn * BM) * 2u;
#pragma unroll
        for (int ai = 0; ai < 2; ++ai)
#pragma unroll
            for (int m = 0; m < 4; ++m)
#pragma unroll
                for (int bj = 0; bj < 2; ++bj) { const f32x4 v0 = acc[ai][bj][m][0], v1 = acc[ai][bj][m][1];
                    u32x4 w; w.x = cvt_pk_bf16(v0[0], v0[1]); w.y = cvt_pk_bf16(v0[2], v0[3]); w.z = cvt_pk_bf16(v1[0], v1[1]); w.w = cvt_pk_bf16(v1[2], v1[3]);
                    __builtin_amdgcn_raw_buffer_store_b128(w, rO, (int)voff, (int)(sbase + (unsigned)((ai * HALF + m * 16) * ldc + bj * HALF) * 2u), 0); }
    }
};
struct EpiGateUp {
    static constexpr bool PERM = true;
    unsigned char* HID; const int* list; const float* gatew;
    __device__ __forceinline__ void operator()(const f32x4 (&acc)[2][2][4][2], const Unit& u, int wr, int wc, int fr, int fq) const {
        const int col0 = u.pn * 128 + wc * 32 + 8 * fq;
#pragma unroll
        for (int ai = 0; ai < 2; ++ai)
#pragma unroll
            for (int m = 0; m < 4; ++m) {
                const int r = ai * HALF + wr * 64 + m * 16 + fr; const int idx = u.pm * BM + r;
                float wgt = 0.f; if (idx < u.cnt) wgt = gatew[list[u.e * T + idx]] * A_PRE;
                const f32x4 g0 = acc[ai][0][m][0], g1 = acc[ai][0][m][1], u0 = acc[ai][1][m][0], u1 = acc[ai][1][m][1];
                float h[8];
#pragma unroll
                for (int i = 0; i < 4; ++i) { h[i] = siluf_(g0[i]) * u0[i] * wgt; h[4 + i] = siluf_(g1[i]) * u1[i] * wgt; }
                u32x2 w; w.x = pk4_fp8(h[0], h[1], h[2], h[3]); w.y = pk4_fp8(h[4], h[5], h[6], h[7]);
                *(u32x2*)(HID + (size_t)(u.arow0 + r) * DEXP + col0) = w;
            }
    }
};
struct EpiGateUpB {
    static constexpr bool PERM = true;
    bf16_t* HID; const int* list; const float* gatew;
    __device__ __forceinline__ void operator()(const f32x4 (&acc)[2][2][4][2], const Unit& u, int wr, int wc, int fr, int fq) const {
        const __amdgpu_buffer_rsrc_t rH = __builtin_amdgcn_make_buffer_rsrc((void*)HID, (short)0, 20480 * 512 * 2, 0x00020000);
        const __amdgpu_buffer_rsrc_t rL = __builtin_amdgcn_make_buffer_rsrc((void*)(list + (size_t)u.e * T), (short)0, T * 4, 0x00020000);
        const __amdgpu_buffer_rsrc_t rG = __builtin_amdgcn_make_buffer_rsrc((void*)gatew, (short)0, 2 * T * 4, 0x00020000);
        const unsigned voff = (unsigned)((wr * 64 + fr) * DEXP + u.pn * 128 + wc * 32 + 8 * fq) * 2u;
        const int idx0 = u.pm * BM + wr * 64 + fr;
#pragma unroll
        for (int ai = 0; ai < 2; ++ai)
#pragma unroll
            for (int m = 0; m < 4; ++m) {
                const int idx = idx0 + ai * HALF + m * 16;
                const int ent = __builtin_amdgcn_raw_buffer_load_b32(rL, idx * 4, 0, 0);
                float wgt = __builtin_bit_cast(float, __builtin_amdgcn_raw_buffer_load_b32(rG, (idx < u.cnt ? ent : 0) * 4, 0, 0)); wgt = idx < u.cnt ? wgt : 0.f;
                const f32x4 g0 = acc[ai][0][m][0], g1 = acc[ai][0][m][1], u0 = acc[ai][1][m][0], u1 = acc[ai][1][m][1];
                float h[8];
#pragma unroll
                for (int i = 0; i < 4; ++i) { h[i] = siluf_(g0[i]) * u0[i] * wgt; h[4 + i] = siluf_(g1[i]) * u1[i] * wgt; }
                u32x4 w; w.x = cvt_pk_bf16(h[0], h[1]); w.y = cvt_pk_bf16(h[2], h[3]); w.z = cvt_pk_bf16(h[4], h[5]); w.w = cvt_pk_bf16(h[6], h[7]);
                __builtin_amdgcn_raw_buffer_store_b128(w, rH, (int)voff, (int)((u.arow0 + ai * HALF + m * 16) * DEXP * 2), 16);
            }
    }
};
struct EpiDown {
    static constexpr bool PERM = true;
    bf16_t* Y2; const int* list;
    __device__ __forceinline__ void operator()(const f32x4 (&acc)[2][2][4][2], const Unit& u, int wr, int wc, int fr, int fq) const {
        const int col0 = u.pn * BM + wc * 32 + 8 * fq;
#pragma unroll
        for (int ai = 0; ai < 2; ++ai)
#pragma unroll
            for (int m = 0; m < 4; ++m) {
                const int r = ai * HALF + wr * 64 + m * 16 + fr; const int idx = u.pm * BM + r;
                if (idx < u.cnt) { const int ent = list[u.e * T + idx]; bf16_t* rowp = Y2 + (size_t)ent * D + col0;
#pragma unroll
                    for (int bj = 0; bj < 2; ++bj) { const f32x4 v0 = acc[ai][bj][m][0], v1 = acc[ai][bj][m][1];
                        u32x4 w; w.x = cvt_pk_bf16(v0[0], v0[1]); w.y = cvt_pk_bf16(v0[2], v0[3]); w.z = cvt_pk_bf16(v1[0], v1[1]); w.w = cvt_pk_bf16(v1[2], v1[3]);
                        *(u32x4*)(rowp + bj * HALF) = w; } }
            }
    }
};

constexpr int NXT_OFF = 131072 + 4096;
template <class Epi, class Sched>
__device__ __forceinline__ void gemm_phase(LAS unsigned char* lds, int wave_id, const Gemm g, const Sched& S, const Epi& E) {
    int lane; asm volatile("v_mbcnt_lo_u32_b32 %0, -1, 0\n\tv_mbcnt_hi_u32_b32 %0, -1, %0" : "=v"(lane));
    const int wid = wave_id, tid = wid * 64 + lane, wr = wid >> 2, wc = wid & 3, fr = lane & 15, fq = lane >> 4;
    const int K = g.K, nt = K / 128;
    unsigned voffB[2];
#pragma unroll
    for (int i = 0; i < 2; ++i) { int R, C; stage_rc(tid * 16 + i * 8192, R, C); const int Rb = Epi::PERM ? ((R & ~31) + perm32(R & 31)) : R; voffB[i] = (unsigned)(Rb * K + 2 * C); }
    const unsigned ldsw = (unsigned)wid * 1024u;
    const int aoff = lds_byte(wr * 64 + fr, 16 * (fq & 1)) + (fq >> 1) * 1024, boff = lds_byte(wc * 32 + fr, 16 * (fq & 1)) + (fq >> 1) * 1024;
    LAS unsigned char* ldsB = lds + 4 * HTB + boff;
    LAS unsigned char* ldsA = lds + aoff;
    const int sc_act = g.sc_a;
#define PG8_SA(b, h) (((b) * 2 + (h)) * HTB)
#define PG8_SB(b, h) ((4 + (b) * 2 + (h)) * HTB)
#define PG8_STAGE(bufoff, rsrc, soff, voff) do { _Pragma("unroll") for (int _i = 0; _i < 2; ++_i) \
        __builtin_amdgcn_raw_ptr_buffer_load_lds(rsrc, (LAS void*)(lds + (bufoff) + ldsw + _i * 8192), 16, (int)(voff)[_i], (int)(soff), 0, 0); } while (0)
#define PG8_LD32(dstv, addr) do { const u32x4 _c0 = *(const LAS u32x4*)(lds + (addr)), _c1 = *(const LAS u32x4*)(lds + (addr) + 16); dstv = (i32x8){(int)_c0.x, (int)_c0.y, (int)_c0.z, (int)_c0.w, (int)_c1.x, (int)_c1.y, (int)_c1.z, (int)_c1.w}; } while (0)
#define PG8_LDA(dst, b, h) do { _Pragma("unroll") for (int m = 0; m < 4; ++m) { const u32x4 _c0 = *(const LAS u32x4*)(ldsA + PG8_SA(b, h) + m * 2048), _c1 = *(const LAS u32x4*)(ldsA + PG8_SA(b, h) + m * 2048 + 16); \
        dst[m] = (i32x8){(int)_c0.x, (int)_c0.y, (int)_c0.z, (int)_c0.w, (int)_c1.x, (int)_c1.y, (int)_c1.z, (int)_c1.w}; } } while (0)
#define PG8_LDB(dst, b, h) do { _Pragma("unroll") for (int n = 0; n < 2; ++n) { const u32x4 _c0 = *(const LAS u32x4*)(ldsB + ((b) * 2 + (h)) * HTB + n * 2048), _c1 = *(const LAS u32x4*)(ldsB + ((b) * 2 + (h)) * HTB + n * 2048 + 16); \
        dst[n] = (i32x8){(int)_c0.x, (int)_c0.y, (int)_c0.z, (int)_c0.w, (int)_c1.x, (int)_c1.y, (int)_c1.z, (int)_c1.w}; } } while (0)
#define PG8_MMA(ai, bj, At, Bt) do { __builtin_amdgcn_sched_barrier(0); __builtin_amdgcn_s_setprio(1); _Pragma("unroll") for (int m = 0; m < 4; ++m) _Pragma("unroll") for (int n = 0; n < 2; ++n) \
        acc[ai][bj][m][n] = __builtin_amdgcn_mfma_scale_f32_16x16x128_f8f6f4(Bt[n], At[m], acc[ai][bj][m][n], 0, 0, 0, SC_W, 0, sc_act); \
        _Pragma("unroll") for (int m = 0; m < 4; ++m) asm volatile("" :: "v"(acc[ai][bj][m][0]), "v"(acc[ai][bj][m][1]));     \
        __builtin_amdgcn_s_setprio(0); __builtin_amdgcn_sched_barrier(0); } while (0)
#define PG8_WAIT_V(n) asm volatile("s_waitcnt vmcnt(" #n ")" ::: "memory")
#define PG8_WAIT_L(n) asm volatile("s_waitcnt lgkmcnt(" #n ")" ::: "memory")
#define PG8_BAR __builtin_amdgcn_s_barrier()
#define PG8_SCHED __builtin_amdgcn_sched_barrier(0)
#define PG8_AOFFS(u, o0, o1) do { _Pragma("unroll") for (int _i = 0; _i < 2; ++_i) { int _R, _C; stage_rc(tid * 16 + _i * 8192, _R, _C); \
        o0[_i] = S.arow(u, _R) * (unsigned)K + 2u * (unsigned)_C; o1[_i] = S.arow(u, HALF + _R) * (unsigned)K + 2u * (unsigned)_C; } } while (0)
    Unit cur, nxt; int ui = 0;
    if (!S.next(0, cur)) return;
    f32x4 acc[2][2][4][2];
#pragma unroll
    for (int a = 0; a < 2; ++a)
#pragma unroll
        for (int b = 0; b < 2; ++b)
#pragma unroll
            for (int m = 0; m < 4; ++m)
#pragma unroll
                for (int n = 0; n < 2; ++n) acc[a][b][m][n] = (f32x4){0.f, 0.f, 0.f, 0.f};
    i32x8 At[4], B0[2], B1[2];
    unsigned cA0[2], cA1[2];
    PG8_AOFFS(cur, cA0, cA1);
    const __amdgpu_buffer_rsrc_t rA = __builtin_amdgcn_make_buffer_rsrc((void*)g.A, (short)0, (int)g.abytes, 0x00020000);
    const __amdgpu_buffer_rsrc_t rB = __builtin_amdgcn_make_buffer_rsrc((void*)g.Bt, (short)0, (int)g.bbytes, 0x00020000);
    const unsigned kstep = (unsigned)(BK * 2);
    const unsigned hstep = (unsigned)HALF * (unsigned)K;
    unsigned cB = (unsigned)cur.brow0 * (unsigned)K;
    PG8_STAGE(PG8_SB(0, 0), rB, cB, voffB); PG8_STAGE(PG8_SB(0, 1), rB, cB + hstep, voffB); PG8_STAGE(PG8_SA(0, 0), rA, 0u, cA0); PG8_STAGE(PG8_SA(0, 1), rA, 0u, cA1);
    if (wr == 1) PG8_BAR;
    PG8_WAIT_V(2); PG8_BAR;
    PG8_STAGE(PG8_SB(1, 0), rB, cB + kstep, voffB); PG8_STAGE(PG8_SA(1, 0), rA, kstep, cA0); PG8_STAGE(PG8_SB(1, 1), rB, cB + hstep + kstep, voffB);
    PG8_WAIT_V(6); PG8_BAR;
#define PG8_PAIR(a1, a2, b2, SWITCH) do { \
            PG8_LDB(B0, 0, 0); PG8_LDB(B1, 0, 1); PG8_SCHED; PG8_LDA(At, 0, 0); PG8_STAGE(PG8_SA(1, 1), rA, a1, cA1); \
            SWITCH; \
            PG8_WAIT_V(8); PG8_WAIT_L(0); PG8_BAR; PG8_MMA(0, 0, At, B0); PG8_MMA(0, 1, At, B1); PG8_BAR; PG8_SCHED; \
            PG8_LDA(At, 0, 1); PG8_STAGE(PG8_SB(0, 0), rB, b2, voffB); PG8_STAGE(PG8_SB(0, 1), rB, (b2) + hstep, voffB); PG8_STAGE(PG8_SA(0, 0), rA, a2, cA0); \
            PG8_WAIT_V(8); PG8_WAIT_L(0); PG8_BAR; PG8_MMA(1, 0, At, B0); PG8_MMA(1, 1, At, B1); PG8_BAR; PG8_SCHED; \
            PG8_LDB(B0, 1, 0); PG8_LDB(B1, 1, 1); PG8_SCHED; PG8_LDA(At, 1, 0); PG8_STAGE(PG8_SA(0, 1), rA, a2, cA1); \
            PG8_WAIT_V(8); PG8_WAIT_L(0); PG8_BAR; PG8_MMA(0, 0, At, B0); PG8_MMA(0, 1, At, B1); PG8_BAR; PG8_SCHED; \
            PG8_LDA(At, 1, 1); PG8_STAGE(PG8_SB(1, 0), rB, (b2) + kstep, voffB); PG8_STAGE(PG8_SB(1, 1), rB, (b2) + kstep + hstep, voffB); PG8_STAGE(PG8_SA(1, 0), rA, (a2) + kstep, cA0); \
            PG8_WAIT_V(8); PG8_WAIT_L(0); PG8_BAR; PG8_MMA(1, 0, At, B0); PG8_MMA(1, 1, At, B1); PG8_BAR; PG8_SCHED; } while (0)
    for (;;) {
        const bool has_next = S.next(ui + 1, nxt);
        const unsigned nB = has_next ? (unsigned)nxt.brow0 * (unsigned)K : cB;
        unsigned dlt = 0u;
        if constexpr (Sched::CONTIG) { dlt = has_next ? (unsigned)(nxt.arow0 - cur.arow0) * (unsigned)K : 0u; }
        else { unsigned n0[2], n1[2]; if (has_next) { PG8_AOFFS(nxt, n0, n1); } else { n0[0] = cA0[0]; n0[1] = cA0[1]; n1[0] = cA1[0]; n1[1] = cA1[1]; }
          *((LAS u32x4*)(lds + NXT_OFF) + tid) = (u32x4){n0[0], n0[1], n1[0], n1[1]}; }
        for (int t = 0; t < nt - 2; t += 2) {
            const unsigned a1 = (unsigned)(t + 1) * kstep, a2 = (unsigned)(t + 2) * kstep, b2 = cB + (unsigned)(t + 2) * kstep;
            PG8_PAIR(a1, a2, b2, (void)0);
        }
        {
            const unsigned a1 = (unsigned)(nt - 1) * kstep;
            PG8_PAIR(a1, 0u, nB, do { if constexpr (Sched::CONTIG) { cA0[0] += dlt; cA0[1] += dlt; cA1[0] += dlt; cA1[1] += dlt; } else { const u32x4 _n = *((LAS u32x4*)(lds + NXT_OFF) + tid); cA0[0] = _n.x; cA0[1] = _n.y; cA1[0] = _n.z; cA1[1] = _n.w; } } while (0));
        }
        { int l2; asm volatile("v_mbcnt_lo_u32_b32 %0, -1, 0\n\tv_mbcnt_hi_u32_b32 %0, -1, %0" : "=v"(l2));
          E(acc, cur, wr, wc, l2 & 15, l2 >> 4); S.done(cur, l2); }
        if (!has_next) break;
#pragma unroll
        for (int a = 0; a < 2; ++a)
#pragma unroll
            for (int b = 0; b < 2; ++b)
#pragma unroll
                for (int m = 0; m < 4; ++m)
#pragma unroll
                    for (int n = 0; n < 2; ++n) acc[a][b][m][n] = (f32x4){0.f, 0.f, 0.f, 0.f};
        cur = nxt; cB = nB; ++ui;
    }
    PG8_WAIT_V(0);
    if (wr == 0) PG8_BAR;
    PG8_BAR;
#undef PG8_PAIR
#undef PG8_AOFFS
#undef PG8_SA
#undef PG8_SB
#undef PG8_STAGE
#undef PG8_LDA
#undef PG8_LDB
#undef PG8_MMA
#undef PG8_WAIT_V
#undef PG8_WAIT_L
#undef PG8_BAR
#undef PG8_SCHED
}
struct Gemm16 { const bf16_t* A; const bf16_t* Bt; int K; unsigned abytes, bbytes; };
struct EpiGateUp16 {
    static constexpr bool PERM = true;
    bf16_t* HID; const int* list; const float* gatew;
    __device__ __forceinline__ void operator()(const f32x4 (&acc)[2][2][4][2], const Unit& u, int wr, int wc, int fr, int fq) const {
        const int col0 = u.pn * 128 + wc * 32 + 8 * fq;
#pragma unroll
        for (int ai = 0; ai < 2; ++ai)
#pragma unroll
            for (int m = 0; m < 4; ++m) {
                const int r = ai * HALF + wr * 64 + m * 16 + fr; const int idx = u.pm * BM + r;
                float wgt = 0.f; if (idx < u.cnt) wgt = gatew[list[u.e * T + idx]];
                const f32x4 g0 = acc[ai][0][m][0], g1 = acc[ai][0][m][1], u0 = acc[ai][1][m][0], u1 = acc[ai][1][m][1];
                float h[8];
#pragma unroll
                for (int i = 0; i < 4; ++i) { h[i] = siluf_(g0[i]) * u0[i] * wgt; h[4 + i] = siluf_(g1[i]) * u1[i] * wgt; }
                u32x4 w; w.x = cvt_pk_bf16(h[0], h[1]); w.y = cvt_pk_bf16(h[2], h[3]); w.z = cvt_pk_bf16(h[4], h[5]); w.w = cvt_pk_bf16(h[6], h[7]);
                *(u32x4*)(HID + (size_t)(u.arow0 + r) * DEXP + col0) = w;
            }
    }
};
template <class Epi, class Sched>
__device__ __forceinline__ void gemm_phase16(LAS unsigned char* lds, int wave_id, const Gemm16 g, const Sched& S, const Epi& E) {
    int lane; asm volatile("v_mbcnt_lo_u32_b32 %0, -1, 0\n\tv_mbcnt_hi_u32_b32 %0, -1, %0" : "=v"(lane));
    const int wid = wave_id, tid = wid * 64 + lane, wr = wid >> 2, wc = wid & 3, fr = lane & 15, fq = lane >> 4;
    const int K = g.K, nt = K / BK;
    unsigned voffB[2];
#pragma unroll
    for (int i = 0; i < 2; ++i) { int R, C; stage_rc(tid * 16 + i * 8192, R, C); const int Rb = Epi::PERM ? ((R & ~31) + perm32(R & 31)) : R; voffB[i] = (unsigned)(Rb * K + C) * 2u; }
    const unsigned ldsw = (unsigned)wid * 1024u;
    const int aoff = lds_byte(wr * 64 + fr, fq * 8), boff = lds_byte(wc * 32 + fr, fq * 8);
#define PG8_SA(b, h) (((b) * 2 + (h)) * HTB)
#define PG8_SB(b, h) ((4 + (b) * 2 + (h)) * HTB)
#define PG8_STAGE(bufoff, rsrc, soff, voff) do { _Pragma("unroll") for (int _i = 0; _i < 2; ++_i) \
        __builtin_amdgcn_raw_ptr_buffer_load_lds(rsrc, (LAS void*)(lds + (bufoff) + ldsw + _i * 8192), 16, (int)(voff)[_i], (int)(soff), 0, 0); } while (0)
#define PG8_LDA(dst, b, h) do { _Pragma("unroll") for (int m = 0; m < 4; ++m) _Pragma("unroll") for (int k = 0; k < 2; ++k) dst[m][k] = *(const LAS bf16x8*)(lds + PG8_SA(b, h) + aoff + m * 2048 + k * 1024); } while (0)
#define PG8_LDB(dst, b, h) do { _Pragma("unroll") for (int n = 0; n < 2; ++n) _Pragma("unroll") for (int k = 0; k < 2; ++k) dst[n][k] = *(const LAS bf16x8*)(lds + PG8_SB(b, h) + boff + n * 2048 + k * 1024); } while (0)
#define PG8_MMA(ai, bj, At, Bt) do { __builtin_amdgcn_s_setprio(1); _Pragma("unroll") for (int m = 0; m < 4; ++m) _Pragma("unroll") for (int n = 0; n < 2; ++n) _Pragma("unroll") for (int k = 0; k < 2; ++k) \
        acc[ai][bj][m][n] = __builtin_amdgcn_mfma_f32_16x16x32_bf16(Bt[n][k], At[m][k], acc[ai][bj][m][n], 0, 0, 0); __builtin_amdgcn_s_setprio(0); } while (0)
#define PG8_WAIT_V(n) asm volatile("s_waitcnt vmcnt(" #n ")" ::: "memory")
#define PG8_WAIT_L(n) asm volatile("s_waitcnt lgkmcnt(" #n ")" ::: "memory")
#define PG8_BAR __builtin_amdgcn_s_barrier()
#define PG8_SCHED __builtin_amdgcn_sched_barrier(0)
#define PG8_AOFFS(u, o0, o1) do { _Pragma("unroll") for (int _i = 0; _i < 2; ++_i) { int _R, _C; stage_rc(tid * 16 + _i * 8192, _R, _C); \
        o0[_i] = (S.arow(u, _R) * (unsigned)K + (unsigned)_C) * 2u; o1[_i] = (S.arow(u, HALF + _R) * (unsigned)K + (unsigned)_C) * 2u; } } while (0)
    Unit cur, nxt; int ui = 0;
    typename Sched::State st;
    if (!S.first(st, cur, tid)) return;
    f32x4 acc[2][2][4][2];
#pragma unroll
    for (int a = 0; a < 2; ++a)
#pragma unroll
        for (int b = 0; b < 2; ++b)
#pragma unroll
            for (int m = 0; m < 4; ++m)
#pragma unroll
                for (int n = 0; n < 2; ++n) acc[a][b][m][n] = (f32x4){0.f, 0.f, 0.f, 0.f};
    bf16x8 At[4][2], B0[2][2], B1[2][2];
    unsigned cA0[2], cA1[2];
    PG8_AOFFS(cur, cA0, cA1);
    const __amdgpu_buffer_rsrc_t rA = __builtin_amdgcn_make_buffer_rsrc((void*)g.A, (short)0, (int)g.abytes, 0x00020000);
    const __amdgpu_buffer_rsrc_t rB = __builtin_amdgcn_make_buffer_rsrc((void*)g.Bt, (short)0, (int)g.bbytes, 0x00020000);
    const unsigned kstep = (unsigned)(BK * 2);
    const unsigned hstep = (unsigned)HALF * (unsigned)K * 2u;
    unsigned cB = (unsigned)cur.brow0 * (unsigned)K * 2u;
    PG8_STAGE(PG8_SB(0, 0), rB, cB, voffB); PG8_STAGE(PG8_SB(0, 1), rB, cB + hstep, voffB); PG8_STAGE(PG8_SA(0, 0), rA, 0u, cA0); PG8_STAGE(PG8_SA(0, 1), rA, 0u, cA1);
    if (wr == 1) PG8_BAR;
    PG8_WAIT_V(2); PG8_BAR;
    PG8_STAGE(PG8_SB(1, 0), rB, cB + kstep, voffB); PG8_STAGE(PG8_SA(1, 0), rA, kstep, cA0); PG8_STAGE(PG8_SB(1, 1), rB, cB + hstep + kstep, voffB);
    PG8_WAIT_V(6); PG8_BAR;
#define PG8_PAIR(a1, a2, b2, SWITCH) do { \
            PG8_LDB(B0, 0, 0); PG8_LDB(B1, 0, 1); PG8_SCHED; PG8_LDA(At, 0, 0); PG8_STAGE(PG8_SA(1, 1), rA, a1, cA1); \
            SWITCH; \
            PG8_WAIT_V(8); PG8_WAIT_L(0); PG8_BAR; PG8_MMA(0, 0, At, B0); PG8_MMA(0, 1, At, B1); PG8_BAR; PG8_SCHED; \
            PG8_LDA(At, 0, 1); PG8_STAGE(PG8_SB(0, 0), rB, b2, voffB); PG8_STAGE(PG8_SB(0, 1), rB, (b2) + hstep, voffB); PG8_STAGE(PG8_SA(0, 0), rA, a2, cA0); \
            PG8_WAIT_V(8); PG8_WAIT_L(0); PG8_BAR; PG8_MMA(1, 0, At, B0); PG8_MMA(1, 1, At, B1); PG8_BAR; PG8_SCHED; \
            PG8_LDB(B0, 1, 0); PG8_LDB(B1, 1, 1); PG8_SCHED; PG8_LDA(At, 1, 0); PG8_STAGE(PG8_SA(0, 1), rA, a2, cA1); \
            PG8_WAIT_V(8); PG8_WAIT_L(0); PG8_BAR; PG8_MMA(0, 0, At, B0); PG8_MMA(0, 1, At, B1); PG8_BAR; PG8_SCHED; \
            PG8_LDA(At, 1, 1); PG8_STAGE(PG8_SB(1, 0), rB, (b2) + kstep, voffB); PG8_STAGE(PG8_SB(1, 1), rB, (b2) + kstep + hstep, voffB); PG8_STAGE(PG8_SA(1, 0), rA, (a2) + kstep, cA0); \
            PG8_WAIT_V(8); PG8_WAIT_L(0); PG8_BAR; PG8_MMA(1, 0, At, B0); PG8_MMA(1, 1, At, B1); PG8_BAR; PG8_SCHED; } while (0)
    for (;;) {
        S.issue(st, ui + 1, tid);
        for (int t = 0; t < nt - 2; t += 2) {
            const unsigned a1 = (unsigned)(t + 1) * kstep, a2 = (unsigned)(t + 2) * kstep, b2 = cB + (unsigned)(t + 2) * kstep;
            PG8_PAIR(a1, a2, b2, (void)0);
        }
        const bool has_next = S.fin(st, ui + 1, nxt, tid);
        const unsigned nB = has_next ? (unsigned)nxt.brow0 * (unsigned)K * 2u : cB;
        {
            const unsigned a1 = (unsigned)(nt - 1) * kstep;
            PG8_PAIR(a1, 0u, nB, do { if (has_next) { PG8_AOFFS(nxt, cA0, cA1); } } while (0));
        }
        if (wr == 0) PG8_BAR;
        { int l2; asm volatile("v_mbcnt_lo_u32_b32 %0, -1, 0\n\tv_mbcnt_hi_u32_b32 %0, -1, %0" : "=v"(l2));
          E(acc, cur, wr, wc, l2 & 15, l2 >> 4); S.done(cur, l2); }
        if (!has_next) break;
#pragma unroll
        for (int a = 0; a < 2; ++a)
#pragma unroll
            for (int b = 0; b < 2; ++b)
#pragma unroll
                for (int m = 0; m < 4; ++m)
#pragma unroll
                    for (int n = 0; n < 2; ++n) acc[a][b][m][n] = (f32x4){0.f, 0.f, 0.f, 0.f};
        cur = nxt; cB = nB; ++ui;
        if (wr == 1) PG8_BAR;
    }
    PG8_WAIT_V(0);
    PG8_BAR;
#undef PG8_PAIR
#undef PG8_AOFFS
#undef PG8_SA
#undef PG8_SB
#undef PG8_STAGE
#undef PG8_LDA
#undef PG8_LDB
#undef PG8_MMA
#undef PG8_WAIT_V
#undef PG8_WAIT_L
#undef PG8_BAR
#undef PG8_SCHED
}
}

#define XB_TMO      128
#define XB_XCNT(j)  (256  + 64 * (j))
#define XB_XSUB(j)  (1280 + 64 * (j))
#define XB_XGEN(j)  (2304 + 64 * (j))
#define XB_TOP      3328
#define XB_TOPGEN   3392
#define XCD_BAR_WORDS 3456
#define XB_SPIN_CAP (1u << 20)
__device__ __forceinline__ unsigned xb_ld(unsigned* p)              { return __hip_atomic_load(p, __ATOMIC_RELAXED, __HIP_MEMORY_SCOPE_AGENT); }
__device__ __forceinline__ unsigned xb_add(unsigned* p, unsigned v) { return __hip_atomic_fetch_add(p, v, __ATOMIC_RELAXED, __HIP_MEMORY_SCOPE_AGENT); }
__device__ __forceinline__ unsigned xb_xcc_id() { return (unsigned)__builtin_amdgcn_s_getreg((3 << 11) | 20) & 0xFu; }
#define XB_SPIN(cond, bar) do { unsigned _sp = 0; while (cond) { __builtin_amdgcn_s_sleep(1); \
    if ((++_sp & 255u) == 0u) { if (xb_ld(&(bar)[XB_TMO])) break; if (_sp > XB_SPIN_CAP) { atomicAdd(&(bar)[XB_TMO], 1u); break; } } } } while (0)
__device__ __forceinline__ void xcd_barrier_complete(unsigned* bar, unsigned x, unsigned& nloc, unsigned& nx) {
    const unsigned G = gridDim.x;
    unsigned sum, cnt, mine, sp = 0u;
    for (;;) {
        sum = 0u; cnt = 0u; mine = 0u;
#pragma unroll
        for (unsigned j = 0; j < 16; ++j) { const unsigned c = xb_ld(&bar[XB_XCNT(j)]); sum += c; cnt += (c > 0u) ? 1u : 0u; mine = (j == x) ? c : mine; }
        if (sum == G) break;
        __builtin_amdgcn_s_sleep(1);
        if ((++sp & 255u) == 0u) { if (xb_ld(&bar[XB_TMO])) break; if (sp > XB_SPIN_CAP) { atomicAdd(&bar[XB_TMO], 1u); break; } }
    }
    nloc = mine > 0u ? mine : 1u; nx = cnt > 0u ? cnt : 1u;
}
__device__ __forceinline__ void xcd_barrier(unsigned* bar, volatile LAS unsigned* st, int wave) {
    asm volatile("s_waitcnt vmcnt(0) lgkmcnt(0)" ::: "memory");
    __syncthreads();
    int lane; asm volatile("v_mbcnt_lo_u32_b32 %0, -1, 0\n\tv_mbcnt_hi_u32_b32 %0, -1, %0" : "=v"(lane));
    if (wave == 0 && lane == 0) {
        __builtin_amdgcn_s_waitcnt(0);
        const unsigned x = xb_xcc_id();
        unsigned nloc = st[0], nx = st[1];
        if (nloc == 0u) { xcd_barrier_complete(bar, x, nloc, nx); st[0] = nloc; st[1] = nx; }
        const unsigned old = xb_add(&bar[XB_XSUB(x)], 1u);
        const unsigned gen = old / nloc;
        if (old + 1u == (gen + 1u) * nloc) {
            __builtin_amdgcn_fence(__ATOMIC_RELEASE, "agent");
            asm volatile("s_waitcnt vmcnt(0)" ::: "memory");
            const unsigned og = xb_add(&bar[XB_TOP], 1u);
            const unsigned tg = og / nx;
            if (og + 1u == (tg + 1u) * nx) xb_add(&bar[XB_TOPGEN], 1u);
            else XB_SPIN(xb_ld(&bar[XB_TOPGEN]) == tg, bar);
            __builtin_amdgcn_fence(__ATOMIC_ACQUIRE, "agent");
            xb_add(&bar[XB_XGEN(x)], 1u);
            asm volatile("s_waitcnt vmcnt(0)" ::: "memory");
        } else {
            XB_SPIN(xb_ld(&bar[XB_XGEN(x)]) == gen, bar);
            __builtin_amdgcn_fence(__ATOMIC_ACQUIRE, "agent");
            asm volatile("s_waitcnt vmcnt(0)" ::: "memory");
        }
    }
    __syncthreads();
}

struct Params {
    const float* in[18];
    float* out; unsigned char* ws;
};
enum { I_X = 0, I_EV_WIN, I_EV_CONV, I_EV_ALOG, I_EV_DTB, I_EV_GDNN, I_EV_HGRNN, I_LBLOG, I_EV_WOUT, I_OD_WIN, I_OD_WOUT, I_RW, I_RB, I_MG, I_MU, I_MD, I_LNG, I_LNB };

struct Frame {
    LAS unsigned char* lds;
    int tid, lane, wave, G, bid;
};
__device__ __forceinline__ Frame refresh(const Frame& F0) {
    Frame F = F0; int l; asm volatile("v_mbcnt_lo_u32_b32 %0, -1, 0\n\tv_mbcnt_hi_u32_b32 %0, -1, %0" : "=v"(l));
    F.lane = l; F.tid = F0.wave * 64 + l; return F;
}

constexpr size_t WS_W3 = WS_AB + 16 * MiB, WS_WOUT1 = WS_WOUT + 4 * MiB, WS_WGU1 = WS_WGU + 32 * MiB;
struct CDesc { const float* src; unsigned char* dst; int ld, Kd, fp8; };
__device__ __forceinline__ CDesc conv_desc(const Params& p, unsigned char* ws, int kind, int r) {
    CDesc d;
    switch (kind) {
    case 0: { const int kb = r / 256, nb = r % 256, n0 = nb * 32; const int c0 = n0 < 4096 ? n0 : n0 + 16;
        d.src = p.in[I_EV_WIN] + (size_t)(kb * 64) * EVEN_IN + c0; d.ld = EVEN_IN; d.dst = ws + WS_WIN + (size_t)n0 * 2048 + kb * 64; d.Kd = 2048; d.fp8 = 1; break; }
    case 1: { const int kb = r / 64, nb = r % 64; d.src = p.in[I_EV_WOUT] + (size_t)(kb * 64) * 2048 + nb * 32; d.ld = 2048; d.dst = ws + WS_WOUT + (size_t)(nb * 32) * 2048 + kb * 64; d.Kd = 2048; d.fp8 = 1; break; }
    case 2: case 6: { const int layer = kind == 6; const int isup = r >= 8192; if (isup) r -= 8192;
        const int e = r / 512, q = r % 512, kb = q / 16, nb = q % 16, f0 = nb * 32;
        d.src = (isup ? p.in[I_MU] : p.in[I_MG]) + (size_t)(layer * NE + e) * 2048 * 512 + (size_t)(kb * 64) * 512 + f0; d.ld = 512;
        d.dst = ws + (layer ? WS_WGU1 : WS_WGU) + (size_t)e * 1024 * 2048 + (size_t)(256 * (f0 >> 7) + 128 * isup + (f0 & 127)) * 2048 + kb * 64; d.Kd = 2048; d.fp8 = 1; break; }
    case 3: case 7: { const int layer = kind == 7; const int e = r / 512, q = r % 512, kb = q / 64, nb = q % 64;
        d.src = p.in[I_MD] + (size_t)(layer * NE + e) * 512 * 2048 + (size_t)(kb * 64) * 2048 + nb * 32; d.ld = 2048;
        d.dst = ws + WS_WD + ((size_t)e * 2048 * 512 + (size_t)(nb * 32) * 512 + kb * 64) * 2; d.Kd = 512; d.fp8 = 0; break; }
    case 4: { const int kb = r / 192, nb = r % 192; d.src = p.in[I_OD_WIN] + (size_t)(kb * 64) * ODD_IN + nb * 32; d.ld = ODD_IN; d.dst = ws + WS_W3 + (size_t)(nb * 32) * 2048 + kb * 64; d.Kd = 2048; d.fp8 = 1; break; }
    default: { const int kb = r / 64, nb = r % 64; d.src = p.in[I_OD_WOUT] + (size_t)(kb * 64) * 2048 + nb * 32; d.ld = 2048; d.dst = ws + WS_WOUT1 + (size_t)(nb * 32) * 1024 + kb * 64; d.Kd = 1024; d.fp8 = 1; break; }
    }
    return d;
}
__device__ __forceinline__ void conv_load(const CDesc& d, int lane, float (&wv)[32]) {
    const float* wp = d.src + (size_t)(lane >> 5) * d.ld + (lane & 31);
#pragma unroll
    for (int i = 0; i < 32; ++i) wv[i] = __builtin_nontemporal_load(wp + (size_t)(2 * i) * d.ld);
}
__device__ __forceinline__ void conv_store(const CDesc& d, int lane, const float (&wv)[32], LAS float* scr) {
#pragma unroll
    for (int i = 0; i < 32; ++i) scr[(2 * i + (lane >> 5)) * 33 + (lane & 31)] = wv[i];
    LDS_WAIT(); asm volatile("" ::: "memory");
    if (d.fp8) {
        const int c = lane & 3;
#pragma unroll
        for (int j = 0; j < 2; ++j) { const int n = (lane >> 2) + 16 * j; const LAS float* sp = scr + (16 * c) * 33 + n;
            u32x4 o;
            o.x = pk4_fp8(sp[0 * 33] * W_PRE, sp[1 * 33] * W_PRE, sp[2 * 33] * W_PRE, sp[3 * 33] * W_PRE);     o.y = pk4_fp8(sp[4 * 33] * W_PRE, sp[5 * 33] * W_PRE, sp[6 * 33] * W_PRE, sp[7 * 33] * W_PRE);
            o.z = pk4_fp8(sp[8 * 33] * W_PRE, sp[9 * 33] * W_PRE, sp[10 * 33] * W_PRE, sp[11 * 33] * W_PRE);   o.w = pk4_fp8(sp[12 * 33] * W_PRE, sp[13 * 33] * W_PRE, sp[14 * 33] * W_PRE, sp[15 * 33] * W_PRE);
            *(u32x4*)(d.dst + (size_t)n * d.Kd + 16 * c) = o; }
    } else {
        const int c = lane & 7;
#pragma unroll
        for (int j = 0; j < 4; ++j) { const int n = (lane >> 3) + 8 * j; const LAS float* sp = scr + (8 * c) * 33 + n;
            u32x4 o; o.x = pk2(sp[0 * 33], sp[1 * 33]); o.y = pk2(sp[2 * 33], sp[3 * 33]); o.z = pk2(sp[4 * 33], sp[5 * 33]); o.w = pk2(sp[6 * 33], sp[7 * 33]);
            *(u32x4*)(d.dst + ((size_t)n * d.Kd + 8 * c) * 2) = o; }
    }
    LDS_WAIT(); asm volatile("" ::: "memory");
}
__device__ __forceinline__ CDesc conv_item(const Params& p, unsigned char* ws, int set, int it) {
    if (set == 0) return it < 8192 ? conv_desc(p, ws, 0, it) : conv_desc(p, ws, 1, it - 8192);
    if (set == 1) { int r = it;
        if (r < 16384) return conv_desc(p, ws, 2, r); r -= 16384;
        if (r < 8192) return conv_desc(p, ws, 3, r); r -= 8192;
        if (r < 6144) return conv_desc(p, ws, 4, r); r -= 6144;
        if (r < 1024) return conv_desc(p, ws, 5, r); r -= 1024;
        return conv_desc(p, ws, 6, r); }
    return conv_desc(p, ws, 7, it);
}
__device__ __forceinline__ void convert_set(const Params& p, const Frame& F0, int set, int w, int nw) {
    const Frame F = refresh(F0);
    LAS float* scr = (LAS float*)(F.lds + F.wave * 16384);
    unsigned char* ws = opq(p.ws);
    const int N = set == 0 ? 8192 + 2048 : set == 1 ? 16384 + 8192 + 6144 + 1024 + 16384 : 8192;
    for (int it = w; it < N; it += 2 * nw) {
        const bool two = it + nw < N;
        const CDesc d0 = conv_item(p, ws, set, it), d1 = conv_item(p, ws, set, two ? it + nw : it);
        float v0[32], v1[32];
        conv_load(d0, F.lane, v0); if (two) conv_load(d1, F.lane, v1);
        conv_store(d0, F.lane, v0, scr); if (two) conv_store(d1, F.lane, v1, scr);
    }
}

__device__ __forceinline__ void load_w16_lds(const Frame& F0, const float* W, int ld, int c0) {
    const Frame F = refresh(F0);
    LAS float* l = (LAS float*)F.lds;
    for (int i = F.tid; i < 2048 * 16; i += NTHR) { const int k = i >> 4, e = i & 15; l[e * 2048 + k] = W[(size_t)k * ld + c0 + e]; }
}
__device__ __forceinline__ float dot16(const Frame& F, const f32x4 (&v)[8]) {
    const LAS f32x4* l = (const LAS f32x4*)F.lds;
    float res = 0.f;
#pragma unroll 1
    for (int e = 0; e < 16; ++e) { float s = 0.f;
#pragma unroll
        for (int j = 0; j < 8; ++j) { const f32x4 w = l[e * 512 + 64 * j + F.lane]; s += (v[j].x * w.x + v[j].y * w.y) + (v[j].z * w.z + v[j].w * w.w); }
        s = wave_sum(s); res = (F.lane == e) ? s : res; }
    return res;
}

__device__ __forceinline__ void p0_xpass(const Params& p, const Frame& F0) {
    const Frame F = refresh(F0);
    const int gw = F.bid * NWAVES + F.wave, NGW = F.G * NWAVES;
    float* BA = (float*)(opq(p.ws) + WS_BA); bf16_t* AB = (bf16_t*)(opq(p.ws) + WS_AB);
    for (int m = gw; m < T; m += NGW) {
        const f32x4* xr = (const f32x4*)(p.in[I_X] + (size_t)m * D) + F.lane;
        f32x4 v[8];
#pragma unroll
        for (int j = 0; j < 8; ++j) v[j] = xr[64 * j];
        unsigned* o = (unsigned*)((unsigned char*)AB + (size_t)m * D) + F.lane;
#pragma unroll
        for (int j = 0; j < 8; ++j) o[64 * j] = pk4_fp8(v[j].x * X_PRE, v[j].y * X_PRE, v[j].z * X_PRE, v[j].w * X_PRE);
        const float a = dot16(F, v);
        if (F.lane < 16) BA[(size_t)m * 16 + F.lane] = a;
    }
}

constexpr size_t WS_R16A = WS_OC + 16 * MiB, WS_R16B = WS_SCR + 190 * MiB;
__device__ __forceinline__ bf16_t* r16_row(unsigned char* ws, int m) { return (bf16_t*)(ws + (m < T / 2 ? WS_R16A + (size_t)m * D * 2 : WS_R16B + (size_t)(m - T / 2) * D * 2)); }
template <bool ROUTE, bool TWO, bool RES16, bool OUT16>
__device__ __forceinline__ void ln_pass(const Params& p, const Frame& F0, const float* resid, const bf16_t* add1, int ld1, const bf16_t* add2, const float* gain, const float* bias,
                                        float* outf, bf16_t* outb, int layer) {
    const Frame F = refresh(F0);
    const int TPB = (T + F.G - 1) / F.G;
    const int mbeg = ROUTE ? F.bid * TPB + F.wave : F.bid * NWAVES + F.wave, mend = ROUTE ? min(T, (F.bid + 1) * TPB) : T, mstep = ROUTE ? NWAVES : F.G * NWAVES;
    int* SEL = (int*)(opq(p.ws) + WS_CTL + 65536);
    int* HIST = (int*)(opq(p.ws) + WS_CTL + 32768);
    LAS int* lhist = (LAS int*)(F.lds + pg8::MOE_HIST_OFF);
    float* gatew = (float*)(opq(p.ws) + WS_GATEW) + (size_t)layer * 2 * T;
    if (ROUTE) { if (F.tid < NE) lhist[F.tid] = 0; __syncthreads(); }
    f32x4 gn[8], bs[8];
#pragma unroll
    for (int j = 0; j < 8; ++j) { gn[j] = ((const f32x4*)gain)[64 * j + F.lane]; bs[j] = ((const f32x4*)bias)[64 * j + F.lane]; }
    f32x4 nxf[8]; u32x2 nx16[8], na1[8], na2[8];
    const GAS float* residg = (const GAS float*)resid; const GAS bf16_t* add1g = (const GAS bf16_t*)add1; const GAS bf16_t* add2g = (const GAS bf16_t*)add2;
#define LN_LOAD(mm) do { const GAS f32x4* xr = (const GAS f32x4*)(residg + (size_t)(mm) * D) + F.lane; const GAS u32x2* xr16 = (const GAS u32x2*)r16_row(opqg(p.ws), (mm)) + F.lane; \
        _Pragma("unroll") for (int j = 0; j < 8; ++j) { \
            if (RES16) nx16[j] = xr16[64 * j]; else nxf[j] = xr[64 * j]; \
            if (add1) na1[j] = ((const GAS u32x2*)(add1g + (size_t)(TWO ? 2 * (mm) : (mm)) * ld1))[64 * j + F.lane]; \
            if (TWO) na2[j] = ((const GAS u32x2*)(add2g + (size_t)(2 * (mm) + 1) * ld1))[64 * j + F.lane]; } } while (0)
    if (mbeg < mend) LN_LOAD(mbeg);
    for (int m = mbeg; m < mend; m += mstep) {
        f32x4 v[8]; float s = 0.f;
#pragma unroll
        for (int j = 0; j < 8; ++j) {
            if (RES16) { const u32x2 a = nx16[j]; v[j] = (f32x4){bflo(a.x), bfhi(a.x), bflo(a.y), bfhi(a.y)} * ALPHA; }
            else v[j] = nxf[j] * ALPHA;
            if (add1) { const u32x2 a = na1[j]; v[j].x += bflo(a.x); v[j].y += bfhi(a.x); v[j].z += bflo(a.y); v[j].w += bfhi(a.y); }
            if (TWO) { const u32x2 a = na2[j]; v[j].x += bflo(a.x); v[j].y += bfhi(a.x); v[j].z += bflo(a.y); v[j].w += bfhi(a.y); }
#ifdef DBG_SANITIZE
            if (!(fabsf(v[j].x) < 1e30f)) v[j].x = 0.f; if (!(fabsf(v[j].y) < 1e30f)) v[j].y = 0.f; if (!(fabsf(v[j].z) < 1e30f)) v[j].z = 0.f; if (!(fabsf(v[j].w) < 1e30f)) v[j].w = 0.f;
#endif
            s += (v[j].x + v[j].y) + (v[j].z + v[j].w);
        }
        if (m + mstep < mend) LN_LOAD(m + mstep);
        const float mean = wave_sum(s) * (1.f / D); float s2 = 0.f;
#pragma unroll
        for (int j = 0; j < 8; ++j) { v[j] = v[j] - mean; s2 += (v[j].x * v[j].x + v[j].y * v[j].y) + (v[j].z * v[j].z + v[j].w * v[j].w); }
        const float rstd = 1.f / sqrtf(wave_sum(s2) * (1.f / D) + LN_EPS);
#pragma unroll
        for (int j = 0; j < 8; ++j) v[j] = v[j] * rstd * gn[j] + bs[j];
        if (OUT16) { u32x2* of = (u32x2*)r16_row(opq(p.ws), m) + F.lane;
#pragma unroll
            for (int j = 0; j < 8; ++j) { u32x2 w; w.x = pk2(v[j].x, v[j].y); w.y = pk2(v[j].z, v[j].w); of[64 * j] = w; } }
        else { f32x4* of = (f32x4*)(outf + (size_t)m * D) + F.lane;
#pragma unroll
            for (int j = 0; j < 8; ++j) of[64 * j] = v[j]; }
        if (outb) {
            { unsigned* o = (unsigned*)((unsigned char*)outb + (size_t)m * D) + F.lane;
#pragma unroll
                for (int j = 0; j < 8; ++j) o[64 * j] = pk4_fp8(v[j].x, v[j].y, v[j].z, v[j].w); } }
        if (ROUTE) {
            const float lgl = dot16(F, v);
            const float scl = 1.0f / (1.0f + expf(-lgl)), bil = scl + p.in[I_RB][F.lane & 15];
            float sc[16], bi[16];
#pragma unroll
            for (int e = 0; e < 16; ++e) { sc[e] = __builtin_bit_cast(float, __builtin_amdgcn_readlane(__builtin_bit_cast(int, scl), e)); bi[e] = __builtin_bit_cast(float, __builtin_amdgcn_readlane(__builtin_bit_cast(int, bil), e)); }
            int bg = 0; float bgs = -3.0e38f;
#pragma unroll
            for (int g = 0; g < 4; ++g) { float m1 = -3.0e38f, m2 = -3.0e38f;
#pragma unroll
                for (int k = 0; k < 4; ++k) { const float x = bi[4 * g + k]; if (x > m1) { m2 = m1; m1 = x; } else if (x > m2) m2 = x; }
                const float gs = m1 + m2; if (gs > bgs) { bgs = gs; bg = g; } }
            int i1 = 0, i2 = 0; float b1 = -3.0e38f, b2 = -3.0e38f, s1 = 0.f, s2v = 0.f;
#pragma unroll
            for (int e = 0; e < 16; ++e) { if ((e >> 2) == bg) { const float x = bi[e]; if (x > b1) { b2 = b1; i2 = i1; s2v = s1; b1 = x; i1 = e; s1 = sc[e]; } else if (x > b2) { b2 = x; i2 = e; s2v = sc[e]; } } }
            if (F.lane == 0) {
                const float den = s1 + s2v;
                SEL[m] = i1 | (i2 << 8); gatew[2 * m] = s1 / den; gatew[2 * m + 1] = s2v / den;
                __hip_atomic_fetch_add(lhist + i1, 1, __ATOMIC_RELAXED, __HIP_MEMORY_SCOPE_WORKGROUP); __hip_atomic_fetch_add(lhist + i2, 1, __ATOMIC_RELAXED, __HIP_MEMORY_SCOPE_WORKGROUP);
            }
        }
    }
#undef LN_LOAD
    if (ROUTE) { __syncthreads(); if (F.tid < NE) HIST[F.bid * NE + F.tid] = lhist[F.tid]; }
}

__device__ __forceinline__ void moe_lists(const Params& p, const Frame& F0, int layer) {
    const Frame F = refresh(F0);
    const int* SEL = (const int*)(opq(p.ws) + WS_CTL + 65536);
    const int* HIST = (const int*)(opq(p.ws) + WS_CTL + 32768);
    int* list = (int*)(opq(p.ws) + WS_LIST) + (size_t)layer * NE * T;
    LAS int* ltot = (LAS int*)(F.lds + pg8::MOE_HIST_OFF) + 16;
    LAS int* lbase = (LAS int*)(F.lds + pg8::MOE_HIST_OFF) + 32;
    if (F.tid < NE) { ltot[F.tid] = 0; lbase[F.tid] = 0; }
    __syncthreads();
    { const int e = F.tid & 15, grp = F.tid >> 4; int base = 0, tot = 0;
#pragma unroll 8
      for (int b = grp; b < F.G; b += 32) { const int h = HIST[b * NE + e]; tot += h; if (b < F.bid) base += h; }
      __hip_atomic_fetch_add(ltot + e, tot, __ATOMIC_RELAXED, __HIP_MEMORY_SCOPE_WORKGROUP); __hip_atomic_fetch_add(lbase + e, base, __ATOMIC_RELAXED, __HIP_MEMORY_SCOPE_WORKGROUP); }
    __syncthreads();
    LAS int* ltpre = (LAS int*)(F.lds + pg8::MOE_HIST_OFF) + 48;
    LAS int* lslot = (LAS int*)(F.lds + pg8::MOE_HIST_OFF) + 64;
    if (F.tid == 0) { int sacc = 0;
#pragma unroll 1
        for (int e = 0; e < NE; ++e) { ltpre[e] = sacc; sacc += (ltot[e] + 255) >> 8; } }
    __syncthreads();
    const int TPB = (T + F.G - 1) / F.G, m0 = F.bid * TPB, m1 = min(T, m0 + TPB);
    if (F.wave == 0) {
        for (int q0 = 2 * m0; q0 < 2 * m1; q0 += 64) {
            const int q = q0 + F.lane; const bool ok = q < 2 * m1;
            int e = -1; if (ok) { const int sv = SEL[q >> 1]; e = (q & 1) ? ((sv >> 8) & 255) : (sv & 255); }
            int rank = 0, cntsame = 0;
#pragma unroll 1
            for (int k = 0; k < NE; ++k) { const unsigned long long bal = __ballot(e == k); if (e == k) { rank = __popcll(bal & ((1ull << F.lane) - 1ull)); cntsame = __popcll(bal); } }
            if (ok) { const int pos = lbase[e] + rank; list[e * T + pos] = q; lslot[q - 2 * m0] = 256 * ltpre[e] + pos; }
            __builtin_amdgcn_s_waitcnt(0);
            if (ok && rank == cntsame - 1) lbase[e] += cntsame;
            __builtin_amdgcn_s_waitcnt(0);
        }
    }
    __syncthreads();
    {
        const unsigned char* AB8 = opq(p.ws) + WS_AB; unsigned char* ABS = opq(p.ws) + WS_ABS;
        const int nt_ = m1 - m0;
        for (int t0 = F.wave; t0 < nt_; t0 += 4 * NWAVES) {
            u32x4 r0[4], r1[4];
#pragma unroll
            for (int k = 0; k < 4; ++k) { const int tt = t0 + k * NWAVES; if (tt < nt_) { const u32x4* src = (const u32x4*)(AB8 + (size_t)(m0 + tt) * D) + F.lane; r0[k] = src[0]; r1[k] = src[64]; } }
#pragma unroll
            for (int k = 0; k < 4; ++k) { const int tt = t0 + k * NWAVES; if (tt < nt_) {
#pragma unroll
                for (int jj = 0; jj < 2; ++jj) { u32x4* dst = (u32x4*)(ABS + (size_t)lslot[2 * tt + jj] * D) + F.lane; dst[0] = r0[k]; dst[64] = r1[k]; } } }
        }
    }
}

constexpr int H1LD = 8192, C_ZA = 3072, C_QB = 4096, C_FB = 5120, C_IB = 6144, C_GB = 7168;
constexpr size_t G_U0 = 0;
constexpr size_t G_WM = 32 * MiB;
constexpr size_t G_QD = 48 * MiB;
constexpr size_t G_KDT = 64 * MiB;
constexpr size_t G_QK = 80 * MiB;
constexpr size_t G_CD = 88 * MiB;
constexpr size_t H_QD = 89 * MiB;
constexpr size_t H_KI = 105 * MiB;
constexpr size_t H_KDT = 121 * MiB;
constexpr size_t H_IT = 137 * MiB;
constexpr size_t H_CD = 153 * MiB;
constexpr size_t O_A = 155 * MiB;
constexpr size_t O_B = 171 * MiB;
static_assert(O_B + 16 * MiB <= 216 * MiB, "mixer-0 scratch");

__device__ __forceinline__ f32x4 mfma32(bf16x8 a, bf16x8 b, f32x4 c) { return __builtin_amdgcn_mfma_f32_16x16x32_bf16(a, b, c, 0, 0, 0); }
__device__ __forceinline__ f32x4 mfma16(bf16x4 a, bf16x4 b, f32x4 c) { const bf16x8 a8 = {a[0], a[1], a[2], a[3], 0, 0, 0, 0}, b8 = {b[0], b[1], b[2], b[3], 0, 0, 0, 0}; return __builtin_amdgcn_mfma_f32_16x16x32_bf16(a8, b8, c, 0, 0, 0); }
__device__ __forceinline__ bf16x8 pack8(f32x4 lo, f32x4 hi) {
    u32x4 w; w.x = cvt_pk_bf16(lo[0], lo[1]); w.y = cvt_pk_bf16(lo[2], lo[3]); w.z = cvt_pk_bf16(hi[0], hi[1]); w.w = cvt_pk_bf16(hi[2], hi[3]); return __builtin_bit_cast(bf16x8, w);
}
__device__ __forceinline__ bf16x4 pack4(f32x4 v) { u32x2 w; w.x = cvt_pk_bf16(v[0], v[1]); w.y = cvt_pk_bf16(v[2], v[3]); return __builtin_bit_cast(bf16x4, w); }
__device__ __forceinline__ bf16x8 frag_perm(const LAS bf16_t* rowp, int col) {
    const u32x2 lo = *(const LAS u32x2*)(rowp + col), hi = *(const LAS u32x2*)(rowp + col + 16);
    u32x4 w; w.x = lo.x; w.y = lo.y; w.z = hi.x; w.w = hi.y; return __builtin_bit_cast(bf16x8, w);
}

__device__ __forceinline__ void gdn_pre_pair(const Params& p, const Frame& F, int unit0, int unit1) {
    const int hb = F.wave >> 2, w4 = F.wave & 3, t8 = F.tid & 255, lane = F.lane, fr = lane & 15, g = lane >> 4;
    const int unit = hb ? unit1 : unit0;
    const bool active = unit < 1024;
    const int bh = unit >> 5, ci = unit & 31, b = bh >> 3, h = bh & 7;
    const int tok0 = b * SEQ + ci * 64;
    LAS unsigned char* hl = F.lds + hb * 72192;
    LAS bf16_t* Qb = (LAS bf16_t*)(hl);
    LAS bf16_t* Kb = (LAS bf16_t*)(hl + 17408);
    LAS bf16_t* RVt = (LAS bf16_t*)(hl + 34816);
    LAS bf16_t* RKt = (LAS bf16_t*)(hl + 53248);
    LAS float* sc_g = (LAS float*)(hl + 71680);
    LAS float* sc_b = sc_g + 64;
    LAS float* Lm = (LAS float*)(hl);
    LAS bf16_t* Tb = (LAS bf16_t*)(hl + 17408);
    const bf16_t* H1 = (const bf16_t*)(opq(p.ws) + WS_H1);
    const float* BA = (const float*)(opq(p.ws) + WS_BA);
    unsigned char* scr = opq(p.ws) + WS_SCR;
    if (active) {
        if (t8 < 192) {
            const int sec = t8 >> 6, c2 = (t8 & 63) * 2;
            const int col = sec * 1024 + h * 128 + c2;
            const float* cw = p.in[I_EV_CONV] + col;
            const float w0a = cw[0], w0b = cw[1], w1a = cw[3072], w1b = cw[3073], w2a = cw[6144], w2b = cw[6145], w3a = cw[9216], w3b = cw[9217];
            float xa[3], xb[3];
#pragma unroll
            for (int k = 0; k < 3; ++k) { const int s = ci * 64 - 3 + k; unsigned v = 0u; if (s >= 0) v = *(const unsigned*)(H1 + (size_t)(b * SEQ + s) * H1LD + col); xa[k] = bflo(v); xb[k] = bfhi(v); }
#pragma unroll 1
            for (int q2 = 0; q2 < 2; ++q2) {
                unsigned vv[32];
                if (sec == 2) { sc_b[32 * q2 + (lane & 31)] = sigmoidf_(BA[(size_t)(tok0 + 32 * q2 + (lane & 31)) * 16 + h]); LDS_WAIT(); }
#pragma unroll
                for (int tl = 0; tl < 32; ++tl) vv[tl] = *(const unsigned*)(H1 + (size_t)(tok0 + 32 * q2 + tl) * H1LD + col);
#pragma unroll
                for (int t2 = 0; t2 < 32; ++t2) {
                    const int tl = 32 * q2 + t2;
                    const float x3a = bflo(vv[t2]), x3b = bfhi(vv[t2]);
                    float ya = w0a * xa[0] + w1a * xa[1] + w2a * xa[2] + w3a * x3a, yb = w0b * xb[0] + w1b * xb[1] + w2b * xb[2] + w3b * x3b;
                    xa[0] = xa[1]; xa[1] = xa[2]; xa[2] = x3a; xb[0] = xb[1]; xb[1] = xb[2]; xb[2] = x3b;
                    ya = siluf_(ya); yb = siluf_(yb);
                    if (sec == 0) *(LAS unsigned*)(Qb + tl * 136 + c2) = pk2(ya, yb);
                    else if (sec == 1) *(LAS unsigned*)(Kb + tl * 136 + c2) = pk2(ya, yb);
                    else { const float be = sc_b[tl]; RVt[c2 * 72 + tl] = (bf16_t)f2bf(ya * be); RVt[(c2 + 1) * 72 + tl] = (bf16_t)f2bf(yb * be); }
                }
            }
        } else {
            const int t = tok0 + lane;
            const float ba = BA[(size_t)t * 16 + h], aa = BA[(size_t)t * 16 + 8 + h];
            const float xx = aa + p.in[I_EV_DTB][h];
            const float sp = xx > 20.f ? xx : __logf(1.f + __expf(xx));
            float gg = -expf(p.in[I_EV_ALOG][h]) * sp;
            gg += dpp_f<0x111>(gg); gg += dpp_f<0x112>(gg); gg += dpp_f<0x114>(gg); gg += dpp_f<0x118>(gg);
            { const float t0 = __builtin_bit_cast(float, __builtin_amdgcn_readlane(__builtin_bit_cast(int, gg), 15)), t1 = __builtin_bit_cast(float, __builtin_amdgcn_readlane(__builtin_bit_cast(int, gg), 31)),
                          t2 = __builtin_bit_cast(float, __builtin_amdgcn_readlane(__builtin_bit_cast(int, gg), 47));
              gg += (lane >= 16 ? t0 : 0.f) + (lane >= 32 ? t1 : 0.f) + (lane >= 48 ? t2 : 0.f); }
            sc_g[lane] = gg; sc_b[lane] = sigmoidf_(ba);
        }
    }
    __syncthreads();
    if (active) {
        bf16_t* QDg = (bf16_t*)(scr + G_QD) + (size_t)unit * 64 * 128;
#pragma unroll 2
        for (int rr = 0; rr < 16; ++rr) {
            const int r = w4 * 16 + rr;
            const unsigned qv = *(const LAS unsigned*)(Qb + r * 136 + 2 * lane), kv = *(const LAS unsigned*)(Kb + r * 136 + 2 * lane);
            const float q0 = bflo(qv), q1 = bfhi(qv), k0 = bflo(kv), k1 = bfhi(kv);
            const float sq = wave_sum(q0 * q0 + q1 * q1), sk = wave_sum(k0 * k0 + k1 * k1);
            const float rq = rsqrtf(sq + RMS_EPS) * 0.08838834764831845f, rk = rsqrtf(sk + RMS_EPS);
            const float gc = sc_g[r], be = sc_b[r], eg = expf(gc);
            const float qn0 = q0 * rq, qn1 = q1 * rq, kn0 = k0 * rk, kn1 = k1 * rk;
            *(LAS unsigned*)(Qb + r * 136 + 2 * lane) = pk2(qn0, qn1);
            *(LAS unsigned*)(Kb + r * 136 + 2 * lane) = pk2(kn0, kn1);
            RKt[(2 * lane) * 72 + r] = (bf16_t)f2bf(kn0 * be * eg); RKt[(2 * lane + 1) * 72 + r] = (bf16_t)f2bf(kn1 * be * eg);
            *(unsigned*)(QDg + r * 128 + 2 * lane) = pk2(qn0 * eg, qn1 * eg);
        }
    }
    __syncthreads();
    f32x4 kk[4];
    if (active) {
        {
            bf16_t* KDt = (bf16_t*)(scr + G_KDT) + (size_t)unit * 128 * 64;
            const float gl = sc_g[63];
#pragma unroll
            for (int it = 0; it < 4; ++it) { const int idx = t8 + 256 * it, f = idx >> 3, c0 = (idx & 7) * 8;
                float v[8];
#pragma unroll
                for (int i = 0; i < 8; ++i) v[i] = bf2f(Kb[(c0 + i) * 136 + f]) * expf(gl - sc_g[c0 + i]);
                u32x4 w; w.x = pk2(v[0], v[1]); w.y = pk2(v[2], v[3]); w.z = pk2(v[4], v[5]); w.w = pk2(v[6], v[7]);
                *(u32x4*)(KDt + f * 64 + c0) = w; }
        }
        const int mt = w4;
        bf16_t* QKm = (bf16_t*)(scr + G_QK) + (size_t)unit * 64 * 64;
        bf16x8 a[4];
#pragma unroll
        for (int kb = 0; kb < 4; ++kb) a[kb] = *(const LAS bf16x8*)(Kb + (16 * mt + fr) * 136 + 32 * kb + 8 * g);
#pragma unroll
        for (int nt = 0; nt < 4; ++nt) {
            f32x4 c = (f32x4){0.f, 0.f, 0.f, 0.f}, c2 = (f32x4){0.f, 0.f, 0.f, 0.f};
#pragma unroll
            for (int kb = 0; kb < 4; ++kb) { const bf16x8 bq = *(const LAS bf16x8*)(Qb + (16 * nt + fr) * 136 + 32 * kb + 8 * g), bk = *(const LAS bf16x8*)(Kb + (16 * nt + fr) * 136 + 32 * kb + 8 * g);
                c = mfma32(a[kb], bq, c); c2 = mfma32(a[kb], bk, c2); }
            const int cj = 16 * nt + fr; const float gcol = sc_g[cj];
            {
                float v[4];
#pragma unroll
                for (int r = 0; r < 4; ++r) { const int j = 16 * mt + 4 * g + r; v[r] = (cj >= j) ? expf(gcol - sc_g[j]) * c[r] : 0.f; }
                u32x2 w; w.x = pk2(v[0], v[1]); w.y = pk2(v[2], v[3]);
                *(u32x2*)(QKm + cj * 64 + 16 * mt + 4 * g) = w;
            }
#pragma unroll
            for (int r = 0; r < 4; ++r) { const int i = 16 * mt + 4 * g + r; kk[nt][r] = (i > cj) ? sc_b[i] * expf(sc_g[i] - gcol) * c2[r] : 0.f; }
        }
    }
    __syncthreads();
    if (active) {
#pragma unroll
        for (int nt = 0; nt < 4; ++nt)
#pragma unroll
            for (int r = 0; r < 4; ++r) Lm[(16 * w4 + 4 * g + r) * 68 + 16 * nt + fr] = kk[nt][r];
    }
    __syncthreads();
    if (active && w4 == 0) {
        float t[64];
#pragma unroll
        for (int i = 0; i < 64; ++i) t[i] = 0.f;
#pragma unroll
        for (int i = 0; i < 64; ++i) {
            float a0 = (i == lane) ? 1.f : 0.f, a1 = 0.f, a2 = 0.f, a3 = 0.f;
#pragma unroll
            for (int jj = 0; jj < (i + 3) / 4; ++jj) { const f32x4 lv = *(const LAS f32x4*)(Lm + i * 68 + 4 * jj);
                a0 -= lv[0] * t[4 * jj]; a1 -= lv[1] * t[4 * jj + 1]; a2 -= lv[2] * t[4 * jj + 2]; a3 -= lv[3] * t[4 * jj + 3]; }
            t[i] = (a0 + a1) + (a2 + a3);
        }
#pragma unroll
        for (int i = 0; i < 64; ++i) Tb[i * 72 + lane] = (bf16_t)f2bf(t[i]);
    }
    __syncthreads();
    if (active) {
        f32x4* U0f = (f32x4*)(scr + G_U0) + (size_t)unit * 8 * 4 * 64;
        bf16_t* Wm = (bf16_t*)(scr + G_WM) + (size_t)unit * 64 * 128;
#pragma unroll
        for (int hh = 0; hh < 2; ++hh) {
            const int ct = w4 + 4 * hh;
            bf16x8 bv[2], ak[2];
#pragma unroll
            for (int k = 0; k < 2; ++k) { bv[k] = *(const LAS bf16x8*)(RVt + (16 * ct + fr) * 72 + 32 * k + 8 * g); ak[k] = *(const LAS bf16x8*)(RKt + (16 * ct + fr) * 72 + 32 * k + 8 * g); }
#pragma unroll
            for (int mt = 0; mt < 4; ++mt) {
                f32x4 c = (f32x4){0.f, 0.f, 0.f, 0.f}, c2 = (f32x4){0.f, 0.f, 0.f, 0.f};
#pragma unroll
                for (int k = 0; k < 2; ++k) { const bf16x8 tt = *(const LAS bf16x8*)(Tb + (16 * mt + fr) * 72 + 32 * k + 8 * g); c = mfma32(tt, bv[k], c); c2 = mfma32(ak[k], tt, c2); }
                U0f[(ct * 4 + mt) * 64 + lane] = c;
                u32x2 w; w.x = pk2(-c2[0], -c2[1]); w.y = pk2(-c2[2], -c2[3]);
                *(u32x2*)(Wm + (16 * mt + fr) * 128 + 16 * ct + 4 * g) = w;
            }
        }
        if (t8 == 0) ((float*)(scr + G_CD))[unit] = expf(sc_g[63]);
    }
    __syncthreads();
}

__device__ __forceinline__ void hgrn_pre_unit(const Params& p, const Frame& F, int tc) {
    const int col = 2 * F.tid, h = col >> 7, f = col & 127;
    const float* lbl = p.in[I_LBLOG];
    float lb[2];
#pragma unroll
    for (int k = 0; k < 2; ++k) { const float l0 = lbl[col + k], l1 = lbl[1024 + col + k], l2 = lbl[2048 + col + k]; const float m = fmaxf(l0, fmaxf(l1, l2));
        const float e0 = expf(l0 - m), e1 = expf(l1 - m), e2 = expf(l2 - m); lb[k] = e0 / (e0 + e1 + e2); }
    const int t0 = tc * 16, b = t0 / SEQ, chunk = (t0 % SEQ) >> 4, bh = b * 8 + h;
    const bf16_t* H1 = (const bf16_t*)(opq(p.ws) + WS_H1);
    unsigned char* scr = opq(p.ws) + WS_SCR;
    float bc0[16], bc1[16], kk0[16], kk1[16]; unsigned iv[16];
    float cum0 = 0.f, cum1 = 0.f;
    unsigned qva[16], fva[16];
#pragma unroll
    for (int c = 0; c < 16; ++c) { const size_t row = (size_t)(t0 + c);
        qva[c] = *(const unsigned*)(H1 + row * H1LD + C_QB + col); fva[c] = *(const unsigned*)(H1 + row * H1LD + C_FB + col); iv[c] = *(const unsigned*)(H1 + row * H1LD + C_IB + col); }
#pragma unroll
    for (int c = 0; c < 16; ++c) {
        const size_t row = (size_t)(t0 + c);
        const unsigned qv = qva[c], fv = fva[c];
        const float f0 = lb[0] + (1.f - lb[0]) * sigmoidf_(bflo(fv)), f1 = lb[1] + (1.f - lb[1]) * sigmoidf_(bfhi(fv));
        cum0 += logf(f0); cum1 += logf(f1);
        bc0[c] = cum0; bc1[c] = cum1; kk0[c] = 1.f - f0; kk1[c] = 1.f - f1;
        *(unsigned*)((bf16_t*)(scr + H_QD) + row * 1024 + col) = pk2(bflo(qv) * expf(cum0), bfhi(qv) * expf(cum1));
        *(unsigned*)((bf16_t*)(scr + H_KI) + row * 1024 + col) = pk2(kk0[c] * expf(-cum0), kk1[c] * expf(-cum1));
    }
    unsigned kd0[8], kd1[8], i0[8], i1[8];
#pragma unroll
    for (int c = 0; c < 16; c += 2) {
        kd0[c >> 1] = pk2(kk0[c] * expf(cum0 - bc0[c]), kk0[c + 1] * expf(cum0 - bc0[c + 1]));
        kd1[c >> 1] = pk2(kk1[c] * expf(cum1 - bc1[c]), kk1[c + 1] * expf(cum1 - bc1[c + 1]));
        i0[c >> 1] = (iv[c] & 0xffffu) | (iv[c + 1] << 16);
        i1[c >> 1] = (iv[c] >> 16) | (iv[c + 1] & 0xffff0000u);
    }
    const size_t base = ((size_t)(bh * 128 + chunk) * 128 + f) * 16;
    u32x4* kd = (u32x4*)((bf16_t*)(scr + H_KDT) + base); u32x4* it = (u32x4*)((bf16_t*)(scr + H_IT) + base);
    kd[0] = (u32x4){kd0[0], kd0[1], kd0[2], kd0[3]}; kd[1] = (u32x4){kd0[4], kd0[5], kd0[6], kd0[7]};
    kd[2] = (u32x4){kd1[0], kd1[1], kd1[2], kd1[3]}; kd[3] = (u32x4){kd1[4], kd1[5], kd1[6], kd1[7]};
    it[0] = (u32x4){i0[0], i0[1], i0[2], i0[3]}; it[1] = (u32x4){i0[4], i0[5], i0[6], i0[7]};
    it[2] = (u32x4){i1[0], i1[1], i1[2], i1[3]}; it[3] = (u32x4){i1[4], i1[5], i1[6], i1[7]};
    *(f32x2*)((float*)(scr + H_CD) + (size_t)(bh * 128 + chunk) * 128 + f) = (f32x2){expf(cum0), expf(cum1)};
}

__device__ __forceinline__ void p2_pre(const Params& p, const Frame& F0) {
    const Frame F = refresh(F0);
    for (int u = F.bid; u < 1024; u += 2 * F.G) gdn_pre_pair(p, F, u, u + F.G);
    for (int u = F.bid; u < 512; u += F.G) hgrn_pre_unit(p, F, u);
}

__device__ __forceinline__ void gdn_scan(const Params& p, const Frame& F0, int bh) {
    const Frame F = refresh(F0);
    const int lane = F.lane, fr = lane & 15, g = lane >> 4, wave = F.wave, b = bh >> 3, h = bh & 7;
    unsigned char* scr = opqg(p.ws) + WS_SCR;
    constexpr int BUFB = 62464, OFF_QD = 17408, OFF_KDT = 34816, OFF_QK = 53248;
    const bf16_t* gWM = (const bf16_t*)(scr + G_WM); const bf16_t* gQD = (const bf16_t*)(scr + G_QD);
    const bf16_t* gKDT = (const bf16_t*)(scr + G_KDT); const bf16_t* gQK = (const bf16_t*)(scr + G_QK);
    const f32x4* gU0 = (const f32x4*)(scr + G_U0); const float* gCD = (const float*)(scr + G_CD);
    bf16_t* OA = (bf16_t*)(scr + O_A);
    u32x4 rw[2], rq[2], rk[2], rqk; f32x4 u0c[4], u0n[4];
#define GS_ISSUE(u) do { _Pragma("unroll") for (int i = 0; i < 2; ++i) { const int idx = F.tid + 512 * i; \
        rw[i] = *(const u32x4*)(gWM + (size_t)(u) * 8192 + idx * 8); rq[i] = *(const u32x4*)(gQD + (size_t)(u) * 8192 + idx * 8); rk[i] = *(const u32x4*)(gKDT + (size_t)(u) * 8192 + idx * 8); } \
        rqk = *(const u32x4*)(gQK + (size_t)(u) * 4096 + F.tid * 8); \
        _Pragma("unroll") for (int mt = 0; mt < 4; ++mt) u0n[mt] = gU0[(((size_t)(u) * 8 + wave) * 4 + mt) * 64 + lane]; } while (0)
#define GS_WRITE(bufp) do { _Pragma("unroll") for (int i = 0; i < 2; ++i) { const int idx = F.tid + 512 * i; \
        *(LAS u32x4*)((bufp) + ((idx >> 4) * 136 + (idx & 15) * 8) * 2) = rw[i]; *(LAS u32x4*)((bufp) + OFF_QD + ((idx >> 4) * 136 + (idx & 15) * 8) * 2) = rq[i]; \
        *(LAS u32x4*)((bufp) + OFF_KDT + ((idx >> 3) * 72 + (idx & 7) * 8) * 2) = rk[i]; } \
        *(LAS u32x4*)((bufp) + OFF_QK + ((F.tid >> 3) * 72 + (F.tid & 7) * 8) * 2) = rqk; } while (0)
    f32x4 Sacc[8];
#pragma unroll
    for (int ft = 0; ft < 8; ++ft) Sacc[ft] = (f32x4){0.f, 0.f, 0.f, 0.f};
    GS_ISSUE(bh * 32);
    GS_WRITE(F.lds);
#pragma unroll
    for (int mt = 0; mt < 4; ++mt) u0c[mt] = u0n[mt];
    __syncthreads();
    float dec = ld_agent(gCD + bh * 32);
    for (int ci = 0; ci < 32; ++ci) {
        const int u = bh * 32 + ci;
        LAS unsigned char* buf = F.lds + (ci & 1) * BUFB;
        float decn = dec; if (ci + 1 < 32) decn = ld_agent(gCD + u + 1);
        if (ci + 1 < 32) GS_ISSUE(u + 1);
        const LAS bf16_t* WM = (const LAS bf16_t*)buf; const LAS bf16_t* QD = (const LAS bf16_t*)(buf + OFF_QD);
        const LAS bf16_t* KDT = (const LAS bf16_t*)(buf + OFF_KDT); const LAS bf16_t* QK = (const LAS bf16_t*)(buf + OFF_QK);
        bf16x8 Sbf[4];
#pragma unroll
        for (int kb = 0; kb < 4; ++kb) Sbf[kb] = pack8(Sacc[2 * kb], Sacc[2 * kb + 1]);
        f32x4 uacc[4], oacc[4];
#pragma unroll
        for (int mt = 0; mt < 4; ++mt) { uacc[mt] = u0c[mt]; oacc[mt] = (f32x4){0.f, 0.f, 0.f, 0.f}; }
        bf16x8 fa[8], fb[8];
#define GS_LD_UQ(dst, mt) do { _Pragma("unroll") for (int kb = 0; kb < 4; ++kb) { dst[kb] = frag_perm(WM + (16 * (mt) + fr) * 136, 32 * kb + 4 * g); dst[4 + kb] = frag_perm(QD + (16 * (mt) + fr) * 136, 32 * kb + 4 * g); } } while (0)
#define GS_MM_UQ(src, mt) do { _Pragma("unroll") for (int kb = 0; kb < 4; ++kb) { uacc[mt] = mfma32(src[kb], Sbf[kb], uacc[mt]); oacc[mt] = mfma32(src[4 + kb], Sbf[kb], oacc[mt]); } } while (0)
        GS_LD_UQ(fa, 0);
        GS_LD_UQ(fb, 1); __builtin_amdgcn_sched_barrier(0); GS_MM_UQ(fa, 0); __builtin_amdgcn_sched_barrier(0);
        GS_LD_UQ(fa, 2); __builtin_amdgcn_sched_barrier(0); GS_MM_UQ(fb, 1); __builtin_amdgcn_sched_barrier(0);
        GS_LD_UQ(fb, 3); __builtin_amdgcn_sched_barrier(0); GS_MM_UQ(fa, 2); __builtin_amdgcn_sched_barrier(0);
#pragma unroll
        for (int mt = 0; mt < 4; ++mt)
#pragma unroll
            for (int k = 0; k < 2; ++k) fa[2 * mt + k] = frag_perm(QK + (16 * mt + fr) * 72, 32 * k + 4 * g);
        __builtin_amdgcn_sched_barrier(0); GS_MM_UQ(fb, 3); __builtin_amdgcn_sched_barrier(0);
#undef GS_LD_UQ
#undef GS_MM_UQ
        bf16x8 ubf[2];
#pragma unroll
        for (int k = 0; k < 2; ++k) ubf[k] = pack8(uacc[2 * k], uacc[2 * k + 1]);
#pragma unroll
        for (int ft = 0; ft < 4; ++ft)
#pragma unroll
            for (int k = 0; k < 2; ++k) fb[2 * ft + k] = frag_perm(KDT + (16 * ft + fr) * 72, 32 * k + 4 * g);
        __builtin_amdgcn_sched_barrier(0);
#pragma unroll
        for (int mt = 0; mt < 4; ++mt)
#pragma unroll
            for (int k = 0; k < 2; ++k) oacc[mt] = mfma32(fa[2 * mt + k], ubf[k], oacc[mt]);
        __builtin_amdgcn_sched_barrier(0);
#pragma unroll
        for (int ft = 0; ft < 4; ++ft)
#pragma unroll
            for (int k = 0; k < 2; ++k) fa[2 * ft + k] = frag_perm(KDT + (16 * (4 + ft) + fr) * 72, 32 * k + 4 * g);
        __builtin_amdgcn_sched_barrier(0);
#pragma unroll
        for (int ft = 0; ft < 4; ++ft) {
            Sacc[ft] = Sacc[ft] * dec;
#pragma unroll
            for (int k = 0; k < 2; ++k) Sacc[ft] = mfma32(fb[2 * ft + k], ubf[k], Sacc[ft]);
        }
        __builtin_amdgcn_sched_barrier(0);
#pragma unroll
        for (int ft = 0; ft < 4; ++ft) {
            Sacc[4 + ft] = Sacc[4 + ft] * dec;
#pragma unroll
            for (int k = 0; k < 2; ++k) Sacc[4 + ft] = mfma32(fa[2 * ft + k], ubf[k], Sacc[4 + ft]);
        }
        dec = decn;
        {
            bf16_t* orow = OA + (size_t)(b * SEQ + ci * 64) * 1024 + h * 128 + 16 * wave + fr;
#pragma unroll
            for (int mt = 0; mt < 4; ++mt)
#pragma unroll
                for (int r = 0; r < 4; ++r) orow[(size_t)(16 * mt + 4 * g + r) * 1024] = (bf16_t)f2bf(oacc[mt][r]);
        }
        if (ci + 1 < 32) { GS_WRITE(F.lds + ((ci + 1) & 1) * BUFB);
#pragma unroll
            for (int mt = 0; mt < 4; ++mt) u0c[mt] = u0n[mt]; }
        asm volatile("s_waitcnt lgkmcnt(0)" ::: "memory"); __builtin_amdgcn_s_barrier();
    }
#undef GS_ISSUE
#undef GS_WRITE
}

__device__ __forceinline__ void hgrn_scan(const Params& p, const Frame& F0, int bh) {
    const Frame F = refresh(F0);
    const int lane = F.lane, fr = lane & 15, g = lane >> 4, wave = F.wave, b = bh >> 3, h = bh & 7;
    unsigned char* scr = opqg(p.ws) + WS_SCR;
    constexpr int BUFB = 61440, OFF_KI = 17408, OFF_KDT = 34816, OFF_CD = 59392;
    const bf16_t* gQD = (const bf16_t*)(scr + H_QD); const bf16_t* gKI = (const bf16_t*)(scr + H_KI);
    const bf16_t* gKDT = (const bf16_t*)(scr + H_KDT) + (size_t)bh * 128 * 128 * 16; const bf16_t* gIT = (const bf16_t*)(scr + H_IT) + (size_t)bh * 128 * 128 * 16;
    const float* gCD = (const float*)(scr + H_CD) + (size_t)bh * 128 * 128;
    bf16_t* OB = (bf16_t*)(scr + O_B);
    u32x4 rq[2], rk[2], rd[2], rc; u32x2 itn[4], itc[4];
#define HS_ISSUE(grp) do { _Pragma("unroll") for (int i = 0; i < 2; ++i) { const int idx = F.tid + 512 * i; const size_t go = (size_t)(b * SEQ + (grp) * 64 + (idx >> 4)) * 1024 + h * 128 + (idx & 15) * 8; \
        rq[i] = *(const u32x4*)(gQD + go); rk[i] = *(const u32x4*)(gKI + go); rd[i] = *(const u32x4*)(gKDT + (size_t)(grp) * 8192 + idx * 8); } \
        if (F.tid < 128) rc = *(const u32x4*)(gCD + (size_t)(grp) * 512 + F.tid * 4); \
        _Pragma("unroll") for (int sc = 0; sc < 4; ++sc) itn[sc] = *(const u32x2*)(gIT + ((size_t)((grp) * 4 + sc) * 128 + 16 * wave + fr) * 16 + 4 * g); } while (0)
#define HS_WRITE(bufp) do { _Pragma("unroll") for (int i = 0; i < 2; ++i) { const int idx = F.tid + 512 * i; \
        *(LAS u32x4*)((bufp) + ((idx >> 4) * 136 + (idx & 15) * 8) * 2) = rq[i]; *(LAS u32x4*)((bufp) + OFF_KI + ((idx >> 4) * 136 + (idx & 15) * 8) * 2) = rk[i]; \
        *(LAS u32x4*)((bufp) + OFF_KDT + ((idx >> 1) * 24 + (idx & 1) * 8) * 2) = rd[i]; } \
        if (F.tid < 128) *(LAS u32x4*)((bufp) + OFF_CD + F.tid * 16) = rc; } while (0)
    f32x4 Sacc[8];
#pragma unroll
    for (int ft = 0; ft < 8; ++ft) Sacc[ft] = (f32x4){0.f, 0.f, 0.f, 0.f};
    HS_ISSUE(0);
    HS_WRITE(F.lds);
#pragma unroll
    for (int sc = 0; sc < 4; ++sc) itc[sc] = itn[sc];
    __syncthreads();
    for (int grp = 0; grp < 32; ++grp) {
        LAS unsigned char* buf = F.lds + (grp & 1) * BUFB;
        if (grp + 1 < 32) HS_ISSUE(grp + 1);
        const LAS bf16_t* QD = (const LAS bf16_t*)buf; const LAS bf16_t* KI = (const LAS bf16_t*)(buf + OFF_KI);
        const LAS bf16_t* KDT = (const LAS bf16_t*)(buf + OFF_KDT); const LAS float* CD = (const LAS float*)(buf + OFF_CD);
        bf16x8 qfA[4], kfA[4], qfB[4], kfB[4];
#define HS_LDS(sc, X) do { _Pragma("unroll") for (int kb = 0; kb < 4; ++kb) { qf##X[kb] = frag_perm(QD + (16 * (sc) + fr) * 136, 32 * kb + 4 * g); kf##X[kb] = frag_perm(KI + (16 * (sc) + fr) * 136, 32 * kb + 4 * g); } \
            } while (0)
#define HS_SUB(sc, X) do { \
            f32x4 dd[8]; bf16x4 kd[8];        \
            _Pragma("unroll") for (int ft = 0; ft < 8; ++ft) { dd[ft] = *(const LAS f32x4*)(CD + (sc) * 128 + 16 * ft + 4 * g); kd[ft] = *(const LAS bf16x4*)(KDT + (((sc) * 128) + 16 * ft + fr) * 24 + 4 * g); } \
            bf16x8 Sbf[4]; \
            _Pragma("unroll") for (int kb = 0; kb < 4; ++kb) Sbf[kb] = pack8(Sacc[2 * kb], Sacc[2 * kb + 1]); \
            f32x4 o = (f32x4){0.f, 0.f, 0.f, 0.f}, pT = (f32x4){0.f, 0.f, 0.f, 0.f}; \
            _Pragma("unroll") for (int kb = 0; kb < 4; ++kb) { o = mfma32(qf##X[kb], Sbf[kb], o); pT = mfma32(kf##X[kb], qf##X[kb], pT); } \
            _Pragma("unroll") for (int r = 0; r < 4; ++r) pT[r] = (fr >= 4 * g + r) ? pT[r] : 0.f; \
            const bf16x4 itf = __builtin_bit_cast(bf16x4, itc[sc]); \
            o = mfma16(pack4(pT), itf, o); \
            _Pragma("unroll") for (int ft = 0; ft < 8; ++ft) Sacc[ft] = mfma16(kd[ft], itf, Sacc[ft] * dd[ft]); \
            bf16_t* orow = OB + (size_t)(b * SEQ + grp * 64 + (sc) * 16) * 1024 + h * 128 + 16 * wave + fr; \
            _Pragma("unroll") for (int r = 0; r < 4; ++r) orow[(size_t)(4 * g + r) * 1024] = (bf16_t)f2bf(o[r]); \
        } while (0)
        HS_LDS(0, A); __builtin_amdgcn_sched_barrier(0);
        HS_LDS(1, B); __builtin_amdgcn_sched_barrier(0); HS_SUB(0, A); __builtin_amdgcn_sched_barrier(0);
        HS_LDS(2, A); __builtin_amdgcn_sched_barrier(0); HS_SUB(1, B); __builtin_amdgcn_sched_barrier(0);
        HS_LDS(3, B); __builtin_amdgcn_sched_barrier(0); HS_SUB(2, A); __builtin_amdgcn_sched_barrier(0);
        HS_SUB(3, B);
#undef HS_LDS
#undef HS_SUB
        if (grp + 1 < 32) { HS_WRITE(F.lds + ((grp + 1) & 1) * BUFB);
#pragma unroll
            for (int sc = 0; sc < 4; ++sc) itc[sc] = itn[sc]; }
        asm volatile("s_waitcnt lgkmcnt(0)" ::: "memory"); __builtin_amdgcn_s_barrier();
    }
#undef HS_ISSUE
#undef HS_WRITE
}

__device__ __forceinline__ void p4_gate(const Params& p, const Frame& F0) {
    const Frame F = refresh(F0);
    const int gw = F.bid * NWAVES + F.wave, NGW = F.G * NWAVES, hs = F.lane >> 4, e0 = (F.lane & 15) * 8;
    unsigned char* scr = opq(p.ws) + WS_SCR;
    const bf16_t* H1 = (const bf16_t*)(opq(p.ws) + WS_H1); bf16_t* OC = (bf16_t*)(opq(p.ws) + WS_OC);
    for (int m0 = gw; m0 < T; m0 += 2 * NGW) {
        u32x4 ovv[2][4], zvv[2][4];
#pragma unroll
        for (int q = 0; q < 2; ++q) { const int m = m0 + q * NGW; if (m < T) {
#pragma unroll
            for (int rr = 0; rr < 4; ++rr) { const int hh = rr * 4 + hs; const bool isb = hh >= 8; const int hd = hh & 7;
                ovv[q][rr] = *(const u32x4*)((const bf16_t*)(scr + (isb ? O_B : O_A)) + (size_t)m * 1024 + hd * 128 + e0);
                zvv[q][rr] = *(const u32x4*)(H1 + (size_t)m * H1LD + (isb ? C_GB : C_ZA) + hd * 128 + e0); } } }
#pragma unroll
        for (int q = 0; q < 2; ++q) { const int m = m0 + q * NGW; if (m < T) {
#pragma unroll
        for (int rr = 0; rr < 4; ++rr) {
            const int hh = rr * 4 + hs;
            const bool isb = hh >= 8;
            const float* gsrc = (isb ? p.in[I_EV_HGRNN] : p.in[I_EV_GDNN]) + e0;
            const u32x4 ov = ovv[q][rr], zv = zvv[q][rr];
            const f32x4 g0 = *(const f32x4*)gsrc, g1 = *(const f32x4*)(gsrc + 4);
            float x[8] = {bflo(ov.x), bfhi(ov.x), bflo(ov.y), bfhi(ov.y), bflo(ov.z), bfhi(ov.z), bflo(ov.w), bfhi(ov.w)};
            const float z[8] = {bflo(zv.x), bfhi(zv.x), bflo(zv.y), bfhi(zv.y), bflo(zv.z), bfhi(zv.z), bflo(zv.w), bfhi(zv.w)};
            const float gn[8] = {g0[0], g0[1], g0[2], g0[3], g1[0], g1[1], g1[2], g1[3]};
            float ss = 0.f;
#pragma unroll
            for (int i = 0; i < 8; ++i) ss += x[i] * x[i];
            ss = row16_sum(ss);
            const float rinv = rsqrtf(ss * (1.f / 128.f) + RMS_EPS);
#pragma unroll
            for (int i = 0; i < 8; ++i) x[i] = x[i] * rinv * gn[i] * siluf_(z[i]);
            u32x2 w; w.x = pk4_fp8(x[0] * A_PRE, x[1] * A_PRE, x[2] * A_PRE, x[3] * A_PRE); w.y = pk4_fp8(x[4] * A_PRE, x[5] * A_PRE, x[6] * A_PRE, x[7] * A_PRE);
            *(u32x2*)((unsigned char*)OC + (size_t)m * 2048 + hh * 128 + e0) = w;
        } } }
    }
}

constexpr int H3LD = 6144;
constexpr size_t A_QR = 0;
constexpr size_t A_KR = 32 * MiB;
constexpr size_t A_VT = 64 * MiB;
constexpr size_t A_OG = 96 * MiB;
constexpr size_t A_LSE = 120 * MiB;
constexpr size_t A_KPART = 121 * MiB;
constexpr float QSCALE = 0.08838834764831845f * 1.4426950408889634f;
__device__ __forceinline__ int head_dil_log2(int hd) { return hd < 4 ? 0 : hd < 8 ? 2 : hd < 12 ? 4 : 0; }
__device__ __forceinline__ int posp(int s, int dl) { return ((s & ((1 << dl) - 1)) << (11 - dl)) + (s >> dl); }

__device__ __forceinline__ void rope_unit(const Params& p, const Frame& F, int unit) {
    const int hh = unit & 1, st = (unit >> 1) & 31, b = unit >> 6, s0 = st * 64;
    const bf16_t* H3 = (const bf16_t*)(opq(p.ws) + WS_H1);
    unsigned char* scr = opq(p.ws) + WS_SCR;
    bf16_t* QR = (bf16_t*)(scr + A_QR); bf16_t* KR = (bf16_t*)(scr + A_KR); bf16_t* VT = (bf16_t*)(scr + A_VT); float* KPART = (float*)(scr + A_KPART);
    LAS float* KS = (LAS float*)F.lds;
    LAS bf16_t* VL = (LAS bf16_t*)(F.lds + 33280);
    const int tok2 = F.tid >> 4, pj = (F.tid & 15) * 4;
    float cs[2][4], sn[2][4];
#pragma unroll
    for (int tt = 0; tt < 2; ++tt)
#pragma unroll
        for (int i = 0; i < 4; ++i) { const float inv = powf(10000.0f, -(float)(pj + i) * (1.0f / 64.0f)); const float ang = (float)(s0 + tok2 + 32 * tt) * inv; sincosf(ang, &sn[tt][i], &cs[tt][i]); }
    u32x2 na[2][2], nc[2][2]; u32x4 nv[2];
#define RP_LOAD(hi_) do { const int hd_ = hh * 8 + (hi_); \
        const int qcol_ = hd_ < 12 ? hd_ * 128 : 4608 + (hd_ - 12) * 128, kcol_ = hd_ < 12 ? 1536 + hd_ * 128 : 5120 + (hd_ - 12) * 128, vcol_ = hd_ < 12 ? 3072 + hd_ * 128 : 5632 + (hd_ - 12) * 128; \
        _Pragma("unroll") for (int tt = 0; tt < 2; ++tt) { const size_t row_ = (size_t)(b * SEQ + s0 + tok2 + 32 * tt) * H3LD; \
            _Pragma("unroll") for (int qk = 0; qk < 2; ++qk) { const bf16_t* src_ = H3 + row_ + (qk ? kcol_ : qcol_) + pj; na[tt][qk] = *(const u32x2*)src_; nc[tt][qk] = *(const u32x2*)(src_ + 64); } } \
        _Pragma("unroll") for (int i = 0; i < 2; ++i) { const int idx = F.tid + 512 * i; nv[i] = *(const u32x4*)(H3 + (size_t)(b * SEQ + s0 + (idx >> 4)) * H3LD + vcol_ + (idx & 15) * 8); } } while (0)
    RP_LOAD(0);
    for (int hi = 0; hi < 8; ++hi) {
        const int hd = hh * 8 + hi, dl = head_dil_log2(hd);
        const size_t hb = (size_t)(b * 16 + hd) * 2048;
        u32x2 ca[2][2], cc[2][2]; u32x4 cv[2];
#pragma unroll
        for (int tt = 0; tt < 2; ++tt)
#pragma unroll
            for (int qk = 0; qk < 2; ++qk) { ca[tt][qk] = na[tt][qk]; cc[tt][qk] = nc[tt][qk]; }
        cv[0] = nv[0]; cv[1] = nv[1];
        if (hi + 1 < 8) RP_LOAD(hi + 1);
#pragma unroll
        for (int tt = 0; tt < 2; ++tt) {
            const int tl = tok2 + 32 * tt, s = s0 + tl; const size_t orow = (hb + posp(s, dl)) * 128;
#pragma unroll
            for (int qk = 0; qk < 2; ++qk) {
                const u32x2 a = ca[tt][qk], c = cc[tt][qk];
                const float x1[4] = {bflo(a.x), bfhi(a.x), bflo(a.y), bfhi(a.y)}, x2[4] = {bflo(c.x), bfhi(c.x), bflo(c.y), bfhi(c.y)};
                float y1[4], y2[4]; const float sc = qk ? 1.0f : QSCALE;
#pragma unroll
                for (int i = 0; i < 4; ++i) { y1[i] = (x1[i] * cs[tt][i] - x2[i] * sn[tt][i]) * sc; y2[i] = (x2[i] * cs[tt][i] + x1[i] * sn[tt][i]) * sc; }
                bf16_t* dst = (qk ? KR : QR) + orow + pj;
                u32x2 w1, w2; w1.x = pk2(y1[0], y1[1]); w1.y = pk2(y1[2], y1[3]); w2.x = pk2(y2[0], y2[1]); w2.y = pk2(y2[2], y2[3]);
                *(u32x2*)dst = w1; *(u32x2*)(dst + 64) = w2;
                if (qk && hd >= 12) {
#pragma unroll
                    for (int i = 0; i < 4; ++i) { KS[tl * 129 + pj + i] = y1[i]; KS[tl * 129 + 64 + pj + i] = y2[i]; }
                }
            }
        }
#pragma unroll
        for (int i = 0; i < 2; ++i) { const int idx = F.tid + 512 * i, tl = idx >> 4, pc = idx & 15;
            *(LAS u32x4*)(VL + tl * 136 + pc * 8) = cv[i]; }
        asm volatile("s_waitcnt lgkmcnt(0)" ::: "memory"); __builtin_amdgcn_s_barrier();
        if (hd >= 12 && F.tid < 128) { float sum = 0.f;
#pragma unroll 8
            for (int tl = 0; tl < 64; ++tl) sum += KS[tl * 129 + F.tid];
            KPART[((size_t)(b * 4 + hd - 12) * 32 + st) * 128 + F.tid] = sum; }
        {
            const int pp = posp(s0 + F.lane, dl);
#pragma unroll 4
            for (int i = 0; i < 16; ++i) { const int d = F.wave * 16 + i; VT[((size_t)(b * 16 + hd) * 128 + d) * 2048 + pp] = VL[F.lane * 136 + d]; }
        }
        asm volatile("s_waitcnt lgkmcnt(0)" ::: "memory"); __builtin_amdgcn_s_barrier();
    }
#undef RP_LOAD
}

template <int MODE>
__device__ __forceinline__ void attn_item(const Params& p, const Frame& F0, int b, int hd, int q0, int ktile_lo, int ktile_hi) {
    const Frame F = refresh(F0);
    const int lane = F.lane, fr = lane & 15, g = lane >> 4, wave = F.wave;
    unsigned char* scr = opq(p.ws) + WS_SCR;
    const size_t hb = (size_t)(b * 16 + hd);
    const bf16_t* Qg = (const bf16_t*)(scr + A_QR) + hb * 2048 * 128; const bf16_t* Kg = (const bf16_t*)(scr + A_KR) + hb * 2048 * 128; const bf16_t* Vg = (const bf16_t*)(scr + A_VT) + hb * 128 * 2048;
    constexpr int BUFB = 35840, OFF_V = 17408, OFF_KM = 71680;
    const int nq = q0 + 16 * wave + fr;
    bf16x8 qf[4];
#pragma unroll
    for (int kb = 0; kb < 4; ++kb) qf[kb] = *(const bf16x8*)(Qg + (size_t)nq * 128 + 32 * kb + 8 * g);
    unsigned selmask = 0u;
    if (MODE == 1) {
        const int qb = q0 >> 8, h = hd - 12;
        LAS float* KM = (LAS float*)(F.lds + OFF_KM);
        const float* KPART = (const float*)(scr + A_KPART) + (size_t)(b * 4 + h) * 32 * 128;
#pragma unroll
        for (int i = 0; i < 2; ++i) { const int idx = F.tid + 512 * i, jb = idx >> 7, d = idx & 127;
            KM[idx] = (KPART[(4 * jb + 0) * 128 + d] + KPART[(4 * jb + 1) * 128 + d]) + (KPART[(4 * jb + 2) * 128 + d] + KPART[(4 * jb + 3) * 128 + d]); }
        __syncthreads();
        float gate[8];
#pragma unroll
        for (int jb = 0; jb < 8; ++jb) { float s = 0.f;
#pragma unroll
            for (int kb = 0; kb < 4; ++kb) { const u32x4 qq = __builtin_bit_cast(u32x4, qf[kb]); const LAS float* km = KM + jb * 128 + 32 * kb + 8 * g;
                const f32x4 k0 = *(const LAS f32x4*)km, k1 = *(const LAS f32x4*)(km + 4);
                s += (bflo(qq.x) * k0[0] + bfhi(qq.x) * k0[1]) + (bflo(qq.y) * k0[2] + bfhi(qq.y) * k0[3]) + (bflo(qq.z) * k1[0] + bfhi(qq.z) * k1[1]) + (bflo(qq.w) * k1[2] + bfhi(qq.w) * k1[3]); }
            s += xor16_f(s); s = xor32_sum(s); gate[jb] = s; }
#pragma unroll
        for (int jb = 0; jb < 8; ++jb) { int rank = 0;
#pragma unroll
            for (int j2 = 0; j2 < 8; ++j2) if (j2 != jb && j2 < qb) rank += (gate[j2] > gate[jb] || (gate[j2] == gate[jb] && j2 < jb)) ? 1 : 0;
            if (jb < qb && rank < 3) selmask |= 1u << jb; }
        __syncthreads();
    }
    u32x4 rk[2], rv[2];
#define AT_ISSUE(kt) do { _Pragma("unroll") for (int i = 0; i < 2; ++i) { const int idx = F.tid + 512 * i; \
        rk[i] = *(const u32x4*)(Kg + (size_t)((kt) * 64 + (idx >> 4)) * 128 + (idx & 15) * 8); rv[i] = *(const u32x4*)(Vg + (size_t)(idx >> 3) * 2048 + (kt) * 64 + (idx & 7) * 8); } } while (0)
#define AT_WRITE(bufp) do { _Pragma("unroll") for (int i = 0; i < 2; ++i) { const int idx = F.tid + 512 * i; \
        *(LAS u32x4*)((bufp) + ((idx >> 4) * 136 + (idx & 15) * 8) * 2) = rk[i]; *(LAS u32x4*)((bufp) + OFF_V + ((idx >> 3) * 72 + (idx & 7) * 8) * 2) = rv[i]; } } while (0)
    f32x4 oacc[8];
#pragma unroll
    for (int dt = 0; dt < 8; ++dt) oacc[dt] = (f32x4){0.f, 0.f, 0.f, 0.f};
    float mrun = -1e30f, lrun = 0.f;
    AT_ISSUE(ktile_lo);
    AT_WRITE(F.lds);
    __syncthreads();
    for (int kt = ktile_lo; kt < ktile_hi; ++kt) {
        LAS unsigned char* buf = F.lds + ((kt - ktile_lo) & 1) * BUFB;
        if (kt + 1 < ktile_hi) AT_ISSUE(kt + 1);
        const LAS bf16_t* KL = (const LAS bf16_t*)buf; const LAS bf16_t* VL = (const LAS bf16_t*)(buf + OFF_V);
        f32x4 sT[4];
        {
            bf16x8 kf[16];
#pragma unroll
            for (int t4 = 0; t4 < 4; ++t4)
#pragma unroll
                for (int kb = 0; kb < 4; ++kb) kf[4 * t4 + kb] = *(const LAS bf16x8*)(KL + (16 * t4 + fr) * 136 + 32 * kb + 8 * g);
            __builtin_amdgcn_sched_barrier(0);
#pragma unroll
            for (int t4 = 0; t4 < 4; ++t4) { sT[t4] = (f32x4){0.f, 0.f, 0.f, 0.f};
#pragma unroll
                for (int kb = 0; kb < 4; ++kb) sT[t4] = mfma32(kf[4 * t4 + kb], qf[kb], sT[t4]); }
        }
        __builtin_amdgcn_sched_barrier(0);
        bf16x8 vf[16];
#pragma unroll
        for (int dt = 0; dt < 8; ++dt) { vf[2 * dt] = frag_perm(VL + (16 * dt + fr) * 72, 4 * g); vf[2 * dt + 1] = frag_perm(VL + (16 * dt + fr) * 72, 32 + 4 * g); }
        __builtin_amdgcn_sched_barrier(0);
        const int k0 = kt * 64; float mx = -1e30f;
        const float NEG = -__builtin_huge_valf();
#pragma unroll
        for (int t4 = 0; t4 < 4; ++t4)
#pragma unroll
            for (int r = 0; r < 4; ++r) { const int nk = k0 + 16 * t4 + 4 * g + r; bool v;
                if (MODE == 0) v = (nk <= nq) && (nq - nk <= 128);
                else v = ((k0 >> 8) == (q0 >> 8)) ? (nk <= nq) : (((selmask >> (k0 >> 8)) & 1u) != 0u);
                sT[t4][r] = v ? sT[t4][r] : NEG; mx = fmaxf(mx, sT[t4][r]); }
        mx = fmaxf(mx, xor16_f(mx)); mx = xor32_max(mx);
        const float mnew = fmaxf(mrun, mx), alpha = exp2f(mrun - mnew); mrun = mnew;
        float ps = 0.f;
#pragma unroll
        for (int t4 = 0; t4 < 4; ++t4)
#pragma unroll
            for (int r = 0; r < 4; ++r) { const float pv = exp2f(sT[t4][r] - mnew); sT[t4][r] = pv; ps += pv; }
        lrun = lrun * alpha + ps;
        const bf16x8 pb0 = pack8(sT[0], sT[1]), pb1 = pack8(sT[2], sT[3]);
#pragma unroll
        for (int dt = 0; dt < 8; ++dt) {
            oacc[dt] = oacc[dt] * alpha;
            oacc[dt] = mfma32(vf[2 * dt], pb0, oacc[dt]);
            oacc[dt] = mfma32(vf[2 * dt + 1], pb1, oacc[dt]);
        }
        if (kt + 1 < ktile_hi) AT_WRITE(F.lds + ((kt + 1 - ktile_lo) & 1) * BUFB);
        __syncthreads();
    }
#undef AT_ISSUE
#undef AT_WRITE
    lrun += xor16_f(lrun); lrun = xor32_sum(lrun);
    const float inv = 1.0f / lrun;
    if (MODE == 0) {
        bf16_t* og = (bf16_t*)(scr + A_OG) + ((size_t)(b * 12 + hd) * 2048 + nq) * 128;
#pragma unroll
        for (int dt = 0; dt < 8; ++dt) { u32x2 w; w.x = pk2(oacc[dt][0] * inv, oacc[dt][1] * inv); w.y = pk2(oacc[dt][2] * inv, oacc[dt][3] * inv); *(u32x2*)(og + 16 * dt + 4 * g) = w; }
        if (g == 0) ((float*)(scr + A_LSE))[(size_t)(b * 12 + hd) * 2048 + nq] = mrun + log2f(lrun);
    } else {
        unsigned char* oc = (opq(p.ws) + WS_OC) + (size_t)(b * SEQ + nq) * 1024 + 512 + (hd - 12) * 128;
        const float inv4 = inv * A_PRE;
#pragma unroll
        for (int dt = 0; dt < 8; ++dt) *(unsigned*)(oc + 16 * dt + 4 * g) = pk4_fp8(oacc[dt][0] * inv4, oacc[dt][1] * inv4, oacc[dt][2] * inv4, oacc[dt][3] * inv4);
    }
}

__device__ __forceinline__ void attn_phase(const Params& p, const Frame& F0) {
    const Frame F = refresh(F0);
    const int i = F.bid & 15, bhm = F.bid >> 4;
    const int nd = (i == 0) ? 7 : (i <= 2) ? 6 : (i <= 4) ? 5 : (i <= 6) ? 4 : (i <= 8) ? 3 : (i <= 10) ? 2 : (i == 11) ? 1 : 0;
    const int st = (i == 0) ? 0 : (i == 1) ? 7 : (i == 2) ? 13 : (i == 3) ? 19 : (i == 4) ? 24 : (i == 5) ? 29 : (i == 6) ? 33 : (i == 7) ? 37 : (i == 8) ? 40 : (i == 9) ? 43 : (i == 10) ? 45 : (i == 11) ? 47 : 48;
    const bool balanced = (F.G == 256);
    for (int k = 0;; ++k) {
        int it;
        if (balanced) { if (k > nd) break; it = (k == 0) ? (bhm * 16 + i) : (256 + bhm * 48 + st + k - 1); }
        else { it = F.bid + k * F.G; if (it >= 1024) break; }
        if (it < 256) { const int qt = it & 15; attn_item<1>(p, F, it >> 6, 12 + ((it >> 4) & 3), qt * 128, 0, 2 * (qt + 1)); }
        else { const int id = it - 256, qt = id & 15, hd = (id >> 4) % 12, b = (id >> 4) / 12, dl = head_dil_log2(hd); const int q0 = qt * 128, first = ((q0 & ((2048 >> dl) - 1)) == 0);
            attn_item<0>(p, F, b, hd, q0, first ? 2 * qt : 2 * qt - 2, 2 * qt + 2); }
    }
}

__device__ __forceinline__ void merge_pass(const Params& p, const Frame& F0) {
    const Frame F = refresh(F0);
    const int gw = F.bid * NWAVES + F.wave, NGW = F.G * NWAVES, hg = F.lane >> 4, d0 = (F.lane & 15) * 8;
    unsigned char* scr = opq(p.ws) + WS_SCR;
    const bf16_t* OG = (const bf16_t*)(scr + A_OG); const float* LSE = (const float*)(scr + A_LSE); bf16_t* OC = (bf16_t*)(opq(p.ws) + WS_OC);
    for (int m = gw; m < T; m += NGW) {
        const int b = m >> 11, s = m & 2047;
        float ls[3]; u32x4 ov[3];
#pragma unroll
        for (int gi = 0; gi < 3; ++gi) { const int hd = 4 * gi + hg; const size_t idx = (size_t)(b * 12 + hd) * 2048 + posp(s, 2 * gi); ls[gi] = LSE[idx]; ov[gi] = *(const u32x4*)(OG + idx * 128 + d0); }
        const float mx = fmaxf(ls[0], fmaxf(ls[1], ls[2]));
        float w[3]; float ws = 0.f;
#pragma unroll
        for (int gi = 0; gi < 3; ++gi) { w[gi] = exp2f(ls[gi] - mx); ws += w[gi]; }
        const float inv = 1.0f / ws;
        float o[8] = {0.f, 0.f, 0.f, 0.f, 0.f, 0.f, 0.f, 0.f};
#pragma unroll
        for (int gi = 0; gi < 3; ++gi) { const float wg = w[gi] * inv;
            o[0] += wg * bflo(ov[gi].x); o[1] += wg * bfhi(ov[gi].x); o[2] += wg * bflo(ov[gi].y); o[3] += wg * bfhi(ov[gi].y);
            o[4] += wg * bflo(ov[gi].z); o[5] += wg * bfhi(ov[gi].z); o[6] += wg * bflo(ov[gi].w); o[7] += wg * bfhi(ov[gi].w); }
        u32x2 wv; wv.x = pk4_fp8(o[0] * A_PRE, o[1] * A_PRE, o[2] * A_PRE, o[3] * A_PRE); wv.y = pk4_fp8(o[4] * A_PRE, o[5] * A_PRE, o[6] * A_PRE, o[7] * A_PRE);
        *(u32x2*)((unsigned char*)OC + (size_t)m * 1024 + hg * 128 + d0) = wv;
    }
}

#define GRID_SYNC() xcd_barrier((unsigned*)(opq(p.ws) + WS_CTL), (volatile LAS unsigned*)(F.lds + LDS_BYTES - 16), F.wave)
#ifndef REPMASK
#define REPMASK 0u
#endif
__device__ __forceinline__ int repn(int k) { int n = 1 + (int)(((REPMASK) >> k) & 1u); asm volatile("" : "+s"(n)); return n; }
#define RP(k) for (int _r = 0, _n = repn(k); _r < _n; ++_r)
__global__ void __launch_bounds__(NTHR, 2) mk_fwd(Params p) {
    extern __shared__ __attribute__((aligned(16))) unsigned char lds_raw[];
    Frame F; F.lds = (LAS unsigned char*)lds_raw; F.tid = 0; F.lane = 0; F.wave = __builtin_amdgcn_readfirstlane(threadIdx.x >> 6); F.G = gridDim.x; F.bid = blockIdx.x;
#define P_WS (opq(p.ws))
#define P_AB ((bf16_t*)(opq(p.ws) + WS_AB))
#define P_R (opq(p.out))
#define P_MIX ((bf16_t*)(opq(p.ws) + WS_MIX))
#define P_HID ((bf16_t*)(opq(p.ws) + WS_HID))
#define P_Y2 ((bf16_t*)(opq(p.ws) + WS_Y2))

    {
        if (threadIdx.x == 0) { volatile LAS unsigned* st = (volatile LAS unsigned*)(F.lds + LDS_BYTES - 16); st[0] = 0u; st[1] = 0u;
            (void)xb_add((unsigned*)(p.ws + WS_CTL) + XB_XCNT(xb_xcc_id()), 1u); }
        __syncthreads();
    }
    RP(0) { convert_set(p, F, 0, F.bid * NWAVES + F.wave, F.G * NWAVES); __syncthreads(); }
    RP(1) { load_w16_lds(F, p.in[I_EV_WIN], EVEN_IN, 4096); __syncthreads(); p0_xpass(p, F); __syncthreads(); }
    GRID_SYNC();

    RP(2) {
        pg8::StaticOrder S; S.init(T, 8192, F.G, F.bid);
        pg8::Gemm g{(const unsigned char*)(P_WS + WS_AB), (const unsigned char*)(P_WS + WS_WIN), 2048, (unsigned)(T * 2048), (unsigned)(8192 * 2048), SC_A16};
        pg8::EpiBf16 E{(bf16_t*)(P_WS + WS_H1), H1LD, (unsigned)(T * 8192 * 2)};
        pg8::gemm_phase(F.lds, F.wave, g, S, E);
    }
    GRID_SYNC();
    RP(3) { p2_pre(p, F); }
    GRID_SYNC();
    RP(4) { if (F.bid < 32) gdn_scan(p, F, F.bid); else if (F.bid < 64) hgrn_scan(p, F, F.bid - 32);
            else if (F.G > 64) convert_set(p, F, 1, (F.bid - 64) * NWAVES + F.wave, (F.G - 64) * NWAVES); }
    if (F.G <= 64) { convert_set(p, F, 1, F.bid * NWAVES + F.wave, F.G * NWAVES); }
    GRID_SYNC();
    RP(5) { p4_gate(p, F); }
    GRID_SYNC();
    RP(6) {
        pg8::StaticOrder S; S.init(T, 2048, F.G, F.bid);
        pg8::Gemm g{(const unsigned char*)(P_WS + WS_OC), (const unsigned char*)(P_WS + WS_WOUT), 2048, (unsigned)(T * 2048), (unsigned)(2048 * 2048), SC_A4};
        pg8::EpiBf16 E{P_MIX, 2048, (unsigned)(T * 2048 * 2)};
        pg8::gemm_phase(F.lds, F.wave, g, S, E);
    }
    GRID_SYNC();
#define MOE_BLOCK(layer, resid, mixp, outfinal, outb2) do { \
        for (int _r = 0, _n = ((layer) == 0 ? repn(7) : 1); _r < _n; ++_r) { load_w16_lds(F, p.in[I_RW], 16, 0); __syncthreads(); \
            ln_pass<true, false, (layer) != 0, true>(p, F, resid, mixp, D, nullptr, p.in[I_LNG] + (size_t)((layer) * 2 + 0) * D, p.in[I_LNB] + (size_t)((layer) * 2 + 0) * D, P_R, P_AB, layer); __syncthreads(); } \
        GRID_SYNC(); \
        const int* list = (const int*)(P_WS + WS_LIST) + (size_t)(layer) * NE * T; \
        const float* gatew = (const float*)(P_WS + WS_GATEW) + (size_t)(layer) * 2 * T; \
        RP(8) { moe_lists(p, F, layer); } \
        GRID_SYNC(); \
        { const Frame Fr = refresh(F); pg8::moe_build_table(F.lds, Fr.tid); } \
        unsigned* tcnt = (unsigned*)(P_WS + WS_CTL) + 3600 + 128 * (layer);        \
        { pg8::MoeOrder<4, false> S; S.init(F.lds, list, F.G, F.bid, 1024, tcnt); \
            pg8::Gemm g{(const unsigned char*)(P_WS + WS_ABS), (const unsigned char*)(P_WS + ((layer) ? WS_WGU1 : WS_WGU)), 2048, (unsigned)(20480 * 2048), (unsigned)(NE * 1024 * 2048), SC_A1}; \
            pg8::EpiGateUpB E{P_HID, list, gatew}; pg8::gemm_phase(F.lds, F.wave, g, S, E); } \
          \
        { pg8::MoeDownS S; S.init(F.lds, tcnt, 2048, F.G, F.bid); \
            pg8::Gemm16 g{P_HID, (const bf16_t*)(P_WS + WS_WD), 512, (unsigned)(20480 * 512 * 2), (unsigned)(NE * 2048 * 512 * 2)}; \
            pg8::EpiDown E{P_Y2, list}; pg8::gemm_phase16(F.lds, F.wave, g, S, E); } \
        GRID_SYNC(); \
        ln_pass<false, true, true, (layer) == 0>(p, F, P_R, P_Y2, D, P_Y2, p.in[I_LNG] + (size_t)((layer) * 2 + 1) * D, p.in[I_LNB] + (size_t)((layer) * 2 + 1) * D, outfinal, outb2, layer); \
    } while (0)
    MOE_BLOCK(0, p.in[I_X], P_MIX, P_R, (bf16_t*)(P_WS + WS_AB8));
    __syncthreads();
    RP(11) { convert_set(p, F, 2, F.bid * NWAVES + F.wave, F.G * NWAVES); __syncthreads(); }
    GRID_SYNC();
    RP(12) {
        pg8::StaticOrder S; S.init(T, 6144, F.G, F.bid);
        pg8::Gemm g{(const unsigned char*)(P_WS + WS_AB8), (const unsigned char*)(P_WS + WS_W3), 2048, (unsigned)(T * 2048), (unsigned)(6144 * 2048), SC_A1};
        pg8::EpiBf16 E{(bf16_t*)(P_WS + WS_H1), H3LD, (unsigned)(T * 6144 * 2)};
        pg8::gemm_phase(F.lds, F.wave, g, S, E);
    }
    GRID_SYNC();
    RP(13) { const Frame Fr = refresh(F); for (int u = Fr.bid; u < 256; u += Fr.G) rope_unit(p, Fr, u); }
    GRID_SYNC();
    RP(14) { attn_phase(p, F); }
    GRID_SYNC();
    RP(15) { merge_pass(p, F); }
    GRID_SYNC();
    RP(16) {
        pg8::StaticOrder S; S.init(T, 2048, F.G, F.bid);
        pg8::Gemm g{(const unsigned char*)(P_WS + WS_OC), (const unsigned char*)(P_WS + WS_WOUT1), 1024, (unsigned)(T * 1024), (unsigned)(2048 * 1024), SC_A4};
        pg8::EpiBf16 E{P_MIX, 2048, (unsigned)(T * 2048 * 2)};
        pg8::gemm_phase(F.lds, F.wave, g, S, E);
    }
    GRID_SYNC();
    MOE_BLOCK(1, P_R, P_MIX, p.out, (bf16_t*)nullptr);
#undef MOE_BLOCK
#undef P_WS
#undef P_AB
#undef P_R
#undef P_MIX
#undef P_HID
#undef P_Y2
}

extern "C" void kernel_launch(void* const* d_in, const int* in_sizes, int n_in, void* d_out, int out_size,
                              void* d_ws, size_t ws_size, hipStream_t stream) {
    static int grid_blocks = 0;
    if (!grid_blocks) {
        int dev = 0, cus = 0, per_cu = 0;
        (void)hipGetDevice(&dev);
        (void)hipDeviceGetAttribute(&cus, hipDeviceAttributeMultiprocessorCount, dev);
        (void)hipFuncSetAttribute((const void*)mk_fwd, hipFuncAttributeMaxDynamicSharedMemorySize, LDS_BYTES);
        (void)hipOccupancyMaxActiveBlocksPerMultiprocessor(&per_cu, (const void*)mk_fwd, NTHR, LDS_BYTES);
        if (per_cu < 1) fprintf(stderr, "kernel_launch: occupancy query says %d blocks per CU\n", per_cu);
        grid_blocks = cus;
        if (ws_size < WS_END) { fprintf(stderr, "kernel_launch: workspace too small: %zu < %zu\n", ws_size, (size_t)WS_END); grid_blocks = -1; }
        if (n_in != 18) { fprintf(stderr, "kernel_launch: expected 18 inputs, got %d\n", n_in); grid_blocks = -1; }
    }
    if (grid_blocks < 0) return;
    Params p{};
    for (int i = 0; i < 18; ++i) p.in[i] = (const float*)d_in[i];
    p.out = (float*)d_out; p.ws = (unsigned char*)d_ws;
    (void)hipMemsetAsync(d_ws, 0, 16384, stream);
    void* args[] = {&p};
    hipError_t e = hipLaunchCooperativeKernel((void*)mk_fwd, dim3(grid_blocks), dim3(NTHR), args, LDS_BYTES, stream);
    if (e != hipSuccess) fprintf(stderr, "cooperative launch failed: %s (grid %d)\n", hipGetErrorString(e), grid_blocks);
}
```

```cpp
#include <hip/hip_runtime.h>
#include <cstdio>
#include <cstdint>

#define GAS __attribute__((address_space(1)))
#define LAS __attribute__((address_space(3)))
typedef unsigned short bf16_t;
typedef short bf16x8 __attribute__((ext_vector_type(8)));
typedef short bf16x4 __attribute__((ext_vector_type(4)));
typedef float f32x4 __attribute__((ext_vector_type(4)));
typedef float f32x2 __attribute__((ext_vector_type(2)));
typedef unsigned u32x4 __attribute__((ext_vector_type(4)));
typedef unsigned u32x2 __attribute__((ext_vector_type(2)));

constexpr int NB = 4, SEQ = 2048, T = NB * SEQ, D = 2048;
constexpr int EVEN_IN = 8208, ODD_IN = 6144;
constexpr int NE = 16, DEXP = 512;
constexpr float ALPHA = 1.4142135623730951f;
constexpr float LN_EPS = 1e-5f, RMS_EPS = 1e-6f;
constexpr int NWAVES = 8, NTHR = 512;
constexpr int LDS_BYTES = 147456;

constexpr size_t MiB = 1u << 20;
constexpr size_t WS_CTL = 0;
constexpr size_t WS_LIST = 1 * MiB;
constexpr size_t WS_GATEW = 2 * MiB;
constexpr size_t WS_BA = 2 * MiB + 512 * 1024;
constexpr size_t WS_ROPE = 3 * MiB;
constexpr size_t WS_KMEAN = 4 * MiB;
constexpr size_t WS_WREG = 8 * MiB;
constexpr size_t WS_WIN = WS_WREG;
constexpr size_t WS_AB8 = WS_WREG + 16 * MiB;
constexpr size_t WS_WOUT = WS_WREG + 32 * MiB;
constexpr size_t WS_WGU = WS_WREG + 40 * MiB;
constexpr size_t WS_WD = WS_WREG + 104 * MiB;
constexpr size_t WS_AB = WS_WREG + 136 * MiB;
constexpr size_t WS_H1 = WS_AB + 32 * MiB;
constexpr size_t WS_OC = WS_H1 + 128 * MiB;
constexpr size_t WS_MIX = WS_OC + 32 * MiB;
constexpr size_t WS_SCR = WS_MIX + 32 * MiB;
constexpr size_t WS_HID = WS_SCR;
constexpr size_t WS_Y2 = WS_SCR + 20 * MiB;
constexpr size_t WS_ABS = WS_SCR + 84 * MiB;
constexpr size_t WS_END = WS_SCR + 216 * MiB;
static_assert(WS_END == 584 * MiB, "workspace map");

typedef __bf16 bf16v2_t __attribute__((ext_vector_type(2)));
__device__ __forceinline__ unsigned pk2(float lo, float hi) { const f32x2 f = {lo, hi}; return __builtin_bit_cast(unsigned, __builtin_convertvector(f, bf16v2_t)); }
__device__ __forceinline__ unsigned f2bf(float f) { return pk2(f, 0.f) & 0xffffu; }
__device__ __forceinline__ unsigned pk4_fp8(float a, float b, float c, float d) {
    a = fminf(fmaxf(a, -448.f), 448.f); b = fminf(fmaxf(b, -448.f), 448.f); c = fminf(fmaxf(c, -448.f), 448.f); d = fminf(fmaxf(d, -448.f), 448.f);
    int w = 0; w = __builtin_amdgcn_cvt_pk_fp8_f32(a, b, w, false); w = __builtin_amdgcn_cvt_pk_fp8_f32(c, d, w, true); return (unsigned)w;
}
constexpr float W_PRE = 64.f;  constexpr int SC_W = 0x79797979;
constexpr float A_PRE = 4.f;   constexpr int SC_A4 = 0x7d7d7d7d;
constexpr int SC_A1 = 0x7f7f7f7f;
constexpr float X_PRE = 16.f;  constexpr int SC_A16 = 0x7b7b7b7b;
typedef int i32x8 __attribute__((ext_vector_type(8)));
__device__ __forceinline__ float bf2f(unsigned short b) { return __builtin_bit_cast(float, (unsigned)b << 16); }
__device__ __forceinline__ float bflo(unsigned w) { return __builtin_bit_cast(float, w << 16); }
__device__ __forceinline__ float bfhi(unsigned w) { return __builtin_bit_cast(float, w & 0xffff0000u); }
__device__ __forceinline__ unsigned cvt_pk_bf16(float lo, float hi) { return pk2(lo, hi); }
template <int CTRL> __device__ __forceinline__ float dpp_f(float x) { return __builtin_bit_cast(float, __builtin_amdgcn_update_dpp(0, __builtin_bit_cast(int, x), CTRL, 0xf, 0xf, true)); }
__device__ __forceinline__ float xor16_f(float x) { return __builtin_bit_cast(float, __builtin_amdgcn_ds_swizzle(__builtin_bit_cast(int, x), 0x401f)); }
__device__ __forceinline__ float row16_sum(float v) { v += dpp_f<0xB1>(v); v += dpp_f<0x4E>(v); v += dpp_f<0x141>(v); v += dpp_f<0x140>(v); return v; }
__device__ __forceinline__ float xor32_sum(float v) { const int i = __builtin_bit_cast(int, v); const auto r = __builtin_amdgcn_permlane32_swap(i, i, false, false);
    return __builtin_bit_cast(float, (int)r[0]) + __builtin_bit_cast(float, (int)r[1]); }
__device__ __forceinline__ float xor32_max(float v) { const int i = __builtin_bit_cast(int, v); const auto r = __builtin_amdgcn_permlane32_swap(i, i, false, false);
    return fmaxf(__builtin_bit_cast(float, (int)r[0]), __builtin_bit_cast(float, (int)r[1])); }
__device__ __forceinline__ float wave_sum(float v) { v = row16_sum(v); v += xor16_f(v); return xor32_sum(v); }
__device__ __forceinline__ float sigmoidf_(float x) { return __builtin_amdgcn_rcpf(1.0f + __expf(-x)); }
__device__ __forceinline__ float siluf_(float x) { return x * __builtin_amdgcn_rcpf(1.0f + __expf(-x)); }
#define NTL(ptr) __builtin_nontemporal_load(ptr)
#define LDS_WAIT() asm volatile("s_waitcnt lgkmcnt(0)" ::: "memory")
template <class Tp> __device__ __forceinline__ Tp* opq(Tp* x) { asm volatile("" : "+s"(x)); return x; }
template <class Tp> __device__ __forceinline__ Tp* opqg(Tp* x) { GAS Tp* g = (GAS Tp*)x; asm volatile("" : "+s"(g)); return (Tp*)g; }
__device__ __forceinline__ float ld_agent(const float* p) { return __hip_atomic_load(p, __ATOMIC_RELAXED, __HIP_MEMORY_SCOPE_AGENT); }

namespace pg8 {
constexpr int BM = 256, BK = 64, HALF = 128, HTB = HALF * BK * 2, STAGE_BYTES = 8 * HTB, NXCD = 8, WGM = 8;
__device__ __forceinline__ int lds_byte(int r, int c) { const int st = (r >> 4) * 2 + (c >> 5), rr = r & 15, cc = c & 31, ob = rr * 64 + cc * 2; return st * 1024 + (ob ^ (((ob >> 9) & 1) << 5)); }
__device__ __forceinline__ void stage_rc(int b, int& R, int& C) { const int st = b / 1024, sb = b % 1024, swz = sb ^ (((sb >> 9) & 1) << 5); R = (st >> 1) * 16 + swz / 64; C = (st & 1) * 32 + (swz % 64) / 2; }
__device__ __forceinline__ int perm32(int rho) { const int n = rho >> 4, i = rho & 15; return 8 * (i >> 2) + 4 * n + (i & 3); }

struct Unit { int pm, pn, e, cnt, arow0, brow0; };
struct Gemm { const unsigned char* A; const unsigned char* Bt; int K; unsigned abytes, bbytes; int sc_a; };

struct StaticOrder {
    static constexpr bool CONTIG = true;
    int nM, nN, nwg, G, c;
    __device__ void init(int M, int N, int G_, int c_) { nM = M / BM; nN = N / BM; nwg = nM * nN; G = G_; c = c_; }
    __device__ bool next(int i, Unit& u) const {
        const long L = (long)i * G + c; if (L >= nwg) return false;
        int wgid = (int)L; { const int q = nwg / NXCD, r = nwg % NXCD, xcd = wgid % NXCD, off = wgid / NXCD; wgid = (xcd < r ? xcd * (q + 1) : r * (q + 1) + (xcd - r) * q) + off; }
        const int nig = WGM * nN, gid = wgid / nig, fm = gid * WGM, gsz = (nM - fm) < WGM ? (nM - fm) : WGM;
        u.pm = fm + ((wgid % nig) % gsz); u.pn = (wgid % nig) / gsz; u.e = 0; u.cnt = 0; u.arow0 = u.pm * BM; u.brow0 = u.pn * BM; return true;
    }
    __device__ __forceinline__ unsigned arow(const Unit& u, int r) const { return (unsigned)(u.arow0 + r); }
    __device__ __forceinline__ void done(const Unit&, int) const {}
    struct State {};
    __device__ __forceinline__ bool first(State&, Unit& u, int) const { return next(0, u); }
    __device__ __forceinline__ void issue(State&, int, int) const {}
    __device__ __forceinline__ bool fin(State&, int i, Unit& u, int) const { return next(i, u); }
};

constexpr int MOE_TAB_OFF = 131072;
constexpr int MOE_HIST_OFF = 131072 + 3072;
__device__ __forceinline__ void moe_build_table(LAS unsigned char* lds, int tid) {
    LAS int* tab = (LAS int*)(lds + MOE_TAB_OFF);
    const LAS int* cnts = (const LAS int*)(lds + MOE_HIST_OFF) + 16;
    if (tid == 0) {
        int s = 0;
#pragma unroll 1
        for (int e = 0; e < NE; ++e) { const int c = cnts[e]; const int nt = (c + 255) >> 8;
#pragma unroll 1
            for (int k = 0; k < nt; ++k) { tab[4 + 4 * (s + k)] = e; tab[4 + 4 * (s + k) + 1] = k; tab[4 + 4 * (s + k) + 2] = c; }
            s += nt; }
        tab[0] = s;
    }
    __syncthreads();
}
template <int NPN, bool GATHER>
struct MoeOrder {
    static constexpr bool CONTIG = !GATHER;
    const int* list;
    LAS const int* tab; int G, c, brows;
    unsigned* tcnt;
    __device__ void init(LAS unsigned char* lds, const int* list_, int G_, int c_, int brows_, unsigned* tcnt_ = nullptr) { list = list_; G = G_; c = c_; brows = brows_; tab = (LAS const int*)(lds + MOE_TAB_OFF); tcnt = tcnt_; }
    __device__ __forceinline__ void done(const Unit& u, int lane) const {
        if (tcnt) { asm volatile("s_waitcnt vmcnt(0)" ::: "memory"); if (lane == 0) __hip_atomic_fetch_add(tcnt + (u.arow0 >> 8), 1u, __ATOMIC_RELAXED, __HIP_MEMORY_SCOPE_AGENT); }
    }
    __device__ bool next(int i, Unit& u) const {
        int L = i * G + c; const int ntile = __builtin_amdgcn_readfirstlane(tab[0]); if (L >= ntile * NPN) return false;
        if (NPN == 4 && i == 0 && G == 256) L = (c & 7) * 32 + (c >> 3);
        const int tile = L / NPN; u.pn = L % NPN;
        u.e = __builtin_amdgcn_readfirstlane(tab[4 + 4 * tile]); u.pm = __builtin_amdgcn_readfirstlane(tab[4 + 4 * tile + 1]); u.cnt = __builtin_amdgcn_readfirstlane(tab[4 + 4 * tile + 2]);
        u.arow0 = tile * BM; u.brow0 = u.e * brows + u.pn * BM; return true;
    }
    __device__ __forceinline__ unsigned arow(const Unit& u, int r) const {
        if (!GATHER) return (unsigned)(u.arow0 + r);
        int idx = u.pm * BM + r; if (idx >= u.cnt) idx = 0;
        return (unsigned)(list[u.e * T + idx] >> 1);
    }
    struct State {};
    __device__ __forceinline__ bool first(State&, Unit& u, int) const { return next(0, u); }
    __device__ __forceinline__ void issue(State&, int, int) const {}
    __device__ __forceinline__ bool fin(State&, int i, Unit& u, int) const { return next(i, u); }
};
constexpr int MOE_Q_OFF = 131072 + 3072 + 512;
struct MoeDownS {
    static constexpr bool CONTIG = true;
    typedef __attribute__((address_space(1))) unsigned gu32;
    LAS const int* tab; LAS unsigned* slot; gu32* tcnt; int brows, G, c, bskew;
    struct State {};
    __device__ void init(LAS unsigned char* lds, unsigned* tcnt_, int brows_, int G_, int c_, int bskew_ = 0) { tab = (LAS const int*)(lds + MOE_TAB_OFF); slot = (LAS unsigned*)(lds + MOE_Q_OFF); tcnt = (gu32*)tcnt_; brows = brows_; G = G_; c = c_; bskew = bskew_; }
    __device__ __forceinline__ unsigned nunits() const { return (unsigned)__builtin_amdgcn_readfirstlane(tab[0]) * 8u; }
    __device__ __forceinline__ unsigned qof(int k) const {
        const int nG = __builtin_amdgcn_readfirstlane(tab[0]) * 4, h = nG % G, nl = G - h;
        return (unsigned)(c >= h ? k * nl + (k >= 3 ? (k - 2) * h : 0) + (c - h) : (k + 3) * nl + k * h + c);
    }
    __device__ __forceinline__ void wait_tile(unsigned q, unsigned cv) const {
        unsigned sp = 0;
        while (cv < 32u) { __builtin_amdgcn_s_sleep(2); if (++sp > (1u << 22)) break; cv = __hip_atomic_load(tcnt + (q >> 3), __ATOMIC_RELAXED, __HIP_MEMORY_SCOPE_AGENT); }
        asm volatile("buffer_inv sc1" ::: "memory");
    }
    __device__ __forceinline__ bool decode(unsigned q, Unit& u) const {
        if (q >= nunits()) return false;
        const int tile = (int)(q >> 3); u.pn = (int)(q & 7u);
        u.e = __builtin_amdgcn_readfirstlane(tab[4 + 4 * tile]); u.pm = __builtin_amdgcn_readfirstlane(tab[4 + 4 * tile + 1]); u.cnt = __builtin_amdgcn_readfirstlane(tab[4 + 4 * tile + 2]);
        u.arow0 = tile * BM; u.brow0 = u.e * brows + u.pn * BM + (u.e >= 8 ? bskew : 0); return true;
    }
    __device__ __forceinline__ bool first(State&, Unit& u, int tid) const {
        const unsigned q = qof(0);
        if (tid == 0 && q < nunits()) wait_tile(q, __hip_atomic_load(tcnt + (q >> 3), __ATOMIC_RELAXED, __HIP_MEMORY_SCOPE_AGENT));
        __syncthreads();
        return decode(q, u);
    }
    __device__ __forceinline__ void issue(State&, int i, int tid) const {
        const unsigned q = qof(i);
        if (tid == 0 && q < nunits()) {
            const __amdgpu_buffer_rsrc_t rc = __builtin_amdgcn_make_buffer_rsrc((void*)tcnt, (short)0, 128 * 4, 0x00020000);
            __builtin_amdgcn_raw_ptr_buffer_load_lds(rc, (LAS void*)slot, 4, (int)((q >> 3) * 4u), 0, 0, 16);
        }
    }
    __device__ __forceinline__ bool fin(State&, int i, Unit& u, int tid) const {
        const unsigned q = qof(i);
        if (tid == 0 && q < nunits()) {
            unsigned cv; asm volatile("ds_read_b32 %0, %1\n\ts_waitcnt lgkmcnt(0)" : "=v"(cv) : "v"((unsigned)(size_t)slot) : "memory");
            wait_tile(q, cv);
        }
        return decode(q, u);
    }
    __device__ __forceinline__ unsigned arow(const Unit& u, int r) const { return (unsigned)(u.arow0 + r); }
    __device__ __forceinline__ void done(const Unit&, int) const {}
};

struct EpiBf16 {
    static constexpr bool PERM = true;
    bf16_t* O; int ldc; unsigned obytes;
    __device__ __forceinline__ void operator()(const f32x4 (&acc)[2][2][4][2], const Unit& u, int wr, int wc, int fr, int fq) const {
        const __amdgpu_buffer_rsrc_t rO = __builtin_amdgcn_make_buffer_rsrc((void*)O, (short)0, (int)obytes, 0x00020000);
        const unsigned voff = (unsigned)((wr * 64 + fr) * ldc + wc * 32 + 8 * fq) * 2u;
        const unsigned sbase = (unsigned)(u.pm * BM * ldc + u.pn * BM) * 2u;
#pragma unroll
        for (int ai = 0; ai < 2; ++ai)
#pragma unroll
            for (int m = 0; m < 4; ++m)
#pragma unroll
                for (int bj = 0; bj < 2; ++bj) { const f32x4 v0 = acc[ai][bj][m][0], v1 = acc[ai][bj][m][1];
                    u32x4 w; w.x = cvt_pk_bf16(v0[0], v0[1]); w.y = cvt_pk_bf16(v0[2], v0[3]); w.z = cvt_pk_bf16(v1[0], v1[1]); w.w = cvt_pk_bf16(v1[2], v1[3]);
                    __builtin_amdgcn_raw_buffer_store_b128(w, rO, (int)voff, (int)(sbase + (unsigned)((ai * HALF + m * 16) * ldc + bj * HALF) * 2u), 0); }
    }
};
struct EpiGateUp {
    static constexpr bool PERM = true;
    unsigned char* HID; const int* list; const float* gatew;
    __device__ __forceinline__ void operator()(const f32x4 (&acc)[2][2][4][2], const Unit& u, int wr, int wc, int fr, int fq) const {
        const int col0 = u.pn * 128 + wc * 32 + 8 * fq;
#pragma unroll
        for (int ai = 0; ai < 2; ++ai)
#pragma unroll
            for (int m = 0; m < 4; ++m) {
                const int r = ai * HALF + wr * 64 + m * 16 + fr; const int idx = u.pm * BM + r;
                float wgt = 0.f; if (idx < u.cnt) wgt = gatew[list[u.e * T + idx]] * A_PRE;
                const f32x4 g0 = acc[ai][0][m][0], g1 = acc[ai][0][m][1], u0 = acc[ai][1][m][0], u1 = acc[ai][1][m][1];
                float h[8];
#pragma unroll
                for (int i = 0; i < 4; ++i) { h[i] = siluf_(g0[i]) * u0[i] * wgt; h[4 + i] = siluf_(g1[i]) * u1[i] * wgt; }
                u32x2 w; w.x = pk4_fp8(h[0], h[1], h[2], h[3]); w.y = pk4_fp8(h[4], h[5], h[6], h[7]);
                *(u32x2*)(HID + (size_t)(u.arow0 + r) * DEXP + col0) = w;
            }
    }
};
struct EpiGateUpB {
    static constexpr bool PERM = true;
    bf16_t* HID; const int* list; const float* gatew;
    __device__ __forceinline__ void operator()(const f32x4 (&acc)[2][2][4][2], const Unit& u, int wr, int wc, int fr, int fq) const {
        const __amdgpu_buffer_rsrc_t rH = __builtin_amdgcn_make_buffer_rsrc((void*)HID, (short)0, 20480 * 512 * 2, 0x00020000);
        const __amdgpu_buffer_rsrc_t rL = __builtin_amdgcn_make_buffer_rsrc((void*)(list + (size_t)u.e * T), (short)0, T * 4, 0x00020000);
        const __amdgpu_buffer_rsrc_t rG = __builtin_amdgcn_make_buffer_rsrc((void*)gatew, (short)0, 2 * T * 4, 0x00020000);
        const unsigned voff = (unsigned)((wr * 64 + fr) * DEXP + u.pn * 128 + wc * 32 + 8 * fq) * 2u;
        const int idx0 = u.pm * BM + wr * 64 + fr;
#pragma unroll
        for (int ai = 0; ai < 2; ++ai)
#pragma unroll
            for (int m = 0; m < 4; ++m) {
                const int idx = idx0 + ai * HALF + m * 16;
                const int ent = __builtin_amdgcn_raw_buffer_load_b32(rL, idx * 4, 0, 0);
                float wgt = __builtin_bit_cast(float, __builtin_amdgcn_raw_buffer_load_b32(rG, (idx < u.cnt ? ent : 0) * 4, 0, 0)); wgt = idx < u.cnt ? wgt : 0.f;
                const f32x4 g0 = acc[ai][0][m][0], g1 = acc[ai][0][m][1], u0 = acc[ai][1][m][0], u1 = acc[ai][1][m][1];
                float h[8];
#pragma unroll
                for (int i = 0; i < 4; ++i) { h[i] = siluf_(g0[i]) * u0[i] * wgt; h[4 + i] = siluf_(g1[i]) * u1[i] * wgt; }
                u32x4 w; w.x = cvt_pk_bf16(h[0], h[1]); w.y = cvt_pk_bf16(h[2], h[3]); w.z = cvt_pk_bf16(h[4], h[5]); w.w = cvt_pk_bf16(h[6], h[7]);
                __builtin_amdgcn_raw_buffer_store_b128(w, rH, (int)voff, (int)((u.arow0 + ai * HALF + m * 16) * DEXP * 2), 16);
            }
    }
};
struct EpiDown {
    static constexpr bool PERM = true;
    bf16_t* Y2; const int* list;
    __device__ __forceinline__ void operator()(const f32x4 (&acc)[2][2][4][2], const Unit& u, int wr, int wc, int fr, int fq) const {
        const int col0 = u.pn * BM + wc * 32 + 8 * fq;
#pragma unroll
        for (int ai = 0; ai < 2; ++ai)
#pragma unroll
            for (int m = 0; m < 4; ++m) {
                const int r = ai * HALF + wr * 64 + m * 16 + fr; const int idx = u.pm * BM + r;
                if (idx < u.cnt) { const int ent = list[u.e * T + idx]; bf16_t* rowp = Y2 + (size_t)ent * D + col0;
#pragma unroll
                    for (int bj = 0; bj < 2; ++bj) { const f32x4 v0 = acc[ai][bj][m][0], v1 = acc[ai][bj][m][1];
                        u32x4 w; w.x = cvt_pk_bf16(v0[0], v0[1]); w.y = cvt_pk_bf16(v0[2], v0[3]); w.z = cvt_pk_bf16(v1[0], v1[1]); w.w = cvt_pk_bf16(v1[2], v1[3]);
                        *(u32x4*)(rowp + bj * HALF) = w; } }
            }
    }
};

constexpr int NXT_OFF = 131072 + 4096;
template <class Epi, class Sched>
__device__ __forceinline__ void gemm_phase(LAS unsigned char* lds, int wave_id, const Gemm g, const Sched& S, const Epi& E) {
    int lane; asm volatile("v_mbcnt_lo_u32_b32 %0, -1, 0\n\tv_mbcnt_hi_u32_b32 %0, -1, %0" : "=v"(lane));
    const int wid = wave_id, tid = wid * 64 + lane, wr = wid >> 2, wc = wid & 3, fr = lane & 15, fq = lane >> 4;
    const int K = g.K, nt = K / 128;
    unsigned voffB[2];
#pragma unroll
    for (int i = 0; i < 2; ++i) { int R, C; stage_rc(tid * 16 + i * 8192, R, C); const int Rb = Epi::PERM ? ((R & ~31) + perm32(R & 31)) : R; voffB[i] = (unsigned)(Rb * K + 2 * C); }
    const unsigned ldsw = (unsigned)wid * 1024u;
    const int aoff = lds_byte(wr * 64 + fr, 16 * (fq & 1)) + (fq >> 1) * 1024, boff = lds_byte(wc * 32 + fr, 16 * (fq & 1)) + (fq >> 1) * 1024;
    LAS unsigned char* ldsB = lds + 4 * HTB + boff;
    LAS unsigned char* ldsA = lds + aoff;
    const int sc_act = g.sc_a;
#define PG8_SA(b, h) (((b) * 2 + (h)) * HTB)
#define PG8_SB(b, h) ((4 + (b) * 2 + (h)) * HTB)
#define PG8_STAGE(bufoff, rsrc, soff, voff) do { _Pragma("unroll") for (int _i = 0; _i < 2; ++_i) \
        __builtin_amdgcn_raw_ptr_buffer_load_lds(rsrc, (LAS void*)(lds + (bufoff) + ldsw + _i * 8192), 16, (int)(voff)[_i], (int)(soff), 0, 0); } while (0)
#define PG8_LD32(dstv, addr) do { const u32x4 _c0 = *(const LAS u32x4*)(lds + (addr)), _c1 = *(const LAS u32x4*)(lds + (addr) + 16); dstv = (i32x8){(int)_c0.x, (int)_c0.y, (int)_c0.z, (int)_c0.w, (int)_c1.x, (int)_c1.y, (int)_c1.z, (int)_c1.w}; } while (0)
#define PG8_LDA(dst, b, h) do { _Pragma("unroll") for (int m = 0; m < 4; ++m) { const u32x4 _c0 = *(const LAS u32x4*)(ldsA + PG8_SA(b, h) + m * 2048), _c1 = *(const LAS u32x4*)(ldsA + PG8_SA(b, h) + m * 2048 + 16); \
        dst[m] = (i32x8){(int)_c0.x, (int)_c0.y, (int)_c0.z, (int)_c0.w, (int)_c1.x, (int)_c1.y, (int)_c1.z, (int)_c1.w}; } } while (0)
#define PG8_LDB(dst, b, h) do { _Pragma("unroll") for (int n = 0; n < 2; ++n) { const u32x4 _c0 = *(const LAS u32x4*)(ldsB + ((b) * 2 + (h)) * HTB + n * 2048), _c1 = *(const LAS u32x4*)(ldsB + ((b) * 2 + (h)) * HTB + n * 2048 + 16); \
        dst[n] = (i32x8){(int)_c0.x, (int)_c0.y, (int)_c0.z, (int)_c0.w, (int)_c1.x, (int)_c1.y, (int)_c1.z, (int)_c1.w}; } } while (0)
#define PG8_MMA(ai, bj, At, Bt) do { __builtin_amdgcn_sched_barrier(0); __builtin_amdgcn_s_setprio(1); _Pragma("unroll") for (int m = 0; m < 4; ++m) _Pragma("unroll") for (int n = 0; n < 2; ++n) \
        acc[ai][bj][m][n] = __builtin_amdgcn_mfma_scale_f32_16x16x128_f8f6f4(Bt[n], At[m], acc[ai][bj][m][n], 0, 0, 0, SC_W, 0, sc_act); \
        _Pragma("unroll") for (int m = 0; m < 4; ++m) asm volatile("" :: "v"(acc[ai][bj][m][0]), "v"(acc[ai][bj][m][1]));     \
        __builtin_amdgcn_s_setprio(0); __builtin_amdgcn_sched_barrier(0); } while (0)
#define PG8_WAIT_V(n) asm volatile("s_waitcnt vmcnt(" #n ")" ::: "memory")
#define PG8_WAIT_L(n) asm volatile("s_waitcnt lgkmcnt(" #n ")" ::: "memory")
#define PG8_BAR __builtin_amdgcn_s_barrier()
#define PG8_SCHED __builtin_amdgcn_sched_barrier(0)
#define PG8_AOFFS(u, o0, o1) do { _Pragma("unroll") for (int _i = 0; _i < 2; ++_i) { int _R, _C; stage_rc(tid * 16 + _i * 8192, _R, _C); \
        o0[_i] = S.arow(u, _R) * (unsigned)K + 2u * (unsigned)_C; o1[_i] = S.arow(u, HALF + _R) * (unsigned)K + 2u * (unsigned)_C; } } while (0)
    Unit cur, nxt; int ui = 0;
    if (!S.next(0, cur)) return;
    f32x4 acc[2][2][4][2];
#pragma unroll
    for (int a = 0; a < 2; ++a)
#pragma unroll
        for (int b = 0; b < 2; ++b)
#pragma unroll
            for (int m = 0; m < 4; ++m)
#pragma unroll
                for (int n = 0; n < 2; ++n) acc[a][b][m][n] = (f32x4){0.f, 0.f, 0.f, 0.f};
    i32x8 At[4], B0[2], B1[2];
    unsigned cA0[2], cA1[2];
    PG8_AOFFS(cur, cA0, cA1);
    const __amdgpu_buffer_rsrc_t rA = __builtin_amdgcn_make_buffer_rsrc((void*)g.A, (short)0, (int)g.abytes, 0x00020000);
    const __amdgpu_buffer_rsrc_t rB = __builtin_amdgcn_make_buffer_rsrc((void*)g.Bt, (short)0, (int)g.bbytes, 0x00020000);
    const unsigned kstep = (unsigned)(BK * 2);
    const unsigned hstep = (unsigned)HALF * (unsigned)K;
    unsigned cB = (unsigned)cur.brow0 * (unsigned)K;
    PG8_STAGE(PG8_SB(0, 0), rB, cB, voffB); PG8_STAGE(PG8_SB(0, 1), rB, cB + hstep, voffB); PG8_STAGE(PG8_SA(0, 0), rA, 0u, cA0); PG8_STAGE(PG8_SA(0, 1), rA, 0u, cA1);
    if (wr == 1) PG8_BAR;
    PG8_WAIT_V(2); PG8_BAR;
    PG8_STAGE(PG8_SB(1, 0), rB, cB + kstep, voffB); PG8_STAGE(PG8_SA(1, 0), rA, kstep, cA0); PG8_STAGE(PG8_SB(1, 1), rB, cB + hstep + kstep, voffB);
    PG8_WAIT_V(6); PG8_BAR;
#define PG8_PAIR(a1, a2, b2, SWITCH) do { \
            PG8_LDB(B0, 0, 0); PG8_LDB(B1, 0, 1); PG8_SCHED; PG8_LDA(At, 0, 0); PG8_STAGE(PG8_SA(1, 1), rA, a1, cA1); \
            SWITCH; \
            PG8_WAIT_V(8); PG8_WAIT_L(0); PG8_BAR; PG8_MMA(0, 0, At, B0); PG8_MMA(0, 1, At, B1); PG8_BAR; PG8_SCHED; \
            PG8_LDA(At, 0, 1); PG8_STAGE(PG8_SB(0, 0), rB, b2, voffB); PG8_STAGE(PG8_SB(0, 1), rB, (b2) + hstep, voffB); PG8_STAGE(PG8_SA(0, 0), rA, a2, cA0); \
            PG8_WAIT_V(8); PG8_WAIT_L(0); PG8_BAR; PG8_MMA(1, 0, At, B0); PG8_MMA(1, 1, At, B1); PG8_BAR; PG8_SCHED; \
            PG8_LDB(B0, 1, 0); PG8_LDB(B1, 1, 1); PG8_SCHED; PG8_LDA(At, 1, 0); PG8_STAGE(PG8_SA(0, 1), rA, a2, cA1); \
            PG8_WAIT_V(8); PG8_WAIT_L(0); PG8_BAR; PG8_MMA(0, 0, At, B0); PG8_MMA(0, 1, At, B1); PG8_BAR; PG8_SCHED; \
            PG8_LDA(At, 1, 1); PG8_STAGE(PG8_SB(1, 0), rB, (b2) + kstep, voffB); PG8_STAGE(PG8_SB(1, 1), rB, (b2) + kstep + hstep, voffB); PG8_STAGE(PG8_SA(1, 0), rA, (a2) + kstep, cA0); \
            PG8_WAIT_V(8); PG8_WAIT_L(0); PG8_BAR; PG8_MMA(1, 0, At, B0); PG8_MMA(1, 1, At, B1); PG8_BAR; PG8_SCHED; } while (0)
    for (;;) {
        const bool has_next = S.next(ui + 1, nxt);
        const unsigned nB = has_next ? (unsigned)nxt.brow0 * (unsigned)K : cB;
        unsigned dlt = 0u;
        if constexpr (Sched::CONTIG) { dlt = has_next ? (unsigned)(nxt.arow0 - cur.arow0) * (unsigned)K : 0u; }
        else { unsigned n0[2], n1[2]; if (has_next) { PG8_AOFFS(nxt, n0, n1); } else { n0[0] = cA0[0]; n0[1] = cA0[1]; n1[0] = cA1[0]; n1[1] = cA1[1]; }
          *((LAS u32x4*)(lds + NXT_OFF) + tid) = (u32x4){n0[0], n0[1], n1[0], n1[1]}; }
        for (int t = 0; t < nt - 2; t += 2) {
            const unsigned a1 = (unsigned)(t + 1) * kstep, a2 = (unsigned)(t + 2) * kstep, b2 = cB + (unsigned)(t + 2) * kstep;
            PG8_PAIR(a1, a2, b2, (void)0);
        }
        {
            const unsigned a1 = (unsigned)(nt - 1) * kstep;
            PG8_PAIR(a1, 0u, nB, do { if constexpr (Sched::CONTIG) { cA0[0] += dlt; cA0[1] += dlt; cA1[0] += dlt; cA1[1] += dlt; } else { const u32x4 _n = *((LAS u32x4*)(lds + NXT_OFF) + tid); cA0[0] = _n.x; cA0[1] = _n.y; cA1[0] = _n.z; cA1[1] = _n.w; } } while (0));
        }
        { int l2; asm volatile("v_mbcnt_lo_u32_b32 %0, -1, 0\n\tv_mbcnt_hi_u32_b32 %0, -1, %0" : "=v"(l2));
          E(acc, cur, wr, wc, l2 & 15, l2 >> 4); S.done(cur, l2); }
        if (!has_next) break;
#pragma unroll
        for (int a = 0; a < 2; ++a)
#pragma unroll
            for (int b = 0; b < 2; ++b)
#pragma unroll
                for (int m = 0; m < 4; ++m)
#pragma unroll
                    for (int n = 0; n < 2; ++n) acc[a][b][m][n] = (f32x4){0.f, 0.f, 0.f, 0.f};
        cur = nxt; cB = nB; ++ui;
    }
    PG8_WAIT_V(0);
    if (wr == 0) PG8_BAR;
    PG8_BAR;
#undef PG8_PAIR
#undef PG8_AOFFS
#undef PG8_SA
#undef PG8_SB
#undef PG8_STAGE
#undef PG8_LDA
#undef PG8_LDB
#undef PG8_MMA
#undef PG8_WAIT_V
#undef PG8_WAIT_L
#undef PG8_BAR
#undef PG8_SCHED
}
struct Gemm16 { const bf16_t* A; const bf16_t* Bt; int K; unsigned abytes, bbytes; };
struct EpiGateUp16 {
    static constexpr bool PERM = true;
    bf16_t* HID; const int* list; const float* gatew;
    __device__ __forceinline__ void operator()(const f32x4 (&acc)[2][2][4][2], const Unit& u, int wr, int wc, int fr, int fq) const {
        const int col0 = u.pn * 128 + wc * 32 + 8 * fq;
#pragma unroll
        for (int ai = 0; ai < 2; ++ai)
#pragma unroll
            for (int m = 0; m < 4; ++m) {
                const int r = ai * HALF + wr * 64 + m * 16 + fr; const int idx = u.pm * BM + r;
                float wgt = 0.f; if (idx < u.cnt) wgt = gatew[list[u.e * T + idx]];
                const f32x4 g0 = acc[ai][0][m][0], g1 = acc[ai][0][m][1], u0 = acc[ai][1][m][0], u1 = acc[ai][1][m][1];
                float h[8];
#pragma unroll
                for (int i = 0; i < 4; ++i) { h[i] = siluf_(g0[i]) * u0[i] * wgt; h[4 + i] = siluf_(g1[i]) * u1[i] * wgt; }
                u32x4 w; w.x = cvt_pk_bf16(h[0], h[1]); w.y = cvt_pk_bf16(h[2], h[3]); w.z = cvt_pk_bf16(h[4], h[5]); w.w = cvt_pk_bf16(h[6], h[7]);
                *(u32x4*)(HID + (size_t)(u.arow0 + r) * DEXP + col0) = w;
            }
    }
};
template <class Epi, class Sched>
__device__ __forceinline__ void gemm_phase16(LAS unsigned char* lds, int wave_id, const Gemm16 g, const Sched& S, const Epi& E) {
    int lane; asm volatile("v_mbcnt_lo_u32_b32 %0, -1, 0\n\tv_mbcnt_hi_u32_b32 %0, -1, %0" : "=v"(lane));
    const int wid = wave_id, tid = wid * 64 + lane, wr = wid >> 2, wc = wid & 3, fr = lane & 15, fq = lane >> 4;
    const int K = g.K, nt = K / BK;
    unsigned voffB[2];
#pragma unroll
    for (int i = 0; i < 2; ++i) { int R, C; stage_rc(tid * 16 + i * 8192, R, C); const int Rb = Epi::PERM ? ((R & ~31) + perm32(R & 31)) : R; voffB[i] = (unsigned)(Rb * K + C) * 2u; }
    const unsigned ldsw = (unsigned)wid * 1024u;
    const int aoff = lds_byte(wr * 64 + fr, fq * 8), boff = lds_byte(wc * 32 + fr, fq * 8);
#define PG8_SA(b, h) (((b) * 2 + (h)) * HTB)
#define PG8_SB(b, h) ((4 + (b) * 2 + (h)) * HTB)
#define PG8_STAGE(bufoff, rsrc, soff, voff) do { _Pragma("unroll") for (int _i = 0; _i < 2; ++_i) \
        __builtin_amdgcn_raw_ptr_buffer_load_lds(rsrc, (LAS void*)(lds + (bufoff) + ldsw + _i * 8192), 16, (int)(voff)[_i], (int)(soff), 0, 0); } while (0)
#define PG8_LDA(dst, b, h) do { _Pragma("unroll") for (int m = 0; m < 4; ++m) _Pragma("unroll") for (int k = 0; k < 2; ++k) dst[m][k] = *(const LAS bf16x8*)(lds + PG8_SA(b, h) + aoff + m * 2048 + k * 1024); } while (0)
#define PG8_LDB(dst, b, h) do { _Pragma("unroll") for (int n = 0; n < 2; ++n) _Pragma("unroll") for (int k = 0; k < 2; ++k) dst[n][k] = *(const LAS bf16x8*)(lds + PG8_SB(b, h) + boff + n * 2048 + k * 1024); } while (0)
#define PG8_MMA(ai, bj, At, Bt) do { __builtin_amdgcn_s_setprio(1); _Pragma("unroll") for (int m = 0; m < 4; ++m) _Pragma("unroll") for (int n = 0; n < 2; ++n) _Pragma("unroll") for (int k = 0; k < 2; ++k) \
        acc[ai][bj][m][n] = __builtin_amdgcn_mfma_f32_16x16x32_bf16(Bt[n][k], At[m][k], acc[ai][bj][m][n], 0, 0, 0); __builtin_amdgcn_s_setprio(0); } while (0)
#define PG8_WAIT_V(n) asm volatile("s_waitcnt vmcnt(" #n ")" ::: "memory")
#define PG8_WAIT_L(n) asm volatile("s_waitcnt lgkmcnt(" #n ")" ::: "memory")
#define PG8_BAR __builtin_amdgcn_s_barrier()
#define PG8_SCHED __builtin_amdgcn_sched_barrier(0)
#define PG8_AOFFS(u, o0, o1) do { _Pragma("unroll") for (int _i = 0; _i < 2; ++_i) { int _R, _C; stage_rc(tid * 16 + _i * 8192, _R, _C); \
        o0[_i] = (S.arow(u, _R) * (unsigned)K + (unsigned)_C) * 2u; o1[_i] = (S.arow(u, HALF + _R) * (unsigned)K + (unsigned)_C) * 2u; } } while (0)
    Unit cur, nxt; int ui = 0;
    typename Sched::State st;
    if (!S.first(st, cur, tid)) return;
    f32x4 acc[2][2][4][2];
#pragma unroll
    for (int a = 0; a < 2; ++a)
#pragma unroll
        for (int b = 0; b < 2; ++b)
#pragma unroll
            for (int m = 0; m < 4; ++m)
#pragma unroll
                for (int n = 0; n < 2; ++n) acc[a][b][m][n] = (f32x4){0.f, 0.f, 0.f, 0.f};
    bf16x8 At[4][2], B0[2][2], B1[2][2];
    unsigned cA0[2], cA1[2];
    PG8_AOFFS(cur, cA0, cA1);
    const __amdgpu_buffer_rsrc_t rA = __builtin_amdgcn_make_buffer_rsrc((void*)g.A, (short)0, (int)g.abytes, 0x00020000);
    const __amdgpu_buffer_rsrc_t rB = __builtin_amdgcn_make_buffer_rsrc((void*)g.Bt, (short)0, (int)g.bbytes, 0x00020000);
    const unsigned kstep = (unsigned)(BK * 2);
    const unsigned hstep = (unsigned)HALF * (unsigned)K * 2u;
    unsigned cB = (unsigned)cur.brow0 * (unsigned)K * 2u;
    PG8_STAGE(PG8_SB(0, 0), rB, cB, voffB); PG8_STAGE(PG8_SB(0, 1), rB, cB + hstep, voffB); PG8_STAGE(PG8_SA(0, 0), rA, 0u, cA0); PG8_STAGE(PG8_SA(0, 1), rA, 0u, cA1);
    if (wr == 1) PG8_BAR;
    PG8_WAIT_V(2); PG8_BAR;
    PG8_STAGE(PG8_SB(1, 0), rB, cB + kstep, voffB); PG8_STAGE(PG8_SA(1, 0), rA, kstep, cA0); PG8_STAGE(PG8_SB(1, 1), rB, cB + hstep + kstep, voffB);
    PG8_WAIT_V(6); PG8_BAR;
#define PG8_PAIR(a1, a2, b2, SWITCH) do { \
            PG8_LDB(B0, 0, 0); PG8_LDB(B1, 0, 1); PG8_SCHED; PG8_LDA(At, 0, 0); PG8_STAGE(PG8_SA(1, 1), rA, a1, cA1); \
            SWITCH; \
            PG8_WAIT_V(8); PG8_WAIT_L(0); PG8_BAR; PG8_MMA(0, 0, At, B0); PG8_MMA(0, 1, At, B1); PG8_BAR; PG8_SCHED; \
            PG8_LDA(At, 0, 1); PG8_STAGE(PG8_SB(0, 0), rB, b2, voffB); PG8_STAGE(PG8_SB(0, 1), rB, (b2) + hstep, voffB); PG8_STAGE(PG8_SA(0, 0), rA, a2, cA0); \
            PG8_WAIT_V(8); PG8_WAIT_L(0); PG8_BAR; PG8_MMA(1, 0, At, B0); PG8_MMA(1, 1, At, B1); PG8_BAR; PG8_SCHED; \
            PG8_LDB(B0, 1, 0); PG8_LDB(B1, 1, 1); PG8_SCHED; PG8_LDA(At, 1, 0); PG8_STAGE(PG8_SA(0, 1), rA, a2, cA1); \
            PG8_WAIT_V(8); PG8_WAIT_L(0); PG8_BAR; PG8_MMA(0, 0, At, B0); PG8_MMA(0, 1, At, B1); PG8_BAR; PG8_SCHED; \
            PG8_LDA(At, 1, 1); PG8_STAGE(PG8_SB(1, 0), rB, (b2) + kstep, voffB); PG8_STAGE(PG8_SB(1, 1), rB, (b2) + kstep + hstep, voffB); PG8_STAGE(PG8_SA(1, 0), rA, (a2) + kstep, cA0); \
            PG8_WAIT_V(8); PG8_WAIT_L(0); PG8_BAR; PG8_MMA(1, 0, At, B0); PG8_MMA(1, 1, At, B1); PG8_BAR; PG8_SCHED; } while (0)
    for (;;) {
        S.issue(st, ui + 1, tid);
        for (int t = 0; t < nt - 2; t += 2) {
            const unsigned a1 = (unsigned)(t + 1) * kstep, a2 = (unsigned)(t + 2) * kstep, b2 = cB + (unsigned)(t + 2) * kstep;
            PG8_PAIR(a1, a2, b2, (void)0);
        }
        const bool has_next = S.fin(st, ui + 1, nxt, tid);
        const unsigned nB = has_next ? (unsigned)nxt.brow0 * (unsigned)K * 2u : cB;
        {
            const unsigned a1 = (unsigned)(nt - 1) * kstep;
            PG8_PAIR(a1, 0u, nB, do { if (has_next) { PG8_AOFFS(nxt, cA0, cA1); } } while (0));
        }
        if (wr == 0) PG8_BAR;
        { int l2; asm volatile("v_mbcnt_lo_u32_b32 %0, -1, 0\n\tv_mbcnt_hi_u32_b32 %0, -1, %0" : "=v"(l2));
          E(acc, cur, wr, wc, l2 & 15, l2 >> 4); S.done(cur, l2); }
        if (!has_next) break;
#pragma unroll
        for (int a = 0; a < 2; ++a)
#pragma unroll
            for (int b = 0; b < 2; ++b)
#pragma unroll
                for (int m = 0; m < 4; ++m)
#pragma unroll
                    for (int n = 0; n < 2; ++n) acc[a][b][m][n] = (f32x4){0.f, 0.f, 0.f, 0.f};
        cur = nxt; cB = nB; ++ui;
        if (wr == 1) PG8_BAR;
    }
    PG8_WAIT_V(0);
    PG8_BAR;
#undef PG8_PAIR
#undef PG8_AOFFS
#undef PG8_SA
#undef PG8_SB
#undef PG8_STAGE
#undef PG8_LDA
#undef PG8_LDB
#undef PG8_MMA
#undef PG8_WAIT_V
#undef PG8_WAIT_L
#undef PG8_BAR
#undef PG8_SCHED
}
}

#define XB_TMO      128
#define XB_XCNT(j)  (256  + 64 * (j))
#define XB_XSUB(j)  (1280 + 64 * (j))
#define XB_XGEN(j)  (2304 + 64 * (j))
#define XB_TOP      3328
#define XB_TOPGEN   3392
#define XCD_BAR_WORDS 3456
#define XB_SPIN_CAP (1u << 20)
__device__ __forceinline__ unsigned xb_ld(unsigned* p)              { return __hip_atomic_load(p, __ATOMIC_RELAXED, __HIP_MEMORY_SCOPE_AGENT); }
__device__ __forceinline__ unsigned xb_add(unsigned* p, unsigned v) { return __hip_atomic_fetch_add(p, v, __ATOMIC_RELAXED, __HIP_MEMORY_SCOPE_AGENT); }
__device__ __forceinline__ unsigned xb_xcc_id() { return (unsigned)__builtin_amdgcn_s_getreg((3 << 11) | 20) & 0xFu; }
#define XB_SPIN(cond, bar) do { unsigned _sp = 0; while (cond) { __builtin_amdgcn_s_sleep(1); \
    if ((++_sp & 255u) == 0u) { if (xb_ld(&(bar)[XB_TMO])) break; if (_sp > XB_SPIN_CAP) { atomicAdd(&(bar)[XB_TMO], 1u); break; } } } } while (0)
__device__ __forceinline__ void xcd_barrier_complete(unsigned* bar, unsigned x, unsigned& nloc, unsigned& nx) {
    const unsigned G = gridDim.x;
    unsigned sum, cnt, mine, sp = 0u;
    for (;;) {
        sum = 0u; cnt = 0u; mine = 0u;
#pragma unroll
        for (unsigned j = 0; j < 16; ++j) { const unsigned c = xb_ld(&bar[XB_XCNT(j)]); sum += c; cnt += (c > 0u) ? 1u : 0u; mine = (j == x) ? c : mine; }
        if (sum == G) break;
        __builtin_amdgcn_s_sleep(1);
        if ((++sp & 255u) == 0u) { if (xb_ld(&bar[XB_TMO])) break; if (sp > XB_SPIN_CAP) { atomicAdd(&bar[XB_TMO], 1u); break; } }
    }
    nloc = mine > 0u ? mine : 1u; nx = cnt > 0u ? cnt : 1u;
}
__device__ __forceinline__ void xcd_barrier(unsigned* bar, volatile LAS unsigned* st, int wave) {
    asm volatile("s_waitcnt vmcnt(0) lgkmcnt(0)" ::: "memory");
    __syncthreads();
    int lane; asm volatile("v_mbcnt_lo_u32_b32 %0, -1, 0\n\tv_mbcnt_hi_u32_b32 %0, -1, %0" : "=v"(lane));
    if (wave == 0 && lane == 0) {
        __builtin_amdgcn_s_waitcnt(0);
        const unsigned x = xb_xcc_id();
        unsigned nloc = st[0], nx = st[1];
        if (nloc == 0u) { xcd_barrier_complete(bar, x, nloc, nx); st[0] = nloc; st[1] = nx; }
        const unsigned old = xb_add(&bar[XB_XSUB(x)], 1u);
        const unsigned gen = old / nloc;
        if (old + 1u == (gen + 1u) * nloc) {
            __builtin_amdgcn_fence(__ATOMIC_RELEASE, "agent");
            asm volatile("s_waitcnt vmcnt(0)" ::: "memory");
            const unsigned og = xb_add(&bar[XB_TOP], 1u);
            const unsigned tg = og / nx;
            if (og + 1u == (tg + 1u) * nx) xb_add(&bar[XB_TOPGEN], 1u);
            else XB_SPIN(xb_ld(&bar[XB_TOPGEN]) == tg, bar);
            __builtin_amdgcn_fence(__ATOMIC_ACQUIRE, "agent");
            xb_add(&bar[XB_XGEN(x)], 1u);
            asm volatile("s_waitcnt vmcnt(0)" ::: "memory");
        } else {
            XB_SPIN(xb_ld(&bar[XB_XGEN(x)]) == gen, bar);
            __builtin_amdgcn_fence(__ATOMIC_ACQUIRE, "agent");
            asm volatile("s_waitcnt vmcnt(0)" ::: "memory");
        }
    }
    __syncthreads();
}

struct Params {
    const float* in[18];
    float* out; unsigned char* ws;
};
enum { I_X = 0, I_EV_WIN, I_EV_CONV, I_EV_ALOG, I_EV_DTB, I_EV_GDNN, I_EV_HGRNN, I_LBLOG, I_EV_WOUT, I_OD_WIN, I_OD_WOUT, I_RW, I_RB, I_MG, I_MU, I_MD, I_LNG, I_LNB };

struct Frame {
    LAS unsigned char* lds;
    int tid, lane, wave, G, bid;
};
__device__ __forceinline__ Frame refresh(const Frame& F0) {
    Frame F = F0; int l; asm volatile("v_mbcnt_lo_u32_b32 %0, -1, 0\n\tv_mbcnt_hi_u32_b32 %0, -1, %0" : "=v"(l));
    F.lane = l; F.tid = F0.wave * 64 + l; return F;
}

constexpr size_t WS_W3 = WS_AB + 16 * MiB, WS_WOUT1 = WS_WOUT + 4 * MiB, WS_WGU1 = WS_WGU + 32 * MiB;
struct CDesc { const float* src; unsigned char* dst; int ld, Kd, fp8, nt; };
__device__ __forceinline__ CDesc conv_desc(const Params& p, unsigned char* ws, int kind, int r) {
    CDesc d;
    switch (kind) {
    case 0: { const int kb = 2 * ((r >> 1) / 256) + (r & 1), nb = (r >> 1) % 256, n0 = nb * 32; const int c0 = n0 < 4096 ? n0 : n0 + 16;
        d.src = p.in[I_EV_WIN] + (size_t)(kb * 64) * EVEN_IN + c0; d.ld = EVEN_IN; d.dst = ws + WS_WIN + (size_t)n0 * 2048 + kb * 64; d.Kd = 2048; d.fp8 = 1; break; }
    case 1: { const int kb = 2 * ((r >> 1) / 64) + (r & 1), nb = (r >> 1) % 64; d.src = p.in[I_EV_WOUT] + (size_t)(kb * 64) * 2048 + nb * 32; d.ld = 2048; d.dst = ws + WS_WOUT + (size_t)(nb * 32) * 2048 + kb * 64; d.Kd = 2048; d.fp8 = 1; break; }
    case 2: case 6: { const int layer = kind == 6; const int isup = r >= 8192; if (isup) r -= 8192;
        const int e = r / 512, q = r % 512, kb = 2 * ((q >> 1) / 16) + (q & 1), nb = (q >> 1) % 16, f0 = nb * 32;
        d.src = (isup ? p.in[I_MU] : p.in[I_MG]) + (size_t)(layer * NE + e) * 2048 * 512 + (size_t)(kb * 64) * 512 + f0; d.ld = 512;
        d.dst = ws + (layer ? WS_WGU1 : WS_WGU) + (size_t)e * 1024 * 2048 + (size_t)(256 * (f0 >> 7) + 128 * isup + (f0 & 127)) * 2048 + kb * 64; d.Kd = 2048; d.fp8 = 1; break; }
    case 3: case 7: { const int layer = kind == 7; const int e = r / 512, q = r % 512, kb = 2 * ((q >> 1) / 64) + (q & 1), nb = (q >> 1) % 64;
        d.src = p.in[I_MD] + (size_t)(layer * NE + e) * 512 * 2048 + (size_t)(kb * 64) * 2048 + nb * 32; d.ld = 2048;
        d.dst = ws + ((layer && e < 8) ? WS_WIN : WS_WD) + ((size_t)e * 2048 * 512 + (size_t)(nb * 32) * 512 + kb * 64) * 2; d.Kd = 512; d.fp8 = 0; break; }
    case 4: { const int kb = 2 * ((r >> 1) / 192) + (r & 1), nb = (r >> 1) % 192; d.src = p.in[I_OD_WIN] + (size_t)(kb * 64) * ODD_IN + nb * 32; d.ld = ODD_IN; d.dst = ws + WS_W3 + (size_t)(nb * 32) * 2048 + kb * 64; d.Kd = 2048; d.fp8 = 1; break; }
    default: { const int kb = 2 * ((r >> 1) / 64) + (r & 1), nb = (r >> 1) % 64; d.src = p.in[I_OD_WOUT] + (size_t)(kb * 64) * 2048 + nb * 32; d.ld = 2048; d.dst = ws + WS_WOUT1 + (size_t)(nb * 32) * 1024 + kb * 64; d.Kd = 1024; d.fp8 = 1; break; }
    }
    d.nt = (kind >= 4) ? 1 : 0;
    return d;
}
__device__ __forceinline__ void conv_load(const CDesc& d, int lane, float (&wv)[32]) {
    const float* wp = d.src + (size_t)(lane >> 5) * d.ld + (lane & 31);
#pragma unroll
    for (int i = 0; i < 32; ++i) wv[i] = __builtin_nontemporal_load(wp + (size_t)(2 * i) * d.ld);
}
__device__ __forceinline__ void conv_store(const CDesc& d, int lane, const float (&wv)[32], LAS float* scr) {
#pragma unroll
    for (int i = 0; i < 32; ++i) scr[(2 * i + (lane >> 5)) * 33 + (lane & 31)] = wv[i];
    LDS_WAIT(); asm volatile("" ::: "memory");
    if (d.fp8) {
        const int c = lane & 3;
#pragma unroll
        for (int j = 0; j < 2; ++j) { const int n = (lane >> 2) + 16 * j; const LAS float* sp = scr + (16 * c) * 33 + n;
            u32x4 o;
            o.x = pk4_fp8(sp[0 * 33] * W_PRE, sp[1 * 33] * W_PRE, sp[2 * 33] * W_PRE, sp[3 * 33] * W_PRE);     o.y = pk4_fp8(sp[4 * 33] * W_PRE, sp[5 * 33] * W_PRE, sp[6 * 33] * W_PRE, sp[7 * 33] * W_PRE);
            o.z = pk4_fp8(sp[8 * 33] * W_PRE, sp[9 * 33] * W_PRE, sp[10 * 33] * W_PRE, sp[11 * 33] * W_PRE);   o.w = pk4_fp8(sp[12 * 33] * W_PRE, sp[13 * 33] * W_PRE, sp[14 * 33] * W_PRE, sp[15 * 33] * W_PRE);
            u32x4* dp = (u32x4*)(d.dst + (size_t)n * d.Kd + 16 * c); if (d.nt) __builtin_nontemporal_store(o, dp); else *dp = o; }
    } else {
        const int c = lane & 7;
#pragma unroll
        for (int j = 0; j < 4; ++j) { const int n = (lane >> 3) + 8 * j; const LAS float* sp = scr + (8 * c) * 33 + n;
            u32x4 o; o.x = pk2(sp[0 * 33], sp[1 * 33]); o.y = pk2(sp[2 * 33], sp[3 * 33]); o.z = pk2(sp[4 * 33], sp[5 * 33]); o.w = pk2(sp[6 * 33], sp[7 * 33]);
            u32x4* dp = (u32x4*)(d.dst + ((size_t)n * d.Kd + 8 * c) * 2); if (d.nt) __builtin_nontemporal_store(o, dp); else *dp = o; }
    }
    LDS_WAIT(); asm volatile("" ::: "memory");
}
__device__ __forceinline__ CDesc conv_item(const Params& p, unsigned char* ws, int set, int it) {
    if (set == 0) return it < 8192 ? conv_desc(p, ws, 0, it) : conv_desc(p, ws, 1, it - 8192);
    if (set == 1) { int r = it;
        if (r < 16384) return conv_desc(p, ws, 2, r); r -= 16384;
        if (r < 8192) return conv_desc(p, ws, 3, r); r -= 8192;
        if (r < 6144) return conv_desc(p, ws, 4, r); r -= 6144;
        if (r < 1024) return conv_desc(p, ws, 5, r); r -= 1024;
        if (r < 16384) return conv_desc(p, ws, 6, r); r -= 16384;
        return conv_desc(p, ws, 7, r); }
    return conv_desc(p, ws, 7, 4096 + it);
}
__device__ __forceinline__ void convert_set(const Params& p, const Frame& F0, int set, int w, int nw) {
    const Frame F = refresh(F0);
    LAS float* scr = (LAS float*)(F.lds + F.wave * 16384);
    unsigned char* ws = opq(p.ws);
    const int N = set == 0 ? 8192 + 2048 : set == 1 ? 16384 + 8192 + 6144 + 1024 + 16384 + 4096 : 4096;
    for (int pi = w; 2 * pi < N; pi += nw) {
        const CDesc d0 = conv_item(p, ws, set, 2 * pi), d1 = conv_item(p, ws, set, 2 * pi + 1);
        float v0[32], v1[32];
        conv_load(d0, F.lane, v0); conv_load(d1, F.lane, v1);
        conv_store(d0, F.lane, v0, scr); conv_store(d1, F.lane, v1, scr);
    }
}

__device__ __forceinline__ void load_w16_lds(const Frame& F0, const float* W, int ld, int c0) {
    const Frame F = refresh(F0);
    LAS float* l = (LAS float*)F.lds;
#pragma unroll 4
    for (int it = 0; it < 16; it += 4) {
        f32x4 w[4];
#pragma unroll
        for (int u = 0; u < 4; ++u) { const int i = F.tid + (it + u) * NTHR, k = i >> 2, q = i & 3; w[u] = *(const f32x4*)(W + (size_t)k * ld + c0 + 4 * q); }
#pragma unroll
        for (int u = 0; u < 4; ++u) { const int i = F.tid + (it + u) * NTHR, k = i >> 2, q = i & 3;
            l[(4 * q + 0) * 2048 + k] = w[u].x; l[(4 * q + 1) * 2048 + k] = w[u].y; l[(4 * q + 2) * 2048 + k] = w[u].z; l[(4 * q + 3) * 2048 + k] = w[u].w; }
    }
}
__device__ __forceinline__ float dot16(const Frame& F, const f32x4 (&v)[8]) {
    const LAS f32x4* l = (const LAS f32x4*)F.lds;
    float res = 0.f;
#pragma unroll 1
    for (int e = 0; e < 16; ++e) { float s = 0.f; f32x2 a2 = (f32x2){0.f, 0.f};
#pragma unroll
        for (int j = 0; j < 8; ++j) { const f32x4 w = l[e * 512 + 64 * j + F.lane]; a2 = __builtin_elementwise_fma(v[j].xy, w.xy, a2); a2 = __builtin_elementwise_fma(v[j].zw, w.zw, a2); }
        s = wave_sum(a2.x + a2.y); res = (F.lane == e) ? s : res; }
    return res;
}
__device__ __forceinline__ void dot16x2(const Frame& F, const f32x4 (&va)[8], const f32x4 (&vb)[8], float& ra, float& rb) {
    const LAS f32x4* l = (const LAS f32x4*)F.lds;
    ra = 0.f; rb = 0.f;
#pragma unroll 1
    for (int e = 0; e < 16; ++e) { f32x2 aa = (f32x2){0.f, 0.f}, ab = (f32x2){0.f, 0.f};
#pragma unroll
        for (int j = 0; j < 8; ++j) { const f32x4 w = l[e * 512 + 64 * j + F.lane];
            aa = __builtin_elementwise_fma(va[j].xy, w.xy, aa); aa = __builtin_elementwise_fma(va[j].zw, w.zw, aa);
            ab = __builtin_elementwise_fma(vb[j].xy, w.xy, ab); ab = __builtin_elementwise_fma(vb[j].zw, w.zw, ab); }
        const float sa = wave_sum(aa.x + aa.y), sb = wave_sum(ab.x + ab.y); ra = (F.lane == e) ? sa : ra; rb = (F.lane == e) ? sb : rb; }
}

__device__ __forceinline__ void p0_xpass(const Params& p, const Frame& F0) {
    const Frame F = refresh(F0);
    const int gw = F.bid * NWAVES + F.wave, NGW = F.G * NWAVES;
    float* BA = (float*)(opq(p.ws) + WS_BA); bf16_t* AB = (bf16_t*)(opq(p.ws) + WS_AB);
    f32x4 vprev[8]; int mprev = 0; bool have_prev = false;
    for (int m = gw; m < T; m += NGW) {
        const f32x4* xr = (const f32x4*)(p.in[I_X] + (size_t)m * D) + F.lane;
        f32x4 v[8];
#pragma unroll
        for (int j = 0; j < 8; ++j) v[j] = __builtin_nontemporal_load(xr + 64 * j);
        unsigned* o = (unsigned*)((unsigned char*)AB + (size_t)m * D) + F.lane;
#pragma unroll
        for (int j = 0; j < 8; ++j) o[64 * j] = pk4_fp8(v[j].x * X_PRE, v[j].y * X_PRE, v[j].z * X_PRE, v[j].w * X_PRE);
        if (!have_prev) {
#pragma unroll
            for (int j = 0; j < 8; ++j) vprev[j] = v[j];
            mprev = m; have_prev = true;
        } else { float a0, a1; dot16x2(F, vprev, v, a0, a1); if (F.lane < 16) { BA[(size_t)mprev * 16 + F.lane] = a0; BA[(size_t)m * 16 + F.lane] = a1; } have_prev = false; }
    }
    if (have_prev) { const float a = dot16(F, vprev); if (F.lane < 16) BA[(size_t)mprev * 16 + F.lane] = a; }
}

constexpr size_t WS_R16A = WS_OC + 16 * MiB, WS_R16B = WS_SCR + 190 * MiB;
__device__ __forceinline__ bf16_t* r16_row(unsigned char* ws, int m) { return (bf16_t*)(ws + (m < T / 2 ? WS_R16A + (size_t)m * D * 2 : WS_R16B + (size_t)(m - T / 2) * D * 2)); }
template <bool ROUTE, bool TWO, bool RES16, bool OUT16>
__device__ __forceinline__ void ln_pass(const Params& p, const Frame& F0, const float* resid, const bf16_t* add1, int ld1, const bf16_t* add2, const float* gain, const float* bias,
                                        float* outf, bf16_t* outb, int layer) {
    const Frame F = refresh(F0);
    const int TPB = (T + F.G - 1) / F.G;
    const int mbeg = ROUTE ? F.bid * TPB + F.wave : F.bid * NWAVES + F.wave, mend = ROUTE ? min(T, (F.bid + 1) * TPB) : T, mstep = ROUTE ? NWAVES : F.G * NWAVES;
    int* SEL = (int*)(opq(p.ws) + WS_CTL + 65536);
    int* HIST = (int*)(opq(p.ws) + WS_CTL + 32768);
    LAS int* lhist = (LAS int*)(F.lds + pg8::MOE_HIST_OFF);
    float* gatew = (float*)(opq(p.ws) + WS_GATEW) + (size_t)layer * 2 * T;
    if (ROUTE) { if (F.tid < NE) lhist[F.tid] = 0; __syncthreads(); }
    f32x4 gn[8], bs[8];
#pragma unroll
    for (int j = 0; j < 8; ++j) { gn[j] = ((const f32x4*)gain)[64 * j + F.lane]; bs[j] = ((const f32x4*)bias)[64 * j + F.lane]; }
    f32x4 nxf[8]; u32x2 nx16[8], na1[8], na2[8];
    const GAS float* residg = (const GAS float*)resid; const GAS bf16_t* add1g = (const GAS bf16_t*)add1; const GAS bf16_t* add2g = (const GAS bf16_t*)add2;
#define LN_LOAD(mm) do { const GAS f32x4* xr = (const GAS f32x4*)(residg + (size_t)(mm) * D) + F.lane; const GAS u32x2* xr16 = (const GAS u32x2*)r16_row(opqg(p.ws), (mm)) + F.lane; \
        _Pragma("unroll") for (int j = 0; j < 8; ++j) { \
            if (RES16) nx16[j] = __builtin_nontemporal_load(xr16 + 64 * j); else nxf[j] = __builtin_nontemporal_load(xr + 64 * j); \
              \
            if (add1) na1[j] = __builtin_nontemporal_load((const GAS u32x2*)(add1g + (size_t)(TWO ? 2 * (mm) : (mm)) * ld1) + 64 * j + F.lane); \
            if (TWO) na2[j] = __builtin_nontemporal_load((const GAS u32x2*)(add2g + (size_t)(2 * (mm) + 1) * ld1) + 64 * j + F.lane); } } while (0)
#define LN_ROUTE(mr_, lg_) do { \
            const float scl = 1.0f / (1.0f + expf(-(lg_))), bil = scl + p.in[I_RB][F.lane & 15]; \
            float sc[16], bi[16];        \
            _Pragma("unroll") for (int e = 0; e < 16; ++e) { sc[e] = __builtin_bit_cast(float, __builtin_amdgcn_readlane(__builtin_bit_cast(int, scl), e)); bi[e] = __builtin_bit_cast(float, __builtin_amdgcn_readlane(__builtin_bit_cast(int, bil), e)); \
                asm volatile("" : "+v"(sc[e]), "+v"(bi[e])); } \
              \
            int bg = 0; float bgs = -3.0e38f; \
            _Pragma("unroll") for (int g = 0; g < 4; ++g) { \
                const float a_ = fmaxf(bi[4 * g], bi[4 * g + 1]), b_ = fminf(bi[4 * g], bi[4 * g + 1]), c_ = fmaxf(bi[4 * g + 2], bi[4 * g + 3]), d_ = fminf(bi[4 * g + 2], bi[4 * g + 3]); \
                const float gs = fmaxf(a_, c_) + fmaxf(fminf(a_, c_), fmaxf(b_, d_)); \
                const bool up = gs > bgs; bgs = up ? gs : bgs; bg = up ? g : bg; } \
              \
            int i1 = 0, i2 = 0; float b1 = -3.0e38f, b2 = -3.0e38f, s1 = 0.f, s2v = 0.f; \
            _Pragma("unroll") for (int k = 0; k < 4; ++k) { \
                const float x = bg == 0 ? bi[k] : bg == 1 ? bi[4 + k] : bg == 2 ? bi[8 + k] : bi[12 + k]; \
                const float y = bg == 0 ? sc[k] : bg == 1 ? sc[4 + k] : bg == 2 ? sc[8 + k] : sc[12 + k]; \
                const int e = 4 * bg + k; \
                const bool c1 = x > b1, c2 = !c1 && (x > b2); \
                b2 = c1 ? b1 : (c2 ? x : b2); i2 = c1 ? i1 : (c2 ? e : i2); s2v = c1 ? s1 : (c2 ? y : s2v); \
                b1 = c1 ? x : b1; i1 = c1 ? e : i1; s1 = c1 ? y : s1; } \
            if (F.lane == 0) { \
                const float den = s1 + s2v; \
                SEL[(mr_)] = i1 | (i2 << 8); gatew[2 * (mr_)] = s1 / den; gatew[2 * (mr_) + 1] = s2v / den; \
                __hip_atomic_fetch_add(lhist + i1, 1, __ATOMIC_RELAXED, __HIP_MEMORY_SCOPE_WORKGROUP); __hip_atomic_fetch_add(lhist + i2, 1, __ATOMIC_RELAXED, __HIP_MEMORY_SCOPE_WORKGROUP); \
            } \
        } while (0)
    f32x4 vprev[8]; int mprev = 0; bool have_prev = false;
    if (mbeg < mend) LN_LOAD(mbeg);
    for (int m = mbeg; m < mend; m += mstep) {
        f32x4 v[8]; float s = 0.f;
#pragma unroll
        for (int j = 0; j < 8; ++j) {
            if (RES16) { const u32x2 a = nx16[j]; v[j] = (f32x4){bflo(a.x), bfhi(a.x), bflo(a.y), bfhi(a.y)} * ALPHA; }
            else v[j] = nxf[j] * ALPHA;
            if (add1) { const u32x2 a = na1[j]; v[j].x += bflo(a.x); v[j].y += bfhi(a.x); v[j].z += bflo(a.y); v[j].w += bfhi(a.y); }
            if (TWO) { const u32x2 a = na2[j]; v[j].x += bflo(a.x); v[j].y += bfhi(a.x); v[j].z += bflo(a.y); v[j].w += bfhi(a.y); }
#ifdef DBG_SANITIZE
            if (!(fabsf(v[j].x) < 1e30f)) v[j].x = 0.f; if (!(fabsf(v[j].y) < 1e30f)) v[j].y = 0.f; if (!(fabsf(v[j].z) < 1e30f)) v[j].z = 0.f; if (!(fabsf(v[j].w) < 1e30f)) v[j].w = 0.f;
#endif
            s += (v[j].x + v[j].y) + (v[j].z + v[j].w);
        }
        if (m + mstep < mend) LN_LOAD(m + mstep);
        const float mean = wave_sum(s) * (1.f / D); float s2 = 0.f;
#pragma unroll
        for (int j = 0; j < 8; ++j) { v[j] = v[j] - mean; s2 += (v[j].x * v[j].x + v[j].y * v[j].y) + (v[j].z * v[j].z + v[j].w * v[j].w); }
        const float rstd = 1.f / sqrtf(wave_sum(s2) * (1.f / D) + LN_EPS);
#pragma unroll
        for (int j = 0; j < 8; ++j) v[j] = v[j] * rstd * gn[j] + bs[j];
        if (OUT16) { u32x2* of = (u32x2*)r16_row(opq(p.ws), m) + F.lane;
#pragma unroll
            for (int j = 0; j < 8; ++j) { u32x2 w; w.x = pk2(v[j].x, v[j].y); w.y = pk2(v[j].z, v[j].w); __builtin_nontemporal_store(w, of + 64 * j); } }
        else { f32x4* of = (f32x4*)(outf + (size_t)m * D) + F.lane;
#pragma unroll
            for (int j = 0; j < 8; ++j) __builtin_nontemporal_store(v[j], of + 64 * j); }
        if (outb) {
            { unsigned* o = (unsigned*)((unsigned char*)outb + (size_t)m * D) + F.lane;
#pragma unroll
                for (int j = 0; j < 8; ++j) o[64 * j] = pk4_fp8(v[j].x, v[j].y, v[j].z, v[j].w); } }
        if (ROUTE) {
            if (!have_prev) {
#pragma unroll
                for (int j = 0; j < 8; ++j) vprev[j] = v[j];
                mprev = m; have_prev = true;
            } else { float la_, lb_; dot16x2(F, vprev, v, la_, lb_); LN_ROUTE(mprev, la_); LN_ROUTE(m, lb_); have_prev = false; }
        }
    }
    if (ROUTE && have_prev) { const float la_ = dot16(F, vprev); LN_ROUTE(mprev, la_); }
#undef LN_ROUTE
#undef LN_LOAD
    if (ROUTE) { __syncthreads(); if (F.tid < NE) HIST[F.bid * NE + F.tid] = lhist[F.tid]; }
}

__device__ __forceinline__ void moe_lists(const Params& p, const Frame& F0, int layer) {
    const Frame F = refresh(F0);
    const int* SEL = (const int*)(opq(p.ws) + WS_CTL + 65536);
    const int* HIST = (const int*)(opq(p.ws) + WS_CTL + 32768);
    int* list = (int*)(opq(p.ws) + WS_LIST) + (size_t)layer * NE * T;
    LAS int* ltot = (LAS int*)(F.lds + pg8::MOE_HIST_OFF) + 16;
    LAS int* lbase = (LAS int*)(F.lds + pg8::MOE_HIST_OFF) + 32;
    if (F.tid < NE) { ltot[F.tid] = 0; lbase[F.tid] = 0; }
    __syncthreads();
    { const int e = F.tid & 15, grp = F.tid >> 4; int base = 0, tot = 0;
#pragma unroll 8
      for (int b = grp; b < F.G; b += 32) { const int h = HIST[b * NE + e]; tot += h; if (b < F.bid) base += h; }
      __hip_atomic_fetch_add(ltot + e, tot, __ATOMIC_RELAXED, __HIP_MEMORY_SCOPE_WORKGROUP); __hip_atomic_fetch_add(lbase + e, base, __ATOMIC_RELAXED, __HIP_MEMORY_SCOPE_WORKGROUP); }
    __syncthreads();
    LAS int* ltpre = (LAS int*)(F.lds + pg8::MOE_HIST_OFF) + 48;
    LAS int* lslot = (LAS int*)(F.lds + pg8::MOE_HIST_OFF) + 64;
    if (F.tid == 0) { int sacc = 0;
#pragma unroll 1
        for (int e = 0; e < NE; ++e) { ltpre[e] = sacc; sacc += (ltot[e] + 255) >> 8; } }
    __syncthreads();
    const int TPB = (T + F.G - 1) / F.G, m0 = F.bid * TPB, m1 = min(T, m0 + TPB);
    if (F.wave == 0) {
        for (int q0 = 2 * m0; q0 < 2 * m1; q0 += 64) {
            const int q = q0 + F.lane; const bool ok = q < 2 * m1;
            int e = -1; if (ok) { const int sv = SEL[q >> 1]; e = (q & 1) ? ((sv >> 8) & 255) : (sv & 255); }
            int rank = 0, cntsame = 0;
#pragma unroll 1
            for (int k = 0; k < NE; ++k) { const unsigned long long bal = __ballot(e == k); if (e == k) { rank = __popcll(bal & ((1ull << F.lane) - 1ull)); cntsame = __popcll(bal); } }
            if (ok) { const int pos = lbase[e] + rank; list[e * T + pos] = q; lslot[q - 2 * m0] = 256 * ltpre[e] + pos; }
            __builtin_amdgcn_s_waitcnt(0);
            if (ok && rank == cntsame - 1) lbase[e] += cntsame;
            __builtin_amdgcn_s_waitcnt(0);
        }
    }
    __syncthreads();
    {
        const unsigned char* AB8 = opq(p.ws) + WS_AB; unsigned char* ABS = opq(p.ws) + WS_ABS;
        const int nt_ = m1 - m0;
        for (int t0 = F.wave; t0 < nt_; t0 += 4 * NWAVES) {
            u32x4 r0[4], r1[4];
#pragma unroll
            for (int k = 0; k < 4; ++k) { const int tt = t0 + k * NWAVES; if (tt < nt_) { const u32x4* src = (const u32x4*)(AB8 + (size_t)(m0 + tt) * D) + F.lane; r0[k] = NTL(src); r1[k] = NTL(src + 64); } }
#pragma unroll
            for (int k = 0; k < 4; ++k) { const int tt = t0 + k * NWAVES; if (tt < nt_) {
#pragma unroll
                for (int jj = 0; jj < 2; ++jj) { u32x4* dst = (u32x4*)(ABS + (size_t)lslot[2 * tt + jj] * D) + F.lane; dst[0] = r0[k]; dst[64] = r1[k]; } } }
        }
    }
}

constexpr int H1LD = 8192, C_ZA = 3072, C_QB = 4096, C_FB = 5120, C_IB = 6144, C_GB = 7168;
constexpr size_t G_U0 = 0;
constexpr size_t G_WM = 32 * MiB;
constexpr size_t G_QD = 48 * MiB;
constexpr size_t G_KDT = 64 * MiB;
constexpr size_t G_QK = 80 * MiB;
constexpr size_t G_CD = 88 * MiB;
constexpr size_t H_QD = 89 * MiB;
constexpr size_t H_KI = 105 * MiB;
constexpr size_t H_KDT = 121 * MiB;
constexpr size_t H_IT = 137 * MiB;
constexpr size_t H_CD = 153 * MiB;
constexpr size_t O_A = 155 * MiB;
constexpr size_t O_B = 171 * MiB;
static_assert(O_B + 16 * MiB <= 216 * MiB, "mixer-0 scratch");

__device__ __forceinline__ f32x4 mfma32(bf16x8 a, bf16x8 b, f32x4 c) { return __builtin_amdgcn_mfma_f32_16x16x32_bf16(a, b, c, 0, 0, 0); }
__device__ __forceinline__ f32x4 mfma16(bf16x4 a, bf16x4 b, f32x4 c) { const bf16x8 a8 = {a[0], a[1], a[2], a[3], 0, 0, 0, 0}, b8 = {b[0], b[1], b[2], b[3], 0, 0, 0, 0}; return __builtin_amdgcn_mfma_f32_16x16x32_bf16(a8, b8, c, 0, 0, 0); }
__device__ __forceinline__ bf16x8 pack8(f32x4 lo, f32x4 hi) {
    u32x4 w; w.x = cvt_pk_bf16(lo[0], lo[1]); w.y = cvt_pk_bf16(lo[2], lo[3]); w.z = cvt_pk_bf16(hi[0], hi[1]); w.w = cvt_pk_bf16(hi[2], hi[3]); return __builtin_bit_cast(bf16x8, w);
}
__device__ __forceinline__ bf16x4 pack4(f32x4 v) { u32x2 w; w.x = cvt_pk_bf16(v[0], v[1]); w.y = cvt_pk_bf16(v[2], v[3]); return __builtin_bit_cast(bf16x4, w); }
__device__ __forceinline__ bf16x8 frag_perm(const LAS bf16_t* rowp, int col) {
    const u32x2 lo = *(const LAS u32x2*)(rowp + col), hi = *(const LAS u32x2*)(rowp + col + 16);
    u32x4 w; w.x = lo.x; w.y = lo.y; w.z = hi.x; w.w = hi.y; return __builtin_bit_cast(bf16x8, w);
}

__device__ __forceinline__ void gdn_pre_pair(const Params& p, const Frame& F, int unit0, int unit1) {
    const int hb = F.wave >> 2, w4 = F.wave & 3, t8 = F.tid & 255, lane = F.lane, fr = lane & 15, g = lane >> 4;
    const int unit = hb ? unit1 : unit0;
    const bool active = unit < 1024;
    const int bh = unit >> 5, ci = unit & 31, b = bh >> 3, h = bh & 7;
    const int tok0 = b * SEQ + ci * 64;
    LAS unsigned char* hl = F.lds + hb * 72192;
    LAS bf16_t* Qb = (LAS bf16_t*)(hl);
    LAS bf16_t* Kb = (LAS bf16_t*)(hl + 17408);
    LAS bf16_t* RVt = (LAS bf16_t*)(hl + 34816);
    LAS bf16_t* RKt = (LAS bf16_t*)(hl + 53248);
    LAS float* sc_g = (LAS float*)(hl + 71680);
    LAS float* sc_b = sc_g + 64;
    LAS float* Lm = (LAS float*)(hl);
    LAS bf16_t* Tb = (LAS bf16_t*)(hl + 17408);
    const bf16_t* H1 = (const bf16_t*)(opq(p.ws) + WS_H1);
    const float* BA = (const float*)(opq(p.ws) + WS_BA);
    unsigned char* scr = opq(p.ws) + WS_SCR;
    if (active) {
        if (t8 < 192) {
            const int sec = t8 >> 6, c2 = (t8 & 63) * 2;
            const int col = sec * 1024 + h * 128 + c2;
            const float* cw = p.in[I_EV_CONV] + col;
            const float w0a = cw[0], w0b = cw[1], w1a = cw[3072], w1b = cw[3073], w2a = cw[6144], w2b = cw[6145], w3a = cw[9216], w3b = cw[9217];
            float xa[3], xb[3];
#pragma unroll
            for (int k = 0; k < 3; ++k) { const int s = ci * 64 - 3 + k; unsigned v = 0u; if (s >= 0) v = *(const unsigned*)(H1 + (size_t)(b * SEQ + s) * H1LD + col); xa[k] = bflo(v); xb[k] = bfhi(v); }
            const int secu = __builtin_amdgcn_readfirstlane(sec);
#define GP_LOOP(SECC) do { _Pragma("unroll 1") for (int q2 = 0; q2 < 2; ++q2) { \
                unsigned vv[32]; \
                  \
                if (SECC == 2) { sc_b[32 * q2 + (lane & 31)] = sigmoidf_(BA[(size_t)(tok0 + 32 * q2 + (lane & 31)) * 16 + h]); LDS_WAIT(); } \
                _Pragma("unroll") for (int tl = 0; tl < 32; ++tl) vv[tl] = __builtin_nontemporal_load((const unsigned*)(H1 + (size_t)(tok0 + 32 * q2 + tl) * H1LD + col)); \
                _Pragma("unroll") for (int t2 = 0; t2 < 32; ++t2) { \
                    const int tl = 32 * q2 + t2; \
                    const float x3a = bflo(vv[t2]), x3b = bfhi(vv[t2]); \
                    float ya = w0a * xa[0] + w1a * xa[1] + w2a * xa[2] + w3a * x3a, yb = w0b * xb[0] + w1b * xb[1] + w2b * xb[2] + w3b * x3b; \
                    xa[0] = xa[1]; xa[1] = xa[2]; xa[2] = x3a; xb[0] = xb[1]; xb[1] = xb[2]; xb[2] = x3b; \
                    ya = siluf_(ya); yb = siluf_(yb); \
                    if (SECC == 0) *(LAS unsigned*)(Qb + tl * 136 + c2) = pk2(ya, yb); \
                    else if (SECC == 1) *(LAS unsigned*)(Kb + tl * 136 + c2) = pk2(ya, yb); \
                    else { const float be = sc_b[tl]; RVt[c2 * 72 + tl] = (bf16_t)f2bf(ya * be); RVt[(c2 + 1) * 72 + tl] = (bf16_t)f2bf(yb * be); } \
                } } } while (0)
            if (secu == 0) GP_LOOP(0); else if (secu == 1) GP_LOOP(1); else GP_LOOP(2);
#undef GP_LOOP
        } else {
            const int t = tok0 + lane;
            const float ba = BA[(size_t)t * 16 + h], aa = BA[(size_t)t * 16 + 8 + h];
            const float xx = aa + p.in[I_EV_DTB][h];
            const float sp = xx > 20.f ? xx : __logf(1.f + __expf(xx));
            float gg = -expf(p.in[I_EV_ALOG][h]) * sp;
            gg += dpp_f<0x111>(gg); gg += dpp_f<0x112>(gg); gg += dpp_f<0x114>(gg); gg += dpp_f<0x118>(gg);
            { const float t0 = __builtin_bit_cast(float, __builtin_amdgcn_readlane(__builtin_bit_cast(int, gg), 15)), t1 = __builtin_bit_cast(float, __builtin_amdgcn_readlane(__builtin_bit_cast(int, gg), 31)),
                          t2 = __builtin_bit_cast(float, __builtin_amdgcn_readlane(__builtin_bit_cast(int, gg), 47));
              gg += (lane >= 16 ? t0 : 0.f) + (lane >= 32 ? t1 : 0.f) + (lane >= 48 ? t2 : 0.f); }
            sc_g[lane] = gg; sc_b[lane] = sigmoidf_(ba);
        }
    }
    __syncthreads();
    if (active) {
        bf16_t* QDg = (bf16_t*)(scr + G_QD) + (size_t)unit * 64 * 128;
#pragma unroll 2
        for (int rr = 0; rr < 16; ++rr) {
            const int r = w4 * 16 + rr;
            const unsigned qv = *(const LAS unsigned*)(Qb + r * 136 + 2 * lane), kv = *(const LAS unsigned*)(Kb + r * 136 + 2 * lane);
            const float q0 = bflo(qv), q1 = bfhi(qv), k0 = bflo(kv), k1 = bfhi(kv);
            const float sq = wave_sum(q0 * q0 + q1 * q1), sk = wave_sum(k0 * k0 + k1 * k1);
            const float rq = rsqrtf(sq + RMS_EPS) * 0.08838834764831845f, rk = rsqrtf(sk + RMS_EPS);
            const float gc = sc_g[r], be = sc_b[r], eg = __expf(gc);
            const float qn0 = q0 * rq, qn1 = q1 * rq, kn0 = k0 * rk, kn1 = k1 * rk;
            *(LAS unsigned*)(Qb + r * 136 + 2 * lane) = pk2(qn0, qn1);
            *(LAS unsigned*)(Kb + r * 136 + 2 * lane) = pk2(kn0, kn1);
            RKt[(2 * lane) * 72 + r] = (bf16_t)f2bf(kn0 * be * eg); RKt[(2 * lane + 1) * 72 + r] = (bf16_t)f2bf(kn1 * be * eg);
            *(unsigned*)(QDg + r * 128 + 2 * lane) = pk2(qn0 * eg, qn1 * eg);
        }
    }
    __syncthreads();
    f32x4 kk[4];
    if (active) {
        {
            bf16_t* KDt = (bf16_t*)(scr + G_KDT) + (size_t)unit * 128 * 64;
            const float gl = sc_g[63];
#pragma unroll
            for (int it = 0; it < 4; ++it) { const int idx = t8 + 256 * it, f = idx >> 3, c0 = (idx & 7) * 8;
                float v[8];
#pragma unroll
                for (int i = 0; i < 8; ++i) v[i] = bf2f(Kb[(c0 + i) * 136 + f]) * __expf(gl - sc_g[c0 + i]);
                u32x4 w; w.x = pk2(v[0], v[1]); w.y = pk2(v[2], v[3]); w.z = pk2(v[4], v[5]); w.w = pk2(v[6], v[7]);
                *(u32x4*)(KDt + f * 64 + c0) = w; }
        }
        const int mt = w4;
        bf16_t* QKm = (bf16_t*)(scr + G_QK) + (size_t)unit * 64 * 64;
        bf16x8 a[4];
#pragma unroll
        for (int kb = 0; kb < 4; ++kb) a[kb] = *(const LAS bf16x8*)(Kb + (16 * mt + fr) * 136 + 32 * kb + 8 * g);
#pragma unroll
        for (int nt = 0; nt < 4; ++nt) {
            f32x4 c = (f32x4){0.f, 0.f, 0.f, 0.f}, c2 = (f32x4){0.f, 0.f, 0.f, 0.f};
#pragma unroll
            for (int kb = 0; kb < 4; ++kb) { const bf16x8 bq = *(const LAS bf16x8*)(Qb + (16 * nt + fr) * 136 + 32 * kb + 8 * g), bk = *(const LAS bf16x8*)(Kb + (16 * nt + fr) * 136 + 32 * kb + 8 * g);
                c = mfma32(a[kb], bq, c); c2 = mfma32(a[kb], bk, c2); }
            const int cj = 16 * nt + fr; const float gcol = sc_g[cj];
            {
                float v[4];
#pragma unroll
                for (int r = 0; r < 4; ++r) { const int j = 16 * mt + 4 * g + r; v[r] = (cj >= j) ? __expf(gcol - sc_g[j]) * c[r] : 0.f; }
                u32x2 w; w.x = pk2(v[0], v[1]); w.y = pk2(v[2], v[3]);
                *(u32x2*)(QKm + cj * 64 + 16 * mt + 4 * g) = w;
            }
#pragma unroll
            for (int r = 0; r < 4; ++r) { const int i = 16 * mt + 4 * g + r; kk[nt][r] = (i > cj) ? sc_b[i] * __expf(sc_g[i] - gcol) * c2[r] : 0.f; }
        }
    }
    __syncthreads();
    if (active) {
#pragma unroll
        for (int nt = 0; nt < 4; ++nt)
#pragma unroll
            for (int r = 0; r < 4; ++r) Lm[(16 * w4 + 4 * g + r) * 68 + 16 * nt + fr] = kk[nt][r];
    }
    __syncthreads();
    if (active && w4 == 0) {
        float t[64];
#pragma unroll
        for (int i = 0; i < 64; ++i) t[i] = 0.f;
#pragma unroll
        for (int i = 0; i < 64; ++i) {
            float a0 = (i == lane) ? 1.f : 0.f, a1 = 0.f, a2 = 0.f, a3 = 0.f;
#pragma unroll
            for (int jj = 0; jj < (i + 3) / 4; ++jj) { const f32x4 lv = *(const LAS f32x4*)(Lm + i * 68 + 4 * jj);
                a0 -= lv[0] * t[4 * jj]; a1 -= lv[1] * t[4 * jj + 1]; a2 -= lv[2] * t[4 * jj + 2]; a3 -= lv[3] * t[4 * jj + 3]; }
            t[i] = (a0 + a1) + (a2 + a3);
        }
#pragma unroll
        for (int i = 0; i < 64; ++i) Tb[i * 72 + lane] = (bf16_t)f2bf(t[i]);
    }
    __syncthreads();
    if (active) {
        f32x4* U0f = (f32x4*)(scr + G_U0) + (size_t)unit * 8 * 4 * 64;
        bf16_t* Wm = (bf16_t*)(scr + G_WM) + (size_t)unit * 64 * 128;
#pragma unroll
        for (int hh = 0; hh < 2; ++hh) {
            const int ct = w4 + 4 * hh;
            bf16x8 bv[2], ak[2];
#pragma unroll
            for (int k = 0; k < 2; ++k) { bv[k] = *(const LAS bf16x8*)(RVt + (16 * ct + fr) * 72 + 32 * k + 8 * g); ak[k] = *(const LAS bf16x8*)(RKt + (16 * ct + fr) * 72 + 32 * k + 8 * g); }
#pragma unroll
            for (int mt = 0; mt < 4; ++mt) {
                f32x4 c = (f32x4){0.f, 0.f, 0.f, 0.f}, c2 = (f32x4){0.f, 0.f, 0.f, 0.f};
#pragma unroll
                for (int k = 0; k < 2; ++k) { const bf16x8 tt = *(const LAS bf16x8*)(Tb + (16 * mt + fr) * 72 + 32 * k + 8 * g); c = mfma32(tt, bv[k], c); c2 = mfma32(ak[k], tt, c2); }
                U0f[(ct * 4 + mt) * 64 + lane] = c;
                u32x2 w; w.x = pk2(-c2[0], -c2[1]); w.y = pk2(-c2[2], -c2[3]);
                *(u32x2*)(Wm + (16 * mt + fr) * 128 + 16 * ct + 4 * g) = w;
            }
        }
        if (t8 == 0) ((float*)(scr + G_CD))[unit] = __expf(sc_g[63]);
    }
    __syncthreads();
}

__device__ __forceinline__ void hgrn_pre_load(const Params& p, const Frame& F, int tc, unsigned (&qva)[16], unsigned (&fva)[16], unsigned (&iv)[16]) {
    const int col = 2 * F.tid; const int t0 = tc * 16;
    const bf16_t* H1 = (const bf16_t*)(opq(p.ws) + WS_H1);
#pragma unroll
    for (int c = 0; c < 16; ++c) { const size_t row = (size_t)(t0 + c);
        qva[c] = __builtin_nontemporal_load((const unsigned*)(H1 + row * H1LD + C_QB + col)); fva[c] = __builtin_nontemporal_load((const unsigned*)(H1 + row * H1LD + C_FB + col)); iv[c] = __builtin_nontemporal_load((const unsigned*)(H1 + row * H1LD + C_IB + col)); }
}
__device__ __forceinline__ void hgrn_pre_unit(const Params& p, const Frame& F, int tc, const unsigned (&qva)[16], const unsigned (&fva)[16], const unsigned (&iv)[16]) {
    const int col = 2 * F.tid, h = col >> 7, f = col & 127;
    const float* lbl = p.in[I_LBLOG];
    float lb[2];
#pragma unroll
    for (int k = 0; k < 2; ++k) { const float l0 = lbl[col + k], l1 = lbl[1024 + col + k], l2 = lbl[2048 + col + k]; const float m = fmaxf(l0, fmaxf(l1, l2));
        const float e0 = __expf(l0 - m), e1 = __expf(l1 - m), e2 = __expf(l2 - m); lb[k] = e0 / (e0 + e1 + e2); }
    const int t0 = tc * 16, b = t0 / SEQ, chunk = (t0 % SEQ) >> 4, bh = b * 8 + h;
    const bf16_t* H1 = (const bf16_t*)(opq(p.ws) + WS_H1);
    unsigned char* scr = opq(p.ws) + WS_SCR;
    float ki0[16], ki1[16];
    float P0 = 1.f, P1 = 1.f;
#pragma unroll
    for (int c = 0; c < 16; ++c) {
        const size_t row = (size_t)(t0 + c);
        const unsigned qv = qva[c], fv = fva[c];
        const float f0 = lb[0] + (1.f - lb[0]) * sigmoidf_(bflo(fv)), f1 = lb[1] + (1.f - lb[1]) * sigmoidf_(bfhi(fv));
        P0 *= f0; P1 *= f1;
        ki0[c] = (1.f - f0) * __builtin_amdgcn_rcpf(P0); ki1[c] = (1.f - f1) * __builtin_amdgcn_rcpf(P1);
        *(unsigned*)((bf16_t*)(scr + H_QD) + row * 1024 + col) = pk2(bflo(qv) * P0, bfhi(qv) * P1);
        *(unsigned*)((bf16_t*)(scr + H_KI) + row * 1024 + col) = pk2(ki0[c], ki1[c]);
    }
    unsigned kd0[8], kd1[8], i0[8], i1[8];
#pragma unroll
    for (int c = 0; c < 16; c += 2) {
        kd0[c >> 1] = pk2(ki0[c] * P0, ki0[c + 1] * P0);
        kd1[c >> 1] = pk2(ki1[c] * P1, ki1[c + 1] * P1);
        i0[c >> 1] = (iv[c] & 0xffffu) | (iv[c + 1] << 16);
        i1[c >> 1] = (iv[c] >> 16) | (iv[c + 1] & 0xffff0000u);
    }
    const size_t base = ((size_t)(bh * 128 + chunk) * 128 + f) * 16;
    u32x4* kd = (u32x4*)((bf16_t*)(scr + H_KDT) + base); u32x4* it = (u32x4*)((bf16_t*)(scr + H_IT) + base);
    kd[0] = (u32x4){kd0[0], kd0[1], kd0[2], kd0[3]}; kd[1] = (u32x4){kd0[4], kd0[5], kd0[6], kd0[7]};
    kd[2] = (u32x4){kd1[0], kd1[1], kd1[2], kd1[3]}; kd[3] = (u32x4){kd1[4], kd1[5], kd1[6], kd1[7]};
    it[0] = (u32x4){i0[0], i0[1], i0[2], i0[3]}; it[1] = (u32x4){i0[4], i0[5], i0[6], i0[7]};
    it[2] = (u32x4){i1[0], i1[1], i1[2], i1[3]}; it[3] = (u32x4){i1[4], i1[5], i1[6], i1[7]};
    *(f32x2*)((float*)(scr + H_CD) + (size_t)(bh * 128 + chunk) * 128 + f) = (f32x2){P0, P1};
}

__device__ __forceinline__ void p2_pre(const Params& p, const Frame& F0) {
    const Frame F = refresh(F0);
    for (int u = F.bid; u < 1024; u += 2 * F.G) gdn_pre_pair(p, F, u, u + F.G);
    {
        const Frame H = refresh(F0);
        unsigned qa[16], fa[16], ia[16], qb[16], fb[16], ib[16];
        int u = H.bid; if (u < 512) hgrn_pre_load(p, H, u, qa, fa, ia);
        for (; u < 512; u += 2 * H.G) {
            const int u2 = u + H.G; if (u2 < 512) hgrn_pre_load(p, H, u2, qb, fb, ib);
            hgrn_pre_unit(p, H, u, qa, fa, ia);
            if (u2 < 512) { if (u2 + H.G < 512) hgrn_pre_load(p, H, u2 + H.G, qa, fa, ia); hgrn_pre_unit(p, H, u2, qb, fb, ib); }
        }
    }
}

__device__ __forceinline__ void gdn_scan(const Params& p, const Frame& F0, int bh) {
    const Frame F = refresh(F0);
    const int lane = F.lane, fr = lane & 15, g = lane >> 4, wave = F.wave, b = bh >> 3, h = bh & 7;
    unsigned char* scr = opqg(p.ws) + WS_SCR;
    constexpr int BUFB = 62464, OFF_QD = 17408, OFF_KDT = 34816, OFF_QK = 53248;
    const bf16_t* gWM = (const bf16_t*)(scr + G_WM); const bf16_t* gQD = (const bf16_t*)(scr + G_QD);
    const bf16_t* gKDT = (const bf16_t*)(scr + G_KDT); const bf16_t* gQK = (const bf16_t*)(scr + G_QK);
    const f32x4* gU0 = (const f32x4*)(scr + G_U0); const float* gCD = (const float*)(scr + G_CD);
    bf16_t* OA = (bf16_t*)(scr + O_A);
    u32x4 rw[2], rq[2], rk[2], rqk; f32x4 u0c[4], u0n[4];
#define GS_ISSUE(u) do { _Pragma("unroll") for (int i = 0; i < 2; ++i) { const int idx = F.tid + 512 * i; \
        rw[i] = NTL((const u32x4*)(gWM + (size_t)(u) * 8192 + idx * 8)); rq[i] = NTL((const u32x4*)(gQD + (size_t)(u) * 8192 + idx * 8)); rk[i] = NTL((const u32x4*)(gKDT + (size_t)(u) * 8192 + idx * 8)); } \
        rqk = NTL((const u32x4*)(gQK + (size_t)(u) * 4096 + F.tid * 8)); \
        _Pragma("unroll") for (int mt = 0; mt < 4; ++mt) u0n[mt] = NTL(gU0 + (((size_t)(u) * 8 + wave) * 4 + mt) * 64 + lane); } while (0)
#define GS_WRITE(bufp) do { _Pragma("unroll") for (int i = 0; i < 2; ++i) { const int idx = F.tid + 512 * i; \
        *(LAS u32x4*)((bufp) + ((idx >> 4) * 136 + (idx & 15) * 8) * 2) = rw[i]; *(LAS u32x4*)((bufp) + OFF_QD + ((idx >> 4) * 136 + (idx & 15) * 8) * 2) = rq[i]; \
        *(LAS u32x4*)((bufp) + OFF_KDT + ((idx >> 3) * 72 + (idx & 7) * 8) * 2) = rk[i]; } \
        *(LAS u32x4*)((bufp) + OFF_QK + ((F.tid >> 3) * 72 + (F.tid & 7) * 8) * 2) = rqk; } while (0)
    f32x4 Sacc[8];
#pragma unroll
    for (int ft = 0; ft < 8; ++ft) Sacc[ft] = (f32x4){0.f, 0.f, 0.f, 0.f};
    GS_ISSUE(bh * 32);
    GS_WRITE(F.lds);
#pragma unroll
    for (int mt = 0; mt < 4; ++mt) u0c[mt] = u0n[mt];
    __syncthreads();
    float dec = ld_agent(gCD + bh * 32);
    for (int ci = 0; ci < 32; ++ci) {
        const int u = bh * 32 + ci;
        LAS unsigned char* buf = F.lds + (ci & 1) * BUFB;
        float decn = dec; if (ci + 1 < 32) decn = ld_agent(gCD + u + 1);
        if (ci + 1 < 32) GS_ISSUE(u + 1);
        const LAS bf16_t* WM = (const LAS bf16_t*)buf; const LAS bf16_t* QD = (const LAS bf16_t*)(buf + OFF_QD);
        const LAS bf16_t* KDT = (const LAS bf16_t*)(buf + OFF_KDT); const LAS bf16_t* QK = (const LAS bf16_t*)(buf + OFF_QK);
        bf16x8 Sbf[4];
#pragma unroll
        for (int kb = 0; kb < 4; ++kb) Sbf[kb] = pack8(Sacc[2 * kb], Sacc[2 * kb + 1]);
        f32x4 uacc[4], oacc[4];
#pragma unroll
        for (int mt = 0; mt < 4; ++mt) { uacc[mt] = u0c[mt]; oacc[mt] = (f32x4){0.f, 0.f, 0.f, 0.f}; }
        bf16x8 fa[8], fb[8];
#define GS_LD_UQ(dst, mt) do { _Pragma("unroll") for (int kb = 0; kb < 4; ++kb) { dst[kb] = frag_perm(WM + (16 * (mt) + fr) * 136, 32 * kb + 4 * g); dst[4 + kb] = frag_perm(QD + (16 * (mt) + fr) * 136, 32 * kb + 4 * g); } } while (0)
#define GS_MM_UQ(src, mt) do { _Pragma("unroll") for (int kb = 0; kb < 4; ++kb) { uacc[mt] = mfma32(src[kb], Sbf[kb], uacc[mt]); oacc[mt] = mfma32(src[4 + kb], Sbf[kb], oacc[mt]); } } while (0)
        GS_LD_UQ(fa, 0);
        GS_LD_UQ(fb, 1); __builtin_amdgcn_sched_barrier(0); GS_MM_UQ(fa, 0); __builtin_amdgcn_sched_barrier(0);
        GS_LD_UQ(fa, 2); __builtin_amdgcn_sched_barrier(0); GS_MM_UQ(fb, 1); __builtin_amdgcn_sched_barrier(0);
        GS_LD_UQ(fb, 3); __builtin_amdgcn_sched_barrier(0); GS_MM_UQ(fa, 2); __builtin_amdgcn_sched_barrier(0);
#pragma unroll
        for (int mt = 0; mt < 4; ++mt)
#pragma unroll
            for (int k = 0; k < 2; ++k) fa[2 * mt + k] = frag_perm(QK + (16 * mt + fr) * 72, 32 * k + 4 * g);
        __builtin_amdgcn_sched_barrier(0); GS_MM_UQ(fb, 3); __builtin_amdgcn_sched_barrier(0);
#undef GS_LD_UQ
#undef GS_MM_UQ
        bf16x8 ubf[2];
#pragma unroll
        for (int k = 0; k < 2; ++k) ubf[k] = pack8(uacc[2 * k], uacc[2 * k + 1]);
#pragma unroll
        for (int ft = 0; ft < 4; ++ft)
#pragma unroll
            for (int k = 0; k < 2; ++k) fb[2 * ft + k] = frag_perm(KDT + (16 * ft + fr) * 72, 32 * k + 4 * g);
        __builtin_amdgcn_sched_barrier(0);
#pragma unroll
        for (int mt = 0; mt < 4; ++mt)
#pragma unroll
            for (int k = 0; k < 2; ++k) oacc[mt] = mfma32(fa[2 * mt + k], ubf[k], oacc[mt]);
        __builtin_amdgcn_sched_barrier(0);
#pragma unroll
        for (int ft = 0; ft < 4; ++ft)
#pragma unroll
            for (int k = 0; k < 2; ++k) fa[2 * ft + k] = frag_perm(KDT + (16 * (4 + ft) + fr) * 72, 32 * k + 4 * g);
        __builtin_amdgcn_sched_barrier(0);
#pragma unroll
        for (int ft = 0; ft < 4; ++ft) {
            Sacc[ft] = Sacc[ft] * dec;
#pragma unroll
            for (int k = 0; k < 2; ++k) Sacc[ft] = mfma32(fb[2 * ft + k], ubf[k], Sacc[ft]);
        }
        __builtin_amdgcn_sched_barrier(0);
#pragma unroll
        for (int ft = 0; ft < 4; ++ft) {
            Sacc[4 + ft] = Sacc[4 + ft] * dec;
#pragma unroll
            for (int k = 0; k < 2; ++k) Sacc[4 + ft] = mfma32(fa[2 * ft + k], ubf[k], Sacc[4 + ft]);
        }
        dec = decn;
        {
            bf16_t* orow = OA + (size_t)(b * SEQ + ci * 64) * 1024 + h * 128 + 16 * wave + fr;
#pragma unroll
            for (int mt = 0; mt < 4; ++mt)
#pragma unroll
                for (int r = 0; r < 4; ++r) orow[(size_t)(16 * mt + 4 * g + r) * 1024] = (bf16_t)f2bf(oacc[mt][r]);
        }
        if (ci + 1 < 32) { GS_WRITE(F.lds + ((ci + 1) & 1) * BUFB);
#pragma unroll
            for (int mt = 0; mt < 4; ++mt) u0c[mt] = u0n[mt]; }
        asm volatile("s_waitcnt lgkmcnt(0)" ::: "memory"); __builtin_amdgcn_s_barrier();
    }
#undef GS_ISSUE
#undef GS_WRITE
}

__device__ __forceinline__ void hgrn_scan(const Params& p, const Frame& F0, int bh) {
    const Frame F = refresh(F0);
    const int lane = F.lane, fr = lane & 15, g = lane >> 4, wave = F.wave, b = bh >> 3, h = bh & 7;
    unsigned char* scr = opqg(p.ws) + WS_SCR;
    constexpr int BUFB = 61440, OFF_KI = 17408, OFF_KDT = 34816, OFF_CD = 59392;
    const bf16_t* gQD = (const bf16_t*)(scr + H_QD); const bf16_t* gKI = (const bf16_t*)(scr + H_KI);
    const bf16_t* gKDT = (const bf16_t*)(scr + H_KDT) + (size_t)bh * 128 * 128 * 16; const bf16_t* gIT = (const bf16_t*)(scr + H_IT) + (size_t)bh * 128 * 128 * 16;
    const float* gCD = (const float*)(scr + H_CD) + (size_t)bh * 128 * 128;
    bf16_t* OB = (bf16_t*)(scr + O_B);
    u32x4 rq[2], rk[2], rd[2], rc; u32x2 itn[4], itc[4];
#define HS_ISSUE(grp) do { _Pragma("unroll") for (int i = 0; i < 2; ++i) { const int idx = F.tid + 512 * i; const size_t go = (size_t)(b * SEQ + (grp) * 64 + (idx >> 4)) * 1024 + h * 128 + (idx & 15) * 8; \
        rq[i] = NTL((const u32x4*)(gQD + go)); rk[i] = NTL((const u32x4*)(gKI + go)); rd[i] = NTL((const u32x4*)(gKDT + (size_t)(grp) * 8192 + idx * 8)); } \
        if (F.tid < 128) rc = NTL((const u32x4*)(gCD + (size_t)(grp) * 512 + F.tid * 4)); \
        _Pragma("unroll") for (int sc = 0; sc < 4; ++sc) itn[sc] = NTL((const u32x2*)(gIT + ((size_t)((grp) * 4 + sc) * 128 + 16 * wave + fr) * 16 + 4 * g)); } while (0)
#define HS_WRITE(bufp) do { _Pragma("unroll") for (int i = 0; i < 2; ++i) { const int idx = F.tid + 512 * i; \
        *(LAS u32x4*)((bufp) + ((idx >> 4) * 136 + (idx & 15) * 8) * 2) = rq[i]; *(LAS u32x4*)((bufp) + OFF_KI + ((idx >> 4) * 136 + (idx & 15) * 8) * 2) = rk[i]; \
        *(LAS u32x4*)((bufp) + OFF_KDT + ((idx >> 1) * 24 + (idx & 1) * 8) * 2) = rd[i]; } \
        if (F.tid < 128) *(LAS u32x4*)((bufp) + OFF_CD + F.tid * 16) = rc; } while (0)
    f32x4 Sacc[8];
#pragma unroll
    for (int ft = 0; ft < 8; ++ft) Sacc[ft] = (f32x4){0.f, 0.f, 0.f, 0.f};
    HS_ISSUE(0);
    HS_WRITE(F.lds);
#pragma unroll
    for (int sc = 0; sc < 4; ++sc) itc[sc] = itn[sc];
    __syncthreads();
    for (int grp = 0; grp < 32; ++grp) {
        LAS unsigned char* buf = F.lds + (grp & 1) * BUFB;
        if (grp + 1 < 32) HS_ISSUE(grp + 1);
        const LAS bf16_t* QD = (const LAS bf16_t*)buf; const LAS bf16_t* KI = (const LAS bf16_t*)(buf + OFF_KI);
        const LAS bf16_t* KDT = (const LAS bf16_t*)(buf + OFF_KDT); const LAS float* CD = (const LAS float*)(buf + OFF_CD);
        bf16x8 qfA[4], kfA[4], qfB[4], kfB[4];
#define HS_LDS(sc, X) do { _Pragma("unroll") for (int kb = 0; kb < 4; ++kb) { qf##X[kb] = frag_perm(QD + (16 * (sc) + fr) * 136, 32 * kb + 4 * g); kf##X[kb] = frag_perm(KI + (16 * (sc) + fr) * 136, 32 * kb + 4 * g); } \
            } while (0)
#define HS_SUB(sc, X) do { \
            f32x4 dd[8]; bf16x4 kd[8];        \
            _Pragma("unroll") for (int ft = 0; ft < 8; ++ft) { dd[ft] = *(const LAS f32x4*)(CD + (sc) * 128 + 16 * ft + 4 * g); kd[ft] = *(const LAS bf16x4*)(KDT + (((sc) * 128) + 16 * ft + fr) * 24 + 4 * g); } \
            bf16x8 Sbf[4]; \
            _Pragma("unroll") for (int kb = 0; kb < 4; ++kb) Sbf[kb] = pack8(Sacc[2 * kb], Sacc[2 * kb + 1]); \
            f32x4 o = (f32x4){0.f, 0.f, 0.f, 0.f}, pT = (f32x4){0.f, 0.f, 0.f, 0.f}; \
            _Pragma("unroll") for (int kb = 0; kb < 4; ++kb) { o = mfma32(qf##X[kb], Sbf[kb], o); pT = mfma32(kf##X[kb], qf##X[kb], pT); } \
            _Pragma("unroll") for (int r = 0; r < 4; ++r) pT[r] = (fr >= 4 * g + r) ? pT[r] : 0.f; \
            const bf16x4 itf = __builtin_bit_cast(bf16x4, itc[sc]); \
            o = mfma16(pack4(pT), itf, o); \
            _Pragma("unroll") for (int ft = 0; ft < 8; ++ft) Sacc[ft] = mfma16(kd[ft], itf, Sacc[ft] * dd[ft]); \
            bf16_t* orow = OB + (size_t)(b * SEQ + grp * 64 + (sc) * 16) * 1024 + h * 128 + 16 * wave + fr; \
            _Pragma("unroll") for (int r = 0; r < 4; ++r) orow[(size_t)(4 * g + r) * 1024] = (bf16_t)f2bf(o[r]); \
        } while (0)
        HS_LDS(0, A); __builtin_amdgcn_sched_barrier(0);
        HS_LDS(1, B); __builtin_amdgcn_sched_barrier(0); HS_SUB(0, A); __builtin_amdgcn_sched_barrier(0);
        HS_LDS(2, A); __builtin_amdgcn_sched_barrier(0); HS_SUB(1, B); __builtin_amdgcn_sched_barrier(0);
        HS_LDS(3, B); __builtin_amdgcn_sched_barrier(0); HS_SUB(2, A); __builtin_amdgcn_sched_barrier(0);
        HS_SUB(3, B);
#undef HS_LDS
#undef HS_SUB
        if (grp + 1 < 32) { HS_WRITE(F.lds + ((grp + 1) & 1) * BUFB);
#pragma unroll
            for (int sc = 0; sc < 4; ++sc) itc[sc] = itn[sc]; }
        asm volatile("s_waitcnt lgkmcnt(0)" ::: "memory"); __builtin_amdgcn_s_barrier();
    }
#undef HS_ISSUE
#undef HS_WRITE
}

__device__ __forceinline__ void p4_gate(const Params& p, const Frame& F0) {
    const Frame F = refresh(F0);
    const int gw = F.bid * NWAVES + F.wave, NGW = F.G * NWAVES, hs = F.lane >> 4, e0 = (F.lane & 15) * 8;
    unsigned char* scr = opq(p.ws) + WS_SCR;
    const bf16_t* H1 = (const bf16_t*)(opq(p.ws) + WS_H1); bf16_t* OC = (bf16_t*)(opq(p.ws) + WS_OC);
    for (int m0 = gw; m0 < T; m0 += 2 * NGW) {
        u32x4 ovv[2][4], zvv[2][4];
#pragma unroll
        for (int q = 0; q < 2; ++q) { const int m = m0 + q * NGW; if (m < T) {
#pragma unroll
            for (int rr = 0; rr < 4; ++rr) { const int hh = rr * 4 + hs; const bool isb = hh >= 8; const int hd = hh & 7;
                ovv[q][rr] = __builtin_nontemporal_load((const u32x4*)((const bf16_t*)(scr + (isb ? O_B : O_A)) + (size_t)m * 1024 + hd * 128 + e0));
                zvv[q][rr] = __builtin_nontemporal_load((const u32x4*)(H1 + (size_t)m * H1LD + (isb ? C_GB : C_ZA) + hd * 128 + e0)); } } }
#pragma unroll
        for (int q = 0; q < 2; ++q) { const int m = m0 + q * NGW; if (m < T) {
#pragma unroll
        for (int rr = 0; rr < 4; ++rr) {
            const int hh = rr * 4 + hs;
            const bool isb = hh >= 8;
            const float* gsrc = (isb ? p.in[I_EV_HGRNN] : p.in[I_EV_GDNN]) + e0;
            const u32x4 ov = ovv[q][rr], zv = zvv[q][rr];
            const f32x4 g0 = *(const f32x4*)gsrc, g1 = *(const f32x4*)(gsrc + 4);
            float x[8] = {bflo(ov.x), bfhi(ov.x), bflo(ov.y), bfhi(ov.y), bflo(ov.z), bfhi(ov.z), bflo(ov.w), bfhi(ov.w)};
            const float z[8] = {bflo(zv.x), bfhi(zv.x), bflo(zv.y), bfhi(zv.y), bflo(zv.z), bfhi(zv.z), bflo(zv.w), bfhi(zv.w)};
            const float gn[8] = {g0[0], g0[1], g0[2], g0[3], g1[0], g1[1], g1[2], g1[3]};
            float ss = 0.f;
#pragma unroll
            for (int i = 0; i < 8; ++i) ss += x[i] * x[i];
            ss = row16_sum(ss);
            const float rinv = rsqrtf(ss * (1.f / 128.f) + RMS_EPS);
#pragma unroll
            for (int i = 0; i < 8; ++i) x[i] = x[i] * rinv * gn[i] * siluf_(z[i]);
            u32x2 w; w.x = pk4_fp8(x[0] * A_PRE, x[1] * A_PRE, x[2] * A_PRE, x[3] * A_PRE); w.y = pk4_fp8(x[4] * A_PRE, x[5] * A_PRE, x[6] * A_PRE, x[7] * A_PRE);
            *(u32x2*)((unsigned char*)OC + (size_t)m * 2048 + hh * 128 + e0) = w;
        } } }
    }
}

constexpr int H3LD = 6144;
constexpr size_t A_QR = 0;
constexpr size_t A_KR = 32 * MiB;
constexpr size_t A_VT = 64 * MiB;
constexpr size_t A_OG = 96 * MiB;
constexpr size_t A_LSE = 120 * MiB;
constexpr size_t A_KPART = 121 * MiB;
constexpr float QSCALE = 0.08838834764831845f * 1.4426950408889634f;
__device__ __forceinline__ int head_dil_log2(int hd) { return hd < 4 ? 0 : hd < 8 ? 2 : hd < 12 ? 4 : 0; }
__device__ __forceinline__ int posp(int s, int dl) { return ((s & ((1 << dl) - 1)) << (11 - dl)) + (s >> dl); }

__device__ __forceinline__ void rope_unit(const Params& p, const Frame& F, int unit) {
    const int hh = unit & 1, st = (unit >> 1) & 31, b = unit >> 6, s0 = st * 64;
    const bf16_t* H3 = (const bf16_t*)(opq(p.ws) + WS_H1);
    unsigned char* scr = opq(p.ws) + WS_SCR;
    bf16_t* QR = (bf16_t*)(scr + A_QR); bf16_t* KR = (bf16_t*)(scr + A_KR); bf16_t* VT = (bf16_t*)(scr + A_VT); float* KPART = (float*)(scr + A_KPART);
    LAS float* KS = (LAS float*)F.lds;
    LAS bf16_t* VL = (LAS bf16_t*)(F.lds + 33280);
    const int tok2 = F.tid >> 4, pj = (F.tid & 15) * 4;
    u32x2 na[2][2], nc[2][2]; u32x4 nv[2];
#define RP_LOAD(hi_) do { const int hd_ = hh * 8 + (hi_); \
        const int qcol_ = hd_ < 12 ? hd_ * 128 : 4608 + (hd_ - 12) * 128, kcol_ = hd_ < 12 ? 1536 + hd_ * 128 : 5120 + (hd_ - 12) * 128, vcol_ = hd_ < 12 ? 3072 + hd_ * 128 : 5632 + (hd_ - 12) * 128; \
        _Pragma("unroll") for (int tt = 0; tt < 2; ++tt) { const size_t row_ = (size_t)(b * SEQ + s0 + tok2 + 32 * tt) * H3LD; \
            _Pragma("unroll") for (int qk = 0; qk < 2; ++qk) { const bf16_t* src_ = H3 + row_ + (qk ? kcol_ : qcol_) + pj; na[tt][qk] = __builtin_nontemporal_load((const u32x2*)src_); nc[tt][qk] = __builtin_nontemporal_load((const u32x2*)(src_ + 64)); } } \
        _Pragma("unroll") for (int i = 0; i < 2; ++i) { const int idx = F.tid + 512 * i; nv[i] = __builtin_nontemporal_load((const u32x4*)(H3 + (size_t)(b * SEQ + s0 + (idx >> 4)) * H3LD + vcol_ + (idx & 15) * 8)); } } while (0)
    RP_LOAD(0);
    float cs[2][4], sn[2][4];
    {   const float base = powf(10000.0f, -(float)pj * (1.0f / 64.0f));
        const float stp[4] = {1.0f, 0.8659643233600653f, 0.7498942093324559f, 0.6493816315762113f};
#pragma unroll
        for (int tt = 0; tt < 2; ++tt)
#pragma unroll
            for (int i = 0; i < 4; ++i) { const float ang = (float)(s0 + tok2 + 32 * tt) * (base * stp[i]);
                const float fr = (float)__builtin_amdgcn_fract((double)ang * 0.15915494309189535);
                sn[tt][i] = __builtin_amdgcn_sinf(fr); cs[tt][i] = __builtin_amdgcn_cosf(fr); }
    }
    for (int hi = 0; hi < 8; ++hi) {
        const int hd = hh * 8 + hi, dl = head_dil_log2(hd);
        const size_t hb = (size_t)(b * 16 + hd) * 2048;
        u32x2 ca[2][2], cc[2][2]; u32x4 cv[2];
#pragma unroll
        for (int tt = 0; tt < 2; ++tt)
#pragma unroll
            for (int qk = 0; qk < 2; ++qk) { ca[tt][qk] = na[tt][qk]; cc[tt][qk] = nc[tt][qk]; }
        cv[0] = nv[0]; cv[1] = nv[1];
        if (hi + 1 < 8) RP_LOAD(hi + 1);
#pragma unroll
        for (int tt = 0; tt < 2; ++tt) {
            const int tl = tok2 + 32 * tt, s = s0 + tl; const size_t orow = (hb + posp(s, dl)) * 128;
#pragma unroll
            for (int qk = 0; qk < 2; ++qk) {
                const u32x2 a = ca[tt][qk], c = cc[tt][qk];
                const float x1[4] = {bflo(a.x), bfhi(a.x), bflo(a.y), bfhi(a.y)}, x2[4] = {bflo(c.x), bfhi(c.x), bflo(c.y), bfhi(c.y)};
                float y1[4], y2[4]; const float sc = qk ? 1.0f : QSCALE;
#pragma unroll
                for (int i = 0; i < 4; ++i) { y1[i] = (x1[i] * cs[tt][i] - x2[i] * sn[tt][i]) * sc; y2[i] = (x2[i] * cs[tt][i] + x1[i] * sn[tt][i]) * sc; }
                bf16_t* dst = (qk ? KR : QR) + orow + pj;
                u32x2 w1, w2; w1.x = pk2(y1[0], y1[1]); w1.y = pk2(y1[2], y1[3]); w2.x = pk2(y2[0], y2[1]); w2.y = pk2(y2[2], y2[3]);
                *(u32x2*)dst = w1; *(u32x2*)(dst + 64) = w2;
                if (qk && hd >= 12) {
#pragma unroll
                    for (int i = 0; i < 4; ++i) { KS[tl * 129 + pj + i] = y1[i]; KS[tl * 129 + 64 + pj + i] = y2[i]; }
                }
            }
        }
#pragma unroll
        for (int i = 0; i < 2; ++i) { const int idx = F.tid + 512 * i, tl = idx >> 4, pc = idx & 15;
            *(LAS u32x4*)(VL + tl * 136 + pc * 8) = cv[i]; }
        asm volatile("s_waitcnt lgkmcnt(0)" ::: "memory"); __builtin_amdgcn_s_barrier();
        if (hd >= 12 && F.tid < 128) { float sum = 0.f;
#pragma unroll 8
            for (int tl = 0; tl < 64; ++tl) sum += KS[tl * 129 + F.tid];
            KPART[((size_t)(b * 4 + hd - 12) * 32 + st) * 128 + F.tid] = sum; }
        {
            const int pp = posp(s0 + F.lane, dl);
#pragma unroll 4
            for (int i = 0; i < 16; ++i) { const int d = F.wave * 16 + i; VT[((size_t)(b * 16 + hd) * 128 + d) * 2048 + pp] = VL[F.lane * 136 + d]; }
        }
        asm volatile("s_waitcnt lgkmcnt(0)" ::: "memory"); __builtin_amdgcn_s_barrier();
    }
#undef RP_LOAD
}

template <int MODE>
__device__ __forceinline__ void attn_item(const Params& p, const Frame& F0, int b, int hd, int q0, int ktile_lo, int ktile_hi) {
    const Frame F = refresh(F0);
    const int lane = F.lane, fr = lane & 15, g = lane >> 4, wave = F.wave;
    unsigned char* scr = opq(p.ws) + WS_SCR;
    const size_t hb = (size_t)(b * 16 + hd);
    const bf16_t* Qg = (const bf16_t*)(scr + A_QR) + hb * 2048 * 128; const bf16_t* Kg = (const bf16_t*)(scr + A_KR) + hb * 2048 * 128; const bf16_t* Vg = (const bf16_t*)(scr + A_VT) + hb * 128 * 2048;
    constexpr int BUFB = 35840, OFF_V = 17408, OFF_KM = 71680;
    const int nq = q0 + 16 * wave + fr;
    bf16x8 qf[4];
#pragma unroll
    for (int kb = 0; kb < 4; ++kb) qf[kb] = NTL((const bf16x8*)(Qg + (size_t)nq * 128 + 32 * kb + 8 * g));
    u32x4 rk[2], rv[2];
#define AT_ISSUE(kt) do { _Pragma("unroll") for (int i = 0; i < 2; ++i) { const int idx = F.tid + 512 * i; \
        rk[i] = *(const u32x4*)(Kg + (size_t)((kt) * 64 + (idx >> 4)) * 128 + (idx & 15) * 8); rv[i] = *(const u32x4*)(Vg + (size_t)(idx >> 3) * 2048 + (kt) * 64 + (idx & 7) * 8); } } while (0)
#define AT_WRITE(bufp) do { _Pragma("unroll") for (int i = 0; i < 2; ++i) { const int idx = F.tid + 512 * i; \
        *(LAS u32x4*)((bufp) + ((idx >> 4) * 136 + (idx & 15) * 8) * 2) = rk[i]; *(LAS u32x4*)((bufp) + OFF_V + ((idx >> 3) * 72 + (idx & 7) * 8) * 2) = rv[i]; } } while (0)
    f32x4 oacc[8];
#pragma unroll
    for (int dt = 0; dt < 8; ++dt) oacc[dt] = (f32x4){0.f, 0.f, 0.f, 0.f};
    float mrun = -1e30f, lrun = 0.f;
    AT_ISSUE(ktile_lo);
    unsigned selmask = 0u;
    if (MODE == 1) {
        const int qb = q0 >> 8, h = hd - 12;
        LAS float* KM = (LAS float*)(F.lds + OFF_KM);
        const float* KPART = (const float*)(scr + A_KPART) + (size_t)(b * 4 + h) * 32 * 128;
#pragma unroll
        for (int i = 0; i < 2; ++i) { const int idx = F.tid + 512 * i, jb = idx >> 7, d = idx & 127;
            KM[idx] = (KPART[(4 * jb + 0) * 128 + d] + KPART[(4 * jb + 1) * 128 + d]) + (KPART[(4 * jb + 2) * 128 + d] + KPART[(4 * jb + 3) * 128 + d]); }
        __syncthreads();
        float gate[8];
#pragma unroll
        for (int jb = 0; jb < 8; ++jb) { float s = 0.f;
#pragma unroll
            for (int kb = 0; kb < 4; ++kb) { const u32x4 qq = __builtin_bit_cast(u32x4, qf[kb]); const LAS float* km = KM + jb * 128 + 32 * kb + 8 * g;
                const f32x4 k0 = *(const LAS f32x4*)km, k1 = *(const LAS f32x4*)(km + 4);
                s += (bflo(qq.x) * k0[0] + bfhi(qq.x) * k0[1]) + (bflo(qq.y) * k0[2] + bfhi(qq.y) * k0[3]) + (bflo(qq.z) * k1[0] + bfhi(qq.z) * k1[1]) + (bflo(qq.w) * k1[2] + bfhi(qq.w) * k1[3]); }
            s += xor16_f(s); s = xor32_sum(s); gate[jb] = s; }
#pragma unroll
        for (int jb = 0; jb < 8; ++jb) { int rank = 0;
#pragma unroll
            for (int j2 = 0; j2 < 8; ++j2) if (j2 != jb && j2 < qb) rank += (gate[j2] > gate[jb] || (gate[j2] == gate[jb] && j2 < jb)) ? 1 : 0;
            if (jb < qb && rank < 3) selmask |= 1u << jb; }
        __syncthreads();
    }
    AT_WRITE(F.lds);
    __syncthreads();
    for (int kt = ktile_lo; kt < ktile_hi; ++kt) {
        LAS unsigned char* buf = F.lds + ((kt - ktile_lo) & 1) * BUFB;
        if (kt + 1 < ktile_hi) AT_ISSUE(kt + 1);
        const LAS bf16_t* KL = (const LAS bf16_t*)buf; const LAS bf16_t* VL = (const LAS bf16_t*)(buf + OFF_V);
        f32x4 sT[4];
        {
            bf16x8 kf[16];
#pragma unroll
            for (int t4 = 0; t4 < 4; ++t4)
#pragma unroll
                for (int kb = 0; kb < 4; ++kb) kf[4 * t4 + kb] = *(const LAS bf16x8*)(KL + (16 * t4 + fr) * 136 + 32 * kb + 8 * g);
            __builtin_amdgcn_sched_barrier(0);
#pragma unroll
            for (int t4 = 0; t4 < 4; ++t4) { sT[t4] = (f32x4){0.f, 0.f, 0.f, 0.f};
#pragma unroll
                for (int kb = 0; kb < 4; ++kb) sT[t4] = mfma32(kf[4 * t4 + kb], qf[kb], sT[t4]); }
        }
        __builtin_amdgcn_sched_barrier(0);
        bf16x8 vf[16];
#pragma unroll
        for (int dt = 0; dt < 8; ++dt) { vf[2 * dt] = frag_perm(VL + (16 * dt + fr) * 72, 4 * g); vf[2 * dt + 1] = frag_perm(VL + (16 * dt + fr) * 72, 32 + 4 * g); }
        __builtin_amdgcn_sched_barrier(0);
        const int k0 = kt * 64; float mx = -1e30f;
        const float NEG = -__builtin_huge_valf();
#pragma unroll
        for (int t4 = 0; t4 < 4; ++t4)
#pragma unroll
            for (int r = 0; r < 4; ++r) { const int nk = k0 + 16 * t4 + 4 * g + r; bool v;
                if (MODE == 0) v = (nk <= nq) && (nq - nk <= 128);
                else v = ((k0 >> 8) == (q0 >> 8)) ? (nk <= nq) : (((selmask >> (k0 >> 8)) & 1u) != 0u);
                sT[t4][r] = v ? sT[t4][r] : NEG; mx = fmaxf(mx, sT[t4][r]); }
        mx = fmaxf(mx, xor16_f(mx)); mx = xor32_max(mx);
        const float mnew = fmaxf(mrun, mx), alpha = exp2f(mrun - mnew); mrun = mnew;
        float ps = 0.f;
#pragma unroll
        for (int t4 = 0; t4 < 4; ++t4)
#pragma unroll
            for (int r = 0; r < 4; ++r) { const float pv = exp2f(sT[t4][r] - mnew); sT[t4][r] = pv; ps += pv; }
        lrun = lrun * alpha + ps;
        const bf16x8 pb0 = pack8(sT[0], sT[1]), pb1 = pack8(sT[2], sT[3]);
#pragma unroll
        for (int dt = 0; dt < 8; ++dt) {
            oacc[dt] = oacc[dt] * alpha;
            oacc[dt] = mfma32(vf[2 * dt], pb0, oacc[dt]);
            oacc[dt] = mfma32(vf[2 * dt + 1], pb1, oacc[dt]);
        }
        if (kt + 1 < ktile_hi) AT_WRITE(F.lds + ((kt + 1 - ktile_lo) & 1) * BUFB);
        __syncthreads();
    }
#undef AT_ISSUE
#undef AT_WRITE
    lrun += xor16_f(lrun); lrun = xor32_sum(lrun);
    const float inv = 1.0f / lrun;
    if (MODE == 0) {
        bf16_t* og = (bf16_t*)(scr + A_OG) + ((size_t)(b * 12 + hd) * 2048 + nq) * 128;
#pragma unroll
        for (int dt = 0; dt < 8; ++dt) { u32x2 w; w.x = pk2(oacc[dt][0] * inv, oacc[dt][1] * inv); w.y = pk2(oacc[dt][2] * inv, oacc[dt][3] * inv); *(u32x2*)(og + 16 * dt + 4 * g) = w; }
        if (g == 0) ((float*)(scr + A_LSE))[(size_t)(b * 12 + hd) * 2048 + nq] = mrun + log2f(lrun);
    } else {
        unsigned char* oc = (opq(p.ws) + WS_OC) + (size_t)(b * SEQ + nq) * 1024 + 512 + (hd - 12) * 128;
        const float inv4 = inv * A_PRE;
#pragma unroll
        for (int dt = 0; dt < 8; ++dt) *(unsigned*)(oc + 16 * dt + 4 * g) = pk4_fp8(oacc[dt][0] * inv4, oacc[dt][1] * inv4, oacc[dt][2] * inv4, oacc[dt][3] * inv4);
    }
}

__device__ __forceinline__ void attn_phase(const Params& p, const Frame& F0) {
    const Frame F = refresh(F0);
    const int i = F.bid & 15, bhm = F.bid >> 4;
    const int nd = (i == 0) ? 7 : (i <= 2) ? 6 : (i <= 4) ? 5 : (i <= 6) ? 4 : (i <= 8) ? 3 : (i <= 10) ? 2 : (i == 11) ? 1 : 0;
    const int st = (i == 0) ? 0 : (i == 1) ? 7 : (i == 2) ? 13 : (i == 3) ? 19 : (i == 4) ? 24 : (i == 5) ? 29 : (i == 6) ? 33 : (i == 7) ? 37 : (i == 8) ? 40 : (i == 9) ? 43 : (i == 10) ? 45 : (i == 11) ? 47 : 48;
    const bool balanced = (F.G == 256);
    for (int k = 0;; ++k) {
        int it;
        if (balanced) { if (k > nd) break; it = (k == 0) ? (bhm * 16 + i) : (256 + bhm * 48 + st + k - 1); }
        else { it = F.bid + k * F.G; if (it >= 1024) break; }
        if (it < 256) { const int qt = it & 15; attn_item<1>(p, F, it >> 6, 12 + ((it >> 4) & 3), qt * 128, 0, 2 * (qt + 1)); }
        else { const int id = it - 256, qt = id & 15, hd = (id >> 4) % 12, b = (id >> 4) / 12, dl = head_dil_log2(hd); const int q0 = qt * 128, first = ((q0 & ((2048 >> dl) - 1)) == 0);
            attn_item<0>(p, F, b, hd, q0, first ? 2 * qt : 2 * qt - 2, 2 * qt + 2); }
    }
}

__device__ __forceinline__ void merge_pass(const Params& p, const Frame& F0) {
    const Frame F = refresh(F0);
    const int gw = F.bid * NWAVES + F.wave, NGW = F.G * NWAVES, hg = F.lane >> 4, d0 = (F.lane & 15) * 8;
    unsigned char* scr = opqg(p.ws) + WS_SCR;
    const bf16_t* OG = (const bf16_t*)(scr + A_OG); const float* LSE = (const float*)(scr + A_LSE); bf16_t* OC = (bf16_t*)(opqg(p.ws) + WS_OC);
    for (int m0 = gw; m0 < T; m0 += 4 * NGW) {
        float ls[4][3]; u32x4 ov[4][3];
#pragma unroll
        for (int j = 0; j < 4; ++j) { const int m = min(m0 + j * NGW, T - 1), b = m >> 11, s = m & 2047;
#pragma unroll
            for (int gi = 0; gi < 3; ++gi) { const int hd = 4 * gi + hg; const size_t idx = (size_t)(b * 12 + hd) * 2048 + posp(s, 2 * gi); ls[j][gi] = NTL(LSE + idx); ov[j][gi] = NTL((const u32x4*)(OG + idx * 128 + d0)); } }
#pragma unroll
        for (int j = 0; j < 4; ++j) { const int m = m0 + j * NGW; if (m >= T) break;
            const float mx = fmaxf(ls[j][0], fmaxf(ls[j][1], ls[j][2]));
            float w[3]; float ws = 0.f;
#pragma unroll
            for (int gi = 0; gi < 3; ++gi) { w[gi] = exp2f(ls[j][gi] - mx); ws += w[gi]; }
            const float inv = 1.0f / ws;
            float o[8] = {0.f, 0.f, 0.f, 0.f, 0.f, 0.f, 0.f, 0.f};
#pragma unroll
            for (int gi = 0; gi < 3; ++gi) { const float wg = w[gi] * inv; const u32x4 v = ov[j][gi];
                o[0] += wg * bflo(v.x); o[1] += wg * bfhi(v.x); o[2] += wg * bflo(v.y); o[3] += wg * bfhi(v.y);
                o[4] += wg * bflo(v.z); o[5] += wg * bfhi(v.z); o[6] += wg * bflo(v.w); o[7] += wg * bfhi(v.w); }
            u32x2 wv; wv.x = pk4_fp8(o[0] * A_PRE, o[1] * A_PRE, o[2] * A_PRE, o[3] * A_PRE); wv.y = pk4_fp8(o[4] * A_PRE, o[5] * A_PRE, o[6] * A_PRE, o[7] * A_PRE);
            *(u32x2*)((unsigned char*)OC + (size_t)m * 1024 + hg * 128 + d0) = wv;
        }
    }
}

#define GRID_SYNC() xcd_barrier((unsigned*)(opq(p.ws) + WS_CTL), (volatile LAS unsigned*)(F.lds + LDS_BYTES - 16), F.wave)
#ifndef REPMASK
#define REPMASK 0u
#endif
__device__ __forceinline__ int repn(int k) { int n = 1 + (int)(((REPMASK) >> k) & 1u); asm volatile("" : "+s"(n)); return n; }
#define RP(k) for (int _r = 0, _n = repn(k); _r < _n; ++_r)
__global__ void __launch_bounds__(NTHR, 2) mk_fwd(Params p) {
    extern __shared__ __attribute__((aligned(16))) unsigned char lds_raw[];
    Frame F; F.lds = (LAS unsigned char*)lds_raw; F.tid = 0; F.lane = 0; F.wave = __builtin_amdgcn_readfirstlane(threadIdx.x >> 6); F.G = gridDim.x; F.bid = blockIdx.x;
#define P_WS (opq(p.ws))
#define P_AB ((bf16_t*)(opq(p.ws) + WS_AB))
#define P_R (opq(p.out))
#define P_MIX ((bf16_t*)(opq(p.ws) + WS_MIX))
#define P_HID ((bf16_t*)(opq(p.ws) + WS_HID))
#define P_Y2 ((bf16_t*)(opq(p.ws) + WS_Y2))

    {
        if (threadIdx.x == 0) { volatile LAS unsigned* st = (volatile LAS unsigned*)(F.lds + LDS_BYTES - 16); st[0] = 0u; st[1] = 0u;
            (void)xb_add((unsigned*)(p.ws + WS_CTL) + XB_XCNT(xb_xcc_id()), 1u); }
        __syncthreads();
    }
    RP(0) { convert_set(p, F, 0, F.bid * NWAVES + F.wave, F.G * NWAVES); __syncthreads(); }
    RP(1) { load_w16_lds(F, p.in[I_EV_WIN], EVEN_IN, 4096); __syncthreads(); p0_xpass(p, F); __syncthreads(); }
    GRID_SYNC();

    RP(2) {
        pg8::StaticOrder S; S.init(T, 8192, F.G, F.bid);
        pg8::Gemm g{(const unsigned char*)(P_WS + WS_AB), (const unsigned char*)(P_WS + WS_WIN), 2048, (unsigned)(T * 2048), (unsigned)(8192 * 2048), SC_A16};
        pg8::EpiBf16 E{(bf16_t*)(P_WS + WS_H1), H1LD, (unsigned)(T * 8192 * 2)};
        pg8::gemm_phase(F.lds, F.wave, g, S, E);
    }
    GRID_SYNC();
    RP(3) { p2_pre(p, F); }
    GRID_SYNC();
    RP(4) { if (F.bid < 32) gdn_scan(p, F, F.bid); else if (F.bid < 64) hgrn_scan(p, F, F.bid - 32);
            else if (F.G > 64) convert_set(p, F, 1, (F.bid - 64) * NWAVES + F.wave, (F.G - 64) * NWAVES); }
    if (F.G <= 64) { convert_set(p, F, 1, F.bid * NWAVES + F.wave, F.G * NWAVES); }
    GRID_SYNC();
    RP(5) { p4_gate(p, F); }
    GRID_SYNC();
    RP(6) {
        pg8::StaticOrder S; S.init(T, 2048, F.G, F.bid);
        pg8::Gemm g{(const unsigned char*)(P_WS + WS_OC), (const unsigned char*)(P_WS + WS_WOUT), 2048, (unsigned)(T * 2048), (unsigned)(2048 * 2048), SC_A4};
        pg8::EpiBf16 E{P_MIX, 2048, (unsigned)(T * 2048 * 2)};
        pg8::gemm_phase(F.lds, F.wave, g, S, E);
    }
    GRID_SYNC();
#define MOE_BLOCK(layer, resid, mixp, outfinal, outb2) do { \
        for (int _r = 0, _n = ((layer) == 0 ? repn(7) : 1); _r < _n; ++_r) { load_w16_lds(F, p.in[I_RW], 16, 0); __syncthreads(); \
            ln_pass<true, false, (layer) != 0, true>(p, F, resid, mixp, D, nullptr, p.in[I_LNG] + (size_t)((layer) * 2 + 0) * D, p.in[I_LNB] + (size_t)((layer) * 2 + 0) * D, P_R, P_AB, layer); __syncthreads(); } \
        GRID_SYNC(); \
        const int* list = (const int*)(P_WS + WS_LIST) + (size_t)(layer) * NE * T; \
        const float* gatew = (const float*)(P_WS + WS_GATEW) + (size_t)(layer) * 2 * T; \
        RP(8) { moe_lists(p, F, layer); } \
        GRID_SYNC(); \
        { const Frame Fr = refresh(F); pg8::moe_build_table(F.lds, Fr.tid); } \
        unsigned* tcnt = (unsigned*)(P_WS + WS_CTL) + 3600 + 128 * (layer);        \
        { pg8::MoeOrder<4, false> S; S.init(F.lds, list, F.G, F.bid, 1024, tcnt); \
            pg8::Gemm g{(const unsigned char*)(P_WS + WS_ABS), (const unsigned char*)(P_WS + ((layer) ? WS_WGU1 : WS_WGU)), 2048, (unsigned)(20480 * 2048), (unsigned)(NE * 1024 * 2048), SC_A1}; \
            pg8::EpiGateUpB E{P_HID, list, gatew}; pg8::gemm_phase(F.lds, F.wave, g, S, E); } \
          \
        { pg8::MoeDownS S; S.init(F.lds, tcnt, 2048, F.G, F.bid, (layer) ? (int)((WS_WD - WS_WIN) / 1024) : 0); \
            pg8::Gemm16 g{P_HID, (const bf16_t*)(P_WS + ((layer) ? WS_WIN : WS_WD)), 512, (unsigned)(20480 * 512 * 2), (layer) ? (unsigned)(WS_WD - WS_WIN + NE * 2048 * 512 * 2) : (unsigned)(NE * 2048 * 512 * 2)}; \
            pg8::EpiDown E{P_Y2, list}; pg8::gemm_phase16(F.lds, F.wave, g, S, E); } \
        GRID_SYNC(); \
        ln_pass<false, true, true, (layer) == 0>(p, F, P_R, P_Y2, D, P_Y2, p.in[I_LNG] + (size_t)((layer) * 2 + 1) * D, p.in[I_LNB] + (size_t)((layer) * 2 + 1) * D, outfinal, outb2, layer); \
    } while (0)
    MOE_BLOCK(0, p.in[I_X], P_MIX, P_R, (bf16_t*)(P_WS + WS_AB8));
    __syncthreads();
    RP(11) { convert_set(p, F, 2, F.bid * NWAVES + F.wave, F.G * NWAVES); __syncthreads(); }
    GRID_SYNC();
    RP(12) {
        pg8::StaticOrder S; S.init(T, 6144, F.G, F.bid);
        pg8::Gemm g{(const unsigned char*)(P_WS + WS_AB8), (const unsigned char*)(P_WS + WS_W3), 2048, (unsigned)(T * 2048), (unsigned)(6144 * 2048), SC_A1};
        pg8::EpiBf16 E{(bf16_t*)(P_WS + WS_H1), H3LD, (unsigned)(T * 6144 * 2)};
        pg8::gemm_phase(F.lds, F.wave, g, S, E);
    }
    GRID_SYNC();
    RP(13) { const Frame Fr = refresh(F); for (int u = Fr.bid; u < 256; u += Fr.G) rope_unit(p, Fr, (u & 7) * 32 + (u >> 3)); }
    GRID_SYNC();
    RP(14) { attn_phase(p, F); }
    GRID_SYNC();
    RP(15) { merge_pass(p, F); }
    GRID_SYNC();
    RP(16) {
        pg8::StaticOrder S; S.init(T, 2048, F.G, F.bid);
        pg8::Gemm g{(const unsigned char*)(P_WS + WS_OC), (const unsigned char*)(P_WS + WS_WOUT1), 1024, (unsigned)(T * 1024), (unsigned)(2048 * 1024), SC_A4};
        pg8::EpiBf16 E{P_MIX, 2048, (unsigned)(T * 2048 * 2)};
        pg8::gemm_phase(F.lds, F.wave, g, S, E);
    }
    GRID_SYNC();
    MOE_BLOCK(1, P_R, P_MIX, p.out, (bf16_t*)nullptr);
#undef MOE_BLOCK
#undef P_WS
#undef P_AB
#undef P_R
#undef P_MIX
#undef P_HID
#undef P_Y2
}

extern "C" void kernel_launch(void* const* d_in, const int* in_sizes, int n_in, void* d_out, int out_size,
                              void* d_ws, size_t ws_size, hipStream_t stream) {
    static int grid_blocks = 0;
    if (!grid_blocks) {
        int dev = 0, cus = 0, per_cu = 0;
        (void)hipGetDevice(&dev);
        (void)hipDeviceGetAttribute(&cus, hipDeviceAttributeMultiprocessorCount, dev);
        (void)hipFuncSetAttribute((const void*)mk_fwd, hipFuncAttributeMaxDynamicSharedMemorySize, LDS_BYTES);
        (void)hipOccupancyMaxActiveBlocksPerMultiprocessor(&per_cu, (const void*)mk_fwd, NTHR, LDS_BYTES);
        if (per_cu < 1) fprintf(stderr, "kernel_launch: occupancy query says %d blocks per CU\n", per_cu);
        grid_blocks = cus;
        if (ws_size < WS_END) { fprintf(stderr, "kernel_launch: workspace too small: %zu < %zu\n", ws_size, (size_t)WS_END); grid_blocks = -1; }
        if (n_in != 18) { fprintf(stderr, "kernel_launch: expected 18 inputs, got %d\n", n_in); grid_blocks = -1; }
    }
    if (grid_blocks < 0) return;
    Params p{};
    for (int i = 0; i < 18; ++i) p.in[i] = (const float*)d_in[i];
    p.out = (float*)d_out; p.ws = (unsigned char*)d_ws;
    (void)hipMemsetAsync(d_ws, 0, 16384, stream);
    void* args[] = {&p};
    hipError_t e = hipLaunchCooperativeKernel((void*)mk_fwd, dim3(grid_blocks), dim3(NTHR), args, LDS_BYTES, stream);
    if (e != hipSuccess) fprintf(stderr, "cooperative launch failed: %s (grid %d)\n", hipGetErrorString(e), grid_blocks);
}
```
